# Optimizing an MI355X kernel written in HIP

```python
import jax
import jax.numpy as jnp
from jax import lax
import numpy as np

D_MODEL = 2048
BATCH = 8
SEQ = 4096
DEPTH = 2

D_MIX = D_MODEL
N_GROUPS = 4
GROUP_W = D_MIX // N_GROUPS
HG_HEADS = 4
HG_DIM = GROUP_W // HG_HEADS
HG_CHUNK = 64
RW_HEAD = 64
RW_HEADS = GROUP_W // RW_HEAD
RW_W_LORA = 32
RW_A_LORA = 32
RW_G_LORA = 96
RW_LN_EPS = 64e-5
ML_HEADS = 4
ML_DIM = GROUP_W // ML_HEADS
ML_CHUNK = 64
ML_CONV = 4
ML_QK_BLOCK = 4
NEG_BIG = -1e30
LRU_BLOCKS = 4
LRU_BLOCK = GROUP_W // LRU_BLOCKS
LRU_C = 8.0
LRU_CONV = 4
D_FF = 5632
N_SUB = 3
NORM_EPS = 1e-6
HG_IN = 4 * GROUP_W
RW_IN = 3 * GROUP_W + RW_W_LORA + RW_A_LORA + RW_G_LORA
ML_IN = 3 * GROUP_W + 2 * ML_HEADS
LRU_IN = 2 * GROUP_W
D_IN = HG_IN + RW_IN + ML_IN + LRU_IN

kernel_name = "hymba_style_hgrn2_rwkv7_mlstm_rglru_macaron_adaln"


def _split(a, sizes):
    return jnp.split(a, np.cumsum(sizes)[:-1].tolist(), axis=-1)


def _rmsnorm(x, w, eps=NORM_EPS):
    x32 = x.astype(jnp.float32)
    y = x32 * lax.rsqrt(jnp.mean(x32 * x32, axis=-1, keepdims=True) + eps)
    return (y * w.astype(jnp.float32)).astype(x.dtype)


def _head_rmsnorm(x, w, n_heads, eps=NORM_EPS):
    shp = x.shape
    xh = x.astype(jnp.float32).reshape(*shp[:-1], n_heads, shp[-1] // n_heads)
    xh = xh * lax.rsqrt(jnp.mean(xh * xh, axis=-1, keepdims=True) + eps)
    return xh.reshape(shp) * w.astype(jnp.float32)


def _modulate(x, gain, shift, scale):
    return _rmsnorm(x, gain) * (1.0 + scale[:, None, :]) + shift[:, None, :]


def _swiglu(h, w1, w3, w2):
    return (jax.nn.silu(h @ w1) * (h @ w3)) @ w2


def _token_shift(u):
    return jnp.pad(u[:, :-1], ((0, 0), (1, 0), (0, 0)))


def _causal_dwconv(x, w, b):
    width = w.shape[0]
    y = lax.conv_general_dilated(
        x, w[:, None, :].astype(x.dtype), window_strides=(1,), padding=[(width - 1, 0)],
        dimension_numbers=("NWC", "WIO", "NWC"), feature_group_count=x.shape[-1])
    return y + b


def _to_chunks(a, chunk):
    bsz, seqlen = a.shape[:2]
    a = a.reshape(bsz, seqlen // chunk, chunk, *a.shape[2:])
    return a.transpose((1, 0, 3, 2) + tuple(range(4, a.ndim)))


def _from_chunks(a):
    nc, bsz, nh, chunk = a.shape[:4]
    a = a.transpose((1, 0, 3, 2) + tuple(range(4, a.ndim)))
    return a.reshape(bsz, nc * chunk, nh, *a.shape[4:])


def _gla_chunked(q, k, v, log_f):
    bsz, _, nh, dk = q.shape
    dv = v.shape[-1]
    causal = jnp.tril(jnp.ones((HG_CHUNK, HG_CHUNK), bool))[:, :, None]

    def step(S, inp):
        q_c, k_c, v_c, g_c = inp
        b = jnp.cumsum(g_c, axis=2)
        diff = b[:, :, :, None, :] - b[:, :, None, :, :]
        decay = jnp.where(causal, jnp.exp(jnp.where(causal, diff, 0.0)), 0.0)
        scores = jnp.einsum("bhtk,bhtsk,bhsk->bhts", q_c, decay, k_c)
        o = (jnp.einsum("bhts,bhsv->bhtv", scores, v_c)
             + jnp.einsum("bhtk,bhkv->bhtv", q_c * jnp.exp(b), S))
        b_last = b[:, :, -1:, :]
        S = (jnp.exp(b_last[:, :, 0, :])[..., None] * S
             + jnp.einsum("bhsk,bhsv->bhkv", k_c * jnp.exp(b_last - b), v_c))
        return S, o

    S0 = jnp.zeros((bsz, nh, dk, dv), jnp.float32)
    _, o = lax.scan(step, S0, tuple(_to_chunks(a, HG_CHUNK) for a in (q, k, v, log_f)))
    return _from_chunks(o)


def _hgrn2(u, lb, g_norm):
    bsz, seqlen, _ = u.shape
    q_raw, f_raw, i_raw, g_raw = _split(u, (GROUP_W,) * 4)
    heads = lambda a: a.reshape(bsz, seqlen, HG_HEADS, HG_DIM)
    q = jax.nn.silu(q_raw)
    log_f = jnp.log(lb + (1.0 - lb) * jax.nn.sigmoid(f_raw))
    k = (1.0 - lb) * jax.nn.sigmoid(-f_raw)
    o = _gla_chunked(heads(q), heads(k), heads(i_raw), heads(log_f))
    o = _head_rmsnorm(o.reshape(bsz, seqlen, GROUP_W), g_norm, HG_HEADS)
    return o * jax.nn.silu(g_raw)


def _wkv7_scan(r, w, k, v, a, b):
    bsz, _, nh, n = r.shape

    def step(S, inp):
        r_t, w_t, k_t, v_t, a_t, b_t = inp
        sa = jnp.einsum("bhvk,bhk->bhv", S, a_t)
        S = (S * w_t[:, :, None, :] + sa[..., None] * b_t[:, :, None, :]
             + v_t[..., None] * k_t[:, :, None, :])
        return S, jnp.einsum("bhvk,bhk->bhv", S, r_t)

    S0 = jnp.zeros((bsz, nh, n, n), jnp.float32)
    _, o = lax.scan(step, S0, tuple(jnp.moveaxis(t, 1, 0) for t in (r, w, k, v, a, b)))
    return jnp.moveaxis(o, 0, 1)


def _rwkv7(u, mu, w0, w2, a0, a2, g2, k_k, k_a, r_k, ln_w, ln_b):
    bsz, seqlen, _ = u.shape
    u = u + (_token_shift(u) - u) * mu
    r, k, v, wd, ad, gd = _split(u, (GROUP_W, GROUP_W, GROUP_W, RW_W_LORA, RW_A_LORA, RW_G_LORA))
    w_log = -jax.nn.softplus(-(w0 + jnp.tanh(wd) @ w2)) - 0.5
    decay = jnp.exp(-jnp.exp(w_log))
    a = jax.nn.sigmoid(a0 + ad @ a2)
    g = jax.nn.sigmoid(gd) @ g2
    heads = lambda t: t.reshape(bsz, seqlen, RW_HEADS, RW_HEAD)
    kk = heads(k * k_k)
    kk = kk / jnp.maximum(jnp.sqrt(jnp.sum(kk * kk, axis=-1, keepdims=True) + 1e-12), 1e-6)
    k = k * (1.0 + (a - 1.0) * k_a)
    rh, kh, vh = heads(r), heads(k), heads(v)
    o = _wkv7_scan(rh, heads(decay), kh, vh, -kk, kk * heads(a))
    mean = jnp.mean(o, axis=-1, keepdims=True)
    var = jnp.mean(jnp.square(o - mean), axis=-1, keepdims=True)
    o = ((o - mean) * lax.rsqrt(var + RW_LN_EPS)).reshape(bsz, seqlen, GROUP_W) * ln_w + ln_b
    bonus = jnp.sum(rh * kh * r_k, axis=-1, keepdims=True) * vh
    return (o + bonus.reshape(bsz, seqlen, GROUP_W)) * g


def _mlstm_chunked(q, k, v, i_pre, log_f):
    bsz, _, nh, dk = q.shape
    dv = v.shape[-1]
    causal = jnp.tril(jnp.ones((ML_CHUNK, ML_CHUNK), bool))

    def step(carry, inp):
        M, n, m = carry
        q_c, k_c, v_c, i_c, f_c = inp
        b = jnp.cumsum(f_c, axis=-1)
        lw = b[..., :, None] - b[..., None, :] + i_c[..., None, :]
        lprev = b + m[..., None]
        m_t = jnp.maximum(lprev, jnp.max(jnp.where(causal, lw, NEG_BIG), axis=-1))
        wts = jnp.where(causal, jnp.exp(jnp.where(causal, lw - m_t[..., None], 0.0)), 0.0)
        s = jnp.einsum("bhtd,bhsd->bhts", q_c, k_c) * wts
        wp = jnp.exp(lprev - m_t)
        num = jnp.einsum("bhts,bhsv->bhtv", s, v_c) + wp[..., None] * jnp.einsum("bhtk,bhkv->bhtv", q_c, M)
        den = jnp.sum(s, axis=-1) + wp * jnp.einsum("bhtk,bhk->bht", q_c, n)
        h = num / jnp.maximum(jnp.abs(den), jnp.exp(-m_t))[..., None]
        m_new = m_t[..., -1]
        wl = jnp.exp(b[..., -1:] - b + i_c - m_new[..., None])
        dec = jnp.exp(b[..., -1] + m - m_new)
        M = dec[..., None, None] * M + jnp.einsum("bhs,bhsk,bhsv->bhkv", wl, k_c, v_c)
        n = dec[..., None] * n + jnp.einsum("bhs,bhsk->bhk", wl, k_c)
        return (M, n, m_new), h

    carry0 = (jnp.zeros((bsz, nh, dk, dv), jnp.float32), jnp.zeros((bsz, nh, dk), jnp.float32),
              jnp.zeros((bsz, nh), jnp.float32))
    _, h = lax.scan(step, carry0, tuple(_to_chunks(a, ML_CHUNK) for a in (q, k, v, i_pre, log_f)))
    return _from_chunks(h)


def _mlstm(u, conv_w, conv_b, wq, wk, i_b, f_b, norm_w, skip):
    bsz, seqlen, _ = u.shape
    xm, v, o_raw, i_raw, f_raw = _split(u, (GROUP_W, GROUP_W, GROUP_W, ML_HEADS, ML_HEADS))
    xc = jax.nn.silu(_causal_dwconv(xm, conv_w, conv_b))
    blocks = xc.reshape(bsz, seqlen, GROUP_W // ML_QK_BLOCK, ML_QK_BLOCK)
    q = jnp.einsum("btnj,nji->btni", blocks, wq).reshape(bsz, seqlen, ML_HEADS, ML_DIM) * ML_DIM ** -0.5
    k = jnp.einsum("btnj,nji->btni", blocks, wk).reshape(bsz, seqlen, ML_HEADS, ML_DIM)
    h = _mlstm_chunked(q, k, v.reshape(bsz, seqlen, ML_HEADS, ML_DIM),
                       i_raw + i_b, jax.nn.log_sigmoid(f_raw + f_b))
    h = jax.nn.sigmoid(o_raw) * h.reshape(bsz, seqlen, GROUP_W)
    return _head_rmsnorm(h, norm_w, ML_HEADS) + skip * xc


def _rglru(u, conv_w, conv_b, wa, ba, wx, bx, lam, norm_w):
    bsz, seqlen, _ = u.shape
    xb, gb = _split(u, (GROUP_W, GROUP_W))
    xc = _causal_dwconv(xb, conv_w, conv_b)
    blocks = xc.reshape(bsz, seqlen, LRU_BLOCKS, LRU_BLOCK)
    r = jax.nn.sigmoid(jnp.einsum("btni,nij->btnj", blocks, wa).reshape(bsz, seqlen, GROUP_W) + ba)
    i = jax.nn.sigmoid(jnp.einsum("btni,nij->btnj", blocks, wx).reshape(bsz, seqlen, GROUP_W) + bx)
    log_a = -LRU_C * r * jax.nn.softplus(-lam)
    a = jnp.exp(log_a)
    bterm = jnp.sqrt(-jnp.expm1(2.0 * log_a)) * (i * xc)

    def combine(p, s):
        return p[0] * s[0], s[0] * p[1] + s[1]

    _, h = lax.associative_scan(combine, (a, bterm), axis=1)
    return _rmsnorm(h * jax.nn.gelu(gb), norm_w)


def setup_inputs(seed: int = 0) -> dict:
    key = jax.random.key(seed)
    ks = iter(jax.random.split(key, 64))

    def nrm(shape, scale):
        return scale * jax.random.normal(next(ks), shape, jnp.float32)

    chan = jnp.arange(GROUP_W, dtype=jnp.float32) / (GROUP_W - 1)
    a8 = jax.random.uniform(next(ks), (DEPTH, GROUP_W), jnp.float32, 0.9, 0.999)
    a_lru = a8 ** (1.0 / LRU_C)
    return {
        "x": nrm((BATCH, SEQ, D_MODEL), 1.0),
        "c": nrm((BATCH, D_MODEL), 1.0),
        "norm_gain": 1.0 + nrm((DEPTH, N_SUB, D_MODEL), 0.02),
        "mod_w": nrm((DEPTH, D_MODEL, N_SUB * 3 * D_MODEL), 0.2 * D_MODEL ** -0.5),
        "mod_b": nrm((DEPTH, N_SUB * 3 * D_MODEL), 0.02),
        "ffn_w1": nrm((DEPTH, 2, D_MODEL, D_FF), D_MODEL ** -0.5),
        "ffn_w3": nrm((DEPTH, 2, D_MODEL, D_FF), D_MODEL ** -0.5),
        "ffn_w2": nrm((DEPTH, 2, D_FF, D_MODEL), D_FF ** -0.5),
        "w_in": nrm((DEPTH, D_MODEL, D_IN), D_MODEL ** -0.5),
        "w_out": nrm((DEPTH, D_MIX, D_MODEL), D_MIX ** -0.5),
        "hg_lb_logits": nrm((DEPTH, GROUP_W), 0.5),
        "hg_norm": 1.0 + nrm((DEPTH, GROUP_W), 0.02),
        "rw_mu": jax.random.uniform(next(ks), (DEPTH, RW_IN), jnp.float32, 0.0, 1.0),
        "rw_w0": (-6.5 + 5.0 * chan ** 0.85) + nrm((DEPTH, GROUP_W), 0.1),
        "rw_w2": nrm((DEPTH, RW_W_LORA, GROUP_W), 0.1),
        "rw_a0": nrm((DEPTH, GROUP_W), 0.1),
        "rw_a2": nrm((DEPTH, RW_A_LORA, GROUP_W), 0.1),
        "rw_g2": nrm((DEPTH, RW_G_LORA, GROUP_W), RW_G_LORA ** -0.5),
        "rw_kk": 0.85 + nrm((DEPTH, GROUP_W), 0.02),
        "rw_ka": 1.0 + nrm((DEPTH, GROUP_W), 0.02),
        "rw_rk": -0.04 + nrm((DEPTH, RW_HEADS, RW_HEAD), 0.02),
        "rw_ln_w": 1.0 + nrm((DEPTH, GROUP_W), 0.02),
        "rw_ln_b": nrm((DEPTH, GROUP_W), 0.02),
        "ml_conv_w": nrm((DEPTH, ML_CONV, GROUP_W), ML_CONV ** -0.5),
        "ml_conv_b": nrm((DEPTH, GROUP_W), 0.02),
        "ml_wq": nrm((DEPTH, GROUP_W // ML_QK_BLOCK, ML_QK_BLOCK, ML_QK_BLOCK), ML_QK_BLOCK ** -0.5),
        "ml_wk": nrm((DEPTH, GROUP_W // ML_QK_BLOCK, ML_QK_BLOCK, ML_QK_BLOCK), ML_QK_BLOCK ** -0.5),
        "ml_i_b": nrm((DEPTH, ML_HEADS), 0.1),
        "ml_f_b": jnp.linspace(3.0, 6.0, ML_HEADS, dtype=jnp.float32) + nrm((DEPTH, ML_HEADS), 0.1),
        "ml_norm": 1.0 + nrm((DEPTH, GROUP_W), 0.02),
        "ml_skip": 1.0 + nrm((DEPTH, GROUP_W), 0.02),
        "lru_conv_w": nrm((DEPTH, LRU_CONV, GROUP_W), LRU_CONV ** -0.5),
        "lru_conv_b": nrm((DEPTH, GROUP_W), 0.02),
        "lru_wa": nrm((DEPTH, LRU_BLOCKS, LRU_BLOCK, LRU_BLOCK), LRU_BLOCK ** -0.5),
        "lru_ba": nrm((DEPTH, GROUP_W), 0.02),
        "lru_wx": nrm((DEPTH, LRU_BLOCKS, LRU_BLOCK, LRU_BLOCK), LRU_BLOCK ** -0.5),
        "lru_bx": nrm((DEPTH, GROUP_W), 0.02),
        "lru_lambda": jnp.log(a_lru) - jnp.log1p(-a_lru),
        "lru_norm": 1.0 + nrm((DEPTH, GROUP_W), 0.02),
        "final_norm": 1.0 + nrm((D_MODEL,), 0.02),
    }


def reference(x, c, norm_gain, mod_w, mod_b, ffn_w1, ffn_w3, ffn_w2, w_in, w_out,
              hg_lb_logits, hg_norm, rw_mu, rw_w0, rw_w2, rw_a0, rw_a2, rw_g2, rw_kk, rw_ka,
              rw_rk, rw_ln_w, rw_ln_b, ml_conv_w, ml_conv_b, ml_wq, ml_wk, ml_i_b, ml_f_b,
              ml_norm, ml_skip, lru_conv_w, lru_conv_b, lru_wa, lru_ba, lru_wx, lru_bx,
              lru_lambda, lru_norm, final_norm):
    lb_w = jax.nn.softmax(hg_lb_logits.astype(jnp.float32), axis=0)
    lower_bounds = jnp.cumsum(lb_w, axis=0) - lb_w[0]
    c_act = jax.nn.silu(c)
    for l in range(DEPTH):
        mod = (c_act @ mod_w[l] + mod_b[l]).reshape(c.shape[0], N_SUB, 3, D_MODEL)
        shift, scale, gate = mod[:, :, 0], mod[:, :, 1], mod[:, :, 2]

        h = _modulate(x, norm_gain[l, 0], shift[:, 0], scale[:, 0])
        x = x + 0.5 * (1.0 + gate[:, 0, None, :]) * _swiglu(h, ffn_w1[l, 0], ffn_w3[l, 0], ffn_w2[l, 0])

        h = _modulate(x, norm_gain[l, 1], shift[:, 1], scale[:, 1])
        u = (h @ w_in[l]).astype(jnp.float32)
        u_hg, u_rw, u_ml, u_lru = _split(u, (HG_IN, RW_IN, ML_IN, LRU_IN))
        y_hg = _hgrn2(u_hg, lower_bounds[l], hg_norm[l])
        y_rw = _rwkv7(u_rw, rw_mu[l], rw_w0[l], rw_w2[l], rw_a0[l], rw_a2[l], rw_g2[l],
                      rw_kk[l], rw_ka[l], rw_rk[l], rw_ln_w[l], rw_ln_b[l])
        y_ml = _mlstm(u_ml, ml_conv_w[l], ml_conv_b[l], ml_wq[l], ml_wk[l], ml_i_b[l],
                      ml_f_b[l], ml_norm[l], ml_skip[l])
        y_lru = _rglru(u_lru, lru_conv_w[l], lru_conv_b[l], lru_wa[l], lru_ba[l], lru_wx[l],
                       lru_bx[l], lru_lambda[l], lru_norm[l])
        y = jnp.concatenate([y_hg, y_rw, y_ml, y_lru], axis=-1).astype(x.dtype)
        x = x + (1.0 + gate[:, 1, None, :]) * (y @ w_out[l])

        h = _modulate(x, norm_gain[l, 2], shift[:, 2], scale[:, 2])
        x = x + 0.5 * (1.0 + gate[:, 2, None, :]) * _swiglu(h, ffn_w1[l, 1], ffn_w3[l, 1], ffn_w2[l, 1])
    return _rmsnorm(x, final_norm)
```

```cpp
#include <hip/hip_runtime.h>
#include <cstdio>
#include <cstdint>
namespace pg8 {
#define PG8_LAS __attribute__((address_space(3)))
typedef unsigned short bf16_t;
typedef short bf16x8 __attribute__((ext_vector_type(8)));
typedef float f32x4 __attribute__((ext_vector_type(4)));
typedef unsigned u32x4 __attribute__((ext_vector_type(4)));
constexpr int BM = 256, BK = 64, HALF = 128, HTB = HALF * BK * 2  , STAGE_BYTES = 8 * HTB, NXCD = 8, WGM = 8;

__host__ __device__ __forceinline__ int lds_byte(int r, int c) { const int st = (r >> 4) * 2 + (c >> 5), rr = r & 15, cc = c & 31, ob = rr * 64 + cc * 2; return st * 1024 + (ob ^ (((ob >> 9) & 1) << 5)); }
__host__ __device__ __forceinline__ void stage_rc(int b, int& R, int& C) { const int st = b / 1024, sb = b % 1024, swz = sb ^ (((sb >> 9) & 1) << 5); R = (st >> 1) * 16 + swz / 64; C = (st & 1) * 32 + (swz % 64) / 2; }
__host__ __device__ __forceinline__ int perm32(int rho) { const int n = rho >> 4, i = rho & 15; return 8 * (i >> 2) + 4 * n + (i & 3); }

struct Unit { int pm, pn; };
struct Gemm { const bf16_t* A; const bf16_t* Bt; int M, N, K; };

struct StaticOrder {
    int nM, nN, nwg, G, c;
    __host__ __device__ void init(int M, int N, int G_, int c_) { nM = M / BM; nN = N / BM; nwg = nM * nN; G = G_; c = c_; }
    __host__ __device__ bool next(int i, Unit& u) const {
        const long L = (long)i * G + c; if (L >= nwg) return false;
        int wgid = (int)L; { const int q = nwg / NXCD, r = nwg % NXCD, xcd = wgid % NXCD, off = wgid / NXCD; wgid = (xcd < r ? xcd * (q + 1) : r * (q + 1) + (xcd - r) * q) + off; }
        const int nig = WGM * nN, gid = wgid / nig, fm = gid * WGM, gsz = (nM - fm) < WGM ? (nM - fm) : WGM;
        u.pm = fm + ((wgid % nig) % gsz); u.pn = (wgid % nig) / gsz; return true;
    }
    __device__ __forceinline__ void a_ready(const Unit&) const {}
    __device__ __forceinline__ void done(const Unit&) const {}
};
template <class Epi, class Sched, bool ALIGN_EPI = false, bool SP2 = false>
__device__ __forceinline__ void gemm_phase(PG8_LAS unsigned char* lds, const Gemm g, const Sched& S, const Epi& E) {
    const int tid = threadIdx.x, wid = __builtin_amdgcn_readfirstlane(tid >> 6), lane = tid & 63, wr = wid >> 2, wc = wid & 3, fr = lane & 15, fq = lane >> 4;
    const int K = g.K, nt = K / BK;
    unsigned voffA[2], voffB[2];
#pragma unroll
    for (int i = 0; i < 2; ++i) { int R, C; stage_rc(tid * 16 + i * 8192, R, C); const int Rb = Epi::PERM ? ((R & ~31) + perm32(R & 31)) : R;
        voffA[i] = (unsigned)(R * K + C) * 2u; voffB[i] = (unsigned)(Rb * K + C) * 2u; }
    const size_t kstep = (size_t)(BK * 2);
    const size_t hstep = (size_t)HALF * K * 2;
    const size_t tstep = 2 * hstep;
    const unsigned ldsw = (unsigned)wid * 1024u;
    const int aoff = lds_byte(wr * 64 + fr, fq * 8), boff = lds_byte(wc * 32 + fr, fq * 8);
#define PG8_SA(b, h) (((b) * 2 + (h)) * HTB)
#define PG8_SB(b, h) ((4 + (b) * 2 + (h)) * HTB)
#define PG8_STAGE(bufoff, gbase, voff) do { _Pragma("unroll") for (int _i = 0; _i < 2; ++_i) \
        __builtin_amdgcn_global_load_lds((const unsigned*)((const char*)(gbase) + (voff)[_i]), (PG8_LAS unsigned*)(lds + (bufoff) + ldsw + _i * 8192), 16, 0, 0); } while (0)
#define PG8_LDA(dst, b, h) do { _Pragma("unroll") for (int m = 0; m < 4; ++m) _Pragma("unroll") for (int k = 0; k < 2; ++k) dst[m][k] = *(const PG8_LAS bf16x8*)(lds + PG8_SA(b, h) + aoff + m * 2048 + k * 1024); } while (0)
#define PG8_LDB(dst, b, h) do { _Pragma("unroll") for (int n = 0; n < 2; ++n) _Pragma("unroll") for (int k = 0; k < 2; ++k) dst[n][k] = *(const PG8_LAS bf16x8*)(lds + PG8_SB(b, h) + boff + n * 2048 + k * 1024); } while (0)
#define PG8_MMA(ai, bj, At, Bt) do { __builtin_amdgcn_s_setprio(1); _Pragma("unroll") for (int m = 0; m < 4; ++m) _Pragma("unroll") for (int n = 0; n < 2; ++n) _Pragma("unroll") for (int k = 0; k < 2; ++k) \
        acc[ai][bj][m][n] = __builtin_amdgcn_mfma_f32_16x16x32_bf16(Bt[n][k], At[m][k], acc[ai][bj][m][n], 0, 0, 0); __builtin_amdgcn_s_setprio(0); } while (0)
#define PG8_WAIT_V(n) asm volatile("s_waitcnt vmcnt(" #n ")" ::: "memory")
#define PG8_WAIT_L(n) asm volatile("s_waitcnt lgkmcnt(" #n ")" ::: "memory")
#define PG8_BAR __builtin_amdgcn_s_barrier()
#define PG8_SCHED __builtin_amdgcn_sched_barrier(0)
    Unit cur, nxt; int ui = 0;
    if (!S.next(0, cur)) return;
    f32x4 acc[2][2][4][2];
#pragma unroll
    for (int a = 0; a < 2; ++a)
#pragma unroll
        for (int b = 0; b < 2; ++b)
#pragma unroll
            for (int m = 0; m < 4; ++m)
#pragma unroll
                for (int n = 0; n < 2; ++n) acc[a][b][m][n] = (f32x4){0.f, 0.f, 0.f, 0.f};
    bf16x8 At[4][2], B0[2][2], B1[2][2];
    const char* cA = (const char*)g.A + (size_t)cur.pm * tstep; const char* cB = (const char*)g.Bt + (size_t)cur.pn * tstep;
    S.a_ready(cur);
    if constexpr (SP2) {
        PG8_STAGE(PG8_SB(0, 0), cB, voffB); PG8_STAGE(PG8_SB(0, 1), cB + hstep, voffB); PG8_STAGE(PG8_SA(0, 0), cA, voffA); PG8_STAGE(PG8_SA(0, 1), cA + hstep, voffA);
        if (wr == 1) PG8_BAR;
        PG8_WAIT_V(2); PG8_BAR;
        PG8_STAGE(PG8_SB(1, 0), cB + kstep, voffB); PG8_STAGE(PG8_SA(1, 0), cA + kstep, voffA); PG8_STAGE(PG8_SB(1, 1), cB + hstep + kstep, voffB);
        PG8_WAIT_V(6); PG8_BAR;
    } else {
        PG8_STAGE(PG8_SB(0, 0), cB, voffB); PG8_STAGE(PG8_SA(0, 0), cA, voffA); PG8_STAGE(PG8_SB(0, 1), cB + hstep, voffB); PG8_STAGE(PG8_SA(0, 1), cA + hstep, voffA);
        if (wr == 1) PG8_BAR;
        PG8_WAIT_V(4); PG8_BAR;
        PG8_STAGE(PG8_SB(1, 0), cB + kstep, voffB); PG8_STAGE(PG8_SA(1, 0), cA + kstep, voffA); PG8_STAGE(PG8_SB(1, 1), cB + hstep + kstep, voffB);
        PG8_WAIT_V(6); PG8_BAR;
    }
    for (;;) {
        const bool has_next = S.next(ui + 1, nxt);
        const char* nA = has_next ? (const char*)g.A + (size_t)nxt.pm * tstep : cA; const char* nB = has_next ? (const char*)g.Bt + (size_t)nxt.pn * tstep : cB;
        for (int t = 0; t < nt; t += 2) {
            const bool last = (t == nt - 2);
            const char* a1 = cA + (size_t)(t + 1) * kstep;
            const char* a2 = last ? nA : cA + (size_t)(t + 2) * kstep; const char* b2 = last ? nB : cB + (size_t)(t + 2) * kstep;
            const char* a3 = a2 + kstep; const char* b3 = b2 + kstep;
            if (last && has_next) S.a_ready(nxt);
            if constexpr (SP2) {
            PG8_LDB(B0, 0, 0); PG8_LDB(B1, 0, 1); PG8_SCHED; PG8_LDA(At, 0, 0); PG8_STAGE(PG8_SA(1, 1), a1 + hstep, voffA);
            PG8_WAIT_V(8); PG8_WAIT_L(0); PG8_BAR; PG8_MMA(0, 0, At, B0); PG8_MMA(0, 1, At, B1); PG8_BAR; PG8_SCHED;
            PG8_LDA(At, 0, 1); PG8_STAGE(PG8_SB(0, 0), b2, voffB); PG8_STAGE(PG8_SB(0, 1), b2 + hstep, voffB); PG8_STAGE(PG8_SA(0, 0), a2, voffA);
            PG8_WAIT_V(8); PG8_WAIT_L(0); PG8_BAR; PG8_MMA(1, 0, At, B0); PG8_MMA(1, 1, At, B1); PG8_BAR; PG8_SCHED;
            PG8_LDB(B0, 1, 0); PG8_LDB(B1, 1, 1); PG8_SCHED; PG8_LDA(At, 1, 0); PG8_STAGE(PG8_SA(0, 1), a2 + hstep, voffA);
            PG8_WAIT_V(8); PG8_WAIT_L(0); PG8_BAR; PG8_MMA(0, 0, At, B0); PG8_MMA(0, 1, At, B1); PG8_BAR; PG8_SCHED;
            PG8_LDA(At, 1, 1); PG8_STAGE(PG8_SB(1, 0), b3, voffB); PG8_STAGE(PG8_SB(1, 1), b3 + hstep, voffB); PG8_STAGE(PG8_SA(1, 0), a3, voffA);
            PG8_WAIT_V(8); PG8_WAIT_L(0); PG8_BAR; PG8_MMA(1, 0, At, B0); PG8_MMA(1, 1, At, B1); PG8_BAR; PG8_SCHED;
            } else {
            PG8_LDB(B0, 0, 0); PG8_SCHED; PG8_LDA(At, 0, 0); PG8_STAGE(PG8_SA(1, 1), a1 + hstep, voffA);
            PG8_WAIT_L(8); PG8_BAR; PG8_WAIT_L(0); PG8_MMA(0, 0, At, B0); PG8_BAR; PG8_SCHED;
            PG8_LDB(B1, 0, 1); PG8_STAGE(PG8_SB(0, 0), b2, voffB);
            PG8_BAR; PG8_WAIT_L(0); PG8_MMA(0, 1, At, B1); PG8_BAR;
            PG8_LDA(At, 0, 1); PG8_STAGE(PG8_SA(0, 0), a2, voffA);
            PG8_BAR; PG8_WAIT_L(0); PG8_MMA(1, 0, At, B0); PG8_BAR; PG8_SCHED;
            PG8_STAGE(PG8_SB(0, 1), b2 + hstep, voffB);
            PG8_WAIT_V(6); PG8_BAR; PG8_MMA(1, 1, At, B1); PG8_BAR;
            PG8_LDB(B0, 1, 0); PG8_SCHED; PG8_LDA(At, 1, 0); PG8_STAGE(PG8_SA(0, 1), a2 + hstep, voffA);
            PG8_WAIT_L(8); PG8_BAR; PG8_WAIT_L(0); PG8_MMA(0, 0, At, B0); PG8_BAR; PG8_SCHED;
            PG8_LDB(B1, 1, 1); PG8_STAGE(PG8_SB(1, 0), b3, voffB);
            PG8_BAR; PG8_WAIT_L(0); PG8_MMA(0, 1, At, B1); PG8_BAR;
            PG8_LDA(At, 1, 1); PG8_STAGE(PG8_SA(1, 0), a3, voffA);
            PG8_BAR; PG8_WAIT_L(0); PG8_MMA(1, 0, At, B0); PG8_BAR; PG8_SCHED;
            PG8_STAGE(PG8_SB(1, 1), b3 + hstep, voffB);
            PG8_WAIT_V(6); PG8_BAR; PG8_MMA(1, 1, At, B1); PG8_BAR;
            }
        }
        if constexpr (ALIGN_EPI) { if (wr == 0) PG8_BAR; }
        if constexpr (!Epi::AFTER_DRAIN) { E(acc, cur, wr, wc, fr, fq); S.done(cur); }
        if (!has_next) break;
#pragma unroll
        for (int a = 0; a < 2; ++a)
#pragma unroll
            for (int b = 0; b < 2; ++b)
#pragma unroll
                for (int m = 0; m < 4; ++m)
#pragma unroll
                    for (int n = 0; n < 2; ++n) acc[a][b][m][n] = (f32x4){0.f, 0.f, 0.f, 0.f};
        cur = nxt; cA = nA; cB = nB; ++ui;
        if constexpr (ALIGN_EPI) { if (wr == 1) PG8_BAR; }
    }
    PG8_WAIT_V(0);
    if constexpr (!ALIGN_EPI) { if (wr == 0) PG8_BAR; }
    PG8_BAR;
    if constexpr (Epi::AFTER_DRAIN) { E.fused(acc, cur, wr, wc, fr, fq, lds, wid, lane); S.done(cur); }
#undef PG8_SA
#undef PG8_SB
#undef PG8_STAGE
#undef PG8_LDA
#undef PG8_LDB
#undef PG8_MMA
#undef PG8_WAIT_V
#undef PG8_WAIT_L
#undef PG8_BAR
#undef PG8_SCHED
}
}
#define XB_TMO      128
#define XB_XCNT(j)  (256  + 64 * (j))
#define XB_XSUB(j)  (1280 + 64 * (j))
#define XB_XGEN(j)  (2304 + 64 * (j))
#define XB_TOP      3328
#define XB_TOPGEN   3392
#define XCD_BAR_WORDS 3456
#define XB_SPIN_CAP (1u << 18)
#define LAS __attribute__((address_space(3)))

__device__ __forceinline__ unsigned xb_ld(unsigned* p)              { return __hip_atomic_load(p, __ATOMIC_RELAXED, __HIP_MEMORY_SCOPE_AGENT); }
__device__ __forceinline__ unsigned xb_add(unsigned* p, unsigned v) { return __hip_atomic_fetch_add(p, v, __ATOMIC_RELAXED, __HIP_MEMORY_SCOPE_AGENT); }
__device__ __forceinline__ unsigned xb_xcc_id() { return (unsigned)__builtin_amdgcn_s_getreg((3 << 11) | 20) & 0xFu; }
#define XB_SPIN(cond, bar) do { unsigned _sp = 0; while (cond) { __builtin_amdgcn_s_sleep(1); \
    if ((++_sp & 255u) == 0u) { if (xb_ld(&(bar)[XB_TMO])) break; if (_sp > XB_SPIN_CAP) { atomicAdd(&(bar)[XB_TMO], 1u); break; } } } } while (0)

struct XcdBarrier {
    unsigned* bar; unsigned x;
    volatile LAS unsigned* st;
};

__device__ __forceinline__ XcdBarrier xcd_barrier_post(unsigned* bar, volatile LAS unsigned* st) {
    XcdBarrier b; b.bar = bar; b.x = xb_xcc_id(); b.st = st;
    if (threadIdx.x == 0) (void)xb_add(&bar[XB_XCNT(b.x)], 1u);
    return b;
}
__device__ __forceinline__ void xcd_barrier_complete(unsigned* bar, unsigned x, unsigned& nloc, unsigned& nx) {
    const unsigned G = gridDim.x * gridDim.y * gridDim.z;
    unsigned sum, cnt, mine, sp = 0u;
    for (;;) {
        sum = 0u; cnt = 0u; mine = 0u;
#pragma unroll
        for (unsigned j = 0; j < 16; ++j) { const unsigned c = xb_ld(&bar[XB_XCNT(j)]); sum += c; cnt += (c > 0u) ? 1u : 0u; mine = (j == x) ? c : mine; }
        if (sum == G) break;
        __builtin_amdgcn_s_sleep(1);
        if ((++sp & 255u) == 0u) { if (xb_ld(&bar[XB_TMO])) break; if (sp > XB_SPIN_CAP) { atomicAdd(&bar[XB_TMO], 1u); break; } }
    }
    nloc = mine > 0u ? mine : 1u; nx = cnt > 0u ? cnt : 1u;
}

__device__ __forceinline__ void xcd_barrier(const XcdBarrier& b) {
    asm volatile("s_waitcnt vmcnt(0)" ::: "memory");
    __syncthreads();
    if (threadIdx.x == 0) {
        unsigned* bar = b.bar;
        __builtin_amdgcn_s_waitcnt(0);
        unsigned nloc = b.st[0], nx = b.st[1];
        if (nloc == 0u) { xcd_barrier_complete(bar, b.x, nloc, nx); b.st[0] = nloc; b.st[1] = nx; }
        const unsigned old = xb_add(&bar[XB_XSUB(b.x)], 1u);
        const unsigned gen = old / nloc;
        if (old + 1u == (gen + 1u) * nloc) {
            __builtin_amdgcn_fence(__ATOMIC_RELEASE, "agent");
            asm volatile("s_waitcnt vmcnt(0)" ::: "memory");
            const unsigned og = xb_add(&bar[XB_TOP], 1u);
            const unsigned tg = og / nx;
            if (og + 1u == (tg + 1u) * nx) xb_add(&bar[XB_TOPGEN], 1u);
            else XB_SPIN(xb_ld(&bar[XB_TOPGEN]) == tg, bar);
            __builtin_amdgcn_fence(__ATOMIC_ACQUIRE, "agent");
            xb_add(&bar[XB_XGEN(b.x)], 1u);
            asm volatile("s_waitcnt vmcnt(0)" ::: "memory");
        } else {
            XB_SPIN(xb_ld(&bar[XB_XGEN(b.x)]) == gen, bar);
            __builtin_amdgcn_fence(__ATOMIC_ACQUIRE, "agent");
            asm volatile("s_waitcnt vmcnt(0)" ::: "memory");
        }
    }
    __syncthreads();
}

typedef unsigned short bf16_t;
typedef short bf16x8 __attribute__((ext_vector_type(8)));
typedef float f32x4 __attribute__((ext_vector_type(4)));
typedef float f32x2 __attribute__((ext_vector_type(2)));
typedef unsigned u32x4 __attribute__((ext_vector_type(4)));
typedef unsigned u32x2 __attribute__((ext_vector_type(2)));

constexpr int NB = 8, SEQ = 4096, DM = 2048, NTOK = NB * SEQ, DFF = 5632, DIN = 6312, LDU = 6400, NMOD = 18432, NTHR = 512;
constexpr int U_HG_Q = 0, U_HG_F = 512, U_HG_I = 1024, U_HG_G = 1536;
constexpr int U_RW_R = 2048, U_RW_K = 2560, U_RW_V = 3072, U_RW_WD = 3584;
constexpr int U_ML_X = 3744, U_ML_V = 4256, U_ML_O = 4768, U_ML_I = 5280, U_ML_F = 5284;
constexpr int U_LRU_X = 5288, U_LRU_G = 5800;
constexpr int RW_IN = 1696;

enum { I_X = 0, I_C, I_GAIN, I_MODW, I_MODB, I_W1, I_W3, I_W2, I_WIN, I_WOUT, I_HGLB, I_HGNORM, I_RWMU, I_RWW0, I_RWW2, I_RWA0, I_RWA2, I_RWG2, I_RWKK, I_RWKA,
       I_RWRK, I_RWLNW, I_RWLNB, I_MLCW, I_MLCB, I_MLWQ, I_MLWK, I_MLIB, I_MLFB, I_MLNORM, I_MLSKIP, I_LRUCW, I_LRUCB, I_LRUWA, I_LRUBA, I_LRUWX, I_LRUBX,
       I_LRULAM, I_LRUNORM, I_FNORM, N_IN };

constexpr size_t WS_BAR = 0;
constexpr size_t WS_MODP = 16384;
constexpr size_t WS_MODF = WS_MODP + (size_t)2 * 16 * 8 * NMOD * 4;
constexpr size_t WS_LRUW = WS_MODF + (size_t)2 * 8 * NMOD * 4;
constexpr size_t WS_W = WS_LRUW + (size_t)2 * 2 * 4 * 16384 * 2;
constexpr size_t LW_W13A = 0, LW_W2A = 23068672, LW_W13B = 34603008, LW_W2B = 57671680, LW_WIN = 69206016, LW_WOUT = 82313216, LW_ELEMS = 86507520;
constexpr size_t WS_HY = WS_W + 2 * LW_ELEMS * 2;
constexpr size_t WS_U = WS_HY + (size_t)NTOK * DM * 2;
constexpr size_t WS_LRUA = WS_U + (size_t)NTOK * LDU * 2;
constexpr size_t WS_LRUB = WS_LRUA + (size_t)NTOK * 512 * 4;
constexpr size_t WS_RWW = WS_LRUB + (size_t)NTOK * 512 * 4;
constexpr size_t WS_RWA = WS_RWW + (size_t)NTOK * 512 * 4;
constexpr size_t WS_RWG = WS_RWA + (size_t)NTOK * 512 * 2;
constexpr size_t WS_END = WS_RWG + (size_t)NTOK * 512 * 2;

constexpr int LDS_BYTES = 144 * 1024;
constexpr int LDS_BARW = LDS_BYTES - 16;

struct Params { const float* in[N_IN]; float* out; unsigned char* ws; int ph_lo, ph_hi; };

__device__ __forceinline__ float bflo(unsigned w) { return __uint_as_float(w << 16); }
__device__ __forceinline__ float bfhi(unsigned w) { return __uint_as_float(w & 0xffff0000u); }
__device__ __forceinline__ float bf2f(bf16_t h) { return __uint_as_float(((unsigned)h) << 16); }
__device__ __forceinline__ unsigned pk_bf16(float lo, float hi) { unsigned r; asm("v_cvt_pk_bf16_f32 %0, %1, %2" : "=v"(r) : "v"(lo), "v"(hi)); return r; }
__device__ __forceinline__ void unpack8(const u32x4 w, float (&f)[8]) { f[0] = bflo(w.x); f[1] = bfhi(w.x); f[2] = bflo(w.y); f[3] = bfhi(w.y); f[4] = bflo(w.z); f[5] = bfhi(w.z); f[6] = bflo(w.w); f[7] = bfhi(w.w); }
__device__ __forceinline__ u32x4 pack8(const float (&f)[8]) { u32x4 w; w.x = pk_bf16(f[0], f[1]); w.y = pk_bf16(f[2], f[3]); w.z = pk_bf16(f[4], f[5]); w.w = pk_bf16(f[6], f[7]); return w; }
__device__ __forceinline__ float fast_rcp(float x) { return __builtin_amdgcn_rcpf(x); }
__device__ __forceinline__ float sigmoidf_(float x) { return fast_rcp(1.0f + __expf(-x)); }
__device__ __forceinline__ float siluf_(float x) { return x * sigmoidf_(x); }
__device__ __forceinline__ float softplusf_(float x) { return fmaxf(x, 0.0f) + log1pf(__expf(-fabsf(x))); }
__device__ __forceinline__ float tanhf_(float x) { const float e = __expf(2.0f * x); return 1.0f - 2.0f * fast_rcp(e + 1.0f); }
__device__ __forceinline__ float gelu_tanhf_(float x) { return 0.5f * x * (1.0f + tanhf_(0.7978845608028654f * (x + 0.044715f * x * x * x))); }
template <int CTRL> __device__ __forceinline__ float dpp_f(float x) { return __int_as_float(__builtin_amdgcn_update_dpp(0, __float_as_int(x), CTRL, 0xF, 0xF, true)); }
__device__ __forceinline__ float red8(float x) { x += dpp_f<0xB1>(x); x += dpp_f<0x4E>(x); x += dpp_f<0x141>(x); return x; }
__device__ __forceinline__ float red16(float x) { x = red8(x); x += dpp_f<0x140>(x); return x; }
__device__ __forceinline__ float red64(float x) { x = red16(x); x += __shfl_xor(x, 16); x += __shfl_xor(x, 32); return x; }

#define LDSF(off) ((LAS float*)(lds + (off)))

__device__ __forceinline__ void cvt_tile(const float* __restrict__ src, bf16_t* __restrict__ dst, int K, int N, int kt, int nt, int mode, LAS unsigned char* lds) {
    const int tid = threadIdx.x; LAS float* tile = LDSF(0);
    const int k0 = kt * 64, n0 = nt * 64;
#pragma unroll
    for (int p = 0; p < 2; ++p) {
        const int kk = p * 32 + (tid >> 4), n4 = (tid & 15) * 4;
        f32x4 v = (f32x4){0.f, 0.f, 0.f, 0.f};
        if (n0 + n4 < N) v = *(const f32x4*)(src + (size_t)(k0 + kk) * N + n0 + n4);
        tile[kk * 65 + n4 + 0] = v[0]; tile[kk * 65 + n4 + 1] = v[1]; tile[kk * 65 + n4 + 2] = v[2]; tile[kk * 65 + n4 + 3] = v[3];
    }
    __syncthreads();
    {
        const int nn = tid >> 3, k8 = (tid & 7) * 8, n = n0 + nn;
        float f[8];
#pragma unroll
        for (int j = 0; j < 8; ++j) f[j] = tile[(k8 + j) * 65 + nn];
        const int row = (mode == 0) ? n : ((n >> 7) * 256 + ((mode == 2) ? 128 : 0) + (n & 127));
        *(u32x4*)(dst + (size_t)row * K + k0 + k8) = pack8(f);
    }
    __syncthreads();
}

__device__ __forceinline__ void phase_convert(const Params& P, LAS unsigned char* lds) {
    const int tid = threadIdx.x, wg = blockIdx.x, nwg = gridDim.x;
    constexpr int T_FF = 2816, T_WIN = 3200, T_WOUT = 1024, T_LAYER = 6 * T_FF + T_WIN + T_WOUT, T_BIG = 2 * T_LAYER, T_LRU = 64, T_MOD = 2 * 36 * 16;
    bf16_t* Wb = (bf16_t*)(P.ws + WS_W);
    for (int it = wg; it < T_BIG + T_LRU + T_MOD; it += nwg) {
        if (it < T_BIG) {
            const int l = it / T_LAYER; int r = it % T_LAYER;
            bf16_t* Wl = Wb + (size_t)l * LW_ELEMS;
            if (r < 6 * T_FF) {
                const int m = r / T_FF, q = r % T_FF, f = m / 3, which = m % 3;
                if (which < 2) {
                    const float* src = P.in[which == 0 ? I_W1 : I_W3] + (size_t)(l * 2 + f) * DM * DFF;
                    cvt_tile(src, Wl + (f ? LW_W13B : LW_W13A), DM, DFF, q / 88, q % 88, which + 1, lds);
                } else {
                    const float* src = P.in[I_W2] + (size_t)(l * 2 + f) * DFF * DM;
                    cvt_tile(src, Wl + (f ? LW_W2B : LW_W2A), DFF, DM, q / 32, q % 32, 0, lds);
                }
            } else if (r < 6 * T_FF + T_WIN) {
                const int q = r - 6 * T_FF;
                cvt_tile(P.in[I_WIN] + (size_t)l * DM * DIN, Wl + LW_WIN, DM, DIN, q / 100, q % 100, 0, lds);
            } else {
                const int q = r - 6 * T_FF - T_WIN;
                cvt_tile(P.in[I_WOUT] + (size_t)l * DM * DM, Wl + LW_WOUT, DM, DM, q / 32, q % 32, 0, lds);
            }
        } else if (it < T_BIG + T_LRU) {
            const int q = it - T_BIG, m16 = q >> 2, tl = q & 3, l = m16 >> 3, which = (m16 >> 2) & 1, blk = m16 & 3;
            const float* src = P.in[which ? I_LRUWX : I_LRUWA] + (size_t)(l * 4 + blk) * 16384;
            bf16_t* dst = (bf16_t*)(P.ws + WS_LRUW) + (size_t)((l * 2 + which) * 4 + blk) * 16384;
            cvt_tile(src, dst, 128, 128, tl >> 1, tl & 1, 0, lds);
        } else {
            const int m = it - T_BIG - T_LRU, l = m / 576, r = m % 576, jb = r / 16, ks = r % 16;
            LAS float* cact = LDSF(0);
#pragma unroll
            for (int e2 = 0; e2 < 2; ++e2) { const int e = tid * 2 + e2, kk = e >> 3, b = e & 7; cact[e] = siluf_(P.in[I_C][b * DM + ks * 128 + kk]); }
            __syncthreads();
            const int j = jb * 512 + tid;
            const float* wp = P.in[I_MODW] + (size_t)l * DM * NMOD + (size_t)(ks * 128) * NMOD + j;
            float acc[8];
#pragma unroll
            for (int b = 0; b < 8; ++b) acc[b] = 0.f;
#pragma unroll 8
            for (int kk = 0; kk < 128; ++kk) {
                const float w = wp[(size_t)kk * NMOD];
                const f32x4 c0 = *(const LAS f32x4*)(cact + kk * 8), c1 = *(const LAS f32x4*)(cact + kk * 8 + 4);
                acc[0] += c0[0] * w; acc[1] += c0[1] * w; acc[2] += c0[2] * w; acc[3] += c0[3] * w;
                acc[4] += c1[0] * w; acc[5] += c1[1] * w; acc[6] += c1[2] * w; acc[7] += c1[3] * w;
            }
            float* mp = (float*)(P.ws + WS_MODP) + (size_t)((l * 16 + ks) * 8) * NMOD + j;
#pragma unroll
            for (int b = 0; b < 8; ++b) mp[(size_t)b * NMOD] = acc[b];
            __syncthreads();
        }
    }
}

__device__ __forceinline__ void phase_modfinal(const Params& P) {
    const float* mp = (const float*)(P.ws + WS_MODP); float* mf = (float*)(P.ws + WS_MODF);
    for (int i = blockIdx.x * NTHR + threadIdx.x; i < 2 * 8 * NMOD; i += gridDim.x * NTHR) {
        const int l = i / (8 * NMOD), r = i % (8 * NMOD), b = r / NMOD, j = r % NMOD;
        float s = P.in[I_MODB][l * NMOD + j];
#pragma unroll
        for (int ks = 0; ks < 16; ++ks) s += mp[(size_t)((l * 16 + ks) * 8 + b) * NMOD + j];
        mf[i] = s;
    }
}

__device__ __forceinline__ void phase_norm(const Params& P, int l, int sub, const float* __restrict__ xsrc, LAS unsigned char* lds) {
    const int tid = threadIdx.x, lane = tid & 63, wave = tid >> 6;
    bf16_t* H = (bf16_t*)(P.ws + WS_HY);
    LAS float* cv = LDSF(0); LAS float* sv = LDSF(8192);
    for (int rb = blockIdx.x; rb < NTOK / 128; rb += gridDim.x) {
        const int b = rb >> 5;
        const float* mod = (const float*)(P.ws + WS_MODF) + (size_t)(l * 8 + b) * NMOD + sub * 6144;
        __syncthreads();
        for (int d = tid; d < DM; d += NTHR) { cv[d] = P.in[I_GAIN][(l * 3 + sub) * DM + d] * (1.0f + mod[2048 + d]); sv[d] = mod[d]; }
        __syncthreads();
        for (int rr = 0; rr < 16; ++rr) {
            const int row = rb * 128 + wave * 16 + rr;
            const float* xr = xsrc + (size_t)row * DM;
            f32x4 v[8]; float ss = 0.f;
#pragma unroll
            for (int i = 0; i < 8; ++i) { v[i] = *(const f32x4*)(xr + i * 256 + lane * 4); ss += v[i][0] * v[i][0] + v[i][1] * v[i][1] + v[i][2] * v[i][2] + v[i][3] * v[i][3]; }
            ss = red64(ss);
            const float rstd = rsqrtf(ss * (1.0f / DM) + 1e-6f);
#pragma unroll
            for (int i = 0; i < 8; ++i) {
                const int d = i * 256 + lane * 4;
                const f32x4 c = *(const LAS f32x4*)(cv + d), s = *(const LAS f32x4*)(sv + d);
                u32x2 w; w.x = pk_bf16(v[i][0] * rstd * c[0] + s[0], v[i][1] * rstd * c[1] + s[1]); w.y = pk_bf16(v[i][2] * rstd * c[2] + s[2], v[i][3] * rstd * c[3] + s[3]);
                *(u32x2*)(H + (size_t)row * DM + d) = w;
            }
        }
    }
}

__device__ __forceinline__ void phase_final_norm(const Params& P) {
    const int tid = threadIdx.x, lane = tid & 63, wave = tid >> 6;
    float* X = P.out; const float* fn = P.in[I_FNORM];
    for (int row = blockIdx.x * 8 + wave; row < NTOK; row += gridDim.x * 8) {
        float* xr = X + (size_t)row * DM;
        f32x4 v[8]; float ss = 0.f;
#pragma unroll
        for (int i = 0; i < 8; ++i) { v[i] = *(const f32x4*)(xr + i * 256 + lane * 4); ss += v[i][0] * v[i][0] + v[i][1] * v[i][1] + v[i][2] * v[i][2] + v[i][3] * v[i][3]; }
        ss = red64(ss);
        const float rstd = rsqrtf(ss * (1.0f / DM) + 1e-6f);
#pragma unroll
        for (int i = 0; i < 8; ++i) { const int d = i * 256 + lane * 4; const f32x4 g = *(const f32x4*)(fn + d); *(f32x4*)(xr + d) = v[i] * rstd * g; }
    }
}

struct EpiSwiGLU {
    static constexpr bool PERM = true, AFTER_DRAIN = false;
    bf16_t* G;
    __device__ __forceinline__ void operator()(const pg8::f32x4 (&acc)[2][2][4][2], const pg8::Unit& u, int wr, int wc, int fr, int fq) const {
        const int row0 = u.pm * 256 + wr * 64 + fr, col0 = u.pn * 128 + wc * 32 + 8 * fq;
#pragma unroll
        for (int ai = 0; ai < 2; ++ai)
#pragma unroll
            for (int m = 0; m < 4; ++m) {
                float o[8];
#pragma unroll
                for (int n = 0; n < 2; ++n)
#pragma unroll
                    for (int j = 0; j < 4; ++j) { const float g = acc[ai][0][m][n][j]; o[n * 4 + j] = g * fast_rcp(1.0f + __expf(-g)) * acc[ai][1][m][n][j]; }
                *(u32x4*)(G + (size_t)(row0 + ai * 128 + m * 16) * DFF + col0) = pack8(o);
            }
    }
};
struct EpiResid {
    static constexpr bool PERM = false, AFTER_DRAIN = false;
    const float* xin; float* xout; const float* gate; float coef;
    __device__ __forceinline__ void operator()(const pg8::f32x4 (&acc)[2][2][4][2], const pg8::Unit& u, int wr, int wc, int fr, int fq) const {
        const int row0 = u.pm * 256 + wr * 64 + fr, col0 = u.pn * 256 + wc * 32 + 4 * fq, b = u.pm >> 4;
        f32x4 gv[2][2];
#pragma unroll
        for (int bj = 0; bj < 2; ++bj)
#pragma unroll
            for (int n = 0; n < 2; ++n) gv[bj][n] = (*(const f32x4*)(gate + (size_t)b * NMOD + col0 + bj * 128 + n * 16) + 1.0f) * coef;
#pragma unroll
        for (int ai = 0; ai < 2; ++ai)
#pragma unroll
            for (int m = 0; m < 4; ++m) {
                const size_t off = (size_t)(row0 + ai * 128 + m * 16) * DM + col0;
#pragma unroll
                for (int bj = 0; bj < 2; ++bj)
#pragma unroll
                    for (int n = 0; n < 2; ++n) { const f32x4 xv = *(const f32x4*)(xin + off + bj * 128 + n * 16); *(f32x4*)(xout + off + bj * 128 + n * 16) = xv + gv[bj][n] * acc[ai][bj][m][n]; }
            }
    }
};
struct EpiU {
    static constexpr bool PERM = true, AFTER_DRAIN = false;
    bf16_t* U;
    __device__ __forceinline__ void operator()(const pg8::f32x4 (&acc)[2][2][4][2], const pg8::Unit& u, int wr, int wc, int fr, int fq) const {
        const int row0 = u.pm * 256 + wr * 64 + fr, col0 = u.pn * 256 + wc * 32 + 8 * fq;
#pragma unroll
        for (int ai = 0; ai < 2; ++ai)
#pragma unroll
            for (int m = 0; m < 4; ++m)
#pragma unroll
                for (int bj = 0; bj < 2; ++bj) {
                    u32x4 w; w.x = pk_bf16(acc[ai][bj][m][0][0], acc[ai][bj][m][0][1]); w.y = pk_bf16(acc[ai][bj][m][0][2], acc[ai][bj][m][0][3]);
                    w.z = pk_bf16(acc[ai][bj][m][1][0], acc[ai][bj][m][1][1]); w.w = pk_bf16(acc[ai][bj][m][1][2], acc[ai][bj][m][1][3]);
                    *(u32x4*)(U + (size_t)(row0 + ai * 128 + m * 16) * LDU + col0 + bj * 128) = w;
                }
    }
};

__device__ __forceinline__ void p1_rw_lora(const Params& P, int l, LAS unsigned char* lds) {
    const int tid = threadIdx.x;
    const bf16_t* U = (const bf16_t*)(P.ws + WS_U);
    float* RWW = (float*)(P.ws + WS_RWW); bf16_t* RWA = (bf16_t*)(P.ws + WS_RWA); bf16_t* RWG = (bf16_t*)(P.ws + WS_RWG);
    LAS float* act = LDSF(0);
    const float* mu = P.in[I_RWMU] + l * RW_IN + 1536;
    const float* w2 = P.in[I_RWW2] + (size_t)l * 32 * 512 + tid;
    const float* a2 = P.in[I_RWA2] + (size_t)l * 32 * 512 + tid;
    const float* g2 = P.in[I_RWG2] + (size_t)l * 96 * 512 + tid;
    const float w0 = P.in[I_RWW0][l * 512 + tid], a0 = P.in[I_RWA0][l * 512 + tid];
    for (int it = blockIdx.x; it < NTOK / 16; it += gridDim.x) {
        const int tok0 = it * 16;
        __syncthreads();
#pragma unroll
        for (int e5 = 0; e5 < 5; ++e5) {
            const int e = tid + e5 * NTHR, tk = e / 160, j = e % 160, tok = tok0 + tk;
            const float cur = bf2f(U[(size_t)tok * LDU + U_RW_WD + j]);
            const float prv = (tok & (SEQ - 1)) ? bf2f(U[(size_t)(tok - 1) * LDU + U_RW_WD + j]) : 0.f;
            const float v = cur + (prv - cur) * mu[j];
            act[j * 16 + tk] = (j < 32) ? tanhf_(v) : ((j < 64) ? v : sigmoidf_(v));
        }
        __syncthreads();
        float aw[16], aa[16], ag[16];
#pragma unroll
        for (int t = 0; t < 16; ++t) { aw[t] = 0.f; aa[t] = 0.f; ag[t] = 0.f; }
#pragma unroll 4
        for (int j = 0; j < 32; ++j) {
            const float w = w2[(size_t)j * 512];
#pragma unroll
            for (int q = 0; q < 4; ++q) { const f32x4 x = *(const LAS f32x4*)(act + j * 16 + q * 4); aw[q * 4 + 0] += x[0] * w; aw[q * 4 + 1] += x[1] * w; aw[q * 4 + 2] += x[2] * w; aw[q * 4 + 3] += x[3] * w; }
        }
#pragma unroll 4
        for (int j = 0; j < 32; ++j) {
            const float w = a2[(size_t)j * 512];
#pragma unroll
            for (int q = 0; q < 4; ++q) { const f32x4 x = *(const LAS f32x4*)(act + (32 + j) * 16 + q * 4); aa[q * 4 + 0] += x[0] * w; aa[q * 4 + 1] += x[1] * w; aa[q * 4 + 2] += x[2] * w; aa[q * 4 + 3] += x[3] * w; }
        }
#pragma unroll 4
        for (int j = 0; j < 96; ++j) {
            const float w = g2[(size_t)j * 512];
#pragma unroll
            for (int q = 0; q < 4; ++q) { const f32x4 x = *(const LAS f32x4*)(act + (64 + j) * 16 + q * 4); ag[q * 4 + 0] += x[0] * w; ag[q * 4 + 1] += x[1] * w; ag[q * 4 + 2] += x[2] * w; ag[q * 4 + 3] += x[3] * w; }
        }
#pragma unroll
        for (int t = 0; t < 16; ++t) {
            const size_t o = (size_t)(tok0 + t) * 512 + tid;
            const float wlog = -softplusf_(-(w0 + aw[t])) - 0.5f;
            RWW[o] = __expf(-__expf(wlog));
            RWA[o] = (bf16_t)(pk_bf16(sigmoidf_(a0 + aa[t]), 0.f) & 0xffffu);
            RWG[o] = (bf16_t)(pk_bf16(ag[t], 0.f) & 0xffffu);
        }
    }
}

__device__ __forceinline__ void p1_lru_prep(const Params& P, int l, LAS unsigned char* lds) {
    const int tid = threadIdx.x, lane = tid & 63, wave = tid >> 6, wg = blockIdx.x, nwg = gridDim.x;
    const bf16_t* U = (const bf16_t*)(P.ws + WS_U);
    float* LA = (float*)(P.ws + WS_LRUA); float* LB = (float*)(P.ws + WS_LRUB);
    constexpr int O_WA = 0, O_WX = 34816, O_XC = 69632, O_XF = 87040;
    const int n = wg & 3;
    __syncthreads();
    {
        const bf16_t* wa = (const bf16_t*)(P.ws + WS_LRUW) + (size_t)((l * 2 + 0) * 4 + n) * 16384;
        const bf16_t* wx = (const bf16_t*)(P.ws + WS_LRUW) + (size_t)((l * 2 + 1) * 4 + n) * 16384;
#pragma unroll
        for (int e4 = 0; e4 < 4; ++e4) {
            const int e = tid + e4 * NTHR, j = e >> 4, i8 = (e & 15) * 8;
            *(LAS u32x4*)(lds + O_WA + (j * 136 + i8) * 2) = *(const u32x4*)(wa + j * 128 + i8);
            *(LAS u32x4*)(lds + O_WX + (j * 136 + i8) * 2) = *(const u32x4*)(wx + j * 128 + i8);
        }
    }
    const int jloc = wave * 16 + (lane & 15), cg = n * 128 + jloc, fq = lane >> 4;
    const float ba = P.in[I_LRUBA][l * 512 + cg], bx = P.in[I_LRUBX][l * 512 + cg], sp8 = 8.0f * softplusf_(-P.in[I_LRULAM][l * 512 + cg]);
    const int tk = tid >> 3, c16 = (tid & 7) * 16;
    const float* cw = P.in[I_LRUCW] + l * 2048 + n * 128 + c16;
    const float* cb = P.in[I_LRUCB] + l * 512 + n * 128 + c16;
    for (int tt = wg >> 2; tt < NTOK / 64; tt += (nwg >> 2)) {
        const int tok0 = tt * 64, tok = tok0 + tk, tseq = tok & (SEQ - 1);
        float xc[16];
#pragma unroll
        for (int q = 0; q < 4; ++q) { const f32x4 c = *(const f32x4*)(cb + q * 4); xc[q * 4 + 0] = c[0]; xc[q * 4 + 1] = c[1]; xc[q * 4 + 2] = c[2]; xc[q * 4 + 3] = c[3]; }
#pragma unroll
        for (int jj = 0; jj < 4; ++jj) {
            const bool valid = (tseq - 3 + jj) >= 0;
            const bf16_t* up = U + (size_t)(valid ? tok - 3 + jj : tok) * LDU + U_LRU_X + n * 128 + c16;
            const u32x4 r0 = *(const u32x4*)up, r1 = *(const u32x4*)(up + 8);
            float x[16]; { float t0[8], t1[8]; unpack8(r0, t0); unpack8(r1, t1);
#pragma unroll
                for (int j = 0; j < 8; ++j) { x[j] = t0[j]; x[8 + j] = t1[j]; } }
            const float vf = valid ? 1.0f : 0.0f;
#pragma unroll
            for (int q = 0; q < 4; ++q) { const f32x4 w = *(const f32x4*)(cw + jj * 512 + q * 4);
                xc[q * 4 + 0] += vf * w[0] * x[q * 4 + 0]; xc[q * 4 + 1] += vf * w[1] * x[q * 4 + 1]; xc[q * 4 + 2] += vf * w[2] * x[q * 4 + 2]; xc[q * 4 + 3] += vf * w[3] * x[q * 4 + 3]; }
        }
        __syncthreads();
        {
            float a8[8], b8[8];
#pragma unroll
            for (int j = 0; j < 8; ++j) { a8[j] = xc[j]; b8[j] = xc[8 + j]; }
            *(LAS u32x4*)(lds + O_XC + (tk * 136 + c16) * 2) = pack8(a8);
            *(LAS u32x4*)(lds + O_XC + (tk * 136 + c16 + 8) * 2) = pack8(b8);
#pragma unroll
            for (int q = 0; q < 4; ++q) *(LAS f32x4*)(lds + O_XF + (tk * 132 + c16 + q * 4) * 4) = (f32x4){xc[q * 4], xc[q * 4 + 1], xc[q * 4 + 2], xc[q * 4 + 3]};
        }
        __syncthreads();
        f32x4 accA[4], accX[4];
#pragma unroll
        for (int mi = 0; mi < 4; ++mi) { accA[mi] = (f32x4){0.f, 0.f, 0.f, 0.f}; accX[mi] = (f32x4){0.f, 0.f, 0.f, 0.f}; }
#pragma unroll
        for (int kk = 0; kk < 4; ++kk) {
            const bf16x8 fa = *(const LAS bf16x8*)(lds + O_WA + (jloc * 136 + kk * 32 + fq * 8) * 2);
            const bf16x8 fx = *(const LAS bf16x8*)(lds + O_WX + (jloc * 136 + kk * 32 + fq * 8) * 2);
#pragma unroll
            for (int mi = 0; mi < 4; ++mi) {
                const bf16x8 xa = *(const LAS bf16x8*)(lds + O_XC + ((mi * 16 + (lane & 15)) * 136 + kk * 32 + fq * 8) * 2);
                accA[mi] = __builtin_amdgcn_mfma_f32_16x16x32_bf16(xa, fa, accA[mi], 0, 0, 0);
                accX[mi] = __builtin_amdgcn_mfma_f32_16x16x32_bf16(xa, fx, accX[mi], 0, 0, 0);
            }
        }
#pragma unroll
        for (int mi = 0; mi < 4; ++mi)
#pragma unroll
            for (int rg = 0; rg < 4; ++rg) {
                const int t = mi * 16 + fq * 4 + rg;
                const float xv = *(const LAS float*)(lds + O_XF + (t * 132 + jloc) * 4);
                const float r = sigmoidf_(accA[mi][rg] + ba), ig = sigmoidf_(accX[mi][rg] + bx);
                const float la = -r * sp8;
                const size_t o = (size_t)(tok0 + t) * 512 + cg;
                LA[o] = __expf(la);
                LB[o] = sqrtf(fmaxf(-expm1f(2.0f * la), 0.0f)) * (ig * xv);
            }
    }
}

__device__ __forceinline__ void p2_rw(const Params& P, int l, int item, LAS unsigned char* lds) {
    const int tid = threadIdx.x, b = item >> 3, h = item & 7;
    const int kq = tid & 15, rp = tid >> 4, st = tid >> 3, sc = (tid & 7) * 8;
    const bf16_t* U = (const bf16_t*)(P.ws + WS_U);
    const float* RWW = (const float*)(P.ws + WS_RWW); const bf16_t* RWA = (const bf16_t*)(P.ws + WS_RWA); const bf16_t* RWG = (const bf16_t*)(P.ws + WS_RWG);
    bf16_t* Y = (bf16_t*)(P.ws + WS_HY);
    LAS float* F = LDSF(0);
    constexpr int CN = 0, BR = 512, KR = 576, BS = 640, MA = 1024, WR = 5120, WD = 9216, BV = 13312, KP = 17408, VV = 21504, OO = 25600;
    __syncthreads();
    {
        const int kind = tid >> 6, c = tid & 63; float v;
        if (kind < 3) v = P.in[I_RWMU][l * RW_IN + kind * 512 + h * 64 + c];
        else if (kind == 3) v = P.in[I_RWKK][l * 512 + h * 64 + c];
        else if (kind == 4) v = P.in[I_RWKA][l * 512 + h * 64 + c];
        else if (kind == 5) v = P.in[I_RWRK][l * 512 + h * 64 + c];
        else if (kind == 6) v = P.in[I_RWLNW][l * 512 + h * 64 + c];
        else v = P.in[I_RWLNB][l * 512 + h * 64 + c];
        F[CN + kind * 64 + c] = v;
    }
    __syncthreads();
    float S0[4] = {0.f, 0.f, 0.f, 0.f}, S1[4] = {0.f, 0.f, 0.f, 0.f};
    u32x4 pr_c, pk_c, pv_c, pr_p, pk_p, pv_p, pa, pg; f32x4 pw0, pw1; float pflag;
#define RW_PREFETCH(ch) do { const int tk_ = b * SEQ + (ch) * 64 + st; const bool first_ = ((ch) == 0 && st == 0); \
        const bf16_t* uc_ = U + (size_t)tk_ * LDU + h * 64 + sc; const bf16_t* up_ = first_ ? uc_ : uc_ - LDU; pflag = first_ ? 0.f : 1.f; \
        pr_c = *(const u32x4*)(uc_ + U_RW_R); pk_c = *(const u32x4*)(uc_ + U_RW_K); pv_c = *(const u32x4*)(uc_ + U_RW_V); \
        pr_p = *(const u32x4*)(up_ + U_RW_R); pk_p = *(const u32x4*)(up_ + U_RW_K); pv_p = *(const u32x4*)(up_ + U_RW_V); \
        const size_t o_ = (size_t)tk_ * 512 + h * 64 + sc; pw0 = *(const f32x4*)(RWW + o_); pw1 = *(const f32x4*)(RWW + o_ + 4); pa = *(const u32x4*)(RWA + o_); pg = *(const u32x4*)(RWG + o_); } while (0)
    RW_PREFETCH(0);
    for (int ch = 0; ch < SEQ / 64; ++ch) {
        float r[8], k[8], v[8], a[8], w[8], ma[8], bv[8], kp[8], wr[8];
        {
            float c[8], p[8], m[8];
            unpack8(pr_c, c); unpack8(pr_p, p);
#pragma unroll
            for (int j = 0; j < 8; ++j) m[j] = F[CN + 0 * 64 + sc + j];
#pragma unroll
            for (int j = 0; j < 8; ++j) r[j] = c[j] + (p[j] * pflag - c[j]) * m[j];
            unpack8(pk_c, c); unpack8(pk_p, p);
#pragma unroll
            for (int j = 0; j < 8; ++j) m[j] = F[CN + 1 * 64 + sc + j];
#pragma unroll
            for (int j = 0; j < 8; ++j) k[j] = c[j] + (p[j] * pflag - c[j]) * m[j];
            unpack8(pv_c, c); unpack8(pv_p, p);
#pragma unroll
            for (int j = 0; j < 8; ++j) m[j] = F[CN + 2 * 64 + sc + j];
#pragma unroll
            for (int j = 0; j < 8; ++j) v[j] = c[j] + (p[j] * pflag - c[j]) * m[j];
            unpack8(pa, a);
            w[0] = pw0[0]; w[1] = pw0[1]; w[2] = pw0[2]; w[3] = pw0[3]; w[4] = pw1[0]; w[5] = pw1[1]; w[6] = pw1[2]; w[7] = pw1[3];
        }
        float ss = 0.f, bsp = 0.f, brp = 0.f, krp = 0.f;
        {
            float kkv[8];
#pragma unroll
            for (int j = 0; j < 8; ++j) { kkv[j] = k[j] * F[CN + 3 * 64 + sc + j]; ss += kkv[j] * kkv[j]; }
            ss = red8(ss);
            const float inv = 1.0f / fmaxf(sqrtf(ss + 1e-12f), 1e-6f);
#pragma unroll
            for (int j = 0; j < 8; ++j) {
                const float kn = kkv[j] * inv;
                kp[j] = k[j] * (1.0f + (a[j] - 1.0f) * F[CN + 4 * 64 + sc + j]);
                ma[j] = -kn; bv[j] = kn * a[j]; wr[j] = w[j] * r[j];
                bsp += r[j] * kp[j] * F[CN + 5 * 64 + sc + j]; brp += bv[j] * r[j]; krp += kp[j] * r[j];
            }
            bsp = red8(bsp); brp = red8(brp); krp = red8(krp);
        }
        const u32x4 cur_g = pg;
        __syncthreads();
        {
            const int o = st * 64 + sc;
            *(LAS f32x4*)(F + MA + o) = (f32x4){ma[0], ma[1], ma[2], ma[3]}; *(LAS f32x4*)(F + MA + o + 4) = (f32x4){ma[4], ma[5], ma[6], ma[7]};
            *(LAS f32x4*)(F + WR + o) = (f32x4){wr[0], wr[1], wr[2], wr[3]}; *(LAS f32x4*)(F + WR + o + 4) = (f32x4){wr[4], wr[5], wr[6], wr[7]};
            *(LAS f32x4*)(F + WD + o) = (f32x4){w[0], w[1], w[2], w[3]};     *(LAS f32x4*)(F + WD + o + 4) = (f32x4){w[4], w[5], w[6], w[7]};
            *(LAS f32x4*)(F + BV + o) = (f32x4){bv[0], bv[1], bv[2], bv[3]}; *(LAS f32x4*)(F + BV + o + 4) = (f32x4){bv[4], bv[5], bv[6], bv[7]};
            *(LAS f32x4*)(F + KP + o) = (f32x4){kp[0], kp[1], kp[2], kp[3]}; *(LAS f32x4*)(F + KP + o + 4) = (f32x4){kp[4], kp[5], kp[6], kp[7]};
            *(LAS f32x4*)(F + VV + o) = (f32x4){v[0], v[1], v[2], v[3]};     *(LAS f32x4*)(F + VV + o + 4) = (f32x4){v[4], v[5], v[6], v[7]};
            if ((tid & 7) == 0) { F[BR + st] = brp; F[KR + st] = krp; F[BS + st] = bsp; }
        }
        __syncthreads();
        if (ch + 1 < SEQ / 64) RW_PREFETCH(ch + 1);
#pragma unroll 2
        for (int t = 0; t < 64; ++t) {
            const f32x4 xma = *(const LAS f32x4*)(F + MA + t * 64 + 4 * kq), xwr = *(const LAS f32x4*)(F + WR + t * 64 + 4 * kq), xwd = *(const LAS f32x4*)(F + WD + t * 64 + 4 * kq);
            const f32x4 xbv = *(const LAS f32x4*)(F + BV + t * 64 + 4 * kq), xkp = *(const LAS f32x4*)(F + KP + t * 64 + 4 * kq);
            const f32x2 vv = *(const LAS f32x2*)(F + VV + t * 64 + 2 * rp);
            const float br = F[BR + t], kr = F[KR + t];
            float p1a = S0[0] * xma[0] + S0[1] * xma[1] + S0[2] * xma[2] + S0[3] * xma[3];
            float p2a = S0[0] * xwr[0] + S0[1] * xwr[1] + S0[2] * xwr[2] + S0[3] * xwr[3];
            float p1b = S1[0] * xma[0] + S1[1] * xma[1] + S1[2] * xma[2] + S1[3] * xma[3];
            float p2b = S1[0] * xwr[0] + S1[1] * xwr[1] + S1[2] * xwr[2] + S1[3] * xwr[3];
            p1a = red16(p1a); p2a = red16(p2a); p1b = red16(p1b); p2b = red16(p2b);
            const float oa = p2a + p1a * br + vv[0] * kr, ob = p2b + p1b * br + vv[1] * kr;
#pragma unroll
            for (int j = 0; j < 4; ++j) { S0[j] = S0[j] * xwd[j] + (p1a * xbv[j] + vv[0] * xkp[j]); S1[j] = S1[j] * xwd[j] + (p1b * xbv[j] + vv[1] * xkp[j]); }
            if (kq == 0) *(LAS f32x2*)(F + OO + t * 64 + 2 * rp) = (f32x2){oa, ob};
        }
        __syncthreads();
        {
            const int o = st * 64 + sc; float ov[8], vv8[8], g8[8], y8[8];
            const f32x4 o0 = *(const LAS f32x4*)(F + OO + o), o1 = *(const LAS f32x4*)(F + OO + o + 4), v0 = *(const LAS f32x4*)(F + VV + o), v1 = *(const LAS f32x4*)(F + VV + o + 4);
            ov[0] = o0[0]; ov[1] = o0[1]; ov[2] = o0[2]; ov[3] = o0[3]; ov[4] = o1[0]; ov[5] = o1[1]; ov[6] = o1[2]; ov[7] = o1[3];
            vv8[0] = v0[0]; vv8[1] = v0[1]; vv8[2] = v0[2]; vv8[3] = v0[3]; vv8[4] = v1[0]; vv8[5] = v1[1]; vv8[6] = v1[2]; vv8[7] = v1[3];
            unpack8(cur_g, g8);
            float s = 0.f;
#pragma unroll
            for (int j = 0; j < 8; ++j) s += ov[j];
            const float mean = red8(s) * (1.0f / 64.0f);
            float q = 0.f;
#pragma unroll
            for (int j = 0; j < 8; ++j) { ov[j] -= mean; q += ov[j] * ov[j]; }
            const float rs = rsqrtf(red8(q) * (1.0f / 64.0f) + 64e-5f), bsv = F[BS + st];
#pragma unroll
            for (int j = 0; j < 8; ++j) y8[j] = (ov[j] * rs * F[CN + 6 * 64 + sc + j] + F[CN + 7 * 64 + sc + j] + bsv * vv8[j]) * g8[j];
            *(u32x4*)(Y + (size_t)(b * SEQ + ch * 64 + st) * DM + 512 + h * 64 + sc) = pack8(y8);
        }
    }
#undef RW_PREFETCH
}

__device__ __forceinline__ void p2_hg(const Params& P, int l, int item, LAS unsigned char* lds) {
    const int tid = threadIdx.x, b = item >> 3, h = (item >> 1) & 3, vh = item & 1;
    const int kg = tid & 15, vp = tid >> 4, st = tid >> 3, c16 = tid & 7, sv = (tid & 7) * 8;
    const bf16_t* U = (const bf16_t*)(P.ws + WS_U); bf16_t* Y = (bf16_t*)(P.ws + WS_HY);
    LAS float* F = LDSF(0);
    constexpr int QK = 0, LBO = 64, FF = 256, KX = 8448, QF = 16640, VV = 24832, OO = 28928;
    __syncthreads();
    if (tid < 128) { float lb = 0.f; if (l == 1) lb = sigmoidf_(P.in[I_HGLB][512 + h * 128 + tid] - P.in[I_HGLB][h * 128 + tid]); F[LBO + tid] = lb; }
    __syncthreads();
    float S0[8], S1[8];
#pragma unroll
    for (int j = 0; j < 8; ++j) { S0[j] = 0.f; S1[j] = 0.f; }
    u32x4 pq0, pq1, pf0, pf1, pv;
#define HG_PREFETCH(ch) do { const bf16_t* ur_ = U + (size_t)(b * SEQ + (ch) * 64 + st) * LDU + h * 128; \
        pq0 = *(const u32x4*)(ur_ + U_HG_Q + c16 * 16); pq1 = *(const u32x4*)(ur_ + U_HG_Q + c16 * 16 + 8); pf0 = *(const u32x4*)(ur_ + U_HG_F + c16 * 16); pf1 = *(const u32x4*)(ur_ + U_HG_F + c16 * 16 + 8); \
        pv = *(const u32x4*)(ur_ + U_HG_I + vh * 64 + sv); } while (0)
    HG_PREFETCH(0);
    for (int ch = 0; ch < SEQ / 64; ++ch) {
        float fo[16], kx[16], qf[16], vv8[8]; float qkp = 0.f;
        {
            float q[16], z[16];
            { float t0[8], t1[8]; unpack8(pq0, t0); unpack8(pq1, t1);
#pragma unroll
              for (int j = 0; j < 8; ++j) { q[j] = t0[j]; q[8 + j] = t1[j]; }
              unpack8(pf0, t0); unpack8(pf1, t1);
#pragma unroll
              for (int j = 0; j < 8; ++j) { z[j] = t0[j]; z[8 + j] = t1[j]; } }
            unpack8(pv, vv8);
#pragma unroll
            for (int j = 0; j < 16; ++j) {
                const float lb = F[LBO + c16 * 16 + j], e = __expf(-z[j]), sg = fast_rcp(1.0f + e);
                fo[j] = lb + (1.0f - lb) * sg; kx[j] = (1.0f - lb) * (e * sg);
                const float qs = siluf_(q[j]); qf[j] = qs * fo[j]; qkp += qs * kx[j];
            }
            qkp = red8(qkp);
        }
        __syncthreads();
        {
#pragma unroll
            for (int m = 0; m < 4; ++m) {
                const int o = st * 128 + (m & 1) * 64 + (2 * c16 + (m >> 1)) * 4;
                *(LAS f32x4*)(F + FF + o) = (f32x4){fo[4 * m], fo[4 * m + 1], fo[4 * m + 2], fo[4 * m + 3]};
                *(LAS f32x4*)(F + KX + o) = (f32x4){kx[4 * m], kx[4 * m + 1], kx[4 * m + 2], kx[4 * m + 3]};
                *(LAS f32x4*)(F + QF + o) = (f32x4){qf[4 * m], qf[4 * m + 1], qf[4 * m + 2], qf[4 * m + 3]};
            }
            *(LAS f32x4*)(F + VV + st * 64 + sv) = (f32x4){vv8[0], vv8[1], vv8[2], vv8[3]}; *(LAS f32x4*)(F + VV + st * 64 + sv + 4) = (f32x4){vv8[4], vv8[5], vv8[6], vv8[7]};
            if (c16 == 0) F[QK + st] = qkp;
        }
        __syncthreads();
        if (ch + 1 < SEQ / 64) HG_PREFETCH(ch + 1);
#pragma unroll 2
        for (int t = 0; t < 64; ++t) {
            const f32x4 fa = *(const LAS f32x4*)(F + FF + t * 128 + kg * 4), fb = *(const LAS f32x4*)(F + FF + t * 128 + 64 + kg * 4);
            const f32x4 ka = *(const LAS f32x4*)(F + KX + t * 128 + kg * 4), kb = *(const LAS f32x4*)(F + KX + t * 128 + 64 + kg * 4);
            const f32x4 qa = *(const LAS f32x4*)(F + QF + t * 128 + kg * 4), qb = *(const LAS f32x4*)(F + QF + t * 128 + 64 + kg * 4);
            const f32x2 vv = *(const LAS f32x2*)(F + VV + t * 64 + 2 * vp);
            const float qk = F[QK + t];
            float pa = 0.f, pb = 0.f;
#pragma unroll
            for (int j = 0; j < 4; ++j) { pa += S0[j] * qa[j] + S0[4 + j] * qb[j]; pb += S1[j] * qa[j] + S1[4 + j] * qb[j]; }
            pa = red16(pa); pb = red16(pb);
#pragma unroll
            for (int j = 0; j < 4; ++j) {
                S0[j] = fa[j] * S0[j] + ka[j] * vv[0]; S0[4 + j] = fb[j] * S0[4 + j] + kb[j] * vv[0];
                S1[j] = fa[j] * S1[j] + ka[j] * vv[1]; S1[4 + j] = fb[j] * S1[4 + j] + kb[j] * vv[1];
            }
            if (kg == 0) *(LAS f32x2*)(F + OO + t * 64 + 2 * vp) = (f32x2){pa + vv[0] * qk, pb + vv[1] * qk};
        }
        __syncthreads();
        {
            const f32x4 o0 = *(const LAS f32x4*)(F + OO + st * 64 + sv), o1 = *(const LAS f32x4*)(F + OO + st * 64 + sv + 4);
            u32x4 w; w.x = pk_bf16(o0[0], o0[1]); w.y = pk_bf16(o0[2], o0[3]); w.z = pk_bf16(o1[0], o1[1]); w.w = pk_bf16(o1[2], o1[3]);
            *(u32x4*)(Y + (size_t)(b * SEQ + ch * 64 + st) * DM + h * 128 + vh * 64 + sv) = w;
        }
    }
#undef HG_PREFETCH
}

__device__ __forceinline__ int ml_poff(int k) { return ((k >> 2) & 1) * 64 + (k >> 3) * 4 + (k & 3); }
__device__ __forceinline__ void p2_ml(const Params& P, int l, int item, LAS unsigned char* lds) {
    const int tid = threadIdx.x, lane = tid & 63, wave = tid >> 6, b = item >> 3, h = (item >> 1) & 3, vh = item & 1;
    const int kg = tid & 15, vp = tid >> 4, st = tid >> 3, c16 = tid & 7, sv = (tid & 7) * 8;
    const int blk = tid & 31, sg = tid >> 5;
    const bf16_t* U = (const bf16_t*)(P.ws + WS_U); bf16_t* Y = (bf16_t*)(P.ws + WS_HY);
    LAS float* F = LDSF(0);
    constexpr int FD = 0, IW = 64, EN = 128, QIK = 192, QFD = 2048, IK = 10240, QP = 18432, VV = 26624, OO = 30720;
    float cw[4][4], cb4[4], wq[4][4], wk[4][4];
    {
        const int cgl = h * 128 + blk * 4;
#pragma unroll
        for (int jj = 0; jj < 4; ++jj) { const f32x4 w = *(const f32x4*)(P.in[I_MLCW] + l * 2048 + jj * 512 + cgl); cw[jj][0] = w[0]; cw[jj][1] = w[1]; cw[jj][2] = w[2]; cw[jj][3] = w[3]; }
        { const f32x4 w = *(const f32x4*)(P.in[I_MLCB] + l * 512 + cgl); cb4[0] = w[0]; cb4[1] = w[1]; cb4[2] = w[2]; cb4[3] = w[3]; }
#pragma unroll
        for (int j = 0; j < 4; ++j) {
            const f32x4 a = *(const f32x4*)(P.in[I_MLWQ] + (size_t)l * 2048 + (h * 32 + blk) * 16 + j * 4), c = *(const f32x4*)(P.in[I_MLWK] + (size_t)l * 2048 + (h * 32 + blk) * 16 + j * 4);
            wq[j][0] = a[0] * 0.08838834764831845f; wq[j][1] = a[1] * 0.08838834764831845f; wq[j][2] = a[2] * 0.08838834764831845f; wq[j][3] = a[3] * 0.08838834764831845f;
            wk[j][0] = c[0]; wk[j][1] = c[1]; wk[j][2] = c[2]; wk[j][3] = c[3];
        }
    }
    const float ib = P.in[I_MLIB][l * 4 + h], fb = P.in[I_MLFB][l * 4 + h];
    float M0[8], M1[8];
#pragma unroll
    for (int j = 0; j < 8; ++j) { M0[j] = 0.f; M1[j] = 0.f; }
    float nk = 0.f;
    float mcarry = 0.f;
    u32x2 px[7]; u32x4 pv; unsigned pif;
#define ML_PREFETCH(ch) do { const int ts0_ = (ch) * 64 + sg * 4 - 3; \
        _Pragma("unroll") for (int r = 0; r < 7; ++r) { const int ts_ = ts0_ + r; \
            px[r] = *(const u32x2*)(U + (size_t)(b * SEQ + (ts_ < 0 ? 0 : ts_)) * LDU + U_ML_X + h * 128 + blk * 4); } \
        pv = *(const u32x4*)(U + (size_t)(b * SEQ + (ch) * 64 + st) * LDU + U_ML_V + h * 128 + vh * 64 + sv); \
        { const bf16_t* ug_ = U + (size_t)(b * SEQ + (ch) * 64 + lane) * LDU; pif = (unsigned)ug_[U_ML_I + h] | ((unsigned)ug_[U_ML_F + h] << 16); } } while (0)
    __syncthreads();
    ML_PREFETCH(0);
    for (int ch = 0; ch < SEQ / 64; ++ch) {
        float q[4][4], k[4][4], vv8[8];
        {
            float x[7][4];
#pragma unroll
            for (int r = 0; r < 7; ++r) { const float vf = (ch * 64 + sg * 4 - 3 + r) < 0 ? 0.f : 1.f; x[r][0] = vf * bflo(px[r].x); x[r][1] = vf * bfhi(px[r].x); x[r][2] = vf * bflo(px[r].y); x[r][3] = vf * bfhi(px[r].y); }
#pragma unroll
            for (int s = 0; s < 4; ++s) {
                float xc[4];
#pragma unroll
                for (int j = 0; j < 4; ++j) xc[j] = siluf_(cb4[j] + cw[0][j] * x[s][j] + cw[1][j] * x[s + 1][j] + cw[2][j] * x[s + 2][j] + cw[3][j] * x[s + 3][j]);
#pragma unroll
                for (int i = 0; i < 4; ++i) {
                    q[s][i] = xc[0] * wq[0][i] + xc[1] * wq[1][i] + xc[2] * wq[2][i] + xc[3] * wq[3][i];
                    k[s][i] = xc[0] * wk[0][i] + xc[1] * wk[1][i] + xc[2] * wk[2][i] + xc[3] * wk[3][i];
                }
            }
            unpack8(pv, vv8);
        }
        __syncthreads();
        if (wave == 0) {
            const float ip = bflo(pif) + ib, xf = bfhi(pif) + fb;
            const float lf = fminf(xf, 0.f) - log1pf(__expf(-fabsf(xf)));
            float bs = lf;
#pragma unroll
            for (int d = 1; d < 64; d <<= 1) { const float o = __shfl_up(bs, d); if (lane >= d) bs += o; }
            float cm = ip - bs;
#pragma unroll
            for (int d = 1; d < 64; d <<= 1) { const float o = __shfl_up(cm, d); if (lane >= d) cm = fmaxf(cm, o); }
            const float g = fmaxf(mcarry, cm), mt = bs + g;
            float gp = __shfl_up(g, 1); if (lane == 0) gp = mcarry;
            F[FD + lane] = __expf(gp - g);
            F[IW + lane] = __expf(ip - mt);
            F[EN + lane] = __expf(-mt);
            mcarry = __shfl(mt, 63);
        }
        __syncthreads();
        {
#pragma unroll
            for (int s = 0; s < 4; ++s) {
                const int t = sg * 4 + s; const float fd = F[FD + t], iw = F[IW + t];
                const f32x4 ik = (f32x4){k[s][0] * iw, k[s][1] * iw, k[s][2] * iw, k[s][3] * iw};
                float qp = q[s][0] * ik[0] + q[s][1] * ik[1] + q[s][2] * ik[2] + q[s][3] * ik[3];
                qp = red16(qp); qp += __shfl_xor(qp, 16);
                const int o = t * 128 + (blk & 1) * 64 + (blk >> 1) * 4;
                *(LAS f32x4*)(F + QFD + o) = (f32x4){q[s][0] * fd, q[s][1] * fd, q[s][2] * fd, q[s][3] * fd};
                *(LAS f32x4*)(F + IK + o) = ik;
                *(LAS f32x4*)(F + QP + t * 128 + blk * 4) = (f32x4){q[s][0], q[s][1], q[s][2], q[s][3]};
                if (blk == 0) F[QIK + t] = qp;
            }
            *(LAS f32x4*)(F + VV + st * 64 + sv) = (f32x4){vv8[0], vv8[1], vv8[2], vv8[3]}; *(LAS f32x4*)(F + VV + st * 64 + sv + 4) = (f32x4){vv8[4], vv8[5], vv8[6], vv8[7]};
        }
        __syncthreads();
        if (ch + 1 < SEQ / 64) ML_PREFETCH(ch + 1);
        if (tid < 128) {
            const int po = ml_poff(tid);
#pragma unroll 4
            for (int t = 0; t < 64; ++t) { nk = F[FD + t] * nk + F[IK + t * 128 + po]; F[QP + t * 128 + tid] *= nk; }
        }
#pragma unroll 2
        for (int t = 0; t < 64; ++t) {
            const f32x4 qa = *(const LAS f32x4*)(F + QFD + t * 128 + kg * 4), qb = *(const LAS f32x4*)(F + QFD + t * 128 + 64 + kg * 4);
            const f32x4 ka = *(const LAS f32x4*)(F + IK + t * 128 + kg * 4), kb = *(const LAS f32x4*)(F + IK + t * 128 + 64 + kg * 4);
            const f32x2 vv = *(const LAS f32x2*)(F + VV + t * 64 + 2 * vp);
            const float fd = F[FD + t], qik = F[QIK + t];
            float pa = 0.f, pb = 0.f;
#pragma unroll
            for (int j = 0; j < 4; ++j) { pa += M0[j] * qa[j] + M0[4 + j] * qb[j]; pb += M1[j] * qa[j] + M1[4 + j] * qb[j]; }
            pa = red16(pa); pb = red16(pb);
#pragma unroll
            for (int j = 0; j < 4; ++j) {
                M0[j] = fd * M0[j] + ka[j] * vv[0]; M0[4 + j] = fd * M0[4 + j] + kb[j] * vv[0];
                M1[j] = fd * M1[j] + ka[j] * vv[1]; M1[4 + j] = fd * M1[4 + j] + kb[j] * vv[1];
            }
            if (kg == 0) *(LAS f32x2*)(F + OO + t * 64 + 2 * vp) = (f32x2){pa + vv[0] * qik, pb + vv[1] * qik};
        }
        __syncthreads();
        {
            float d = 0.f;
#pragma unroll
            for (int m = 0; m < 4; ++m) { const f32x4 x = *(const LAS f32x4*)(F + QP + st * 128 + c16 * 16 + 4 * m); d += (x[0] + x[1]) + (x[2] + x[3]); }
            d = red8(d);
            const float dinv = 1.0f / fmaxf(fabsf(d), F[EN + st]);
            const f32x4 o0 = *(const LAS f32x4*)(F + OO + st * 64 + sv), o1 = *(const LAS f32x4*)(F + OO + st * 64 + sv + 4);
            u32x4 w; w.x = pk_bf16(o0[0] * dinv, o0[1] * dinv); w.y = pk_bf16(o0[2] * dinv, o0[3] * dinv); w.z = pk_bf16(o1[0] * dinv, o1[1] * dinv); w.w = pk_bf16(o1[2] * dinv, o1[3] * dinv);
            *(u32x4*)(Y + (size_t)(b * SEQ + ch * 64 + st) * DM + 1024 + h * 128 + vh * 64 + sv) = w;
        }
    }
#undef ML_PREFETCH
}

__device__ __forceinline__ void p2_lru(const Params& P, int item, LAS unsigned char* lds) {
    const int tid = threadIdx.x, lane = tid & 63, wave = tid >> 6, b = item >> 3, cgp = item & 7;
    const float* LA = (const float*)(P.ws + WS_LRUA); const float* LB = (const float*)(P.ws + WS_LRUB); bf16_t* Y = (bf16_t*)(P.ws + WS_HY);
    LAS float* F = LDSF(0);
    const size_t base = (size_t)(b * SEQ + wave * 512) * 512 + cgp * 64 + lane;
    float hh = 0.f, ap = 1.f;
#pragma unroll 8
    for (int t = 0; t < 512; ++t) { const float a = LA[base + (size_t)t * 512], x = LB[base + (size_t)t * 512]; hh = a * hh + x; ap *= a; }
    __syncthreads();
    F[wave * 64 + lane] = ap; F[512 + wave * 64 + lane] = hh;
    __syncthreads();
    float c = 0.f;
    for (int j = 0; j < wave; ++j) c = F[j * 64 + lane] * c + F[512 + j * 64 + lane];
    hh = c;
    bf16_t* yp = Y + (size_t)(b * SEQ + wave * 512) * DM + 1536 + cgp * 64 + lane;
#pragma unroll 8
    for (int t = 0; t < 512; ++t) { const float a = LA[base + (size_t)t * 512], x = LB[base + (size_t)t * 512]; hh = a * hh + x; yp[(size_t)t * DM] = (bf16_t)(pk_bf16(hh, 0.f) & 0xffffu); }
}

__device__ __forceinline__ void phase_p3(const Params& P, int l) {
    const int tid = threadIdx.x, lane = tid & 63, wave = tid >> 6, c0 = lane * 8;
    const bf16_t* U = (const bf16_t*)(P.ws + WS_U); bf16_t* Y = (bf16_t*)(P.ws + WS_HY);
    float hgn[8], mln[8], msk[8], mcb[8], lrn[8];
#pragma unroll
    for (int j = 0; j < 8; ++j) { hgn[j] = P.in[I_HGNORM][l * 512 + c0 + j]; mln[j] = P.in[I_MLNORM][l * 512 + c0 + j]; msk[j] = P.in[I_MLSKIP][l * 512 + c0 + j]; mcb[j] = P.in[I_MLCB][l * 512 + c0 + j]; lrn[j] = P.in[I_LRUNORM][l * 512 + c0 + j]; }
    const float* mcw = P.in[I_MLCW] + l * 2048 + c0;
    for (int tok = blockIdx.x * 8 + wave; tok < NTOK; tok += gridDim.x * 8) {
        bf16_t* yr = Y + (size_t)tok * DM; const bf16_t* ur = U + (size_t)tok * LDU; const int tseq = tok & (SEQ - 1);
        {
            float o[8], g[8], y8[8]; unpack8(*(const u32x4*)(yr + c0), o); unpack8(*(const u32x4*)(ur + U_HG_G + c0), g);
            float ss = 0.f;
#pragma unroll
            for (int j = 0; j < 8; ++j) ss += o[j] * o[j];
            const float rs = rsqrtf(red16(ss) * (1.0f / 128.0f) + 1e-6f);
#pragma unroll
            for (int j = 0; j < 8; ++j) y8[j] = o[j] * rs * hgn[j] * siluf_(g[j]);
            *(u32x4*)(yr + c0) = pack8(y8);
        }
        {
            float hv[8], og[8], y8[8], xc[8]; unpack8(*(const u32x4*)(yr + 1024 + c0), hv); unpack8(*(const u32x4*)(ur + U_ML_O + c0), og);
#pragma unroll
            for (int j = 0; j < 8; ++j) xc[j] = mcb[j];
#pragma unroll
            for (int jj = 0; jj < 4; ++jj) {
                const bool valid = (tseq - 3 + jj) >= 0; const float vf = valid ? 1.f : 0.f;
                float x[8]; unpack8(*(const u32x4*)(U + (size_t)(valid ? tok - 3 + jj : tok) * LDU + U_ML_X + c0), x);
                const f32x4 w0 = *(const f32x4*)(mcw + jj * 512), w1 = *(const f32x4*)(mcw + jj * 512 + 4);
                xc[0] += vf * w0[0] * x[0]; xc[1] += vf * w0[1] * x[1]; xc[2] += vf * w0[2] * x[2]; xc[3] += vf * w0[3] * x[3];
                xc[4] += vf * w1[0] * x[4]; xc[5] += vf * w1[1] * x[5]; xc[6] += vf * w1[2] * x[6]; xc[7] += vf * w1[3] * x[7];
            }
            float ss = 0.f;
#pragma unroll
            for (int j = 0; j < 8; ++j) { hv[j] *= sigmoidf_(og[j]); ss += hv[j] * hv[j]; }
            const float rs = rsqrtf(red16(ss) * (1.0f / 128.0f) + 1e-6f);
#pragma unroll
            for (int j = 0; j < 8; ++j) y8[j] = hv[j] * rs * mln[j] + msk[j] * siluf_(xc[j]);
            *(u32x4*)(yr + 1024 + c0) = pack8(y8);
        }
        {
            float hv[8], gb[8], y8[8]; unpack8(*(const u32x4*)(yr + 1536 + c0), hv); unpack8(*(const u32x4*)(ur + U_LRU_G + c0), gb);
            float ss = 0.f;
#pragma unroll
            for (int j = 0; j < 8; ++j) { hv[j] *= gelu_tanhf_(gb[j]); ss += hv[j] * hv[j]; }
            const float rs = rsqrtf(red64(ss) * (1.0f / 512.0f) + 1e-6f);
#pragma unroll
            for (int j = 0; j < 8; ++j) y8[j] = hv[j] * rs * lrn[j];
            *(u32x4*)(yr + 1536 + c0) = pack8(y8);
        }
    }
}

#ifndef MK_ONE_LAUNCH
#define MK_ONE_LAUNCH 0
#endif
enum { K_CONVERT = 0, K_MODFINAL, K_NORM, K_UP, K_DOWN, K_WIN, K_P1, K_P2, K_P3, K_WOUT, K_FINAL };
template <int KIND> __device__ __forceinline__ void run_phase(const Params& P, int l, int sub, LAS unsigned char* lds) {
    const float* modf = (const float*)(P.ws + WS_MODF);
    bf16_t* HY = (bf16_t*)(P.ws + WS_HY); bf16_t* UU = (bf16_t*)(P.ws + WS_U);
    const bf16_t* Wl = (const bf16_t*)(P.ws + WS_W) + (size_t)l * LW_ELEMS;
    const float* xcur = (l == 0 && sub == 0) ? P.in[I_X] : P.out;
    const int f = sub >> 1;
    if constexpr (KIND == K_CONVERT) phase_convert(P, lds);
    if constexpr (KIND == K_MODFINAL) phase_modfinal(P);
    if constexpr (KIND == K_NORM) phase_norm(P, l, sub, xcur, lds);
    if constexpr (KIND == K_UP) {
        pg8::Gemm g{HY, Wl + (f ? LW_W13B : LW_W13A), NTOK, 2 * DFF, DM}; pg8::StaticOrder S; S.init(NTOK, 2 * DFF, (int)gridDim.x, (int)blockIdx.x);
        EpiSwiGLU E{UU};
        pg8::gemm_phase<EpiSwiGLU, pg8::StaticOrder, true, true>(lds, g, S, E);
    }
    if constexpr (KIND == K_DOWN) {
        pg8::Gemm g{UU, Wl + (f ? LW_W2B : LW_W2A), NTOK, DM, DFF}; pg8::StaticOrder S; S.init(NTOK, DM, (int)gridDim.x, (int)blockIdx.x);
        EpiResid E{xcur, P.out, modf + (size_t)l * 8 * NMOD + sub * 6144 + 4096, 0.5f};
        pg8::gemm_phase<EpiResid, pg8::StaticOrder, true, true>(lds, g, S, E);
    }
    if constexpr (KIND == K_WIN) {
        pg8::Gemm g{HY, Wl + LW_WIN, NTOK, LDU, DM}; pg8::StaticOrder S; S.init(NTOK, LDU, (int)gridDim.x, (int)blockIdx.x);
        EpiU E{UU};
        pg8::gemm_phase<EpiU, pg8::StaticOrder, true, true>(lds, g, S, E);
    }
    if constexpr (KIND == K_P1) { p1_rw_lora(P, l, lds); p1_lru_prep(P, l, lds); }
    if constexpr (KIND == K_P2) {
        for (int it = blockIdx.x; it < 256; it += gridDim.x) {
            const int kind = it >> 6, sub_it = it & 63;
            if (kind == 0) p2_rw(P, l, sub_it, lds);
            else if (kind == 1) p2_hg(P, l, sub_it, lds);
            else if (kind == 2) p2_ml(P, l, sub_it, lds);
            else p2_lru(P, sub_it, lds);
        }
    }
    if constexpr (KIND == K_P3) phase_p3(P, l);
    if constexpr (KIND == K_WOUT) {
        pg8::Gemm g{HY, Wl + LW_WOUT, NTOK, DM, DM}; pg8::StaticOrder S; S.init(NTOK, DM, (int)gridDim.x, (int)blockIdx.x);
        EpiResid E{P.out, P.out, modf + (size_t)l * 8 * NMOD + 1 * 6144 + 4096, 1.0f};
        pg8::gemm_phase<EpiResid, pg8::StaticOrder, true, true>(lds, g, S, E);
    }
    if constexpr (KIND == K_FINAL) phase_final_norm(P);
}

#if !MK_ONE_LAUNCH
template <int KIND> __global__ void __launch_bounds__(NTHR, 2) k_phase(Params P, int l, int sub) {
    extern __shared__ __attribute__((aligned(16))) unsigned char lds_raw[];
    run_phase<KIND>(P, l, sub, (LAS unsigned char*)lds_raw);
}
#else
constexpr int N_PHASES = 27;
__global__ void __launch_bounds__(NTHR, 2) hymba_fwd(Params P) {
    extern __shared__ __attribute__((aligned(16))) unsigned char lds_raw[];
    LAS unsigned char* lds = (LAS unsigned char*)lds_raw;
    const int lo = P.ph_lo, hi = P.ph_hi;
    if (threadIdx.x == 0) *(LAS uint4*)(lds + LDS_BARW) = make_uint4(0u, 0u, 0u, 0u);
    __syncthreads();
    XcdBarrier bar = xcd_barrier_post((unsigned*)(P.ws + WS_BAR), (volatile LAS unsigned*)(lds + LDS_BARW));
#define SEAM(k) do { if ((k) + 1 < hi) xcd_barrier(bar); } while (0)
#define IN(k) (lo <= (k) && (k) < hi)
    if (IN(0)) { run_phase<K_CONVERT>(P, 0, 0, lds); SEAM(0); }
    if (IN(1)) { run_phase<K_MODFINAL>(P, 0, 0, lds); SEAM(1); }
    for (int l = 0; l < 2; ++l) {
        for (int sub = 0; sub < 3; ++sub) {
            const int pb = 2 + 12 * l + (sub == 0 ? 0 : (sub == 1 ? 3 : 9));
            if (IN(pb)) { run_phase<K_NORM>(P, l, sub, lds); SEAM(pb); }
            if (sub != 1) {
                if (IN(pb + 1)) { run_phase<K_UP>(P, l, sub, lds); SEAM(pb + 1); }
                if (IN(pb + 2)) { run_phase<K_DOWN>(P, l, sub, lds); SEAM(pb + 2); }
            } else {
                if (IN(pb + 1)) { run_phase<K_WIN>(P, l, sub, lds); SEAM(pb + 1); }
                if (IN(pb + 2)) { run_phase<K_P1>(P, l, sub, lds); SEAM(pb + 2); }
                if (IN(pb + 3)) { run_phase<K_P2>(P, l, sub, lds); SEAM(pb + 3); }
                if (IN(pb + 4)) { run_phase<K_P3>(P, l, sub, lds); SEAM(pb + 4); }
                if (IN(pb + 5)) { run_phase<K_WOUT>(P, l, sub, lds); SEAM(pb + 5); }
            }
        }
    }
    if (IN(26)) run_phase<K_FINAL>(P, 0, 0, lds);
#undef IN
#undef SEAM
}
#endif

#if !MK_ONE_LAUNCH
template <int KIND> static void launch_phase(const Params& p, int l, int sub, int grid, hipStream_t stream) {
    static bool attr_set = false;
    if (!attr_set) { (void)hipFuncSetAttribute((const void*)k_phase<KIND>, hipFuncAttributeMaxDynamicSharedMemorySize, LDS_BYTES); attr_set = true; }
    hipLaunchKernelGGL(k_phase<KIND>, dim3(grid), dim3(NTHR), LDS_BYTES, stream, p, l, sub);
}
#endif
extern "C" void kernel_launch(void* const* d_in, const int* in_sizes, int n_in, void* d_out, int out_size, void* d_ws, size_t ws_size, hipStream_t stream) {
    static int grid = 0;
    if (grid == 0) {
        if (n_in != N_IN || out_size != NTOK * DM || ws_size < WS_END) { fprintf(stderr, "kernel_launch: unexpected shapes (n_in %d, out %d, ws %zu < %zu)\n", n_in, out_size, ws_size, (size_t)WS_END); grid = -1; return; }
        int dev = 0, cus = 0;
        if (hipGetDevice(&dev) != hipSuccess || hipDeviceGetAttribute(&cus, hipDeviceAttributeMultiprocessorCount, dev) != hipSuccess) { grid = -1; return; }
#if MK_ONE_LAUNCH
        int per_cu = 0;
        if (hipFuncSetAttribute((const void*)hymba_fwd, hipFuncAttributeMaxDynamicSharedMemorySize, LDS_BYTES) != hipSuccess) { fprintf(stderr, "kernel_launch: hipFuncSetAttribute failed\n"); grid = -1; return; }
        if (hipOccupancyMaxActiveBlocksPerMultiprocessor(&per_cu, (const void*)hymba_fwd, NTHR, LDS_BYTES) != hipSuccess || per_cu < 1) fprintf(stderr, "kernel_launch: occupancy query says %d\n", per_cu);
        (void)hipGetLastError();
#endif
        grid = cus;
        if (grid != 256) fprintf(stderr, "kernel_launch: %d CUs (built for 256)\n", grid);
    }
    if (grid < 0) return;
    Params p{};
    for (int i = 0; i < N_IN; ++i) p.in[i] = (const float*)d_in[i];
    p.out = (float*)d_out; p.ws = (unsigned char*)d_ws;
#if MK_ONE_LAUNCH
    (void)hipMemsetAsync((char*)d_ws + WS_BAR, 0, 16384, stream);
    p.ph_lo = 0; p.ph_hi = N_PHASES;
    hipLaunchKernelGGL(hymba_fwd, dim3(grid), dim3(NTHR), LDS_BYTES, stream, p);
#else
    p.ph_lo = 0; p.ph_hi = 0;
    launch_phase<K_CONVERT>(p, 0, 0, grid, stream);
    launch_phase<K_MODFINAL>(p, 0, 0, grid, stream);
    for (int l = 0; l < 2; ++l)
        for (int sub = 0; sub < 3; ++sub) {
            launch_phase<K_NORM>(p, l, sub, grid, stream);
            if (sub != 1) { launch_phase<K_UP>(p, l, sub, grid, stream); launch_phase<K_DOWN>(p, l, sub, grid, stream); }
            else { launch_phase<K_WIN>(p, l, sub, grid, stream); launch_phase<K_P1>(p, l, sub, grid, stream); launch_phase<K_P2>(p, l, sub, grid, stream);
                   launch_phase<K_P3>(p, l, sub, grid, stream); launch_phase<K_WOUT>(p, l, sub, grid, stream); }
        }
    launch_phase<K_FINAL>(p, 0, 0, grid, stream);
#endif
}
```

```cpp
#include <hip/hip_runtime.h>
#include <cstdio>
#include <cstdint>
__device__ __forceinline__ int ltid() { int t = (int)threadIdx.x; asm volatile("" : "+v"(t)); return t; }
__device__ __forceinline__ int lbid() { int x = (int)blockIdx.x; asm volatile("" : "+s"(x)); return x; }
__device__ __forceinline__ int lgdim() { int x = (int)gridDim.x; asm volatile("" : "+s"(x)); return x; }
__device__ __forceinline__ int lsgpr(int x) { asm volatile("" : "+s"(x)); return x; }
namespace pg8 {
#define PG8_LAS __attribute__((address_space(3)))
typedef unsigned short bf16_t;
typedef short bf16x8 __attribute__((ext_vector_type(8)));
typedef float f32x4 __attribute__((ext_vector_type(4)));
typedef unsigned u32x4 __attribute__((ext_vector_type(4)));
constexpr int BM = 256, BK = 64, HALF = 128, HTB = HALF * BK * 2  , STAGE_BYTES = 8 * HTB, NXCD = 8, WGM = 8;

__host__ __device__ __forceinline__ int lds_byte(int r, int c) { const int st = (r >> 4) * 2 + (c >> 5), rr = r & 15, cc = c & 31, ob = rr * 64 + cc * 2; return st * 1024 + (ob ^ (((ob >> 9) & 1) << 5)); }
__host__ __device__ __forceinline__ void stage_rc(int b, int& R, int& C) { const int st = b / 1024, sb = b % 1024, swz = sb ^ (((sb >> 9) & 1) << 5); R = (st >> 1) * 16 + swz / 64; C = (st & 1) * 32 + (swz % 64) / 2; }
__host__ __device__ __forceinline__ int perm32(int rho) { const int n = rho >> 4, i = rho & 15; return 8 * (i >> 2) + 4 * n + (i & 3); }

struct Unit { int pm, pn; };
struct Gemm { const bf16_t* A; const bf16_t* Bt; int M, N, K; };

struct StaticOrder {
    int nM, nN, nwg, G, c;
    __host__ __device__ void init(int M, int N, int G_, int c_) { nM = M / BM; nN = N / BM; nwg = nM * nN; G = G_; c = c_; }
    __host__ __device__ bool next(int i, Unit& u) const {
        const long L = (long)i * G + c; if (L >= nwg) return false;
        int wgid = (int)L; { const int q = nwg / NXCD, r = nwg % NXCD, xcd = wgid % NXCD, off = wgid / NXCD; wgid = (xcd < r ? xcd * (q + 1) : r * (q + 1) + (xcd - r) * q) + off; }
        const int nig = WGM * nN, gid = wgid / nig, fm = gid * WGM, gsz = (nM - fm) < WGM ? (nM - fm) : WGM;
        u.pm = fm + ((wgid % nig) % gsz); u.pn = (wgid % nig) / gsz; return true;
    }
    __device__ __forceinline__ void a_ready(const Unit&) const {}
    __device__ __forceinline__ void done(const Unit&) const {}
};
template <class Epi, class Sched, bool ALIGN_EPI = false, bool SP2 = false>
__device__ __forceinline__ void gemm_phase(PG8_LAS unsigned char* lds, const Gemm g, const Sched& S, const Epi& E) {
    const int tid = ltid(), wid = __builtin_amdgcn_readfirstlane(tid >> 6), lane = tid & 63, wr = wid >> 2, wc = wid & 3, fr = lane & 15, fq = lane >> 4;
    const int K = g.K, nt = K / BK;
    unsigned voffA[2], voffB[2];
#pragma unroll
    for (int i = 0; i < 2; ++i) { int R, C; stage_rc(tid * 16 + i * 8192, R, C); const int Rb = Epi::PERM ? ((R & ~31) + perm32(R & 31)) : R;
        voffA[i] = (unsigned)(R * K + C) * 2u; voffB[i] = (unsigned)(Rb * K + C) * 2u; }
    const size_t kstep = (size_t)(BK * 2);
    const size_t hstep = (size_t)HALF * K * 2;
    const size_t tstep = 2 * hstep;
    const unsigned ldsw = (unsigned)wid * 1024u;
    const int aoff = lds_byte(wr * 64 + fr, fq * 8), boff = lds_byte(wc * 32 + fr, fq * 8);
#define PG8_SA(b, h) (((b) * 2 + (h)) * HTB)
#define PG8_SB(b, h) ((4 + (b) * 2 + (h)) * HTB)
#define PG8_STAGE(bufoff, gbase, voff) do { _Pragma("unroll") for (int _i = 0; _i < 2; ++_i) \
        __builtin_amdgcn_global_load_lds((const unsigned*)((const char*)(gbase) + (voff)[_i]), (PG8_LAS unsigned*)(lds + (bufoff) + ldsw + _i * 8192), 16, 0, 0); } while (0)
#define PG8_LDA(dst, b, h) do { _Pragma("unroll") for (int m = 0; m < 4; ++m) _Pragma("unroll") for (int k = 0; k < 2; ++k) dst[m][k] = *(const PG8_LAS bf16x8*)(lds + PG8_SA(b, h) + aoff + m * 2048 + k * 1024); } while (0)
#define PG8_LDB(dst, b, h) do { _Pragma("unroll") for (int n = 0; n < 2; ++n) _Pragma("unroll") for (int k = 0; k < 2; ++k) dst[n][k] = *(const PG8_LAS bf16x8*)(lds + PG8_SB(b, h) + boff + n * 2048 + k * 1024); } while (0)
#define PG8_MMA(ai, bj, At, Bt) do { __builtin_amdgcn_s_setprio(1); _Pragma("unroll") for (int m = 0; m < 4; ++m) _Pragma("unroll") for (int n = 0; n < 2; ++n) _Pragma("unroll") for (int k = 0; k < 2; ++k) \
        acc[ai][bj][m][n] = __builtin_amdgcn_mfma_f32_16x16x32_bf16(Bt[n][k], At[m][k], acc[ai][bj][m][n], 0, 0, 0); __builtin_amdgcn_s_setprio(0); } while (0)
#define PG8_WAIT_V(n) asm volatile("s_waitcnt vmcnt(" #n ")" ::: "memory")
#define PG8_WAIT_L(n) asm volatile("s_waitcnt lgkmcnt(" #n ")" ::: "memory")
#define PG8_BAR __builtin_amdgcn_s_barrier()
#define PG8_SCHED __builtin_amdgcn_sched_barrier(0)
    Unit cur, nxt; int ui = 0;
    if (!S.next(0, cur)) return;
    f32x4 acc[2][2][4][2];
#pragma unroll
    for (int a = 0; a < 2; ++a)
#pragma unroll
        for (int b = 0; b < 2; ++b)
#pragma unroll
            for (int m = 0; m < 4; ++m)
#pragma unroll
                for (int n = 0; n < 2; ++n) acc[a][b][m][n] = (f32x4){0.f, 0.f, 0.f, 0.f};
    bf16x8 At[4][2], B0[2][2], B1[2][2];
    const char* cA = (const char*)g.A + (size_t)cur.pm * tstep; const char* cB = (const char*)g.Bt + (size_t)cur.pn * tstep;
    S.a_ready(cur);
    if constexpr (SP2) {
        PG8_STAGE(PG8_SB(0, 0), cB, voffB); PG8_STAGE(PG8_SB(0, 1), cB + hstep, voffB); PG8_STAGE(PG8_SA(0, 0), cA, voffA); PG8_STAGE(PG8_SA(0, 1), cA + hstep, voffA);
        if (wr == 1) PG8_BAR;
        PG8_WAIT_V(2); PG8_BAR;
        PG8_STAGE(PG8_SB(1, 0), cB + kstep, voffB); PG8_STAGE(PG8_SA(1, 0), cA + kstep, voffA); PG8_STAGE(PG8_SB(1, 1), cB + hstep + kstep, voffB);
        PG8_WAIT_V(6); PG8_BAR;
    } else {
        PG8_STAGE(PG8_SB(0, 0), cB, voffB); PG8_STAGE(PG8_SA(0, 0), cA, voffA); PG8_STAGE(PG8_SB(0, 1), cB + hstep, voffB); PG8_STAGE(PG8_SA(0, 1), cA + hstep, voffA);
        if (wr == 1) PG8_BAR;
        PG8_WAIT_V(4); PG8_BAR;
        PG8_STAGE(PG8_SB(1, 0), cB + kstep, voffB); PG8_STAGE(PG8_SA(1, 0), cA + kstep, voffA); PG8_STAGE(PG8_SB(1, 1), cB + hstep + kstep, voffB);
        PG8_WAIT_V(6); PG8_BAR;
    }
    for (;;) {
        const bool has_next = S.next(ui + 1, nxt);
        const char* nA = has_next ? (const char*)g.A + (size_t)nxt.pm * tstep : cA; const char* nB = has_next ? (const char*)g.Bt + (size_t)nxt.pn * tstep : cB;
        for (int t = 0; t < nt; t += 2) {
            const bool last = (t == nt - 2);
            const char* a1 = cA + (size_t)(t + 1) * kstep;
            const char* a2 = last ? nA : cA + (size_t)(t + 2) * kstep; const char* b2 = last ? nB : cB + (size_t)(t + 2) * kstep;
            const char* a3 = a2 + kstep; const char* b3 = b2 + kstep;
            if (last && has_next) S.a_ready(nxt);
            if constexpr (SP2) {
            PG8_LDB(B0, 0, 0); PG8_LDB(B1, 0, 1); PG8_SCHED; PG8_LDA(At, 0, 0); PG8_STAGE(PG8_SA(1, 1), a1 + hstep, voffA);
            PG8_WAIT_V(8); PG8_WAIT_L(0); PG8_BAR; PG8_MMA(0, 0, At, B0); PG8_MMA(0, 1, At, B1); PG8_BAR; PG8_SCHED;
            PG8_LDA(At, 0, 1); PG8_STAGE(PG8_SB(0, 0), b2, voffB); PG8_STAGE(PG8_SB(0, 1), b2 + hstep, voffB); PG8_STAGE(PG8_SA(0, 0), a2, voffA);
            PG8_WAIT_V(8); PG8_WAIT_L(0); PG8_BAR; PG8_MMA(1, 0, At, B0); PG8_MMA(1, 1, At, B1); PG8_BAR; PG8_SCHED;
            PG8_LDB(B0, 1, 0); PG8_LDB(B1, 1, 1); PG8_SCHED; PG8_LDA(At, 1, 0); PG8_STAGE(PG8_SA(0, 1), a2 + hstep, voffA);
            PG8_WAIT_V(8); PG8_WAIT_L(0); PG8_BAR; PG8_MMA(0, 0, At, B0); PG8_MMA(0, 1, At, B1); PG8_BAR; PG8_SCHED;
            PG8_LDA(At, 1, 1); PG8_STAGE(PG8_SB(1, 0), b3, voffB); PG8_STAGE(PG8_SB(1, 1), b3 + hstep, voffB); PG8_STAGE(PG8_SA(1, 0), a3, voffA);
            PG8_WAIT_V(8); PG8_WAIT_L(0); PG8_BAR; PG8_MMA(1, 0, At, B0); PG8_MMA(1, 1, At, B1); PG8_BAR; PG8_SCHED;
            } else {
            PG8_LDB(B0, 0, 0); PG8_SCHED; PG8_LDA(At, 0, 0); PG8_STAGE(PG8_SA(1, 1), a1 + hstep, voffA);
            PG8_WAIT_L(8); PG8_BAR; PG8_WAIT_L(0); PG8_MMA(0, 0, At, B0); PG8_BAR; PG8_SCHED;
            PG8_LDB(B1, 0, 1); PG8_STAGE(PG8_SB(0, 0), b2, voffB);
            PG8_BAR; PG8_WAIT_L(0); PG8_MMA(0, 1, At, B1); PG8_BAR;
            PG8_LDA(At, 0, 1); PG8_STAGE(PG8_SA(0, 0), a2, voffA);
            PG8_BAR; PG8_WAIT_L(0); PG8_MMA(1, 0, At, B0); PG8_BAR; PG8_SCHED;
            PG8_STAGE(PG8_SB(0, 1), b2 + hstep, voffB);
            PG8_WAIT_V(6); PG8_BAR; PG8_MMA(1, 1, At, B1); PG8_BAR;
            PG8_LDB(B0, 1, 0); PG8_SCHED; PG8_LDA(At, 1, 0); PG8_STAGE(PG8_SA(0, 1), a2 + hstep, voffA);
            PG8_WAIT_L(8); PG8_BAR; PG8_WAIT_L(0); PG8_MMA(0, 0, At, B0); PG8_BAR; PG8_SCHED;
            PG8_LDB(B1, 1, 1); PG8_STAGE(PG8_SB(1, 0), b3, voffB);
            PG8_BAR; PG8_WAIT_L(0); PG8_MMA(0, 1, At, B1); PG8_BAR;
            PG8_LDA(At, 1, 1); PG8_STAGE(PG8_SA(1, 0), a3, voffA);
            PG8_BAR; PG8_WAIT_L(0); PG8_MMA(1, 0, At, B0); PG8_BAR; PG8_SCHED;
            PG8_STAGE(PG8_SB(1, 1), b3 + hstep, voffB);
            PG8_WAIT_V(6); PG8_BAR; PG8_MMA(1, 1, At, B1); PG8_BAR;
            }
        }
        if constexpr (ALIGN_EPI) { if (wr == 0) PG8_BAR; }
        if constexpr (!Epi::AFTER_DRAIN) { E(acc, cur, wr, wc, fr, fq); S.done(cur); }
        if (!has_next) break;
#pragma unroll
        for (int a = 0; a < 2; ++a)
#pragma unroll
            for (int b = 0; b < 2; ++b)
#pragma unroll
                for (int m = 0; m < 4; ++m)
#pragma unroll
                    for (int n = 0; n < 2; ++n) acc[a][b][m][n] = (f32x4){0.f, 0.f, 0.f, 0.f};
        cur = nxt; cA = nA; cB = nB; ++ui;
        if constexpr (ALIGN_EPI) { if (wr == 1) PG8_BAR; }
    }
    PG8_WAIT_V(0);
    if constexpr (!ALIGN_EPI) { if (wr == 0) PG8_BAR; }
    PG8_BAR;
    if constexpr (Epi::AFTER_DRAIN) { E.fused(acc, cur, wr, wc, fr, fq, lds, wid, lane); S.done(cur); }
#undef PG8_SA
#undef PG8_SB
#undef PG8_STAGE
#undef PG8_LDA
#undef PG8_LDB
#undef PG8_MMA
#undef PG8_WAIT_V
#undef PG8_WAIT_L
#undef PG8_BAR
#undef PG8_SCHED
}
}
#define XB_TMO      128
#define XB_XCNT(j)  (256  + 64 * (j))
#define XB_XSUB(j)  (1280 + 64 * (j))
#define XB_XGEN(j)  (2304 + 64 * (j))
#define XB_TOP      3328
#define XB_TOPGEN   3392
#define XCD_BAR_WORDS 3456
#define XB_SPIN_CAP (1u << 18)
#define LAS __attribute__((address_space(3)))

__device__ __forceinline__ unsigned xb_ld(unsigned* p)              { return __hip_atomic_load(p, __ATOMIC_RELAXED, __HIP_MEMORY_SCOPE_AGENT); }
__device__ __forceinline__ unsigned xb_add(unsigned* p, unsigned v) { return __hip_atomic_fetch_add(p, v, __ATOMIC_RELAXED, __HIP_MEMORY_SCOPE_AGENT); }
__device__ __forceinline__ unsigned xb_xcc_id() { return (unsigned)__builtin_amdgcn_s_getreg((3 << 11) | 20) & 0xFu; }
#define XB_SPIN(cond, bar) do { unsigned _sp = 0; while (cond) { __builtin_amdgcn_s_sleep(1); \
    if ((++_sp & 255u) == 0u) { if (xb_ld(&(bar)[XB_TMO])) break; if (_sp > XB_SPIN_CAP) { atomicAdd(&(bar)[XB_TMO], 1u); break; } } } } while (0)

struct XcdBarrier {
    unsigned* bar; unsigned x;
    volatile LAS unsigned* st;
};

__device__ __forceinline__ XcdBarrier xcd_barrier_post(unsigned* bar, volatile LAS unsigned* st) {
    XcdBarrier b; b.bar = bar; b.x = xb_xcc_id(); b.st = st;
    if (threadIdx.x == 0) (void)xb_add(&bar[XB_XCNT(b.x)], 1u);
    return b;
}
__device__ __forceinline__ void xcd_barrier_complete(unsigned* bar, unsigned x, unsigned& nloc, unsigned& nx) {
    const unsigned G = gridDim.x * gridDim.y * gridDim.z;
    unsigned sum, cnt, mine, sp = 0u;
    for (;;) {
        sum = 0u; cnt = 0u; mine = 0u;
#pragma unroll
        for (unsigned j = 0; j < 16; ++j) { const unsigned c = xb_ld(&bar[XB_XCNT(j)]); sum += c; cnt += (c > 0u) ? 1u : 0u; mine = (j == x) ? c : mine; }
        if (sum == G) break;
        __builtin_amdgcn_s_sleep(1);
        if ((++sp & 255u) == 0u) { if (xb_ld(&bar[XB_TMO])) break; if (sp > XB_SPIN_CAP) { atomicAdd(&bar[XB_TMO], 1u); break; } }
    }
    nloc = mine > 0u ? mine : 1u; nx = cnt > 0u ? cnt : 1u;
}

__device__ __forceinline__ void xcd_barrier(const XcdBarrier& b) {
    asm volatile("s_waitcnt vmcnt(0)" ::: "memory");
    __syncthreads();
    if (threadIdx.x == 0) {
        unsigned* bar = b.bar;
        __builtin_amdgcn_s_waitcnt(0);
        unsigned nloc = b.st[0], nx = b.st[1];
        if (nloc == 0u) { xcd_barrier_complete(bar, b.x, nloc, nx); b.st[0] = nloc; b.st[1] = nx; }
        const unsigned old = xb_add(&bar[XB_XSUB(b.x)], 1u);
        const unsigned gen = old / nloc;
        if (old + 1u == (gen + 1u) * nloc) {
            __builtin_amdgcn_fence(__ATOMIC_RELEASE, "agent");
            asm volatile("s_waitcnt vmcnt(0)" ::: "memory");
            const unsigned og = xb_add(&bar[XB_TOP], 1u);
            const unsigned tg = og / nx;
            if (og + 1u == (tg + 1u) * nx) xb_add(&bar[XB_TOPGEN], 1u);
            else XB_SPIN(xb_ld(&bar[XB_TOPGEN]) == tg, bar);
            __builtin_amdgcn_fence(__ATOMIC_ACQUIRE, "agent");
            xb_add(&bar[XB_XGEN(b.x)], 1u);
            asm volatile("s_waitcnt vmcnt(0)" ::: "memory");
        } else {
            XB_SPIN(xb_ld(&bar[XB_XGEN(b.x)]) == gen, bar);
            __builtin_amdgcn_fence(__ATOMIC_ACQUIRE, "agent");
            asm volatile("s_waitcnt vmcnt(0)" ::: "memory");
        }
    }
    __syncthreads();
}

typedef unsigned short bf16_t;
typedef short bf16x8 __attribute__((ext_vector_type(8)));
typedef float f32x4 __attribute__((ext_vector_type(4)));
typedef float f32x2 __attribute__((ext_vector_type(2)));
typedef unsigned u32x4 __attribute__((ext_vector_type(4)));
typedef unsigned u32x2 __attribute__((ext_vector_type(2)));

constexpr int NB = 8, SEQ = 4096, DM = 2048, NTOK = NB * SEQ, DFF = 5632, DIN = 6312, LDU = 6400, NMOD = 18432, NTHR = 512;
constexpr int U_HG_Q = 0, U_HG_F = 512, U_HG_I = 1024, U_HG_G = 1536;
constexpr int U_RW_R = 2048, U_RW_K = 2560, U_RW_V = 3072, U_RW_WD = 3584;
constexpr int U_ML_X = 3744, U_ML_V = 4256, U_ML_O = 4768, U_ML_I = 5280, U_ML_F = 5284;
constexpr int U_LRU_X = 5288, U_LRU_G = 5800;
constexpr int RW_IN = 1696;

enum { I_X = 0, I_C, I_GAIN, I_MODW, I_MODB, I_W1, I_W3, I_W2, I_WIN, I_WOUT, I_HGLB, I_HGNORM, I_RWMU, I_RWW0, I_RWW2, I_RWA0, I_RWA2, I_RWG2, I_RWKK, I_RWKA,
       I_RWRK, I_RWLNW, I_RWLNB, I_MLCW, I_MLCB, I_MLWQ, I_MLWK, I_MLIB, I_MLFB, I_MLNORM, I_MLSKIP, I_LRUCW, I_LRUCB, I_LRUWA, I_LRUBA, I_LRUWX, I_LRUBX,
       I_LRULAM, I_LRUNORM, I_FNORM, N_IN };

constexpr size_t WS_BAR = 0;
constexpr size_t WS_BAR_STRIDE = 16384, WS_MODP = 32 * WS_BAR_STRIDE;
constexpr size_t WS_MODF = WS_MODP + (size_t)2 * 16 * 8 * NMOD * 4;
constexpr size_t WS_LRUW = WS_MODF + (size_t)2 * 8 * NMOD * 4;
constexpr size_t WS_W = WS_LRUW + (size_t)2 * 2 * 4 * 16384 * 2;
constexpr size_t LW_W13A = 0, LW_W2A = 23068672, LW_W13B = 34603008, LW_W2B = 57671680, LW_WIN = 69206016, LW_WOUT = 82313216, LW_ELEMS = 86507520;
constexpr size_t WS_HY = WS_W + 2 * LW_ELEMS * 2;
constexpr size_t WS_U = WS_HY + (size_t)NTOK * DM * 2;
constexpr size_t WS_LRUA = WS_U + (size_t)NTOK * LDU * 2;
constexpr size_t WS_LRUB = WS_LRUA + (size_t)NTOK * 512 * 4;
constexpr size_t WS_RWW = WS_LRUB + (size_t)NTOK * 512 * 4;
constexpr size_t WS_RWA = WS_RWW + (size_t)NTOK * 512 * 4;
constexpr size_t WS_RWG = WS_RWA + (size_t)NTOK * 512 * 2;
constexpr size_t WS_END = WS_RWG + (size_t)NTOK * 512 * 2;

constexpr int LDS_BYTES = 144 * 1024;
constexpr int LDS_BARW = LDS_BYTES - 16;

struct Params { const float* in[N_IN]; float* out; unsigned char* ws; int ph_lo, ph_hi, li, pad; };
typedef const Params __attribute__((address_space(4)))* KP;
__device__ __forceinline__ KP kp_fresh() { KP p = (KP)__builtin_amdgcn_kernarg_segment_ptr(); asm volatile("" : "+s"(p)); return p; }

__device__ __forceinline__ float bflo(unsigned w) { return __uint_as_float(w << 16); }
__device__ __forceinline__ float bfhi(unsigned w) { return __uint_as_float(w & 0xffff0000u); }
__device__ __forceinline__ float bf2f(bf16_t h) { return __uint_as_float(((unsigned)h) << 16); }
__device__ __forceinline__ unsigned pk_bf16(float lo, float hi) { unsigned r; asm("v_cvt_pk_bf16_f32 %0, %1, %2" : "=v"(r) : "v"(lo), "v"(hi)); return r; }
__device__ __forceinline__ void unpack8(const u32x4 w, float (&f)[8]) { f[0] = bflo(w.x); f[1] = bfhi(w.x); f[2] = bflo(w.y); f[3] = bfhi(w.y); f[4] = bflo(w.z); f[5] = bfhi(w.z); f[6] = bflo(w.w); f[7] = bfhi(w.w); }
__device__ __forceinline__ u32x4 pack8(const float (&f)[8]) { u32x4 w; w.x = pk_bf16(f[0], f[1]); w.y = pk_bf16(f[2], f[3]); w.z = pk_bf16(f[4], f[5]); w.w = pk_bf16(f[6], f[7]); return w; }
__device__ __forceinline__ float fast_rcp(float x) { return __builtin_amdgcn_rcpf(x); }
__device__ __forceinline__ float sigmoidf_(float x) { return fast_rcp(1.0f + __expf(-x)); }
__device__ __forceinline__ float siluf_(float x) { return x * sigmoidf_(x); }
__device__ __forceinline__ float softplusf_(float x) { return fmaxf(x, 0.0f) + log1pf(__expf(-fabsf(x))); }
__device__ __forceinline__ float tanhf_(float x) { const float e = __expf(2.0f * x); return 1.0f - 2.0f * fast_rcp(e + 1.0f); }
__device__ __forceinline__ float gelu_tanhf_(float x) { return 0.5f * x * (1.0f + tanhf_(0.7978845608028654f * (x + 0.044715f * x * x * x))); }
template <int CTRL> __device__ __forceinline__ float dpp_f(float x) { return __int_as_float(__builtin_amdgcn_update_dpp(0, __float_as_int(x), CTRL, 0xF, 0xF, true)); }
__device__ __forceinline__ float red8(float x) { x += dpp_f<0xB1>(x); x += dpp_f<0x4E>(x); x += dpp_f<0x141>(x); return x; }
__device__ __forceinline__ float red16(float x) { x = red8(x); x += dpp_f<0x140>(x); return x; }
__device__ __forceinline__ float red64(float x) { x = red16(x); x += __shfl_xor(x, 16); x += __shfl_xor(x, 32); return x; }

#define LDSF(off) ((LAS float*)(lds + (off)))

__device__ __forceinline__ void cvt_tile(const float* __restrict__ src, bf16_t* __restrict__ dst, int K, int N, int kt, int nt, int mode, LAS unsigned char* lds) {
    const int tid = ltid(); LAS float* tile = LDSF(0);
    const int k0 = kt * 64, n0 = nt * 64;
#pragma unroll
    for (int p = 0; p < 2; ++p) {
        const int kk = p * 32 + (tid >> 4), n4 = (tid & 15) * 4;
        f32x4 v = (f32x4){0.f, 0.f, 0.f, 0.f};
        if (n0 + n4 < N) v = *(const f32x4*)(src + (size_t)(k0 + kk) * N + n0 + n4);
        tile[kk * 65 + n4 + 0] = v[0]; tile[kk * 65 + n4 + 1] = v[1]; tile[kk * 65 + n4 + 2] = v[2]; tile[kk * 65 + n4 + 3] = v[3];
    }
    __syncthreads();
    {
        const int nn = tid >> 3, k8 = (tid & 7) * 8, n = n0 + nn;
        float f[8];
#pragma unroll
        for (int j = 0; j < 8; ++j) f[j] = tile[(k8 + j) * 65 + nn];
        const int row = (mode == 0) ? n : ((n >> 7) * 256 + ((mode == 2) ? 128 : 0) + (n & 127));
        *(u32x4*)(dst + (size_t)row * K + k0 + k8) = pack8(f);
    }
    __syncthreads();
}

__device__ __forceinline__ void phase_convert(KP P, LAS unsigned char* lds) {
    const int tid = ltid(), wg = lbid(), nwg = lgdim();
    constexpr int T_FF = 2816, T_WIN = 3200, T_WOUT = 1024, T_LAYER = 6 * T_FF + T_WIN + T_WOUT, T_BIG = 2 * T_LAYER, T_LRU = 64, T_MOD = 2 * 36 * 16;
    bf16_t* Wb = (bf16_t*)(P->ws + WS_W);
    for (int it = wg; it < T_BIG + T_LRU + T_MOD; it += nwg) {
        if (it < T_BIG) {
            const int l = it / T_LAYER; int r = it % T_LAYER;
            bf16_t* Wl = Wb + (size_t)l * LW_ELEMS;
            if (r < 6 * T_FF) {
                const int m = r / T_FF, q = r % T_FF, f = m / 3, which = m % 3;
                if (which < 2) {
                    const float* src = P->in[which == 0 ? I_W1 : I_W3] + (size_t)(l * 2 + f) * DM * DFF;
                    cvt_tile(src, Wl + (f ? LW_W13B : LW_W13A), DM, DFF, q / 88, q % 88, which + 1, lds);
                } else {
                    const float* src = P->in[I_W2] + (size_t)(l * 2 + f) * DFF * DM;
                    cvt_tile(src, Wl + (f ? LW_W2B : LW_W2A), DFF, DM, q / 32, q % 32, 0, lds);
                }
            } else if (r < 6 * T_FF + T_WIN) {
                const int q = r - 6 * T_FF;
                cvt_tile(P->in[I_WIN] + (size_t)l * DM * DIN, Wl + LW_WIN, DM, DIN, q / 100, q % 100, 0, lds);
            } else {
                const int q = r - 6 * T_FF - T_WIN;
                cvt_tile(P->in[I_WOUT] + (size_t)l * DM * DM, Wl + LW_WOUT, DM, DM, q / 32, q % 32, 0, lds);
            }
        } else if (it < T_BIG + T_LRU) {
            const int q = it - T_BIG, m16 = q >> 2, tl = q & 3, l = m16 >> 3, which = (m16 >> 2) & 1, blk = m16 & 3;
            const float* src = P->in[which ? I_LRUWX : I_LRUWA] + (size_t)(l * 4 + blk) * 16384;
            bf16_t* dst = (bf16_t*)(P->ws + WS_LRUW) + (size_t)((l * 2 + which) * 4 + blk) * 16384;
            cvt_tile(src, dst, 128, 128, tl >> 1, tl & 1, 0, lds);
        } else {
            const int m = it - T_BIG - T_LRU, l = m / 576, r = m % 576, jb = r / 16, ks = r % 16;
            LAS float* cact = LDSF(0);
#pragma unroll
            for (int e2 = 0; e2 < 2; ++e2) { const int e = tid * 2 + e2, kk = e >> 3, b = e & 7; cact[e] = siluf_(P->in[I_C][b * DM + ks * 128 + kk]); }
            __syncthreads();
            const int j = jb * 512 + tid;
            const float* wp = P->in[I_MODW] + (size_t)l * DM * NMOD + (size_t)(ks * 128) * NMOD + j;
            float acc[8];
#pragma unroll
            for (int b = 0; b < 8; ++b) acc[b] = 0.f;
#pragma unroll 8
            for (int kk = 0; kk < 128; ++kk) {
                const float w = wp[(size_t)kk * NMOD];
                const f32x4 c0 = *(const LAS f32x4*)(cact + kk * 8), c1 = *(const LAS f32x4*)(cact + kk * 8 + 4);
                acc[0] += c0[0] * w; acc[1] += c0[1] * w; acc[2] += c0[2] * w; acc[3] += c0[3] * w;
                acc[4] += c1[0] * w; acc[5] += c1[1] * w; acc[6] += c1[2] * w; acc[7] += c1[3] * w;
            }
            float* mp = (float*)(P->ws + WS_MODP) + (size_t)((l * 16 + ks) * 8) * NMOD + j;
#pragma unroll
            for (int b = 0; b < 8; ++b) mp[(size_t)b * NMOD] = acc[b];
            __syncthreads();
        }
    }
}

__device__ __forceinline__ void phase_modfinal(KP P) {
    const float* mp = (const float*)(P->ws + WS_MODP); float* mf = (float*)(P->ws + WS_MODF);
    for (int i = lbid() * NTHR + ltid(); i < 2 * 8 * NMOD; i += lgdim() * NTHR) {
        const int l = i / (8 * NMOD), r = i % (8 * NMOD), b = r / NMOD, j = r % NMOD;
        float s = P->in[I_MODB][l * NMOD + j];
#pragma unroll
        for (int ks = 0; ks < 16; ++ks) s += mp[(size_t)((l * 16 + ks) * 8 + b) * NMOD + j];
        mf[i] = s;
    }
}

__device__ __forceinline__ void phase_norm(KP P, int l, int sub, const float* __restrict__ xsrc, LAS unsigned char* lds) {
    const int tid = ltid(), lane = tid & 63, wave = tid >> 6;
    bf16_t* H = (bf16_t*)(P->ws + WS_HY);
    LAS float* cv = LDSF(0); LAS float* sv = LDSF(8192);
    for (int rb = lbid(); rb < NTOK / 128; rb += lgdim()) {
        const int b = rb >> 5;
        const float* mod = (const float*)(P->ws + WS_MODF) + (size_t)(l * 8 + b) * NMOD + sub * 6144;
        __syncthreads();
        for (int d = tid; d < DM; d += NTHR) { cv[d] = P->in[I_GAIN][(l * 3 + sub) * DM + d] * (1.0f + mod[2048 + d]); sv[d] = mod[d]; }
        __syncthreads();
        for (int rr = 0; rr < 16; ++rr) {
            const int row = rb * 128 + wave * 16 + rr;
            const float* xr = xsrc + (size_t)row * DM;
            f32x4 v[8]; float ss = 0.f;
#pragma unroll
            for (int i = 0; i < 8; ++i) { v[i] = *(const f32x4*)(xr + i * 256 + lane * 4); ss += v[i][0] * v[i][0] + v[i][1] * v[i][1] + v[i][2] * v[i][2] + v[i][3] * v[i][3]; }
            ss = red64(ss);
            const float rstd = rsqrtf(ss * (1.0f / DM) + 1e-6f);
#pragma unroll
            for (int i = 0; i < 8; ++i) {
                const int d = i * 256 + lane * 4;
                const f32x4 c = *(const LAS f32x4*)(cv + d), s = *(const LAS f32x4*)(sv + d);
                u32x2 w; w.x = pk_bf16(v[i][0] * rstd * c[0] + s[0], v[i][1] * rstd * c[1] + s[1]); w.y = pk_bf16(v[i][2] * rstd * c[2] + s[2], v[i][3] * rstd * c[3] + s[3]);
                *(u32x2*)(H + (size_t)row * DM + d) = w;
            }
        }
    }
}

__device__ __forceinline__ void phase_final_norm(KP P) {
    const int tid = ltid(), lane = tid & 63, wave = tid >> 6;
    float* X = P->out; const float* fn = P->in[I_FNORM];
    for (int row = lbid() * 8 + wave; row < NTOK; row += lgdim() * 8) {
        float* xr = X + (size_t)row * DM;
        f32x4 v[8]; float ss = 0.f;
#pragma unroll
        for (int i = 0; i < 8; ++i) { v[i] = *(const f32x4*)(xr + i * 256 + lane * 4); ss += v[i][0] * v[i][0] + v[i][1] * v[i][1] + v[i][2] * v[i][2] + v[i][3] * v[i][3]; }
        ss = red64(ss);
        const float rstd = rsqrtf(ss * (1.0f / DM) + 1e-6f);
#pragma unroll
        for (int i = 0; i < 8; ++i) { const int d = i * 256 + lane * 4; const f32x4 g = *(const f32x4*)(fn + d); *(f32x4*)(xr + d) = v[i] * rstd * g; }
    }
}

struct EpiSwiGLU {
    static constexpr bool PERM = true, AFTER_DRAIN = false;
    bf16_t* G;
    __device__ __forceinline__ void operator()(const pg8::f32x4 (&acc)[2][2][4][2], const pg8::Unit& u, int wr, int wc, int fr, int fq) const {
        const int row0 = u.pm * 256 + wr * 64 + fr, col0 = u.pn * 128 + wc * 32 + 8 * fq;
#pragma unroll
        for (int ai = 0; ai < 2; ++ai)
#pragma unroll
            for (int m = 0; m < 4; ++m) {
                float o[8];
#pragma unroll
                for (int n = 0; n < 2; ++n)
#pragma unroll
                    for (int j = 0; j < 4; ++j) { const float g = acc[ai][0][m][n][j]; o[n * 4 + j] = g * fast_rcp(1.0f + __expf(-g)) * acc[ai][1][m][n][j]; }
                *(u32x4*)(G + (size_t)(row0 + ai * 128 + m * 16) * DFF + col0) = pack8(o);
            }
    }
};
struct EpiResid {
    static constexpr bool PERM = false, AFTER_DRAIN = false;
    const float* xin; float* xout; const float* gate; float coef;
    __device__ __forceinline__ void operator()(const pg8::f32x4 (&acc)[2][2][4][2], const pg8::Unit& u, int wr, int wc, int fr, int fq) const {
        const int row0 = u.pm * 256 + wr * 64 + fr, col0 = u.pn * 256 + wc * 32 + 4 * fq, b = u.pm >> 4;
        f32x4 gv[2][2];
#pragma unroll
        for (int bj = 0; bj < 2; ++bj)
#pragma unroll
            for (int n = 0; n < 2; ++n) gv[bj][n] = (*(const f32x4*)(gate + (size_t)b * NMOD + col0 + bj * 128 + n * 16) + 1.0f) * coef;
#pragma unroll
        for (int ai = 0; ai < 2; ++ai)
#pragma unroll
            for (int m = 0; m < 4; ++m) {
                const size_t off = (size_t)(row0 + ai * 128 + m * 16) * DM + col0;
#pragma unroll
                for (int bj = 0; bj < 2; ++bj)
#pragma unroll
                    for (int n = 0; n < 2; ++n) { const f32x4 xv = *(const f32x4*)(xin + off + bj * 128 + n * 16); *(f32x4*)(xout + off + bj * 128 + n * 16) = xv + gv[bj][n] * acc[ai][bj][m][n]; }
            }
    }
};
struct EpiU {
    static constexpr bool PERM = true, AFTER_DRAIN = false;
    bf16_t* U;
    __device__ __forceinline__ void operator()(const pg8::f32x4 (&acc)[2][2][4][2], const pg8::Unit& u, int wr, int wc, int fr, int fq) const {
        const int row0 = u.pm * 256 + wr * 64 + fr, col0 = u.pn * 256 + wc * 32 + 8 * fq;
#pragma unroll
        for (int ai = 0; ai < 2; ++ai)
#pragma unroll
            for (int m = 0; m < 4; ++m)
#pragma unroll
                for (int bj = 0; bj < 2; ++bj) {
                    u32x4 w; w.x = pk_bf16(acc[ai][bj][m][0][0], acc[ai][bj][m][0][1]); w.y = pk_bf16(acc[ai][bj][m][0][2], acc[ai][bj][m][0][3]);
                    w.z = pk_bf16(acc[ai][bj][m][1][0], acc[ai][bj][m][1][1]); w.w = pk_bf16(acc[ai][bj][m][1][2], acc[ai][bj][m][1][3]);
                    *(u32x4*)(U + (size_t)(row0 + ai * 128 + m * 16) * LDU + col0 + bj * 128) = w;
                }
    }
};

__device__ __forceinline__ void p1_rw_lora(KP P, int l, LAS unsigned char* lds) {
    const int tid = ltid();
    const bf16_t* U = (const bf16_t*)(P->ws + WS_U);
    float* RWW = (float*)(P->ws + WS_RWW); bf16_t* RWA = (bf16_t*)(P->ws + WS_RWA); bf16_t* RWG = (bf16_t*)(P->ws + WS_RWG);
    LAS float* act = LDSF(0);
    const float* mu = P->in[I_RWMU] + l * RW_IN + 1536;
    const float* w2 = P->in[I_RWW2] + (size_t)l * 32 * 512 + tid;
    const float* a2 = P->in[I_RWA2] + (size_t)l * 32 * 512 + tid;
    const float* g2 = P->in[I_RWG2] + (size_t)l * 96 * 512 + tid;
    const float w0 = P->in[I_RWW0][l * 512 + tid], a0 = P->in[I_RWA0][l * 512 + tid];
    for (int it = lbid(); it < NTOK / 16; it += lgdim()) {
        const int tok0 = it * 16;
        __syncthreads();
#pragma unroll
        for (int e5 = 0; e5 < 5; ++e5) {
            const int e = tid + e5 * NTHR, tk = e / 160, j = e % 160, tok = tok0 + tk;
            const float cur = bf2f(U[(size_t)tok * LDU + U_RW_WD + j]);
            const float prv = (tok & (SEQ - 1)) ? bf2f(U[(size_t)(tok - 1) * LDU + U_RW_WD + j]) : 0.f;
            const float v = cur + (prv - cur) * mu[j];
            act[j * 16 + tk] = (j < 32) ? tanhf_(v) : ((j < 64) ? v : sigmoidf_(v));
        }
        __syncthreads();
        float aw[16], aa[16], ag[16];
#pragma unroll
        for (int t = 0; t < 16; ++t) { aw[t] = 0.f; aa[t] = 0.f; ag[t] = 0.f; }
#pragma unroll 4
        for (int j = 0; j < 32; ++j) {
            const float w = w2[(size_t)j * 512];
#pragma unroll
            for (int q = 0; q < 4; ++q) { const f32x4 x = *(const LAS f32x4*)(act + j * 16 + q * 4); aw[q * 4 + 0] += x[0] * w; aw[q * 4 + 1] += x[1] * w; aw[q * 4 + 2] += x[2] * w; aw[q * 4 + 3] += x[3] * w; }
        }
#pragma unroll 4
        for (int j = 0; j < 32; ++j) {
            const float w = a2[(size_t)j * 512];
#pragma unroll
            for (int q = 0; q < 4; ++q) { const f32x4 x = *(const LAS f32x4*)(act + (32 + j) * 16 + q * 4); aa[q * 4 + 0] += x[0] * w; aa[q * 4 + 1] += x[1] * w; aa[q * 4 + 2] += x[2] * w; aa[q * 4 + 3] += x[3] * w; }
        }
#pragma unroll 4
        for (int j = 0; j < 96; ++j) {
            const float w = g2[(size_t)j * 512];
#pragma unroll
            for (int q = 0; q < 4; ++q) { const f32x4 x = *(const LAS f32x4*)(act + (64 + j) * 16 + q * 4); ag[q * 4 + 0] += x[0] * w; ag[q * 4 + 1] += x[1] * w; ag[q * 4 + 2] += x[2] * w; ag[q * 4 + 3] += x[3] * w; }
        }
#pragma unroll
        for (int t = 0; t < 16; ++t) {
            const size_t o = (size_t)(tok0 + t) * 512 + tid;
            const float wlog = -softplusf_(-(w0 + aw[t])) - 0.5f;
            RWW[o] = __expf(-__expf(wlog));
            RWA[o] = (bf16_t)(pk_bf16(sigmoidf_(a0 + aa[t]), 0.f) & 0xffffu);
            RWG[o] = (bf16_t)(pk_bf16(ag[t], 0.f) & 0xffffu);
        }
    }
}

__device__ __forceinline__ void p1_lru_prep(KP P, int l, LAS unsigned char* lds) {
    const int tid = ltid(), lane = tid & 63, wave = tid >> 6, wg = lbid(), nwg = lgdim();
    const bf16_t* U = (const bf16_t*)(P->ws + WS_U);
    float* LA = (float*)(P->ws + WS_LRUA); float* LB = (float*)(P->ws + WS_LRUB);
    constexpr int O_WA = 0, O_WX = 34816, O_XC = 69632, O_XF = 87040;
    const int n = wg & 3;
    __syncthreads();
    {
        const bf16_t* wa = (const bf16_t*)(P->ws + WS_LRUW) + (size_t)((l * 2 + 0) * 4 + n) * 16384;
        const bf16_t* wx = (const bf16_t*)(P->ws + WS_LRUW) + (size_t)((l * 2 + 1) * 4 + n) * 16384;
#pragma unroll
        for (int e4 = 0; e4 < 4; ++e4) {
            const int e = tid + e4 * NTHR, j = e >> 4, i8 = (e & 15) * 8;
            *(LAS u32x4*)(lds + O_WA + (j * 136 + i8) * 2) = *(const u32x4*)(wa + j * 128 + i8);
            *(LAS u32x4*)(lds + O_WX + (j * 136 + i8) * 2) = *(const u32x4*)(wx + j * 128 + i8);
        }
    }
    const int jloc = wave * 16 + (lane & 15), cg = n * 128 + jloc, fq = lane >> 4;
    const float ba = P->in[I_LRUBA][l * 512 + cg], bx = P->in[I_LRUBX][l * 512 + cg], sp8 = 8.0f * softplusf_(-P->in[I_LRULAM][l * 512 + cg]);
    const int tk = tid >> 3, c16 = (tid & 7) * 16;
    const float* cw = P->in[I_LRUCW] + l * 2048 + n * 128 + c16;
    const float* cb = P->in[I_LRUCB] + l * 512 + n * 128 + c16;
    for (int tt = wg >> 2; tt < NTOK / 64; tt += (nwg >> 2)) {
        const int tok0 = tt * 64, tok = tok0 + tk, tseq = tok & (SEQ - 1);
        float xc[16];
#pragma unroll
        for (int q = 0; q < 4; ++q) { const f32x4 c = *(const f32x4*)(cb + q * 4); xc[q * 4 + 0] = c[0]; xc[q * 4 + 1] = c[1]; xc[q * 4 + 2] = c[2]; xc[q * 4 + 3] = c[3]; }
#pragma unroll
        for (int jj = 0; jj < 4; ++jj) {
            const bool valid = (tseq - 3 + jj) >= 0;
            const bf16_t* up = U + (size_t)(valid ? tok - 3 + jj : tok) * LDU + U_LRU_X + n * 128 + c16;
            const u32x4 r0 = *(const u32x4*)up, r1 = *(const u32x4*)(up + 8);
            float x[16]; { float t0[8], t1[8]; unpack8(r0, t0); unpack8(r1, t1);
#pragma unroll
                for (int j = 0; j < 8; ++j) { x[j] = t0[j]; x[8 + j] = t1[j]; } }
            const float vf = valid ? 1.0f : 0.0f;
#pragma unroll
            for (int q = 0; q < 4; ++q) { const f32x4 w = *(const f32x4*)(cw + jj * 512 + q * 4);
                xc[q * 4 + 0] += vf * w[0] * x[q * 4 + 0]; xc[q * 4 + 1] += vf * w[1] * x[q * 4 + 1]; xc[q * 4 + 2] += vf * w[2] * x[q * 4 + 2]; xc[q * 4 + 3] += vf * w[3] * x[q * 4 + 3]; }
        }
        __syncthreads();
        {
            float a8[8], b8[8];
#pragma unroll
            for (int j = 0; j < 8; ++j) { a8[j] = xc[j]; b8[j] = xc[8 + j]; }
            *(LAS u32x4*)(lds + O_XC + (tk * 136 + c16) * 2) = pack8(a8);
            *(LAS u32x4*)(lds + O_XC + (tk * 136 + c16 + 8) * 2) = pack8(b8);
#pragma unroll
            for (int q = 0; q < 4; ++q) *(LAS f32x4*)(lds + O_XF + (tk * 132 + c16 + q * 4) * 4) = (f32x4){xc[q * 4], xc[q * 4 + 1], xc[q * 4 + 2], xc[q * 4 + 3]};
        }
        __syncthreads();
        f32x4 accA[4], accX[4];
#pragma unroll
        for (int mi = 0; mi < 4; ++mi) { accA[mi] = (f32x4){0.f, 0.f, 0.f, 0.f}; accX[mi] = (f32x4){0.f, 0.f, 0.f, 0.f}; }
#pragma unroll
        for (int kk = 0; kk < 4; ++kk) {
            const bf16x8 fa = *(const LAS bf16x8*)(lds + O_WA + (jloc * 136 + kk * 32 + fq * 8) * 2);
            const bf16x8 fx = *(const LAS bf16x8*)(lds + O_WX + (jloc * 136 + kk * 32 + fq * 8) * 2);
#pragma unroll
            for (int mi = 0; mi < 4; ++mi) {
                const bf16x8 xa = *(const LAS bf16x8*)(lds + O_XC + ((mi * 16 + (lane & 15)) * 136 + kk * 32 + fq * 8) * 2);
                accA[mi] = __builtin_amdgcn_mfma_f32_16x16x32_bf16(xa, fa, accA[mi], 0, 0, 0);
                accX[mi] = __builtin_amdgcn_mfma_f32_16x16x32_bf16(xa, fx, accX[mi], 0, 0, 0);
            }
        }
#pragma unroll
        for (int mi = 0; mi < 4; ++mi)
#pragma unroll
            for (int rg = 0; rg < 4; ++rg) {
                const int t = mi * 16 + fq * 4 + rg;
                const float xv = *(const LAS float*)(lds + O_XF + (t * 132 + jloc) * 4);
                const float r = sigmoidf_(accA[mi][rg] + ba), ig = sigmoidf_(accX[mi][rg] + bx);
                const float la = -r * sp8;
                const size_t o = (size_t)(tok0 + t) * 512 + cg;
                LA[o] = __expf(la);
                LB[o] = sqrtf(fmaxf(-expm1f(2.0f * la), 0.0f)) * (ig * xv);
            }
    }
}

__device__ __forceinline__ void p2_rw(KP P, int l, int item, LAS unsigned char* lds) {
    const int tid = ltid(), b = item >> 3, h = item & 7;
    const int kq = tid & 15, rp = tid >> 4, st = tid >> 3, sc = (tid & 7) * 8;
    const bf16_t* U = (const bf16_t*)(P->ws + WS_U);
    const float* RWW = (const float*)(P->ws + WS_RWW); const bf16_t* RWA = (const bf16_t*)(P->ws + WS_RWA); const bf16_t* RWG = (const bf16_t*)(P->ws + WS_RWG);
    bf16_t* Y = (bf16_t*)(P->ws + WS_HY);
    LAS float* F = LDSF(0);
    constexpr int CN = 0, BR = 512, KR = 576, BS = 640, MA = 1024, WR = 5120, WD = 9216, BV = 13312, KP = 17408, VV = 21504, OO = 25600;
    __syncthreads();
    {
        const int kind = tid >> 6, c = tid & 63; float v;
        if (kind < 3) v = P->in[I_RWMU][l * RW_IN + kind * 512 + h * 64 + c];
        else if (kind == 3) v = P->in[I_RWKK][l * 512 + h * 64 + c];
        else if (kind == 4) v = P->in[I_RWKA][l * 512 + h * 64 + c];
        else if (kind == 5) v = P->in[I_RWRK][l * 512 + h * 64 + c];
        else if (kind == 6) v = P->in[I_RWLNW][l * 512 + h * 64 + c];
        else v = P->in[I_RWLNB][l * 512 + h * 64 + c];
        F[CN + kind * 64 + c] = v;
    }
    __syncthreads();
    float S0[4] = {0.f, 0.f, 0.f, 0.f}, S1[4] = {0.f, 0.f, 0.f, 0.f};
    u32x4 pr_c, pk_c, pv_c, pr_p, pk_p, pv_p, pa, pg; f32x4 pw0, pw1; float pflag;
#define RW_PREFETCH(ch) do { const int tk_ = b * SEQ + (ch) * 64 + st; const bool first_ = ((ch) == 0 && st == 0); \
        const bf16_t* uc_ = U + (size_t)tk_ * LDU + h * 64 + sc; const bf16_t* up_ = first_ ? uc_ : uc_ - LDU; pflag = first_ ? 0.f : 1.f; \
        pr_c = *(const u32x4*)(uc_ + U_RW_R); pk_c = *(const u32x4*)(uc_ + U_RW_K); pv_c = *(const u32x4*)(uc_ + U_RW_V); \
        pr_p = *(const u32x4*)(up_ + U_RW_R); pk_p = *(const u32x4*)(up_ + U_RW_K); pv_p = *(const u32x4*)(up_ + U_RW_V); \
        const size_t o_ = (size_t)tk_ * 512 + h * 64 + sc; pw0 = *(const f32x4*)(RWW + o_); pw1 = *(const f32x4*)(RWW + o_ + 4); pa = *(const u32x4*)(RWA + o_); pg = *(const u32x4*)(RWG + o_); } while (0)
    RW_PREFETCH(0);
    for (int ch = 0; ch < SEQ / 64; ++ch) {
        float r[8], k[8], v[8], a[8], w[8], ma[8], bv[8], kp[8], wr[8];
        {
            float c[8], p[8], m[8];
            unpack8(pr_c, c); unpack8(pr_p, p);
#pragma unroll
            for (int j = 0; j < 8; ++j) m[j] = F[CN + 0 * 64 + sc + j];
#pragma unroll
            for (int j = 0; j < 8; ++j) r[j] = c[j] + (p[j] * pflag - c[j]) * m[j];
            unpack8(pk_c, c); unpack8(pk_p, p);
#pragma unroll
            for (int j = 0; j < 8; ++j) m[j] = F[CN + 1 * 64 + sc + j];
#pragma unroll
            for (int j = 0; j < 8; ++j) k[j] = c[j] + (p[j] * pflag - c[j]) * m[j];
            unpack8(pv_c, c); unpack8(pv_p, p);
#pragma unroll
            for (int j = 0; j < 8; ++j) m[j] = F[CN + 2 * 64 + sc + j];
#pragma unroll
            for (int j = 0; j < 8; ++j) v[j] = c[j] + (p[j] * pflag - c[j]) * m[j];
            unpack8(pa, a);
            w[0] = pw0[0]; w[1] = pw0[1]; w[2] = pw0[2]; w[3] = pw0[3]; w[4] = pw1[0]; w[5] = pw1[1]; w[6] = pw1[2]; w[7] = pw1[3];
        }
        float ss = 0.f, bsp = 0.f, brp = 0.f, krp = 0.f;
        {
            float kkv[8];
#pragma unroll
            for (int j = 0; j < 8; ++j) { kkv[j] = k[j] * F[CN + 3 * 64 + sc + j]; ss += kkv[j] * kkv[j]; }
            ss = red8(ss);
            const float inv = 1.0f / fmaxf(sqrtf(ss + 1e-12f), 1e-6f);
#pragma unroll
            for (int j = 0; j < 8; ++j) {
                const float kn = kkv[j] * inv;
                kp[j] = k[j] * (1.0f + (a[j] - 1.0f) * F[CN + 4 * 64 + sc + j]);
                ma[j] = -kn; bv[j] = kn * a[j]; wr[j] = w[j] * r[j];
                bsp += r[j] * kp[j] * F[CN + 5 * 64 + sc + j]; brp += bv[j] * r[j]; krp += kp[j] * r[j];
            }
            bsp = red8(bsp); brp = red8(brp); krp = red8(krp);
        }
        const u32x4 cur_g = pg;
        __syncthreads();
        {
            const int o = st * 64 + sc;
            *(LAS f32x4*)(F + MA + o) = (f32x4){ma[0], ma[1], ma[2], ma[3]}; *(LAS f32x4*)(F + MA + o + 4) = (f32x4){ma[4], ma[5], ma[6], ma[7]};
            *(LAS f32x4*)(F + WR + o) = (f32x4){wr[0], wr[1], wr[2], wr[3]}; *(LAS f32x4*)(F + WR + o + 4) = (f32x4){wr[4], wr[5], wr[6], wr[7]};
            *(LAS f32x4*)(F + WD + o) = (f32x4){w[0], w[1], w[2], w[3]};     *(LAS f32x4*)(F + WD + o + 4) = (f32x4){w[4], w[5], w[6], w[7]};
            *(LAS f32x4*)(F + BV + o) = (f32x4){bv[0], bv[1], bv[2], bv[3]}; *(LAS f32x4*)(F + BV + o + 4) = (f32x4){bv[4], bv[5], bv[6], bv[7]};
            *(LAS f32x4*)(F + KP + o) = (f32x4){kp[0], kp[1], kp[2], kp[3]}; *(LAS f32x4*)(F + KP + o + 4) = (f32x4){kp[4], kp[5], kp[6], kp[7]};
            *(LAS f32x4*)(F + VV + o) = (f32x4){v[0], v[1], v[2], v[3]};     *(LAS f32x4*)(F + VV + o + 4) = (f32x4){v[4], v[5], v[6], v[7]};
            if ((tid & 7) == 0) { F[BR + st] = brp; F[KR + st] = krp; F[BS + st] = bsp; }
        }
        __syncthreads();
        if (ch + 1 < SEQ / 64) RW_PREFETCH(ch + 1);
#pragma unroll 2
        for (int t = 0; t < 64; ++t) {
            const f32x4 xma = *(const LAS f32x4*)(F + MA + t * 64 + 4 * kq), xwr = *(const LAS f32x4*)(F + WR + t * 64 + 4 * kq), xwd = *(const LAS f32x4*)(F + WD + t * 64 + 4 * kq);
            const f32x4 xbv = *(const LAS f32x4*)(F + BV + t * 64 + 4 * kq), xkp = *(const LAS f32x4*)(F + KP + t * 64 + 4 * kq);
            const f32x2 vv = *(const LAS f32x2*)(F + VV + t * 64 + 2 * rp);
            const float br = F[BR + t], kr = F[KR + t];
            float p1a = S0[0] * xma[0] + S0[1] * xma[1] + S0[2] * xma[2] + S0[3] * xma[3];
            float p2a = S0[0] * xwr[0] + S0[1] * xwr[1] + S0[2] * xwr[2] + S0[3] * xwr[3];
            float p1b = S1[0] * xma[0] + S1[1] * xma[1] + S1[2] * xma[2] + S1[3] * xma[3];
            float p2b = S1[0] * xwr[0] + S1[1] * xwr[1] + S1[2] * xwr[2] + S1[3] * xwr[3];
            p1a = red16(p1a); p2a = red16(p2a); p1b = red16(p1b); p2b = red16(p2b);
            const float oa = p2a + p1a * br + vv[0] * kr, ob = p2b + p1b * br + vv[1] * kr;
#pragma unroll
            for (int j = 0; j < 4; ++j) { S0[j] = S0[j] * xwd[j] + (p1a * xbv[j] + vv[0] * xkp[j]); S1[j] = S1[j] * xwd[j] + (p1b * xbv[j] + vv[1] * xkp[j]); }
            if (kq == 0) *(LAS f32x2*)(F + OO + t * 64 + 2 * rp) = (f32x2){oa, ob};
        }
        __syncthreads();
        {
            const int o = st * 64 + sc; float ov[8], vv8[8], g8[8], y8[8];
            const f32x4 o0 = *(const LAS f32x4*)(F + OO + o), o1 = *(const LAS f32x4*)(F + OO + o + 4), v0 = *(const LAS f32x4*)(F + VV + o), v1 = *(const LAS f32x4*)(F + VV + o + 4);
            ov[0] = o0[0]; ov[1] = o0[1]; ov[2] = o0[2]; ov[3] = o0[3]; ov[4] = o1[0]; ov[5] = o1[1]; ov[6] = o1[2]; ov[7] = o1[3];
            vv8[0] = v0[0]; vv8[1] = v0[1]; vv8[2] = v0[2]; vv8[3] = v0[3]; vv8[4] = v1[0]; vv8[5] = v1[1]; vv8[6] = v1[2]; vv8[7] = v1[3];
            unpack8(cur_g, g8);
            float s = 0.f;
#pragma unroll
            for (int j = 0; j < 8; ++j) s += ov[j];
            const float mean = red8(s) * (1.0f / 64.0f);
            float q = 0.f;
#pragma unroll
            for (int j = 0; j < 8; ++j) { ov[j] -= mean; q += ov[j] * ov[j]; }
            const float rs = rsqrtf(red8(q) * (1.0f / 64.0f) + 64e-5f), bsv = F[BS + st];
#pragma unroll
            for (int j = 0; j < 8; ++j) y8[j] = (ov[j] * rs * F[CN + 6 * 64 + sc + j] + F[CN + 7 * 64 + sc + j] + bsv * vv8[j]) * g8[j];
            *(u32x4*)(Y + (size_t)(b * SEQ + ch * 64 + st) * DM + 512 + h * 64 + sc) = pack8(y8);
        }
    }
#undef RW_PREFETCH
}

__device__ __forceinline__ void p2_hg(KP P, int l, int item, LAS unsigned char* lds) {
    const int tid = ltid(), b = item >> 3, h = (item >> 1) & 3, vh = item & 1;
    const int kg = tid & 15, vp = tid >> 4, st = tid >> 3, c16 = tid & 7, sv = (tid & 7) * 8;
    const bf16_t* U = (const bf16_t*)(P->ws + WS_U); bf16_t* Y = (bf16_t*)(P->ws + WS_HY);
    LAS float* F = LDSF(0);
    constexpr int QK = 0, LBO = 64, FF = 256, KX = 8448, QF = 16640, VV = 24832, OO = 28928;
    __syncthreads();
    if (tid < 128) { float lb = 0.f; if (l == 1) lb = sigmoidf_(P->in[I_HGLB][512 + h * 128 + tid] - P->in[I_HGLB][h * 128 + tid]); F[LBO + tid] = lb; }
    __syncthreads();
    float S0[8], S1[8];
#pragma unroll
    for (int j = 0; j < 8; ++j) { S0[j] = 0.f; S1[j] = 0.f; }
    u32x4 pq0, pq1, pf0, pf1, pv;
#define HG_PREFETCH(ch) do { const bf16_t* ur_ = U + (size_t)(b * SEQ + (ch) * 64 + st) * LDU + h * 128; \
        pq0 = *(const u32x4*)(ur_ + U_HG_Q + c16 * 16); pq1 = *(const u32x4*)(ur_ + U_HG_Q + c16 * 16 + 8); pf0 = *(const u32x4*)(ur_ + U_HG_F + c16 * 16); pf1 = *(const u32x4*)(ur_ + U_HG_F + c16 * 16 + 8); \
        pv = *(const u32x4*)(ur_ + U_HG_I + vh * 64 + sv); } while (0)
    HG_PREFETCH(0);
    for (int ch = 0; ch < SEQ / 64; ++ch) {
        float fo[16], kx[16], qf[16], vv8[8]; float qkp = 0.f;
        {
            float q[16], z[16];
            { float t0[8], t1[8]; unpack8(pq0, t0); unpack8(pq1, t1);
#pragma unroll
              for (int j = 0; j < 8; ++j) { q[j] = t0[j]; q[8 + j] = t1[j]; }
              unpack8(pf0, t0); unpack8(pf1, t1);
#pragma unroll
              for (int j = 0; j < 8; ++j) { z[j] = t0[j]; z[8 + j] = t1[j]; } }
            unpack8(pv, vv8);
#pragma unroll
            for (int j = 0; j < 16; ++j) {
                const float lb = F[LBO + c16 * 16 + j], e = __expf(-z[j]), sg = fast_rcp(1.0f + e);
                fo[j] = lb + (1.0f - lb) * sg; kx[j] = (1.0f - lb) * (e * sg);
                const float qs = siluf_(q[j]); qf[j] = qs * fo[j]; qkp += qs * kx[j];
            }
            qkp = red8(qkp);
        }
        __syncthreads();
        {
#pragma unroll
            for (int m = 0; m < 4; ++m) {
                const int o = st * 128 + (m & 1) * 64 + (2 * c16 + (m >> 1)) * 4;
                *(LAS f32x4*)(F + FF + o) = (f32x4){fo[4 * m], fo[4 * m + 1], fo[4 * m + 2], fo[4 * m + 3]};
                *(LAS f32x4*)(F + KX + o) = (f32x4){kx[4 * m], kx[4 * m + 1], kx[4 * m + 2], kx[4 * m + 3]};
                *(LAS f32x4*)(F + QF + o) = (f32x4){qf[4 * m], qf[4 * m + 1], qf[4 * m + 2], qf[4 * m + 3]};
            }
            *(LAS f32x4*)(F + VV + st * 64 + sv) = (f32x4){vv8[0], vv8[1], vv8[2], vv8[3]}; *(LAS f32x4*)(F + VV + st * 64 + sv + 4) = (f32x4){vv8[4], vv8[5], vv8[6], vv8[7]};
            if (c16 == 0) F[QK + st] = qkp;
        }
        __syncthreads();
        if (ch + 1 < SEQ / 64) HG_PREFETCH(ch + 1);
#pragma unroll 2
        for (int t = 0; t < 64; ++t) {
            const f32x4 fa = *(const LAS f32x4*)(F + FF + t * 128 + kg * 4), fb = *(const LAS f32x4*)(F + FF + t * 128 + 64 + kg * 4);
            const f32x4 ka = *(const LAS f32x4*)(F + KX + t * 128 + kg * 4), kb = *(const LAS f32x4*)(F + KX + t * 128 + 64 + kg * 4);
            const f32x4 qa = *(const LAS f32x4*)(F + QF + t * 128 + kg * 4), qb = *(const LAS f32x4*)(F + QF + t * 128 + 64 + kg * 4);
            const f32x2 vv = *(const LAS f32x2*)(F + VV + t * 64 + 2 * vp);
            const float qk = F[QK + t];
            float pa = 0.f, pb = 0.f;
#pragma unroll
            for (int j = 0; j < 4; ++j) { pa += S0[j] * qa[j] + S0[4 + j] * qb[j]; pb += S1[j] * qa[j] + S1[4 + j] * qb[j]; }
            pa = red16(pa); pb = red16(pb);
#pragma unroll
            for (int j = 0; j < 4; ++j) {
                S0[j] = fa[j] * S0[j] + ka[j] * vv[0]; S0[4 + j] = fb[j] * S0[4 + j] + kb[j] * vv[0];
                S1[j] = fa[j] * S1[j] + ka[j] * vv[1]; S1[4 + j] = fb[j] * S1[4 + j] + kb[j] * vv[1];
            }
            if (kg == 0) *(LAS f32x2*)(F + OO + t * 64 + 2 * vp) = (f32x2){pa + vv[0] * qk, pb + vv[1] * qk};
        }
        __syncthreads();
        {
            const f32x4 o0 = *(const LAS f32x4*)(F + OO + st * 64 + sv), o1 = *(const LAS f32x4*)(F + OO + st * 64 + sv + 4);
            u32x4 w; w.x = pk_bf16(o0[0], o0[1]); w.y = pk_bf16(o0[2], o0[3]); w.z = pk_bf16(o1[0], o1[1]); w.w = pk_bf16(o1[2], o1[3]);
            *(u32x4*)(Y + (size_t)(b * SEQ + ch * 64 + st) * DM + h * 128 + vh * 64 + sv) = w;
        }
    }
#undef HG_PREFETCH
}

__device__ __forceinline__ int ml_poff(int k) { return ((k >> 2) & 1) * 64 + (k >> 3) * 4 + (k & 3); }
__device__ __forceinline__ void p2_ml(KP P, int l, int item, LAS unsigned char* lds) {
    const int tid = ltid(), lane = tid & 63, wave = tid >> 6, b = item >> 3, h = (item >> 1) & 3, vh = item & 1;
    const int kg = tid & 15, vp = tid >> 4, st = tid >> 3, c16 = tid & 7, sv = (tid & 7) * 8;
    const int blk = tid & 31, sg = tid >> 5;
    const bf16_t* U = (const bf16_t*)(P->ws + WS_U); bf16_t* Y = (bf16_t*)(P->ws + WS_HY);
    LAS float* F = LDSF(0);
    constexpr int FD = 0, IW = 64, EN = 128, QIK = 192, QFD = 2048, IK = 10240, QP = 18432, VV = 26624, OO = 30720;
    float cw[4][4], cb4[4], wq[4][4], wk[4][4];
    {
        const int cgl = h * 128 + blk * 4;
#pragma unroll
        for (int jj = 0; jj < 4; ++jj) { const f32x4 w = *(const f32x4*)(P->in[I_MLCW] + l * 2048 + jj * 512 + cgl); cw[jj][0] = w[0]; cw[jj][1] = w[1]; cw[jj][2] = w[2]; cw[jj][3] = w[3]; }
        { const f32x4 w = *(const f32x4*)(P->in[I_MLCB] + l * 512 + cgl); cb4[0] = w[0]; cb4[1] = w[1]; cb4[2] = w[2]; cb4[3] = w[3]; }
#pragma unroll
        for (int j = 0; j < 4; ++j) {
            const f32x4 a = *(const f32x4*)(P->in[I_MLWQ] + (size_t)l * 2048 + (h * 32 + blk) * 16 + j * 4), c = *(const f32x4*)(P->in[I_MLWK] + (size_t)l * 2048 + (h * 32 + blk) * 16 + j * 4);
            wq[j][0] = a[0] * 0.08838834764831845f; wq[j][1] = a[1] * 0.08838834764831845f; wq[j][2] = a[2] * 0.08838834764831845f; wq[j][3] = a[3] * 0.08838834764831845f;
            wk[j][0] = c[0]; wk[j][1] = c[1]; wk[j][2] = c[2]; wk[j][3] = c[3];
        }
    }
    const float ib = P->in[I_MLIB][l * 4 + h], fb = P->in[I_MLFB][l * 4 + h];
    float M0[8], M1[8];
#pragma unroll
    for (int j = 0; j < 8; ++j) { M0[j] = 0.f; M1[j] = 0.f; }
    float nk = 0.f;
    float mcarry = 0.f;
    u32x2 px[7]; u32x4 pv; unsigned pif;
#define ML_PREFETCH(ch) do { const int ts0_ = (ch) * 64 + sg * 4 - 3; \
        _Pragma("unroll") for (int r = 0; r < 7; ++r) { const int ts_ = ts0_ + r; \
            px[r] = *(const u32x2*)(U + (size_t)(b * SEQ + (ts_ < 0 ? 0 : ts_)) * LDU + U_ML_X + h * 128 + blk * 4); } \
        pv = *(const u32x4*)(U + (size_t)(b * SEQ + (ch) * 64 + st) * LDU + U_ML_V + h * 128 + vh * 64 + sv); \
        { const bf16_t* ug_ = U + (size_t)(b * SEQ + (ch) * 64 + lane) * LDU; pif = (unsigned)ug_[U_ML_I + h] | ((unsigned)ug_[U_ML_F + h] << 16); } } while (0)
    __syncthreads();
    ML_PREFETCH(0);
    for (int ch = 0; ch < SEQ / 64; ++ch) {
        float q[4][4], k[4][4], vv8[8];
        {
            float x[7][4];
#pragma unroll
            for (int r = 0; r < 7; ++r) { const float vf = (ch * 64 + sg * 4 - 3 + r) < 0 ? 0.f : 1.f; x[r][0] = vf * bflo(px[r].x); x[r][1] = vf * bfhi(px[r].x); x[r][2] = vf * bflo(px[r].y); x[r][3] = vf * bfhi(px[r].y); }
#pragma unroll
            for (int s = 0; s < 4; ++s) {
                float xc[4];
#pragma unroll
                for (int j = 0; j < 4; ++j) xc[j] = siluf_(cb4[j] + cw[0][j] * x[s][j] + cw[1][j] * x[s + 1][j] + cw[2][j] * x[s + 2][j] + cw[3][j] * x[s + 3][j]);
#pragma unroll
                for (int i = 0; i < 4; ++i) {
                    q[s][i] = xc[0] * wq[0][i] + xc[1] * wq[1][i] + xc[2] * wq[2][i] + xc[3] * wq[3][i];
                    k[s][i] = xc[0] * wk[0][i] + xc[1] * wk[1][i] + xc[2] * wk[2][i] + xc[3] * wk[3][i];
                }
            }
            unpack8(pv, vv8);
        }
        __syncthreads();
        if (wave == 0) {
            const float ip = bflo(pif) + ib, xf = bfhi(pif) + fb;
            const float lf = fminf(xf, 0.f) - log1pf(__expf(-fabsf(xf)));
            float bs = lf;
#pragma unroll
            for (int d = 1; d < 64; d <<= 1) { const float o = __shfl_up(bs, d); if (lane >= d) bs += o; }
            float cm = ip - bs;
#pragma unroll
            for (int d = 1; d < 64; d <<= 1) { const float o = __shfl_up(cm, d); if (lane >= d) cm = fmaxf(cm, o); }
            const float g = fmaxf(mcarry, cm), mt = bs + g;
            float gp = __shfl_up(g, 1); if (lane == 0) gp = mcarry;
            F[FD + lane] = __expf(gp - g);
            F[IW + lane] = __expf(ip - mt);
            F[EN + lane] = __expf(-mt);
            mcarry = __shfl(mt, 63);
        }
        __syncthreads();
        {
#pragma unroll
            for (int s = 0; s < 4; ++s) {
                const int t = sg * 4 + s; const float fd = F[FD + t], iw = F[IW + t];
                const f32x4 ik = (f32x4){k[s][0] * iw, k[s][1] * iw, k[s][2] * iw, k[s][3] * iw};
                float qp = q[s][0] * ik[0] + q[s][1] * ik[1] + q[s][2] * ik[2] + q[s][3] * ik[3];
                qp = red16(qp); qp += __shfl_xor(qp, 16);
                const int o = t * 128 + (blk & 1) * 64 + (blk >> 1) * 4;
                *(LAS f32x4*)(F + QFD + o) = (f32x4){q[s][0] * fd, q[s][1] * fd, q[s][2] * fd, q[s][3] * fd};
                *(LAS f32x4*)(F + IK + o) = ik;
                *(LAS f32x4*)(F + QP + t * 128 + blk * 4) = (f32x4){q[s][0], q[s][1], q[s][2], q[s][3]};
                if (blk == 0) F[QIK + t] = qp;
            }
            *(LAS f32x4*)(F + VV + st * 64 + sv) = (f32x4){vv8[0], vv8[1], vv8[2], vv8[3]}; *(LAS f32x4*)(F + VV + st * 64 + sv + 4) = (f32x4){vv8[4], vv8[5], vv8[6], vv8[7]};
        }
        __syncthreads();
        if (ch + 1 < SEQ / 64) ML_PREFETCH(ch + 1);
        if (tid < 128) {
            const int po = ml_poff(tid);
#pragma unroll 4
            for (int t = 0; t < 64; ++t) { nk = F[FD + t] * nk + F[IK + t * 128 + po]; F[QP + t * 128 + tid] *= nk; }
        }
#pragma unroll 2
        for (int t = 0; t < 64; ++t) {
            const f32x4 qa = *(const LAS f32x4*)(F + QFD + t * 128 + kg * 4), qb = *(const LAS f32x4*)(F + QFD + t * 128 + 64 + kg * 4);
            const f32x4 ka = *(const LAS f32x4*)(F + IK + t * 128 + kg * 4), kb = *(const LAS f32x4*)(F + IK + t * 128 + 64 + kg * 4);
            const f32x2 vv = *(const LAS f32x2*)(F + VV + t * 64 + 2 * vp);
            const float fd = F[FD + t], qik = F[QIK + t];
            float pa = 0.f, pb = 0.f;
#pragma unroll
            for (int j = 0; j < 4; ++j) { pa += M0[j] * qa[j] + M0[4 + j] * qb[j]; pb += M1[j] * qa[j] + M1[4 + j] * qb[j]; }
            pa = red16(pa); pb = red16(pb);
#pragma unroll
            for (int j = 0; j < 4; ++j) {
                M0[j] = fd * M0[j] + ka[j] * vv[0]; M0[4 + j] = fd * M0[4 + j] + kb[j] * vv[0];
                M1[j] = fd * M1[j] + ka[j] * vv[1]; M1[4 + j] = fd * M1[4 + j] + kb[j] * vv[1];
            }
            if (kg == 0) *(LAS f32x2*)(F + OO + t * 64 + 2 * vp) = (f32x2){pa + vv[0] * qik, pb + vv[1] * qik};
        }
        __syncthreads();
        {
            float d = 0.f;
#pragma unroll
            for (int m = 0; m < 4; ++m) { const f32x4 x = *(const LAS f32x4*)(F + QP + st * 128 + c16 * 16 + 4 * m); d += (x[0] + x[1]) + (x[2] + x[3]); }
            d = red8(d);
            const float dinv = 1.0f / fmaxf(fabsf(d), F[EN + st]);
            const f32x4 o0 = *(const LAS f32x4*)(F + OO + st * 64 + sv), o1 = *(const LAS f32x4*)(F + OO + st * 64 + sv + 4);
            u32x4 w; w.x = pk_bf16(o0[0] * dinv, o0[1] * dinv); w.y = pk_bf16(o0[2] * dinv, o0[3] * dinv); w.z = pk_bf16(o1[0] * dinv, o1[1] * dinv); w.w = pk_bf16(o1[2] * dinv, o1[3] * dinv);
            *(u32x4*)(Y + (size_t)(b * SEQ + ch * 64 + st) * DM + 1024 + h * 128 + vh * 64 + sv) = w;
        }
    }
#undef ML_PREFETCH
}

__device__ __forceinline__ void p2_lru(KP P, int item, LAS unsigned char* lds) {
    const int tid = ltid(), lane = tid & 63, wave = tid >> 6, b = item >> 3, cgp = item & 7;
    const float* LA = (const float*)(P->ws + WS_LRUA); const float* LB = (const float*)(P->ws + WS_LRUB); bf16_t* Y = (bf16_t*)(P->ws + WS_HY);
    LAS float* F = LDSF(0);
    const size_t base = (size_t)(b * SEQ + wave * 512) * 512 + cgp * 64 + lane;
    float hh = 0.f, ap = 1.f;
#pragma unroll 8
    for (int t = 0; t < 512; ++t) { const float a = LA[base + (size_t)t * 512], x = LB[base + (size_t)t * 512]; hh = a * hh + x; ap *= a; }
    __syncthreads();
    F[wave * 64 + lane] = ap; F[512 + wave * 64 + lane] = hh;
    __syncthreads();
    float c = 0.f;
    for (int j = 0; j < wave; ++j) c = F[j * 64 + lane] * c + F[512 + j * 64 + lane];
    hh = c;
    bf16_t* yp = Y + (size_t)(b * SEQ + wave * 512) * DM + 1536 + cgp * 64 + lane;
#pragma unroll 8
    for (int t = 0; t < 512; ++t) { const float a = LA[base + (size_t)t * 512], x = LB[base + (size_t)t * 512]; hh = a * hh + x; yp[(size_t)t * DM] = (bf16_t)(pk_bf16(hh, 0.f) & 0xffffu); }
}

__device__ __forceinline__ void phase_p3(KP P, int l) {
    const int tid = ltid(), lane = tid & 63, wave = tid >> 6, c0 = lane * 8;
    const bf16_t* U = (const bf16_t*)(P->ws + WS_U); bf16_t* Y = (bf16_t*)(P->ws + WS_HY);
    float hgn[8], mln[8], msk[8], mcb[8], lrn[8];
#pragma unroll
    for (int j = 0; j < 8; ++j) { hgn[j] = P->in[I_HGNORM][l * 512 + c0 + j]; mln[j] = P->in[I_MLNORM][l * 512 + c0 + j]; msk[j] = P->in[I_MLSKIP][l * 512 + c0 + j]; mcb[j] = P->in[I_MLCB][l * 512 + c0 + j]; lrn[j] = P->in[I_LRUNORM][l * 512 + c0 + j]; }
    const float* mcw = P->in[I_MLCW] + l * 2048 + c0;
    for (int tok = lbid() * 8 + wave; tok < NTOK; tok += lgdim() * 8) {
        bf16_t* yr = Y + (size_t)tok * DM; const bf16_t* ur = U + (size_t)tok * LDU; const int tseq = tok & (SEQ - 1);
        {
            float o[8], g[8], y8[8]; unpack8(*(const u32x4*)(yr + c0), o); unpack8(*(const u32x4*)(ur + U_HG_G + c0), g);
            float ss = 0.f;
#pragma unroll
            for (int j = 0; j < 8; ++j) ss += o[j] * o[j];
            const float rs = rsqrtf(red16(ss) * (1.0f / 128.0f) + 1e-6f);
#pragma unroll
            for (int j = 0; j < 8; ++j) y8[j] = o[j] * rs * hgn[j] * siluf_(g[j]);
            *(u32x4*)(yr + c0) = pack8(y8);
        }
        {
            float hv[8], og[8], y8[8], xc[8]; unpack8(*(const u32x4*)(yr + 1024 + c0), hv); unpack8(*(const u32x4*)(ur + U_ML_O + c0), og);
#pragma unroll
            for (int j = 0; j < 8; ++j) xc[j] = mcb[j];
#pragma unroll
            for (int jj = 0; jj < 4; ++jj) {
                const bool valid = (tseq - 3 + jj) >= 0; const float vf = valid ? 1.f : 0.f;
                float x[8]; unpack8(*(const u32x4*)(U + (size_t)(valid ? tok - 3 + jj : tok) * LDU + U_ML_X + c0), x);
                const f32x4 w0 = *(const f32x4*)(mcw + jj * 512), w1 = *(const f32x4*)(mcw + jj * 512 + 4);
                xc[0] += vf * w0[0] * x[0]; xc[1] += vf * w0[1] * x[1]; xc[2] += vf * w0[2] * x[2]; xc[3] += vf * w0[3] * x[3];
                xc[4] += vf * w1[0] * x[4]; xc[5] += vf * w1[1] * x[5]; xc[6] += vf * w1[2] * x[6]; xc[7] += vf * w1[3] * x[7];
            }
            float ss = 0.f;
#pragma unroll
            for (int j = 0; j < 8; ++j) { hv[j] *= sigmoidf_(og[j]); ss += hv[j] * hv[j]; }
            const float rs = rsqrtf(red16(ss) * (1.0f / 128.0f) + 1e-6f);
#pragma unroll
            for (int j = 0; j < 8; ++j) y8[j] = hv[j] * rs * mln[j] + msk[j] * siluf_(xc[j]);
            *(u32x4*)(yr + 1024 + c0) = pack8(y8);
        }
        {
            float hv[8], gb[8], y8[8]; unpack8(*(const u32x4*)(yr + 1536 + c0), hv); unpack8(*(const u32x4*)(ur + U_LRU_G + c0), gb);
            float ss = 0.f;
#pragma unroll
            for (int j = 0; j < 8; ++j) { hv[j] *= gelu_tanhf_(gb[j]); ss += hv[j] * hv[j]; }
            const float rs = rsqrtf(red64(ss) * (1.0f / 512.0f) + 1e-6f);
#pragma unroll
            for (int j = 0; j < 8; ++j) y8[j] = hv[j] * rs * lrn[j];
            *(u32x4*)(yr + 1536 + c0) = pack8(y8);
        }
    }
}

#ifndef MK_ONE_LAUNCH
#define MK_ONE_LAUNCH 1
#endif
#ifndef MK_DEBUG_BAR
#define MK_DEBUG_BAR 0
#endif
#ifndef MK_FUSE_MASK
#define MK_FUSE_MASK 0x3FFFFFFull
#endif
#ifndef MK_SEAM_DELAY
#define MK_SEAM_DELAY 0
#endif
#ifndef MK_KIND_MASK
#define MK_KIND_MASK 0x40
#endif
#ifndef MK_P1_SPLIT
#define MK_P1_SPLIT 0
#endif
#ifndef MK_SIMPLE_BAR
#define MK_SIMPLE_BAR 0
#endif
__device__ __forceinline__ void simple_barrier(unsigned* bar, unsigned& epoch) {
    asm volatile("s_waitcnt vmcnt(0)" ::: "memory");
    __syncthreads();
    if (threadIdx.x == 0) {
        __builtin_amdgcn_fence(__ATOMIC_RELEASE, "agent");
        asm volatile("s_waitcnt vmcnt(0)" ::: "memory");
        (void)xb_add(&bar[XB_TOP], 1u);
        const unsigned target = (epoch + 1u) * gridDim.x;
        XB_SPIN(xb_ld(&bar[XB_TOP]) < target, bar);
        __builtin_amdgcn_fence(__ATOMIC_ACQUIRE, "agent");
        asm volatile("s_waitcnt vmcnt(0)" ::: "memory");
    }
    ++epoch;
    __syncthreads();
}
enum { K_CONVERT = 0, K_MODFINAL, K_NORM, K_UP, K_DOWN, K_WIN, K_P1, K_P2, K_P3, K_WOUT, K_FINAL };
template <int KIND> __device__ __forceinline__ void run_phase(int l_, int sub_, LAS unsigned char* lds) {
    const int l = lsgpr(l_), sub = lsgpr(sub_);
    const KP P = kp_fresh();
    const float* modf = (const float*)(P->ws + WS_MODF);
    bf16_t* HY = (bf16_t*)(P->ws + WS_HY); bf16_t* UU = (bf16_t*)(P->ws + WS_U);
    const bf16_t* Wl = (const bf16_t*)(P->ws + WS_W) + (size_t)l * LW_ELEMS;
    const float* xcur = (l == 0 && sub == 0) ? P->in[I_X] : P->out;
    const int f = sub >> 1;
    if constexpr (KIND == K_CONVERT) phase_convert(P, lds);
    if constexpr (KIND == K_MODFINAL) phase_modfinal(P);
    if constexpr (KIND == K_NORM) phase_norm(P, l, sub, xcur, lds);
    if constexpr (KIND == K_UP) {
        pg8::Gemm g{HY, Wl + (f ? LW_W13B : LW_W13A), NTOK, 2 * DFF, DM}; pg8::StaticOrder S; S.init(NTOK, 2 * DFF, lgdim(), lbid());
        EpiSwiGLU E{UU};
        pg8::gemm_phase<EpiSwiGLU, pg8::StaticOrder, true, true>(lds, g, S, E);
    }
    if constexpr (KIND == K_DOWN) {
        pg8::Gemm g{UU, Wl + (f ? LW_W2B : LW_W2A), NTOK, DM, DFF}; pg8::StaticOrder S; S.init(NTOK, DM, lgdim(), lbid());
        EpiResid E{xcur, P->out, modf + (size_t)l * 8 * NMOD + sub * 6144 + 4096, 0.5f};
        pg8::gemm_phase<EpiResid, pg8::StaticOrder, true, true>(lds, g, S, E);
    }
    if constexpr (KIND == K_WIN) {
        pg8::Gemm g{HY, Wl + LW_WIN, NTOK, LDU, DM}; pg8::StaticOrder S; S.init(NTOK, LDU, lgdim(), lbid());
        EpiU E{UU};
        pg8::gemm_phase<EpiU, pg8::StaticOrder, true, true>(lds, g, S, E);
    }
    if constexpr (KIND == K_P1) { const int part = P->pad; if (part != 2) p1_rw_lora(P, l, lds); if (part != 1) p1_lru_prep(P, l, lds); }
    if constexpr (KIND == K_P2) {
        for (int it = lbid(); it < 256; it += lgdim()) {
            const int kind = it >> 6, sub_it = it & 63;
            if (kind == 0) p2_rw(P, l, sub_it, lds);
            else if (kind == 1) p2_hg(P, l, sub_it, lds);
            else if (kind == 2) p2_ml(P, l, sub_it, lds);
            else p2_lru(P, sub_it, lds);
        }
    }
    if constexpr (KIND == K_P3) phase_p3(P, l);
    if constexpr (KIND == K_WOUT) {
        pg8::Gemm g{HY, Wl + LW_WOUT, NTOK, DM, DM}; pg8::StaticOrder S; S.init(NTOK, DM, lgdim(), lbid());
        EpiResid E{P->out, P->out, modf + (size_t)l * 8 * NMOD + 1 * 6144 + 4096, 1.0f};
        pg8::gemm_phase<EpiResid, pg8::StaticOrder, true, true>(lds, g, S, E);
    }
    if constexpr (KIND == K_FINAL) phase_final_norm(P);
}

template <int KIND> __global__ void __launch_bounds__(NTHR, 2) k_phase(Params P_unused, int l, int sub) {
    extern __shared__ __attribute__((aligned(16))) unsigned char lds_raw[];
    run_phase<KIND>(l, sub, (LAS unsigned char*)lds_raw);
}
constexpr int N_PHASES = 27;
__global__ void __launch_bounds__(NTHR, 2) hymba_fwd(Params P_unused) {
    extern __shared__ __attribute__((aligned(16))) unsigned char lds_raw[];
    LAS unsigned char* lds = (LAS unsigned char*)lds_raw;
    const KP P = kp_fresh();
    const int lo = P->ph_lo, hi = P->ph_hi;
    if (threadIdx.x == 0) *(LAS u32x4*)(lds + LDS_BARW) = (u32x4){0u, 0u, 0u, 0u};
    __syncthreads();
    unsigned* barw = (unsigned*)(P->ws + WS_BAR + (size_t)P->li * WS_BAR_STRIDE);
    XcdBarrier bar = xcd_barrier_post(barw, (volatile LAS unsigned*)(lds + LDS_BARW));
#define SEAM(k) do { if ((k) + 1 < hi) xcd_barrier(bar); } while (0)
#define IN(k) (lo <= (k) && (k) < hi)
#define PH(k, KIND, l, sub) do { if (IN(k)) { run_phase<KIND>(l, sub, lds); SEAM(k); } } while (0)
    PH(0, K_CONVERT, 0, 0);
    PH(1, K_MODFINAL, 0, 0);
#define LAYER(l, b) \
    PH((b) + 0, K_NORM, l, 0); PH((b) + 1, K_UP, l, 0); PH((b) + 2, K_DOWN, l, 0); \
    PH((b) + 3, K_NORM, l, 1); PH((b) + 4, K_WIN, l, 1); PH((b) + 5, K_P1, l, 1); PH((b) + 6, K_P2, l, 1); PH((b) + 7, K_P3, l, 1); PH((b) + 8, K_WOUT, l, 1); \
    PH((b) + 9, K_NORM, l, 2); PH((b) + 10, K_UP, l, 2); PH((b) + 11, K_DOWN, l, 2);
    LAYER(0, 2)
    LAYER(1, 14)
#undef LAYER
    if (IN(26)) run_phase<K_FINAL>(0, 0, lds);
    {
        unsigned bad = 0u;
        if (IN(26)) { for (int li = 0; li < 32; ++li) bad |= __hip_atomic_load((unsigned*)(P->ws + WS_BAR + (size_t)li * WS_BAR_STRIDE) + XB_TMO, __ATOMIC_RELAXED, __HIP_MEMORY_SCOPE_AGENT); }
        if (bad) { const float qn = __builtin_nanf(""); for (size_t i = (size_t)blockIdx.x * NTHR + threadIdx.x; i < (size_t)NTOK * DM; i += (size_t)gridDim.x * NTHR) P->out[i] = qn; }
    }
#undef PH
#undef IN
#undef SEAM
}

#if 1
template <int KIND> static void launch_phase(const Params& p, int l, int sub, int grid, hipStream_t stream) {
    static bool attr_set = false;
    if (!attr_set) { (void)hipFuncSetAttribute((const void*)k_phase<KIND>, hipFuncAttributeMaxDynamicSharedMemorySize, LDS_BYTES); attr_set = true; }
    hipLaunchKernelGGL(k_phase<KIND>, dim3(grid), dim3(NTHR), LDS_BYTES, stream, p, l, sub);
}
#endif
extern "C" void kernel_launch(void* const* d_in, const int* in_sizes, int n_in, void* d_out, int out_size, void* d_ws, size_t ws_size, hipStream_t stream) {
    static int grid = 0;
    if (grid == 0) {
        if (n_in != N_IN || out_size != NTOK * DM || ws_size < WS_END) { fprintf(stderr, "kernel_launch: unexpected shapes (n_in %d, out %d, ws %zu < %zu)\n", n_in, out_size, ws_size, (size_t)WS_END); grid = -1; return; }
        int dev = 0, cus = 0;
        if (hipGetDevice(&dev) != hipSuccess || hipDeviceGetAttribute(&cus, hipDeviceAttributeMultiprocessorCount, dev) != hipSuccess) { grid = -1; return; }
#if MK_ONE_LAUNCH
        int per_cu = 0;
        if (hipFuncSetAttribute((const void*)hymba_fwd, hipFuncAttributeMaxDynamicSharedMemorySize, LDS_BYTES) != hipSuccess) { fprintf(stderr, "kernel_launch: hipFuncSetAttribute failed\n"); grid = -1; return; }
        if (hipOccupancyMaxActiveBlocksPerMultiprocessor(&per_cu, (const void*)hymba_fwd, NTHR, LDS_BYTES) != hipSuccess || per_cu < 1) fprintf(stderr, "kernel_launch: occupancy query says %d\n", per_cu);
        (void)hipGetLastError();
#endif
        grid = cus;
        if (grid != 256) fprintf(stderr, "kernel_launch: %d CUs (built for 256)\n", grid);
    }
    if (grid < 0) return;
    Params p{};
    for (int i = 0; i < N_IN; ++i) p.in[i] = (const float*)d_in[i];
    p.out = (float*)d_out; p.ws = (unsigned char*)d_ws;
#if MK_ONE_LAUNCH
    (void)hipMemsetAsync((char*)d_ws + WS_BAR, 0, 32 * WS_BAR_STRIDE, stream);
    {
        int lo = 0, li = 0;
        for (int k = 0; k < N_PHASES; ++k) {
            const bool fused = (k + 1 < N_PHASES) && ((MK_FUSE_MASK >> k) & 1ull);
            if (!fused) { p.ph_lo = lo; p.ph_hi = k + 1; p.li = li++; hipLaunchKernelGGL(hymba_fwd, dim3(grid), dim3(NTHR), LDS_BYTES, stream, p); lo = k + 1; }
        }
    }
#else
    (void)hipMemsetAsync((char*)d_ws + WS_BAR, 0, 32 * WS_BAR_STRIDE, stream);
    static bool attr2 = false;
    if (!attr2) { (void)hipFuncSetAttribute((const void*)hymba_fwd, hipFuncAttributeMaxDynamicSharedMemorySize, LDS_BYTES); attr2 = true; }
    int k = 0;
#define LAUNCH(KIND, l, sub) do { if ((MK_KIND_MASK >> (KIND)) & 1) { p.ph_lo = k; p.ph_hi = k + 1; p.li = 0; hipLaunchKernelGGL(hymba_fwd, dim3(grid), dim3(NTHR), LDS_BYTES, stream, p); } \
        else { p.ph_lo = 0; p.ph_hi = 0; launch_phase<KIND>(p, l, sub, grid, stream); } ++k; } while (0)
    LAUNCH(K_CONVERT, 0, 0);
    LAUNCH(K_MODFINAL, 0, 0);
    for (int l = 0; l < 2; ++l)
        for (int sub = 0; sub < 3; ++sub) {
            LAUNCH(K_NORM, l, sub);
            if (sub != 1) { LAUNCH(K_UP, l, sub); LAUNCH(K_DOWN, l, sub); }
            else { LAUNCH(K_WIN, l, sub); {
                   if (MK_P1_SPLIT == 0) { LAUNCH(K_P1, l, sub); }
                   else { const int fa = (MK_P1_SPLIT == 1);
                       p.pad = 1; if (fa) { p.ph_lo = k; p.ph_hi = k + 1; p.li = 0; hipLaunchKernelGGL(hymba_fwd, dim3(grid), dim3(NTHR), LDS_BYTES, stream, p); } else { p.ph_lo = 0; p.ph_hi = 0; launch_phase<K_P1>(p, l, sub, grid, stream); }
                       p.pad = 2; if (!fa) { p.ph_lo = k; p.ph_hi = k + 1; p.li = 0; hipLaunchKernelGGL(hymba_fwd, dim3(grid), dim3(NTHR), LDS_BYTES, stream, p); } else { p.ph_lo = 0; p.ph_hi = 0; launch_phase<K_P1>(p, l, sub, grid, stream); }
                       p.pad = 0; ++k; } } LAUNCH(K_P2, l, sub); LAUNCH(K_P3, l, sub); LAUNCH(K_WOUT, l, sub); }
        }
    LAUNCH(K_FINAL, 0, 0);
#undef LAUNCH
#endif
}
```

```cpp
#include <hip/hip_runtime.h>
#include <cstdio>
#include <cstdint>
__device__ __forceinline__ int ltid() { int t = (int)threadIdx.x; asm volatile("" : "+v"(t)); return t; }
__device__ __forceinline__ int lbid() { int x = (int)blockIdx.x; asm volatile("" : "+s"(x)); return x; }
__device__ __forceinline__ int lgdim() { int x = (int)gridDim.x; asm volatile("" : "+s"(x)); return x; }
__device__ __forceinline__ int lsgpr(int x) { asm volatile("" : "+s"(x)); return x; }
namespace pg8 {
#define PG8_LAS __attribute__((address_space(3)))
typedef unsigned short bf16_t;
typedef short bf16x8 __attribute__((ext_vector_type(8)));
typedef float f32x4 __attribute__((ext_vector_type(4)));
typedef unsigned u32x4 __attribute__((ext_vector_type(4)));
constexpr int BM = 256, BK = 64, HALF = 128, HTB = HALF * BK * 2  , STAGE_BYTES = 8 * HTB, NXCD = 8, WGM = 8;

__host__ __device__ __forceinline__ int lds_byte(int r, int c) { const int st = (r >> 4) * 2 + (c >> 5), rr = r & 15, cc = c & 31, ob = rr * 64 + cc * 2; return st * 1024 + (ob ^ (((ob >> 9) & 1) << 5)); }
__host__ __device__ __forceinline__ void stage_rc(int b, int& R, int& C) { const int st = b / 1024, sb = b % 1024, swz = sb ^ (((sb >> 9) & 1) << 5); R = (st >> 1) * 16 + swz / 64; C = (st & 1) * 32 + (swz % 64) / 2; }
__host__ __device__ __forceinline__ int perm32(int rho) { const int n = rho >> 4, i = rho & 15; return 8 * (i >> 2) + 4 * n + (i & 3); }

struct Unit { int pm, pn; };
struct Gemm { const bf16_t* A; const bf16_t* Bt; int M, N, K; };

struct StaticOrder {
    int nM, nN, nwg, G, c, wgm;
    __host__ __device__ void init(int M, int N, int G_, int c_, int wgm_ = WGM) { nM = M / BM; nN = N / BM; nwg = nM * nN; G = G_; c = c_; wgm = wgm_; }
    __host__ __device__ bool next(int i, Unit& u) const {
        const long L = (long)i * G + c; if (L >= nwg) return false;
        int wgid = (int)L; { const int q = nwg / NXCD, r = nwg % NXCD, xcd = wgid % NXCD, off = wgid / NXCD; wgid = (xcd < r ? xcd * (q + 1) : r * (q + 1) + (xcd - r) * q) + off; }
        const int nig = wgm * nN, gid = wgid / nig, fm = gid * wgm, gsz = (nM - fm) < wgm ? (nM - fm) : wgm;
        u.pm = fm + ((wgid % nig) % gsz); u.pn = (wgid % nig) / gsz; return true;
    }
    __device__ __forceinline__ void a_ready(const Unit&) const {}
    __device__ __forceinline__ void done(const Unit&) const {}
};
template <class Epi, class Sched, bool ALIGN_EPI = false, bool SP2 = false>
__device__ __forceinline__ void gemm_phase(PG8_LAS unsigned char* lds, const Gemm g, const Sched& S, const Epi& E) {
    const int tid = ltid(), wid = __builtin_amdgcn_readfirstlane(tid >> 6), lane = tid & 63, wr = wid >> 2, wc = wid & 3, fr = lane & 15, fq = lane >> 4;
    const int K = g.K, nt = K / BK;
    unsigned voffA[2], voffB[2];
#pragma unroll
    for (int i = 0; i < 2; ++i) { int R, C; stage_rc(tid * 16 + i * 8192, R, C); const int Rb = Epi::PERM ? ((R & ~31) + perm32(R & 31)) : R;
        voffA[i] = (unsigned)(R * K + C) * 2u; voffB[i] = (unsigned)(Rb * K + C) * 2u; }
    const size_t kstep = (size_t)(BK * 2);
    const size_t hstep = (size_t)HALF * K * 2;
    const size_t tstep = 2 * hstep;
    const unsigned ldsw = (unsigned)wid * 1024u;
    const int aoff = lds_byte(wr * 64 + fr, fq * 8), boff = lds_byte(wc * 32 + fr, fq * 8);
#define PG8_SA(b, h) (((b) * 2 + (h)) * HTB)
#define PG8_SB(b, h) ((4 + (b) * 2 + (h)) * HTB)
#define PG8_STAGE(bufoff, gbase, voff) do { _Pragma("unroll") for (int _i = 0; _i < 2; ++_i) \
        __builtin_amdgcn_global_load_lds((const unsigned*)((const char*)(gbase) + (voff)[_i]), (PG8_LAS unsigned*)(lds + (bufoff) + ldsw + _i * 8192), 16, 0, 0); } while (0)
#define PG8_LDA(dst, b, h) do { _Pragma("unroll") for (int m = 0; m < 4; ++m) _Pragma("unroll") for (int k = 0; k < 2; ++k) dst[m][k] = *(const PG8_LAS bf16x8*)(lds + PG8_SA(b, h) + aoff + m * 2048 + k * 1024); } while (0)
#define PG8_LDB(dst, b, h) do { _Pragma("unroll") for (int n = 0; n < 2; ++n) _Pragma("unroll") for (int k = 0; k < 2; ++k) dst[n][k] = *(const PG8_LAS bf16x8*)(lds + PG8_SB(b, h) + boff + n * 2048 + k * 1024); } while (0)
#define PG8_MMA(ai, bj, At, Bt) do { __builtin_amdgcn_s_setprio(1); _Pragma("unroll") for (int m = 0; m < 4; ++m) _Pragma("unroll") for (int n = 0; n < 2; ++n) _Pragma("unroll") for (int k = 0; k < 2; ++k) \
        acc[ai][bj][m][n] = __builtin_amdgcn_mfma_f32_16x16x32_bf16(Bt[n][k], At[m][k], acc[ai][bj][m][n], 0, 0, 0); __builtin_amdgcn_s_setprio(0); } while (0)
#define PG8_WAIT_V(n) asm volatile("s_waitcnt vmcnt(" #n ")" ::: "memory")
#define PG8_WAIT_L(n) asm volatile("s_waitcnt lgkmcnt(" #n ")" ::: "memory")
#define PG8_BAR __builtin_amdgcn_s_barrier()
#define PG8_SCHED __builtin_amdgcn_sched_barrier(0)
    Unit cur, nxt; int ui = 0;
    if (!S.next(0, cur)) return;
    f32x4 acc[2][2][4][2];
#pragma unroll
    for (int a = 0; a < 2; ++a)
#pragma unroll
        for (int b = 0; b < 2; ++b)
#pragma unroll
            for (int m = 0; m < 4; ++m)
#pragma unroll
                for (int n = 0; n < 2; ++n) acc[a][b][m][n] = (f32x4){0.f, 0.f, 0.f, 0.f};
    bf16x8 At[4][2], B0[2][2], B1[2][2];
    const char* cA = (const char*)g.A + (size_t)cur.pm * tstep; const char* cB = (const char*)g.Bt + (size_t)cur.pn * tstep;
    S.a_ready(cur);
    if constexpr (SP2) {
        PG8_STAGE(PG8_SB(0, 0), cB, voffB); PG8_STAGE(PG8_SB(0, 1), cB + hstep, voffB); PG8_STAGE(PG8_SA(0, 0), cA, voffA); PG8_STAGE(PG8_SA(0, 1), cA + hstep, voffA);
        if (wr == 1) PG8_BAR;
        PG8_WAIT_V(2); PG8_BAR;
        PG8_STAGE(PG8_SB(1, 0), cB + kstep, voffB); PG8_STAGE(PG8_SA(1, 0), cA + kstep, voffA); PG8_STAGE(PG8_SB(1, 1), cB + hstep + kstep, voffB);
        PG8_WAIT_V(6); PG8_BAR;
    } else {
        PG8_STAGE(PG8_SB(0, 0), cB, voffB); PG8_STAGE(PG8_SA(0, 0), cA, voffA); PG8_STAGE(PG8_SB(0, 1), cB + hstep, voffB); PG8_STAGE(PG8_SA(0, 1), cA + hstep, voffA);
        if (wr == 1) PG8_BAR;
        PG8_WAIT_V(4); PG8_BAR;
        PG8_STAGE(PG8_SB(1, 0), cB + kstep, voffB); PG8_STAGE(PG8_SA(1, 0), cA + kstep, voffA); PG8_STAGE(PG8_SB(1, 1), cB + hstep + kstep, voffB);
        PG8_WAIT_V(6); PG8_BAR;
    }
    for (;;) {
        const bool has_next = S.next(ui + 1, nxt);
        const char* nA = has_next ? (const char*)g.A + (size_t)nxt.pm * tstep : cA; const char* nB = has_next ? (const char*)g.Bt + (size_t)nxt.pn * tstep : cB;
        for (int t = 0; t < nt; t += 2) {
            const bool last = (t == nt - 2);
            const char* a1 = cA + (size_t)(t + 1) * kstep;
            const char* a2 = last ? nA : cA + (size_t)(t + 2) * kstep; const char* b2 = last ? nB : cB + (size_t)(t + 2) * kstep;
            const char* a3 = a2 + kstep; const char* b3 = b2 + kstep;
            if (last && has_next) S.a_ready(nxt);
            if constexpr (SP2) {
            PG8_LDB(B0, 0, 0); PG8_LDB(B1, 0, 1); PG8_SCHED; PG8_LDA(At, 0, 0); PG8_STAGE(PG8_SA(1, 1), a1 + hstep, voffA);
            PG8_WAIT_V(8); PG8_WAIT_L(0); PG8_BAR; PG8_MMA(0, 0, At, B0); PG8_MMA(0, 1, At, B1); PG8_BAR; PG8_SCHED;
            PG8_LDA(At, 0, 1); PG8_STAGE(PG8_SB(0, 0), b2, voffB); PG8_STAGE(PG8_SB(0, 1), b2 + hstep, voffB); PG8_STAGE(PG8_SA(0, 0), a2, voffA);
            PG8_WAIT_V(8); PG8_WAIT_L(0); PG8_BAR; PG8_MMA(1, 0, At, B0); PG8_MMA(1, 1, At, B1); PG8_BAR; PG8_SCHED;
            PG8_LDB(B0, 1, 0); PG8_LDB(B1, 1, 1); PG8_SCHED; PG8_LDA(At, 1, 0); PG8_STAGE(PG8_SA(0, 1), a2 + hstep, voffA);
            PG8_WAIT_V(8); PG8_WAIT_L(0); PG8_BAR; PG8_MMA(0, 0, At, B0); PG8_MMA(0, 1, At, B1); PG8_BAR; PG8_SCHED;
            PG8_LDA(At, 1, 1); PG8_STAGE(PG8_SB(1, 0), b3, voffB); PG8_STAGE(PG8_SB(1, 1), b3 + hstep, voffB); PG8_STAGE(PG8_SA(1, 0), a3, voffA);
            PG8_WAIT_V(8); PG8_WAIT_L(0); PG8_BAR; PG8_MMA(1, 0, At, B0); PG8_MMA(1, 1, At, B1); PG8_BAR; PG8_SCHED;
            } else {
            PG8_LDB(B0, 0, 0); PG8_SCHED; PG8_LDA(At, 0, 0); PG8_STAGE(PG8_SA(1, 1), a1 + hstep, voffA);
            PG8_WAIT_L(8); PG8_BAR; PG8_WAIT_L(0); PG8_MMA(0, 0, At, B0); PG8_BAR; PG8_SCHED;
            PG8_LDB(B1, 0, 1); PG8_STAGE(PG8_SB(0, 0), b2, voffB);
            PG8_BAR; PG8_WAIT_L(0); PG8_MMA(0, 1, At, B1); PG8_BAR;
            PG8_LDA(At, 0, 1); PG8_STAGE(PG8_SA(0, 0), a2, voffA);
            PG8_BAR; PG8_WAIT_L(0); PG8_MMA(1, 0, At, B0); PG8_BAR; PG8_SCHED;
            PG8_STAGE(PG8_SB(0, 1), b2 + hstep, voffB);
            PG8_WAIT_V(6); PG8_BAR; PG8_MMA(1, 1, At, B1); PG8_BAR;
            PG8_LDB(B0, 1, 0); PG8_SCHED; PG8_LDA(At, 1, 0); PG8_STAGE(PG8_SA(0, 1), a2 + hstep, voffA);
            PG8_WAIT_L(8); PG8_BAR; PG8_WAIT_L(0); PG8_MMA(0, 0, At, B0); PG8_BAR; PG8_SCHED;
            PG8_LDB(B1, 1, 1); PG8_STAGE(PG8_SB(1, 0), b3, voffB);
            PG8_BAR; PG8_WAIT_L(0); PG8_MMA(0, 1, At, B1); PG8_BAR;
            PG8_LDA(At, 1, 1); PG8_STAGE(PG8_SA(1, 0), a3, voffA);
            PG8_BAR; PG8_WAIT_L(0); PG8_MMA(1, 0, At, B0); PG8_BAR; PG8_SCHED;
            PG8_STAGE(PG8_SB(1, 1), b3 + hstep, voffB);
            PG8_WAIT_V(6); PG8_BAR; PG8_MMA(1, 1, At, B1); PG8_BAR;
            }
        }
        if constexpr (ALIGN_EPI) { if (wr == 0) PG8_BAR; }
        if constexpr (!Epi::AFTER_DRAIN) { E(acc, cur, wr, wc, fr, fq); S.done(cur); }
        if (!has_next) break;
#pragma unroll
        for (int a = 0; a < 2; ++a)
#pragma unroll
            for (int b = 0; b < 2; ++b)
#pragma unroll
                for (int m = 0; m < 4; ++m)
#pragma unroll
                    for (int n = 0; n < 2; ++n) acc[a][b][m][n] = (f32x4){0.f, 0.f, 0.f, 0.f};
        cur = nxt; cA = nA; cB = nB; ++ui;
        if constexpr (ALIGN_EPI) { if (wr == 1) PG8_BAR; }
    }
    PG8_WAIT_V(0);
    if constexpr (!ALIGN_EPI) { if (wr == 0) PG8_BAR; }
    PG8_BAR;
    if constexpr (Epi::AFTER_DRAIN) { E.fused(acc, cur, wr, wc, fr, fq, lds, wid, lane); S.done(cur); }
#undef PG8_SA
#undef PG8_SB
#undef PG8_STAGE
#undef PG8_LDA
#undef PG8_LDB
#undef PG8_MMA
#undef PG8_WAIT_V
#undef PG8_WAIT_L
#undef PG8_BAR
#undef PG8_SCHED
}
}
#define XB_TMO      128
#define XB_XCNT(j)  (256  + 64 * (j))
#define XB_XSUB(j)  (1280 + 64 * (j))
#define XB_XGEN(j)  (2304 + 64 * (j))
#define XB_TOP      3328
#define XB_TOPGEN   3392
#define XCD_BAR_WORDS 3456
#define XB_SPIN_CAP (1u << 18)
#define LAS __attribute__((address_space(3)))

__device__ __forceinline__ unsigned xb_ld(unsigned* p)              { return __hip_atomic_load(p, __ATOMIC_RELAXED, __HIP_MEMORY_SCOPE_AGENT); }
__device__ __forceinline__ unsigned xb_add(unsigned* p, unsigned v) { return __hip_atomic_fetch_add(p, v, __ATOMIC_RELAXED, __HIP_MEMORY_SCOPE_AGENT); }
__device__ __forceinline__ unsigned xb_xcc_id() { return (unsigned)__builtin_amdgcn_s_getreg((3 << 11) | 20) & 0xFu; }
#define XB_SPIN(cond, bar) do { unsigned _sp = 0; while (cond) { __builtin_amdgcn_s_sleep(1); \
    if ((++_sp & 255u) == 0u) { if (xb_ld(&(bar)[XB_TMO])) break; if (_sp > XB_SPIN_CAP) { atomicAdd(&(bar)[XB_TMO], 1u); break; } } } } while (0)

struct XcdBarrier {
    unsigned* bar; unsigned x;
    volatile LAS unsigned* st;
};

__device__ __forceinline__ XcdBarrier xcd_barrier_post(unsigned* bar, volatile LAS unsigned* st) {
    XcdBarrier b; b.bar = bar; b.x = xb_xcc_id(); b.st = st;
    if (threadIdx.x == 0) (void)xb_add(&bar[XB_XCNT(b.x)], 1u);
    return b;
}
__device__ __forceinline__ void xcd_barrier_complete(unsigned* bar, unsigned x, unsigned& nloc, unsigned& nx) {
    const unsigned G = gridDim.x * gridDim.y * gridDim.z;
    unsigned sum, cnt, mine, sp = 0u;
    for (;;) {
        sum = 0u; cnt = 0u; mine = 0u;
#pragma unroll
        for (unsigned j = 0; j < 16; ++j) { const unsigned c = xb_ld(&bar[XB_XCNT(j)]); sum += c; cnt += (c > 0u) ? 1u : 0u; mine = (j == x) ? c : mine; }
        if (sum == G) break;
        __builtin_amdgcn_s_sleep(1);
        if ((++sp & 255u) == 0u) { if (xb_ld(&bar[XB_TMO])) break; if (sp > XB_SPIN_CAP) { atomicAdd(&bar[XB_TMO], 1u); break; } }
    }
    nloc = mine > 0u ? mine : 1u; nx = cnt > 0u ? cnt : 1u;
}

__device__ __forceinline__ void xcd_barrier(const XcdBarrier& b) {
    asm volatile("s_waitcnt vmcnt(0)" ::: "memory");
    __syncthreads();
    if (threadIdx.x == 0) {
        unsigned* bar = b.bar;
        __builtin_amdgcn_s_waitcnt(0);
        unsigned nloc = b.st[0], nx = b.st[1];
        if (nloc == 0u) { xcd_barrier_complete(bar, b.x, nloc, nx); b.st[0] = nloc; b.st[1] = nx; }
        const unsigned old = xb_add(&bar[XB_XSUB(b.x)], 1u);
        const unsigned gen = old / nloc;
        if (old + 1u == (gen + 1u) * nloc) {
            __builtin_amdgcn_fence(__ATOMIC_RELEASE, "agent");
            asm volatile("s_waitcnt vmcnt(0)" ::: "memory");
            const unsigned og = xb_add(&bar[XB_TOP], 1u);
            const unsigned tg = og / nx;
            if (og + 1u == (tg + 1u) * nx) xb_add(&bar[XB_TOPGEN], 1u);
            else XB_SPIN(xb_ld(&bar[XB_TOPGEN]) == tg, bar);
            __builtin_amdgcn_fence(__ATOMIC_ACQUIRE, "agent");
            xb_add(&bar[XB_XGEN(b.x)], 1u);
            asm volatile("s_waitcnt vmcnt(0)" ::: "memory");
        } else {
            XB_SPIN(xb_ld(&bar[XB_XGEN(b.x)]) == gen, bar);
            __builtin_amdgcn_fence(__ATOMIC_ACQUIRE, "agent");
            asm volatile("s_waitcnt vmcnt(0)" ::: "memory");
        }
    }
    __syncthreads();
}

typedef unsigned short bf16_t;
typedef short bf16x8 __attribute__((ext_vector_type(8)));
typedef float f32x4 __attribute__((ext_vector_type(4)));
typedef float f32x2 __attribute__((ext_vector_type(2)));
typedef unsigned u32x4 __attribute__((ext_vector_type(4)));
typedef unsigned u32x2 __attribute__((ext_vector_type(2)));

constexpr int NB = 8, SEQ = 4096, DM = 2048, NTOK = NB * SEQ, DFF = 5632, DIN = 6312, LDU = 6400, NMOD = 18432, NTHR = 512;
constexpr int U_HG_Q = 0, U_HG_F = 512, U_HG_I = 1024, U_HG_G = 1536;
constexpr int U_RW_R = 2048, U_RW_K = 2560, U_RW_V = 3072, U_RW_WD = 3584;
constexpr int U_ML_X = 3744, U_ML_V = 4256, U_ML_O = 4768, U_ML_I = 5280, U_ML_F = 5284;
constexpr int U_LRU_X = 5288, U_LRU_G = 5800;
constexpr int RW_IN = 1696;

enum { I_X = 0, I_C, I_GAIN, I_MODW, I_MODB, I_W1, I_W3, I_W2, I_WIN, I_WOUT, I_HGLB, I_HGNORM, I_RWMU, I_RWW0, I_RWW2, I_RWA0, I_RWA2, I_RWG2, I_RWKK, I_RWKA,
       I_RWRK, I_RWLNW, I_RWLNB, I_MLCW, I_MLCB, I_MLWQ, I_MLWK, I_MLIB, I_MLFB, I_MLNORM, I_MLSKIP, I_LRUCW, I_LRUCB, I_LRUWA, I_LRUBA, I_LRUWX, I_LRUBX,
       I_LRULAM, I_LRUNORM, I_FNORM, N_IN };

constexpr size_t WS_BAR = 0;
constexpr size_t WS_BAR_STRIDE = 16384, WS_MODP = 32 * WS_BAR_STRIDE;
constexpr size_t WS_MODF = WS_MODP + (size_t)2 * 16 * 8 * NMOD * 4;
constexpr size_t WS_LRUW = WS_MODF + (size_t)2 * 8 * NMOD * 4;
constexpr size_t WS_W = WS_LRUW + (size_t)2 * 2 * 4 * 16384 * 2;
constexpr size_t LW_W13A = 0, LW_W2A = 23068672, LW_W13B = 34603008, LW_W2B = 57671680, LW_WIN = 69206016, LW_WOUT = 82313216, LW_ELEMS = 86507520;
constexpr size_t WS_HY = WS_W + 2 * LW_ELEMS * 2;
constexpr size_t WS_U = WS_HY + (size_t)NTOK * DM * 2;
constexpr size_t WS_LRUA = WS_U + (size_t)NTOK * LDU * 2;
constexpr size_t WS_LRUB = WS_LRUA + (size_t)NTOK * 512 * 4;
constexpr size_t WS_RWW = WS_LRUB + (size_t)NTOK * 512 * 4;
constexpr size_t WS_RWA = WS_RWW + (size_t)NTOK * 512 * 4;
constexpr size_t WS_RWG = WS_RWA + (size_t)NTOK * 512 * 2;
constexpr size_t WS_LORAT = WS_RWG + (size_t)NTOK * 512 * 2;
constexpr size_t WS_END = WS_LORAT + (size_t)2 * 512 * 160 * 2;

constexpr int LDS_BYTES = 144 * 1024;
constexpr int LDS_BARW = LDS_BYTES - 16;

struct Params { const float* in[N_IN]; float* out; unsigned char* ws; int ph_lo, ph_hi, li, pad; };
typedef const Params __attribute__((address_space(4)))* KP;
__device__ __forceinline__ KP kp_fresh() { KP p = (KP)__builtin_amdgcn_kernarg_segment_ptr(); asm volatile("" : "+s"(p)); return p; }

__device__ __forceinline__ float bflo(unsigned w) { return __uint_as_float(w << 16); }
__device__ __forceinline__ float bfhi(unsigned w) { return __uint_as_float(w & 0xffff0000u); }
__device__ __forceinline__ float bf2f(bf16_t h) { return __uint_as_float(((unsigned)h) << 16); }
typedef __bf16 bf16x2n __attribute__((ext_vector_type(2)));
__device__ __forceinline__ unsigned pk_bf16(float lo, float hi) { const f32x2 v = {lo, hi}; return __builtin_bit_cast(unsigned, __builtin_convertvector(v, bf16x2n)); }
__device__ __forceinline__ void unpack8(const u32x4 w, float (&f)[8]) { f[0] = bflo(w.x); f[1] = bfhi(w.x); f[2] = bflo(w.y); f[3] = bfhi(w.y); f[4] = bflo(w.z); f[5] = bfhi(w.z); f[6] = bflo(w.w); f[7] = bfhi(w.w); }
__device__ __forceinline__ u32x4 pack8(const float (&f)[8]) { u32x4 w; w.x = pk_bf16(f[0], f[1]); w.y = pk_bf16(f[2], f[3]); w.z = pk_bf16(f[4], f[5]); w.w = pk_bf16(f[6], f[7]); return w; }
__device__ __forceinline__ float fast_rcp(float x) { return __builtin_amdgcn_rcpf(x); }
__device__ __forceinline__ float sigmoidf_(float x) { return fast_rcp(1.0f + __expf(-x)); }
__device__ __forceinline__ float siluf_(float x) { return x * sigmoidf_(x); }
__device__ __forceinline__ float softplusf_(float x) { return fmaxf(x, 0.0f) + __logf(1.0f + __expf(-fabsf(x))); }
__device__ __forceinline__ float tanhf_(float x) { const float e = __expf(2.0f * x); return 1.0f - 2.0f * fast_rcp(e + 1.0f); }
__device__ __forceinline__ float gelu_tanhf_(float x) { return 0.5f * x * (1.0f + tanhf_(0.7978845608028654f * (x + 0.044715f * x * x * x))); }
template <int CTRL> __device__ __forceinline__ float dpp_f(float x) { return __int_as_float(__builtin_amdgcn_update_dpp(0, __float_as_int(x), CTRL, 0xF, 0xF, true)); }
__device__ __forceinline__ float wave_scan_sum(float x) {
#define DPP_SC_(v, old, ctrl, rmask) __int_as_float(__builtin_amdgcn_update_dpp(__float_as_int(old), __float_as_int(v), ctrl, rmask, 0xF, false))
    x += DPP_SC_(x, 0.f, 0x111, 0xF); x += DPP_SC_(x, 0.f, 0x112, 0xF); x += DPP_SC_(x, 0.f, 0x114, 0xF); x += DPP_SC_(x, 0.f, 0x118, 0xF);
    x += DPP_SC_(x, 0.f, 0x142, 0xA); x += DPP_SC_(x, 0.f, 0x143, 0xC);
    return x;
}
__device__ __forceinline__ float wave_scan_max(float x) {
    x = fmaxf(x, DPP_SC_(x, x, 0x111, 0xF)); x = fmaxf(x, DPP_SC_(x, x, 0x112, 0xF)); x = fmaxf(x, DPP_SC_(x, x, 0x114, 0xF)); x = fmaxf(x, DPP_SC_(x, x, 0x118, 0xF));
    x = fmaxf(x, DPP_SC_(x, x, 0x142, 0xA)); x = fmaxf(x, DPP_SC_(x, x, 0x143, 0xC));
    return x;
#undef DPP_SC_
}
__device__ __forceinline__ float red8(float x) { x += dpp_f<0xB1>(x); x += dpp_f<0x4E>(x); x += dpp_f<0x141>(x); return x; }
__device__ __forceinline__ float red16(float x) { x = red8(x); x += dpp_f<0x140>(x); return x; }
__device__ __forceinline__ float red64(float x) { x = red16(x); x += __shfl_xor(x, 16); x += __shfl_xor(x, 32); return x; }


#define DPP_ADD4_(CTRL) "v_add_f32_dpp %0, %0, %0 " CTRL " row_mask:0xf bank_mask:0xf bound_ctrl:1\n\t" "v_add_f32_dpp %1, %1, %1 " CTRL " row_mask:0xf bank_mask:0xf bound_ctrl:1\n\t" \
                        "v_add_f32_dpp %2, %2, %2 " CTRL " row_mask:0xf bank_mask:0xf bound_ctrl:1\n\t" "v_add_f32_dpp %3, %3, %3 " CTRL " row_mask:0xf bank_mask:0xf bound_ctrl:1\n\t"
__device__ __forceinline__ void red16x4(float& a, float& b, float& c, float& d) {
    asm volatile("s_nop 4\n\t" DPP_ADD4_("quad_perm:[1,0,3,2]") DPP_ADD4_("quad_perm:[2,3,0,1]") DPP_ADD4_("row_half_mirror") DPP_ADD4_("row_mirror") : "+v"(a), "+v"(b), "+v"(c), "+v"(d));
}

__device__ __forceinline__ void rw1_dots(float s0, float s1, float s2, float s3, const f32x4 ma, const f32x4 wr, float& p1, float& p2) {
    asm volatile(
        "v_mul_f32 %[p1], %[s0], %[ma0]\n\t" "v_mul_f32 %[p2], %[s0], %[wr0]\n\t" "v_fmac_f32 %[p1], %[s1], %[ma1]\n\t" "v_fmac_f32 %[p2], %[s1], %[wr1]\n\t"
        "v_fmac_f32 %[p1], %[s2], %[ma2]\n\t" "v_fmac_f32 %[p2], %[s2], %[wr2]\n\t" "v_fmac_f32 %[p1], %[s3], %[ma3]\n\t" "v_fmac_f32 %[p2], %[s3], %[wr3]\n\t"
        : [p1] "=&v"(p1), [p2] "=&v"(p2)
        : [s0] "v"(s0), [s1] "v"(s1), [s2] "v"(s2), [s3] "v"(s3), [ma0] "v"(ma[0]), [ma1] "v"(ma[1]), [ma2] "v"(ma[2]), [ma3] "v"(ma[3]),
          [wr0] "v"(wr[0]), [wr1] "v"(wr[1]), [wr2] "v"(wr[2]), [wr3] "v"(wr[3]));
}
#define DPP_ADD2_(CTRL, TL) "v_add_f32_dpp %[a], %[a], %[a] " CTRL " row_mask:0xf bank_mask:0xf bound_ctrl:1\n\t" "v_add_f32_dpp %[b], %[b], %[b] " CTRL " row_mask:0xf bank_mask:0xf bound_ctrl:1\n\t" TL
__device__ __forceinline__ void rw1_reduce(float& a, float& b, float v, const f32x4 kp, float& t0, float& t1, float& t2, float& t3) {
    asm volatile("s_nop 4\n\t"
        DPP_ADD2_("quad_perm:[1,0,3,2]", "v_mul_f32 %[t0], %[v], %[kp0]\n\t") DPP_ADD2_("quad_perm:[2,3,0,1]", "v_mul_f32 %[t1], %[v], %[kp1]\n\t")
        DPP_ADD2_("row_half_mirror", "v_mul_f32 %[t2], %[v], %[kp2]\n\t") DPP_ADD2_("row_mirror", "v_mul_f32 %[t3], %[v], %[kp3]\n\t")
        : [a] "+v"(a), [b] "+v"(b), [t0] "=&v"(t0), [t1] "=&v"(t1), [t2] "=&v"(t2), [t3] "=&v"(t3)
        : [v] "v"(v), [kp0] "v"(kp[0]), [kp1] "v"(kp[1]), [kp2] "v"(kp[2]), [kp3] "v"(kp[3]));
}
__device__ __forceinline__ void rw1_update(float& s0, float& s1, float& s2, float& s3, float sa, float t0, float t1, float t2, float t3, const f32x4 wd, const f32x4 bv) {
    asm volatile(
        "v_fmac_f32 %[t0], %[sa], %[bv0]\n\t" "v_fmac_f32 %[t1], %[sa], %[bv1]\n\t" "v_fmac_f32 %[t2], %[sa], %[bv2]\n\t" "v_fmac_f32 %[t3], %[sa], %[bv3]\n\t"
        "v_fma_f32 %[s0], %[s0], %[wd0], %[t0]\n\t" "v_fma_f32 %[s1], %[s1], %[wd1], %[t1]\n\t" "v_fma_f32 %[s2], %[s2], %[wd2], %[t2]\n\t" "v_fma_f32 %[s3], %[s3], %[wd3], %[t3]\n\t"
        : [s0] "+v"(s0), [s1] "+v"(s1), [s2] "+v"(s2), [s3] "+v"(s3), [t0] "+v"(t0), [t1] "+v"(t1), [t2] "+v"(t2), [t3] "+v"(t3)
        : [sa] "v"(sa), [wd0] "v"(wd[0]), [wd1] "v"(wd[1]), [wd2] "v"(wd[2]), [wd3] "v"(wd[3]), [bv0] "v"(bv[0]), [bv1] "v"(bv[1]), [bv2] "v"(bv[2]), [bv3] "v"(bv[3]));
}

#define LDSF(off) ((LAS float*)(lds + (off)))

__device__ __forceinline__ void cvt_tile(const float* __restrict__ src, bf16_t* __restrict__ dst, int K, int N, int kt, int nt, int mode, LAS unsigned char* lds) {
    const int tid = ltid(); LAS float* tile = LDSF(0);
    const int k0 = kt * 64, n0 = nt * 64;
#pragma unroll
    for (int p = 0; p < 2; ++p) {
        const int kk = p * 32 + (tid >> 4), n4 = (tid & 15) * 4;
        f32x4 v = (f32x4){0.f, 0.f, 0.f, 0.f};
        if (n0 + n4 < N) v = *(const f32x4*)(src + (size_t)(k0 + kk) * N + n0 + n4);
        tile[kk * 65 + n4 + 0] = v[0]; tile[kk * 65 + n4 + 1] = v[1]; tile[kk * 65 + n4 + 2] = v[2]; tile[kk * 65 + n4 + 3] = v[3];
    }
    __syncthreads();
    {
        const int nn = tid >> 3, k8 = (tid & 7) * 8, n = n0 + nn;
        float f[8];
#pragma unroll
        for (int j = 0; j < 8; ++j) f[j] = tile[(k8 + j) * 65 + nn];
        const int row = (mode == 0) ? n : ((n >> 7) * 256 + ((mode == 2) ? 128 : 0) + (n & 127));
        *(u32x4*)(dst + (size_t)row * K + k0 + k8) = pack8(f);
    }
    __syncthreads();
}

constexpr int T_FF = 2816, T_WIN = 3200, T_WOUT = 1024, T_LAYER = 6 * T_FF + T_WIN + T_WOUT;
struct CvtTile { const float* src; bf16_t* dst; int K, N, kt, nt, mode; };
__device__ __forceinline__ CvtTile cvt_desc(KP P, int l, int r) {
    bf16_t* Wl = (bf16_t*)(P->ws + WS_W) + (size_t)l * LW_ELEMS;
    CvtTile t;
    if (r < 6 * T_FF) {
        const int m = r / T_FF, q = r % T_FF, f = m / 3, which = m % 3;
        if (which < 2) { t.src = P->in[which == 0 ? I_W1 : I_W3] + (size_t)(l * 2 + f) * DM * DFF; t.dst = Wl + (f ? LW_W13B : LW_W13A); t.K = DM; t.N = DFF; t.kt = q / 88; t.nt = q % 88; t.mode = which + 1; }
        else { t.src = P->in[I_W2] + (size_t)(l * 2 + f) * DFF * DM; t.dst = Wl + (f ? LW_W2B : LW_W2A); t.K = DFF; t.N = DM; t.kt = q / 32; t.nt = q % 32; t.mode = 0; }
    } else if (r < 6 * T_FF + T_WIN) {
        const int q = r - 6 * T_FF;
        t.src = P->in[I_WIN] + (size_t)l * DM * DIN; t.dst = Wl + LW_WIN; t.K = DM; t.N = DIN; t.kt = q / 100; t.nt = q % 100; t.mode = 0;
    } else {
        const int q = r - 6 * T_FF - T_WIN;
        t.src = P->in[I_WOUT] + (size_t)l * DM * DM; t.dst = Wl + LW_WOUT; t.K = DM; t.N = DM; t.kt = q / 32; t.nt = q % 32; t.mode = 0;
    }
    return t;
}
__device__ __forceinline__ void cvt_load(const CvtTile& t, f32x4 (&v)[2]) {
    const int tid = ltid(), n4 = (tid & 15) * 4;
#pragma unroll
    for (int p = 0; p < 2; ++p) {
        const int kk = p * 32 + (tid >> 4);
        v[p] = (f32x4){0.f, 0.f, 0.f, 0.f};
        if (t.nt * 64 + n4 < t.N) v[p] = *(const f32x4*)(t.src + (size_t)(t.kt * 64 + kk) * t.N + t.nt * 64 + n4);
    }
}
__device__ __forceinline__ void cvt_store(const CvtTile& t, const f32x4 (&v)[2], LAS unsigned char* lds) {
    const int tid = ltid(); LAS float* tile = LDSF(0);
#pragma unroll
    for (int p = 0; p < 2; ++p) {
        const int kk = p * 32 + (tid >> 4), n4 = (tid & 15) * 4;
        tile[kk * 65 + n4 + 0] = v[p][0]; tile[kk * 65 + n4 + 1] = v[p][1]; tile[kk * 65 + n4 + 2] = v[p][2]; tile[kk * 65 + n4 + 3] = v[p][3];
    }
    __syncthreads();
    {
        const int nn = tid >> 3, k8 = (tid & 7) * 8, n = t.nt * 64 + nn;
        float f[8];
#pragma unroll
        for (int j = 0; j < 8; ++j) f[j] = tile[(k8 + j) * 65 + nn];
        const int row = (t.mode == 0) ? n : ((n >> 7) * 256 + ((t.mode == 2) ? 128 : 0) + (n & 127));
        *(u32x4*)(t.dst + (size_t)row * t.K + t.kt * 64 + k8) = pack8(f);
    }
    __syncthreads();
}
__device__ __forceinline__ CvtTile cvt_desc_dyn(KP P, int r);
constexpr int T_EARLY = 3 * T_FF + T_WIN, T_LATE0 = 3 * T_FF + T_WOUT, T_DYN = T_LATE0 + T_LAYER;
__device__ __forceinline__ CvtTile cvt_desc_dyn(KP P, int r) {
    if (r < T_LATE0) return cvt_desc(P, 0, (r < 3 * T_FF) ? r + 3 * T_FF : r + 3 * T_FF + T_WIN);
    return cvt_desc(P, 1, r - T_LATE0);
}
__device__ __forceinline__ void convert_dynamic(KP P, LAS unsigned char* lds) {
    unsigned* ctr = (unsigned*)(P->ws + WS_BAR + (size_t)31 * WS_BAR_STRIDE);
    LAS unsigned* sh = (LAS unsigned*)(lds + 32768);
    const int tid = ltid();
    for (;;) {
        __syncthreads();
        if (tid == 0) *sh = __hip_atomic_fetch_add(ctr, 8u, __ATOMIC_RELAXED, __HIP_MEMORY_SCOPE_AGENT);
        __syncthreads();
        const int base = (int)*sh;
        if (base >= T_DYN) break;
        const int end = (base + 8 < T_DYN) ? base + 8 : T_DYN;
        CvtTile cur = cvt_desc_dyn(P, base); f32x4 v[2]; cvt_load(cur, v);
        for (int r = base; r < end; ++r) {
            CvtTile nxt = cur; f32x4 w[2] = {v[0], v[1]};
            if (r + 1 < end) { nxt = cvt_desc_dyn(P, r + 1); cvt_load(nxt, w); }
            cvt_store(cur, v, lds);
            cur = nxt; v[0] = w[0]; v[1] = w[1];
        }
    }
}
__device__ __forceinline__ void phase_convert(KP P, LAS unsigned char* lds) {
    const int tid = ltid(), wg = lbid(), nwg = lgdim();
    constexpr int T_BIG = 0, T_LRU = 64, T_MOD = 2 * 36 * 16;
    if (wg < T_EARLY) {
        CvtTile cur = cvt_desc(P, 0, (wg < 3 * T_FF) ? wg : wg + 3 * T_FF); f32x4 v[2]; cvt_load(cur, v);
        for (int r = wg; r < T_EARLY; r += nwg) {
            CvtTile nxt = cur; f32x4 w[2] = {v[0], v[1]};
            const int rn = r + nwg;
            if (rn < T_EARLY) { nxt = cvt_desc(P, 0, (rn < 3 * T_FF) ? rn : rn + 3 * T_FF); cvt_load(nxt, w); }
            cvt_store(cur, v, lds);
            cur = nxt; v[0] = w[0]; v[1] = w[1];
        }
    }
    {
        bf16_t* LT = (bf16_t*)(P->ws + WS_LORAT);
        for (int e = wg * NTHR + tid; e < 2 * 512 * 160; e += nwg * NTHR) {
            const int l = e / 81920, r = e % 81920, ch = r / 160, j = r % 160;
            const float v = (j < 32) ? P->in[I_RWW2][(size_t)(l * 32 + j) * 512 + ch] : ((j < 64) ? P->in[I_RWA2][(size_t)(l * 32 + j - 32) * 512 + ch] : P->in[I_RWG2][(size_t)(l * 96 + j - 64) * 512 + ch]);
            LT[e] = (bf16_t)(pk_bf16(v, 0.f) & 0xffffu);
        }
    }
    for (int it = wg; it < T_BIG + T_LRU + T_MOD; it += nwg) {
        if (false) {
        } else if (it < T_BIG + T_LRU) {
            const int q = it - T_BIG, m16 = q >> 2, tl = q & 3, l = m16 >> 3, which = (m16 >> 2) & 1, blk = m16 & 3;
            const float* src = P->in[which ? I_LRUWX : I_LRUWA] + (size_t)(l * 4 + blk) * 16384;
            bf16_t* dst = (bf16_t*)(P->ws + WS_LRUW) + (size_t)((l * 2 + which) * 4 + blk) * 16384;
            cvt_tile(src, dst, 128, 128, tl >> 1, tl & 1, 0, lds);
        } else {
            const int m = it - T_BIG - T_LRU, l = m / 576, r = m % 576, jb = r / 16, ks = r % 16;
            LAS float* cact = LDSF(0);
#pragma unroll
            for (int e2 = 0; e2 < 2; ++e2) { const int e = tid * 2 + e2, kk = e >> 3, b = e & 7; cact[e] = siluf_(P->in[I_C][b * DM + ks * 128 + kk]); }
            __syncthreads();
            const int j = jb * 512 + tid;
            const float* wp = P->in[I_MODW] + (size_t)l * DM * NMOD + (size_t)(ks * 128) * NMOD + j;
            float acc[8];
#pragma unroll
            for (int b = 0; b < 8; ++b) acc[b] = 0.f;
#pragma unroll 32
            for (int kk = 0; kk < 128; ++kk) {
                const float w = wp[(size_t)kk * NMOD];
                const f32x4 c0 = *(const LAS f32x4*)(cact + kk * 8), c1 = *(const LAS f32x4*)(cact + kk * 8 + 4);
                acc[0] += c0[0] * w; acc[1] += c0[1] * w; acc[2] += c0[2] * w; acc[3] += c0[3] * w;
                acc[4] += c1[0] * w; acc[5] += c1[1] * w; acc[6] += c1[2] * w; acc[7] += c1[3] * w;
            }
            float* mp = (float*)(P->ws + WS_MODP) + (size_t)((l * 16 + ks) * 8) * NMOD + j;
#pragma unroll
            for (int b = 0; b < 8; ++b) mp[(size_t)b * NMOD] = acc[b];
            __syncthreads();
        }
    }
}

__device__ __forceinline__ void phase_modfinal(KP P) {
    const float* mp = (const float*)(P->ws + WS_MODP); float* mf = (float*)(P->ws + WS_MODF);
    for (int i = lbid() * NTHR + ltid(); i < 2 * 8 * NMOD; i += lgdim() * NTHR) {
        const int l = i / (8 * NMOD), r = i % (8 * NMOD), b = r / NMOD, j = r % NMOD;
        float s = P->in[I_MODB][l * NMOD + j];
#pragma unroll
        for (int ks = 0; ks < 16; ++ks) s += mp[(size_t)((l * 16 + ks) * 8 + b) * NMOD + j];
        mf[i] = s;
    }
}

__device__ __forceinline__ void phase_norm(KP P, int l, int sub, const void* __restrict__ xsrc, int xf32, LAS unsigned char* lds) {
    const int tid = ltid(), lane = tid & 63, wave = tid >> 6;
    bf16_t* H = (bf16_t*)(P->ws + WS_HY);
    LAS float* cv = LDSF(0); LAS float* sv = LDSF(8192);
    for (int rb = lbid(); rb < NTOK / 128; rb += lgdim()) {
        const int b = rb >> 5;
        const float* mod = (const float*)(P->ws + WS_MODF) + (size_t)(l * 8 + b) * NMOD + sub * 6144;
        __syncthreads();
        for (int d = tid; d < DM; d += NTHR) { cv[d] = P->in[I_GAIN][(l * 3 + sub) * DM + d] * (1.0f + mod[2048 + d]); sv[d] = mod[d]; }
        __syncthreads();
        if (xf32) {
            for (int rr = 0; rr < 16; ++rr) {
                const int row = rb * 128 + wave * 16 + rr;
                const float* xr = (const float*)xsrc + (size_t)row * DM;
                f32x4 v[8]; float ss = 0.f;
#pragma unroll
                for (int i = 0; i < 8; ++i) { v[i] = *(const f32x4*)(xr + i * 256 + lane * 4); ss += v[i][0] * v[i][0] + v[i][1] * v[i][1] + v[i][2] * v[i][2] + v[i][3] * v[i][3]; }
                ss = red64(ss);
                const float rstd = rsqrtf(ss * (1.0f / DM) + 1e-6f);
#pragma unroll
                for (int i = 0; i < 8; ++i) {
                    const int d = i * 256 + lane * 4;
                    const f32x4 c = *(const LAS f32x4*)(cv + d), s = *(const LAS f32x4*)(sv + d);
                    u32x2 w; w.x = pk_bf16(v[i][0] * rstd * c[0] + s[0], v[i][1] * rstd * c[1] + s[1]); w.y = pk_bf16(v[i][2] * rstd * c[2] + s[2], v[i][3] * rstd * c[3] + s[3]);
                    *(u32x2*)(H + (size_t)row * DM + d) = w;
                }
            }
        } else {
            for (int rr = 0; rr < 16; ++rr) {
                const int row = rb * 128 + wave * 16 + rr;
                const bf16_t* xr = (const bf16_t*)xsrc + (size_t)row * DM;
                u32x4 xw[4]; float ss = 0.f;
#pragma unroll
                for (int i = 0; i < 4; ++i) xw[i] = *(const u32x4*)(xr + i * 512 + lane * 8);
                float v[4][8];
#pragma unroll
                for (int i = 0; i < 4; ++i) {
                    unpack8(xw[i], v[i]);
#pragma unroll
                    for (int j = 0; j < 8; ++j) ss += v[i][j] * v[i][j];
                }
                ss = red64(ss);
                const float rstd = rsqrtf(ss * (1.0f / DM) + 1e-6f);
#pragma unroll
                for (int i = 0; i < 4; ++i) {
                    const int d = i * 512 + lane * 8;
                    const f32x4 c0 = *(const LAS f32x4*)(cv + d), c1 = *(const LAS f32x4*)(cv + d + 4), s0 = *(const LAS f32x4*)(sv + d), s1 = *(const LAS f32x4*)(sv + d + 4);
                    float o[8];
#pragma unroll
                    for (int j = 0; j < 4; ++j) { o[j] = v[i][j] * rstd * c0[j] + s0[j]; o[4 + j] = v[i][4 + j] * rstd * c1[j] + s1[j]; }
                    *(u32x4*)(H + (size_t)row * DM + d) = pack8(o);
                }
            }
        }
    }
}

__device__ __forceinline__ void phase_final_norm(KP P, const bf16_t* __restrict__ X) {
    const int tid = ltid(), lane = tid & 63, wave = tid >> 6;
    const float* fn = P->in[I_FNORM];
    for (int row = lbid() * 8 + wave; row < NTOK; row += lgdim() * 8) {
        const bf16_t* xr = X + (size_t)row * DM; float* orow = P->out + (size_t)row * DM;
        u32x4 xw[4]; float ss = 0.f;
#pragma unroll
        for (int i = 0; i < 4; ++i) xw[i] = *(const u32x4*)(xr + i * 512 + lane * 8);
        float v[4][8];
#pragma unroll
        for (int i = 0; i < 4; ++i) {
            unpack8(xw[i], v[i]);
#pragma unroll
            for (int j = 0; j < 8; ++j) ss += v[i][j] * v[i][j];
        }
        ss = red64(ss);
        const float rstd = rsqrtf(ss * (1.0f / DM) + 1e-6f);
#pragma unroll
        for (int i = 0; i < 4; ++i) {
            const int d = i * 512 + lane * 8;
            const f32x4 g0 = *(const f32x4*)(fn + d), g1 = *(const f32x4*)(fn + d + 4);
            f32x4 o0, o1;
#pragma unroll
            for (int j = 0; j < 4; ++j) { o0[j] = v[i][j] * rstd * g0[j]; o1[j] = v[i][4 + j] * rstd * g1[j]; }
            *(f32x4*)(orow + d) = o0; *(f32x4*)(orow + d + 4) = o1;
        }
    }
}

struct EpiSwiGLU {
    static constexpr bool PERM = true, AFTER_DRAIN = false;
    bf16_t* G;
    __device__ __forceinline__ void operator()(const pg8::f32x4 (&acc)[2][2][4][2], const pg8::Unit& u, int wr, int wc, int fr, int fq) const {
        const int row0 = u.pm * 256 + wr * 64 + fr, col0 = u.pn * 128 + wc * 32 + 8 * fq;
#pragma unroll
        for (int ai = 0; ai < 2; ++ai)
#pragma unroll
            for (int m = 0; m < 4; ++m) {
                float o[8];
#pragma unroll
                for (int n = 0; n < 2; ++n)
#pragma unroll
                    for (int j = 0; j < 4; ++j) { const float g = acc[ai][0][m][n][j]; o[n * 4 + j] = g * fast_rcp(1.0f + __expf(-g)) * acc[ai][1][m][n][j]; }
                *(u32x4*)(G + (size_t)(row0 + ai * 128 + m * 16) * DFF + col0) = pack8(o);
            }
    }
};
struct EpiResid {
    static constexpr bool PERM = false, AFTER_DRAIN = false;
    const void* xin; bf16_t* xout; const float* gate; float coef; int xf32;
    __device__ __forceinline__ void operator()(const pg8::f32x4 (&acc)[2][2][4][2], const pg8::Unit& u, int wr, int wc, int fr, int fq) const {
        const int row0 = u.pm * 256 + wr * 64 + fr, col0 = u.pn * 256 + wc * 32 + 4 * fq, b = u.pm >> 4;
        f32x4 gv[2][2];
#pragma unroll
        for (int bj = 0; bj < 2; ++bj)
#pragma unroll
            for (int n = 0; n < 2; ++n) gv[bj][n] = (*(const f32x4*)(gate + (size_t)b * NMOD + col0 + bj * 128 + n * 16) + 1.0f) * coef;
#pragma unroll
        for (int ai = 0; ai < 2; ++ai) {
            if (xf32) {
                const float* xi = (const float*)xin;
                f32x4 xv[4][2][2];
#pragma unroll
                for (int m = 0; m < 4; ++m)
#pragma unroll
                    for (int bj = 0; bj < 2; ++bj)
#pragma unroll
                        for (int n = 0; n < 2; ++n) xv[m][bj][n] = *(const f32x4*)(xi + (size_t)(row0 + ai * 128 + m * 16) * DM + col0 + bj * 128 + n * 16);
#pragma unroll
                for (int m = 0; m < 4; ++m)
#pragma unroll
                    for (int bj = 0; bj < 2; ++bj)
#pragma unroll
                        for (int n = 0; n < 2; ++n) {
                            const f32x4 r = xv[m][bj][n] + gv[bj][n] * acc[ai][bj][m][n];
                            u32x2 w; w.x = pk_bf16(r[0], r[1]); w.y = pk_bf16(r[2], r[3]);
                            *(u32x2*)(xout + (size_t)(row0 + ai * 128 + m * 16) * DM + col0 + bj * 128 + n * 16) = w;
                        }
            } else {
                const bf16_t* xi = (const bf16_t*)xin;
                u32x2 xw[4][2][2];
#pragma unroll
                for (int m = 0; m < 4; ++m)
#pragma unroll
                    for (int bj = 0; bj < 2; ++bj)
#pragma unroll
                        for (int n = 0; n < 2; ++n) xw[m][bj][n] = *(const u32x2*)(xi + (size_t)(row0 + ai * 128 + m * 16) * DM + col0 + bj * 128 + n * 16);
#pragma unroll
                for (int m = 0; m < 4; ++m)
#pragma unroll
                    for (int bj = 0; bj < 2; ++bj)
#pragma unroll
                        for (int n = 0; n < 2; ++n) {
                            const f32x4 xv = (f32x4){bflo(xw[m][bj][n].x), bfhi(xw[m][bj][n].x), bflo(xw[m][bj][n].y), bfhi(xw[m][bj][n].y)};
                            const f32x4 r = xv + gv[bj][n] * acc[ai][bj][m][n];
                            u32x2 w; w.x = pk_bf16(r[0], r[1]); w.y = pk_bf16(r[2], r[3]);
                            *(u32x2*)(xout + (size_t)(row0 + ai * 128 + m * 16) * DM + col0 + bj * 128 + n * 16) = w;
                        }
            }
        }
    }
};
struct EpiU {
    static constexpr bool PERM = true, AFTER_DRAIN = false;
    bf16_t* U;
    __device__ __forceinline__ void operator()(const pg8::f32x4 (&acc)[2][2][4][2], const pg8::Unit& u, int wr, int wc, int fr, int fq) const {
        const int row0 = u.pm * 256 + wr * 64 + fr, col0 = u.pn * 256 + wc * 32 + 8 * fq;
#pragma unroll
        for (int ai = 0; ai < 2; ++ai)
#pragma unroll
            for (int m = 0; m < 4; ++m)
#pragma unroll
                for (int bj = 0; bj < 2; ++bj) {
                    u32x4 w; w.x = pk_bf16(acc[ai][bj][m][0][0], acc[ai][bj][m][0][1]); w.y = pk_bf16(acc[ai][bj][m][0][2], acc[ai][bj][m][0][3]);
                    w.z = pk_bf16(acc[ai][bj][m][1][0], acc[ai][bj][m][1][1]); w.w = pk_bf16(acc[ai][bj][m][1][2], acc[ai][bj][m][1][3]);
                    *(u32x4*)(U + (size_t)(row0 + ai * 128 + m * 16) * LDU + col0 + bj * 128) = w;
                }
    }
};

__device__ __forceinline__ void p1_rw_lora(KP P, int l, LAS unsigned char* lds) {
    const int tid = ltid(), lane = tid & 63, wave = tid >> 6, fq = lane >> 4, fr = lane & 15, half = lbid() & 1;
    const bf16_t* U = (const bf16_t*)(P->ws + WS_U);
    float* RWW = (float*)(P->ws + WS_RWW); bf16_t* RWA = (bf16_t*)(P->ws + WS_RWA); bf16_t* RWG = (bf16_t*)(P->ws + WS_RWG);
    constexpr int O_WT = 0, O_ACT = 256 * 168 * 2, LDW = 168;
    const float* mu = P->in[I_RWMU] + l * RW_IN + 1536;
    __syncthreads();
    {
        const bf16_t* LT = (const bf16_t*)(P->ws + WS_LORAT) + (size_t)(l * 512 + half * 256) * 160;
#pragma unroll 2
        for (int e = tid; e < 256 * 20; e += NTHR) { const int ch = e / 20, c = e % 20; *(LAS u32x4*)(lds + O_WT + (ch * LDW + c * 8) * 2) = *(const u32x4*)(LT + (size_t)ch * 160 + c * 8); }
    }
    float w0[2], a0[2];
#pragma unroll
    for (int q = 0; q < 2; ++q) { const int ch = half * 256 + (wave * 2 + q) * 16 + fr; w0[q] = P->in[I_RWW0][l * 512 + ch]; a0[q] = P->in[I_RWA0][l * 512 + ch]; }
    u32x4 pc[3], pp[3];
#define LORA_PREFETCH(tt_) do { _Pragma("unroll") for (int i = 0; i < 3; ++i) { const int e_ = tid + i * NTHR; if (e_ < 1280) { const int tk_ = e_ / 20, c_ = e_ % 20, tok_ = (tt_) * 64 + tk_; \
        const bf16_t* uc_ = U + (size_t)tok_ * LDU + U_RW_WD + c_ * 8; pc[i] = *(const u32x4*)uc_; pp[i] = *(const u32x4*)((tok_ & (SEQ - 1)) ? uc_ - LDU : uc_); } } } while (0)
    const int tstep = lgdim() >> 1;
    if ((lbid() >> 1) < NTOK / 64) LORA_PREFETCH(lbid() >> 1);
    for (int tt = lbid() >> 1; tt < NTOK / 64; tt += tstep) {
        const int tok0 = tt * 64;
        __syncthreads();
#pragma unroll
        for (int i = 0; i < 3; ++i) {
            const int e = tid + i * NTHR;
            if (e < 1280) {
                const int tk = e / 20, c = e % 20, tok = tok0 + tk;
                float cur[8], prv[8], av[8]; unpack8(pc[i], cur); unpack8(pp[i], prv);
                const float pf = (tok & (SEQ - 1)) ? 1.0f : 0.0f;
                const f32x4 m0 = *(const f32x4*)(mu + c * 8), m1 = *(const f32x4*)(mu + c * 8 + 4);
#pragma unroll
                for (int j = 0; j < 8; ++j) {
                    const float v = cur[j] + (prv[j] * pf - cur[j]) * ((j < 4) ? m0[j & 3] : m1[j & 3]);
                    av[j] = (c < 4) ? tanhf_(v) : ((c < 8) ? v : sigmoidf_(v));
                }
                *(LAS u32x4*)(lds + O_ACT + (tk * LDW + c * 8) * 2) = pack8(av);
            }
        }
        if (tt + tstep < NTOK / 64) LORA_PREFETCH(tt + tstep);
        __syncthreads();
#pragma unroll
        for (int q = 0; q < 2; ++q) {
            const int nrow = (wave * 2 + q) * 16 + fr;
            const bf16x8 bw = *(const LAS bf16x8*)(lds + O_WT + (nrow * LDW + fq * 8) * 2), ba = *(const LAS bf16x8*)(lds + O_WT + (nrow * LDW + 32 + fq * 8) * 2);
            const bf16x8 bg0 = *(const LAS bf16x8*)(lds + O_WT + (nrow * LDW + 64 + fq * 8) * 2), bg1 = *(const LAS bf16x8*)(lds + O_WT + (nrow * LDW + 96 + fq * 8) * 2), bg2 = *(const LAS bf16x8*)(lds + O_WT + (nrow * LDW + 128 + fq * 8) * 2);
            const int ch = half * 256 + (wave * 2 + q) * 16 + fr;
#pragma unroll
            for (int mi = 0; mi < 4; ++mi) {
                const int arow = mi * 16 + fr;
                const bf16x8 aw = *(const LAS bf16x8*)(lds + O_ACT + (arow * LDW + fq * 8) * 2), aa = *(const LAS bf16x8*)(lds + O_ACT + (arow * LDW + 32 + fq * 8) * 2);
                const bf16x8 ag0 = *(const LAS bf16x8*)(lds + O_ACT + (arow * LDW + 64 + fq * 8) * 2), ag1 = *(const LAS bf16x8*)(lds + O_ACT + (arow * LDW + 96 + fq * 8) * 2), ag2 = *(const LAS bf16x8*)(lds + O_ACT + (arow * LDW + 128 + fq * 8) * 2);
                const f32x4 z = (f32x4){0.f, 0.f, 0.f, 0.f};
                const f32x4 cw = __builtin_amdgcn_mfma_f32_16x16x32_bf16(aw, bw, z, 0, 0, 0);
                const f32x4 ca = __builtin_amdgcn_mfma_f32_16x16x32_bf16(aa, ba, z, 0, 0, 0);
                f32x4 cg = __builtin_amdgcn_mfma_f32_16x16x32_bf16(ag0, bg0, z, 0, 0, 0);
                cg = __builtin_amdgcn_mfma_f32_16x16x32_bf16(ag1, bg1, cg, 0, 0, 0);
                cg = __builtin_amdgcn_mfma_f32_16x16x32_bf16(ag2, bg2, cg, 0, 0, 0);
#pragma unroll
                for (int rg = 0; rg < 4; ++rg) {
                    const size_t o = (size_t)(tok0 + mi * 16 + fq * 4 + rg) * 512 + ch;
                    const float wlog = -softplusf_(-(w0[q] + cw[rg])) - 0.5f;
                    RWW[o] = __expf(-__expf(wlog));
                    RWA[o] = (bf16_t)(pk_bf16(sigmoidf_(a0[q] + ca[rg]), 0.f) & 0xffffu);
                    RWG[o] = (bf16_t)(pk_bf16(cg[rg], 0.f) & 0xffffu);
                }
            }
        }
    }
}

#undef LORA_PREFETCH
__device__ __forceinline__ void p1_lru_prep(KP P, int l, LAS unsigned char* lds) {
    const int tid = ltid(), lane = tid & 63, wave = tid >> 6, wg = lbid(), nwg = lgdim();
    const bf16_t* U = (const bf16_t*)(P->ws + WS_U);
    float* LA = (float*)(P->ws + WS_LRUA); float* LB = (float*)(P->ws + WS_LRUB);
    constexpr int O_WA = 0, O_WX = 34816, O_XC = 69632, O_XF = 87040;
    const int n = wg & 3;
    __syncthreads();
    {
        const bf16_t* wa = (const bf16_t*)(P->ws + WS_LRUW) + (size_t)((l * 2 + 0) * 4 + n) * 16384;
        const bf16_t* wx = (const bf16_t*)(P->ws + WS_LRUW) + (size_t)((l * 2 + 1) * 4 + n) * 16384;
#pragma unroll
        for (int e4 = 0; e4 < 4; ++e4) {
            const int e = tid + e4 * NTHR, j = e >> 4, i8 = (e & 15) * 8;
            *(LAS u32x4*)(lds + O_WA + (j * 136 + i8) * 2) = *(const u32x4*)(wa + j * 128 + i8);
            *(LAS u32x4*)(lds + O_WX + (j * 136 + i8) * 2) = *(const u32x4*)(wx + j * 128 + i8);
        }
    }
    const int jloc = wave * 16 + (lane & 15), cg = n * 128 + jloc, fq = lane >> 4;
    const float ba = P->in[I_LRUBA][l * 512 + cg], bx = P->in[I_LRUBX][l * 512 + cg], sp8 = 8.0f * softplusf_(-P->in[I_LRULAM][l * 512 + cg]);
    const int tk = tid >> 3, c16 = (tid & 7) * 16;
    const float* cw = P->in[I_LRUCW] + l * 2048 + n * 128 + c16;
    const float* cb = P->in[I_LRUCB] + l * 512 + n * 128 + c16;
    u32x4 pr[4][2];
#define LRU_PREFETCH(tt_) do { const int tok_ = (tt_) * 64 + tk, ts_ = tok_ & (SEQ - 1); _Pragma("unroll") for (int jj = 0; jj < 4; ++jj) { \
        const bf16_t* up_ = U + (size_t)(((ts_ - 3 + jj) >= 0) ? tok_ - 3 + jj : tok_) * LDU + U_LRU_X + n * 128 + c16; pr[jj][0] = *(const u32x4*)up_; pr[jj][1] = *(const u32x4*)(up_ + 8); } } while (0)
    const int tstep = nwg >> 2;
    if ((wg >> 2) < NTOK / 64) LRU_PREFETCH(wg >> 2);
    for (int tt = wg >> 2; tt < NTOK / 64; tt += tstep) {
        const int tok0 = tt * 64, tok = tok0 + tk, tseq = tok & (SEQ - 1);
        float xc[16];
#pragma unroll
        for (int q = 0; q < 4; ++q) { const f32x4 c = *(const f32x4*)(cb + q * 4); xc[q * 4 + 0] = c[0]; xc[q * 4 + 1] = c[1]; xc[q * 4 + 2] = c[2]; xc[q * 4 + 3] = c[3]; }
#pragma unroll
        for (int jj = 0; jj < 4; ++jj) {
            const bool valid = (tseq - 3 + jj) >= 0;
            float x[16]; { float t0[8], t1[8]; unpack8(pr[jj][0], t0); unpack8(pr[jj][1], t1);
#pragma unroll
                for (int j = 0; j < 8; ++j) { x[j] = t0[j]; x[8 + j] = t1[j]; } }
            const float vf = valid ? 1.0f : 0.0f;
#pragma unroll
            for (int q = 0; q < 4; ++q) { const f32x4 w = *(const f32x4*)(cw + jj * 512 + q * 4);
                xc[q * 4 + 0] += vf * w[0] * x[q * 4 + 0]; xc[q * 4 + 1] += vf * w[1] * x[q * 4 + 1]; xc[q * 4 + 2] += vf * w[2] * x[q * 4 + 2]; xc[q * 4 + 3] += vf * w[3] * x[q * 4 + 3]; }
        }
        __syncthreads();
        {
            float a8[8], b8[8];
#pragma unroll
            for (int j = 0; j < 8; ++j) { a8[j] = xc[j]; b8[j] = xc[8 + j]; }
            *(LAS u32x4*)(lds + O_XC + (tk * 136 + c16) * 2) = pack8(a8);
            *(LAS u32x4*)(lds + O_XC + (tk * 136 + c16 + 8) * 2) = pack8(b8);
#pragma unroll
            for (int q = 0; q < 4; ++q) *(LAS f32x4*)(lds + O_XF + (tk * 132 + c16 + q * 4) * 4) = (f32x4){xc[q * 4], xc[q * 4 + 1], xc[q * 4 + 2], xc[q * 4 + 3]};
        }
        __syncthreads();
        if (tt + tstep < NTOK / 64) LRU_PREFETCH(tt + tstep);
        f32x4 accA[4], accX[4];
#pragma unroll
        for (int mi = 0; mi < 4; ++mi) { accA[mi] = (f32x4){0.f, 0.f, 0.f, 0.f}; accX[mi] = (f32x4){0.f, 0.f, 0.f, 0.f}; }
#pragma unroll
        for (int kk = 0; kk < 4; ++kk) {
            const bf16x8 fa = *(const LAS bf16x8*)(lds + O_WA + (jloc * 136 + kk * 32 + fq * 8) * 2);
            const bf16x8 fx = *(const LAS bf16x8*)(lds + O_WX + (jloc * 136 + kk * 32 + fq * 8) * 2);
#pragma unroll
            for (int mi = 0; mi < 4; ++mi) {
                const bf16x8 xa = *(const LAS bf16x8*)(lds + O_XC + ((mi * 16 + (lane & 15)) * 136 + kk * 32 + fq * 8) * 2);
                accA[mi] = __builtin_amdgcn_mfma_f32_16x16x32_bf16(xa, fa, accA[mi], 0, 0, 0);
                accX[mi] = __builtin_amdgcn_mfma_f32_16x16x32_bf16(xa, fx, accX[mi], 0, 0, 0);
            }
        }
#pragma unroll
        for (int mi = 0; mi < 4; ++mi)
#pragma unroll
            for (int rg = 0; rg < 4; ++rg) {
                const int t = mi * 16 + fq * 4 + rg;
                const float xv = *(const LAS float*)(lds + O_XF + (t * 132 + jloc) * 4);
                const float r = sigmoidf_(accA[mi][rg] + ba), ig = sigmoidf_(accX[mi][rg] + bx);
                const float la = -r * sp8;
                const size_t o = (size_t)(tok0 + t) * 512 + cg;
                LA[o] = __expf(la);
                LB[o] = sqrtf(fmaxf(-expm1f(2.0f * la), 0.0f)) * (ig * xv);
            }
    }
}

#undef LRU_PREFETCH
__device__ __forceinline__ bf16x8 rw_op16(LAS unsigned char* lds, int off) { return *(const LAS bf16x8*)(lds + off); }
__device__ __forceinline__ bf16x8 rw_op8x2(LAS unsigned char* lds, int off0, int off1) { const u32x2 lo = *(const LAS u32x2*)(lds + off0), hi = *(const LAS u32x2*)(lds + off1); const u32x4 w = (u32x4){lo.x, lo.y, hi.x, hi.y}; return __builtin_bit_cast(bf16x8, w); }
__device__ __forceinline__ bf16x8 rw_accop(const f32x4 a, const f32x4 b) { u32x4 w; w.x = pk_bf16(a[0], a[1]); w.y = pk_bf16(a[2], a[3]); w.z = pk_bf16(b[0], b[1]); w.w = pk_bf16(b[2], b[3]); return __builtin_bit_cast(bf16x8, w); }
#define RW_MFMA(a, b, c) __builtin_amdgcn_mfma_f32_16x16x32_bf16(a, b, c, 0, 0, 0)
__device__ __forceinline__ void p2_rw(KP P, int l, int item, LAS unsigned char* lds) {
    const int tid = ltid(), lane = tid & 63, wave = tid >> 6, b = item >> 3, h = item & 7;
    const int fr = lane & 15, fq = lane >> 4, st = tid >> 3, sc = (tid & 7) * 8;
    const bf16_t* U = (const bf16_t*)(P->ws + WS_U);
    const float* RWW = (const float*)(P->ws + WS_RWW); const bf16_t* RWA = (const bf16_t*)(P->ws + WS_RWA); const bf16_t* RWG = (const bf16_t*)(P->ws + WS_RWG);
    bf16_t* Y = (bf16_t*)(P->ws + WS_HY);
    LAS float* F = LDSF(0);
    constexpr int CN = 0, WC = 512, TOT = 4608, LD = 4864;
    constexpr int XD = 23552, AT = 25600, RT = AT + 9216, BT = RT + 9216, KT = BT + 9216, BTT = KT + 9216, KTT = BTT + 9216, VT = KTT + 9216, GAB = VT + 9216, GAK = GAB + 9216, GRB = GAK + 9216, GRK = GRB + 9216, OO = GRK + 9216;
    __syncthreads();
    {
        const int kind = tid >> 6, c = tid & 63; float v;
        if (kind < 3) v = P->in[I_RWMU][l * RW_IN + kind * 512 + h * 64 + c];
        else if (kind == 3) v = P->in[I_RWKK][l * 512 + h * 64 + c];
        else if (kind == 4) v = P->in[I_RWKA][l * 512 + h * 64 + c];
        else if (kind == 5) v = P->in[I_RWRK][l * 512 + h * 64 + c];
        else if (kind == 6) v = P->in[I_RWLNW][l * 512 + h * 64 + c];
        else v = P->in[I_RWLNB][l * 512 + h * 64 + c];
        F[CN + kind * 64 + c] = v;
        for (int e = tid; e < 4 * 9216 / 16; e += NTHR) *(LAS u32x4*)(lds + GAB + e * 16) = (u32x4){0u, 0u, 0u, 0u};
    }
    __syncthreads();
    f32x4 ST[4];
#pragma unroll
    for (int j = 0; j < 4; ++j) ST[j] = (f32x4){0.f, 0.f, 0.f, 0.f};
    u32x4 pr_c, pk_c, pv_c, pr_p, pk_p, pv_p, pa, pg; f32x4 pw0, pw1; float pflag;
#define RW_IDS const int tid = ltid(), lane = tid & 63, wave = tid >> 6, fr = lane & 15, fq = lane >> 4, st = tid >> 3, sc = (tid & 7) * 8; (void)lane; (void)wave; (void)fr; (void)fq; (void)st; (void)sc;
#define RW_PREFETCH(ch) do { RW_IDS const int tk_ = b * SEQ + (ch) * 64 + st; const bool first_ = ((ch) == 0 && st == 0); \
        const bf16_t* uc_ = U + (size_t)tk_ * LDU + h * 64 + sc; const bf16_t* up_ = first_ ? uc_ : uc_ - LDU; pflag = first_ ? 0.f : 1.f; \
        pr_c = *(const u32x4*)(uc_ + U_RW_R); pk_c = *(const u32x4*)(uc_ + U_RW_K); pv_c = *(const u32x4*)(uc_ + U_RW_V); \
        pr_p = *(const u32x4*)(up_ + U_RW_R); pk_p = *(const u32x4*)(up_ + U_RW_K); pv_p = *(const u32x4*)(up_ + U_RW_V); \
        const size_t o_ = (size_t)tk_ * 512 + h * 64 + sc; pw0 = *(const f32x4*)(RWW + o_); pw1 = *(const f32x4*)(RWW + o_ + 4); pa = *(const u32x4*)(RWA + o_); pg = *(const u32x4*)(RWG + o_); } while (0)
    RW_PREFETCH(0);
    for (int ch = 0; ch < SEQ / 64; ++ch) {
        u32x4 cg, cvp; float bsum = 0.f;
        {   RW_IDS
        {
        float wt[8];
        {
            wt[0] = pw0[0]; wt[1] = pw0[1]; wt[2] = pw0[2]; wt[3] = pw0[3]; wt[4] = pw1[0]; wt[5] = pw1[1]; wt[6] = pw1[2]; wt[7] = pw1[3];
            const int sl = lane >> 3;
#pragma unroll
            for (int d = 1; d < 8; d <<= 1) {
#pragma unroll
                for (int j = 0; j < 8; ++j) { const float o = __shfl_up(wt[j], 8 * d); if (sl >= d) wt[j] *= o; }
            }
            if (sl == 7) { *(LAS f32x4*)(F + TOT + wave * 64 + sc) = (f32x4){wt[0], wt[1], wt[2], wt[3]}; *(LAS f32x4*)(F + TOT + wave * 64 + sc + 4) = (f32x4){wt[4], wt[5], wt[6], wt[7]}; }
        }
        __syncthreads();
        {
            f32x4 b0 = (f32x4){1.f, 1.f, 1.f, 1.f}, b1 = b0;
            for (int wv = 0; wv < wave; ++wv) { b0 *= *(const LAS f32x4*)(F + TOT + wv * 64 + sc); b1 *= *(const LAS f32x4*)(F + TOT + wv * 64 + sc + 4); }
#pragma unroll
            for (int j = 0; j < 4; ++j) { wt[j] *= b0[j]; wt[4 + j] *= b1[j]; }
            *(LAS f32x4*)(F + WC + st * 64 + sc) = (f32x4){wt[0], wt[1], wt[2], wt[3]}; *(LAS f32x4*)(F + WC + st * 64 + sc + 4) = (f32x4){wt[4], wt[5], wt[6], wt[7]};
        }
        }
        float r[8], v[8], ma[8], bv[8], kp[8];
        cg = pg;
        {
            float k[8], a[8];
            {
                float c[8], p[8], m[8];
                unpack8(pr_c, c); unpack8(pr_p, p);
#pragma unroll
                for (int j = 0; j < 8; ++j) m[j] = F[CN + 0 * 64 + sc + j];
#pragma unroll
                for (int j = 0; j < 8; ++j) r[j] = c[j] + (p[j] * pflag - c[j]) * m[j];
                unpack8(pk_c, c); unpack8(pk_p, p);
#pragma unroll
                for (int j = 0; j < 8; ++j) m[j] = F[CN + 1 * 64 + sc + j];
#pragma unroll
                for (int j = 0; j < 8; ++j) k[j] = c[j] + (p[j] * pflag - c[j]) * m[j];
                unpack8(pv_c, c); unpack8(pv_p, p);
#pragma unroll
                for (int j = 0; j < 8; ++j) m[j] = F[CN + 2 * 64 + sc + j];
#pragma unroll
                for (int j = 0; j < 8; ++j) v[j] = c[j] + (p[j] * pflag - c[j]) * m[j];
                unpack8(pa, a);
            }
            float ss = 0.f, kkv[8];
#pragma unroll
            for (int j = 0; j < 8; ++j) { kkv[j] = k[j] * F[CN + 3 * 64 + sc + j]; ss += kkv[j] * kkv[j]; }
            ss = red8(ss);
            const float inv = 1.0f / fmaxf(sqrtf(ss + 1e-12f), 1e-6f);
#pragma unroll
            for (int j = 0; j < 8; ++j) {
                const float kn = kkv[j] * inv;
                kp[j] = k[j] * (1.0f + (a[j] - 1.0f) * F[CN + 4 * 64 + sc + j]);
                ma[j] = -kn; bv[j] = kn * a[j];
                bsum += r[j] * kp[j] * F[CN + 5 * 64 + sc + j];
            }
            bsum = red8(bsum);
        }
        {
#pragma unroll
            for (int j = 0; j < 8; j += 2) {
                const unsigned pw = pk_bf16(v[j], v[j + 1]);
                *(LAS bf16_t*)(lds + VT + ((sc + j) * 72 + st) * 2) = (bf16_t)(pw & 0xffffu);
                *(LAS bf16_t*)(lds + VT + ((sc + j + 1) * 72 + st) * 2) = (bf16_t)(pw >> 16);
            }
        }
        cvp = pack8(v);
        {
            float al[8], be[8], ka[8], rh[8];
            const f32x4 wa0 = *(const LAS f32x4*)(F + WC + st * 64 + sc), wa1 = *(const LAS f32x4*)(F + WC + st * 64 + sc + 4);
#pragma unroll
            for (int j = 0; j < 8; ++j) {
                const float wtj = (j < 4) ? wa0[j & 3] : wa1[j & 3];
                const float w1 = (j < 4) ? pw0[j & 3] : pw1[j & 3], iw = fast_rcp(wtj), wp = wtj * fast_rcp(w1);
                al[j] = ma[j] * wp; be[j] = bv[j] * iw; ka[j] = kp[j] * iw; rh[j] = r[j] * wtj;
            }
            const u32x4 qa = pack8(al), qb = pack8(be), qk = pack8(ka), qr = pack8(rh);
            *(LAS u32x4*)(lds + AT + (st * 72 + sc) * 2) = qa; *(LAS u32x4*)(lds + RT + (st * 72 + sc) * 2) = qr;
            *(LAS u32x4*)(lds + BT + (st * 72 + sc) * 2) = qb; *(LAS u32x4*)(lds + KT + (st * 72 + sc) * 2) = qk;
#pragma unroll
            for (int j = 0; j < 8; ++j) {
                const unsigned wb = qb[j >> 1], wk = qk[j >> 1];
                *(LAS bf16_t*)(lds + BTT + ((sc + j) * 72 + st) * 2) = (bf16_t)((j & 1) ? (wb >> 16) : (wb & 0xffffu));
                *(LAS bf16_t*)(lds + KTT + ((sc + j) * 72 + st) * 2) = (bf16_t)((j & 1) ? (wk >> 16) : (wk & 0xffffu));
            }
        }
        }
        __syncthreads();
        if (ch + 1 < SEQ / 64) RW_PREFETCH(ch + 1);
        {   RW_IDS
            const int m = wave >> 1;
            const int ta = (m < 2) ? AT : RT, tb = (m & 1) ? KT : BT, tg = GAB + m * 9216;
#pragma unroll
            for (int e = 0; e < 5; ++e) {
                int ti, ji;
                if (wave & 1) { ti = (e < 2) ? 1 : 2; ji = (e < 2) ? e : e - 2; } else { ti = (e < 1) ? 0 : 3; ji = (e < 1) ? 0 : e - 1; }
                f32x4 g = (f32x4){0.f, 0.f, 0.f, 0.f};
#pragma unroll
                for (int kk = 0; kk < 2; ++kk) g = RW_MFMA(rw_op16(lds, ta + ((ti * 16 + fr) * 72 + kk * 32 + fq * 8) * 2), rw_op16(lds, tb + ((ji * 16 + fr) * 72 + kk * 32 + fq * 8) * 2), g);
#pragma unroll
                for (int rg = 0; rg < 4; ++rg) {
                    const int t = ti * 16 + fq * 4 + rg, j = ji * 16 + fr;
                    const bool keep = (m >= 2) ? (j <= t) : (j < t);
                    const float val = keep ? g[rg] : 0.f;
                    *(LAS bf16_t*)(lds + tg + (t * 72 + j) * 2) = (bf16_t)(pk_bf16(val, 0.f) & 0xffffu);
                    if (m == 0 && ti == ji) F[LD + ti * 256 + (fq * 4 + rg) * 16 + fr] = val;
                }
            }
        }
        __syncthreads();
        f32x4 Yc[4]; bf16x8 s0b[2], vtb[2];
        {   RW_IDS
        if (wave == 4) {
            const int c = lane >> 4, col = lane & 15;
            float x[16];
#pragma unroll
            for (int t = 0; t < 16; ++t) {
                float acc = (t == col) ? 1.0f : 0.0f, acc1 = 0.f;
#pragma unroll
                for (int j = 0; j < t; ++j) { if (j & 1) acc1 += F[LD + c * 256 + t * 16 + j] * x[j]; else acc += F[LD + c * 256 + t * 16 + j] * x[j]; }
                acc += acc1;
                x[t] = acc;
                __builtin_amdgcn_sched_barrier(0);
                *(LAS bf16_t*)(lds + XD + ((c * 16 + t) * 16 + col) * 2) = (bf16_t)(pk_bf16(acc, 0.f) & 0xffffu);
            }
        }
        if (wave < 4) {
#pragma unroll
            for (int kk = 0; kk < 2; ++kk) { s0b[kk] = rw_accop(ST[2 * kk], ST[2 * kk + 1]); vtb[kk] = rw_op16(lds, VT + ((wave * 16 + fr) * 72 + kk * 32 + fq * 8) * 2); }
#pragma unroll
            for (int c = 0; c < 4; ++c) {
                const int row = c * 16 + fr;
                f32x4 y = (f32x4){0.f, 0.f, 0.f, 0.f};
#pragma unroll
                for (int kk = 0; kk < 2; ++kk) y = RW_MFMA(rw_op8x2(lds, AT + (row * 72 + kk * 32 + fq * 4) * 2, AT + (row * 72 + kk * 32 + 16 + fq * 4) * 2), s0b[kk], y);
                y = RW_MFMA(rw_op16(lds, GAK + (row * 72 + fq * 8) * 2), vtb[0], y);
                if (c >= 2) y = RW_MFMA(rw_op16(lds, GAK + (row * 72 + 32 + fq * 8) * 2), vtb[1], y);
                Yc[c] = y;
            }
        }
        }
        __syncthreads();
        {   RW_IDS
        if (wave < 4) {
            const f32x4 z4 = (f32x4){0.f, 0.f, 0.f, 0.f};
#define RW_XOP(c) __builtin_bit_cast(bf16x8, (u32x4){(*(const LAS u32x2*)(lds + XD + (((c) * 16 + fr) * 16 + fq * 4) * 2)).x, (*(const LAS u32x2*)(lds + XD + (((c) * 16 + fr) * 16 + fq * 4) * 2)).y, 0u, 0u})
#define RW_LOP(c, kk) rw_op8x2(lds, GAB + (((c) * 16 + fr) * 72 + (kk) * 32 + fq * 4) * 2, GAB + (((c) * 16 + fr) * 72 + (kk) * 32 + 16 + fq * 4) * 2)
            const f32x4 U0 = RW_MFMA(RW_XOP(0), rw_accop(Yc[0], z4), z4);
            const f32x4 Y1 = RW_MFMA(RW_LOP(1, 0), rw_accop(U0, z4), Yc[1]);
            const f32x4 U1 = RW_MFMA(RW_XOP(1), rw_accop(Y1, z4), z4);
            const bf16x8 ub0 = rw_accop(U0, U1);
            const f32x4 Y2 = RW_MFMA(RW_LOP(2, 0), ub0, Yc[2]);
            const f32x4 U2 = RW_MFMA(RW_XOP(2), rw_accop(Y2, z4), z4);
            f32x4 Y3 = RW_MFMA(RW_LOP(3, 0), ub0, Yc[3]);
            Y3 = RW_MFMA(RW_LOP(3, 1), rw_accop(U2, z4), Y3);
            const f32x4 U3 = RW_MFMA(RW_XOP(3), rw_accop(Y3, z4), z4);
            const bf16x8 ub1 = rw_accop(U2, U3);
#undef RW_XOP
#undef RW_LOP
#pragma unroll
            for (int c = 0; c < 4; ++c) {
                const int row = c * 16 + fr;
                f32x4 o = (f32x4){0.f, 0.f, 0.f, 0.f};
#pragma unroll
                for (int kk = 0; kk < 2; ++kk) o = RW_MFMA(rw_op8x2(lds, RT + (row * 72 + kk * 32 + fq * 4) * 2, RT + (row * 72 + kk * 32 + 16 + fq * 4) * 2), s0b[kk], o);
                o = RW_MFMA(rw_op8x2(lds, GRB + (row * 72 + fq * 4) * 2, GRB + (row * 72 + 16 + fq * 4) * 2), ub0, o);
                o = RW_MFMA(rw_op16(lds, GRK + (row * 72 + fq * 8) * 2), vtb[0], o);
                if (c >= 2) {
                    o = RW_MFMA(rw_op8x2(lds, GRB + (row * 72 + 32 + fq * 4) * 2, GRB + (row * 72 + 48 + fq * 4) * 2), ub1, o);
                    o = RW_MFMA(rw_op16(lds, GRK + (row * 72 + 32 + fq * 8) * 2), vtb[1], o);
                }
#pragma unroll
                for (int rg = 0; rg < 4; ++rg) *(LAS float*)(lds + OO + ((c * 16 + fq * 4 + rg) * 68 + wave * 16 + fr) * 4) = o[rg];
            }
#pragma unroll
            for (int kt = 0; kt < 4; ++kt) {
                const int row = kt * 16 + fr;
                f32x4 s = ST[kt];
                s = RW_MFMA(rw_op8x2(lds, BTT + (row * 72 + fq * 4) * 2, BTT + (row * 72 + 16 + fq * 4) * 2), ub0, s);
                s = RW_MFMA(rw_op8x2(lds, BTT + (row * 72 + 32 + fq * 4) * 2, BTT + (row * 72 + 48 + fq * 4) * 2), ub1, s);
                s = RW_MFMA(rw_op16(lds, KTT + (row * 72 + fq * 8) * 2), vtb[0], s);
                s = RW_MFMA(rw_op16(lds, KTT + (row * 72 + 32 + fq * 8) * 2), vtb[1], s);
                ST[kt] = s * *(const LAS f32x4*)(F + WC + 63 * 64 + kt * 16 + fq * 4);
            }
        }
        }
        __syncthreads();
        {   RW_IDS
            const f32x4 o0 = *(const LAS f32x4*)(lds + OO + (st * 68 + sc) * 4), o1 = *(const LAS f32x4*)(lds + OO + (st * 68 + sc + 4) * 4);
            float o[8] = {o0[0], o0[1], o0[2], o0[3], o1[0], o1[1], o1[2], o1[3]}, v8[8], g8[8], y8[8];
            unpack8(cvp, v8); unpack8(cg, g8);
            float sm = 0.f;
#pragma unroll
            for (int j = 0; j < 8; ++j) sm += o[j];
            const float mean = red8(sm) * (1.0f / 64.0f);
            float q = 0.f;
#pragma unroll
            for (int j = 0; j < 8; ++j) { o[j] -= mean; q += o[j] * o[j]; }
            const float rs = rsqrtf(red8(q) * (1.0f / 64.0f) + 64e-5f);
#pragma unroll
            for (int j = 0; j < 8; ++j) y8[j] = (o[j] * rs * F[CN + 6 * 64 + sc + j] + F[CN + 7 * 64 + sc + j] + bsum * v8[j]) * g8[j];
            *(u32x4*)(Y + (size_t)(b * SEQ + ch * 64 + st) * DM + 512 + h * 64 + sc) = pack8(y8);
        }
    }
#undef RW_PREFETCH
#undef RW_IDS
}
#undef RW_MFMA


__device__ __forceinline__ void p2_hg(KP P, int l, int item, LAS unsigned char* lds) {
    const int tid = ltid(), lane = tid & 63, wave = tid >> 6, b = item >> 2, h = item & 3;
    const int fr = lane & 15, fq = lane >> 4, st = tid >> 3, c16 = tid & 7, sv = c16 * 16;
    const bf16_t* U = (const bf16_t*)(P->ws + WS_U); bf16_t* Y = (bf16_t*)(P->ws + WS_HY);
    LAS float* F = LDSF(0);
    constexpr int LBO = 0, HN = 128, FF = 256, TT = 8448;
    constexpr int QB = 35840, KB = QB + 64 * 136 * 2, KT = KB + 64 * 136 * 2, VT = KT + 128 * 72 * 2, AB = VT + 128 * 72 * 2, OO = AB + 64 * 40 * 2;
    __syncthreads();
    if (tid < 128) { float lb = 0.f; if (l == 1) lb = sigmoidf_(P->in[I_HGLB][512 + h * 128 + tid] - P->in[I_HGLB][h * 128 + tid]); F[LBO + tid] = lb; F[HN + tid] = P->in[I_HGNORM][l * 512 + h * 128 + tid]; }
    __syncthreads();
    f32x4 S[8];
#pragma unroll
    for (int j = 0; j < 8; ++j) S[j] = (f32x4){0.f, 0.f, 0.f, 0.f};
    u32x4 pq0, pq1, pf0, pf1, pv0, pv1;
#define HG_IDS const int tid = ltid(), lane = tid & 63, wave = tid >> 6, fr = lane & 15, fq = lane >> 4, st = tid >> 3, c16 = tid & 7, sv = c16 * 16; (void)lane; (void)wave; (void)fr; (void)fq; (void)st; (void)c16; (void)sv;
#define HG_PREFETCH(ch) do { HG_IDS const bf16_t* ur_ = U + (size_t)(b * SEQ + (ch) * 64 + st) * LDU + h * 128; \
        pq0 = *(const u32x4*)(ur_ + U_HG_Q + c16 * 16); pq1 = *(const u32x4*)(ur_ + U_HG_Q + c16 * 16 + 8); pf0 = *(const u32x4*)(ur_ + U_HG_F + c16 * 16); pf1 = *(const u32x4*)(ur_ + U_HG_F + c16 * 16 + 8); \
        pv0 = *(const u32x4*)(ur_ + U_HG_I + sv); pv1 = *(const u32x4*)(ur_ + U_HG_I + sv + 8); } while (0)
    HG_PREFETCH(0);
    for (int ch = 0; ch < SEQ / 64; ++ch) {
        float fo[16], kx[16], qs[16];
        u32x4 cg0, cg1;
        {   HG_IDS
            { const bf16_t* ug_ = U + (size_t)(b * SEQ + ch * 64 + st) * LDU + U_HG_G + h * 128 + sv; cg0 = *(const u32x4*)ug_; cg1 = *(const u32x4*)(ug_ + 8); }
            float q[16], z[16];
            { float t0[8], t1[8]; unpack8(pq0, t0); unpack8(pq1, t1);
#pragma unroll
              for (int j = 0; j < 8; ++j) { q[j] = t0[j]; q[8 + j] = t1[j]; }
              unpack8(pf0, t0); unpack8(pf1, t1);
#pragma unroll
              for (int j = 0; j < 8; ++j) { z[j] = t0[j]; z[8 + j] = t1[j]; } }
#pragma unroll
            for (int j = 0; j < 16; ++j) {
                const float lb = F[LBO + c16 * 16 + j], e = __expf(-z[j]), sg = fast_rcp(1.0f + e);
                fo[j] = lb + (1.0f - lb) * sg; kx[j] = (1.0f - lb) * (e * sg);
                qs[j] = siluf_(q[j]);
            }
        }
        const u32x4 cv0 = pv0, cv1 = pv1;
        __syncthreads();
        {   HG_IDS
#pragma unroll
            for (int m = 0; m < 4; ++m) *(LAS f32x4*)(F + FF + st * 128 + c16 * 16 + 4 * m) = (f32x4){fo[4 * m], fo[4 * m + 1], fo[4 * m + 2], fo[4 * m + 3]};
#pragma unroll
            for (int j = 0; j < 8; ++j) {
                const unsigned w0 = cv0[j >> 1], w1 = cv1[j >> 1];
                *(LAS bf16_t*)(lds + VT + ((sv + j) * 72 + st) * 2) = (bf16_t)((j & 1) ? (w0 >> 16) : (w0 & 0xffffu));
                *(LAS bf16_t*)(lds + VT + ((sv + 8 + j) * 72 + st) * 2) = (bf16_t)((j & 1) ? (w1 >> 16) : (w1 & 0xffffu));
            }
        }
        __syncthreads();
        {   HG_IDS
            const int kk = tid & 127, w4 = tid >> 7; float c = 1.0f;
#pragma unroll 4
            for (int i = 0; i < 16; ++i) { const int ix = FF + (w4 * 16 + i) * 128 + kk; c *= F[ix]; F[ix] = c; }
            F[TT + w4 * 128 + kk] = c;
        }
        __syncthreads();
        if ((ltid() >> 7) & 1) {   HG_IDS
            const int kk = tid & 127, w4 = tid >> 7; const float m0 = F[TT + (w4 - 1) * 128 + kk];
#pragma unroll 4
            for (int i = 0; i < 16; ++i) F[FF + (w4 * 16 + i) * 128 + kk] *= m0;
        }
        __syncthreads();
        {   HG_IDS
#pragma unroll
            for (int m = 0; m < 4; ++m) {
                const f32x4 c4 = *(const LAS f32x4*)(F + FF + st * 128 + c16 * 16 + 4 * m);
                float qc[4], kc[4];
#pragma unroll
                for (int j = 0; j < 4; ++j) { const float cc = fmaxf(c4[j], 1e-30f); qc[j] = qs[4 * m + j] * cc; kc[j] = kx[4 * m + j] * fast_rcp(cc); }
                u32x2 w; w.x = pk_bf16(qc[0], qc[1]); w.y = pk_bf16(qc[2], qc[3]);
                *(LAS u32x2*)(lds + QB + (st * 136 + c16 * 16 + 4 * m) * 2) = w;
                w.x = pk_bf16(kc[0], kc[1]); w.y = pk_bf16(kc[2], kc[3]);
                *(LAS u32x2*)(lds + KB + (st * 136 + c16 * 16 + 4 * m) * 2) = w;
                *(LAS bf16_t*)(lds + KT + ((c16 * 16 + 4 * m + 0) * 72 + st) * 2) = (bf16_t)(w.x & 0xffffu);
                *(LAS bf16_t*)(lds + KT + ((c16 * 16 + 4 * m + 1) * 72 + st) * 2) = (bf16_t)(w.x >> 16);
                *(LAS bf16_t*)(lds + KT + ((c16 * 16 + 4 * m + 2) * 72 + st) * 2) = (bf16_t)(w.y & 0xffffu);
                *(LAS bf16_t*)(lds + KT + ((c16 * 16 + 4 * m + 3) * 72 + st) * 2) = (bf16_t)(w.y >> 16);
            }
        }
        __syncthreads();
        {   HG_IDS
        if (ch + 1 < SEQ / 64) HG_PREFETCH(ch + 1);
        {
            const int wn = wave >> 2, ti = (wave >> 1) & 1, si = wave & 1;
            f32x4 a0 = (f32x4){0.f, 0.f, 0.f, 0.f};
#pragma unroll
            for (int kk = 0; kk < 4; ++kk) {
                const bf16x8 qa = *(const LAS bf16x8*)(lds + QB + ((wn * 32 + ti * 16 + fr) * 136 + kk * 32 + fq * 8) * 2);
                const bf16x8 k0 = *(const LAS bf16x8*)(lds + KB + ((wn * 32 + si * 16 + fr) * 136 + kk * 32 + fq * 8) * 2);
                a0 = __builtin_amdgcn_mfma_f32_16x16x32_bf16(qa, k0, a0, 0, 0, 0);
            }
#pragma unroll
            for (int rg = 0; rg < 4; ++rg) {
                const int tl = ti * 16 + fq * 4 + rg, sl = si * 16 + fr;
                const unsigned w0 = pk_bf16((sl <= tl) ? a0[rg] : 0.f, 0.f) & 0xffffu;
                *(LAS bf16_t*)(lds + AB + ((wn * 32 + tl) * 40 + sl) * 2) = (bf16_t)w0;
            }
        }
        }
        __syncthreads();
        {   HG_IDS
        *(LAS u32x4*)(lds + KB + (st * 136 + sv) * 2) = cg0; *(LAS u32x4*)(lds + KB + (st * 136 + sv + 8) * 2) = cg1;
        {
            bf16x8 vb[2];
#pragma unroll
            for (int wn = 0; wn < 2; ++wn) vb[wn] = *(const LAS bf16x8*)(lds + VT + ((wave * 16 + fr) * 72 + wn * 32 + fq * 8) * 2);
#pragma unroll
            for (int wn = 0; wn < 2; ++wn) {
                bf16x8 mb[4];
#pragma unroll
                for (int kk = 0; kk < 4; ++kk) {
                    u32x4 w; w.x = pk_bf16(S[2 * kk][0], S[2 * kk][1]); w.y = pk_bf16(S[2 * kk][2], S[2 * kk][3]); w.z = pk_bf16(S[2 * kk + 1][0], S[2 * kk + 1][1]); w.w = pk_bf16(S[2 * kk + 1][2], S[2 * kk + 1][3]);
                    mb[kk] = __builtin_bit_cast(bf16x8, w);
                }
#pragma unroll
                for (int ti = 0; ti < 2; ++ti) {
                    const int row = wn * 32 + ti * 16 + fr;
                    const bf16x8 sa = *(const LAS bf16x8*)(lds + AB + (row * 40 + fq * 8) * 2);
                    f32x4 o = __builtin_amdgcn_mfma_f32_16x16x32_bf16(sa, vb[wn], (f32x4){0.f, 0.f, 0.f, 0.f}, 0, 0, 0);
#pragma unroll
                    for (int kk = 0; kk < 4; ++kk) {
                        const u32x2 lo = *(const LAS u32x2*)(lds + QB + (row * 136 + kk * 32 + fq * 4) * 2), hi = *(const LAS u32x2*)(lds + QB + (row * 136 + kk * 32 + 16 + fq * 4) * 2);
                        const u32x4 w = (u32x4){lo.x, lo.y, hi.x, hi.y};
                        o = __builtin_amdgcn_mfma_f32_16x16x32_bf16(__builtin_bit_cast(bf16x8, w), mb[kk], o, 0, 0, 0);
                    }
#pragma unroll
                    for (int rg = 0; rg < 4; ++rg) *(LAS float*)(lds + OO + ((wn * 32 + ti * 16 + fq * 4 + rg) * 132 + wave * 16 + fr) * 4) = o[rg];
                }
#pragma unroll
                for (int kt = 0; kt < 8; ++kt) {
                    const bf16x8 ka = *(const LAS bf16x8*)(lds + KT + ((kt * 16 + fr) * 72 + wn * 32 + fq * 8) * 2);
                    S[kt] = __builtin_amdgcn_mfma_f32_16x16x32_bf16(ka, vb[wn], S[kt], 0, 0, 0);
                    S[kt] *= *(const LAS f32x4*)(F + FF + (wn * 32 + 31) * 128 + kt * 16 + fq * 4);
                }
            }
        }
        }
        __syncthreads();
        {   HG_IDS
            float ss = 0.f;
#pragma unroll
            for (int m = 0; m < 4; ++m) { const f32x4 x = *(const LAS f32x4*)(lds + OO + (st * 132 + sv + 4 * m) * 4); ss += x[0] * x[0] + x[1] * x[1] + x[2] * x[2] + x[3] * x[3]; }
            const float rs = rsqrtf(red8(ss) * (1.0f / 128.0f) + 1e-6f);
            bf16_t* yr = Y + (size_t)(b * SEQ + ch * 64 + st) * DM + h * 128 + sv;
#pragma unroll 1
            for (int hf = 0; hf < 2; ++hf) {
                const f32x4 x0 = *(const LAS f32x4*)(lds + OO + (st * 132 + sv + hf * 8) * 4), x1 = *(const LAS f32x4*)(lds + OO + (st * 132 + sv + hf * 8 + 4) * 4);
                const f32x4 n0 = *(const LAS f32x4*)(F + HN + sv + hf * 8), n1 = *(const LAS f32x4*)(F + HN + sv + hf * 8 + 4);
                float g[8], y8[8]; unpack8(*(const LAS u32x4*)(lds + KB + (st * 136 + sv + hf * 8) * 2), g);
#pragma unroll
                for (int j = 0; j < 4; ++j) { y8[j] = x0[j] * rs * n0[j] * siluf_(g[j]); y8[4 + j] = x1[j] * rs * n1[j] * siluf_(g[4 + j]); }
                *(u32x4*)(yr + hf * 8) = pack8(y8);
            }
        }
    }
#undef HG_PREFETCH
#undef HG_IDS
}

__device__ __forceinline__ void p2_ml(KP P, int l, int item, LAS unsigned char* lds) {
    const int tid = ltid(), lane = tid & 63, wave = tid >> 6, b = item >> 2, h = item & 3;
    const int fr = lane & 15, fq = lane >> 4, st = tid >> 3, c8 = tid & 7, sv = c8 * 16;
    const int blk = tid & 31, sg = tid >> 5;
    const bf16_t* U = (const bf16_t*)(P->ws + WS_U); bf16_t* Y = (bf16_t*)(P->ws + WS_HY);
    LAS float* F = LDSF(0);
    constexpr int FD = 0, IW = 64, EN = 128, RS = 256, NK = 512, TNS = 768, CT = 1280, MN = 2944, MS = 3072;
    constexpr int QB = 12800, KB = QB + 64 * 136 * 2, KT = KB + 64 * 136 * 2, VT = KT + 128 * 72 * 2, AB = VT + 128 * 72 * 2, OO = AB + 64 * 72 * 2, XC = OO + 64 * 132 * 4;
    __syncthreads();
    if (tid < 32) {
        const int cgl = h * 128 + blk * 4;
#pragma unroll
        for (int jj = 0; jj < 4; ++jj) *(LAS f32x4*)(F + CT + (jj * 32 + blk) * 4) = *(const f32x4*)(P->in[I_MLCW] + l * 2048 + jj * 512 + cgl);
        *(LAS f32x4*)(F + CT + (4 * 32 + blk) * 4) = *(const f32x4*)(P->in[I_MLCB] + l * 512 + cgl);
#pragma unroll
        for (int j = 0; j < 4; ++j) {
            *(LAS f32x4*)(F + CT + ((5 + j) * 32 + blk) * 4) = *(const f32x4*)(P->in[I_MLWQ] + (size_t)l * 2048 + (h * 32 + blk) * 16 + j * 4) * 0.08838834764831845f;
            *(LAS f32x4*)(F + CT + ((9 + j) * 32 + blk) * 4) = *(const f32x4*)(P->in[I_MLWK] + (size_t)l * 2048 + (h * 32 + blk) * 16 + j * 4);
        }
    }
    const float ib = P->in[I_MLIB][l * 4 + h], fb = P->in[I_MLFB][l * 4 + h];
    f32x4 M[8];
#pragma unroll
    for (int j = 0; j < 8; ++j) M[j] = (f32x4){0.f, 0.f, 0.f, 0.f};
    float mcarry = 0.f;
    u32x2 px[7]; u32x4 pv0, pv1; unsigned pif;
#define ML_IDS const int tid = ltid(), lane = tid & 63, wave = tid >> 6, fr = lane & 15, fq = lane >> 4, st = tid >> 3, c8 = tid & 7, sv = c8 * 16, blk = tid & 31, sg = tid >> 5; (void)lane; (void)wave; (void)fr; (void)fq; (void)st; (void)c8; (void)sv; (void)blk; (void)sg;
#define ML_PREFETCH(ch) do { ML_IDS const int ts0_ = (ch) * 64 + sg * 4 - 3; \
        _Pragma("unroll") for (int r = 0; r < 7; ++r) { const int ts_ = ts0_ + r; \
            px[r] = *(const u32x2*)(U + (size_t)(b * SEQ + (ts_ < 0 ? 0 : ts_)) * LDU + U_ML_X + h * 128 + blk * 4); } \
        { const bf16_t* uv_ = U + (size_t)(b * SEQ + (ch) * 64 + st) * LDU + U_ML_V + h * 128 + sv; pv0 = *(const u32x4*)uv_; pv1 = *(const u32x4*)(uv_ + 8); } \
        { const bf16_t* ug_ = U + (size_t)(b * SEQ + (ch) * 64 + lane) * LDU; pif = (unsigned)ug_[U_ML_I + h] | ((unsigned)ug_[U_ML_F + h] << 16); } } while (0)
    if (tid < 128) { F[NK + tid] = 0.f; F[MN + tid] = P->in[I_MLNORM][l * 512 + h * 128 + tid]; F[MS + tid] = P->in[I_MLSKIP][l * 512 + h * 128 + tid]; }
    ML_PREFETCH(0);
    __syncthreads();
    for (int ch = 0; ch < SEQ / 64; ++ch) {
        const u32x4 cv0 = pv0, cv1 = pv1;
        u32x4 co0, co1;
        {   ML_IDS
        { const bf16_t* uo_ = U + (size_t)(b * SEQ + ch * 64 + st) * LDU + U_ML_O + h * 128 + sv; co0 = *(const u32x4*)uo_; co1 = *(const u32x4*)(uo_ + 8); }
        }
        __syncthreads();
        float q[4][4], k[4][4];
        {   ML_IDS
        {
            float xc[4][4];
            {
                f32x4 cw[4];
#pragma unroll
                for (int j = 0; j < 4; ++j) cw[j] = *(const LAS f32x4*)(F + CT + (j * 32 + blk) * 4);
                const f32x4 cb4 = *(const LAS f32x4*)(F + CT + (4 * 32 + blk) * 4);
                float x[7][4];
#pragma unroll
                for (int r = 0; r < 7; ++r) { const float vf = (ch * 64 + sg * 4 - 3 + r) < 0 ? 0.f : 1.f; x[r][0] = vf * bflo(px[r].x); x[r][1] = vf * bfhi(px[r].x); x[r][2] = vf * bflo(px[r].y); x[r][3] = vf * bfhi(px[r].y); }
#pragma unroll
                for (int s = 0; s < 4; ++s)
#pragma unroll
                    for (int j = 0; j < 4; ++j) xc[s][j] = siluf_(cb4[j] + cw[0][j] * x[s][j] + cw[1][j] * x[s + 1][j] + cw[2][j] * x[s + 2][j] + cw[3][j] * x[s + 3][j]);
            }
#pragma unroll
            for (int s = 0; s < 4; ++s) { u32x2 w; w.x = pk_bf16(xc[s][0], xc[s][1]); w.y = pk_bf16(xc[s][2], xc[s][3]); *(LAS u32x2*)(lds + XC + ((sg * 4 + s) * 136 + blk * 4) * 2) = w; }
            __builtin_amdgcn_sched_barrier(0);
            {
                f32x4 wq[4];
#pragma unroll
                for (int j = 0; j < 4; ++j) wq[j] = *(const LAS f32x4*)(F + CT + ((5 + j) * 32 + blk) * 4);
#pragma unroll
                for (int s = 0; s < 4; ++s)
#pragma unroll
                    for (int i = 0; i < 4; ++i) q[s][i] = xc[s][0] * wq[0][i] + xc[s][1] * wq[1][i] + xc[s][2] * wq[2][i] + xc[s][3] * wq[3][i];
            }
            __builtin_amdgcn_sched_barrier(0);
            {
                f32x4 wk[4];
#pragma unroll
                for (int j = 0; j < 4; ++j) wk[j] = *(const LAS f32x4*)(F + CT + ((9 + j) * 32 + blk) * 4);
#pragma unroll
                for (int s = 0; s < 4; ++s)
#pragma unroll
                    for (int i = 0; i < 4; ++i) k[s][i] = xc[s][0] * wk[0][i] + xc[s][1] * wk[1][i] + xc[s][2] * wk[2][i] + xc[s][3] * wk[3][i];
            }
        }
        if (wave == 0) {
            const float ip = bflo(pif) + ib, xf = bfhi(pif) + fb;
            const float lf = fminf(xf, 0.f) - log1pf(__expf(-fabsf(xf)));
            const float bs = wave_scan_sum(lf);
            const float cm = wave_scan_max(ip - bs);
            const float g = fmaxf(mcarry, cm), mt = bs + g;
            const int lq = lane + lsgpr(0);
            F[FD + lq] = __expf(mcarry - g);
            F[IW + lq] = __expf(ip - bs - mcarry);
            F[EN + lq] = __expf(-mt);
            mcarry = __int_as_float(__builtin_amdgcn_readlane(__float_as_int(mt), 63));
        }
        }
        __syncthreads();
        {   ML_IDS
#pragma unroll
            for (int s = 0; s < 4; ++s) {
                const int t = sg * 4 + s; const float fd = F[FD + t], iw = F[IW + t];
#pragma unroll
                for (int i = 0; i < 4; ++i) { q[s][i] *= fd; k[s][i] *= iw; }
                u32x2 w; w.x = pk_bf16(q[s][0], q[s][1]); w.y = pk_bf16(q[s][2], q[s][3]);
                *(LAS u32x2*)(lds + QB + (t * 136 + blk * 4) * 2) = w;
                w.x = pk_bf16(k[s][0], k[s][1]); w.y = pk_bf16(k[s][2], k[s][3]);
                *(LAS u32x2*)(lds + KB + (t * 136 + blk * 4) * 2) = w;
            }
#pragma unroll
            for (int i = 0; i < 4; ++i) {
                u32x2 w; w.x = pk_bf16(k[0][i], k[1][i]); w.y = pk_bf16(k[2][i], k[3][i]);
                *(LAS u32x2*)(lds + KT + ((blk * 4 + i) * 72 + sg * 4) * 2) = w;
            }
#pragma unroll
            for (int j = 0; j < 8; ++j) {
                const unsigned w0 = cv0[j >> 1], w1 = cv1[j >> 1];
                *(LAS bf16_t*)(lds + VT + ((sv + j) * 72 + st) * 2) = (bf16_t)((j & 1) ? (w0 >> 16) : (w0 & 0xffffu));
                *(LAS bf16_t*)(lds + VT + ((sv + 8 + j) * 72 + st) * 2) = (bf16_t)((j & 1) ? (w1 >> 16) : (w1 & 0xffffu));
            }
        }
        __syncthreads();
        {   ML_IDS
        if (ch + 1 < SEQ / 64) ML_PREFETCH(ch + 1);
        {
            const int ti = wave >> 1, si0 = 2 * (wave & 1);
            f32x4 a0 = (f32x4){0.f, 0.f, 0.f, 0.f}, a1 = a0;
#pragma unroll
            for (int kk = 0; kk < 4; ++kk) {
                const bf16x8 qa = *(const LAS bf16x8*)(lds + QB + ((ti * 16 + fr) * 136 + kk * 32 + fq * 8) * 2);
                const bf16x8 k0 = *(const LAS bf16x8*)(lds + KB + (((si0) * 16 + fr) * 136 + kk * 32 + fq * 8) * 2);
                const bf16x8 k1 = *(const LAS bf16x8*)(lds + KB + (((si0 + 1) * 16 + fr) * 136 + kk * 32 + fq * 8) * 2);
                a0 = __builtin_amdgcn_mfma_f32_16x16x32_bf16(qa, k0, a0, 0, 0, 0);
                a1 = __builtin_amdgcn_mfma_f32_16x16x32_bf16(qa, k1, a1, 0, 0, 0);
            }
#pragma unroll
            for (int rg = 0; rg < 4; ++rg) {
                const int ta = ti * 16 + fq * 4 + rg, s0 = si0 * 16 + fr, s1 = s0 + 16;
                const unsigned w0 = pk_bf16((s0 <= ta) ? a0[rg] : 0.f, 0.f) & 0xffffu, w1 = pk_bf16((s1 <= ta) ? a1[rg] : 0.f, 0.f) & 0xffffu;
                *(LAS bf16_t*)(lds + AB + (ta * 72 + s0) * 2) = (bf16_t)w0;
                *(LAS bf16_t*)(lds + AB + (ta * 72 + s1) * 2) = (bf16_t)w1;
                const float r0 = red16(bflo(w0)), r1 = red16(bflo(w1));
                if (fr == 0) { F[RS + si0 * 64 + ta] = r0; F[RS + (si0 + 1) * 64 + ta] = r1; }
            }
            const int kk = tid & 127, q4 = tid >> 7;
            const u32x4 t0 = *(const LAS u32x4*)(lds + KT + (kk * 72 + q4 * 16) * 2), t1 = *(const LAS u32x4*)(lds + KT + (kk * 72 + q4 * 16 + 8) * 2);
            float f0[8], f1[8]; unpack8(t0, f0); unpack8(t1, f1);
            float s = 0.f;
#pragma unroll
            for (int j = 0; j < 8; ++j) s += f0[j] + f1[j];
            F[TNS + q4 * 128 + kk] = s;
        }
        }
        __syncthreads();
        {   ML_IDS
        *(LAS u32x4*)(lds + KB + (st * 136 + sv) * 2) = co0; *(LAS u32x4*)(lds + KB + (st * 136 + sv + 8) * 2) = co1;
        {
            const float ce = F[FD + 63];
            bf16x8 mb[4], vb[2];
#pragma unroll
            for (int kk = 0; kk < 4; ++kk) {
                u32x4 w; w.x = pk_bf16(M[2 * kk][0], M[2 * kk][1]); w.y = pk_bf16(M[2 * kk][2], M[2 * kk][3]); w.z = pk_bf16(M[2 * kk + 1][0], M[2 * kk + 1][1]); w.w = pk_bf16(M[2 * kk + 1][2], M[2 * kk + 1][3]);
                mb[kk] = __builtin_bit_cast(bf16x8, w);
            }
#pragma unroll
            for (int kk = 0; kk < 2; ++kk) vb[kk] = *(const LAS bf16x8*)(lds + VT + ((wave * 16 + fr) * 72 + kk * 32 + fq * 8) * 2);
#pragma unroll
            for (int ti = 0; ti < 4; ++ti) {
                f32x4 o = (f32x4){0.f, 0.f, 0.f, 0.f};
#pragma unroll
                for (int kk = 0; kk < 2; ++kk) {
                    const bf16x8 sa = *(const LAS bf16x8*)(lds + AB + ((ti * 16 + fr) * 72 + kk * 32 + fq * 8) * 2);
                    o = __builtin_amdgcn_mfma_f32_16x16x32_bf16(sa, vb[kk], o, 0, 0, 0);
                }
#pragma unroll
                for (int kk = 0; kk < 4; ++kk) {
                    const u32x2 lo = *(const LAS u32x2*)(lds + QB + ((ti * 16 + fr) * 136 + kk * 32 + fq * 4) * 2), hi = *(const LAS u32x2*)(lds + QB + ((ti * 16 + fr) * 136 + kk * 32 + 16 + fq * 4) * 2);
                    const u32x4 w = (u32x4){lo.x, lo.y, hi.x, hi.y};
                    o = __builtin_amdgcn_mfma_f32_16x16x32_bf16(__builtin_bit_cast(bf16x8, w), mb[kk], o, 0, 0, 0);
                }
#pragma unroll
                for (int rg = 0; rg < 4; ++rg) *(LAS float*)(lds + OO + ((ti * 16 + fq * 4 + rg) * 132 + wave * 16 + fr) * 4) = o[rg];
            }
#pragma unroll
            for (int kt = 0; kt < 8; ++kt) {
#pragma unroll
                for (int kk = 0; kk < 2; ++kk) {
                    const bf16x8 ka = *(const LAS bf16x8*)(lds + KT + ((kt * 16 + fr) * 72 + kk * 32 + fq * 8) * 2);
                    M[kt] = __builtin_amdgcn_mfma_f32_16x16x32_bf16(ka, vb[kk], M[kt], 0, 0, 0);
                }
                M[kt] *= ce;
            }
            if (tid < 128) F[NK + ((ch + 1) & 1) * 128 + tid] = (F[NK + (ch & 1) * 128 + tid] + (F[TNS + tid] + F[TNS + 128 + tid]) + (F[TNS + 256 + tid] + F[TNS + 384 + tid])) * ce;
        }
        }
        __syncthreads();
        {   ML_IDS
            const u32x4 q0 = *(const LAS u32x4*)(lds + QB + (st * 136 + c8 * 16) * 2), q1 = *(const LAS u32x4*)(lds + QB + (st * 136 + c8 * 16 + 8) * 2);
            float f0[8], f1[8]; unpack8(q0, f0); unpack8(q1, f1);
            float d = 0.f;
#pragma unroll
            for (int m = 0; m < 2; ++m) {
                const f32x4 n0 = *(const LAS f32x4*)(F + NK + (ch & 1) * 128 + c8 * 16 + 4 * m), n1 = *(const LAS f32x4*)(F + NK + (ch & 1) * 128 + c8 * 16 + 8 + 4 * m);
#pragma unroll
                for (int j = 0; j < 4; ++j) d += f0[4 * m + j] * n0[j] + f1[4 * m + j] * n1[j];
            }
            d = red8(d);
            d += (F[RS + st] + F[RS + 64 + st]) + (F[RS + 128 + st] + F[RS + 192 + st]);
            const float dinv = 1.0f / fmaxf(fabsf(d), F[EN + st]);
            float o[16], og[16], xs[16];
#pragma unroll
            for (int m = 0; m < 4; ++m) { const f32x4 x = *(const LAS f32x4*)(lds + OO + (st * 132 + sv + 4 * m) * 4); o[4 * m] = x[0] * dinv; o[4 * m + 1] = x[1] * dinv; o[4 * m + 2] = x[2] * dinv; o[4 * m + 3] = x[3] * dinv; }
            { float t0[8], t1[8]; unpack8(*(const LAS u32x4*)(lds + KB + (st * 136 + sv) * 2), t0); unpack8(*(const LAS u32x4*)(lds + KB + (st * 136 + sv + 8) * 2), t1);
#pragma unroll
              for (int j = 0; j < 8; ++j) { og[j] = t0[j]; og[8 + j] = t1[j]; }
              unpack8(*(const LAS u32x4*)(lds + XC + (st * 136 + sv) * 2), t0); unpack8(*(const LAS u32x4*)(lds + XC + (st * 136 + sv + 8) * 2), t1);
#pragma unroll
              for (int j = 0; j < 8; ++j) { xs[j] = t0[j]; xs[8 + j] = t1[j]; } }
            float ss = 0.f;
#pragma unroll
            for (int j = 0; j < 16; ++j) { o[j] *= sigmoidf_(og[j]); ss += o[j] * o[j]; }
            const float rs = rsqrtf(red8(ss) * (1.0f / 128.0f) + 1e-6f);
#pragma unroll
            for (int j = 0; j < 16; ++j) o[j] = o[j] * rs * F[MN + sv + j] + F[MS + sv + j] * xs[j];
            u32x4 w0, w1;
            w0.x = pk_bf16(o[0], o[1]); w0.y = pk_bf16(o[2], o[3]); w0.z = pk_bf16(o[4], o[5]); w0.w = pk_bf16(o[6], o[7]);
            w1.x = pk_bf16(o[8], o[9]); w1.y = pk_bf16(o[10], o[11]); w1.z = pk_bf16(o[12], o[13]); w1.w = pk_bf16(o[14], o[15]);
            bf16_t* yr = Y + (size_t)(b * SEQ + ch * 64 + st) * DM + 1024 + h * 128 + sv;
            *(u32x4*)yr = w0; *(u32x4*)(yr + 8) = w1;
        }
    }
#undef ML_PREFETCH
#undef ML_IDS
}

__device__ __forceinline__ void p2_lru(KP P, int item, LAS unsigned char* lds) {
    const int tid = ltid(), lane = tid & 63, wave = tid >> 6, b = item >> 3, cgp = item & 7;
    const float* LA = (const float*)(P->ws + WS_LRUA); const float* LB = (const float*)(P->ws + WS_LRUB); bf16_t* Y = (bf16_t*)(P->ws + WS_HY);
    LAS float* F = LDSF(0);
    const size_t base = (size_t)(b * SEQ + wave * 512) * 512 + cgp * 64 + lane;
    float hh = 0.f, ap = 1.f;
#pragma unroll 8
    for (int t = 0; t < 512; ++t) { const float a = LA[base + (size_t)t * 512], x = LB[base + (size_t)t * 512]; hh = a * hh + x; ap *= a; }
    __syncthreads();
    F[wave * 64 + lane] = ap; F[512 + wave * 64 + lane] = hh;
    __syncthreads();
    float c = 0.f;
    for (int j = 0; j < wave; ++j) c = F[j * 64 + lane] * c + F[512 + j * 64 + lane];
    hh = c;
    bf16_t* yp = Y + (size_t)(b * SEQ + wave * 512) * DM + 1536 + cgp * 64 + lane;
#pragma unroll 8
    for (int t = 0; t < 512; ++t) { const float a = LA[base + (size_t)t * 512], x = LB[base + (size_t)t * 512]; hh = a * hh + x; yp[(size_t)t * DM] = (bf16_t)(pk_bf16(hh, 0.f) & 0xffffu); }
}

__device__ __forceinline__ void phase_p3(KP P, int l) {
    const int tid = ltid(), lane = tid & 63, wave = tid >> 6, c0 = lane * 8;
    const bf16_t* U = (const bf16_t*)(P->ws + WS_U); bf16_t* Y = (bf16_t*)(P->ws + WS_HY);
    float hgn[8], mln[8], msk[8], mcb[8], lrn[8];
#pragma unroll
    for (int j = 0; j < 8; ++j) { hgn[j] = P->in[I_HGNORM][l * 512 + c0 + j]; mln[j] = P->in[I_MLNORM][l * 512 + c0 + j]; msk[j] = P->in[I_MLSKIP][l * 512 + c0 + j]; mcb[j] = P->in[I_MLCB][l * 512 + c0 + j]; lrn[j] = P->in[I_LRUNORM][l * 512 + c0 + j]; }
    const float* mcw = P->in[I_MLCW] + l * 2048 + c0;
    for (int tok = lbid() * 8 + wave; tok < NTOK; tok += lgdim() * 8) {
        bf16_t* yr = Y + (size_t)tok * DM; const bf16_t* ur = U + (size_t)tok * LDU; const int tseq = tok & (SEQ - 1);
        {
            float hv[8], gb[8], y8[8]; unpack8(*(const u32x4*)(yr + 1536 + c0), hv); unpack8(*(const u32x4*)(ur + U_LRU_G + c0), gb);
            float ss = 0.f;
#pragma unroll
            for (int j = 0; j < 8; ++j) { hv[j] *= gelu_tanhf_(gb[j]); ss += hv[j] * hv[j]; }
            const float rs = rsqrtf(red64(ss) * (1.0f / 512.0f) + 1e-6f);
#pragma unroll
            for (int j = 0; j < 8; ++j) y8[j] = hv[j] * rs * lrn[j];
            *(u32x4*)(yr + 1536 + c0) = pack8(y8);
        }
    }
}

#ifndef MK_ONE_LAUNCH
#define MK_ONE_LAUNCH 1
#endif
#ifndef MK_DEBUG_BAR
#define MK_DEBUG_BAR 0
#endif
#ifndef MK_FUSE_MASK
#define MK_FUSE_MASK 0x3FFFFFFull
#endif
#ifndef MK_SEAM_DELAY
#define MK_SEAM_DELAY 0
#endif
#ifndef MK_KIND_MASK
#define MK_KIND_MASK 0x40
#endif
#ifndef MK_P1_SPLIT
#define MK_P1_SPLIT 0
#endif
#ifndef MK_REPEAT_PHASE
#define MK_REPEAT_PHASE (-1)
#endif
#ifndef MK_REPEAT_ITEM
#define MK_REPEAT_ITEM (-1)
#endif
#ifndef MK_REPEAT_KIND
#define MK_REPEAT_KIND (-1)
#endif
#ifndef MK_SIMPLE_BAR
#define MK_SIMPLE_BAR 0
#endif
__device__ __forceinline__ void simple_barrier(unsigned* bar, unsigned& epoch) {
    asm volatile("s_waitcnt vmcnt(0)" ::: "memory");
    __syncthreads();
    if (threadIdx.x == 0) {
        __builtin_amdgcn_fence(__ATOMIC_RELEASE, "agent");
        asm volatile("s_waitcnt vmcnt(0)" ::: "memory");
        (void)xb_add(&bar[XB_TOP], 1u);
        const unsigned target = (epoch + 1u) * gridDim.x;
        XB_SPIN(xb_ld(&bar[XB_TOP]) < target, bar);
        __builtin_amdgcn_fence(__ATOMIC_ACQUIRE, "agent");
        asm volatile("s_waitcnt vmcnt(0)" ::: "memory");
    }
    ++epoch;
    __syncthreads();
}
enum { K_CONVERT = 0, K_MODFINAL, K_NORM, K_UP, K_DOWN, K_WIN, K_P1, K_P2, K_P3, K_WOUT, K_FINAL };
template <int KIND> __device__ __forceinline__ void run_phase(int l_, int sub_, LAS unsigned char* lds) {
    const int l = lsgpr(l_), sub = lsgpr(sub_);
    const KP P = kp_fresh();
    const float* modf = (const float*)(P->ws + WS_MODF);
    bf16_t* HY = (bf16_t*)(P->ws + WS_HY); bf16_t* UU = (bf16_t*)(P->ws + WS_U);
    const bf16_t* Wl = (const bf16_t*)(P->ws + WS_W) + (size_t)l * LW_ELEMS;
    bf16_t* XB = (bf16_t*)P->out; bf16_t* XFIN = (bf16_t*)(P->ws + WS_LRUA);
    const int xf32 = (l == 0 && sub == 0) ? 1 : 0;
    const void* xcur = xf32 ? (const void*)P->in[I_X] : (const void*)XB;
    const int f = sub >> 1;
    if constexpr (KIND == K_CONVERT) phase_convert(P, lds);
    if constexpr (KIND == K_MODFINAL) phase_modfinal(P);
    if constexpr (KIND == K_NORM) phase_norm(P, l, sub, xcur, xf32, lds);
    if constexpr (KIND == K_UP) {
        pg8::Gemm g{HY, Wl + (f ? LW_W13B : LW_W13A), NTOK, 2 * DFF, DM}; pg8::StaticOrder S; S.init(NTOK, 2 * DFF, lgdim(), lbid());
        EpiSwiGLU E{UU};
        pg8::gemm_phase<EpiSwiGLU, pg8::StaticOrder, true, true>(lds, g, S, E);
    }
    if constexpr (KIND == K_DOWN) {
        pg8::Gemm g{UU, Wl + (f ? LW_W2B : LW_W2A), NTOK, DM, DFF}; pg8::StaticOrder S; S.init(NTOK, DM, lgdim(), lbid(), 4);
        EpiResid E{xcur, (l == 1 && sub == 2) ? XFIN : XB, modf + (size_t)l * 8 * NMOD + sub * 6144 + 4096, 0.5f, xf32};
        pg8::gemm_phase<EpiResid, pg8::StaticOrder, true, true>(lds, g, S, E);
    }
    if constexpr (KIND == K_WIN) {
        pg8::Gemm g{HY, Wl + LW_WIN, NTOK, LDU, DM}; pg8::StaticOrder S; S.init(NTOK, LDU, lgdim(), lbid());
        EpiU E{UU};
        pg8::gemm_phase<EpiU, pg8::StaticOrder, true, true>(lds, g, S, E);
    }
    if constexpr (KIND == K_P1) { const int part = P->pad; if (part != 2) p1_rw_lora(P, l, lds); if (part != 1) p1_lru_prep(P, l, lds); }
    if constexpr (KIND == K_P2) {
        for (int it = lbid(); it < 256; it += lgdim()) {
            if (it < 64) { _Pragma("unroll 1") for (int rep = 0; rep < ((MK_REPEAT_ITEM == 0) ? 2 : 1); ++rep) p2_rw(P, l, it, lds); }
            else if (it < 96) { p2_hg(P, l, it - 64, lds); if (MK_REPEAT_ITEM == 1) p2_hg(P, l, it - 64, lds); }
            else if (it < 128) { p2_ml(P, l, it - 96, lds); if (MK_REPEAT_ITEM == 2) p2_ml(P, l, it - 96, lds); }
            else if (it < 192) { p2_lru(P, it - 128, lds); if (MK_REPEAT_ITEM == 3) p2_lru(P, it - 128, lds); }
        }
        if (l == 0) convert_dynamic(P, lds);
    }
    if constexpr (KIND == K_P3) phase_p3(P, l);
    if constexpr (KIND == K_WOUT) {
        pg8::Gemm g{HY, Wl + LW_WOUT, NTOK, DM, DM}; pg8::StaticOrder S; S.init(NTOK, DM, lgdim(), lbid(), 4);
        EpiResid E{XB, XB, modf + (size_t)l * 8 * NMOD + 1 * 6144 + 4096, 1.0f, 0};
        pg8::gemm_phase<EpiResid, pg8::StaticOrder, true, true>(lds, g, S, E);
    }
    if constexpr (KIND == K_FINAL) phase_final_norm(P, XFIN);
}

template <int KIND> __global__ void __launch_bounds__(NTHR, 2) k_phase(Params P_unused, int l, int sub) {
    extern __shared__ __attribute__((aligned(16))) unsigned char lds_raw[];
    run_phase<KIND>(l, sub, (LAS unsigned char*)lds_raw);
}
constexpr int N_PHASES = 27;
__global__ void __launch_bounds__(NTHR, 2) hymba_fwd(Params P_unused) {
    extern __shared__ __attribute__((aligned(16))) unsigned char lds_raw[];
    LAS unsigned char* lds = (LAS unsigned char*)lds_raw;
    const KP P = kp_fresh();
    const int lo = P->ph_lo, hi = P->ph_hi;
    if (threadIdx.x == 0) *(LAS u32x4*)(lds + LDS_BARW) = (u32x4){0u, 0u, 0u, 0u};
    __syncthreads();
    unsigned* barw = (unsigned*)(P->ws + WS_BAR + (size_t)P->li * WS_BAR_STRIDE);
    XcdBarrier bar = xcd_barrier_post(barw, (volatile LAS unsigned*)(lds + LDS_BARW));
#define SEAM(k) do { if ((k) + 1 < hi) xcd_barrier(bar); } while (0)
#define IN(k) (lo <= (k) && (k) < hi)
#define PH(k, KIND, l, sub) do { if (IN(k)) { run_phase<KIND>(l, sub, lds); if ((MK_REPEAT_KIND) == (KIND) || (MK_REPEAT_PHASE) == (k)) { xcd_barrier(bar); run_phase<KIND>(l, sub, lds); } SEAM(k); } } while (0)
    PH(0, K_CONVERT, 0, 0);
    PH(1, K_MODFINAL, 0, 0);
#define LAYER(l, b) \
    PH((b) + 0, K_NORM, l, 0); PH((b) + 1, K_UP, l, 0); PH((b) + 2, K_DOWN, l, 0); \
    PH((b) + 3, K_NORM, l, 1); PH((b) + 4, K_WIN, l, 1); PH((b) + 5, K_P1, l, 1); PH((b) + 6, K_P2, l, 1); PH((b) + 7, K_P3, l, 1); PH((b) + 8, K_WOUT, l, 1); \
    PH((b) + 9, K_NORM, l, 2); PH((b) + 10, K_UP, l, 2); PH((b) + 11, K_DOWN, l, 2);
    LAYER(0, 2)
    LAYER(1, 14)
#undef LAYER
    if (IN(26)) run_phase<K_FINAL>(0, 0, lds);
    {
        unsigned bad = 0u;
        if (IN(26)) { for (int li = 0; li < 32; ++li) bad |= __hip_atomic_load((unsigned*)(P->ws + WS_BAR + (size_t)li * WS_BAR_STRIDE) + XB_TMO, __ATOMIC_RELAXED, __HIP_MEMORY_SCOPE_AGENT); }
        if (bad) { const float qn = __builtin_nanf(""); for (size_t i = (size_t)blockIdx.x * NTHR + threadIdx.x; i < (size_t)NTOK * DM; i += (size_t)gridDim.x * NTHR) P->out[i] = qn; }
    }
#undef PH
#undef IN
#undef SEAM
}

#if 1
template <int KIND> static void launch_phase(const Params& p, int l, int sub, int grid, hipStream_t stream) {
    static bool attr_set = false;
    if (!attr_set) { (void)hipFuncSetAttribute((const void*)k_phase<KIND>, hipFuncAttributeMaxDynamicSharedMemorySize, LDS_BYTES); attr_set = true; }
    hipLaunchKernelGGL(k_phase<KIND>, dim3(grid), dim3(NTHR), LDS_BYTES, stream, p, l, sub);
}
#endif
extern "C" void kernel_launch(void* const* d_in, const int* in_sizes, int n_in, void* d_out, int out_size, void* d_ws, size_t ws_size, hipStream_t stream) {
    static int grid = 0;
    if (grid == 0) {
        if (n_in != N_IN || out_size != NTOK * DM || ws_size < WS_END) { fprintf(stderr, "kernel_launch: unexpected shapes (n_in %d, out %d, ws %zu < %zu)\n", n_in, out_size, ws_size, (size_t)WS_END); grid = -1; return; }
        int dev = 0, cus = 0;
        if (hipGetDevice(&dev) != hipSuccess || hipDeviceGetAttribute(&cus, hipDeviceAttributeMultiprocessorCount, dev) != hipSuccess) { grid = -1; return; }
#if MK_ONE_LAUNCH
        int per_cu = 0;
        if (hipFuncSetAttribute((const void*)hymba_fwd, hipFuncAttributeMaxDynamicSharedMemorySize, LDS_BYTES) != hipSuccess) { fprintf(stderr, "kernel_launch: hipFuncSetAttribute failed\n"); grid = -1; return; }
        if (hipOccupancyMaxActiveBlocksPerMultiprocessor(&per_cu, (const void*)hymba_fwd, NTHR, LDS_BYTES) != hipSuccess || per_cu < 1) fprintf(stderr, "kernel_launch: occupancy query says %d\n", per_cu);
        (void)hipGetLastError();
#endif
        grid = cus;
        if (grid != 256) fprintf(stderr, "kernel_launch: %d CUs (built for 256)\n", grid);
    }
    if (grid < 0) return;
    Params p{};
    for (int i = 0; i < N_IN; ++i) p.in[i] = (const float*)d_in[i];
    p.out = (float*)d_out; p.ws = (unsigned char*)d_ws;
#if MK_ONE_LAUNCH
    (void)hipMemsetAsync((char*)d_ws + WS_BAR, 0, 32 * WS_BAR_STRIDE, stream);
    {
        int lo = 0, li = 0;
        for (int k = 0; k < N_PHASES; ++k) {
            const bool fused = (k + 1 < N_PHASES) && ((MK_FUSE_MASK >> k) & 1ull);
            if (!fused) { p.ph_lo = lo; p.ph_hi = k + 1; p.li = li++; hipLaunchKernelGGL(hymba_fwd, dim3(grid), dim3(NTHR), LDS_BYTES, stream, p); lo = k + 1; }
        }
    }
#else
    (void)hipMemsetAsync((char*)d_ws + WS_BAR, 0, 32 * WS_BAR_STRIDE, stream);
    static bool attr2 = false;
    if (!attr2) { (void)hipFuncSetAttribute((const void*)hymba_fwd, hipFuncAttributeMaxDynamicSharedMemorySize, LDS_BYTES); attr2 = true; }
    int k = 0;
#define LAUNCH(KIND, l, sub) do { if ((MK_KIND_MASK >> (KIND)) & 1) { p.ph_lo = k; p.ph_hi = k + 1; p.li = 0; hipLaunchKernelGGL(hymba_fwd, dim3(grid), dim3(NTHR), LDS_BYTES, stream, p); } \
        else { p.ph_lo = 0; p.ph_hi = 0; launch_phase<KIND>(p, l, sub, grid, stream); } ++k; } while (0)
    LAUNCH(K_CONVERT, 0, 0);
    LAUNCH(K_MODFINAL, 0, 0);
    for (int l = 0; l < 2; ++l)
        for (int sub = 0; sub < 3; ++sub) {
            LAUNCH(K_NORM, l, sub);
            if (sub != 1) { LAUNCH(K_UP, l, sub); LAUNCH(K_DOWN, l, sub); }
            else { LAUNCH(K_WIN, l, sub); {
                   if (MK_P1_SPLIT == 0) { LAUNCH(K_P1, l, sub); }
                   else { const int fa = (MK_P1_SPLIT == 1);
                       p.pad = 1; if (fa) { p.ph_lo = k; p.ph_hi = k + 1; p.li = 0; hipLaunchKernelGGL(hymba_fwd, dim3(grid), dim3(NTHR), LDS_BYTES, stream, p); } else { p.ph_lo = 0; p.ph_hi = 0; launch_phase<K_P1>(p, l, sub, grid, stream); }
                       p.pad = 2; if (!fa) { p.ph_lo = k; p.ph_hi = k + 1; p.li = 0; hipLaunchKernelGGL(hymba_fwd, dim3(grid), dim3(NTHR), LDS_BYTES, stream, p); } else { p.ph_lo = 0; p.ph_hi = 0; launch_phase<K_P1>(p, l, sub, grid, stream); }
                       p.pad = 0; ++k; } } LAUNCH(K_P2, l, sub); LAUNCH(K_P3, l, sub); LAUNCH(K_WOUT, l, sub); }
        }
    LAUNCH(K_FINAL, 0, 0);
#undef LAUNCH
#endif
}
```

```cpp
#include <hip/hip_runtime.h>
#include <cstdio>
#include <cstdint>
__device__ __forceinline__ int ltid() { int t = (int)threadIdx.x; asm volatile("" : "+v"(t)); return t; }
__device__ __forceinline__ int lbid() { int x = (int)blockIdx.x; asm volatile("" : "+s"(x)); return x; }
__device__ __forceinline__ int lgdim() { int x = (int)gridDim.x; asm volatile("" : "+s"(x)); return x; }
__device__ __forceinline__ int lsgpr(int x) { asm volatile("" : "+s"(x)); return x; }
namespace pg8 {
#define PG8_LAS __attribute__((address_space(3)))
typedef unsigned short bf16_t;
typedef short bf16x8 __attribute__((ext_vector_type(8)));
typedef float f32x4 __attribute__((ext_vector_type(4)));
typedef unsigned u32x4 __attribute__((ext_vector_type(4)));
constexpr int BM = 256, BK = 64, HALF = 128, HTB = HALF * BK * 2  , STAGE_BYTES = 8 * HTB, NXCD = 8, WGM = 8;

__host__ __device__ __forceinline__ int lds_byte(int r, int c) { const int st = (r >> 4) * 2 + (c >> 5), rr = r & 15, cc = c & 31, ob = rr * 64 + cc * 2; return st * 1024 + (ob ^ (((ob >> 9) & 1) << 5)); }
__host__ __device__ __forceinline__ void stage_rc(int b, int& R, int& C) { const int st = b / 1024, sb = b % 1024, swz = sb ^ (((sb >> 9) & 1) << 5); R = (st >> 1) * 16 + swz / 64; C = (st & 1) * 32 + (swz % 64) / 2; }
__host__ __device__ __forceinline__ int perm32(int rho) { const int n = rho >> 4, i = rho & 15; return 8 * (i >> 2) + 4 * n + (i & 3); }

struct Unit { int pm, pn; };
struct Gemm { const bf16_t* A; const bf16_t* Bt; int M, N, K; };

struct StaticOrder {
    int nM, nN, nwg, G, c, wgm;
    __host__ __device__ void init(int M, int N, int G_, int c_, int wgm_ = WGM) { nM = M / BM; nN = N / BM; nwg = nM * nN; G = G_; c = c_; wgm = wgm_; }
    __host__ __device__ bool next(int i, Unit& u) const {
        const long L = (long)i * G + c; if (L >= nwg) return false;
        int wgid = (int)L; { const int q = nwg / NXCD, r = nwg % NXCD, xcd = wgid % NXCD, off = wgid / NXCD; wgid = (xcd < r ? xcd * (q + 1) : r * (q + 1) + (xcd - r) * q) + off; }
        const int nig = wgm * nN, gid = wgid / nig, fm = gid * wgm, gsz = (nM - fm) < wgm ? (nM - fm) : wgm;
        u.pm = fm + ((wgid % nig) % gsz); u.pn = (wgid % nig) / gsz; return true;
    }
    __device__ __forceinline__ void a_ready(const Unit&) const {}
    __device__ __forceinline__ void done(const Unit&) const {}
};
template <class Epi, class Sched, bool ALIGN_EPI = false, bool SP2 = false>
__device__ __forceinline__ void gemm_phase(PG8_LAS unsigned char* lds, const Gemm g, const Sched& S, const Epi& E) {
    const int tid = ltid(), wid = __builtin_amdgcn_readfirstlane(tid >> 6), lane = tid & 63, wr = wid >> 2, wc = wid & 3, fr = lane & 15, fq = lane >> 4;
    const int K = g.K, nt = K / BK;
    unsigned voffA[2], voffB[2];
#pragma unroll
    for (int i = 0; i < 2; ++i) { int R, C; stage_rc(tid * 16 + i * 8192, R, C); const int Rb = Epi::PERM ? ((R & ~31) + perm32(R & 31)) : R;
        voffA[i] = (unsigned)(R * K + C) * 2u; voffB[i] = (unsigned)(Rb * K + C) * 2u; }
    const size_t kstep = (size_t)(BK * 2);
    const size_t hstep = (size_t)HALF * K * 2;
    const size_t tstep = 2 * hstep;
    const unsigned ldsw = (unsigned)wid * 1024u;
    const int aoff = lds_byte(wr * 64 + fr, fq * 8), boff = lds_byte(wc * 32 + fr, fq * 8);
#define PG8_SA(b, h) (((b) * 2 + (h)) * HTB)
#define PG8_SB(b, h) ((4 + (b) * 2 + (h)) * HTB)
#define PG8_STAGE(bufoff, gbase, voff) do { _Pragma("unroll") for (int _i = 0; _i < 2; ++_i) \
        __builtin_amdgcn_global_load_lds((const unsigned*)((const char*)(gbase) + (voff)[_i]), (PG8_LAS unsigned*)(lds + (bufoff) + ldsw + _i * 8192), 16, 0, 0); } while (0)
#define PG8_LDA(dst, b, h) do { _Pragma("unroll") for (int m = 0; m < 4; ++m) _Pragma("unroll") for (int k = 0; k < 2; ++k) dst[m][k] = *(const PG8_LAS bf16x8*)(lds + PG8_SA(b, h) + aoff + m * 2048 + k * 1024); } while (0)
#define PG8_LDB(dst, b, h) do { _Pragma("unroll") for (int n = 0; n < 2; ++n) _Pragma("unroll") for (int k = 0; k < 2; ++k) dst[n][k] = *(const PG8_LAS bf16x8*)(lds + PG8_SB(b, h) + boff + n * 2048 + k * 1024); } while (0)
#define PG8_MMA(ai, bj, At, Bt) do { __builtin_amdgcn_s_setprio(1); _Pragma("unroll") for (int m = 0; m < 4; ++m) _Pragma("unroll") for (int n = 0; n < 2; ++n) _Pragma("unroll") for (int k = 0; k < 2; ++k) \
        acc[ai][bj][m][n] = __builtin_amdgcn_mfma_f32_16x16x32_bf16(Bt[n][k], At[m][k], acc[ai][bj][m][n], 0, 0, 0); __builtin_amdgcn_s_setprio(0); } while (0)
#define PG8_WAIT_V(n) asm volatile("s_waitcnt vmcnt(" #n ")" ::: "memory")
#define PG8_WAIT_L(n) asm volatile("s_waitcnt lgkmcnt(" #n ")" ::: "memory")
#define PG8_BAR __builtin_amdgcn_s_barrier()
#define PG8_SCHED __builtin_amdgcn_sched_barrier(0)
    Unit cur, nxt; int ui = 0;
    if (!S.next(0, cur)) return;
    f32x4 acc[2][2][4][2];
#pragma unroll
    for (int a = 0; a < 2; ++a)
#pragma unroll
        for (int b = 0; b < 2; ++b)
#pragma unroll
            for (int m = 0; m < 4; ++m)
#pragma unroll
                for (int n = 0; n < 2; ++n) acc[a][b][m][n] = (f32x4){0.f, 0.f, 0.f, 0.f};
    bf16x8 At[4][2], B0[2][2], B1[2][2];
    const char* cA = (const char*)g.A + (size_t)cur.pm * tstep; const char* cB = (const char*)g.Bt + (size_t)cur.pn * tstep;
    S.a_ready(cur);
    if constexpr (SP2) {
        PG8_STAGE(PG8_SB(0, 0), cB, voffB); PG8_STAGE(PG8_SB(0, 1), cB + hstep, voffB); PG8_STAGE(PG8_SA(0, 0), cA, voffA); PG8_STAGE(PG8_SA(0, 1), cA + hstep, voffA);
        if (wr == 1) PG8_BAR;
        PG8_WAIT_V(2); PG8_BAR;
        PG8_STAGE(PG8_SB(1, 0), cB + kstep, voffB); PG8_STAGE(PG8_SA(1, 0), cA + kstep, voffA); PG8_STAGE(PG8_SB(1, 1), cB + hstep + kstep, voffB);
        PG8_WAIT_V(6); PG8_BAR;
    } else {
        PG8_STAGE(PG8_SB(0, 0), cB, voffB); PG8_STAGE(PG8_SA(0, 0), cA, voffA); PG8_STAGE(PG8_SB(0, 1), cB + hstep, voffB); PG8_STAGE(PG8_SA(0, 1), cA + hstep, voffA);
        if (wr == 1) PG8_BAR;
        PG8_WAIT_V(4); PG8_BAR;
        PG8_STAGE(PG8_SB(1, 0), cB + kstep, voffB); PG8_STAGE(PG8_SA(1, 0), cA + kstep, voffA); PG8_STAGE(PG8_SB(1, 1), cB + hstep + kstep, voffB);
        PG8_WAIT_V(6); PG8_BAR;
    }
    for (;;) {
        const bool has_next = S.next(ui + 1, nxt);
        const char* nA = has_next ? (const char*)g.A + (size_t)nxt.pm * tstep : cA; const char* nB = has_next ? (const char*)g.Bt + (size_t)nxt.pn * tstep : cB;
        for (int t = 0; t < nt; t += 2) {
            const bool last = (t == nt - 2);
            const char* a1 = cA + (size_t)(t + 1) * kstep;
            const char* a2 = last ? nA : cA + (size_t)(t + 2) * kstep; const char* b2 = last ? nB : cB + (size_t)(t + 2) * kstep;
            const char* a3 = a2 + kstep; const char* b3 = b2 + kstep;
            if (last && has_next) S.a_ready(nxt);
            if constexpr (SP2) {
            PG8_LDB(B0, 0, 0); PG8_LDB(B1, 0, 1); PG8_SCHED; PG8_LDA(At, 0, 0); PG8_STAGE(PG8_SA(1, 1), a1 + hstep, voffA);
            PG8_WAIT_V(8); PG8_WAIT_L(0); PG8_BAR; PG8_MMA(0, 0, At, B0); PG8_MMA(0, 1, At, B1); PG8_BAR; PG8_SCHED;
            PG8_LDA(At, 0, 1); PG8_STAGE(PG8_SB(0, 0), b2, voffB); PG8_STAGE(PG8_SB(0, 1), b2 + hstep, voffB); PG8_STAGE(PG8_SA(0, 0), a2, voffA);
            PG8_WAIT_V(8); PG8_WAIT_L(0); PG8_BAR; PG8_MMA(1, 0, At, B0); PG8_MMA(1, 1, At, B1); PG8_BAR; PG8_SCHED;
            PG8_LDB(B0, 1, 0); PG8_LDB(B1, 1, 1); PG8_SCHED; PG8_LDA(At, 1, 0); PG8_STAGE(PG8_SA(0, 1), a2 + hstep, voffA);
            PG8_WAIT_V(8); PG8_WAIT_L(0); PG8_BAR; PG8_MMA(0, 0, At, B0); PG8_MMA(0, 1, At, B1); PG8_BAR; PG8_SCHED;
            PG8_LDA(At, 1, 1); PG8_STAGE(PG8_SB(1, 0), b3, voffB); PG8_STAGE(PG8_SB(1, 1), b3 + hstep, voffB); PG8_STAGE(PG8_SA(1, 0), a3, voffA);
            PG8_WAIT_V(8); PG8_WAIT_L(0); PG8_BAR; PG8_MMA(1, 0, At, B0); PG8_MMA(1, 1, At, B1); PG8_BAR; PG8_SCHED;
            } else {
            PG8_LDB(B0, 0, 0); PG8_SCHED; PG8_LDA(At, 0, 0); PG8_STAGE(PG8_SA(1, 1), a1 + hstep, voffA);
            PG8_WAIT_L(8); PG8_BAR; PG8_WAIT_L(0); PG8_MMA(0, 0, At, B0); PG8_BAR; PG8_SCHED;
            PG8_LDB(B1, 0, 1); PG8_STAGE(PG8_SB(0, 0), b2, voffB);
            PG8_BAR; PG8_WAIT_L(0); PG8_MMA(0, 1, At, B1); PG8_BAR;
            PG8_LDA(At, 0, 1); PG8_STAGE(PG8_SA(0, 0), a2, voffA);
            PG8_BAR; PG8_WAIT_L(0); PG8_MMA(1, 0, At, B0); PG8_BAR; PG8_SCHED;
            PG8_STAGE(PG8_SB(0, 1), b2 + hstep, voffB);
            PG8_WAIT_V(6); PG8_BAR; PG8_MMA(1, 1, At, B1); PG8_BAR;
            PG8_LDB(B0, 1, 0); PG8_SCHED; PG8_LDA(At, 1, 0); PG8_STAGE(PG8_SA(0, 1), a2 + hstep, voffA);
            PG8_WAIT_L(8); PG8_BAR; PG8_WAIT_L(0); PG8_MMA(0, 0, At, B0); PG8_BAR; PG8_SCHED;
            PG8_LDB(B1, 1, 1); PG8_STAGE(PG8_SB(1, 0), b3, voffB);
            PG8_BAR; PG8_WAIT_L(0); PG8_MMA(0, 1, At, B1); PG8_BAR;
            PG8_LDA(At, 1, 1); PG8_STAGE(PG8_SA(1, 0), a3, voffA);
            PG8_BAR; PG8_WAIT_L(0); PG8_MMA(1, 0, At, B0); PG8_BAR; PG8_SCHED;
            PG8_STAGE(PG8_SB(1, 1), b3 + hstep, voffB);
            PG8_WAIT_V(6); PG8_BAR; PG8_MMA(1, 1, At, B1); PG8_BAR;
            }
        }
        if constexpr (ALIGN_EPI) { if (wr == 0) PG8_BAR; }
        if constexpr (!Epi::AFTER_DRAIN) { E(acc, cur, wr, wc, fr, fq); S.done(cur); }
        if (!has_next) break;
#pragma unroll
        for (int a = 0; a < 2; ++a)
#pragma unroll
            for (int b = 0; b < 2; ++b)
#pragma unroll
                for (int m = 0; m < 4; ++m)
#pragma unroll
                    for (int n = 0; n < 2; ++n) acc[a][b][m][n] = (f32x4){0.f, 0.f, 0.f, 0.f};
        cur = nxt; cA = nA; cB = nB; ++ui;
        if constexpr (ALIGN_EPI) { if (wr == 1) PG8_BAR; }
    }
    PG8_WAIT_V(0);
    if constexpr (!ALIGN_EPI) { if (wr == 0) PG8_BAR; }
    PG8_BAR;
    if constexpr (Epi::AFTER_DRAIN) { E.fused(acc, cur, wr, wc, fr, fq, lds, wid, lane); S.done(cur); }
#undef PG8_SA
#undef PG8_SB
#undef PG8_STAGE
#undef PG8_LDA
#undef PG8_LDB
#undef PG8_MMA
#undef PG8_WAIT_V
#undef PG8_WAIT_L
#undef PG8_BAR
#undef PG8_SCHED
}
}
#define XB_TMO      128
#define XB_XCNT(j)  (256  + 64 * (j))
#define XB_XSUB(j)  (1280 + 64 * (j))
#define XB_XGEN(j)  (2304 + 64 * (j))
#define XB_TOP      3328
#define XB_TOPGEN   3392
#define XCD_BAR_WORDS 3456
#define XB_SPIN_CAP (1u << 18)
#define LAS __attribute__((address_space(3)))

__device__ __forceinline__ unsigned xb_ld(unsigned* p)              { return __hip_atomic_load(p, __ATOMIC_RELAXED, __HIP_MEMORY_SCOPE_AGENT); }
__device__ __forceinline__ unsigned xb_add(unsigned* p, unsigned v) { return __hip_atomic_fetch_add(p, v, __ATOMIC_RELAXED, __HIP_MEMORY_SCOPE_AGENT); }
__device__ __forceinline__ unsigned xb_xcc_id() { return (unsigned)__builtin_amdgcn_s_getreg((3 << 11) | 20) & 0xFu; }
#define XB_SPIN(cond, bar) do { unsigned _sp = 0; while (cond) { __builtin_amdgcn_s_sleep(1); \
    if ((++_sp & 255u) == 0u) { if (xb_ld(&(bar)[XB_TMO])) break; if (_sp > XB_SPIN_CAP) { atomicAdd(&(bar)[XB_TMO], 1u); break; } } } } while (0)

struct XcdBarrier {
    unsigned* bar; unsigned x;
    volatile LAS unsigned* st;
};

__device__ __forceinline__ XcdBarrier xcd_barrier_post(unsigned* bar, volatile LAS unsigned* st) {
    XcdBarrier b; b.bar = bar; b.x = xb_xcc_id(); b.st = st;
    if (threadIdx.x == 0) (void)xb_add(&bar[XB_XCNT(b.x)], 1u);
    return b;
}
__device__ __forceinline__ void xcd_barrier_complete(unsigned* bar, unsigned x, unsigned& nloc, unsigned& nx) {
    const unsigned G = gridDim.x * gridDim.y * gridDim.z;
    unsigned sum, cnt, mine, sp = 0u;
    for (;;) {
        sum = 0u; cnt = 0u; mine = 0u;
#pragma unroll
        for (unsigned j = 0; j < 16; ++j) { const unsigned c = xb_ld(&bar[XB_XCNT(j)]); sum += c; cnt += (c > 0u) ? 1u : 0u; mine = (j == x) ? c : mine; }
        if (sum == G) break;
        __builtin_amdgcn_s_sleep(1);
        if ((++sp & 255u) == 0u) { if (xb_ld(&bar[XB_TMO])) break; if (sp > XB_SPIN_CAP) { atomicAdd(&bar[XB_TMO], 1u); break; } }
    }
    nloc = mine > 0u ? mine : 1u; nx = cnt > 0u ? cnt : 1u;
}

__device__ __forceinline__ void xcd_barrier(const XcdBarrier& b) {
    asm volatile("s_waitcnt vmcnt(0)" ::: "memory");
    __syncthreads();
    if (threadIdx.x == 0) {
        unsigned* bar = b.bar;
        __builtin_amdgcn_s_waitcnt(0);
        unsigned nloc = b.st[0], nx = b.st[1];
        if (nloc == 0u) { xcd_barrier_complete(bar, b.x, nloc, nx); b.st[0] = nloc; b.st[1] = nx; }
        const unsigned old = xb_add(&bar[XB_XSUB(b.x)], 1u);
        const unsigned gen = old / nloc;
        if (old + 1u == (gen + 1u) * nloc) {
            __builtin_amdgcn_fence(__ATOMIC_RELEASE, "agent");
            asm volatile("s_waitcnt vmcnt(0)" ::: "memory");
            const unsigned og = xb_add(&bar[XB_TOP], 1u);
            const unsigned tg = og / nx;
            if (og + 1u == (tg + 1u) * nx) xb_add(&bar[XB_TOPGEN], 1u);
            else XB_SPIN(xb_ld(&bar[XB_TOPGEN]) == tg, bar);
            __builtin_amdgcn_fence(__ATOMIC_ACQUIRE, "agent");
            xb_add(&bar[XB_XGEN(b.x)], 1u);
            asm volatile("s_waitcnt vmcnt(0)" ::: "memory");
        } else {
            XB_SPIN(xb_ld(&bar[XB_XGEN(b.x)]) == gen, bar);
            __builtin_amdgcn_fence(__ATOMIC_ACQUIRE, "agent");
            asm volatile("s_waitcnt vmcnt(0)" ::: "memory");
        }
    }
    __syncthreads();
}

typedef unsigned short bf16_t;
typedef short bf16x8 __attribute__((ext_vector_type(8)));
typedef float f32x4 __attribute__((ext_vector_type(4)));
typedef float f32x2 __attribute__((ext_vector_type(2)));
typedef unsigned u32x4 __attribute__((ext_vector_type(4)));
typedef unsigned u32x2 __attribute__((ext_vector_type(2)));

constexpr int NB = 8, SEQ = 4096, DM = 2048, NTOK = NB * SEQ, DFF = 5632, DIN = 6312, LDU = 6400, NMOD = 18432, NTHR = 512;
constexpr int U_HG_Q = 0, U_HG_F = 512, U_HG_I = 1024, U_HG_G = 1536;
constexpr int U_RW_R = 2048, U_RW_K = 2560, U_RW_V = 3072, U_RW_WD = 3584;
constexpr int U_ML_X = 3744, U_ML_V = 4256, U_ML_O = 4768, U_ML_I = 5280, U_ML_F = 5284;
constexpr int U_LRU_X = 5288, U_LRU_G = 5800;
constexpr int RW_IN = 1696;

enum { I_X = 0, I_C, I_GAIN, I_MODW, I_MODB, I_W1, I_W3, I_W2, I_WIN, I_WOUT, I_HGLB, I_HGNORM, I_RWMU, I_RWW0, I_RWW2, I_RWA0, I_RWA2, I_RWG2, I_RWKK, I_RWKA,
       I_RWRK, I_RWLNW, I_RWLNB, I_MLCW, I_MLCB, I_MLWQ, I_MLWK, I_MLIB, I_MLFB, I_MLNORM, I_MLSKIP, I_LRUCW, I_LRUCB, I_LRUWA, I_LRUBA, I_LRUWX, I_LRUBX,
       I_LRULAM, I_LRUNORM, I_FNORM, N_IN };

constexpr size_t WS_BAR = 0;
constexpr size_t WS_BAR_STRIDE = 16384, WS_MODP = 32 * WS_BAR_STRIDE;
constexpr size_t WS_MODF = WS_MODP + (size_t)2 * 16 * 8 * NMOD * 4;
constexpr size_t WS_LRUW = WS_MODF + (size_t)2 * 8 * NMOD * 4;
constexpr size_t WS_W = WS_LRUW + (size_t)2 * 2 * 4 * 16384 * 2;
constexpr size_t LW_W13A = 0, LW_W2A = 23068672, LW_W13B = 34603008, LW_W2B = 57671680, LW_WIN = 69206016, LW_WOUT = 82313216, LW_ELEMS = 86507520;
constexpr size_t WS_HY = WS_W + 2 * LW_ELEMS * 2;
constexpr size_t WS_U = WS_HY + (size_t)NTOK * DM * 2;
constexpr size_t WS_LRUA = WS_U + (size_t)NTOK * LDU * 2;
constexpr size_t WS_LRUB = WS_LRUA + (size_t)NTOK * 512 * 4;
constexpr size_t WS_RWW = WS_LRUB + (size_t)NTOK * 512 * 4;
constexpr size_t WS_RWA = WS_RWW + (size_t)NTOK * 512 * 4;
constexpr size_t WS_RWG = WS_RWA + (size_t)NTOK * 512 * 2;
constexpr size_t WS_LORAT = WS_RWG + (size_t)NTOK * 512 * 2;
constexpr size_t WS_END = WS_LORAT + (size_t)2 * 512 * 160 * 2;

constexpr int LDS_BYTES = 144 * 1024;
constexpr int LDS_BARW = LDS_BYTES - 16;

struct Params { const float* in[N_IN]; float* out; unsigned char* ws; int ph_lo, ph_hi, li, pad; };
typedef const Params __attribute__((address_space(4)))* KP;
__device__ __forceinline__ KP kp_fresh() { KP p = (KP)__builtin_amdgcn_kernarg_segment_ptr(); asm volatile("" : "+s"(p)); return p; }

__device__ __forceinline__ float bflo(unsigned w) { return __uint_as_float(w << 16); }
__device__ __forceinline__ float bfhi(unsigned w) { return __uint_as_float(w & 0xffff0000u); }
__device__ __forceinline__ float bf2f(bf16_t h) { return __uint_as_float(((unsigned)h) << 16); }
typedef __bf16 bf16x2n __attribute__((ext_vector_type(2)));
__device__ __forceinline__ unsigned pk_bf16(float lo, float hi) { const f32x2 v = {lo, hi}; return __builtin_bit_cast(unsigned, __builtin_convertvector(v, bf16x2n)); }
__device__ __forceinline__ void unpack8(const u32x4 w, float (&f)[8]) { f[0] = bflo(w.x); f[1] = bfhi(w.x); f[2] = bflo(w.y); f[3] = bfhi(w.y); f[4] = bflo(w.z); f[5] = bfhi(w.z); f[6] = bflo(w.w); f[7] = bfhi(w.w); }
__device__ __forceinline__ u32x4 pack8(const float (&f)[8]) { u32x4 w; w.x = pk_bf16(f[0], f[1]); w.y = pk_bf16(f[2], f[3]); w.z = pk_bf16(f[4], f[5]); w.w = pk_bf16(f[6], f[7]); return w; }
__device__ __forceinline__ float fast_rcp(float x) { return __builtin_amdgcn_rcpf(x); }
__device__ __forceinline__ float sigmoidf_(float x) { return fast_rcp(1.0f + __expf(-x)); }
__device__ __forceinline__ float siluf_(float x) { return x * sigmoidf_(x); }
__device__ __forceinline__ float softplusf_(float x) { return fmaxf(x, 0.0f) + __logf(1.0f + __expf(-fabsf(x))); }
__device__ __forceinline__ float tanhf_(float x) { const float e = __expf(2.0f * x); return 1.0f - 2.0f * fast_rcp(e + 1.0f); }
__device__ __forceinline__ float gelu_tanhf_(float x) { return 0.5f * x * (1.0f + tanhf_(0.7978845608028654f * (x + 0.044715f * x * x * x))); }
template <int CTRL> __device__ __forceinline__ float dpp_f(float x) { return __int_as_float(__builtin_amdgcn_update_dpp(0, __float_as_int(x), CTRL, 0xF, 0xF, true)); }
__device__ __forceinline__ float wave_scan_sum(float x) {
#define DPP_SC_(v, old, ctrl, rmask) __int_as_float(__builtin_amdgcn_update_dpp(__float_as_int(old), __float_as_int(v), ctrl, rmask, 0xF, false))
    x += DPP_SC_(x, 0.f, 0x111, 0xF); x += DPP_SC_(x, 0.f, 0x112, 0xF); x += DPP_SC_(x, 0.f, 0x114, 0xF); x += DPP_SC_(x, 0.f, 0x118, 0xF);
    x += DPP_SC_(x, 0.f, 0x142, 0xA); x += DPP_SC_(x, 0.f, 0x143, 0xC);
    return x;
}
__device__ __forceinline__ float wave_scan_max(float x) {
    x = fmaxf(x, DPP_SC_(x, x, 0x111, 0xF)); x = fmaxf(x, DPP_SC_(x, x, 0x112, 0xF)); x = fmaxf(x, DPP_SC_(x, x, 0x114, 0xF)); x = fmaxf(x, DPP_SC_(x, x, 0x118, 0xF));
    x = fmaxf(x, DPP_SC_(x, x, 0x142, 0xA)); x = fmaxf(x, DPP_SC_(x, x, 0x143, 0xC));
    return x;
#undef DPP_SC_
}
__device__ __forceinline__ float red8(float x) { x += dpp_f<0xB1>(x); x += dpp_f<0x4E>(x); x += dpp_f<0x141>(x); return x; }
__device__ __forceinline__ float red16(float x) { x = red8(x); x += dpp_f<0x140>(x); return x; }
__device__ __forceinline__ float red64(float x) { x = red16(x); x += __shfl_xor(x, 16); x += __shfl_xor(x, 32); return x; }


#define DPP_ADD4_(CTRL) "v_add_f32_dpp %0, %0, %0 " CTRL " row_mask:0xf bank_mask:0xf bound_ctrl:1\n\t" "v_add_f32_dpp %1, %1, %1 " CTRL " row_mask:0xf bank_mask:0xf bound_ctrl:1\n\t" \
                        "v_add_f32_dpp %2, %2, %2 " CTRL " row_mask:0xf bank_mask:0xf bound_ctrl:1\n\t" "v_add_f32_dpp %3, %3, %3 " CTRL " row_mask:0xf bank_mask:0xf bound_ctrl:1\n\t"
__device__ __forceinline__ void red16x4(float& a, float& b, float& c, float& d) {
    asm volatile("s_nop 4\n\t" DPP_ADD4_("quad_perm:[1,0,3,2]") DPP_ADD4_("quad_perm:[2,3,0,1]") DPP_ADD4_("row_half_mirror") DPP_ADD4_("row_mirror") : "+v"(a), "+v"(b), "+v"(c), "+v"(d));
}

__device__ __forceinline__ void rw1_dots(float s0, float s1, float s2, float s3, const f32x4 ma, const f32x4 wr, float& p1, float& p2) {
    asm volatile(
        "v_mul_f32 %[p1], %[s0], %[ma0]\n\t" "v_mul_f32 %[p2], %[s0], %[wr0]\n\t" "v_fmac_f32 %[p1], %[s1], %[ma1]\n\t" "v_fmac_f32 %[p2], %[s1], %[wr1]\n\t"
        "v_fmac_f32 %[p1], %[s2], %[ma2]\n\t" "v_fmac_f32 %[p2], %[s2], %[wr2]\n\t" "v_fmac_f32 %[p1], %[s3], %[ma3]\n\t" "v_fmac_f32 %[p2], %[s3], %[wr3]\n\t"
        : [p1] "=&v"(p1), [p2] "=&v"(p2)
        : [s0] "v"(s0), [s1] "v"(s1), [s2] "v"(s2), [s3] "v"(s3), [ma0] "v"(ma[0]), [ma1] "v"(ma[1]), [ma2] "v"(ma[2]), [ma3] "v"(ma[3]),
          [wr0] "v"(wr[0]), [wr1] "v"(wr[1]), [wr2] "v"(wr[2]), [wr3] "v"(wr[3]));
}
#define DPP_ADD2_(CTRL, TL) "v_add_f32_dpp %[a], %[a], %[a] " CTRL " row_mask:0xf bank_mask:0xf bound_ctrl:1\n\t" "v_add_f32_dpp %[b], %[b], %[b] " CTRL " row_mask:0xf bank_mask:0xf bound_ctrl:1\n\t" TL
__device__ __forceinline__ void rw1_reduce(float& a, float& b, float v, const f32x4 kp, float& t0, float& t1, float& t2, float& t3) {
    asm volatile("s_nop 4\n\t"
        DPP_ADD2_("quad_perm:[1,0,3,2]", "v_mul_f32 %[t0], %[v], %[kp0]\n\t") DPP_ADD2_("quad_perm:[2,3,0,1]", "v_mul_f32 %[t1], %[v], %[kp1]\n\t")
        DPP_ADD2_("row_half_mirror", "v_mul_f32 %[t2], %[v], %[kp2]\n\t") DPP_ADD2_("row_mirror", "v_mul_f32 %[t3], %[v], %[kp3]\n\t")
        : [a] "+v"(a), [b] "+v"(b), [t0] "=&v"(t0), [t1] "=&v"(t1), [t2] "=&v"(t2), [t3] "=&v"(t3)
        : [v] "v"(v), [kp0] "v"(kp[0]), [kp1] "v"(kp[1]), [kp2] "v"(kp[2]), [kp3] "v"(kp[3]));
}
__device__ __forceinline__ void rw1_update(float& s0, float& s1, float& s2, float& s3, float sa, float t0, float t1, float t2, float t3, const f32x4 wd, const f32x4 bv) {
    asm volatile(
        "v_fmac_f32 %[t0], %[sa], %[bv0]\n\t" "v_fmac_f32 %[t1], %[sa], %[bv1]\n\t" "v_fmac_f32 %[t2], %[sa], %[bv2]\n\t" "v_fmac_f32 %[t3], %[sa], %[bv3]\n\t"
        "v_fma_f32 %[s0], %[s0], %[wd0], %[t0]\n\t" "v_fma_f32 %[s1], %[s1], %[wd1], %[t1]\n\t" "v_fma_f32 %[s2], %[s2], %[wd2], %[t2]\n\t" "v_fma_f32 %[s3], %[s3], %[wd3], %[t3]\n\t"
        : [s0] "+v"(s0), [s1] "+v"(s1), [s2] "+v"(s2), [s3] "+v"(s3), [t0] "+v"(t0), [t1] "+v"(t1), [t2] "+v"(t2), [t3] "+v"(t3)
        : [sa] "v"(sa), [wd0] "v"(wd[0]), [wd1] "v"(wd[1]), [wd2] "v"(wd[2]), [wd3] "v"(wd[3]), [bv0] "v"(bv[0]), [bv1] "v"(bv[1]), [bv2] "v"(bv[2]), [bv3] "v"(bv[3]));
}

#define LDSF(off) ((LAS float*)(lds + (off)))

__device__ __forceinline__ void cvt_tile(const float* __restrict__ src, bf16_t* __restrict__ dst, int K, int N, int kt, int nt, int mode, LAS unsigned char* lds) {
    const int tid = ltid(); LAS float* tile = LDSF(0);
    const int k0 = kt * 64, n0 = nt * 64;
#pragma unroll
    for (int p = 0; p < 2; ++p) {
        const int kk = p * 32 + (tid >> 4), n4 = (tid & 15) * 4;
        f32x4 v = (f32x4){0.f, 0.f, 0.f, 0.f};
        if (n0 + n4 < N) v = *(const f32x4*)(src + (size_t)(k0 + kk) * N + n0 + n4);
        tile[kk * 65 + n4 + 0] = v[0]; tile[kk * 65 + n4 + 1] = v[1]; tile[kk * 65 + n4 + 2] = v[2]; tile[kk * 65 + n4 + 3] = v[3];
    }
    __syncthreads();
    {
        const int nn = tid >> 3, k8 = (tid & 7) * 8, n = n0 + nn;
        float f[8];
#pragma unroll
        for (int j = 0; j < 8; ++j) f[j] = tile[(k8 + j) * 65 + nn];
        const int row = (mode == 0) ? n : ((n >> 7) * 256 + ((mode == 2) ? 128 : 0) + (n & 127));
        *(u32x4*)(dst + (size_t)row * K + k0 + k8) = pack8(f);
    }
    __syncthreads();
}

constexpr int T_FF = 2816, T_WIN = 3200, T_WOUT = 1024, T_LAYER = 6 * T_FF + T_WIN + T_WOUT;
struct CvtTile { const float* src; bf16_t* dst; int K, N, kt, nt, mode; };
__device__ __forceinline__ CvtTile cvt_desc(KP P, int l, int r) {
    bf16_t* Wl = (bf16_t*)(P->ws + WS_W) + (size_t)l * LW_ELEMS;
    CvtTile t;
    if (r < 6 * T_FF) {
        const int m = r / T_FF, q = r % T_FF, f = m / 3, which = m % 3;
        if (which < 2) { t.src = P->in[which == 0 ? I_W1 : I_W3] + (size_t)(l * 2 + f) * DM * DFF; t.dst = Wl + (f ? LW_W13B : LW_W13A); t.K = DM; t.N = DFF; t.kt = q / 88; t.nt = q % 88; t.mode = which + 1; }
        else { t.src = P->in[I_W2] + (size_t)(l * 2 + f) * DFF * DM; t.dst = Wl + (f ? LW_W2B : LW_W2A); t.K = DFF; t.N = DM; t.kt = q / 32; t.nt = q % 32; t.mode = 0; }
    } else if (r < 6 * T_FF + T_WIN) {
        const int q = r - 6 * T_FF;
        t.src = P->in[I_WIN] + (size_t)l * DM * DIN; t.dst = Wl + LW_WIN; t.K = DM; t.N = DIN; t.kt = q / 100; t.nt = q % 100; t.mode = 0;
    } else {
        const int q = r - 6 * T_FF - T_WIN;
        t.src = P->in[I_WOUT] + (size_t)l * DM * DM; t.dst = Wl + LW_WOUT; t.K = DM; t.N = DM; t.kt = q / 32; t.nt = q % 32; t.mode = 0;
    }
    return t;
}
__device__ __forceinline__ void cvt_load(const CvtTile& t, f32x4 (&v)[2]) {
    const int tid = ltid(), n4 = (tid & 15) * 4;
#pragma unroll
    for (int p = 0; p < 2; ++p) {
        const int kk = p * 32 + (tid >> 4);
        v[p] = (f32x4){0.f, 0.f, 0.f, 0.f};
        if (t.nt * 64 + n4 < t.N) v[p] = *(const f32x4*)(t.src + (size_t)(t.kt * 64 + kk) * t.N + t.nt * 64 + n4);
    }
}
__device__ __forceinline__ void cvt_store(const CvtTile& t, const f32x4 (&v)[2], LAS unsigned char* lds) {
    const int tid = ltid(); LAS float* tile = LDSF(0);
#pragma unroll
    for (int p = 0; p < 2; ++p) {
        const int kk = p * 32 + (tid >> 4), n4 = (tid & 15) * 4;
        tile[kk * 65 + n4 + 0] = v[p][0]; tile[kk * 65 + n4 + 1] = v[p][1]; tile[kk * 65 + n4 + 2] = v[p][2]; tile[kk * 65 + n4 + 3] = v[p][3];
    }
    __syncthreads();
    {
        const int nn = tid >> 3, k8 = (tid & 7) * 8, n = t.nt * 64 + nn;
        float f[8];
#pragma unroll
        for (int j = 0; j < 8; ++j) f[j] = tile[(k8 + j) * 65 + nn];
        const int row = (t.mode == 0) ? n : ((n >> 7) * 256 + ((t.mode == 2) ? 128 : 0) + (n & 127));
        *(u32x4*)(t.dst + (size_t)row * t.K + t.kt * 64 + k8) = pack8(f);
    }
    __syncthreads();
}
__device__ __forceinline__ CvtTile cvt_desc_dyn(KP P, int r);
constexpr int T_EARLY = 3 * T_FF + T_WIN, T_LATE0 = 3 * T_FF + T_WOUT, T_DYN = T_LATE0 + T_LAYER;
__device__ __forceinline__ CvtTile cvt_desc_dyn(KP P, int r) {
    if (r < T_LATE0) return cvt_desc(P, 0, (r < 3 * T_FF) ? r + 3 * T_FF : r + 3 * T_FF + T_WIN);
    return cvt_desc(P, 1, r - T_LATE0);
}
__device__ __forceinline__ void convert_dynamic(KP P, LAS unsigned char* lds) {
    unsigned* ctr = (unsigned*)(P->ws + WS_BAR + (size_t)31 * WS_BAR_STRIDE);
    LAS unsigned* sh = (LAS unsigned*)(lds + 32768);
    const int tid = ltid();
    for (;;) {
        __syncthreads();
        if (tid == 0) *sh = __hip_atomic_fetch_add(ctr, 8u, __ATOMIC_RELAXED, __HIP_MEMORY_SCOPE_AGENT);
        __syncthreads();
        const int base = (int)*sh;
        if (base >= T_DYN) break;
        const int end = (base + 8 < T_DYN) ? base + 8 : T_DYN;
        CvtTile cur = cvt_desc_dyn(P, base); f32x4 v[2]; cvt_load(cur, v);
        for (int r = base; r < end; ++r) {
            CvtTile nxt = cur; f32x4 w[2] = {v[0], v[1]};
            if (r + 1 < end) { nxt = cvt_desc_dyn(P, r + 1); cvt_load(nxt, w); }
            cvt_store(cur, v, lds);
            cur = nxt; v[0] = w[0]; v[1] = w[1];
        }
    }
}
__device__ __forceinline__ void phase_convert(KP P, LAS unsigned char* lds) {
    const int tid = ltid(), wg = lbid(), nwg = lgdim();
    constexpr int T_BIG = 0, T_LRU = 64, T_MOD = 2 * 36 * 16;
    if (wg < T_EARLY) {
        CvtTile cur = cvt_desc(P, 0, (wg < 3 * T_FF) ? wg : wg + 3 * T_FF); f32x4 v[2]; cvt_load(cur, v);
        for (int r = wg; r < T_EARLY; r += nwg) {
            CvtTile nxt = cur; f32x4 w[2] = {v[0], v[1]};
            const int rn = r + nwg;
            if (rn < T_EARLY) { nxt = cvt_desc(P, 0, (rn < 3 * T_FF) ? rn : rn + 3 * T_FF); cvt_load(nxt, w); }
            cvt_store(cur, v, lds);
            cur = nxt; v[0] = w[0]; v[1] = w[1];
        }
    }
    {
        bf16_t* LT = (bf16_t*)(P->ws + WS_LORAT);
        for (int e = wg * NTHR + tid; e < 2 * 512 * 160; e += nwg * NTHR) {
            const int l = e / 81920, r = e % 81920, ch = r / 160, j = r % 160;
            const float v = (j < 32) ? P->in[I_RWW2][(size_t)(l * 32 + j) * 512 + ch] : ((j < 64) ? P->in[I_RWA2][(size_t)(l * 32 + j - 32) * 512 + ch] : P->in[I_RWG2][(size_t)(l * 96 + j - 64) * 512 + ch]);
            LT[e] = (bf16_t)(pk_bf16(v, 0.f) & 0xffffu);
        }
    }
    for (int it = wg; it < T_BIG + T_LRU + T_MOD; it += nwg) {
        if (false) {
        } else if (it < T_BIG + T_LRU) {
            const int q = it - T_BIG, m16 = q >> 2, tl = q & 3, l = m16 >> 3, which = (m16 >> 2) & 1, blk = m16 & 3;
            const float* src = P->in[which ? I_LRUWX : I_LRUWA] + (size_t)(l * 4 + blk) * 16384;
            bf16_t* dst = (bf16_t*)(P->ws + WS_LRUW) + (size_t)((l * 2 + which) * 4 + blk) * 16384;
            cvt_tile(src, dst, 128, 128, tl >> 1, tl & 1, 0, lds);
        } else {
            const int m = it - T_BIG - T_LRU, l = m / 576, r = m % 576, jb = r / 16, ks = r % 16;
            LAS float* cact = LDSF(0);
#pragma unroll
            for (int e2 = 0; e2 < 2; ++e2) { const int e = tid * 2 + e2, kk = e >> 3, b = e & 7; cact[e] = siluf_(P->in[I_C][b * DM + ks * 128 + kk]); }
            __syncthreads();
            const int j = jb * 512 + tid;
            const float* wp = P->in[I_MODW] + (size_t)l * DM * NMOD + (size_t)(ks * 128) * NMOD + j;
            float acc[8];
#pragma unroll
            for (int b = 0; b < 8; ++b) acc[b] = 0.f;
#pragma unroll 32
            for (int kk = 0; kk < 128; ++kk) {
                const float w = wp[(size_t)kk * NMOD];
                const f32x4 c0 = *(const LAS f32x4*)(cact + kk * 8), c1 = *(const LAS f32x4*)(cact + kk * 8 + 4);
                acc[0] += c0[0] * w; acc[1] += c0[1] * w; acc[2] += c0[2] * w; acc[3] += c0[3] * w;
                acc[4] += c1[0] * w; acc[5] += c1[1] * w; acc[6] += c1[2] * w; acc[7] += c1[3] * w;
            }
            float* mp = (float*)(P->ws + WS_MODP) + (size_t)((l * 16 + ks) * 8) * NMOD + j;
#pragma unroll
            for (int b = 0; b < 8; ++b) mp[(size_t)b * NMOD] = acc[b];
            __syncthreads();
        }
    }
}

__device__ __forceinline__ void phase_modfinal(KP P) {
    const float* mp = (const float*)(P->ws + WS_MODP); float* mf = (float*)(P->ws + WS_MODF);
    for (int i = lbid() * NTHR + ltid(); i < 2 * 8 * NMOD; i += lgdim() * NTHR) {
        const int l = i / (8 * NMOD), r = i % (8 * NMOD), b = r / NMOD, j = r % NMOD;
        float s = P->in[I_MODB][l * NMOD + j];
#pragma unroll
        for (int ks = 0; ks < 16; ++ks) s += mp[(size_t)((l * 16 + ks) * 8 + b) * NMOD + j];
        mf[i] = s;
    }
}

__device__ __forceinline__ void phase_norm(KP P, int l, int sub, const void* __restrict__ xsrc, int xf32, LAS unsigned char* lds) {
    const int tid = ltid(), lane = tid & 63, wave = tid >> 6;
    bf16_t* H = (bf16_t*)(P->ws + WS_HY);
    LAS float* cv = LDSF(0); LAS float* sv = LDSF(8192);
    for (int rb = lbid(); rb < NTOK / 128; rb += lgdim()) {
        const int b = rb >> 5;
        const float* mod = (const float*)(P->ws + WS_MODF) + (size_t)(l * 8 + b) * NMOD + sub * 6144;
        __syncthreads();
        for (int d = tid; d < DM; d += NTHR) { cv[d] = P->in[I_GAIN][(l * 3 + sub) * DM + d] * (1.0f + mod[2048 + d]); sv[d] = mod[d]; }
        __syncthreads();
        if (xf32) {
            for (int rr = 0; rr < 16; ++rr) {
                const int row = rb * 128 + wave * 16 + rr;
                const float* xr = (const float*)xsrc + (size_t)row * DM;
                f32x4 v[8]; float ss = 0.f;
#pragma unroll
                for (int i = 0; i < 8; ++i) { v[i] = *(const f32x4*)(xr + i * 256 + lane * 4); ss += v[i][0] * v[i][0] + v[i][1] * v[i][1] + v[i][2] * v[i][2] + v[i][3] * v[i][3]; }
                ss = red64(ss);
                const float rstd = rsqrtf(ss * (1.0f / DM) + 1e-6f);
#pragma unroll
                for (int i = 0; i < 8; ++i) {
                    const int d = i * 256 + lane * 4;
                    const f32x4 c = *(const LAS f32x4*)(cv + d), s = *(const LAS f32x4*)(sv + d);
                    u32x2 w; w.x = pk_bf16(v[i][0] * rstd * c[0] + s[0], v[i][1] * rstd * c[1] + s[1]); w.y = pk_bf16(v[i][2] * rstd * c[2] + s[2], v[i][3] * rstd * c[3] + s[3]);
                    *(u32x2*)(H + (size_t)row * DM + d) = w;
                }
            }
        } else {
            for (int rr = 0; rr < 16; ++rr) {
                const int row = rb * 128 + wave * 16 + rr;
                const bf16_t* xr = (const bf16_t*)xsrc + (size_t)row * DM;
                u32x4 xw[4]; float ss = 0.f;
#pragma unroll
                for (int i = 0; i < 4; ++i) xw[i] = *(const u32x4*)(xr + i * 512 + lane * 8);
                float v[4][8];
#pragma unroll
                for (int i = 0; i < 4; ++i) {
                    unpack8(xw[i], v[i]);
#pragma unroll
                    for (int j = 0; j < 8; ++j) ss += v[i][j] * v[i][j];
                }
                ss = red64(ss);
                const float rstd = rsqrtf(ss * (1.0f / DM) + 1e-6f);
#pragma unroll
                for (int i = 0; i < 4; ++i) {
                    const int d = i * 512 + lane * 8;
                    const f32x4 c0 = *(const LAS f32x4*)(cv + d), c1 = *(const LAS f32x4*)(cv + d + 4), s0 = *(const LAS f32x4*)(sv + d), s1 = *(const LAS f32x4*)(sv + d + 4);
                    float o[8];
#pragma unroll
                    for (int j = 0; j < 4; ++j) { o[j] = v[i][j] * rstd * c0[j] + s0[j]; o[4 + j] = v[i][4 + j] * rstd * c1[j] + s1[j]; }
                    *(u32x4*)(H + (size_t)row * DM + d) = pack8(o);
                }
            }
        }
    }
}

__device__ __forceinline__ void phase_final_norm(KP P, const bf16_t* __restrict__ X) {
    const int tid = ltid(), lane = tid & 63, wave = tid >> 6;
    const float* fn = P->in[I_FNORM];
    for (int row = lbid() * 8 + wave; row < NTOK; row += lgdim() * 8) {
        const bf16_t* xr = X + (size_t)row * DM; float* orow = P->out + (size_t)row * DM;
        u32x4 xw[4]; float ss = 0.f;
#pragma unroll
        for (int i = 0; i < 4; ++i) xw[i] = *(const u32x4*)(xr + i * 512 + lane * 8);
        float v[4][8];
#pragma unroll
        for (int i = 0; i < 4; ++i) {
            unpack8(xw[i], v[i]);
#pragma unroll
            for (int j = 0; j < 8; ++j) ss += v[i][j] * v[i][j];
        }
        ss = red64(ss);
        const float rstd = rsqrtf(ss * (1.0f / DM) + 1e-6f);
#pragma unroll
        for (int i = 0; i < 4; ++i) {
            const int d = i * 512 + lane * 8;
            const f32x4 g0 = *(const f32x4*)(fn + d), g1 = *(const f32x4*)(fn + d + 4);
            f32x4 o0, o1;
#pragma unroll
            for (int j = 0; j < 4; ++j) { o0[j] = v[i][j] * rstd * g0[j]; o1[j] = v[i][4 + j] * rstd * g1[j]; }
            *(f32x4*)(orow + d) = o0; *(f32x4*)(orow + d + 4) = o1;
        }
    }
}

struct EpiSwiGLU {
    static constexpr bool PERM = true, AFTER_DRAIN = false;
    bf16_t* G;
    __device__ __forceinline__ void operator()(const pg8::f32x4 (&acc)[2][2][4][2], const pg8::Unit& u, int wr, int wc, int fr, int fq) const {
        const int row0 = u.pm * 256 + wr * 64 + fr, col0 = u.pn * 128 + wc * 32 + 8 * fq;
#pragma unroll
        for (int ai = 0; ai < 2; ++ai)
#pragma unroll
            for (int m = 0; m < 4; ++m) {
                float o[8];
#pragma unroll
                for (int n = 0; n < 2; ++n)
#pragma unroll
                    for (int j = 0; j < 4; ++j) { const float g = acc[ai][0][m][n][j]; o[n * 4 + j] = g * fast_rcp(1.0f + __expf(-g)) * acc[ai][1][m][n][j]; }
                *(u32x4*)(G + (size_t)(row0 + ai * 128 + m * 16) * DFF + col0) = pack8(o);
            }
    }
};
struct EpiResid {
    static constexpr bool PERM = false, AFTER_DRAIN = false;
    const void* xin; bf16_t* xout; const float* gate; float coef; int xf32;
    __device__ __forceinline__ void operator()(const pg8::f32x4 (&acc)[2][2][4][2], const pg8::Unit& u, int wr, int wc, int fr, int fq) const {
        const int row0 = u.pm * 256 + wr * 64 + fr, col0 = u.pn * 256 + wc * 32 + 4 * fq, b = u.pm >> 4;
        f32x4 gv[2][2];
#pragma unroll
        for (int bj = 0; bj < 2; ++bj)
#pragma unroll
            for (int n = 0; n < 2; ++n) gv[bj][n] = (*(const f32x4*)(gate + (size_t)b * NMOD + col0 + bj * 128 + n * 16) + 1.0f) * coef;
#pragma unroll
        for (int ai = 0; ai < 2; ++ai) {
            if (xf32) {
                const float* xi = (const float*)xin;
                f32x4 xv[4][2][2];
#pragma unroll
                for (int m = 0; m < 4; ++m)
#pragma unroll
                    for (int bj = 0; bj < 2; ++bj)
#pragma unroll
                        for (int n = 0; n < 2; ++n) xv[m][bj][n] = *(const f32x4*)(xi + (size_t)(row0 + ai * 128 + m * 16) * DM + col0 + bj * 128 + n * 16);
#pragma unroll
                for (int m = 0; m < 4; ++m)
#pragma unroll
                    for (int bj = 0; bj < 2; ++bj)
#pragma unroll
                        for (int n = 0; n < 2; ++n) {
                            const f32x4 r = xv[m][bj][n] + gv[bj][n] * acc[ai][bj][m][n];
                            u32x2 w; w.x = pk_bf16(r[0], r[1]); w.y = pk_bf16(r[2], r[3]);
                            *(u32x2*)(xout + (size_t)(row0 + ai * 128 + m * 16) * DM + col0 + bj * 128 + n * 16) = w;
                        }
            } else {
                const bf16_t* xi = (const bf16_t*)xin;
                u32x2 xw[4][2][2];
#pragma unroll
                for (int m = 0; m < 4; ++m)
#pragma unroll
                    for (int bj = 0; bj < 2; ++bj)
#pragma unroll
                        for (int n = 0; n < 2; ++n) xw[m][bj][n] = *(const u32x2*)(xi + (size_t)(row0 + ai * 128 + m * 16) * DM + col0 + bj * 128 + n * 16);
#pragma unroll
                for (int m = 0; m < 4; ++m)
#pragma unroll
                    for (int bj = 0; bj < 2; ++bj)
#pragma unroll
                        for (int n = 0; n < 2; ++n) {
                            const f32x4 xv = (f32x4){bflo(xw[m][bj][n].x), bfhi(xw[m][bj][n].x), bflo(xw[m][bj][n].y), bfhi(xw[m][bj][n].y)};
                            const f32x4 r = xv + gv[bj][n] * acc[ai][bj][m][n];
                            u32x2 w; w.x = pk_bf16(r[0], r[1]); w.y = pk_bf16(r[2], r[3]);
                            *(u32x2*)(xout + (size_t)(row0 + ai * 128 + m * 16) * DM + col0 + bj * 128 + n * 16) = w;
                        }
            }
        }
    }
};
struct EpiU {
    static constexpr bool PERM = true, AFTER_DRAIN = false;
    bf16_t* U;
    __device__ __forceinline__ void operator()(const pg8::f32x4 (&acc)[2][2][4][2], const pg8::Unit& u, int wr, int wc, int fr, int fq) const {
        const int row0 = u.pm * 256 + wr * 64 + fr, col0 = u.pn * 256 + wc * 32 + 8 * fq;
#pragma unroll
        for (int ai = 0; ai < 2; ++ai)
#pragma unroll
            for (int m = 0; m < 4; ++m)
#pragma unroll
                for (int bj = 0; bj < 2; ++bj) {
                    u32x4 w; w.x = pk_bf16(acc[ai][bj][m][0][0], acc[ai][bj][m][0][1]); w.y = pk_bf16(acc[ai][bj][m][0][2], acc[ai][bj][m][0][3]);
                    w.z = pk_bf16(acc[ai][bj][m][1][0], acc[ai][bj][m][1][1]); w.w = pk_bf16(acc[ai][bj][m][1][2], acc[ai][bj][m][1][3]);
                    *(u32x4*)(U + (size_t)(row0 + ai * 128 + m * 16) * LDU + col0 + bj * 128) = w;
                }
    }
};

__device__ __forceinline__ void p1_rw_lora(KP P, int l, LAS unsigned char* lds) {
    const int tid = ltid(), lane = tid & 63, wave = tid >> 6, fq = lane >> 4, fr = lane & 15, half = lbid() & 1;
    const bf16_t* U = (const bf16_t*)(P->ws + WS_U);
    float* RWW = (float*)(P->ws + WS_RWW); bf16_t* RWA = (bf16_t*)(P->ws + WS_RWA); bf16_t* RWG = (bf16_t*)(P->ws + WS_RWG);
    constexpr int O_WT = 0, O_ACT = 256 * 168 * 2, LDW = 168;
    const float* mu = P->in[I_RWMU] + l * RW_IN + 1536;
    __syncthreads();
    {
        const bf16_t* LT = (const bf16_t*)(P->ws + WS_LORAT) + (size_t)(l * 512 + half * 256) * 160;
#pragma unroll 2
        for (int e = tid; e < 256 * 20; e += NTHR) { const int ch = e / 20, c = e % 20; *(LAS u32x4*)(lds + O_WT + (ch * LDW + c * 8) * 2) = *(const u32x4*)(LT + (size_t)ch * 160 + c * 8); }
    }
    float w0[2], a0[2];
#pragma unroll
    for (int q = 0; q < 2; ++q) { const int ch = half * 256 + (wave * 2 + q) * 16 + fr; w0[q] = P->in[I_RWW0][l * 512 + ch]; a0[q] = P->in[I_RWA0][l * 512 + ch]; }
    u32x4 pc[3], pp[3];
#define LORA_PREFETCH(tt_) do { _Pragma("unroll") for (int i = 0; i < 3; ++i) { const int e_ = tid + i * NTHR; if (e_ < 1280) { const int tk_ = e_ / 20, c_ = e_ % 20, tok_ = (tt_) * 64 + tk_; \
        const bf16_t* uc_ = U + (size_t)tok_ * LDU + U_RW_WD + c_ * 8; pc[i] = *(const u32x4*)uc_; pp[i] = *(const u32x4*)((tok_ & (SEQ - 1)) ? uc_ - LDU : uc_); } } } while (0)
    const int tstep = lgdim() >> 1;
    if ((lbid() >> 1) < NTOK / 64) LORA_PREFETCH(lbid() >> 1);
    for (int tt = lbid() >> 1; tt < NTOK / 64; tt += tstep) {
        const int tok0 = tt * 64;
        __syncthreads();
#pragma unroll
        for (int i = 0; i < 3; ++i) {
            const int e = tid + i * NTHR;
            if (e < 1280) {
                const int tk = e / 20, c = e % 20, tok = tok0 + tk;
                float cur[8], prv[8], av[8]; unpack8(pc[i], cur); unpack8(pp[i], prv);
                const float pf = (tok & (SEQ - 1)) ? 1.0f : 0.0f;
                const f32x4 m0 = *(const f32x4*)(mu + c * 8), m1 = *(const f32x4*)(mu + c * 8 + 4);
#pragma unroll
                for (int j = 0; j < 8; ++j) {
                    const float v = cur[j] + (prv[j] * pf - cur[j]) * ((j < 4) ? m0[j & 3] : m1[j & 3]);
                    av[j] = (c < 4) ? tanhf_(v) : ((c < 8) ? v : sigmoidf_(v));
                }
                *(LAS u32x4*)(lds + O_ACT + (tk * LDW + c * 8) * 2) = pack8(av);
            }
        }
        if (tt + tstep < NTOK / 64) LORA_PREFETCH(tt + tstep);
        __syncthreads();
#pragma unroll
        for (int q = 0; q < 2; ++q) {
            const int nrow = (wave * 2 + q) * 16 + fr;
            const bf16x8 bw = *(const LAS bf16x8*)(lds + O_WT + (nrow * LDW + fq * 8) * 2), ba = *(const LAS bf16x8*)(lds + O_WT + (nrow * LDW + 32 + fq * 8) * 2);
            const bf16x8 bg0 = *(const LAS bf16x8*)(lds + O_WT + (nrow * LDW + 64 + fq * 8) * 2), bg1 = *(const LAS bf16x8*)(lds + O_WT + (nrow * LDW + 96 + fq * 8) * 2), bg2 = *(const LAS bf16x8*)(lds + O_WT + (nrow * LDW + 128 + fq * 8) * 2);
            const int ch = half * 256 + (wave * 2 + q) * 16 + fr;
#pragma unroll
            for (int mi = 0; mi < 4; ++mi) {
                const int arow = mi * 16 + fr;
                const bf16x8 aw = *(const LAS bf16x8*)(lds + O_ACT + (arow * LDW + fq * 8) * 2), aa = *(const LAS bf16x8*)(lds + O_ACT + (arow * LDW + 32 + fq * 8) * 2);
                const bf16x8 ag0 = *(const LAS bf16x8*)(lds + O_ACT + (arow * LDW + 64 + fq * 8) * 2), ag1 = *(const LAS bf16x8*)(lds + O_ACT + (arow * LDW + 96 + fq * 8) * 2), ag2 = *(const LAS bf16x8*)(lds + O_ACT + (arow * LDW + 128 + fq * 8) * 2);
                const f32x4 z = (f32x4){0.f, 0.f, 0.f, 0.f};
                const f32x4 cw = __builtin_amdgcn_mfma_f32_16x16x32_bf16(aw, bw, z, 0, 0, 0);
                const f32x4 ca = __builtin_amdgcn_mfma_f32_16x16x32_bf16(aa, ba, z, 0, 0, 0);
                f32x4 cg = __builtin_amdgcn_mfma_f32_16x16x32_bf16(ag0, bg0, z, 0, 0, 0);
                cg = __builtin_amdgcn_mfma_f32_16x16x32_bf16(ag1, bg1, cg, 0, 0, 0);
                cg = __builtin_amdgcn_mfma_f32_16x16x32_bf16(ag2, bg2, cg, 0, 0, 0);
#pragma unroll
                for (int rg = 0; rg < 4; ++rg) {
                    const size_t o = (size_t)(tok0 + mi * 16 + fq * 4 + rg) * 512 + ch;
                    const float wlog = -softplusf_(-(w0[q] + cw[rg])) - 0.5f;
                    RWW[o] = __expf(-__expf(wlog));
                    RWA[o] = (bf16_t)(pk_bf16(sigmoidf_(a0[q] + ca[rg]), 0.f) & 0xffffu);
                    RWG[o] = (bf16_t)(pk_bf16(cg[rg], 0.f) & 0xffffu);
                }
            }
        }
    }
}

#undef LORA_PREFETCH
__device__ __forceinline__ void p1_lru_prep(KP P, int l, LAS unsigned char* lds) {
    const int tid = ltid(), lane = tid & 63, wave = tid >> 6, wg = lbid(), nwg = lgdim();
    const bf16_t* U = (const bf16_t*)(P->ws + WS_U);
    float* LA = (float*)(P->ws + WS_LRUA); float* LB = (float*)(P->ws + WS_LRUB);
    constexpr int O_WA = 0, O_WX = 34816, O_XC = 69632, O_XF = 87040;
    const int n = wg & 3;
    __syncthreads();
    {
        const bf16_t* wa = (const bf16_t*)(P->ws + WS_LRUW) + (size_t)((l * 2 + 0) * 4 + n) * 16384;
        const bf16_t* wx = (const bf16_t*)(P->ws + WS_LRUW) + (size_t)((l * 2 + 1) * 4 + n) * 16384;
#pragma unroll
        for (int e4 = 0; e4 < 4; ++e4) {
            const int e = tid + e4 * NTHR, j = e >> 4, i8 = (e & 15) * 8;
            *(LAS u32x4*)(lds + O_WA + (j * 136 + i8) * 2) = *(const u32x4*)(wa + j * 128 + i8);
            *(LAS u32x4*)(lds + O_WX + (j * 136 + i8) * 2) = *(const u32x4*)(wx + j * 128 + i8);
        }
    }
    const int jloc = wave * 16 + (lane & 15), cg = n * 128 + jloc, fq = lane >> 4;
    const float ba = P->in[I_LRUBA][l * 512 + cg], bx = P->in[I_LRUBX][l * 512 + cg], sp8 = 8.0f * softplusf_(-P->in[I_LRULAM][l * 512 + cg]);
    const int tk = tid >> 3, c16 = (tid & 7) * 16;
    const float* cw = P->in[I_LRUCW] + l * 2048 + n * 128 + c16;
    const float* cb = P->in[I_LRUCB] + l * 512 + n * 128 + c16;
    u32x4 pr[4][2];
#define LRU_PREFETCH(tt_) do { const int tok_ = (tt_) * 64 + tk, ts_ = tok_ & (SEQ - 1); _Pragma("unroll") for (int jj = 0; jj < 4; ++jj) { \
        const bf16_t* up_ = U + (size_t)(((ts_ - 3 + jj) >= 0) ? tok_ - 3 + jj : tok_) * LDU + U_LRU_X + n * 128 + c16; pr[jj][0] = *(const u32x4*)up_; pr[jj][1] = *(const u32x4*)(up_ + 8); } } while (0)
    const int tstep = nwg >> 2;
    if ((wg >> 2) < NTOK / 64) LRU_PREFETCH(wg >> 2);
    for (int tt = wg >> 2; tt < NTOK / 64; tt += tstep) {
        const int tok0 = tt * 64, tok = tok0 + tk, tseq = tok & (SEQ - 1);
        float xc[16];
#pragma unroll
        for (int q = 0; q < 4; ++q) { const f32x4 c = *(const f32x4*)(cb + q * 4); xc[q * 4 + 0] = c[0]; xc[q * 4 + 1] = c[1]; xc[q * 4 + 2] = c[2]; xc[q * 4 + 3] = c[3]; }
#pragma unroll
        for (int jj = 0; jj < 4; ++jj) {
            const bool valid = (tseq - 3 + jj) >= 0;
            float x[16]; { float t0[8], t1[8]; unpack8(pr[jj][0], t0); unpack8(pr[jj][1], t1);
#pragma unroll
                for (int j = 0; j < 8; ++j) { x[j] = t0[j]; x[8 + j] = t1[j]; } }
            const float vf = valid ? 1.0f : 0.0f;
#pragma unroll
            for (int q = 0; q < 4; ++q) { const f32x4 w = *(const f32x4*)(cw + jj * 512 + q * 4);
                xc[q * 4 + 0] += vf * w[0] * x[q * 4 + 0]; xc[q * 4 + 1] += vf * w[1] * x[q * 4 + 1]; xc[q * 4 + 2] += vf * w[2] * x[q * 4 + 2]; xc[q * 4 + 3] += vf * w[3] * x[q * 4 + 3]; }
        }
        __syncthreads();
        {
            float a8[8], b8[8];
#pragma unroll
            for (int j = 0; j < 8; ++j) { a8[j] = xc[j]; b8[j] = xc[8 + j]; }
            *(LAS u32x4*)(lds + O_XC + (tk * 136 + c16) * 2) = pack8(a8);
            *(LAS u32x4*)(lds + O_XC + (tk * 136 + c16 + 8) * 2) = pack8(b8);
#pragma unroll
            for (int q = 0; q < 4; ++q) *(LAS f32x4*)(lds + O_XF + (tk * 132 + c16 + q * 4) * 4) = (f32x4){xc[q * 4], xc[q * 4 + 1], xc[q * 4 + 2], xc[q * 4 + 3]};
        }
        __syncthreads();
        if (tt + tstep < NTOK / 64) LRU_PREFETCH(tt + tstep);
        f32x4 accA[4], accX[4];
#pragma unroll
        for (int mi = 0; mi < 4; ++mi) { accA[mi] = (f32x4){0.f, 0.f, 0.f, 0.f}; accX[mi] = (f32x4){0.f, 0.f, 0.f, 0.f}; }
#pragma unroll
        for (int kk = 0; kk < 4; ++kk) {
            const bf16x8 fa = *(const LAS bf16x8*)(lds + O_WA + (jloc * 136 + kk * 32 + fq * 8) * 2);
            const bf16x8 fx = *(const LAS bf16x8*)(lds + O_WX + (jloc * 136 + kk * 32 + fq * 8) * 2);
#pragma unroll
            for (int mi = 0; mi < 4; ++mi) {
                const bf16x8 xa = *(const LAS bf16x8*)(lds + O_XC + ((mi * 16 + (lane & 15)) * 136 + kk * 32 + fq * 8) * 2);
                accA[mi] = __builtin_amdgcn_mfma_f32_16x16x32_bf16(xa, fa, accA[mi], 0, 0, 0);
                accX[mi] = __builtin_amdgcn_mfma_f32_16x16x32_bf16(xa, fx, accX[mi], 0, 0, 0);
            }
        }
#pragma unroll
        for (int mi = 0; mi < 4; ++mi)
#pragma unroll
            for (int rg = 0; rg < 4; ++rg) {
                const int t = mi * 16 + fq * 4 + rg;
                const float xv = *(const LAS float*)(lds + O_XF + (t * 132 + jloc) * 4);
                const float r = sigmoidf_(accA[mi][rg] + ba), ig = sigmoidf_(accX[mi][rg] + bx);
                const float la = -r * sp8;
                const size_t o = (size_t)(tok0 + t) * 512 + cg;
                LA[o] = __expf(la);
                LB[o] = sqrtf(fmaxf(-expm1f(2.0f * la), 0.0f)) * (ig * xv);
            }
    }
}

#undef LRU_PREFETCH
__device__ __forceinline__ bf16x8 rw_op16(LAS unsigned char* lds, int off) { return *(const LAS bf16x8*)(lds + off); }
__device__ __forceinline__ bf16x8 rw_op8x2(LAS unsigned char* lds, int off0, int off1) { const u32x2 lo = *(const LAS u32x2*)(lds + off0), hi = *(const LAS u32x2*)(lds + off1); const u32x4 w = (u32x4){lo.x, lo.y, hi.x, hi.y}; return __builtin_bit_cast(bf16x8, w); }
__device__ __forceinline__ bf16x8 rw_accop(const f32x4 a, const f32x4 b) { u32x4 w; w.x = pk_bf16(a[0], a[1]); w.y = pk_bf16(a[2], a[3]); w.z = pk_bf16(b[0], b[1]); w.w = pk_bf16(b[2], b[3]); return __builtin_bit_cast(bf16x8, w); }
#define RW_MFMA(a, b, c) __builtin_amdgcn_mfma_f32_16x16x32_bf16(a, b, c, 0, 0, 0)
__device__ __forceinline__ void p2_rw(KP P, int l, int item, LAS unsigned char* lds) {
    const int tid = ltid(), lane = tid & 63, wave = tid >> 6, b = item >> 3, h = item & 7;
    const int fr = lane & 15, fq = lane >> 4, st = tid >> 3, sc = (tid & 7) * 8;
    const bf16_t* U = (const bf16_t*)(P->ws + WS_U);
    const float* RWW = (const float*)(P->ws + WS_RWW); const bf16_t* RWA = (const bf16_t*)(P->ws + WS_RWA); const bf16_t* RWG = (const bf16_t*)(P->ws + WS_RWG);
    bf16_t* Y = (bf16_t*)(P->ws + WS_HY);
    LAS float* F = LDSF(0);
    constexpr int CN = 0, WC = 512, TOT = 4608, LD = 4864;
    constexpr int XD = 23552, AT = 25600, RT = AT + 9216, BT = RT + 9216, KT = BT + 9216, BTT = KT + 9216, KTT = BTT + 9216, VT = KTT + 9216, GAB = VT + 9216, GAK = GAB + 9216, GRB = GAK + 9216, GRK = GRB + 9216, OO = GRK + 9216;
    __syncthreads();
    {
        const int kind = tid >> 6, c = tid & 63; float v;
        if (kind < 3) v = P->in[I_RWMU][l * RW_IN + kind * 512 + h * 64 + c];
        else if (kind == 3) v = P->in[I_RWKK][l * 512 + h * 64 + c];
        else if (kind == 4) v = P->in[I_RWKA][l * 512 + h * 64 + c];
        else if (kind == 5) v = P->in[I_RWRK][l * 512 + h * 64 + c];
        else if (kind == 6) v = P->in[I_RWLNW][l * 512 + h * 64 + c];
        else v = P->in[I_RWLNB][l * 512 + h * 64 + c];
        F[CN + kind * 64 + c] = v;
        for (int e = tid; e < 4 * 9216 / 16; e += NTHR) *(LAS u32x4*)(lds + GAB + e * 16) = (u32x4){0u, 0u, 0u, 0u};
    }
    __syncthreads();
    f32x4 ST[4];
#pragma unroll
    for (int j = 0; j < 4; ++j) ST[j] = (f32x4){0.f, 0.f, 0.f, 0.f};
    u32x4 pr_c, pk_c, pv_c, pr_p, pk_p, pv_p, pa, pg; f32x4 pw0, pw1; float pflag;
#define RW_IDS const int tid = ltid(), lane = tid & 63, wave = tid >> 6, fr = lane & 15, fq = lane >> 4, st = tid >> 3, sc = (tid & 7) * 8; (void)lane; (void)wave; (void)fr; (void)fq; (void)st; (void)sc;
#define RW_PREFETCH(ch) do { RW_IDS const int tk_ = b * SEQ + (ch) * 64 + st; const bool first_ = ((ch) == 0 && st == 0); \
        const bf16_t* uc_ = U + (size_t)tk_ * LDU + h * 64 + sc; const bf16_t* up_ = first_ ? uc_ : uc_ - LDU; pflag = first_ ? 0.f : 1.f; \
        pr_c = *(const u32x4*)(uc_ + U_RW_R); pk_c = *(const u32x4*)(uc_ + U_RW_K); pv_c = *(const u32x4*)(uc_ + U_RW_V); \
        pr_p = *(const u32x4*)(up_ + U_RW_R); pk_p = *(const u32x4*)(up_ + U_RW_K); pv_p = *(const u32x4*)(up_ + U_RW_V); \
        const size_t o_ = (size_t)tk_ * 512 + h * 64 + sc; pw0 = *(const f32x4*)(RWW + o_); pw1 = *(const f32x4*)(RWW + o_ + 4); pa = *(const u32x4*)(RWA + o_); pg = *(const u32x4*)(RWG + o_); } while (0)
    RW_PREFETCH(0);
    for (int ch = 0; ch < SEQ / 64; ++ch) {
        u32x4 cg, cvp; float bsum = 0.f;
        {   RW_IDS
        {
        float wt[8];
        {
            wt[0] = pw0[0]; wt[1] = pw0[1]; wt[2] = pw0[2]; wt[3] = pw0[3]; wt[4] = pw1[0]; wt[5] = pw1[1]; wt[6] = pw1[2]; wt[7] = pw1[3];
            const int sl = lane >> 3;
#pragma unroll
            for (int d = 1; d < 8; d <<= 1) {
#pragma unroll
                for (int j = 0; j < 8; ++j) { const float o = __shfl_up(wt[j], 8 * d); if (sl >= d) wt[j] *= o; }
            }
            if (sl == 7) { *(LAS f32x4*)(F + TOT + wave * 64 + sc) = (f32x4){wt[0], wt[1], wt[2], wt[3]}; *(LAS f32x4*)(F + TOT + wave * 64 + sc + 4) = (f32x4){wt[4], wt[5], wt[6], wt[7]}; }
        }
        __syncthreads();
        {
            f32x4 b0 = (f32x4){1.f, 1.f, 1.f, 1.f}, b1 = b0;
            for (int wv = 0; wv < wave; ++wv) { b0 *= *(const LAS f32x4*)(F + TOT + wv * 64 + sc); b1 *= *(const LAS f32x4*)(F + TOT + wv * 64 + sc + 4); }
#pragma unroll
            for (int j = 0; j < 4; ++j) { wt[j] *= b0[j]; wt[4 + j] *= b1[j]; }
            *(LAS f32x4*)(F + WC + st * 64 + sc) = (f32x4){wt[0], wt[1], wt[2], wt[3]}; *(LAS f32x4*)(F + WC + st * 64 + sc + 4) = (f32x4){wt[4], wt[5], wt[6], wt[7]};
        }
        }
        float r[8], v[8], ma[8], bv[8], kp[8];
        cg = pg;
        {
            float k[8], a[8];
            {
                float c[8], p[8], m[8];
                unpack8(pr_c, c); unpack8(pr_p, p);
#pragma unroll
                for (int j = 0; j < 8; ++j) m[j] = F[CN + 0 * 64 + sc + j];
#pragma unroll
                for (int j = 0; j < 8; ++j) r[j] = c[j] + (p[j] * pflag - c[j]) * m[j];
                unpack8(pk_c, c); unpack8(pk_p, p);
#pragma unroll
                for (int j = 0; j < 8; ++j) m[j] = F[CN + 1 * 64 + sc + j];
#pragma unroll
                for (int j = 0; j < 8; ++j) k[j] = c[j] + (p[j] * pflag - c[j]) * m[j];
                unpack8(pv_c, c); unpack8(pv_p, p);
#pragma unroll
                for (int j = 0; j < 8; ++j) m[j] = F[CN + 2 * 64 + sc + j];
#pragma unroll
                for (int j = 0; j < 8; ++j) v[j] = c[j] + (p[j] * pflag - c[j]) * m[j];
                unpack8(pa, a);
            }
            float ss = 0.f, kkv[8];
#pragma unroll
            for (int j = 0; j < 8; ++j) { kkv[j] = k[j] * F[CN + 3 * 64 + sc + j]; ss += kkv[j] * kkv[j]; }
            ss = red8(ss);
            const float inv = 1.0f / fmaxf(sqrtf(ss + 1e-12f), 1e-6f);
#pragma unroll
            for (int j = 0; j < 8; ++j) {
                const float kn = kkv[j] * inv;
                kp[j] = k[j] * (1.0f + (a[j] - 1.0f) * F[CN + 4 * 64 + sc + j]);
                ma[j] = -kn; bv[j] = kn * a[j];
                bsum += r[j] * kp[j] * F[CN + 5 * 64 + sc + j];
            }
            bsum = red8(bsum);
        }
        {
#pragma unroll
            for (int j = 0; j < 8; j += 2) {
                const unsigned pw = pk_bf16(v[j], v[j + 1]);
                *(LAS bf16_t*)(lds + VT + ((sc + j) * 72 + st) * 2) = (bf16_t)(pw & 0xffffu);
                *(LAS bf16_t*)(lds + VT + ((sc + j + 1) * 72 + st) * 2) = (bf16_t)(pw >> 16);
            }
        }
        cvp = pack8(v);
        {
            float al[8], be[8], ka[8], rh[8];
            const f32x4 wa0 = *(const LAS f32x4*)(F + WC + st * 64 + sc), wa1 = *(const LAS f32x4*)(F + WC + st * 64 + sc + 4);
#pragma unroll
            for (int j = 0; j < 8; ++j) {
                const float wtj = (j < 4) ? wa0[j & 3] : wa1[j & 3];
                const float w1 = (j < 4) ? pw0[j & 3] : pw1[j & 3], iw = fast_rcp(wtj), wp = wtj * fast_rcp(w1);
                al[j] = ma[j] * wp; be[j] = bv[j] * iw; ka[j] = kp[j] * iw; rh[j] = r[j] * wtj;
            }
            const u32x4 qa = pack8(al), qb = pack8(be), qk = pack8(ka), qr = pack8(rh);
            *(LAS u32x4*)(lds + AT + (st * 72 + sc) * 2) = qa; *(LAS u32x4*)(lds + RT + (st * 72 + sc) * 2) = qr;
            *(LAS u32x4*)(lds + BT + (st * 72 + sc) * 2) = qb; *(LAS u32x4*)(lds + KT + (st * 72 + sc) * 2) = qk;
#pragma unroll
            for (int j = 0; j < 8; ++j) {
                const unsigned wb = qb[j >> 1], wk = qk[j >> 1];
                *(LAS bf16_t*)(lds + BTT + ((sc + j) * 72 + st) * 2) = (bf16_t)((j & 1) ? (wb >> 16) : (wb & 0xffffu));
                *(LAS bf16_t*)(lds + KTT + ((sc + j) * 72 + st) * 2) = (bf16_t)((j & 1) ? (wk >> 16) : (wk & 0xffffu));
            }
        }
        }
        __syncthreads();
        if (ch + 1 < SEQ / 64) RW_PREFETCH(ch + 1);
        {   RW_IDS
            const int m = wave >> 1;
            const int ta = (m < 2) ? AT : RT, tb = (m & 1) ? KT : BT, tg = GAB + m * 9216;
#pragma unroll
            for (int e = 0; e < 5; ++e) {
                int ti, ji;
                if (wave & 1) { ti = (e < 2) ? 1 : 2; ji = (e < 2) ? e : e - 2; } else { ti = (e < 1) ? 0 : 3; ji = (e < 1) ? 0 : e - 1; }
                f32x4 g = (f32x4){0.f, 0.f, 0.f, 0.f};
#pragma unroll
                for (int kk = 0; kk < 2; ++kk) g = RW_MFMA(rw_op16(lds, ta + ((ti * 16 + fr) * 72 + kk * 32 + fq * 8) * 2), rw_op16(lds, tb + ((ji * 16 + fr) * 72 + kk * 32 + fq * 8) * 2), g);
#pragma unroll
                for (int rg = 0; rg < 4; ++rg) {
                    const int t = ti * 16 + fq * 4 + rg, j = ji * 16 + fr;
                    const bool keep = (m >= 2) ? (j <= t) : (j < t);
                    const float val = keep ? g[rg] : 0.f;
                    *(LAS bf16_t*)(lds + tg + (t * 72 + j) * 2) = (bf16_t)(pk_bf16(val, 0.f) & 0xffffu);
                    if (m == 0 && ti == ji) F[LD + ti * 256 + (fq * 4 + rg) * 16 + fr] = val;
                }
            }
        }
        __syncthreads();
        f32x4 Yc[4]; bf16x8 s0b[2], vtb[2];
        {   RW_IDS
        if (wave == 4) {
            const int c = lane >> 4, col = lane & 15;
            float x[16];
#pragma unroll
            for (int t = 0; t < 16; ++t) {
                float acc = (t == col) ? 1.0f : 0.0f, acc1 = 0.f;
#pragma unroll
                for (int j = 0; j < t; ++j) { if (j & 1) acc1 += F[LD + c * 256 + t * 16 + j] * x[j]; else acc += F[LD + c * 256 + t * 16 + j] * x[j]; }
                acc += acc1;
                x[t] = acc;
                __builtin_amdgcn_sched_barrier(0);
                *(LAS bf16_t*)(lds + XD + ((c * 16 + t) * 16 + col) * 2) = (bf16_t)(pk_bf16(acc, 0.f) & 0xffffu);
            }
        }
        if (wave < 4) {
#pragma unroll
            for (int kk = 0; kk < 2; ++kk) { s0b[kk] = rw_accop(ST[2 * kk], ST[2 * kk + 1]); vtb[kk] = rw_op16(lds, VT + ((wave * 16 + fr) * 72 + kk * 32 + fq * 8) * 2); }
#pragma unroll
            for (int c = 0; c < 4; ++c) {
                const int row = c * 16 + fr;
                f32x4 y = (f32x4){0.f, 0.f, 0.f, 0.f};
#pragma unroll
                for (int kk = 0; kk < 2; ++kk) y = RW_MFMA(rw_op8x2(lds, AT + (row * 72 + kk * 32 + fq * 4) * 2, AT + (row * 72 + kk * 32 + 16 + fq * 4) * 2), s0b[kk], y);
                y = RW_MFMA(rw_op16(lds, GAK + (row * 72 + fq * 8) * 2), vtb[0], y);
                if (c >= 2) y = RW_MFMA(rw_op16(lds, GAK + (row * 72 + 32 + fq * 8) * 2), vtb[1], y);
                Yc[c] = y;
            }
        }
        }
        __syncthreads();
        {   RW_IDS
        if (wave < 4) {
            const f32x4 z4 = (f32x4){0.f, 0.f, 0.f, 0.f};
#define RW_XOP(c) __builtin_bit_cast(bf16x8, (u32x4){(*(const LAS u32x2*)(lds + XD + (((c) * 16 + fr) * 16 + fq * 4) * 2)).x, (*(const LAS u32x2*)(lds + XD + (((c) * 16 + fr) * 16 + fq * 4) * 2)).y, 0u, 0u})
#define RW_LOP(c, kk) rw_op8x2(lds, GAB + (((c) * 16 + fr) * 72 + (kk) * 32 + fq * 4) * 2, GAB + (((c) * 16 + fr) * 72 + (kk) * 32 + 16 + fq * 4) * 2)
            const f32x4 U0 = RW_MFMA(RW_XOP(0), rw_accop(Yc[0], z4), z4);
            const f32x4 Y1 = RW_MFMA(RW_LOP(1, 0), rw_accop(U0, z4), Yc[1]);
            const f32x4 U1 = RW_MFMA(RW_XOP(1), rw_accop(Y1, z4), z4);
            const bf16x8 ub0 = rw_accop(U0, U1);
            const f32x4 Y2 = RW_MFMA(RW_LOP(2, 0), ub0, Yc[2]);
            const f32x4 U2 = RW_MFMA(RW_XOP(2), rw_accop(Y2, z4), z4);
            f32x4 Y3 = RW_MFMA(RW_LOP(3, 0), ub0, Yc[3]);
            Y3 = RW_MFMA(RW_LOP(3, 1), rw_accop(U2, z4), Y3);
            const f32x4 U3 = RW_MFMA(RW_XOP(3), rw_accop(Y3, z4), z4);
            const bf16x8 ub1 = rw_accop(U2, U3);
#undef RW_XOP
#undef RW_LOP
#pragma unroll
            for (int c = 0; c < 4; ++c) {
                const int row = c * 16 + fr;
                f32x4 o = (f32x4){0.f, 0.f, 0.f, 0.f};
#pragma unroll
                for (int kk = 0; kk < 2; ++kk) o = RW_MFMA(rw_op8x2(lds, RT + (row * 72 + kk * 32 + fq * 4) * 2, RT + (row * 72 + kk * 32 + 16 + fq * 4) * 2), s0b[kk], o);
                o = RW_MFMA(rw_op8x2(lds, GRB + (row * 72 + fq * 4) * 2, GRB + (row * 72 + 16 + fq * 4) * 2), ub0, o);
                o = RW_MFMA(rw_op16(lds, GRK + (row * 72 + fq * 8) * 2), vtb[0], o);
                if (c >= 2) {
                    o = RW_MFMA(rw_op8x2(lds, GRB + (row * 72 + 32 + fq * 4) * 2, GRB + (row * 72 + 48 + fq * 4) * 2), ub1, o);
                    o = RW_MFMA(rw_op16(lds, GRK + (row * 72 + 32 + fq * 8) * 2), vtb[1], o);
                }
#pragma unroll
                for (int rg = 0; rg < 4; ++rg) *(LAS float*)(lds + OO + ((c * 16 + fq * 4 + rg) * 68 + wave * 16 + fr) * 4) = o[rg];
            }
#pragma unroll
            for (int kt = 0; kt < 4; ++kt) {
                const int row = kt * 16 + fr;
                f32x4 s = ST[kt];
                s = RW_MFMA(rw_op8x2(lds, BTT + (row * 72 + fq * 4) * 2, BTT + (row * 72 + 16 + fq * 4) * 2), ub0, s);
                s = RW_MFMA(rw_op8x2(lds, BTT + (row * 72 + 32 + fq * 4) * 2, BTT + (row * 72 + 48 + fq * 4) * 2), ub1, s);
                s = RW_MFMA(rw_op16(lds, KTT + (row * 72 + fq * 8) * 2), vtb[0], s);
                s = RW_MFMA(rw_op16(lds, KTT + (row * 72 + 32 + fq * 8) * 2), vtb[1], s);
                ST[kt] = s * *(const LAS f32x4*)(F + WC + 63 * 64 + kt * 16 + fq * 4);
            }
        }
        }
        __syncthreads();
        {   RW_IDS
            const f32x4 o0 = *(const LAS f32x4*)(lds + OO + (st * 68 + sc) * 4), o1 = *(const LAS f32x4*)(lds + OO + (st * 68 + sc + 4) * 4);
            float o[8] = {o0[0], o0[1], o0[2], o0[3], o1[0], o1[1], o1[2], o1[3]}, v8[8], g8[8], y8[8];
            unpack8(cvp, v8); unpack8(cg, g8);
            float sm = 0.f;
#pragma unroll
            for (int j = 0; j < 8; ++j) sm += o[j];
            const float mean = red8(sm) * (1.0f / 64.0f);
            float q = 0.f;
#pragma unroll
            for (int j = 0; j < 8; ++j) { o[j] -= mean; q += o[j] * o[j]; }
            const float rs = rsqrtf(red8(q) * (1.0f / 64.0f) + 64e-5f);
#pragma unroll
            for (int j = 0; j < 8; ++j) y8[j] = (o[j] * rs * F[CN + 6 * 64 + sc + j] + F[CN + 7 * 64 + sc + j] + bsum * v8[j]) * g8[j];
            *(u32x4*)(Y + (size_t)(b * SEQ + ch * 64 + st) * DM + 512 + h * 64 + sc) = pack8(y8);
        }
    }
#undef RW_PREFETCH
#undef RW_IDS
}
#undef RW_MFMA


__device__ __forceinline__ void p2_hg(KP P, int l, int item, LAS unsigned char* lds) {
    const int tid = ltid(), lane = tid & 63, wave = tid >> 6, b = item >> 2, h = item & 3;
    const int fr = lane & 15, fq = lane >> 4, st = tid >> 3, c16 = tid & 7, sv = c16 * 16;
    const bf16_t* U = (const bf16_t*)(P->ws + WS_U); bf16_t* Y = (bf16_t*)(P->ws + WS_HY);
    LAS float* F = LDSF(0);
    constexpr int LBO = 0, HN = 128, FF = 256, TT = 8448;
    constexpr int QB = 35840, KB = QB + 64 * 136 * 2, KT = KB + 64 * 136 * 2, VT = KT + 128 * 72 * 2, AB = VT + 128 * 72 * 2, OO = AB + 64 * 40 * 2;
    __syncthreads();
    if (tid < 128) { float lb = 0.f; if (l == 1) lb = sigmoidf_(P->in[I_HGLB][512 + h * 128 + tid] - P->in[I_HGLB][h * 128 + tid]); F[LBO + tid] = lb; F[HN + tid] = P->in[I_HGNORM][l * 512 + h * 128 + tid]; }
    __syncthreads();
    f32x4 S[8];
#pragma unroll
    for (int j = 0; j < 8; ++j) S[j] = (f32x4){0.f, 0.f, 0.f, 0.f};
    u32x4 pq0, pq1, pf0, pf1, pv0, pv1;
#define HG_IDS const int tid = ltid(), lane = tid & 63, wave = tid >> 6, fr = lane & 15, fq = lane >> 4, st = tid >> 3, c16 = tid & 7, sv = c16 * 16; (void)lane; (void)wave; (void)fr; (void)fq; (void)st; (void)c16; (void)sv;
#define HG_PREFETCH(ch) do { HG_IDS const bf16_t* ur_ = U + (size_t)(b * SEQ + (ch) * 64 + st) * LDU + h * 128; \
        pq0 = *(const u32x4*)(ur_ + U_HG_Q + c16 * 16); pq1 = *(const u32x4*)(ur_ + U_HG_Q + c16 * 16 + 8); pf0 = *(const u32x4*)(ur_ + U_HG_F + c16 * 16); pf1 = *(const u32x4*)(ur_ + U_HG_F + c16 * 16 + 8); \
        pv0 = *(const u32x4*)(ur_ + U_HG_I + sv); pv1 = *(const u32x4*)(ur_ + U_HG_I + sv + 8); } while (0)
    HG_PREFETCH(0);
    for (int ch = 0; ch < SEQ / 64; ++ch) {
        float fo[16], kx[16], qs[16];
        u32x4 cg0, cg1;
        {   HG_IDS
            { const bf16_t* ug_ = U + (size_t)(b * SEQ + ch * 64 + st) * LDU + U_HG_G + h * 128 + sv; cg0 = *(const u32x4*)ug_; cg1 = *(const u32x4*)(ug_ + 8); }
            float q[16], z[16];
            { float t0[8], t1[8]; unpack8(pq0, t0); unpack8(pq1, t1);
#pragma unroll
              for (int j = 0; j < 8; ++j) { q[j] = t0[j]; q[8 + j] = t1[j]; }
              unpack8(pf0, t0); unpack8(pf1, t1);
#pragma unroll
              for (int j = 0; j < 8; ++j) { z[j] = t0[j]; z[8 + j] = t1[j]; } }
#pragma unroll
            for (int j = 0; j < 16; ++j) {
                const float lb = F[LBO + c16 * 16 + j], e = __expf(-z[j]), sg = fast_rcp(1.0f + e);
                fo[j] = lb + (1.0f - lb) * sg; kx[j] = (1.0f - lb) * (e * sg);
                qs[j] = siluf_(q[j]);
            }
        }
        const u32x4 cv0 = pv0, cv1 = pv1;
        __syncthreads();
        {   HG_IDS
#pragma unroll
            for (int m = 0; m < 4; ++m) *(LAS f32x4*)(F + FF + st * 128 + c16 * 16 + 4 * m) = (f32x4){fo[4 * m], fo[4 * m + 1], fo[4 * m + 2], fo[4 * m + 3]};
#pragma unroll
            for (int j = 0; j < 8; ++j) {
                const unsigned w0 = cv0[j >> 1], w1 = cv1[j >> 1];
                *(LAS bf16_t*)(lds + VT + ((sv + j) * 72 + st) * 2) = (bf16_t)((j & 1) ? (w0 >> 16) : (w0 & 0xffffu));
                *(LAS bf16_t*)(lds + VT + ((sv + 8 + j) * 72 + st) * 2) = (bf16_t)((j & 1) ? (w1 >> 16) : (w1 & 0xffffu));
            }
        }
        __syncthreads();
        {   HG_IDS
            const int kk = tid & 127, w4 = tid >> 7; float c = 1.0f;
#pragma unroll 4
            for (int i = 0; i < 16; ++i) { const int ix = FF + (w4 * 16 + i) * 128 + kk; c *= F[ix]; F[ix] = c; }
            F[TT + w4 * 128 + kk] = c;
        }
        __syncthreads();
        if ((ltid() >> 7) & 1) {   HG_IDS
            const int kk = tid & 127, w4 = tid >> 7; const float m0 = F[TT + (w4 - 1) * 128 + kk];
#pragma unroll 4
            for (int i = 0; i < 16; ++i) F[FF + (w4 * 16 + i) * 128 + kk] *= m0;
        }
        __syncthreads();
        {   HG_IDS
#pragma unroll
            for (int m = 0; m < 4; ++m) {
                const f32x4 c4 = *(const LAS f32x4*)(F + FF + st * 128 + c16 * 16 + 4 * m);
                float qc[4], kc[4];
#pragma unroll
                for (int j = 0; j < 4; ++j) { const float cc = fmaxf(c4[j], 1e-30f); qc[j] = qs[4 * m + j] * cc; kc[j] = kx[4 * m + j] * fast_rcp(cc); }
                u32x2 w; w.x = pk_bf16(qc[0], qc[1]); w.y = pk_bf16(qc[2], qc[3]);
                *(LAS u32x2*)(lds + QB + (st * 136 + c16 * 16 + 4 * m) * 2) = w;
                w.x = pk_bf16(kc[0], kc[1]); w.y = pk_bf16(kc[2], kc[3]);
                *(LAS u32x2*)(lds + KB + (st * 136 + c16 * 16 + 4 * m) * 2) = w;
                *(LAS bf16_t*)(lds + KT + ((c16 * 16 + 4 * m + 0) * 72 + st) * 2) = (bf16_t)(w.x & 0xffffu);
                *(LAS bf16_t*)(lds + KT + ((c16 * 16 + 4 * m + 1) * 72 + st) * 2) = (bf16_t)(w.x >> 16);
                *(LAS bf16_t*)(lds + KT + ((c16 * 16 + 4 * m + 2) * 72 + st) * 2) = (bf16_t)(w.y & 0xffffu);
                *(LAS bf16_t*)(lds + KT + ((c16 * 16 + 4 * m + 3) * 72 + st) * 2) = (bf16_t)(w.y >> 16);
            }
        }
        __syncthreads();
        {   HG_IDS
        if (ch + 1 < SEQ / 64) HG_PREFETCH(ch + 1);
        {
            const int wn = wave >> 2, ti = (wave >> 1) & 1, si = wave & 1;
            f32x4 a0 = (f32x4){0.f, 0.f, 0.f, 0.f};
#pragma unroll
            for (int kk = 0; kk < 4; ++kk) {
                const bf16x8 qa = *(const LAS bf16x8*)(lds + QB + ((wn * 32 + ti * 16 + fr) * 136 + kk * 32 + fq * 8) * 2);
                const bf16x8 k0 = *(const LAS bf16x8*)(lds + KB + ((wn * 32 + si * 16 + fr) * 136 + kk * 32 + fq * 8) * 2);
                a0 = __builtin_amdgcn_mfma_f32_16x16x32_bf16(qa, k0, a0, 0, 0, 0);
            }
#pragma unroll
            for (int rg = 0; rg < 4; ++rg) {
                const int tl = ti * 16 + fq * 4 + rg, sl = si * 16 + fr;
                const unsigned w0 = pk_bf16((sl <= tl) ? a0[rg] : 0.f, 0.f) & 0xffffu;
                *(LAS bf16_t*)(lds + AB + ((wn * 32 + tl) * 40 + sl) * 2) = (bf16_t)w0;
            }
        }
        }
        __syncthreads();
        {   HG_IDS
        *(LAS u32x4*)(lds + KB + (st * 136 + sv) * 2) = cg0; *(LAS u32x4*)(lds + KB + (st * 136 + sv + 8) * 2) = cg1;
        {
            bf16x8 vb[2];
#pragma unroll
            for (int wn = 0; wn < 2; ++wn) vb[wn] = *(const LAS bf16x8*)(lds + VT + ((wave * 16 + fr) * 72 + wn * 32 + fq * 8) * 2);
#pragma unroll
            for (int wn = 0; wn < 2; ++wn) {
                bf16x8 mb[4];
#pragma unroll
                for (int kk = 0; kk < 4; ++kk) {
                    u32x4 w; w.x = pk_bf16(S[2 * kk][0], S[2 * kk][1]); w.y = pk_bf16(S[2 * kk][2], S[2 * kk][3]); w.z = pk_bf16(S[2 * kk + 1][0], S[2 * kk + 1][1]); w.w = pk_bf16(S[2 * kk + 1][2], S[2 * kk + 1][3]);
                    mb[kk] = __builtin_bit_cast(bf16x8, w);
                }
#pragma unroll
                for (int ti = 0; ti < 2; ++ti) {
                    const int row = wn * 32 + ti * 16 + fr;
                    const bf16x8 sa = *(const LAS bf16x8*)(lds + AB + (row * 40 + fq * 8) * 2);
                    f32x4 o = __builtin_amdgcn_mfma_f32_16x16x32_bf16(sa, vb[wn], (f32x4){0.f, 0.f, 0.f, 0.f}, 0, 0, 0);
#pragma unroll
                    for (int kk = 0; kk < 4; ++kk) {
                        const u32x2 lo = *(const LAS u32x2*)(lds + QB + (row * 136 + kk * 32 + fq * 4) * 2), hi = *(const LAS u32x2*)(lds + QB + (row * 136 + kk * 32 + 16 + fq * 4) * 2);
                        const u32x4 w = (u32x4){lo.x, lo.y, hi.x, hi.y};
                        o = __builtin_amdgcn_mfma_f32_16x16x32_bf16(__builtin_bit_cast(bf16x8, w), mb[kk], o, 0, 0, 0);
                    }
#pragma unroll
                    for (int rg = 0; rg < 4; ++rg) *(LAS float*)(lds + OO + ((wn * 32 + ti * 16 + fq * 4 + rg) * 132 + wave * 16 + fr) * 4) = o[rg];
                }
#pragma unroll
                for (int kt = 0; kt < 8; ++kt) {
                    const bf16x8 ka = *(const LAS bf16x8*)(lds + KT + ((kt * 16 + fr) * 72 + wn * 32 + fq * 8) * 2);
                    S[kt] = __builtin_amdgcn_mfma_f32_16x16x32_bf16(ka, vb[wn], S[kt], 0, 0, 0);
                    S[kt] *= *(const LAS f32x4*)(F + FF + (wn * 32 + 31) * 128 + kt * 16 + fq * 4);
                }
            }
        }
        }
        __syncthreads();
        {   HG_IDS
            float ss = 0.f;
#pragma unroll
            for (int m = 0; m < 4; ++m) { const f32x4 x = *(const LAS f32x4*)(lds + OO + (st * 132 + sv + 4 * m) * 4); ss += x[0] * x[0] + x[1] * x[1] + x[2] * x[2] + x[3] * x[3]; }
            const float rs = rsqrtf(red8(ss) * (1.0f / 128.0f) + 1e-6f);
            bf16_t* yr = Y + (size_t)(b * SEQ + ch * 64 + st) * DM + h * 128 + sv;
#pragma unroll 1
            for (int hf = 0; hf < 2; ++hf) {
                const f32x4 x0 = *(const LAS f32x4*)(lds + OO + (st * 132 + sv + hf * 8) * 4), x1 = *(const LAS f32x4*)(lds + OO + (st * 132 + sv + hf * 8 + 4) * 4);
                const f32x4 n0 = *(const LAS f32x4*)(F + HN + sv + hf * 8), n1 = *(const LAS f32x4*)(F + HN + sv + hf * 8 + 4);
                float g[8], y8[8]; unpack8(*(const LAS u32x4*)(lds + KB + (st * 136 + sv + hf * 8) * 2), g);
#pragma unroll
                for (int j = 0; j < 4; ++j) { y8[j] = x0[j] * rs * n0[j] * siluf_(g[j]); y8[4 + j] = x1[j] * rs * n1[j] * siluf_(g[4 + j]); }
                *(u32x4*)(yr + hf * 8) = pack8(y8);
            }
        }
    }
#undef HG_PREFETCH
#undef HG_IDS
}

__device__ __forceinline__ void p2_ml(KP P, int l, int item, LAS unsigned char* lds) {
    const int tid = ltid(), lane = tid & 63, wave = tid >> 6, b = item >> 2, h = item & 3;
    const int fr = lane & 15, fq = lane >> 4, st = tid >> 3, c8 = tid & 7, sv = c8 * 16;
    const int blk = tid & 31, sg = tid >> 5;
    const bf16_t* U = (const bf16_t*)(P->ws + WS_U); bf16_t* Y = (bf16_t*)(P->ws + WS_HY);
    LAS float* F = LDSF(0);
    constexpr int FD = 0, IW = 64, EN = 128, RS = 256, NK = 512, TNS = 768, CT = 1280, MN = 2944, MS = 3072;
    constexpr int QB = 12800, KB = QB + 64 * 136 * 2, KT = KB + 64 * 136 * 2, VT = KT + 128 * 72 * 2, AB = VT + 128 * 72 * 2, OO = AB + 64 * 72 * 2, XC = OO + 64 * 132 * 4;
    __syncthreads();
    if (tid < 32) {
        const int cgl = h * 128 + blk * 4;
#pragma unroll
        for (int jj = 0; jj < 4; ++jj) *(LAS f32x4*)(F + CT + (jj * 32 + blk) * 4) = *(const f32x4*)(P->in[I_MLCW] + l * 2048 + jj * 512 + cgl);
        *(LAS f32x4*)(F + CT + (4 * 32 + blk) * 4) = *(const f32x4*)(P->in[I_MLCB] + l * 512 + cgl);
#pragma unroll
        for (int j = 0; j < 4; ++j) {
            *(LAS f32x4*)(F + CT + ((5 + j) * 32 + blk) * 4) = *(const f32x4*)(P->in[I_MLWQ] + (size_t)l * 2048 + (h * 32 + blk) * 16 + j * 4) * 0.08838834764831845f;
            *(LAS f32x4*)(F + CT + ((9 + j) * 32 + blk) * 4) = *(const f32x4*)(P->in[I_MLWK] + (size_t)l * 2048 + (h * 32 + blk) * 16 + j * 4);
        }
    }
    const float ib = P->in[I_MLIB][l * 4 + h], fb = P->in[I_MLFB][l * 4 + h];
    f32x4 M[8];
#pragma unroll
    for (int j = 0; j < 8; ++j) M[j] = (f32x4){0.f, 0.f, 0.f, 0.f};
    float mcarry = 0.f;
    u32x2 px[7]; u32x4 pv0, pv1; unsigned pif;
#define ML_IDS const int tid = ltid(), lane = tid & 63, wave = tid >> 6, fr = lane & 15, fq = lane >> 4, st = tid >> 3, c8 = tid & 7, sv = c8 * 16, blk = tid & 31, sg = tid >> 5; (void)lane; (void)wave; (void)fr; (void)fq; (void)st; (void)c8; (void)sv; (void)blk; (void)sg;
#define ML_PREFETCH(ch) do { ML_IDS const int ts0_ = (ch) * 64 + sg * 4 - 3; \
        _Pragma("unroll") for (int r = 0; r < 7; ++r) { const int ts_ = ts0_ + r; \
            px[r] = *(const u32x2*)(U + (size_t)(b * SEQ + (ts_ < 0 ? 0 : ts_)) * LDU + U_ML_X + h * 128 + blk * 4); } \
        { const bf16_t* uv_ = U + (size_t)(b * SEQ + (ch) * 64 + st) * LDU + U_ML_V + h * 128 + sv; pv0 = *(const u32x4*)uv_; pv1 = *(const u32x4*)(uv_ + 8); } \
        { const bf16_t* ug_ = U + (size_t)(b * SEQ + (ch) * 64 + lane) * LDU; pif = (unsigned)ug_[U_ML_I + h] | ((unsigned)ug_[U_ML_F + h] << 16); } } while (0)
    if (tid < 128) { F[NK + tid] = 0.f; F[MN + tid] = P->in[I_MLNORM][l * 512 + h * 128 + tid]; F[MS + tid] = P->in[I_MLSKIP][l * 512 + h * 128 + tid]; }
    ML_PREFETCH(0);
    __syncthreads();
    for (int ch = 0; ch < SEQ / 64; ++ch) {
        const u32x4 cv0 = pv0, cv1 = pv1;
        u32x4 co0, co1;
        {   ML_IDS
        { const bf16_t* uo_ = U + (size_t)(b * SEQ + ch * 64 + st) * LDU + U_ML_O + h * 128 + sv; co0 = *(const u32x4*)uo_; co1 = *(const u32x4*)(uo_ + 8); }
        }
        __syncthreads();
        float q[4][4], k[4][4];
        {   ML_IDS
        {
            float xc[4][4];
            {
                f32x4 cw[4];
#pragma unroll
                for (int j = 0; j < 4; ++j) cw[j] = *(const LAS f32x4*)(F + CT + (j * 32 + blk) * 4);
                const f32x4 cb4 = *(const LAS f32x4*)(F + CT + (4 * 32 + blk) * 4);
                float x[7][4];
#pragma unroll
                for (int r = 0; r < 7; ++r) { const float vf = (ch * 64 + sg * 4 - 3 + r) < 0 ? 0.f : 1.f; x[r][0] = vf * bflo(px[r].x); x[r][1] = vf * bfhi(px[r].x); x[r][2] = vf * bflo(px[r].y); x[r][3] = vf * bfhi(px[r].y); }
#pragma unroll
                for (int s = 0; s < 4; ++s)
#pragma unroll
                    for (int j = 0; j < 4; ++j) xc[s][j] = siluf_(cb4[j] + cw[0][j] * x[s][j] + cw[1][j] * x[s + 1][j] + cw[2][j] * x[s + 2][j] + cw[3][j] * x[s + 3][j]);
            }
#pragma unroll
            for (int s = 0; s < 4; ++s) { u32x2 w; w.x = pk_bf16(xc[s][0], xc[s][1]); w.y = pk_bf16(xc[s][2], xc[s][3]); *(LAS u32x2*)(lds + XC + ((sg * 4 + s) * 136 + blk * 4) * 2) = w; }
            __builtin_amdgcn_sched_barrier(0);
            {
                f32x4 wq[4];
#pragma unroll
                for (int j = 0; j < 4; ++j) wq[j] = *(const LAS f32x4*)(F + CT + ((5 + j) * 32 + blk) * 4);
#pragma unroll
                for (int s = 0; s < 4; ++s)
#pragma unroll
                    for (int i = 0; i < 4; ++i) q[s][i] = xc[s][0] * wq[0][i] + xc[s][1] * wq[1][i] + xc[s][2] * wq[2][i] + xc[s][3] * wq[3][i];
            }
            __builtin_amdgcn_sched_barrier(0);
            {
                f32x4 wk[4];
#pragma unroll
                for (int j = 0; j < 4; ++j) wk[j] = *(const LAS f32x4*)(F + CT + ((9 + j) * 32 + blk) * 4);
#pragma unroll
                for (int s = 0; s < 4; ++s)
#pragma unroll
                    for (int i = 0; i < 4; ++i) k[s][i] = xc[s][0] * wk[0][i] + xc[s][1] * wk[1][i] + xc[s][2] * wk[2][i] + xc[s][3] * wk[3][i];
            }
        }
        if (wave == 0) {
            const float ip = bflo(pif) + ib, xf = bfhi(pif) + fb;
            const float lf = fminf(xf, 0.f) - log1pf(__expf(-fabsf(xf)));
            const float bs = wave_scan_sum(lf);
            const float cm = wave_scan_max(ip - bs);
            const float g = fmaxf(mcarry, cm), mt = bs + g;
            const int lq = lane + lsgpr(0);
            F[FD + lq] = __expf(mcarry - g);
            F[IW + lq] = __expf(ip - bs - mcarry);
            F[EN + lq] = __expf(-mt);
            mcarry = __int_as_float(__builtin_amdgcn_readlane(__float_as_int(mt), 63));
        }
        }
        __syncthreads();
        {   ML_IDS
#pragma unroll
            for (int s = 0; s < 4; ++s) {
                const int t = sg * 4 + s; const float fd = F[FD + t], iw = F[IW + t];
#pragma unroll
                for (int i = 0; i < 4; ++i) { q[s][i] *= fd; k[s][i] *= iw; }
                u32x2 w; w.x = pk_bf16(q[s][0], q[s][1]); w.y = pk_bf16(q[s][2], q[s][3]);
                *(LAS u32x2*)(lds + QB + (t * 136 + blk * 4) * 2) = w;
                w.x = pk_bf16(k[s][0], k[s][1]); w.y = pk_bf16(k[s][2], k[s][3]);
                *(LAS u32x2*)(lds + KB + (t * 136 + blk * 4) * 2) = w;
            }
#pragma unroll
            for (int i = 0; i < 4; ++i) {
                u32x2 w; w.x = pk_bf16(k[0][i], k[1][i]); w.y = pk_bf16(k[2][i], k[3][i]);
                *(LAS u32x2*)(lds + KT + ((blk * 4 + i) * 72 + sg * 4) * 2) = w;
            }
#pragma unroll
            for (int j = 0; j < 8; ++j) {
                const unsigned w0 = cv0[j >> 1], w1 = cv1[j >> 1];
                *(LAS bf16_t*)(lds + VT + ((sv + j) * 72 + st) * 2) = (bf16_t)((j & 1) ? (w0 >> 16) : (w0 & 0xffffu));
                *(LAS bf16_t*)(lds + VT + ((sv + 8 + j) * 72 + st) * 2) = (bf16_t)((j & 1) ? (w1 >> 16) : (w1 & 0xffffu));
            }
        }
        __syncthreads();
        {   ML_IDS
        if (ch + 1 < SEQ / 64) ML_PREFETCH(ch + 1);
        {
            const int ti = wave >> 1, si0 = 2 * (wave & 1);
            f32x4 a0 = (f32x4){0.f, 0.f, 0.f, 0.f}, a1 = a0;
#pragma unroll
            for (int kk = 0; kk < 4; ++kk) {
                const bf16x8 qa = *(const LAS bf16x8*)(lds + QB + ((ti * 16 + fr) * 136 + kk * 32 + fq * 8) * 2);
                const bf16x8 k0 = *(const LAS bf16x8*)(lds + KB + (((si0) * 16 + fr) * 136 + kk * 32 + fq * 8) * 2);
                const bf16x8 k1 = *(const LAS bf16x8*)(lds + KB + (((si0 + 1) * 16 + fr) * 136 + kk * 32 + fq * 8) * 2);
                a0 = __builtin_amdgcn_mfma_f32_16x16x32_bf16(qa, k0, a0, 0, 0, 0);
                a1 = __builtin_amdgcn_mfma_f32_16x16x32_bf16(qa, k1, a1, 0, 0, 0);
            }
#pragma unroll
            for (int rg = 0; rg < 4; ++rg) {
                const int ta = ti * 16 + fq * 4 + rg, s0 = si0 * 16 + fr, s1 = s0 + 16;
                const unsigned w0 = pk_bf16((s0 <= ta) ? a0[rg] : 0.f, 0.f) & 0xffffu, w1 = pk_bf16((s1 <= ta) ? a1[rg] : 0.f, 0.f) & 0xffffu;
                *(LAS bf16_t*)(lds + AB + (ta * 72 + s0) * 2) = (bf16_t)w0;
                *(LAS bf16_t*)(lds + AB + (ta * 72 + s1) * 2) = (bf16_t)w1;
                const float r0 = red16(bflo(w0)), r1 = red16(bflo(w1));
                if (fr == 0) { F[RS + si0 * 64 + ta] = r0; F[RS + (si0 + 1) * 64 + ta] = r1; }
            }
            const int kk = tid & 127, q4 = tid >> 7;
            const u32x4 t0 = *(const LAS u32x4*)(lds + KT + (kk * 72 + q4 * 16) * 2), t1 = *(const LAS u32x4*)(lds + KT + (kk * 72 + q4 * 16 + 8) * 2);
            float f0[8], f1[8]; unpack8(t0, f0); unpack8(t1, f1);
            float s = 0.f;
#pragma unroll
            for (int j = 0; j < 8; ++j) s += f0[j] + f1[j];
            F[TNS + q4 * 128 + kk] = s;
        }
        }
        __syncthreads();
        {   ML_IDS
        *(LAS u32x4*)(lds + KB + (st * 136 + sv) * 2) = co0; *(LAS u32x4*)(lds + KB + (st * 136 + sv + 8) * 2) = co1;
        {
            const float ce = F[FD + 63];
            bf16x8 mb[4], vb[2];
#pragma unroll
            for (int kk = 0; kk < 4; ++kk) {
                u32x4 w; w.x = pk_bf16(M[2 * kk][0], M[2 * kk][1]); w.y = pk_bf16(M[2 * kk][2], M[2 * kk][3]); w.z = pk_bf16(M[2 * kk + 1][0], M[2 * kk + 1][1]); w.w = pk_bf16(M[2 * kk + 1][2], M[2 * kk + 1][3]);
                mb[kk] = __builtin_bit_cast(bf16x8, w);
            }
#pragma unroll
            for (int kk = 0; kk < 2; ++kk) vb[kk] = *(const LAS bf16x8*)(lds + VT + ((wave * 16 + fr) * 72 + kk * 32 + fq * 8) * 2);
#pragma unroll
            for (int ti = 0; ti < 4; ++ti) {
                f32x4 o = (f32x4){0.f, 0.f, 0.f, 0.f};
#pragma unroll
                for (int kk = 0; kk < 2; ++kk) {
                    const bf16x8 sa = *(const LAS bf16x8*)(lds + AB + ((ti * 16 + fr) * 72 + kk * 32 + fq * 8) * 2);
                    o = __builtin_amdgcn_mfma_f32_16x16x32_bf16(sa, vb[kk], o, 0, 0, 0);
                }
#pragma unroll
                for (int kk = 0; kk < 4; ++kk) {
                    const u32x2 lo = *(const LAS u32x2*)(lds + QB + ((ti * 16 + fr) * 136 + kk * 32 + fq * 4) * 2), hi = *(const LAS u32x2*)(lds + QB + ((ti * 16 + fr) * 136 + kk * 32 + 16 + fq * 4) * 2);
                    const u32x4 w = (u32x4){lo.x, lo.y, hi.x, hi.y};
                    o = __builtin_amdgcn_mfma_f32_16x16x32_bf16(__builtin_bit_cast(bf16x8, w), mb[kk], o, 0, 0, 0);
                }
#pragma unroll
                for (int rg = 0; rg < 4; ++rg) *(LAS float*)(lds + OO + ((ti * 16 + fq * 4 + rg) * 132 + wave * 16 + fr) * 4) = o[rg];
            }
#pragma unroll
            for (int kt = 0; kt < 8; ++kt) {
#pragma unroll
                for (int kk = 0; kk < 2; ++kk) {
                    const bf16x8 ka = *(const LAS bf16x8*)(lds + KT + ((kt * 16 + fr) * 72 + kk * 32 + fq * 8) * 2);
                    M[kt] = __builtin_amdgcn_mfma_f32_16x16x32_bf16(ka, vb[kk], M[kt], 0, 0, 0);
                }
                M[kt] *= ce;
            }
            if (tid < 128) F[NK + ((ch + 1) & 1) * 128 + tid] = (F[NK + (ch & 1) * 128 + tid] + (F[TNS + tid] + F[TNS + 128 + tid]) + (F[TNS + 256 + tid] + F[TNS + 384 + tid])) * ce;
        }
        }
        __syncthreads();
        {   ML_IDS
            const u32x4 q0 = *(const LAS u32x4*)(lds + QB + (st * 136 + c8 * 16) * 2), q1 = *(const LAS u32x4*)(lds + QB + (st * 136 + c8 * 16 + 8) * 2);
            float f0[8], f1[8]; unpack8(q0, f0); unpack8(q1, f1);
            float d = 0.f;
#pragma unroll
            for (int m = 0; m < 2; ++m) {
                const f32x4 n0 = *(const LAS f32x4*)(F + NK + (ch & 1) * 128 + c8 * 16 + 4 * m), n1 = *(const LAS f32x4*)(F + NK + (ch & 1) * 128 + c8 * 16 + 8 + 4 * m);
#pragma unroll
                for (int j = 0; j < 4; ++j) d += f0[4 * m + j] * n0[j] + f1[4 * m + j] * n1[j];
            }
            d = red8(d);
            d += (F[RS + st] + F[RS + 64 + st]) + (F[RS + 128 + st] + F[RS + 192 + st]);
            const float dinv = 1.0f / fmaxf(fabsf(d), F[EN + st]);
            float o[16], og[16], xs[16];
#pragma unroll
            for (int m = 0; m < 4; ++m) { const f32x4 x = *(const LAS f32x4*)(lds + OO + (st * 132 + sv + 4 * m) * 4); o[4 * m] = x[0] * dinv; o[4 * m + 1] = x[1] * dinv; o[4 * m + 2] = x[2] * dinv; o[4 * m + 3] = x[3] * dinv; }
            { float t0[8], t1[8]; unpack8(*(const LAS u32x4*)(lds + KB + (st * 136 + sv) * 2), t0); unpack8(*(const LAS u32x4*)(lds + KB + (st * 136 + sv + 8) * 2), t1);
#pragma unroll
              for (int j = 0; j < 8; ++j) { og[j] = t0[j]; og[8 + j] = t1[j]; }
              unpack8(*(const LAS u32x4*)(lds + XC + (st * 136 + sv) * 2), t0); unpack8(*(const LAS u32x4*)(lds + XC + (st * 136 + sv + 8) * 2), t1);
#pragma unroll
              for (int j = 0; j < 8; ++j) { xs[j] = t0[j]; xs[8 + j] = t1[j]; } }
            float ss = 0.f;
#pragma unroll
            for (int j = 0; j < 16; ++j) { o[j] *= sigmoidf_(og[j]); ss += o[j] * o[j]; }
            const float rs = rsqrtf(red8(ss) * (1.0f / 128.0f) + 1e-6f);
#pragma unroll
            for (int j = 0; j < 16; ++j) o[j] = o[j] * rs * F[MN + sv + j] + F[MS + sv + j] * xs[j];
            u32x4 w0, w1;
            w0.x = pk_bf16(o[0], o[1]); w0.y = pk_bf16(o[2], o[3]); w0.z = pk_bf16(o[4], o[5]); w0.w = pk_bf16(o[6], o[7]);
            w1.x = pk_bf16(o[8], o[9]); w1.y = pk_bf16(o[10], o[11]); w1.z = pk_bf16(o[12], o[13]); w1.w = pk_bf16(o[14], o[15]);
            bf16_t* yr = Y + (size_t)(b * SEQ + ch * 64 + st) * DM + 1024 + h * 128 + sv;
            *(u32x4*)yr = w0; *(u32x4*)(yr + 8) = w1;
        }
    }
#undef ML_PREFETCH
#undef ML_IDS
}

__device__ __forceinline__ void p2_lru(KP P, int l, int item, LAS unsigned char* lds) {
    const int tid = ltid(), lane = tid & 63, wave = tid >> 6, b = item >> 3, cgp = item & 7;
    const float* LA = (const float*)(P->ws + WS_LRUA); const float* LB = (const float*)(P->ws + WS_LRUB); bf16_t* Y = (bf16_t*)(P->ws + WS_HY);
    LAS float* F = LDSF(0);
    const size_t base = (size_t)(b * SEQ + wave * 512) * 512 + cgp * 64 + lane;
    float hh = 0.f, ap = 1.f;
#pragma unroll 8
    for (int t = 0; t < 512; ++t) { const float a = LA[base + (size_t)t * 512], x = LB[base + (size_t)t * 512]; hh = a * hh + x; ap *= a; }
    __syncthreads();
    F[wave * 64 + lane] = ap; F[512 + wave * 64 + lane] = hh;
    __syncthreads();
    float c = 0.f;
    for (int j = 0; j < wave; ++j) c = F[j * 64 + lane] * c + F[512 + j * 64 + lane];
    hh = c;
    bf16_t* yp = Y + (size_t)(b * SEQ + wave * 512) * DM + 1536 + cgp * 64 + lane;
#pragma unroll 8
    for (int t = 0; t < 512; ++t) { const float a = LA[base + (size_t)t * 512], x = LB[base + (size_t)t * 512]; hh = a * hh + x; yp[(size_t)t * DM] = (bf16_t)(pk_bf16(hh, 0.f) & 0xffffu); }

    {
        unsigned* bar0 = (unsigned*)(P->ws + WS_BAR + (size_t)P->li * WS_BAR_STRIDE);
        unsigned* fl = (unsigned*)(P->ws + WS_BAR + (size_t)30 * WS_BAR_STRIDE) + (l * 8 + b) * 64 + 32;
        asm volatile("s_waitcnt vmcnt(0)" ::: "memory");
        __syncthreads();
        if (threadIdx.x == 0) {
            __builtin_amdgcn_fence(__ATOMIC_RELEASE, "agent");
            asm volatile("s_waitcnt vmcnt(0)" ::: "memory");
            (void)xb_add(fl, 1u);
            XB_SPIN(xb_ld(fl) < 8u, bar0);
            __builtin_amdgcn_fence(__ATOMIC_ACQUIRE, "agent");
            asm volatile("s_waitcnt vmcnt(0)" ::: "memory");
        }
        __syncthreads();
        const bf16_t* U = (const bf16_t*)(P->ws + WS_U);
        const int c0 = lane * 8;
        float lrn[8];
#pragma unroll
        for (int j = 0; j < 8; ++j) lrn[j] = P->in[I_LRUNORM][l * 512 + c0 + j];
#pragma unroll 2
        for (int i = 0; i < 64; ++i) {
            const int tok = b * SEQ + cgp * 512 + wave * 64 + i;
            bf16_t* yr = Y + (size_t)tok * DM; const bf16_t* ur = U + (size_t)tok * LDU;
            float hv[8], gb[8], y8[8]; unpack8(*(const u32x4*)(yr + 1536 + c0), hv); unpack8(*(const u32x4*)(ur + U_LRU_G + c0), gb);
            float ss = 0.f;
#pragma unroll
            for (int j = 0; j < 8; ++j) { hv[j] *= gelu_tanhf_(gb[j]); ss += hv[j] * hv[j]; }
            const float rs = rsqrtf(red64(ss) * (1.0f / 512.0f) + 1e-6f);
#pragma unroll
            for (int j = 0; j < 8; ++j) y8[j] = hv[j] * rs * lrn[j];
            *(u32x4*)(yr + 1536 + c0) = pack8(y8);
        }
    }
}

__device__ __forceinline__ void phase_p3(KP P, int l) { (void)P; (void)l; }

#ifndef MK_ONE_LAUNCH
#define MK_ONE_LAUNCH 1
#endif
#ifndef MK_DEBUG_BAR
#define MK_DEBUG_BAR 0
#endif
#ifndef MK_FUSE_MASK
#define MK_FUSE_MASK 0x3FFFFFFull
#endif
#ifndef MK_SEAM_DELAY
#define MK_SEAM_DELAY 0
#endif
#ifndef MK_KIND_MASK
#define MK_KIND_MASK 0x40
#endif
#ifndef MK_P1_SPLIT
#define MK_P1_SPLIT 0
#endif
#ifndef MK_REPEAT_PHASE
#define MK_REPEAT_PHASE (-1)
#endif
#ifndef MK_REPEAT_ITEM
#define MK_REPEAT_ITEM (-1)
#endif
#ifndef MK_REPEAT_KIND
#define MK_REPEAT_KIND (-1)
#endif
#ifndef MK_SIMPLE_BAR
#define MK_SIMPLE_BAR 0
#endif
__device__ __forceinline__ void simple_barrier(unsigned* bar, unsigned& epoch) {
    asm volatile("s_waitcnt vmcnt(0)" ::: "memory");
    __syncthreads();
    if (threadIdx.x == 0) {
        __builtin_amdgcn_fence(__ATOMIC_RELEASE, "agent");
        asm volatile("s_waitcnt vmcnt(0)" ::: "memory");
        (void)xb_add(&bar[XB_TOP], 1u);
        const unsigned target = (epoch + 1u) * gridDim.x;
        XB_SPIN(xb_ld(&bar[XB_TOP]) < target, bar);
        __builtin_amdgcn_fence(__ATOMIC_ACQUIRE, "agent");
        asm volatile("s_waitcnt vmcnt(0)" ::: "memory");
    }
    ++epoch;
    __syncthreads();
}
enum { K_CONVERT = 0, K_MODFINAL, K_NORM, K_UP, K_DOWN, K_WIN, K_P1, K_P2, K_P3, K_WOUT, K_FINAL };
template <int KIND> __device__ __forceinline__ void run_phase(int l_, int sub_, LAS unsigned char* lds) {
    const int l = lsgpr(l_), sub = lsgpr(sub_);
    const KP P = kp_fresh();
    const float* modf = (const float*)(P->ws + WS_MODF);
    bf16_t* HY = (bf16_t*)(P->ws + WS_HY); bf16_t* UU = (bf16_t*)(P->ws + WS_U);
    const bf16_t* Wl = (const bf16_t*)(P->ws + WS_W) + (size_t)l * LW_ELEMS;
    bf16_t* XB = (bf16_t*)P->out; bf16_t* XFIN = (bf16_t*)(P->ws + WS_LRUA);
    const int xf32 = (l == 0 && sub == 0) ? 1 : 0;
    const void* xcur = xf32 ? (const void*)P->in[I_X] : (const void*)XB;
    const int f = sub >> 1;
    if constexpr (KIND == K_CONVERT) phase_convert(P, lds);
    if constexpr (KIND == K_MODFINAL) phase_modfinal(P);
    if constexpr (KIND == K_NORM) phase_norm(P, l, sub, xcur, xf32, lds);
    if constexpr (KIND == K_UP) {
        pg8::Gemm g{HY, Wl + (f ? LW_W13B : LW_W13A), NTOK, 2 * DFF, DM}; pg8::StaticOrder S; S.init(NTOK, 2 * DFF, lgdim(), lbid());
        EpiSwiGLU E{UU};
        pg8::gemm_phase<EpiSwiGLU, pg8::StaticOrder, true, true>(lds, g, S, E);
    }
    if constexpr (KIND == K_DOWN) {
        pg8::Gemm g{UU, Wl + (f ? LW_W2B : LW_W2A), NTOK, DM, DFF}; pg8::StaticOrder S; S.init(NTOK, DM, lgdim(), lbid(), 4);
        EpiResid E{xcur, (l == 1 && sub == 2) ? XFIN : XB, modf + (size_t)l * 8 * NMOD + sub * 6144 + 4096, 0.5f, xf32};
        pg8::gemm_phase<EpiResid, pg8::StaticOrder, true, true>(lds, g, S, E);
    }
    if constexpr (KIND == K_WIN) {
        pg8::Gemm g{HY, Wl + LW_WIN, NTOK, LDU, DM}; pg8::StaticOrder S; S.init(NTOK, LDU, lgdim(), lbid());
        EpiU E{UU};
        pg8::gemm_phase<EpiU, pg8::StaticOrder, true, true>(lds, g, S, E);
    }
    if constexpr (KIND == K_P1) { const int part = P->pad; if (part != 2) p1_rw_lora(P, l, lds); if (part != 1) p1_lru_prep(P, l, lds); }
    if constexpr (KIND == K_P2) {
        for (int it = lbid(); it < 256; it += lgdim()) {
            if (it < 64) { _Pragma("unroll 1") for (int rep = 0; rep < ((MK_REPEAT_ITEM == 0) ? 2 : 1); ++rep) p2_rw(P, l, it, lds); }
            else if (it < 96) { p2_hg(P, l, it - 64, lds); if (MK_REPEAT_ITEM == 1) p2_hg(P, l, it - 64, lds); }
            else if (it < 128) { p2_ml(P, l, it - 96, lds); if (MK_REPEAT_ITEM == 2) p2_ml(P, l, it - 96, lds); }
            else if (it < 192) { p2_lru(P, l, it - 128, lds); }
        }
        if (l == 0) convert_dynamic(P, lds);
    }
    if constexpr (KIND == K_P3) phase_p3(P, l);
    if constexpr (KIND == K_WOUT) {
        pg8::Gemm g{HY, Wl + LW_WOUT, NTOK, DM, DM}; pg8::StaticOrder S; S.init(NTOK, DM, lgdim(), lbid(), 4);
        EpiResid E{XB, XB, modf + (size_t)l * 8 * NMOD + 1 * 6144 + 4096, 1.0f, 0};
        pg8::gemm_phase<EpiResid, pg8::StaticOrder, true, true>(lds, g, S, E);
    }
    if constexpr (KIND == K_FINAL) phase_final_norm(P, XFIN);
}

template <int KIND> __global__ void __launch_bounds__(NTHR, 2) k_phase(Params P_unused, int l, int sub) {
    extern __shared__ __attribute__((aligned(16))) unsigned char lds_raw[];
    run_phase<KIND>(l, sub, (LAS unsigned char*)lds_raw);
}
constexpr int N_PHASES = 27;
__global__ void __launch_bounds__(NTHR, 2) hymba_fwd(Params P_unused) {
    extern __shared__ __attribute__((aligned(16))) unsigned char lds_raw[];
    LAS unsigned char* lds = (LAS unsigned char*)lds_raw;
    const KP P = kp_fresh();
    const int lo = P->ph_lo, hi = P->ph_hi;
    if (threadIdx.x == 0) *(LAS u32x4*)(lds + LDS_BARW) = (u32x4){0u, 0u, 0u, 0u};
    __syncthreads();
    unsigned* barw = (unsigned*)(P->ws + WS_BAR + (size_t)P->li * WS_BAR_STRIDE);
    XcdBarrier bar = xcd_barrier_post(barw, (volatile LAS unsigned*)(lds + LDS_BARW));
#define SEAM(k) do { if ((k) + 1 < hi) xcd_barrier(bar); } while (0)
#define IN(k) (lo <= (k) && (k) < hi)
#define PH(k, KIND, l, sub) do { if (IN(k)) { run_phase<KIND>(l, sub, lds); if ((MK_REPEAT_KIND) == (KIND) || (MK_REPEAT_PHASE) == (k)) { xcd_barrier(bar); run_phase<KIND>(l, sub, lds); } SEAM(k); } } while (0)
    PH(0, K_CONVERT, 0, 0);
    PH(1, K_MODFINAL, 0, 0);
#define LAYER(l, b) \
    PH((b) + 0, K_NORM, l, 0); PH((b) + 1, K_UP, l, 0); PH((b) + 2, K_DOWN, l, 0); \
    PH((b) + 3, K_NORM, l, 1); PH((b) + 4, K_WIN, l, 1); PH((b) + 5, K_P1, l, 1); PH((b) + 6, K_P2, l, 1); PH((b) + 8, K_WOUT, l, 1); \
    PH((b) + 9, K_NORM, l, 2); PH((b) + 10, K_UP, l, 2); PH((b) + 11, K_DOWN, l, 2);
    LAYER(0, 2)
    LAYER(1, 14)
#undef LAYER
    if (IN(26)) run_phase<K_FINAL>(0, 0, lds);
    {
        unsigned bad = 0u;
        if (IN(26)) { for (int li = 0; li < 32; ++li) bad |= __hip_atomic_load((unsigned*)(P->ws + WS_BAR + (size_t)li * WS_BAR_STRIDE) + XB_TMO, __ATOMIC_RELAXED, __HIP_MEMORY_SCOPE_AGENT); }
        if (bad) { const float qn = __builtin_nanf(""); for (size_t i = (size_t)blockIdx.x * NTHR + threadIdx.x; i < (size_t)NTOK * DM; i += (size_t)gridDim.x * NTHR) P->out[i] = qn; }
    }
#undef PH
#undef IN
#undef SEAM
}

#if 1
template <int KIND> static void launch_phase(const Params& p, int l, int sub, int grid, hipStream_t stream) {
    static bool attr_set = false;
    if (!attr_set) { (void)hipFuncSetAttribute((const void*)k_phase<KIND>, hipFuncAttributeMaxDynamicSharedMemorySize, LDS_BYTES); attr_set = true; }
    hipLaunchKernelGGL(k_phase<KIND>, dim3(grid), dim3(NTHR), LDS_BYTES, stream, p, l, sub);
}
#endif
extern "C" void kernel_launch(void* const* d_in, const int* in_sizes, int n_in, void* d_out, int out_size, void* d_ws, size_t ws_size, hipStream_t stream) {
    static int grid = 0;
    if (grid == 0) {
        if (n_in != N_IN || out_size != NTOK * DM || ws_size < WS_END) { fprintf(stderr, "kernel_launch: unexpected shapes (n_in %d, out %d, ws %zu < %zu)\n", n_in, out_size, ws_size, (size_t)WS_END); grid = -1; return; }
        int dev = 0, cus = 0;
        if (hipGetDevice(&dev) != hipSuccess || hipDeviceGetAttribute(&cus, hipDeviceAttributeMultiprocessorCount, dev) != hipSuccess) { grid = -1; return; }
#if MK_ONE_LAUNCH
        int per_cu = 0;
        if (hipFuncSetAttribute((const void*)hymba_fwd, hipFuncAttributeMaxDynamicSharedMemorySize, LDS_BYTES) != hipSuccess) { fprintf(stderr, "kernel_launch: hipFuncSetAttribute failed\n"); grid = -1; return; }
        if (hipOccupancyMaxActiveBlocksPerMultiprocessor(&per_cu, (const void*)hymba_fwd, NTHR, LDS_BYTES) != hipSuccess || per_cu < 1) fprintf(stderr, "kernel_launch: occupancy query says %d\n", per_cu);
        (void)hipGetLastError();
#endif
        grid = cus;
        if (grid != 256) fprintf(stderr, "kernel_launch: %d CUs (built for 256)\n", grid);
    }
    if (grid < 0) return;
    Params p{};
    for (int i = 0; i < N_IN; ++i) p.in[i] = (const float*)d_in[i];
    p.out = (float*)d_out; p.ws = (unsigned char*)d_ws;
#if MK_ONE_LAUNCH
    (void)hipMemsetAsync((char*)d_ws + WS_BAR, 0, 32 * WS_BAR_STRIDE, stream);
    {
        int lo = 0, li = 0;
        for (int k = 0; k < N_PHASES; ++k) {
            const bool fused = (k + 1 < N_PHASES) && ((MK_FUSE_MASK >> k) & 1ull);
            if (!fused) { p.ph_lo = lo; p.ph_hi = k + 1; p.li = li++; hipLaunchKernelGGL(hymba_fwd, dim3(grid), dim3(NTHR), LDS_BYTES, stream, p); lo = k + 1; }
        }
    }
#else
    (void)hipMemsetAsync((char*)d_ws + WS_BAR, 0, 32 * WS_BAR_STRIDE, stream);
    static bool attr2 = false;
    if (!attr2) { (void)hipFuncSetAttribute((const void*)hymba_fwd, hipFuncAttributeMaxDynamicSharedMemorySize, LDS_BYTES); attr2 = true; }
    int k = 0;
#define LAUNCH(KIND, l, sub) do { if ((MK_KIND_MASK >> (KIND)) & 1) { p.ph_lo = k; p.ph_hi = k + 1; p.li = 0; hipLaunchKernelGGL(hymba_fwd, dim3(grid), dim3(NTHR), LDS_BYTES, stream, p); } \
        else { p.ph_lo = 0; p.ph_hi = 0; launch_phase<KIND>(p, l, sub, grid, stream); } ++k; } while (0)
    LAUNCH(K_CONVERT, 0, 0);
    LAUNCH(K_MODFINAL, 0, 0);
    for (int l = 0; l < 2; ++l)
        for (int sub = 0; sub < 3; ++sub) {
            LAUNCH(K_NORM, l, sub);
            if (sub != 1) { LAUNCH(K_UP, l, sub); LAUNCH(K_DOWN, l, sub); }
            else { LAUNCH(K_WIN, l, sub); {
                   if (MK_P1_SPLIT == 0) { LAUNCH(K_P1, l, sub); }
                   else { const int fa = (MK_P1_SPLIT == 1);
                       p.pad = 1; if (fa) { p.ph_lo = k; p.ph_hi = k + 1; p.li = 0; hipLaunchKernelGGL(hymba_fwd, dim3(grid), dim3(NTHR), LDS_BYTES, stream, p); } else { p.ph_lo = 0; p.ph_hi = 0; launch_phase<K_P1>(p, l, sub, grid, stream); }
                       p.pad = 2; if (!fa) { p.ph_lo = k; p.ph_hi = k + 1; p.li = 0; hipLaunchKernelGGL(hymba_fwd, dim3(grid), dim3(NTHR), LDS_BYTES, stream, p); } else { p.ph_lo = 0; p.ph_hi = 0; launch_phase<K_P1>(p, l, sub, grid, stream); }
                       p.pad = 0; ++k; } } LAUNCH(K_P2, l, sub); LAUNCH(K_P3, l, sub); LAUNCH(K_WOUT, l, sub); }
        }
    LAUNCH(K_FINAL, 0, 0);
#undef LAUNCH
#endif
}
```

```cpp
#include <hip/hip_runtime.h>
#include <cstdio>
#include <cstdint>
__device__ __forceinline__ int ltid() { int t = (int)threadIdx.x; asm volatile("" : "+v"(t)); return t; }
__device__ __forceinline__ int lbid() { int x = (int)blockIdx.x; asm volatile("" : "+s"(x)); return x; }
__device__ __forceinline__ int lgdim() { int x = (int)gridDim.x; asm volatile("" : "+s"(x)); return x; }
__device__ __forceinline__ int lsgpr(int x) { asm volatile("" : "+s"(x)); return x; }
namespace pg8 {
#define PG8_LAS __attribute__((address_space(3)))
typedef unsigned short bf16_t;
typedef short bf16x8 __attribute__((ext_vector_type(8)));
typedef float f32x4 __attribute__((ext_vector_type(4)));
typedef unsigned u32x4 __attribute__((ext_vector_type(4)));
constexpr int BM = 256, BK = 64, HALF = 128, HTB = HALF * BK * 2  , STAGE_BYTES = 8 * HTB, NXCD = 8, WGM = 8;

__host__ __device__ __forceinline__ int lds_byte(int r, int c) { const int st = (r >> 4) * 2 + (c >> 5), rr = r & 15, cc = c & 31, ob = rr * 64 + cc * 2; return st * 1024 + (ob ^ (((ob >> 9) & 1) << 5)); }
__host__ __device__ __forceinline__ void stage_rc(int b, int& R, int& C) { const int st = b / 1024, sb = b % 1024, swz = sb ^ (((sb >> 9) & 1) << 5); R = (st >> 1) * 16 + swz / 64; C = (st & 1) * 32 + (swz % 64) / 2; }
__host__ __device__ __forceinline__ int perm32(int rho) { const int n = rho >> 4, i = rho & 15; return 8 * (i >> 2) + 4 * n + (i & 3); }

struct Unit { int pm, pn; };
struct Gemm { const bf16_t* A; const bf16_t* Bt; int M, N, K; };

struct StaticOrder {
    int nM, nN, nwg, G, c, wgm;
    __host__ __device__ void init(int M, int N, int G_, int c_, int wgm_ = WGM) { nM = M / BM; nN = N / BM; nwg = nM * nN; G = G_; c = c_; wgm = wgm_; }
    __host__ __device__ bool next(int i, Unit& u) const {
        const long L = (long)i * G + c; if (L >= nwg) return false;
        int wgid = (int)L; { const int q = nwg / NXCD, r = nwg % NXCD, xcd = wgid % NXCD, off = wgid / NXCD; wgid = (xcd < r ? xcd * (q + 1) : r * (q + 1) + (xcd - r) * q) + off; }
        const int nig = wgm * nN, gid = wgid / nig, fm = gid * wgm, gsz = (nM - fm) < wgm ? (nM - fm) : wgm;
        u.pm = fm + ((wgid % nig) % gsz); u.pn = (wgid % nig) / gsz; return true;
    }
    __device__ __forceinline__ void a_ready(const Unit&) const {}
    __device__ __forceinline__ void done(const Unit&) const {}
};
template <class Epi, class Sched, bool ALIGN_EPI = false, bool SP2 = false>
__device__ __forceinline__ void gemm_phase(PG8_LAS unsigned char* lds, const Gemm g, const Sched& S, const Epi& E) {
    const int tid = ltid(), wid = __builtin_amdgcn_readfirstlane(tid >> 6), lane = tid & 63, wr = wid >> 2, wc = wid & 3, fr = lane & 15, fq = lane >> 4;
    const int K = g.K, nt = K / BK;
    unsigned voffA[2], voffB[2];
#pragma unroll
    for (int i = 0; i < 2; ++i) { int R, C; stage_rc(tid * 16 + i * 8192, R, C); const int Rb = Epi::PERM ? ((R & ~31) + perm32(R & 31)) : R;
        voffA[i] = (unsigned)(R * K + C) * 2u; voffB[i] = (unsigned)(Rb * K + C) * 2u; }
    const size_t kstep = (size_t)(BK * 2);
    const size_t hstep = (size_t)HALF * K * 2;
    const size_t tstep = 2 * hstep;
    const unsigned ldsw = (unsigned)wid * 1024u;
    const int aoff = lds_byte(wr * 64 + fr, fq * 8), boff = lds_byte(wc * 32 + fr, fq * 8);
#define PG8_SA(b, h) (((b) * 2 + (h)) * HTB)
#define PG8_SB(b, h) ((4 + (b) * 2 + (h)) * HTB)
#define PG8_STAGE(bufoff, gbase, voff) do { _Pragma("unroll") for (int _i = 0; _i < 2; ++_i) \
        __builtin_amdgcn_global_load_lds((const unsigned*)((const char*)(gbase) + (voff)[_i]), (PG8_LAS unsigned*)(lds + (bufoff) + ldsw + _i * 8192), 16, 0, 0); } while (0)
#define PG8_LDA(dst, b, h) do { _Pragma("unroll") for (int m = 0; m < 4; ++m) _Pragma("unroll") for (int k = 0; k < 2; ++k) dst[m][k] = *(const PG8_LAS bf16x8*)(lds + PG8_SA(b, h) + aoff + m * 2048 + k * 1024); } while (0)
#define PG8_LDB(dst, b, h) do { _Pragma("unroll") for (int n = 0; n < 2; ++n) _Pragma("unroll") for (int k = 0; k < 2; ++k) dst[n][k] = *(const PG8_LAS bf16x8*)(lds + PG8_SB(b, h) + boff + n * 2048 + k * 1024); } while (0)
#define PG8_MMA(ai, bj, At, Bt) do { __builtin_amdgcn_s_setprio(1); _Pragma("unroll") for (int m = 0; m < 4; ++m) _Pragma("unroll") for (int n = 0; n < 2; ++n) _Pragma("unroll") for (int k = 0; k < 2; ++k) \
        acc[ai][bj][m][n] = __builtin_amdgcn_mfma_f32_16x16x32_bf16(Bt[n][k], At[m][k], acc[ai][bj][m][n], 0, 0, 0); __builtin_amdgcn_s_setprio(0); } while (0)
#define PG8_WAIT_V(n) asm volatile("s_waitcnt vmcnt(" #n ")" ::: "memory")
#define PG8_WAIT_L(n) asm volatile("s_waitcnt lgkmcnt(" #n ")" ::: "memory")
#define PG8_BAR __builtin_amdgcn_s_barrier()
#define PG8_SCHED __builtin_amdgcn_sched_barrier(0)
    Unit cur, nxt; int ui = 0;
    if (!S.next(0, cur)) return;
    f32x4 acc[2][2][4][2];
#pragma unroll
    for (int a = 0; a < 2; ++a)
#pragma unroll
        for (int b = 0; b < 2; ++b)
#pragma unroll
            for (int m = 0; m < 4; ++m)
#pragma unroll
                for (int n = 0; n < 2; ++n) acc[a][b][m][n] = (f32x4){0.f, 0.f, 0.f, 0.f};
    bf16x8 At[4][2], B0[2][2], B1[2][2];
    const char* cA = (const char*)g.A + (size_t)cur.pm * tstep; const char* cB = (const char*)g.Bt + (size_t)cur.pn * tstep;
    S.a_ready(cur);
    if constexpr (SP2) {
        PG8_STAGE(PG8_SB(0, 0), cB, voffB); PG8_STAGE(PG8_SB(0, 1), cB + hstep, voffB); PG8_STAGE(PG8_SA(0, 0), cA, voffA); PG8_STAGE(PG8_SA(0, 1), cA + hstep, voffA);
        if (wr == 1) PG8_BAR;
        PG8_WAIT_V(2); PG8_BAR;
        PG8_STAGE(PG8_SB(1, 0), cB + kstep, voffB); PG8_STAGE(PG8_SA(1, 0), cA + kstep, voffA); PG8_STAGE(PG8_SB(1, 1), cB + hstep + kstep, voffB);
        PG8_WAIT_V(6); PG8_BAR;
    } else {
        PG8_STAGE(PG8_SB(0, 0), cB, voffB); PG8_STAGE(PG8_SA(0, 0), cA, voffA); PG8_STAGE(PG8_SB(0, 1), cB + hstep, voffB); PG8_STAGE(PG8_SA(0, 1), cA + hstep, voffA);
        if (wr == 1) PG8_BAR;
        PG8_WAIT_V(4); PG8_BAR;
        PG8_STAGE(PG8_SB(1, 0), cB + kstep, voffB); PG8_STAGE(PG8_SA(1, 0), cA + kstep, voffA); PG8_STAGE(PG8_SB(1, 1), cB + hstep + kstep, voffB);
        PG8_WAIT_V(6); PG8_BAR;
    }
    for (;;) {
        const bool has_next = S.next(ui + 1, nxt);
        const char* nA = has_next ? (const char*)g.A + (size_t)nxt.pm * tstep : cA; const char* nB = has_next ? (const char*)g.Bt + (size_t)nxt.pn * tstep : cB;
        for (int t = 0; t < nt; t += 2) {
            const bool last = (t == nt - 2);
            const char* a1 = cA + (size_t)(t + 1) * kstep;
            const char* a2 = last ? nA : cA + (size_t)(t + 2) * kstep; const char* b2 = last ? nB : cB + (size_t)(t + 2) * kstep;
            const char* a3 = a2 + kstep; const char* b3 = b2 + kstep;
            if (last && has_next) S.a_ready(nxt);
            if constexpr (SP2) {
            PG8_LDB(B0, 0, 0); PG8_LDB(B1, 0, 1); PG8_SCHED; PG8_LDA(At, 0, 0); PG8_STAGE(PG8_SA(1, 1), a1 + hstep, voffA);
            PG8_WAIT_V(8); PG8_WAIT_L(0); PG8_BAR; PG8_MMA(0, 0, At, B0); PG8_MMA(0, 1, At, B1); PG8_BAR; PG8_SCHED;
            PG8_LDA(At, 0, 1); PG8_STAGE(PG8_SB(0, 0), b2, voffB); PG8_STAGE(PG8_SB(0, 1), b2 + hstep, voffB); PG8_STAGE(PG8_SA(0, 0), a2, voffA);
            PG8_WAIT_V(8); PG8_WAIT_L(0); PG8_BAR; PG8_MMA(1, 0, At, B0); PG8_MMA(1, 1, At, B1); PG8_BAR; PG8_SCHED;
            PG8_LDB(B0, 1, 0); PG8_LDB(B1, 1, 1); PG8_SCHED; PG8_LDA(At, 1, 0); PG8_STAGE(PG8_SA(0, 1), a2 + hstep, voffA);
            PG8_WAIT_V(8); PG8_WAIT_L(0); PG8_BAR; PG8_MMA(0, 0, At, B0); PG8_MMA(0, 1, At, B1); PG8_BAR; PG8_SCHED;
            PG8_LDA(At, 1, 1); PG8_STAGE(PG8_SB(1, 0), b3, voffB); PG8_STAGE(PG8_SB(1, 1), b3 + hstep, voffB); PG8_STAGE(PG8_SA(1, 0), a3, voffA);
            PG8_WAIT_V(8); PG8_WAIT_L(0); PG8_BAR; PG8_MMA(1, 0, At, B0); PG8_MMA(1, 1, At, B1); PG8_BAR; PG8_SCHED;
            } else {
            PG8_LDB(B0, 0, 0); PG8_SCHED; PG8_LDA(At, 0, 0); PG8_STAGE(PG8_SA(1, 1), a1 + hstep, voffA);
            PG8_WAIT_L(8); PG8_BAR; PG8_WAIT_L(0); PG8_MMA(0, 0, At, B0); PG8_BAR; PG8_SCHED;
            PG8_LDB(B1, 0, 1); PG8_STAGE(PG8_SB(0, 0), b2, voffB);
            PG8_BAR; PG8_WAIT_L(0); PG8_MMA(0, 1, At, B1); PG8_BAR;
            PG8_LDA(At, 0, 1); PG8_STAGE(PG8_SA(0, 0), a2, voffA);
            PG8_BAR; PG8_WAIT_L(0); PG8_MMA(1, 0, At, B0); PG8_BAR; PG8_SCHED;
            PG8_STAGE(PG8_SB(0, 1), b2 + hstep, voffB);
            PG8_WAIT_V(6); PG8_BAR; PG8_MMA(1, 1, At, B1); PG8_BAR;
            PG8_LDB(B0, 1, 0); PG8_SCHED; PG8_LDA(At, 1, 0); PG8_STAGE(PG8_SA(0, 1), a2 + hstep, voffA);
            PG8_WAIT_L(8); PG8_BAR; PG8_WAIT_L(0); PG8_MMA(0, 0, At, B0); PG8_BAR; PG8_SCHED;
            PG8_LDB(B1, 1, 1); PG8_STAGE(PG8_SB(1, 0), b3, voffB);
            PG8_BAR; PG8_WAIT_L(0); PG8_MMA(0, 1, At, B1); PG8_BAR;
            PG8_LDA(At, 1, 1); PG8_STAGE(PG8_SA(1, 0), a3, voffA);
            PG8_BAR; PG8_WAIT_L(0); PG8_MMA(1, 0, At, B0); PG8_BAR; PG8_SCHED;
            PG8_STAGE(PG8_SB(1, 1), b3 + hstep, voffB);
            PG8_WAIT_V(6); PG8_BAR; PG8_MMA(1, 1, At, B1); PG8_BAR;
            }
        }
        if constexpr (ALIGN_EPI) { if (wr == 0) PG8_BAR; }
        if constexpr (!Epi::AFTER_DRAIN) { E(acc, cur, wr, wc, fr, fq); S.done(cur); }
        if (!has_next) break;
#pragma unroll
        for (int a = 0; a < 2; ++a)
#pragma unroll
            for (int b = 0; b < 2; ++b)
#pragma unroll
                for (int m = 0; m < 4; ++m)
#pragma unroll
                    for (int n = 0; n < 2; ++n) acc[a][b][m][n] = (f32x4){0.f, 0.f, 0.f, 0.f};
        cur = nxt; cA = nA; cB = nB; ++ui;
        if constexpr (ALIGN_EPI) { if (wr == 1) PG8_BAR; }
    }
    PG8_WAIT_V(0);
    if constexpr (!ALIGN_EPI) { if (wr == 0) PG8_BAR; }
    PG8_BAR;
    if constexpr (Epi::AFTER_DRAIN) { E.fused(acc, cur, wr, wc, fr, fq, lds, wid, lane); S.done(cur); }
#undef PG8_SA
#undef PG8_SB
#undef PG8_STAGE
#undef PG8_LDA
#undef PG8_LDB
#undef PG8_MMA
#undef PG8_WAIT_V
#undef PG8_WAIT_L
#undef PG8_BAR
#undef PG8_SCHED
}
}
#define XB_TMO      128
#define XB_XCNT(j)  (256  + 64 * (j))
#define XB_XSUB(j)  (1280 + 64 * (j))
#define XB_XGEN(j)  (2304 + 64 * (j))
#define XB_TOP      3328
#define XB_TOPGEN   3392
#define XCD_BAR_WORDS 3456
#define XB_SPIN_CAP (1u << 18)
#define LAS __attribute__((address_space(3)))

__device__ __forceinline__ unsigned xb_ld(unsigned* p)              { return __hip_atomic_load(p, __ATOMIC_RELAXED, __HIP_MEMORY_SCOPE_AGENT); }
__device__ __forceinline__ unsigned xb_add(unsigned* p, unsigned v) { return __hip_atomic_fetch_add(p, v, __ATOMIC_RELAXED, __HIP_MEMORY_SCOPE_AGENT); }
__device__ __forceinline__ unsigned xb_xcc_id() { return (unsigned)__builtin_amdgcn_s_getreg((3 << 11) | 20) & 0xFu; }
#define XB_SPIN(cond, bar) do { unsigned _sp = 0; while (cond) { __builtin_amdgcn_s_sleep(1); \
    if ((++_sp & 255u) == 0u) { if (xb_ld(&(bar)[XB_TMO])) break; if (_sp > XB_SPIN_CAP) { atomicAdd(&(bar)[XB_TMO], 1u); break; } } } } while (0)

struct XcdBarrier {
    unsigned* bar; unsigned x;
    volatile LAS unsigned* st;
};

__device__ __forceinline__ XcdBarrier xcd_barrier_post(unsigned* bar, volatile LAS unsigned* st) {
    XcdBarrier b; b.bar = bar; b.x = xb_xcc_id(); b.st = st;
    if (threadIdx.x == 0) (void)xb_add(&bar[XB_XCNT(b.x)], 1u);
    return b;
}
__device__ __forceinline__ void xcd_barrier_complete(unsigned* bar, unsigned x, unsigned& nloc, unsigned& nx) {
    const unsigned G = gridDim.x * gridDim.y * gridDim.z;
    unsigned sum, cnt, mine, sp = 0u;
    for (;;) {
        sum = 0u; cnt = 0u; mine = 0u;
#pragma unroll
        for (unsigned j = 0; j < 16; ++j) { const unsigned c = xb_ld(&bar[XB_XCNT(j)]); sum += c; cnt += (c > 0u) ? 1u : 0u; mine = (j == x) ? c : mine; }
        if (sum == G) break;
        __builtin_amdgcn_s_sleep(1);
        if ((++sp & 255u) == 0u) { if (xb_ld(&bar[XB_TMO])) break; if (sp > XB_SPIN_CAP) { atomicAdd(&bar[XB_TMO], 1u); break; } }
    }
    nloc = mine > 0u ? mine : 1u; nx = cnt > 0u ? cnt : 1u;
}

__device__ __forceinline__ void xcd_barrier(const XcdBarrier& b) {
    asm volatile("s_waitcnt vmcnt(0)" ::: "memory");
    __syncthreads();
    if (threadIdx.x == 0) {
        unsigned* bar = b.bar;
        __builtin_amdgcn_s_waitcnt(0);
        unsigned nloc = b.st[0], nx = b.st[1];
        if (nloc == 0u) { xcd_barrier_complete(bar, b.x, nloc, nx); b.st[0] = nloc; b.st[1] = nx; }
        const unsigned old = xb_add(&bar[XB_XSUB(b.x)], 1u);
        const unsigned gen = old / nloc;
        if (old + 1u == (gen + 1u) * nloc) {
            __builtin_amdgcn_fence(__ATOMIC_RELEASE, "agent");
            asm volatile("s_waitcnt vmcnt(0)" ::: "memory");
            const unsigned og = xb_add(&bar[XB_TOP], 1u);
            const unsigned tg = og / nx;
            if (og + 1u == (tg + 1u) * nx) xb_add(&bar[XB_TOPGEN], 1u);
            else XB_SPIN(xb_ld(&bar[XB_TOPGEN]) == tg, bar);
            __builtin_amdgcn_fence(__ATOMIC_ACQUIRE, "agent");
            xb_add(&bar[XB_XGEN(b.x)], 1u);
            asm volatile("s_waitcnt vmcnt(0)" ::: "memory");
        } else {
            XB_SPIN(xb_ld(&bar[XB_XGEN(b.x)]) == gen, bar);
            __builtin_amdgcn_fence(__ATOMIC_ACQUIRE, "agent");
            asm volatile("s_waitcnt vmcnt(0)" ::: "memory");
        }
    }
    __syncthreads();
}

typedef unsigned short bf16_t;
typedef short bf16x8 __attribute__((ext_vector_type(8)));
typedef float f32x4 __attribute__((ext_vector_type(4)));
typedef float f32x2 __attribute__((ext_vector_type(2)));
typedef unsigned u32x4 __attribute__((ext_vector_type(4)));
typedef unsigned u32x2 __attribute__((ext_vector_type(2)));

constexpr int NB = 8, SEQ = 4096, DM = 2048, NTOK = NB * SEQ, DFF = 5632, DIN = 6312, LDU = 6400, NMOD = 18432, NTHR = 512;
constexpr int U_HG_Q = 0, U_HG_F = 512, U_HG_I = 1024, U_HG_G = 1536;
constexpr int U_RW_R = 2048, U_RW_K = 2560, U_RW_V = 3072, U_RW_WD = 3584;
constexpr int U_ML_X = 3744, U_ML_V = 4256, U_ML_O = 4768, U_ML_I = 5280, U_ML_F = 5284;
constexpr int U_LRU_X = 5288, U_LRU_G = 5800;
constexpr int RW_IN = 1696;

enum { I_X = 0, I_C, I_GAIN, I_MODW, I_MODB, I_W1, I_W3, I_W2, I_WIN, I_WOUT, I_HGLB, I_HGNORM, I_RWMU, I_RWW0, I_RWW2, I_RWA0, I_RWA2, I_RWG2, I_RWKK, I_RWKA,
       I_RWRK, I_RWLNW, I_RWLNB, I_MLCW, I_MLCB, I_MLWQ, I_MLWK, I_MLIB, I_MLFB, I_MLNORM, I_MLSKIP, I_LRUCW, I_LRUCB, I_LRUWA, I_LRUBA, I_LRUWX, I_LRUBX,
       I_LRULAM, I_LRUNORM, I_FNORM, N_IN };

constexpr size_t WS_BAR = 0;
constexpr size_t WS_BAR_STRIDE = 16384, WS_MODP = 32 * WS_BAR_STRIDE;
constexpr size_t WS_MODF = WS_MODP + (size_t)2 * 16 * 8 * NMOD * 4;
constexpr size_t WS_LRUW = WS_MODF + (size_t)2 * 8 * NMOD * 4;
constexpr size_t WS_W = WS_LRUW + (size_t)2 * 2 * 4 * 16384 * 2;
constexpr size_t LW_W13A = 0, LW_W2A = 23068672, LW_W13B = 34603008, LW_W2B = 57671680, LW_WIN = 69206016, LW_WOUT = 82313216, LW_ELEMS = 86507520;
constexpr size_t WS_HY = WS_W + 2 * LW_ELEMS * 2;
constexpr size_t WS_U = WS_HY + (size_t)NTOK * DM * 2;
constexpr size_t WS_LRUA = WS_U + (size_t)NTOK * LDU * 2;
constexpr size_t WS_LRUB = WS_LRUA + (size_t)NTOK * 512 * 4;
constexpr size_t WS_RWW = WS_LRUB + (size_t)NTOK * 512 * 4;
constexpr size_t WS_RWA = WS_RWW + (size_t)NTOK * 512 * 4;
constexpr size_t WS_RWG = WS_RWA + (size_t)NTOK * 512 * 2;
constexpr size_t WS_LORAT = WS_RWG + (size_t)NTOK * 512 * 2;
constexpr size_t WS_END = WS_LORAT + (size_t)2 * 512 * 160 * 2;

constexpr int LDS_BYTES = 144 * 1024;
constexpr int LDS_BARW = LDS_BYTES - 16;

struct Params { const float* in[N_IN]; float* out; unsigned char* ws; int ph_lo, ph_hi, li, pad; };
typedef const Params __attribute__((address_space(4)))* KP;
__device__ __forceinline__ KP kp_fresh() { KP p = (KP)__builtin_amdgcn_kernarg_segment_ptr(); asm volatile("" : "+s"(p)); return p; }

__device__ __forceinline__ float bflo(unsigned w) { return __uint_as_float(w << 16); }
__device__ __forceinline__ float bfhi(unsigned w) { return __uint_as_float(w & 0xffff0000u); }
__device__ __forceinline__ float bf2f(bf16_t h) { return __uint_as_float(((unsigned)h) << 16); }
typedef __bf16 bf16x2n __attribute__((ext_vector_type(2)));
__device__ __forceinline__ unsigned pk_bf16(float lo, float hi) { const f32x2 v = {lo, hi}; return __builtin_bit_cast(unsigned, __builtin_convertvector(v, bf16x2n)); }
__device__ __forceinline__ void unpack8(const u32x4 w, float (&f)[8]) { f[0] = bflo(w.x); f[1] = bfhi(w.x); f[2] = bflo(w.y); f[3] = bfhi(w.y); f[4] = bflo(w.z); f[5] = bfhi(w.z); f[6] = bflo(w.w); f[7] = bfhi(w.w); }
__device__ __forceinline__ u32x4 pack8(const float (&f)[8]) { u32x4 w; w.x = pk_bf16(f[0], f[1]); w.y = pk_bf16(f[2], f[3]); w.z = pk_bf16(f[4], f[5]); w.w = pk_bf16(f[6], f[7]); return w; }
__device__ __forceinline__ float fast_rcp(float x) { return __builtin_amdgcn_rcpf(x); }
__device__ __forceinline__ float sigmoidf_(float x) { return fast_rcp(1.0f + __expf(-x)); }
__device__ __forceinline__ float siluf_(float x) { return x * sigmoidf_(x); }
__device__ __forceinline__ float softplusf_(float x) { return fmaxf(x, 0.0f) + __logf(1.0f + __expf(-fabsf(x))); }
__device__ __forceinline__ float tanhf_(float x) { const float e = __expf(2.0f * x); return 1.0f - 2.0f * fast_rcp(e + 1.0f); }
__device__ __forceinline__ float gelu_tanhf_(float x) { return 0.5f * x * (1.0f + tanhf_(0.7978845608028654f * (x + 0.044715f * x * x * x))); }
template <int CTRL> __device__ __forceinline__ float dpp_f(float x) { return __int_as_float(__builtin_amdgcn_update_dpp(0, __float_as_int(x), CTRL, 0xF, 0xF, true)); }
__device__ __forceinline__ float wave_scan_sum(float x) {
#define DPP_SC_(v, old, ctrl, rmask) __int_as_float(__builtin_amdgcn_update_dpp(__float_as_int(old), __float_as_int(v), ctrl, rmask, 0xF, false))
    x += DPP_SC_(x, 0.f, 0x111, 0xF); x += DPP_SC_(x, 0.f, 0x112, 0xF); x += DPP_SC_(x, 0.f, 0x114, 0xF); x += DPP_SC_(x, 0.f, 0x118, 0xF);
    x += DPP_SC_(x, 0.f, 0x142, 0xA); x += DPP_SC_(x, 0.f, 0x143, 0xC);
    return x;
}
__device__ __forceinline__ float wave_scan_max(float x) {
    x = fmaxf(x, DPP_SC_(x, x, 0x111, 0xF)); x = fmaxf(x, DPP_SC_(x, x, 0x112, 0xF)); x = fmaxf(x, DPP_SC_(x, x, 0x114, 0xF)); x = fmaxf(x, DPP_SC_(x, x, 0x118, 0xF));
    x = fmaxf(x, DPP_SC_(x, x, 0x142, 0xA)); x = fmaxf(x, DPP_SC_(x, x, 0x143, 0xC));
    return x;
#undef DPP_SC_
}
__device__ __forceinline__ float red8(float x) { x += dpp_f<0xB1>(x); x += dpp_f<0x4E>(x); x += dpp_f<0x141>(x); return x; }
__device__ __forceinline__ float red16(float x) { x = red8(x); x += dpp_f<0x140>(x); return x; }
__device__ __forceinline__ float red64(float x) { x = red16(x); x += __shfl_xor(x, 16); x += __shfl_xor(x, 32); return x; }


#define DPP_ADD4_(CTRL) "v_add_f32_dpp %0, %0, %0 " CTRL " row_mask:0xf bank_mask:0xf bound_ctrl:1\n\t" "v_add_f32_dpp %1, %1, %1 " CTRL " row_mask:0xf bank_mask:0xf bound_ctrl:1\n\t" \
                        "v_add_f32_dpp %2, %2, %2 " CTRL " row_mask:0xf bank_mask:0xf bound_ctrl:1\n\t" "v_add_f32_dpp %3, %3, %3 " CTRL " row_mask:0xf bank_mask:0xf bound_ctrl:1\n\t"
__device__ __forceinline__ void red16x4(float& a, float& b, float& c, float& d) {
    asm volatile("s_nop 4\n\t" DPP_ADD4_("quad_perm:[1,0,3,2]") DPP_ADD4_("quad_perm:[2,3,0,1]") DPP_ADD4_("row_half_mirror") DPP_ADD4_("row_mirror") : "+v"(a), "+v"(b), "+v"(c), "+v"(d));
}

__device__ __forceinline__ void rw1_dots(float s0, float s1, float s2, float s3, const f32x4 ma, const f32x4 wr, float& p1, float& p2) {
    asm volatile(
        "v_mul_f32 %[p1], %[s0], %[ma0]\n\t" "v_mul_f32 %[p2], %[s0], %[wr0]\n\t" "v_fmac_f32 %[p1], %[s1], %[ma1]\n\t" "v_fmac_f32 %[p2], %[s1], %[wr1]\n\t"
        "v_fmac_f32 %[p1], %[s2], %[ma2]\n\t" "v_fmac_f32 %[p2], %[s2], %[wr2]\n\t" "v_fmac_f32 %[p1], %[s3], %[ma3]\n\t" "v_fmac_f32 %[p2], %[s3], %[wr3]\n\t"
        : [p1] "=&v"(p1), [p2] "=&v"(p2)
        : [s0] "v"(s0), [s1] "v"(s1), [s2] "v"(s2), [s3] "v"(s3), [ma0] "v"(ma[0]), [ma1] "v"(ma[1]), [ma2] "v"(ma[2]), [ma3] "v"(ma[3]),
          [wr0] "v"(wr[0]), [wr1] "v"(wr[1]), [wr2] "v"(wr[2]), [wr3] "v"(wr[3]));
}
#define DPP_ADD2_(CTRL, TL) "v_add_f32_dpp %[a], %[a], %[a] " CTRL " row_mask:0xf bank_mask:0xf bound_ctrl:1\n\t" "v_add_f32_dpp %[b], %[b], %[b] " CTRL " row_mask:0xf bank_mask:0xf bound_ctrl:1\n\t" TL
__device__ __forceinline__ void rw1_reduce(float& a, float& b, float v, const f32x4 kp, float& t0, float& t1, float& t2, float& t3) {
    asm volatile("s_nop 4\n\t"
        DPP_ADD2_("quad_perm:[1,0,3,2]", "v_mul_f32 %[t0], %[v], %[kp0]\n\t") DPP_ADD2_("quad_perm:[2,3,0,1]", "v_mul_f32 %[t1], %[v], %[kp1]\n\t")
        DPP_ADD2_("row_half_mirror", "v_mul_f32 %[t2], %[v], %[kp2]\n\t") DPP_ADD2_("row_mirror", "v_mul_f32 %[t3], %[v], %[kp3]\n\t")
        : [a] "+v"(a), [b] "+v"(b), [t0] "=&v"(t0), [t1] "=&v"(t1), [t2] "=&v"(t2), [t3] "=&v"(t3)
        : [v] "v"(v), [kp0] "v"(kp[0]), [kp1] "v"(kp[1]), [kp2] "v"(kp[2]), [kp3] "v"(kp[3]));
}
__device__ __forceinline__ void rw1_update(float& s0, float& s1, float& s2, float& s3, float sa, float t0, float t1, float t2, float t3, const f32x4 wd, const f32x4 bv) {
    asm volatile(
        "v_fmac_f32 %[t0], %[sa], %[bv0]\n\t" "v_fmac_f32 %[t1], %[sa], %[bv1]\n\t" "v_fmac_f32 %[t2], %[sa], %[bv2]\n\t" "v_fmac_f32 %[t3], %[sa], %[bv3]\n\t"
        "v_fma_f32 %[s0], %[s0], %[wd0], %[t0]\n\t" "v_fma_f32 %[s1], %[s1], %[wd1], %[t1]\n\t" "v_fma_f32 %[s2], %[s2], %[wd2], %[t2]\n\t" "v_fma_f32 %[s3], %[s3], %[wd3], %[t3]\n\t"
        : [s0] "+v"(s0), [s1] "+v"(s1), [s2] "+v"(s2), [s3] "+v"(s3), [t0] "+v"(t0), [t1] "+v"(t1), [t2] "+v"(t2), [t3] "+v"(t3)
        : [sa] "v"(sa), [wd0] "v"(wd[0]), [wd1] "v"(wd[1]), [wd2] "v"(wd[2]), [wd3] "v"(wd[3]), [bv0] "v"(bv[0]), [bv1] "v"(bv[1]), [bv2] "v"(bv[2]), [bv3] "v"(bv[3]));
}

#define LDSF(off) ((LAS float*)(lds + (off)))

__device__ __forceinline__ void cvt_tile(const float* __restrict__ src, bf16_t* __restrict__ dst, int K, int N, int kt, int nt, int mode, LAS unsigned char* lds) {
    const int tid = ltid(); LAS float* tile = LDSF(0);
    const int k0 = kt * 64, n0 = nt * 64;
#pragma unroll
    for (int p = 0; p < 2; ++p) {
        const int kk = p * 32 + (tid >> 4), n4 = (tid & 15) * 4;
        f32x4 v = (f32x4){0.f, 0.f, 0.f, 0.f};
        if (n0 + n4 < N) v = *(const f32x4*)(src + (size_t)(k0 + kk) * N + n0 + n4);
        tile[kk * 65 + n4 + 0] = v[0]; tile[kk * 65 + n4 + 1] = v[1]; tile[kk * 65 + n4 + 2] = v[2]; tile[kk * 65 + n4 + 3] = v[3];
    }
    __syncthreads();
    {
        const int nn = tid >> 3, k8 = (tid & 7) * 8, n = n0 + nn;
        float f[8];
#pragma unroll
        for (int j = 0; j < 8; ++j) f[j] = tile[(k8 + j) * 65 + nn];
        const int row = (mode == 0) ? n : ((n >> 7) * 256 + ((mode == 2) ? 128 : 0) + (n & 127));
        *(u32x4*)(dst + (size_t)row * K + k0 + k8) = pack8(f);
    }
    __syncthreads();
}

constexpr int T_FF = 2816, T_WIN = 3200, T_WOUT = 1024, T_LAYER = 6 * T_FF + T_WIN + T_WOUT;
struct CvtTile { const float* src; bf16_t* dst; int K, N, kt, nt, mode; };
__device__ __forceinline__ CvtTile cvt_desc(KP P, int l, int r) {
    bf16_t* Wl = (bf16_t*)(P->ws + WS_W) + (size_t)l * LW_ELEMS;
    CvtTile t;
    if (r < 6 * T_FF) {
        const int m = r / T_FF, q = r % T_FF, f = m / 3, which = m % 3;
        if (which < 2) { t.src = P->in[which == 0 ? I_W1 : I_W3] + (size_t)(l * 2 + f) * DM * DFF; t.dst = Wl + (f ? LW_W13B : LW_W13A); t.K = DM; t.N = DFF; t.kt = q / 88; t.nt = q % 88; t.mode = which + 1; }
        else { t.src = P->in[I_W2] + (size_t)(l * 2 + f) * DFF * DM; t.dst = Wl + (f ? LW_W2B : LW_W2A); t.K = DFF; t.N = DM; t.kt = q / 32; t.nt = q % 32; t.mode = 0; }
    } else if (r < 6 * T_FF + T_WIN) {
        const int q = r - 6 * T_FF;
        t.src = P->in[I_WIN] + (size_t)l * DM * DIN; t.dst = Wl + LW_WIN; t.K = DM; t.N = DIN; t.kt = q / 100; t.nt = q % 100; t.mode = 0;
    } else {
        const int q = r - 6 * T_FF - T_WIN;
        t.src = P->in[I_WOUT] + (size_t)l * DM * DM; t.dst = Wl + LW_WOUT; t.K = DM; t.N = DM; t.kt = q / 32; t.nt = q % 32; t.mode = 0;
    }
    return t;
}
__device__ __forceinline__ void cvt_load(const CvtTile& t, f32x4 (&v)[2]) {
    const int tid = ltid(), n4 = (tid & 15) * 4;
#pragma unroll
    for (int p = 0; p < 2; ++p) {
        const int kk = p * 32 + (tid >> 4);
        v[p] = (f32x4){0.f, 0.f, 0.f, 0.f};
        if (t.nt * 64 + n4 < t.N) v[p] = *(const f32x4*)(t.src + (size_t)(t.kt * 64 + kk) * t.N + t.nt * 64 + n4);
    }
}
__device__ __forceinline__ void cvt_store(const CvtTile& t, const f32x4 (&v)[2], LAS unsigned char* lds) {
    const int tid = ltid(); LAS float* tile = LDSF(0);
#pragma unroll
    for (int p = 0; p < 2; ++p) {
        const int kk = p * 32 + (tid >> 4), n4 = (tid & 15) * 4;
        tile[kk * 65 + n4 + 0] = v[p][0]; tile[kk * 65 + n4 + 1] = v[p][1]; tile[kk * 65 + n4 + 2] = v[p][2]; tile[kk * 65 + n4 + 3] = v[p][3];
    }
    __syncthreads();
    {
        const int nn = tid >> 3, k8 = (tid & 7) * 8, n = t.nt * 64 + nn;
        float f[8];
#pragma unroll
        for (int j = 0; j < 8; ++j) f[j] = tile[(k8 + j) * 65 + nn];
        const int row = (t.mode == 0) ? n : ((n >> 7) * 256 + ((t.mode == 2) ? 128 : 0) + (n & 127));
        *(u32x4*)(t.dst + (size_t)row * t.K + t.kt * 64 + k8) = pack8(f);
    }
    __syncthreads();
}
__device__ __forceinline__ CvtTile cvt_desc_dyn(KP P, int r);
constexpr int T_EARLY = 3 * T_FF + T_WIN, T_LATE0 = 3 * T_FF + T_WOUT, T_DYN = T_LATE0 + T_LAYER;
__device__ __forceinline__ CvtTile cvt_desc_dyn(KP P, int r) {
    if (r < T_LATE0) return cvt_desc(P, 0, (r < 3 * T_FF) ? r + 3 * T_FF : r + 3 * T_FF + T_WIN);
    return cvt_desc(P, 1, r - T_LATE0);
}
__device__ __forceinline__ void convert_dynamic(KP P, LAS unsigned char* lds) {
    unsigned* ctr = (unsigned*)(P->ws + WS_BAR + (size_t)31 * WS_BAR_STRIDE);
    LAS unsigned* sh = (LAS unsigned*)(lds + 32768);
    const int tid = ltid();
    for (;;) {
        __syncthreads();
        if (tid == 0) *sh = __hip_atomic_fetch_add(ctr, 8u, __ATOMIC_RELAXED, __HIP_MEMORY_SCOPE_AGENT);
        __syncthreads();
        const int base = (int)*sh;
        if (base >= T_DYN) break;
        const int end = (base + 8 < T_DYN) ? base + 8 : T_DYN;
        CvtTile cur = cvt_desc_dyn(P, base); f32x4 v[2]; cvt_load(cur, v);
        for (int r = base; r < end; ++r) {
            CvtTile nxt = cur; f32x4 w[2] = {v[0], v[1]};
            if (r + 1 < end) { nxt = cvt_desc_dyn(P, r + 1); cvt_load(nxt, w); }
            cvt_store(cur, v, lds);
            cur = nxt; v[0] = w[0]; v[1] = w[1];
        }
    }
}
__device__ __forceinline__ void phase_convert(KP P, LAS unsigned char* lds) {
    const int tid = ltid(), wg = lbid(), nwg = lgdim();
    constexpr int T_BIG = 0, T_LRU = 64, T_MOD = 2 * 36 * 16;
    if (wg < T_EARLY) {
        CvtTile cur = cvt_desc(P, 0, (wg < 3 * T_FF) ? wg : wg + 3 * T_FF); f32x4 v[2]; cvt_load(cur, v);
        for (int r = wg; r < T_EARLY; r += nwg) {
            CvtTile nxt = cur; f32x4 w[2] = {v[0], v[1]};
            const int rn = r + nwg;
            if (rn < T_EARLY) { nxt = cvt_desc(P, 0, (rn < 3 * T_FF) ? rn : rn + 3 * T_FF); cvt_load(nxt, w); }
            cvt_store(cur, v, lds);
            cur = nxt; v[0] = w[0]; v[1] = w[1];
        }
    }
    {
        bf16_t* LT = (bf16_t*)(P->ws + WS_LORAT);
        for (int e = wg * NTHR + tid; e < 2 * 512 * 160; e += nwg * NTHR) {
            const int l = e / 81920, r = e % 81920, ch = r / 160, j = r % 160;
            const float v = (j < 32) ? P->in[I_RWW2][(size_t)(l * 32 + j) * 512 + ch] : ((j < 64) ? P->in[I_RWA2][(size_t)(l * 32 + j - 32) * 512 + ch] : P->in[I_RWG2][(size_t)(l * 96 + j - 64) * 512 + ch]);
            LT[e] = (bf16_t)(pk_bf16(v, 0.f) & 0xffffu);
        }
    }
    for (int it = wg; it < T_BIG + T_LRU + T_MOD; it += nwg) {
        if (false) {
        } else if (it < T_BIG + T_LRU) {
            const int q = it - T_BIG, m16 = q >> 2, tl = q & 3, l = m16 >> 3, which = (m16 >> 2) & 1, blk = m16 & 3;
            const float* src = P->in[which ? I_LRUWX : I_LRUWA] + (size_t)(l * 4 + blk) * 16384;
            bf16_t* dst = (bf16_t*)(P->ws + WS_LRUW) + (size_t)((l * 2 + which) * 4 + blk) * 16384;
            cvt_tile(src, dst, 128, 128, tl >> 1, tl & 1, 0, lds);
        } else {
            const int m = it - T_BIG - T_LRU, l = m / 576, r = m % 576, jb = r / 16, ks = r % 16;
            LAS float* cact = LDSF(0);
#pragma unroll
            for (int e2 = 0; e2 < 2; ++e2) { const int e = tid * 2 + e2, kk = e >> 3, b = e & 7; cact[e] = siluf_(P->in[I_C][b * DM + ks * 128 + kk]); }
            __syncthreads();
            const int j = jb * 512 + tid;
            const float* wp = P->in[I_MODW] + (size_t)l * DM * NMOD + (size_t)(ks * 128) * NMOD + j;
            float acc[8];
#pragma unroll
            for (int b = 0; b < 8; ++b) acc[b] = 0.f;
#pragma unroll 32
            for (int kk = 0; kk < 128; ++kk) {
                const float w = wp[(size_t)kk * NMOD];
                const f32x4 c0 = *(const LAS f32x4*)(cact + kk * 8), c1 = *(const LAS f32x4*)(cact + kk * 8 + 4);
                acc[0] += c0[0] * w; acc[1] += c0[1] * w; acc[2] += c0[2] * w; acc[3] += c0[3] * w;
                acc[4] += c1[0] * w; acc[5] += c1[1] * w; acc[6] += c1[2] * w; acc[7] += c1[3] * w;
            }
            float* mp = (float*)(P->ws + WS_MODP) + (size_t)((l * 16 + ks) * 8) * NMOD + j;
#pragma unroll
            for (int b = 0; b < 8; ++b) mp[(size_t)b * NMOD] = acc[b];
            __syncthreads();
        }
    }
}

__device__ __forceinline__ void phase_modfinal(KP P) {
    const float* mp = (const float*)(P->ws + WS_MODP); float* mf = (float*)(P->ws + WS_MODF);
    for (int i = lbid() * NTHR + ltid(); i < 2 * 8 * NMOD; i += lgdim() * NTHR) {
        const int l = i / (8 * NMOD), r = i % (8 * NMOD), b = r / NMOD, j = r % NMOD;
        float s = P->in[I_MODB][l * NMOD + j];
#pragma unroll
        for (int ks = 0; ks < 16; ++ks) s += mp[(size_t)((l * 16 + ks) * 8 + b) * NMOD + j];
        mf[i] = s;
    }
}

__device__ __forceinline__ void phase_norm(KP P, int l, int sub, const void* __restrict__ xsrc, int xf32, LAS unsigned char* lds) {
    const int tid = ltid(), lane = tid & 63, wave = tid >> 6;
    bf16_t* H = (bf16_t*)(P->ws + WS_HY);
    LAS float* cv = LDSF(0); LAS float* sv = LDSF(8192);
    for (int rb = lbid(); rb < NTOK / 128; rb += lgdim()) {
        const int b = rb >> 5;
        const float* mod = (const float*)(P->ws + WS_MODF) + (size_t)(l * 8 + b) * NMOD + sub * 6144;
        __syncthreads();
        for (int d = tid; d < DM; d += NTHR) { cv[d] = P->in[I_GAIN][(l * 3 + sub) * DM + d] * (1.0f + mod[2048 + d]); sv[d] = mod[d]; }
        __syncthreads();
        if (xf32) {
            for (int rr = 0; rr < 16; ++rr) {
                const int row = rb * 128 + wave * 16 + rr;
                const float* xr = (const float*)xsrc + (size_t)row * DM;
                f32x4 v[8]; float ss = 0.f;
#pragma unroll
                for (int i = 0; i < 8; ++i) { v[i] = *(const f32x4*)(xr + i * 256 + lane * 4); ss += v[i][0] * v[i][0] + v[i][1] * v[i][1] + v[i][2] * v[i][2] + v[i][3] * v[i][3]; }
                ss = red64(ss);
                const float rstd = rsqrtf(ss * (1.0f / DM) + 1e-6f);
#pragma unroll
                for (int i = 0; i < 8; ++i) {
                    const int d = i * 256 + lane * 4;
                    const f32x4 c = *(const LAS f32x4*)(cv + d), s = *(const LAS f32x4*)(sv + d);
                    u32x2 w; w.x = pk_bf16(v[i][0] * rstd * c[0] + s[0], v[i][1] * rstd * c[1] + s[1]); w.y = pk_bf16(v[i][2] * rstd * c[2] + s[2], v[i][3] * rstd * c[3] + s[3]);
                    *(u32x2*)(H + (size_t)row * DM + d) = w;
                }
            }
        } else {
            for (int rr = 0; rr < 16; ++rr) {
                const int row = rb * 128 + wave * 16 + rr;
                const bf16_t* xr = (const bf16_t*)xsrc + (size_t)row * DM;
                u32x4 xw[4]; float ss = 0.f;
#pragma unroll
                for (int i = 0; i < 4; ++i) xw[i] = *(const u32x4*)(xr + i * 512 + lane * 8);
                float v[4][8];
#pragma unroll
                for (int i = 0; i < 4; ++i) {
                    unpack8(xw[i], v[i]);
#pragma unroll
                    for (int j = 0; j < 8; ++j) ss += v[i][j] * v[i][j];
                }
                ss = red64(ss);
                const float rstd = rsqrtf(ss * (1.0f / DM) + 1e-6f);
#pragma unroll
                for (int i = 0; i < 4; ++i) {
                    const int d = i * 512 + lane * 8;
                    const f32x4 c0 = *(const LAS f32x4*)(cv + d), c1 = *(const LAS f32x4*)(cv + d + 4), s0 = *(const LAS f32x4*)(sv + d), s1 = *(const LAS f32x4*)(sv + d + 4);
                    float o[8];
#pragma unroll
                    for (int j = 0; j < 4; ++j) { o[j] = v[i][j] * rstd * c0[j] + s0[j]; o[4 + j] = v[i][4 + j] * rstd * c1[j] + s1[j]; }
                    *(u32x4*)(H + (size_t)row * DM + d) = pack8(o);
                }
            }
        }
    }
}

__device__ __forceinline__ void phase_final_norm(KP P, const bf16_t* __restrict__ X) {
    const int tid = ltid(), lane = tid & 63, wave = tid >> 6;
    const float* fn = P->in[I_FNORM];
    for (int row = lbid() * 8 + wave; row < NTOK; row += lgdim() * 8) {
        const bf16_t* xr = X + (size_t)row * DM; float* orow = P->out + (size_t)row * DM;
        u32x4 xw[4]; float ss = 0.f;
#pragma unroll
        for (int i = 0; i < 4; ++i) xw[i] = *(const u32x4*)(xr + i * 512 + lane * 8);
        float v[4][8];
#pragma unroll
        for (int i = 0; i < 4; ++i) {
            unpack8(xw[i], v[i]);
#pragma unroll
            for (int j = 0; j < 8; ++j) ss += v[i][j] * v[i][j];
        }
        ss = red64(ss);
        const float rstd = rsqrtf(ss * (1.0f / DM) + 1e-6f);
#pragma unroll
        for (int i = 0; i < 4; ++i) {
            const int d = i * 512 + lane * 8;
            const f32x4 g0 = *(const f32x4*)(fn + d), g1 = *(const f32x4*)(fn + d + 4);
            f32x4 o0, o1;
#pragma unroll
            for (int j = 0; j < 4; ++j) { o0[j] = v[i][j] * rstd * g0[j]; o1[j] = v[i][4 + j] * rstd * g1[j]; }
            *(f32x4*)(orow + d) = o0; *(f32x4*)(orow + d + 4) = o1;
        }
    }
}

struct EpiSwiGLU {
    static constexpr bool PERM = true, AFTER_DRAIN = false;
    bf16_t* G;
    __device__ __forceinline__ void operator()(const pg8::f32x4 (&acc)[2][2][4][2], const pg8::Unit& u, int wr, int wc, int fr, int fq) const {
        const int row0 = u.pm * 256 + wr * 64 + fr, col0 = u.pn * 128 + wc * 32 + 8 * fq;
#pragma unroll
        for (int ai = 0; ai < 2; ++ai)
#pragma unroll
            for (int m = 0; m < 4; ++m) {
                float o[8];
#pragma unroll
                for (int n = 0; n < 2; ++n)
#pragma unroll
                    for (int j = 0; j < 4; ++j) { const float g = acc[ai][0][m][n][j]; o[n * 4 + j] = g * fast_rcp(1.0f + __expf(-g)) * acc[ai][1][m][n][j]; }
                *(u32x4*)(G + (size_t)(row0 + ai * 128 + m * 16) * DFF + col0) = pack8(o);
            }
    }
};
struct EpiResid {
    static constexpr bool PERM = false, AFTER_DRAIN = false;
    const void* xin; bf16_t* xout; const float* gate; float coef; int xf32;
    __device__ __forceinline__ void operator()(const pg8::f32x4 (&acc)[2][2][4][2], const pg8::Unit& u, int wr, int wc, int fr, int fq) const {
        const int row0 = u.pm * 256 + wr * 64 + fr, col0 = u.pn * 256 + wc * 32 + 4 * fq, b = u.pm >> 4;
        f32x4 gv[2][2];
#pragma unroll
        for (int bj = 0; bj < 2; ++bj)
#pragma unroll
            for (int n = 0; n < 2; ++n) gv[bj][n] = (*(const f32x4*)(gate + (size_t)b * NMOD + col0 + bj * 128 + n * 16) + 1.0f) * coef;
#pragma unroll
        for (int ai = 0; ai < 2; ++ai) {
            if (xf32) {
                const float* xi = (const float*)xin;
                f32x4 xv[4][2][2];
#pragma unroll
                for (int m = 0; m < 4; ++m)
#pragma unroll
                    for (int bj = 0; bj < 2; ++bj)
#pragma unroll
                        for (int n = 0; n < 2; ++n) xv[m][bj][n] = *(const f32x4*)(xi + (size_t)(row0 + ai * 128 + m * 16) * DM + col0 + bj * 128 + n * 16);
#pragma unroll
                for (int m = 0; m < 4; ++m)
#pragma unroll
                    for (int bj = 0; bj < 2; ++bj)
#pragma unroll
                        for (int n = 0; n < 2; ++n) {
                            const f32x4 r = xv[m][bj][n] + gv[bj][n] * acc[ai][bj][m][n];
                            u32x2 w; w.x = pk_bf16(r[0], r[1]); w.y = pk_bf16(r[2], r[3]);
                            *(u32x2*)(xout + (size_t)(row0 + ai * 128 + m * 16) * DM + col0 + bj * 128 + n * 16) = w;
                        }
            } else {
                const bf16_t* xi = (const bf16_t*)xin;
                u32x2 xw[4][2][2];
#pragma unroll
                for (int m = 0; m < 4; ++m)
#pragma unroll
                    for (int bj = 0; bj < 2; ++bj)
#pragma unroll
                        for (int n = 0; n < 2; ++n) xw[m][bj][n] = *(const u32x2*)(xi + (size_t)(row0 + ai * 128 + m * 16) * DM + col0 + bj * 128 + n * 16);
#pragma unroll
                for (int m = 0; m < 4; ++m)
#pragma unroll
                    for (int bj = 0; bj < 2; ++bj)
#pragma unroll
                        for (int n = 0; n < 2; ++n) {
                            const f32x4 xv = (f32x4){bflo(xw[m][bj][n].x), bfhi(xw[m][bj][n].x), bflo(xw[m][bj][n].y), bfhi(xw[m][bj][n].y)};
                            const f32x4 r = xv + gv[bj][n] * acc[ai][bj][m][n];
                            u32x2 w; w.x = pk_bf16(r[0], r[1]); w.y = pk_bf16(r[2], r[3]);
                            *(u32x2*)(xout + (size_t)(row0 + ai * 128 + m * 16) * DM + col0 + bj * 128 + n * 16) = w;
                        }
            }
        }
    }
};
struct EpiFinal {
    static constexpr bool PERM = false, AFTER_DRAIN = false;
    const bf16_t* xin; float* out; const float* gate; float coef; const float* fn; float* part; unsigned* flags; unsigned* bar0; LAS float* spare;
    __device__ __forceinline__ void operator()(const pg8::f32x4 (&acc_)[2][2][4][2], const pg8::Unit& u, int wr, int wc, int fr, int fq) const {
        pg8::f32x4 (&acc)[2][2][4][2] = const_cast<pg8::f32x4 (&)[2][2][4][2]>(acc_);
        const int row0 = u.pm * 256 + wr * 64 + fr, col0 = u.pn * 256 + wc * 32 + 4 * fq, b = u.pm >> 4, tid = ltid();
        f32x4 gv[2][2];
#pragma unroll
        for (int bj = 0; bj < 2; ++bj)
#pragma unroll
            for (int n = 0; n < 2; ++n) gv[bj][n] = (*(const f32x4*)(gate + (size_t)b * NMOD + col0 + bj * 128 + n * 16) + 1.0f) * coef;
#pragma unroll
        for (int ai = 0; ai < 2; ++ai) {
            u32x2 xw[4][2][2];
#pragma unroll
            for (int m = 0; m < 4; ++m)
#pragma unroll
                for (int bj = 0; bj < 2; ++bj)
#pragma unroll
                    for (int n = 0; n < 2; ++n) xw[m][bj][n] = *(const u32x2*)(xin + (size_t)(row0 + ai * 128 + m * 16) * DM + col0 + bj * 128 + n * 16);
#pragma unroll
            for (int m = 0; m < 4; ++m) {
                float sq = 0.f;
#pragma unroll
                for (int bj = 0; bj < 2; ++bj)
#pragma unroll
                    for (int n = 0; n < 2; ++n) {
                        const f32x4 xv = (f32x4){bflo(xw[m][bj][n].x), bfhi(xw[m][bj][n].x), bflo(xw[m][bj][n].y), bfhi(xw[m][bj][n].y)};
                        const f32x4 r = xv + gv[bj][n] * acc[ai][bj][m][n];
                        acc[ai][bj][m][n] = r;
                        sq += r[0] * r[0] + r[1] * r[1] + r[2] * r[2] + r[3] * r[3];
                    }
                sq += __int_as_float(__builtin_amdgcn_ds_bpermute(((tid & 63) ^ 16) << 2, __float_as_int(sq))); sq += __int_as_float(__builtin_amdgcn_ds_bpermute(((tid & 63) ^ 32) << 2, __float_as_int(sq)));
                if (fq == 0) spare[wc * 256 + wr * 64 + fr + ai * 128 + m * 16] = sq;
            }
        }
        __syncthreads();
        if (tid < 256) __hip_atomic_store(part + (size_t)(u.pm * 256 + tid) * 8 + u.pn, (spare[tid] + spare[256 + tid]) + (spare[512 + tid] + spare[768 + tid]), __ATOMIC_RELAXED, __HIP_MEMORY_SCOPE_AGENT);
        asm volatile("s_waitcnt vmcnt(0)" ::: "memory");
        __syncthreads();
        if (threadIdx.x == 0) {
            (void)xb_add(flags + u.pm, 1u);
            XB_SPIN(xb_ld(flags + u.pm) < 8u, bar0);
        }
        __syncthreads();
        if (tid < 256) {
            const float* pr = part + (size_t)(u.pm * 256 + tid) * 8;
            float t = 0.f;
#pragma unroll
            for (int j = 0; j < 8; ++j) t += __hip_atomic_load(pr + j, __ATOMIC_RELAXED, __HIP_MEMORY_SCOPE_AGENT);
            spare[1024 + tid] = rsqrtf(t * (1.0f / DM) + 1e-6f);
        }
        __syncthreads();
        f32x4 fv[2][2];
#pragma unroll
        for (int bj = 0; bj < 2; ++bj)
#pragma unroll
            for (int n = 0; n < 2; ++n) fv[bj][n] = *(const f32x4*)(fn + col0 + bj * 128 + n * 16);
#pragma unroll
        for (int ai = 0; ai < 2; ++ai)
#pragma unroll
            for (int m = 0; m < 4; ++m) {
                const size_t row = (size_t)(row0 + ai * 128 + m * 16);
                const float rstd = spare[1024 + wr * 64 + fr + ai * 128 + m * 16];
#pragma unroll
                for (int bj = 0; bj < 2; ++bj)
#pragma unroll
                    for (int n = 0; n < 2; ++n) *(f32x4*)(out + row * DM + col0 + bj * 128 + n * 16) = acc[ai][bj][m][n] * rstd * fv[bj][n];
            }
    }
};
struct EpiU {
    static constexpr bool PERM = true, AFTER_DRAIN = false;
    bf16_t* U;
    __device__ __forceinline__ void operator()(const pg8::f32x4 (&acc)[2][2][4][2], const pg8::Unit& u, int wr, int wc, int fr, int fq) const {
        const int row0 = u.pm * 256 + wr * 64 + fr, col0 = u.pn * 256 + wc * 32 + 8 * fq;
#pragma unroll
        for (int ai = 0; ai < 2; ++ai)
#pragma unroll
            for (int m = 0; m < 4; ++m)
#pragma unroll
                for (int bj = 0; bj < 2; ++bj) {
                    u32x4 w; w.x = pk_bf16(acc[ai][bj][m][0][0], acc[ai][bj][m][0][1]); w.y = pk_bf16(acc[ai][bj][m][0][2], acc[ai][bj][m][0][3]);
                    w.z = pk_bf16(acc[ai][bj][m][1][0], acc[ai][bj][m][1][1]); w.w = pk_bf16(acc[ai][bj][m][1][2], acc[ai][bj][m][1][3]);
                    *(u32x4*)(U + (size_t)(row0 + ai * 128 + m * 16) * LDU + col0 + bj * 128) = w;
                }
    }
};

__device__ __forceinline__ void p1_rw_lora(KP P, int l, LAS unsigned char* lds) {
    const int tid = ltid(), lane = tid & 63, wave = tid >> 6, fq = lane >> 4, fr = lane & 15, half = lbid() & 1;
    const bf16_t* U = (const bf16_t*)(P->ws + WS_U);
    float* RWW = (float*)(P->ws + WS_RWW); bf16_t* RWA = (bf16_t*)(P->ws + WS_RWA); bf16_t* RWG = (bf16_t*)(P->ws + WS_RWG);
    constexpr int O_WT = 0, O_ACT = 256 * 168 * 2, LDW = 168;
    const float* mu = P->in[I_RWMU] + l * RW_IN + 1536;
    __syncthreads();
    {
        const bf16_t* LT = (const bf16_t*)(P->ws + WS_LORAT) + (size_t)(l * 512 + half * 256) * 160;
#pragma unroll 2
        for (int e = tid; e < 256 * 20; e += NTHR) { const int ch = e / 20, c = e % 20; *(LAS u32x4*)(lds + O_WT + (ch * LDW + c * 8) * 2) = *(const u32x4*)(LT + (size_t)ch * 160 + c * 8); }
    }
    float w0[2], a0[2];
#pragma unroll
    for (int q = 0; q < 2; ++q) { const int ch = half * 256 + (wave * 2 + q) * 16 + fr; w0[q] = P->in[I_RWW0][l * 512 + ch]; a0[q] = P->in[I_RWA0][l * 512 + ch]; }
    u32x4 pc[3], pp[3];
#define LORA_PREFETCH(tt_) do { _Pragma("unroll") for (int i = 0; i < 3; ++i) { const int e_ = tid + i * NTHR; if (e_ < 1280) { const int tk_ = e_ / 20, c_ = e_ % 20, tok_ = (tt_) * 64 + tk_; \
        const bf16_t* uc_ = U + (size_t)tok_ * LDU + U_RW_WD + c_ * 8; pc[i] = *(const u32x4*)uc_; pp[i] = *(const u32x4*)((tok_ & (SEQ - 1)) ? uc_ - LDU : uc_); } } } while (0)
    const int tstep = lgdim() >> 1;
    if ((lbid() >> 1) < NTOK / 64) LORA_PREFETCH(lbid() >> 1);
    for (int tt = lbid() >> 1; tt < NTOK / 64; tt += tstep) {
        const int tok0 = tt * 64;
        __syncthreads();
#pragma unroll
        for (int i = 0; i < 3; ++i) {
            const int e = tid + i * NTHR;
            if (e < 1280) {
                const int tk = e / 20, c = e % 20, tok = tok0 + tk;
                float cur[8], prv[8], av[8]; unpack8(pc[i], cur); unpack8(pp[i], prv);
                const float pf = (tok & (SEQ - 1)) ? 1.0f : 0.0f;
                const f32x4 m0 = *(const f32x4*)(mu + c * 8), m1 = *(const f32x4*)(mu + c * 8 + 4);
#pragma unroll
                for (int j = 0; j < 8; ++j) {
                    const float v = cur[j] + (prv[j] * pf - cur[j]) * ((j < 4) ? m0[j & 3] : m1[j & 3]);
                    av[j] = (c < 4) ? tanhf_(v) : ((c < 8) ? v : sigmoidf_(v));
                }
                *(LAS u32x4*)(lds + O_ACT + (tk * LDW + c * 8) * 2) = pack8(av);
            }
        }
        if (tt + tstep < NTOK / 64) LORA_PREFETCH(tt + tstep);
        __syncthreads();
#pragma unroll
        for (int q = 0; q < 2; ++q) {
            const int nrow = (wave * 2 + q) * 16 + fr;
            const bf16x8 bw = *(const LAS bf16x8*)(lds + O_WT + (nrow * LDW + fq * 8) * 2), ba = *(const LAS bf16x8*)(lds + O_WT + (nrow * LDW + 32 + fq * 8) * 2);
            const bf16x8 bg0 = *(const LAS bf16x8*)(lds + O_WT + (nrow * LDW + 64 + fq * 8) * 2), bg1 = *(const LAS bf16x8*)(lds + O_WT + (nrow * LDW + 96 + fq * 8) * 2), bg2 = *(const LAS bf16x8*)(lds + O_WT + (nrow * LDW + 128 + fq * 8) * 2);
            const int ch = half * 256 + (wave * 2 + q) * 16 + fr;
#pragma unroll
            for (int mi = 0; mi < 4; ++mi) {
                const int arow = mi * 16 + fr;
                const bf16x8 aw = *(const LAS bf16x8*)(lds + O_ACT + (arow * LDW + fq * 8) * 2), aa = *(const LAS bf16x8*)(lds + O_ACT + (arow * LDW + 32 + fq * 8) * 2);
                const bf16x8 ag0 = *(const LAS bf16x8*)(lds + O_ACT + (arow * LDW + 64 + fq * 8) * 2), ag1 = *(const LAS bf16x8*)(lds + O_ACT + (arow * LDW + 96 + fq * 8) * 2), ag2 = *(const LAS bf16x8*)(lds + O_ACT + (arow * LDW + 128 + fq * 8) * 2);
                const f32x4 z = (f32x4){0.f, 0.f, 0.f, 0.f};
                const f32x4 cw = __builtin_amdgcn_mfma_f32_16x16x32_bf16(aw, bw, z, 0, 0, 0);
                const f32x4 ca = __builtin_amdgcn_mfma_f32_16x16x32_bf16(aa, ba, z, 0, 0, 0);
                f32x4 cg = __builtin_amdgcn_mfma_f32_16x16x32_bf16(ag0, bg0, z, 0, 0, 0);
                cg = __builtin_amdgcn_mfma_f32_16x16x32_bf16(ag1, bg1, cg, 0, 0, 0);
                cg = __builtin_amdgcn_mfma_f32_16x16x32_bf16(ag2, bg2, cg, 0, 0, 0);
#pragma unroll
                for (int rg = 0; rg < 4; ++rg) {
                    const size_t o = (size_t)(tok0 + mi * 16 + fq * 4 + rg) * 512 + ch;
                    const float wlog = -softplusf_(-(w0[q] + cw[rg])) - 0.5f;
                    RWW[o] = __expf(-__expf(wlog));
                    RWA[o] = (bf16_t)(pk_bf16(sigmoidf_(a0[q] + ca[rg]), 0.f) & 0xffffu);
                    RWG[o] = (bf16_t)(pk_bf16(cg[rg], 0.f) & 0xffffu);
                }
            }
        }
    }
}

#undef LORA_PREFETCH
__device__ __forceinline__ void p1_lru_prep(KP P, int l, LAS unsigned char* lds) {
    const int tid = ltid(), lane = tid & 63, wave = tid >> 6, wg = lbid(), nwg = lgdim();
    const bf16_t* U = (const bf16_t*)(P->ws + WS_U);
    float* LA = (float*)(P->ws + WS_LRUA); float* LB = (float*)(P->ws + WS_LRUB);
    constexpr int O_WA = 0, O_WX = 34816, O_XC = 69632, O_XF = 87040;
    const int n = wg & 3;
    __syncthreads();
    {
        const bf16_t* wa = (const bf16_t*)(P->ws + WS_LRUW) + (size_t)((l * 2 + 0) * 4 + n) * 16384;
        const bf16_t* wx = (const bf16_t*)(P->ws + WS_LRUW) + (size_t)((l * 2 + 1) * 4 + n) * 16384;
#pragma unroll
        for (int e4 = 0; e4 < 4; ++e4) {
            const int e = tid + e4 * NTHR, j = e >> 4, i8 = (e & 15) * 8;
            *(LAS u32x4*)(lds + O_WA + (j * 136 + i8) * 2) = *(const u32x4*)(wa + j * 128 + i8);
            *(LAS u32x4*)(lds + O_WX + (j * 136 + i8) * 2) = *(const u32x4*)(wx + j * 128 + i8);
        }
    }
    const int jloc = wave * 16 + (lane & 15), cg = n * 128 + jloc, fq = lane >> 4;
    const float ba = P->in[I_LRUBA][l * 512 + cg], bx = P->in[I_LRUBX][l * 512 + cg], sp8 = 8.0f * softplusf_(-P->in[I_LRULAM][l * 512 + cg]);
    const int tk = tid >> 3, c16 = (tid & 7) * 16;
    const float* cw = P->in[I_LRUCW] + l * 2048 + n * 128 + c16;
    const float* cb = P->in[I_LRUCB] + l * 512 + n * 128 + c16;
    u32x4 pr[4][2];
#define LRU_PREFETCH(tt_) do { const int tok_ = (tt_) * 64 + tk, ts_ = tok_ & (SEQ - 1); _Pragma("unroll") for (int jj = 0; jj < 4; ++jj) { \
        const bf16_t* up_ = U + (size_t)(((ts_ - 3 + jj) >= 0) ? tok_ - 3 + jj : tok_) * LDU + U_LRU_X + n * 128 + c16; pr[jj][0] = *(const u32x4*)up_; pr[jj][1] = *(const u32x4*)(up_ + 8); } } while (0)
    const int tstep = nwg >> 2;
    if ((wg >> 2) < NTOK / 64) LRU_PREFETCH(wg >> 2);
    for (int tt = wg >> 2; tt < NTOK / 64; tt += tstep) {
        const int tok0 = tt * 64, tok = tok0 + tk, tseq = tok & (SEQ - 1);
        float xc[16];
#pragma unroll
        for (int q = 0; q < 4; ++q) { const f32x4 c = *(const f32x4*)(cb + q * 4); xc[q * 4 + 0] = c[0]; xc[q * 4 + 1] = c[1]; xc[q * 4 + 2] = c[2]; xc[q * 4 + 3] = c[3]; }
#pragma unroll
        for (int jj = 0; jj < 4; ++jj) {
            const bool valid = (tseq - 3 + jj) >= 0;
            float x[16]; { float t0[8], t1[8]; unpack8(pr[jj][0], t0); unpack8(pr[jj][1], t1);
#pragma unroll
                for (int j = 0; j < 8; ++j) { x[j] = t0[j]; x[8 + j] = t1[j]; } }
            const float vf = valid ? 1.0f : 0.0f;
#pragma unroll
            for (int q = 0; q < 4; ++q) { const f32x4 w = *(const f32x4*)(cw + jj * 512 + q * 4);
                xc[q * 4 + 0] += vf * w[0] * x[q * 4 + 0]; xc[q * 4 + 1] += vf * w[1] * x[q * 4 + 1]; xc[q * 4 + 2] += vf * w[2] * x[q * 4 + 2]; xc[q * 4 + 3] += vf * w[3] * x[q * 4 + 3]; }
        }
        __syncthreads();
        {
            float a8[8], b8[8];
#pragma unroll
            for (int j = 0; j < 8; ++j) { a8[j] = xc[j]; b8[j] = xc[8 + j]; }
            *(LAS u32x4*)(lds + O_XC + (tk * 136 + c16) * 2) = pack8(a8);
            *(LAS u32x4*)(lds + O_XC + (tk * 136 + c16 + 8) * 2) = pack8(b8);
#pragma unroll
            for (int q = 0; q < 4; ++q) *(LAS f32x4*)(lds + O_XF + (tk * 132 + c16 + q * 4) * 4) = (f32x4){xc[q * 4], xc[q * 4 + 1], xc[q * 4 + 2], xc[q * 4 + 3]};
        }
        __syncthreads();
        if (tt + tstep < NTOK / 64) LRU_PREFETCH(tt + tstep);
        f32x4 accA[4], accX[4];
#pragma unroll
        for (int mi = 0; mi < 4; ++mi) { accA[mi] = (f32x4){0.f, 0.f, 0.f, 0.f}; accX[mi] = (f32x4){0.f, 0.f, 0.f, 0.f}; }
#pragma unroll
        for (int kk = 0; kk < 4; ++kk) {
            const bf16x8 fa = *(const LAS bf16x8*)(lds + O_WA + (jloc * 136 + kk * 32 + fq * 8) * 2);
            const bf16x8 fx = *(const LAS bf16x8*)(lds + O_WX + (jloc * 136 + kk * 32 + fq * 8) * 2);
#pragma unroll
            for (int mi = 0; mi < 4; ++mi) {
                const bf16x8 xa = *(const LAS bf16x8*)(lds + O_XC + ((mi * 16 + (lane & 15)) * 136 + kk * 32 + fq * 8) * 2);
                accA[mi] = __builtin_amdgcn_mfma_f32_16x16x32_bf16(xa, fa, accA[mi], 0, 0, 0);
                accX[mi] = __builtin_amdgcn_mfma_f32_16x16x32_bf16(xa, fx, accX[mi], 0, 0, 0);
            }
        }
#pragma unroll
        for (int mi = 0; mi < 4; ++mi)
#pragma unroll
            for (int rg = 0; rg < 4; ++rg) {
                const int t = mi * 16 + fq * 4 + rg;
                const float xv = *(const LAS float*)(lds + O_XF + (t * 132 + jloc) * 4);
                const float r = sigmoidf_(accA[mi][rg] + ba), ig = sigmoidf_(accX[mi][rg] + bx);
                const float la = -r * sp8;
                const size_t o = (size_t)(tok0 + t) * 512 + cg;
                LA[o] = __expf(la);
                LB[o] = sqrtf(fmaxf(-expm1f(2.0f * la), 0.0f)) * (ig * xv);
            }
    }
}

#undef LRU_PREFETCH
__device__ __forceinline__ bf16x8 rw_op16(LAS unsigned char* lds, int off) { return *(const LAS bf16x8*)(lds + off); }
__device__ __forceinline__ bf16x8 rw_op8x2(LAS unsigned char* lds, int off0, int off1) { const u32x2 lo = *(const LAS u32x2*)(lds + off0), hi = *(const LAS u32x2*)(lds + off1); const u32x4 w = (u32x4){lo.x, lo.y, hi.x, hi.y}; return __builtin_bit_cast(bf16x8, w); }
__device__ __forceinline__ bf16x8 rw_accop(const f32x4 a, const f32x4 b) { u32x4 w; w.x = pk_bf16(a[0], a[1]); w.y = pk_bf16(a[2], a[3]); w.z = pk_bf16(b[0], b[1]); w.w = pk_bf16(b[2], b[3]); return __builtin_bit_cast(bf16x8, w); }
#define RW_MFMA(a, b, c) __builtin_amdgcn_mfma_f32_16x16x32_bf16(a, b, c, 0, 0, 0)
__device__ __forceinline__ void p2_rw(KP P, int l, int item, LAS unsigned char* lds) {
    const int tid = ltid(), lane = tid & 63, wave = tid >> 6, b = item >> 3, h = item & 7;
    const int fr = lane & 15, fq = lane >> 4, st = tid >> 3, sc = (tid & 7) * 8;
    const bf16_t* U = (const bf16_t*)(P->ws + WS_U);
    const float* RWW = (const float*)(P->ws + WS_RWW); const bf16_t* RWA = (const bf16_t*)(P->ws + WS_RWA); const bf16_t* RWG = (const bf16_t*)(P->ws + WS_RWG);
    bf16_t* Y = (bf16_t*)(P->ws + WS_HY);
    LAS float* F = LDSF(0);
    constexpr int CN = 0, WC = 512, TOT = 4608, LD = 4864;
    constexpr int XD = 23552, AT = 25600, RT = AT + 9216, BT = RT + 9216, KT = BT + 9216, BTT = KT + 9216, KTT = BTT + 9216, VT = KTT + 9216, GAB = VT + 9216, GAK = GAB + 9216, GRB = GAK + 9216, GRK = GRB + 9216, OO = GRK + 9216;
    __syncthreads();
    {
        const int kind = tid >> 6, c = tid & 63; float v;
        if (kind < 3) v = P->in[I_RWMU][l * RW_IN + kind * 512 + h * 64 + c];
        else if (kind == 3) v = P->in[I_RWKK][l * 512 + h * 64 + c];
        else if (kind == 4) v = P->in[I_RWKA][l * 512 + h * 64 + c];
        else if (kind == 5) v = P->in[I_RWRK][l * 512 + h * 64 + c];
        else if (kind == 6) v = P->in[I_RWLNW][l * 512 + h * 64 + c];
        else v = P->in[I_RWLNB][l * 512 + h * 64 + c];
        F[CN + kind * 64 + c] = v;
        for (int e = tid; e < 4 * 9216 / 16; e += NTHR) *(LAS u32x4*)(lds + GAB + e * 16) = (u32x4){0u, 0u, 0u, 0u};
    }
    __syncthreads();
    f32x4 ST[4];
#pragma unroll
    for (int j = 0; j < 4; ++j) ST[j] = (f32x4){0.f, 0.f, 0.f, 0.f};
    u32x4 pr_c, pk_c, pv_c, pr_p, pk_p, pv_p, pa, pg; f32x4 pw0, pw1; float pflag;
#define RW_IDS const int tid = ltid(), lane = tid & 63, wave = tid >> 6, fr = lane & 15, fq = lane >> 4, st = tid >> 3, sc = (tid & 7) * 8; (void)lane; (void)wave; (void)fr; (void)fq; (void)st; (void)sc;
#define RW_PREFETCH(ch) do { RW_IDS const int tk_ = b * SEQ + (ch) * 64 + st; const bool first_ = ((ch) == 0 && st == 0); \
        const bf16_t* uc_ = U + (size_t)tk_ * LDU + h * 64 + sc; const bf16_t* up_ = first_ ? uc_ : uc_ - LDU; pflag = first_ ? 0.f : 1.f; \
        pr_c = *(const u32x4*)(uc_ + U_RW_R); pk_c = *(const u32x4*)(uc_ + U_RW_K); pv_c = *(const u32x4*)(uc_ + U_RW_V); \
        pr_p = *(const u32x4*)(up_ + U_RW_R); pk_p = *(const u32x4*)(up_ + U_RW_K); pv_p = *(const u32x4*)(up_ + U_RW_V); \
        const size_t o_ = (size_t)tk_ * 512 + h * 64 + sc; pw0 = *(const f32x4*)(RWW + o_); pw1 = *(const f32x4*)(RWW + o_ + 4); pa = *(const u32x4*)(RWA + o_); pg = *(const u32x4*)(RWG + o_); } while (0)
    RW_PREFETCH(0);
    for (int ch = 0; ch < SEQ / 64; ++ch) {
        u32x4 cg, cvp; float bsum = 0.f;
        {   RW_IDS
        {
        float wt[8];
        {
            wt[0] = pw0[0]; wt[1] = pw0[1]; wt[2] = pw0[2]; wt[3] = pw0[3]; wt[4] = pw1[0]; wt[5] = pw1[1]; wt[6] = pw1[2]; wt[7] = pw1[3];
            const int sl = lane >> 3;
#pragma unroll
            for (int d = 1; d < 8; d <<= 1) {
#pragma unroll
                for (int j = 0; j < 8; ++j) { const float o = __shfl_up(wt[j], 8 * d); if (sl >= d) wt[j] *= o; }
            }
            if (sl == 7) { *(LAS f32x4*)(F + TOT + wave * 64 + sc) = (f32x4){wt[0], wt[1], wt[2], wt[3]}; *(LAS f32x4*)(F + TOT + wave * 64 + sc + 4) = (f32x4){wt[4], wt[5], wt[6], wt[7]}; }
        }
        __syncthreads();
        {
            f32x4 b0 = (f32x4){1.f, 1.f, 1.f, 1.f}, b1 = b0;
            for (int wv = 0; wv < wave; ++wv) { b0 *= *(const LAS f32x4*)(F + TOT + wv * 64 + sc); b1 *= *(const LAS f32x4*)(F + TOT + wv * 64 + sc + 4); }
#pragma unroll
            for (int j = 0; j < 4; ++j) { wt[j] *= b0[j]; wt[4 + j] *= b1[j]; }
            *(LAS f32x4*)(F + WC + st * 64 + sc) = (f32x4){wt[0], wt[1], wt[2], wt[3]}; *(LAS f32x4*)(F + WC + st * 64 + sc + 4) = (f32x4){wt[4], wt[5], wt[6], wt[7]};
        }
        }
        float r[8], v[8], ma[8], bv[8], kp[8];
        cg = pg;
        {
            float k[8], a[8];
            {
                float c[8], p[8], m[8];
                unpack8(pr_c, c); unpack8(pr_p, p);
#pragma unroll
                for (int j = 0; j < 8; ++j) m[j] = F[CN + 0 * 64 + sc + j];
#pragma unroll
                for (int j = 0; j < 8; ++j) r[j] = c[j] + (p[j] * pflag - c[j]) * m[j];
                unpack8(pk_c, c); unpack8(pk_p, p);
#pragma unroll
                for (int j = 0; j < 8; ++j) m[j] = F[CN + 1 * 64 + sc + j];
#pragma unroll
                for (int j = 0; j < 8; ++j) k[j] = c[j] + (p[j] * pflag - c[j]) * m[j];
                unpack8(pv_c, c); unpack8(pv_p, p);
#pragma unroll
                for (int j = 0; j < 8; ++j) m[j] = F[CN + 2 * 64 + sc + j];
#pragma unroll
                for (int j = 0; j < 8; ++j) v[j] = c[j] + (p[j] * pflag - c[j]) * m[j];
                unpack8(pa, a);
            }
            float ss = 0.f, kkv[8];
#pragma unroll
            for (int j = 0; j < 8; ++j) { kkv[j] = k[j] * F[CN + 3 * 64 + sc + j]; ss += kkv[j] * kkv[j]; }
            ss = red8(ss);
            const float inv = 1.0f / fmaxf(sqrtf(ss + 1e-12f), 1e-6f);
#pragma unroll
            for (int j = 0; j < 8; ++j) {
                const float kn = kkv[j] * inv;
                kp[j] = k[j] * (1.0f + (a[j] - 1.0f) * F[CN + 4 * 64 + sc + j]);
                ma[j] = -kn; bv[j] = kn * a[j];
                bsum += r[j] * kp[j] * F[CN + 5 * 64 + sc + j];
            }
            bsum = red8(bsum);
        }
        {
#pragma unroll
            for (int j = 0; j < 8; j += 2) {
                const unsigned pw = pk_bf16(v[j], v[j + 1]);
                *(LAS bf16_t*)(lds + VT + ((sc + j) * 72 + st) * 2) = (bf16_t)(pw & 0xffffu);
                *(LAS bf16_t*)(lds + VT + ((sc + j + 1) * 72 + st) * 2) = (bf16_t)(pw >> 16);
            }
        }
        cvp = pack8(v);
        {
            float al[8], be[8], ka[8], rh[8];
            const f32x4 wa0 = *(const LAS f32x4*)(F + WC + st * 64 + sc), wa1 = *(const LAS f32x4*)(F + WC + st * 64 + sc + 4);
#pragma unroll
            for (int j = 0; j < 8; ++j) {
                const float wtj = (j < 4) ? wa0[j & 3] : wa1[j & 3];
                const float w1 = (j < 4) ? pw0[j & 3] : pw1[j & 3], iw = fast_rcp(wtj), wp = wtj * fast_rcp(w1);
                al[j] = ma[j] * wp; be[j] = bv[j] * iw; ka[j] = kp[j] * iw; rh[j] = r[j] * wtj;
            }
            const u32x4 qa = pack8(al), qb = pack8(be), qk = pack8(ka), qr = pack8(rh);
            *(LAS u32x4*)(lds + AT + (st * 72 + sc) * 2) = qa; *(LAS u32x4*)(lds + RT + (st * 72 + sc) * 2) = qr;
            *(LAS u32x4*)(lds + BT + (st * 72 + sc) * 2) = qb; *(LAS u32x4*)(lds + KT + (st * 72 + sc) * 2) = qk;
#pragma unroll
            for (int j = 0; j < 8; ++j) {
                const unsigned wb = qb[j >> 1], wk = qk[j >> 1];
                *(LAS bf16_t*)(lds + BTT + ((sc + j) * 72 + st) * 2) = (bf16_t)((j & 1) ? (wb >> 16) : (wb & 0xffffu));
                *(LAS bf16_t*)(lds + KTT + ((sc + j) * 72 + st) * 2) = (bf16_t)((j & 1) ? (wk >> 16) : (wk & 0xffffu));
            }
        }
        }
        __syncthreads();
        if (ch + 1 < SEQ / 64) RW_PREFETCH(ch + 1);
        {   RW_IDS
            const int m = wave >> 1;
            const int ta = (m < 2) ? AT : RT, tb = (m & 1) ? KT : BT, tg = GAB + m * 9216;
#pragma unroll
            for (int e = 0; e < 5; ++e) {
                int ti, ji;
                if (wave & 1) { ti = (e < 2) ? 1 : 2; ji = (e < 2) ? e : e - 2; } else { ti = (e < 1) ? 0 : 3; ji = (e < 1) ? 0 : e - 1; }
                f32x4 g = (f32x4){0.f, 0.f, 0.f, 0.f};
#pragma unroll
                for (int kk = 0; kk < 2; ++kk) g = RW_MFMA(rw_op16(lds, ta + ((ti * 16 + fr) * 72 + kk * 32 + fq * 8) * 2), rw_op16(lds, tb + ((ji * 16 + fr) * 72 + kk * 32 + fq * 8) * 2), g);
#pragma unroll
                for (int rg = 0; rg < 4; ++rg) {
                    const int t = ti * 16 + fq * 4 + rg, j = ji * 16 + fr;
                    const bool keep = (m >= 2) ? (j <= t) : (j < t);
                    const float val = keep ? g[rg] : 0.f;
                    *(LAS bf16_t*)(lds + tg + (t * 72 + j) * 2) = (bf16_t)(pk_bf16(val, 0.f) & 0xffffu);
                    if (m == 0 && ti == ji) F[LD + ti * 256 + (fq * 4 + rg) * 16 + fr] = val;
                }
            }
        }
        __syncthreads();
        f32x4 Yc[4]; bf16x8 s0b[2], vtb[2];
        {   RW_IDS
        if (wave == 4) {
            const int c = lane >> 4, col = lane & 15;
            float x[16];
#pragma unroll
            for (int t = 0; t < 16; ++t) {
                float acc = (t == col) ? 1.0f : 0.0f, acc1 = 0.f;
#pragma unroll
                for (int j = 0; j < t; ++j) { if (j & 1) acc1 += F[LD + c * 256 + t * 16 + j] * x[j]; else acc += F[LD + c * 256 + t * 16 + j] * x[j]; }
                acc += acc1;
                x[t] = acc;
                __builtin_amdgcn_sched_barrier(0);
                *(LAS bf16_t*)(lds + XD + ((c * 16 + t) * 16 + col) * 2) = (bf16_t)(pk_bf16(acc, 0.f) & 0xffffu);
            }
        }
        if (wave < 4) {
#pragma unroll
            for (int kk = 0; kk < 2; ++kk) { s0b[kk] = rw_accop(ST[2 * kk], ST[2 * kk + 1]); vtb[kk] = rw_op16(lds, VT + ((wave * 16 + fr) * 72 + kk * 32 + fq * 8) * 2); }
#pragma unroll
            for (int c = 0; c < 4; ++c) {
                const int row = c * 16 + fr;
                f32x4 y = (f32x4){0.f, 0.f, 0.f, 0.f};
#pragma unroll
                for (int kk = 0; kk < 2; ++kk) y = RW_MFMA(rw_op8x2(lds, AT + (row * 72 + kk * 32 + fq * 4) * 2, AT + (row * 72 + kk * 32 + 16 + fq * 4) * 2), s0b[kk], y);
                y = RW_MFMA(rw_op16(lds, GAK + (row * 72 + fq * 8) * 2), vtb[0], y);
                if (c >= 2) y = RW_MFMA(rw_op16(lds, GAK + (row * 72 + 32 + fq * 8) * 2), vtb[1], y);
                Yc[c] = y;
            }
        }
        }
        __syncthreads();
        {   RW_IDS
        if (wave < 4) {
            const f32x4 z4 = (f32x4){0.f, 0.f, 0.f, 0.f};
#define RW_XOP(c) __builtin_bit_cast(bf16x8, (u32x4){(*(const LAS u32x2*)(lds + XD + (((c) * 16 + fr) * 16 + fq * 4) * 2)).x, (*(const LAS u32x2*)(lds + XD + (((c) * 16 + fr) * 16 + fq * 4) * 2)).y, 0u, 0u})
#define RW_LOP(c, kk) rw_op8x2(lds, GAB + (((c) * 16 + fr) * 72 + (kk) * 32 + fq * 4) * 2, GAB + (((c) * 16 + fr) * 72 + (kk) * 32 + 16 + fq * 4) * 2)
            const f32x4 U0 = RW_MFMA(RW_XOP(0), rw_accop(Yc[0], z4), z4);
            const f32x4 Y1 = RW_MFMA(RW_LOP(1, 0), rw_accop(U0, z4), Yc[1]);
            const f32x4 U1 = RW_MFMA(RW_XOP(1), rw_accop(Y1, z4), z4);
            const bf16x8 ub0 = rw_accop(U0, U1);
            const f32x4 Y2 = RW_MFMA(RW_LOP(2, 0), ub0, Yc[2]);
            const f32x4 U2 = RW_MFMA(RW_XOP(2), rw_accop(Y2, z4), z4);
            f32x4 Y3 = RW_MFMA(RW_LOP(3, 0), ub0, Yc[3]);
            Y3 = RW_MFMA(RW_LOP(3, 1), rw_accop(U2, z4), Y3);
            const f32x4 U3 = RW_MFMA(RW_XOP(3), rw_accop(Y3, z4), z4);
            const bf16x8 ub1 = rw_accop(U2, U3);
#undef RW_XOP
#undef RW_LOP
#pragma unroll
            for (int c = 0; c < 4; ++c) {
                const int row = c * 16 + fr;
                f32x4 o = (f32x4){0.f, 0.f, 0.f, 0.f};
#pragma unroll
                for (int kk = 0; kk < 2; ++kk) o = RW_MFMA(rw_op8x2(lds, RT + (row * 72 + kk * 32 + fq * 4) * 2, RT + (row * 72 + kk * 32 + 16 + fq * 4) * 2), s0b[kk], o);
                o = RW_MFMA(rw_op8x2(lds, GRB + (row * 72 + fq * 4) * 2, GRB + (row * 72 + 16 + fq * 4) * 2), ub0, o);
                o = RW_MFMA(rw_op16(lds, GRK + (row * 72 + fq * 8) * 2), vtb[0], o);
                if (c >= 2) {
                    o = RW_MFMA(rw_op8x2(lds, GRB + (row * 72 + 32 + fq * 4) * 2, GRB + (row * 72 + 48 + fq * 4) * 2), ub1, o);
                    o = RW_MFMA(rw_op16(lds, GRK + (row * 72 + 32 + fq * 8) * 2), vtb[1], o);
                }
#pragma unroll
                for (int rg = 0; rg < 4; ++rg) *(LAS float*)(lds + OO + ((c * 16 + fq * 4 + rg) * 68 + wave * 16 + fr) * 4) = o[rg];
            }
#pragma unroll
            for (int kt = 0; kt < 4; ++kt) {
                const int row = kt * 16 + fr;
                f32x4 s = ST[kt];
                s = RW_MFMA(rw_op8x2(lds, BTT + (row * 72 + fq * 4) * 2, BTT + (row * 72 + 16 + fq * 4) * 2), ub0, s);
                s = RW_MFMA(rw_op8x2(lds, BTT + (row * 72 + 32 + fq * 4) * 2, BTT + (row * 72 + 48 + fq * 4) * 2), ub1, s);
                s = RW_MFMA(rw_op16(lds, KTT + (row * 72 + fq * 8) * 2), vtb[0], s);
                s = RW_MFMA(rw_op16(lds, KTT + (row * 72 + 32 + fq * 8) * 2), vtb[1], s);
                ST[kt] = s * *(const LAS f32x4*)(F + WC + 63 * 64 + kt * 16 + fq * 4);
            }
        }
        }
        __syncthreads();
        {   RW_IDS
            const f32x4 o0 = *(const LAS f32x4*)(lds + OO + (st * 68 + sc) * 4), o1 = *(const LAS f32x4*)(lds + OO + (st * 68 + sc + 4) * 4);
            float o[8] = {o0[0], o0[1], o0[2], o0[3], o1[0], o1[1], o1[2], o1[3]}, v8[8], g8[8], y8[8];
            unpack8(cvp, v8); unpack8(cg, g8);
            float sm = 0.f;
#pragma unroll
            for (int j = 0; j < 8; ++j) sm += o[j];
            const float mean = red8(sm) * (1.0f / 64.0f);
            float q = 0.f;
#pragma unroll
            for (int j = 0; j < 8; ++j) { o[j] -= mean; q += o[j] * o[j]; }
            const float rs = rsqrtf(red8(q) * (1.0f / 64.0f) + 64e-5f);
#pragma unroll
            for (int j = 0; j < 8; ++j) y8[j] = (o[j] * rs * F[CN + 6 * 64 + sc + j] + F[CN + 7 * 64 + sc + j] + bsum * v8[j]) * g8[j];
            *(u32x4*)(Y + (size_t)(b * SEQ + ch * 64 + st) * DM + 512 + h * 64 + sc) = pack8(y8);
        }
    }
#undef RW_PREFETCH
#undef RW_IDS
}
#undef RW_MFMA


__device__ __forceinline__ void p2_hg(KP P, int l, int item, LAS unsigned char* lds) {
    const int tid = ltid(), lane = tid & 63, wave = tid >> 6, b = item >> 2, h = item & 3;
    const int fr = lane & 15, fq = lane >> 4, st = tid >> 3, c16 = tid & 7, sv = c16 * 16;
    const bf16_t* U = (const bf16_t*)(P->ws + WS_U); bf16_t* Y = (bf16_t*)(P->ws + WS_HY);
    LAS float* F = LDSF(0);
    constexpr int LBO = 0, HN = 128, FF = 256, TT = 8448;
    constexpr int QB = 35840, KB = QB + 64 * 136 * 2, KT = KB + 64 * 136 * 2, VT = KT + 128 * 72 * 2, AB = VT + 128 * 72 * 2, OO = AB + 64 * 40 * 2;
    __syncthreads();
    if (tid < 128) { float lb = 0.f; if (l == 1) lb = sigmoidf_(P->in[I_HGLB][512 + h * 128 + tid] - P->in[I_HGLB][h * 128 + tid]); F[LBO + tid] = lb; F[HN + tid] = P->in[I_HGNORM][l * 512 + h * 128 + tid]; }
    __syncthreads();
    f32x4 S[8];
#pragma unroll
    for (int j = 0; j < 8; ++j) S[j] = (f32x4){0.f, 0.f, 0.f, 0.f};
    u32x4 pq0, pq1, pf0, pf1, pv0, pv1;
#define HG_IDS const int tid = ltid(), lane = tid & 63, wave = tid >> 6, fr = lane & 15, fq = lane >> 4, st = tid >> 3, c16 = tid & 7, sv = c16 * 16; (void)lane; (void)wave; (void)fr; (void)fq; (void)st; (void)c16; (void)sv;
#define HG_PREFETCH(ch) do { HG_IDS const bf16_t* ur_ = U + (size_t)(b * SEQ + (ch) * 64 + st) * LDU + h * 128; \
        pq0 = *(const u32x4*)(ur_ + U_HG_Q + c16 * 16); pq1 = *(const u32x4*)(ur_ + U_HG_Q + c16 * 16 + 8); pf0 = *(const u32x4*)(ur_ + U_HG_F + c16 * 16); pf1 = *(const u32x4*)(ur_ + U_HG_F + c16 * 16 + 8); \
        pv0 = *(const u32x4*)(ur_ + U_HG_I + sv); pv1 = *(const u32x4*)(ur_ + U_HG_I + sv + 8); } while (0)
    HG_PREFETCH(0);
    for (int ch = 0; ch < SEQ / 64; ++ch) {
        float fo[16], kx[16], qs[16];
        u32x4 cg0, cg1;
        {   HG_IDS
            { const bf16_t* ug_ = U + (size_t)(b * SEQ + ch * 64 + st) * LDU + U_HG_G + h * 128 + sv; cg0 = *(const u32x4*)ug_; cg1 = *(const u32x4*)(ug_ + 8); }
            float q[16], z[16];
            { float t0[8], t1[8]; unpack8(pq0, t0); unpack8(pq1, t1);
#pragma unroll
              for (int j = 0; j < 8; ++j) { q[j] = t0[j]; q[8 + j] = t1[j]; }
              unpack8(pf0, t0); unpack8(pf1, t1);
#pragma unroll
              for (int j = 0; j < 8; ++j) { z[j] = t0[j]; z[8 + j] = t1[j]; } }
#pragma unroll
            for (int j = 0; j < 16; ++j) {
                const float lb = F[LBO + c16 * 16 + j], e = __expf(-z[j]), sg = fast_rcp(1.0f + e);
                fo[j] = lb + (1.0f - lb) * sg; kx[j] = (1.0f - lb) * (e * sg);
                qs[j] = siluf_(q[j]);
            }
        }
        const u32x4 cv0 = pv0, cv1 = pv1;
        __syncthreads();
        {   HG_IDS
#pragma unroll
            for (int m = 0; m < 4; ++m) *(LAS f32x4*)(F + FF + st * 128 + c16 * 16 + 4 * m) = (f32x4){fo[4 * m], fo[4 * m + 1], fo[4 * m + 2], fo[4 * m + 3]};
#pragma unroll
            for (int j = 0; j < 8; ++j) {
                const unsigned w0 = cv0[j >> 1], w1 = cv1[j >> 1];
                *(LAS bf16_t*)(lds + VT + ((sv + j) * 72 + st) * 2) = (bf16_t)((j & 1) ? (w0 >> 16) : (w0 & 0xffffu));
                *(LAS bf16_t*)(lds + VT + ((sv + 8 + j) * 72 + st) * 2) = (bf16_t)((j & 1) ? (w1 >> 16) : (w1 & 0xffffu));
            }
        }
        __syncthreads();
        {   HG_IDS
            const int kk = tid & 127, w4 = tid >> 7; float c = 1.0f;
#pragma unroll 4
            for (int i = 0; i < 16; ++i) { const int ix = FF + (w4 * 16 + i) * 128 + kk; c *= F[ix]; F[ix] = c; }
            F[TT + w4 * 128 + kk] = c;
        }
        __syncthreads();
        if ((ltid() >> 7) & 1) {   HG_IDS
            const int kk = tid & 127, w4 = tid >> 7; const float m0 = F[TT + (w4 - 1) * 128 + kk];
#pragma unroll 4
            for (int i = 0; i < 16; ++i) F[FF + (w4 * 16 + i) * 128 + kk] *= m0;
        }
        __syncthreads();
        {   HG_IDS
#pragma unroll
            for (int m = 0; m < 4; ++m) {
                const f32x4 c4 = *(const LAS f32x4*)(F + FF + st * 128 + c16 * 16 + 4 * m);
                float qc[4], kc[4];
#pragma unroll
                for (int j = 0; j < 4; ++j) { const float cc = fmaxf(c4[j], 1e-30f); qc[j] = qs[4 * m + j] * cc; kc[j] = kx[4 * m + j] * fast_rcp(cc); }
                u32x2 w; w.x = pk_bf16(qc[0], qc[1]); w.y = pk_bf16(qc[2], qc[3]);
                *(LAS u32x2*)(lds + QB + (st * 136 + c16 * 16 + 4 * m) * 2) = w;
                w.x = pk_bf16(kc[0], kc[1]); w.y = pk_bf16(kc[2], kc[3]);
                *(LAS u32x2*)(lds + KB + (st * 136 + c16 * 16 + 4 * m) * 2) = w;
                *(LAS bf16_t*)(lds + KT + ((c16 * 16 + 4 * m + 0) * 72 + st) * 2) = (bf16_t)(w.x & 0xffffu);
                *(LAS bf16_t*)(lds + KT + ((c16 * 16 + 4 * m + 1) * 72 + st) * 2) = (bf16_t)(w.x >> 16);
                *(LAS bf16_t*)(lds + KT + ((c16 * 16 + 4 * m + 2) * 72 + st) * 2) = (bf16_t)(w.y & 0xffffu);
                *(LAS bf16_t*)(lds + KT + ((c16 * 16 + 4 * m + 3) * 72 + st) * 2) = (bf16_t)(w.y >> 16);
            }
        }
        __syncthreads();
        {   HG_IDS
        if (ch + 1 < SEQ / 64) HG_PREFETCH(ch + 1);
        {
            const int wn = wave >> 2, ti = (wave >> 1) & 1, si = wave & 1;
            f32x4 a0 = (f32x4){0.f, 0.f, 0.f, 0.f};
#pragma unroll
            for (int kk = 0; kk < 4; ++kk) {
                const bf16x8 qa = *(const LAS bf16x8*)(lds + QB + ((wn * 32 + ti * 16 + fr) * 136 + kk * 32 + fq * 8) * 2);
                const bf16x8 k0 = *(const LAS bf16x8*)(lds + KB + ((wn * 32 + si * 16 + fr) * 136 + kk * 32 + fq * 8) * 2);
                a0 = __builtin_amdgcn_mfma_f32_16x16x32_bf16(qa, k0, a0, 0, 0, 0);
            }
#pragma unroll
            for (int rg = 0; rg < 4; ++rg) {
                const int tl = ti * 16 + fq * 4 + rg, sl = si * 16 + fr;
                const unsigned w0 = pk_bf16((sl <= tl) ? a0[rg] : 0.f, 0.f) & 0xffffu;
                *(LAS bf16_t*)(lds + AB + ((wn * 32 + tl) * 40 + sl) * 2) = (bf16_t)w0;
            }
        }
        }
        __syncthreads();
        {   HG_IDS
        *(LAS u32x4*)(lds + KB + (st * 136 + sv) * 2) = cg0; *(LAS u32x4*)(lds + KB + (st * 136 + sv + 8) * 2) = cg1;
        {
            bf16x8 vb[2];
#pragma unroll
            for (int wn = 0; wn < 2; ++wn) vb[wn] = *(const LAS bf16x8*)(lds + VT + ((wave * 16 + fr) * 72 + wn * 32 + fq * 8) * 2);
#pragma unroll
            for (int wn = 0; wn < 2; ++wn) {
                bf16x8 mb[4];
#pragma unroll
                for (int kk = 0; kk < 4; ++kk) {
                    u32x4 w; w.x = pk_bf16(S[2 * kk][0], S[2 * kk][1]); w.y = pk_bf16(S[2 * kk][2], S[2 * kk][3]); w.z = pk_bf16(S[2 * kk + 1][0], S[2 * kk + 1][1]); w.w = pk_bf16(S[2 * kk + 1][2], S[2 * kk + 1][3]);
                    mb[kk] = __builtin_bit_cast(bf16x8, w);
                }
#pragma unroll
                for (int ti = 0; ti < 2; ++ti) {
                    const int row = wn * 32 + ti * 16 + fr;
                    const bf16x8 sa = *(const LAS bf16x8*)(lds + AB + (row * 40 + fq * 8) * 2);
                    f32x4 o = __builtin_amdgcn_mfma_f32_16x16x32_bf16(sa, vb[wn], (f32x4){0.f, 0.f, 0.f, 0.f}, 0, 0, 0);
#pragma unroll
                    for (int kk = 0; kk < 4; ++kk) {
                        const u32x2 lo = *(const LAS u32x2*)(lds + QB + (row * 136 + kk * 32 + fq * 4) * 2), hi = *(const LAS u32x2*)(lds + QB + (row * 136 + kk * 32 + 16 + fq * 4) * 2);
                        const u32x4 w = (u32x4){lo.x, lo.y, hi.x, hi.y};
                        o = __builtin_amdgcn_mfma_f32_16x16x32_bf16(__builtin_bit_cast(bf16x8, w), mb[kk], o, 0, 0, 0);
                    }
#pragma unroll
                    for (int rg = 0; rg < 4; ++rg) *(LAS float*)(lds + OO + ((wn * 32 + ti * 16 + fq * 4 + rg) * 132 + wave * 16 + fr) * 4) = o[rg];
                }
#pragma unroll
                for (int kt = 0; kt < 8; ++kt) {
                    const bf16x8 ka = *(const LAS bf16x8*)(lds + KT + ((kt * 16 + fr) * 72 + wn * 32 + fq * 8) * 2);
                    S[kt] = __builtin_amdgcn_mfma_f32_16x16x32_bf16(ka, vb[wn], S[kt], 0, 0, 0);
                    S[kt] *= *(const LAS f32x4*)(F + FF + (wn * 32 + 31) * 128 + kt * 16 + fq * 4);
                }
            }
        }
        }
        __syncthreads();
        {   HG_IDS
            float ss = 0.f;
#pragma unroll
            for (int m = 0; m < 4; ++m) { const f32x4 x = *(const LAS f32x4*)(lds + OO + (st * 132 + sv + 4 * m) * 4); ss += x[0] * x[0] + x[1] * x[1] + x[2] * x[2] + x[3] * x[3]; }
            const float rs = rsqrtf(red8(ss) * (1.0f / 128.0f) + 1e-6f);
            bf16_t* yr = Y + (size_t)(b * SEQ + ch * 64 + st) * DM + h * 128 + sv;
#pragma unroll 1
            for (int hf = 0; hf < 2; ++hf) {
                const f32x4 x0 = *(const LAS f32x4*)(lds + OO + (st * 132 + sv + hf * 8) * 4), x1 = *(const LAS f32x4*)(lds + OO + (st * 132 + sv + hf * 8 + 4) * 4);
                const f32x4 n0 = *(const LAS f32x4*)(F + HN + sv + hf * 8), n1 = *(const LAS f32x4*)(F + HN + sv + hf * 8 + 4);
                float g[8], y8[8]; unpack8(*(const LAS u32x4*)(lds + KB + (st * 136 + sv + hf * 8) * 2), g);
#pragma unroll
                for (int j = 0; j < 4; ++j) { y8[j] = x0[j] * rs * n0[j] * siluf_(g[j]); y8[4 + j] = x1[j] * rs * n1[j] * siluf_(g[4 + j]); }
                *(u32x4*)(yr + hf * 8) = pack8(y8);
            }
        }
    }
#undef HG_PREFETCH
#undef HG_IDS
}

__device__ __forceinline__ void p2_ml(KP P, int l, int item, LAS unsigned char* lds) {
    const int tid = ltid(), lane = tid & 63, wave = tid >> 6, b = item >> 2, h = item & 3;
    const int fr = lane & 15, fq = lane >> 4, st = tid >> 3, c8 = tid & 7, sv = c8 * 16;
    const int blk = tid & 31, sg = tid >> 5;
    const bf16_t* U = (const bf16_t*)(P->ws + WS_U); bf16_t* Y = (bf16_t*)(P->ws + WS_HY);
    LAS float* F = LDSF(0);
    constexpr int FD = 0, IW = 64, EN = 128, RS = 256, NK = 512, TNS = 768, CT = 1280, MN = 2944, MS = 3072;
    constexpr int QB = 12800, KB = QB + 64 * 136 * 2, KT = KB + 64 * 136 * 2, VT = KT + 128 * 72 * 2, AB = VT + 128 * 72 * 2, OO = AB + 64 * 72 * 2, XC = OO + 64 * 132 * 4;
    __syncthreads();
    if (tid < 32) {
        const int cgl = h * 128 + blk * 4;
#pragma unroll
        for (int jj = 0; jj < 4; ++jj) *(LAS f32x4*)(F + CT + (jj * 32 + blk) * 4) = *(const f32x4*)(P->in[I_MLCW] + l * 2048 + jj * 512 + cgl);
        *(LAS f32x4*)(F + CT + (4 * 32 + blk) * 4) = *(const f32x4*)(P->in[I_MLCB] + l * 512 + cgl);
#pragma unroll
        for (int j = 0; j < 4; ++j) {
            *(LAS f32x4*)(F + CT + ((5 + j) * 32 + blk) * 4) = *(const f32x4*)(P->in[I_MLWQ] + (size_t)l * 2048 + (h * 32 + blk) * 16 + j * 4) * 0.08838834764831845f;
            *(LAS f32x4*)(F + CT + ((9 + j) * 32 + blk) * 4) = *(const f32x4*)(P->in[I_MLWK] + (size_t)l * 2048 + (h * 32 + blk) * 16 + j * 4);
        }
    }
    const float ib = P->in[I_MLIB][l * 4 + h], fb = P->in[I_MLFB][l * 4 + h];
    f32x4 M[8];
#pragma unroll
    for (int j = 0; j < 8; ++j) M[j] = (f32x4){0.f, 0.f, 0.f, 0.f};
    float mcarry = 0.f;
    u32x2 px[7]; u32x4 pv0, pv1; unsigned pif;
#define ML_IDS const int tid = ltid(), lane = tid & 63, wave = tid >> 6, fr = lane & 15, fq = lane >> 4, st = tid >> 3, c8 = tid & 7, sv = c8 * 16, blk = tid & 31, sg = tid >> 5; (void)lane; (void)wave; (void)fr; (void)fq; (void)st; (void)c8; (void)sv; (void)blk; (void)sg;
#define ML_PREFETCH(ch) do { ML_IDS const int ts0_ = (ch) * 64 + sg * 4 - 3; \
        _Pragma("unroll") for (int r = 0; r < 7; ++r) { const int ts_ = ts0_ + r; \
            px[r] = *(const u32x2*)(U + (size_t)(b * SEQ + (ts_ < 0 ? 0 : ts_)) * LDU + U_ML_X + h * 128 + blk * 4); } \
        { const bf16_t* uv_ = U + (size_t)(b * SEQ + (ch) * 64 + st) * LDU + U_ML_V + h * 128 + sv; pv0 = *(const u32x4*)uv_; pv1 = *(const u32x4*)(uv_ + 8); } \
        { const bf16_t* ug_ = U + (size_t)(b * SEQ + (ch) * 64 + lane) * LDU; pif = (unsigned)ug_[U_ML_I + h] | ((unsigned)ug_[U_ML_F + h] << 16); } } while (0)
    if (tid < 128) { F[NK + tid] = 0.f; F[MN + tid] = P->in[I_MLNORM][l * 512 + h * 128 + tid]; F[MS + tid] = P->in[I_MLSKIP][l * 512 + h * 128 + tid]; }
    ML_PREFETCH(0);
    __syncthreads();
    for (int ch = 0; ch < SEQ / 64; ++ch) {
        const u32x4 cv0 = pv0, cv1 = pv1;
        u32x4 co0, co1;
        {   ML_IDS
        { const bf16_t* uo_ = U + (size_t)(b * SEQ + ch * 64 + st) * LDU + U_ML_O + h * 128 + sv; co0 = *(const u32x4*)uo_; co1 = *(const u32x4*)(uo_ + 8); }
        }
        __syncthreads();
        float q[4][4], k[4][4];
        {   ML_IDS
        {
            float xc[4][4];
            {
                f32x4 cw[4];
#pragma unroll
                for (int j = 0; j < 4; ++j) cw[j] = *(const LAS f32x4*)(F + CT + (j * 32 + blk) * 4);
                const f32x4 cb4 = *(const LAS f32x4*)(F + CT + (4 * 32 + blk) * 4);
                float x[7][4];
#pragma unroll
                for (int r = 0; r < 7; ++r) { const float vf = (ch * 64 + sg * 4 - 3 + r) < 0 ? 0.f : 1.f; x[r][0] = vf * bflo(px[r].x); x[r][1] = vf * bfhi(px[r].x); x[r][2] = vf * bflo(px[r].y); x[r][3] = vf * bfhi(px[r].y); }
#pragma unroll
                for (int s = 0; s < 4; ++s)
#pragma unroll
                    for (int j = 0; j < 4; ++j) xc[s][j] = siluf_(cb4[j] + cw[0][j] * x[s][j] + cw[1][j] * x[s + 1][j] + cw[2][j] * x[s + 2][j] + cw[3][j] * x[s + 3][j]);
            }
#pragma unroll
            for (int s = 0; s < 4; ++s) { u32x2 w; w.x = pk_bf16(xc[s][0], xc[s][1]); w.y = pk_bf16(xc[s][2], xc[s][3]); *(LAS u32x2*)(lds + XC + ((sg * 4 + s) * 136 + blk * 4) * 2) = w; }
            __builtin_amdgcn_sched_barrier(0);
            {
                f32x4 wq[4];
#pragma unroll
                for (int j = 0; j < 4; ++j) wq[j] = *(const LAS f32x4*)(F + CT + ((5 + j) * 32 + blk) * 4);
#pragma unroll
                for (int s = 0; s < 4; ++s)
#pragma unroll
                    for (int i = 0; i < 4; ++i) q[s][i] = xc[s][0] * wq[0][i] + xc[s][1] * wq[1][i] + xc[s][2] * wq[2][i] + xc[s][3] * wq[3][i];
            }
            __builtin_amdgcn_sched_barrier(0);
            {
                f32x4 wk[4];
#pragma unroll
                for (int j = 0; j < 4; ++j) wk[j] = *(const LAS f32x4*)(F + CT + ((9 + j) * 32 + blk) * 4);
#pragma unroll
                for (int s = 0; s < 4; ++s)
#pragma unroll
                    for (int i = 0; i < 4; ++i) k[s][i] = xc[s][0] * wk[0][i] + xc[s][1] * wk[1][i] + xc[s][2] * wk[2][i] + xc[s][3] * wk[3][i];
            }
        }
        if (wave == 0) {
            const float ip = bflo(pif) + ib, xf = bfhi(pif) + fb;
            const float lf = fminf(xf, 0.f) - log1pf(__expf(-fabsf(xf)));
            const float bs = wave_scan_sum(lf);
            const float cm = wave_scan_max(ip - bs);
            const float g = fmaxf(mcarry, cm), mt = bs + g;
            const int lq = lane + lsgpr(0);
            F[FD + lq] = __expf(mcarry - g);
            F[IW + lq] = __expf(ip - bs - mcarry);
            F[EN + lq] = __expf(-mt);
            mcarry = __int_as_float(__builtin_amdgcn_readlane(__float_as_int(mt), 63));
        }
        }
        __syncthreads();
        {   ML_IDS
#pragma unroll
            for (int s = 0; s < 4; ++s) {
                const int t = sg * 4 + s; const float fd = F[FD + t], iw = F[IW + t];
#pragma unroll
                for (int i = 0; i < 4; ++i) { q[s][i] *= fd; k[s][i] *= iw; }
                u32x2 w; w.x = pk_bf16(q[s][0], q[s][1]); w.y = pk_bf16(q[s][2], q[s][3]);
                *(LAS u32x2*)(lds + QB + (t * 136 + blk * 4) * 2) = w;
                w.x = pk_bf16(k[s][0], k[s][1]); w.y = pk_bf16(k[s][2], k[s][3]);
                *(LAS u32x2*)(lds + KB + (t * 136 + blk * 4) * 2) = w;
            }
#pragma unroll
            for (int i = 0; i < 4; ++i) {
                u32x2 w; w.x = pk_bf16(k[0][i], k[1][i]); w.y = pk_bf16(k[2][i], k[3][i]);
                *(LAS u32x2*)(lds + KT + ((blk * 4 + i) * 72 + sg * 4) * 2) = w;
            }
#pragma unroll
            for (int j = 0; j < 8; ++j) {
                const unsigned w0 = cv0[j >> 1], w1 = cv1[j >> 1];
                *(LAS bf16_t*)(lds + VT + ((sv + j) * 72 + st) * 2) = (bf16_t)((j & 1) ? (w0 >> 16) : (w0 & 0xffffu));
                *(LAS bf16_t*)(lds + VT + ((sv + 8 + j) * 72 + st) * 2) = (bf16_t)((j & 1) ? (w1 >> 16) : (w1 & 0xffffu));
            }
        }
        __syncthreads();
        {   ML_IDS
        if (ch + 1 < SEQ / 64) ML_PREFETCH(ch + 1);
        {
            const int ti = wave >> 1, si0 = 2 * (wave & 1);
            f32x4 a0 = (f32x4){0.f, 0.f, 0.f, 0.f}, a1 = a0;
#pragma unroll
            for (int kk = 0; kk < 4; ++kk) {
                const bf16x8 qa = *(const LAS bf16x8*)(lds + QB + ((ti * 16 + fr) * 136 + kk * 32 + fq * 8) * 2);
                const bf16x8 k0 = *(const LAS bf16x8*)(lds + KB + (((si0) * 16 + fr) * 136 + kk * 32 + fq * 8) * 2);
                const bf16x8 k1 = *(const LAS bf16x8*)(lds + KB + (((si0 + 1) * 16 + fr) * 136 + kk * 32 + fq * 8) * 2);
                a0 = __builtin_amdgcn_mfma_f32_16x16x32_bf16(qa, k0, a0, 0, 0, 0);
                a1 = __builtin_amdgcn_mfma_f32_16x16x32_bf16(qa, k1, a1, 0, 0, 0);
            }
#pragma unroll
            for (int rg = 0; rg < 4; ++rg) {
                const int ta = ti * 16 + fq * 4 + rg, s0 = si0 * 16 + fr, s1 = s0 + 16;
                const unsigned w0 = pk_bf16((s0 <= ta) ? a0[rg] : 0.f, 0.f) & 0xffffu, w1 = pk_bf16((s1 <= ta) ? a1[rg] : 0.f, 0.f) & 0xffffu;
                *(LAS bf16_t*)(lds + AB + (ta * 72 + s0) * 2) = (bf16_t)w0;
                *(LAS bf16_t*)(lds + AB + (ta * 72 + s1) * 2) = (bf16_t)w1;
                const float r0 = red16(bflo(w0)), r1 = red16(bflo(w1));
                if (fr == 0) { F[RS + si0 * 64 + ta] = r0; F[RS + (si0 + 1) * 64 + ta] = r1; }
            }
            const int kk = tid & 127, q4 = tid >> 7;
            const u32x4 t0 = *(const LAS u32x4*)(lds + KT + (kk * 72 + q4 * 16) * 2), t1 = *(const LAS u32x4*)(lds + KT + (kk * 72 + q4 * 16 + 8) * 2);
            float f0[8], f1[8]; unpack8(t0, f0); unpack8(t1, f1);
            float s = 0.f;
#pragma unroll
            for (int j = 0; j < 8; ++j) s += f0[j] + f1[j];
            F[TNS + q4 * 128 + kk] = s;
        }
        }
        __syncthreads();
        {   ML_IDS
        *(LAS u32x4*)(lds + KB + (st * 136 + sv) * 2) = co0; *(LAS u32x4*)(lds + KB + (st * 136 + sv + 8) * 2) = co1;
        {
            const float ce = F[FD + 63];
            bf16x8 mb[4], vb[2];
#pragma unroll
            for (int kk = 0; kk < 4; ++kk) {
                u32x4 w; w.x = pk_bf16(M[2 * kk][0], M[2 * kk][1]); w.y = pk_bf16(M[2 * kk][2], M[2 * kk][3]); w.z = pk_bf16(M[2 * kk + 1][0], M[2 * kk + 1][1]); w.w = pk_bf16(M[2 * kk + 1][2], M[2 * kk + 1][3]);
                mb[kk] = __builtin_bit_cast(bf16x8, w);
            }
#pragma unroll
            for (int kk = 0; kk < 2; ++kk) vb[kk] = *(const LAS bf16x8*)(lds + VT + ((wave * 16 + fr) * 72 + kk * 32 + fq * 8) * 2);
#pragma unroll
            for (int ti = 0; ti < 4; ++ti) {
                f32x4 o = (f32x4){0.f, 0.f, 0.f, 0.f};
#pragma unroll
                for (int kk = 0; kk < 2; ++kk) {
                    const bf16x8 sa = *(const LAS bf16x8*)(lds + AB + ((ti * 16 + fr) * 72 + kk * 32 + fq * 8) * 2);
                    o = __builtin_amdgcn_mfma_f32_16x16x32_bf16(sa, vb[kk], o, 0, 0, 0);
                }
#pragma unroll
                for (int kk = 0; kk < 4; ++kk) {
                    const u32x2 lo = *(const LAS u32x2*)(lds + QB + ((ti * 16 + fr) * 136 + kk * 32 + fq * 4) * 2), hi = *(const LAS u32x2*)(lds + QB + ((ti * 16 + fr) * 136 + kk * 32 + 16 + fq * 4) * 2);
                    const u32x4 w = (u32x4){lo.x, lo.y, hi.x, hi.y};
                    o = __builtin_amdgcn_mfma_f32_16x16x32_bf16(__builtin_bit_cast(bf16x8, w), mb[kk], o, 0, 0, 0);
                }
#pragma unroll
                for (int rg = 0; rg < 4; ++rg) *(LAS float*)(lds + OO + ((ti * 16 + fq * 4 + rg) * 132 + wave * 16 + fr) * 4) = o[rg];
            }
#pragma unroll
            for (int kt = 0; kt < 8; ++kt) {
#pragma unroll
                for (int kk = 0; kk < 2; ++kk) {
                    const bf16x8 ka = *(const LAS bf16x8*)(lds + KT + ((kt * 16 + fr) * 72 + kk * 32 + fq * 8) * 2);
                    M[kt] = __builtin_amdgcn_mfma_f32_16x16x32_bf16(ka, vb[kk], M[kt], 0, 0, 0);
                }
                M[kt] *= ce;
            }
            if (tid < 128) F[NK + ((ch + 1) & 1) * 128 + tid] = (F[NK + (ch & 1) * 128 + tid] + (F[TNS + tid] + F[TNS + 128 + tid]) + (F[TNS + 256 + tid] + F[TNS + 384 + tid])) * ce;
        }
        }
        __syncthreads();
        {   ML_IDS
            const u32x4 q0 = *(const LAS u32x4*)(lds + QB + (st * 136 + c8 * 16) * 2), q1 = *(const LAS u32x4*)(lds + QB + (st * 136 + c8 * 16 + 8) * 2);
            float f0[8], f1[8]; unpack8(q0, f0); unpack8(q1, f1);
            float d = 0.f;
#pragma unroll
            for (int m = 0; m < 2; ++m) {
                const f32x4 n0 = *(const LAS f32x4*)(F + NK + (ch & 1) * 128 + c8 * 16 + 4 * m), n1 = *(const LAS f32x4*)(F + NK + (ch & 1) * 128 + c8 * 16 + 8 + 4 * m);
#pragma unroll
                for (int j = 0; j < 4; ++j) d += f0[4 * m + j] * n0[j] + f1[4 * m + j] * n1[j];
            }
            d = red8(d);
            d += (F[RS + st] + F[RS + 64 + st]) + (F[RS + 128 + st] + F[RS + 192 + st]);
            const float dinv = 1.0f / fmaxf(fabsf(d), F[EN + st]);
            float o[16], og[16], xs[16];
#pragma unroll
            for (int m = 0; m < 4; ++m) { const f32x4 x = *(const LAS f32x4*)(lds + OO + (st * 132 + sv + 4 * m) * 4); o[4 * m] = x[0] * dinv; o[4 * m + 1] = x[1] * dinv; o[4 * m + 2] = x[2] * dinv; o[4 * m + 3] = x[3] * dinv; }
            { float t0[8], t1[8]; unpack8(*(const LAS u32x4*)(lds + KB + (st * 136 + sv) * 2), t0); unpack8(*(const LAS u32x4*)(lds + KB + (st * 136 + sv + 8) * 2), t1);
#pragma unroll
              for (int j = 0; j < 8; ++j) { og[j] = t0[j]; og[8 + j] = t1[j]; }
              unpack8(*(const LAS u32x4*)(lds + XC + (st * 136 + sv) * 2), t0); unpack8(*(const LAS u32x4*)(lds + XC + (st * 136 + sv + 8) * 2), t1);
#pragma unroll
              for (int j = 0; j < 8; ++j) { xs[j] = t0[j]; xs[8 + j] = t1[j]; } }
            float ss = 0.f;
#pragma unroll
            for (int j = 0; j < 16; ++j) { o[j] *= sigmoidf_(og[j]); ss += o[j] * o[j]; }
            const float rs = rsqrtf(red8(ss) * (1.0f / 128.0f) + 1e-6f);
#pragma unroll
            for (int j = 0; j < 16; ++j) o[j] = o[j] * rs * F[MN + sv + j] + F[MS + sv + j] * xs[j];
            u32x4 w0, w1;
            w0.x = pk_bf16(o[0], o[1]); w0.y = pk_bf16(o[2], o[3]); w0.z = pk_bf16(o[4], o[5]); w0.w = pk_bf16(o[6], o[7]);
            w1.x = pk_bf16(o[8], o[9]); w1.y = pk_bf16(o[10], o[11]); w1.z = pk_bf16(o[12], o[13]); w1.w = pk_bf16(o[14], o[15]);
            bf16_t* yr = Y + (size_t)(b * SEQ + ch * 64 + st) * DM + 1024 + h * 128 + sv;
            *(u32x4*)yr = w0; *(u32x4*)(yr + 8) = w1;
        }
    }
#undef ML_PREFETCH
#undef ML_IDS
}

__device__ __forceinline__ void p2_lru(KP P, int l, int item, LAS unsigned char* lds) {
    const int tid = ltid(), lane = tid & 63, wave = tid >> 6, b = item >> 3, cgp = item & 7;
    const float* LA = (const float*)(P->ws + WS_LRUA); const float* LB = (const float*)(P->ws + WS_LRUB); bf16_t* Y = (bf16_t*)(P->ws + WS_HY);
    LAS float* F = LDSF(0);
    const size_t base = (size_t)(b * SEQ + wave * 512) * 512 + cgp * 64 + lane;
    float hh = 0.f, ap = 1.f;
#pragma unroll 8
    for (int t = 0; t < 512; ++t) { const float a = LA[base + (size_t)t * 512], x = LB[base + (size_t)t * 512]; hh = a * hh + x; ap *= a; }
    __syncthreads();
    F[wave * 64 + lane] = ap; F[512 + wave * 64 + lane] = hh;
    __syncthreads();
    float c = 0.f;
    for (int j = 0; j < wave; ++j) c = F[j * 64 + lane] * c + F[512 + j * 64 + lane];
    hh = c;
    bf16_t* yp = Y + (size_t)(b * SEQ + wave * 512) * DM + 1536 + cgp * 64 + lane;
#pragma unroll 8
    for (int t = 0; t < 512; ++t) { const float a = LA[base + (size_t)t * 512], x = LB[base + (size_t)t * 512]; hh = a * hh + x; yp[(size_t)t * DM] = (bf16_t)(pk_bf16(hh, 0.f) & 0xffffu); }

    {
        unsigned* bar0 = (unsigned*)(P->ws + WS_BAR + (size_t)P->li * WS_BAR_STRIDE);
        unsigned* fl = (unsigned*)(P->ws + WS_BAR + (size_t)30 * WS_BAR_STRIDE) + (l * 8 + b) * 64 + 32;
        asm volatile("s_waitcnt vmcnt(0)" ::: "memory");
        __syncthreads();
        if (threadIdx.x == 0) {
            __builtin_amdgcn_fence(__ATOMIC_RELEASE, "agent");
            asm volatile("s_waitcnt vmcnt(0)" ::: "memory");
            (void)xb_add(fl, 1u);
            XB_SPIN(xb_ld(fl) < 8u, bar0);
            __builtin_amdgcn_fence(__ATOMIC_ACQUIRE, "agent");
            asm volatile("s_waitcnt vmcnt(0)" ::: "memory");
        }
        __syncthreads();
        const bf16_t* U = (const bf16_t*)(P->ws + WS_U);
        const int c0 = lane * 8;
        float lrn[8];
#pragma unroll
        for (int j = 0; j < 8; ++j) lrn[j] = P->in[I_LRUNORM][l * 512 + c0 + j];
#pragma unroll 2
        for (int i = 0; i < 64; ++i) {
            const int tok = b * SEQ + cgp * 512 + wave * 64 + i;
            bf16_t* yr = Y + (size_t)tok * DM; const bf16_t* ur = U + (size_t)tok * LDU;
            float hv[8], gb[8], y8[8]; unpack8(*(const u32x4*)(yr + 1536 + c0), hv); unpack8(*(const u32x4*)(ur + U_LRU_G + c0), gb);
            float ss = 0.f;
#pragma unroll
            for (int j = 0; j < 8; ++j) { hv[j] *= gelu_tanhf_(gb[j]); ss += hv[j] * hv[j]; }
            const float rs = rsqrtf(red64(ss) * (1.0f / 512.0f) + 1e-6f);
#pragma unroll
            for (int j = 0; j < 8; ++j) y8[j] = hv[j] * rs * lrn[j];
            *(u32x4*)(yr + 1536 + c0) = pack8(y8);
        }
    }
}

__device__ __forceinline__ void phase_p3(KP P, int l) { (void)P; (void)l; }

#ifndef MK_ONE_LAUNCH
#define MK_ONE_LAUNCH 1
#endif
#ifndef MK_DEBUG_BAR
#define MK_DEBUG_BAR 0
#endif
#ifndef MK_FUSE_MASK
#define MK_FUSE_MASK 0x3FFFFFFull
#endif
#ifndef MK_SEAM_DELAY
#define MK_SEAM_DELAY 0
#endif
#ifndef MK_KIND_MASK
#define MK_KIND_MASK 0x40
#endif
#ifndef MK_P1_SPLIT
#define MK_P1_SPLIT 0
#endif
#ifndef MK_REPEAT_PHASE
#define MK_REPEAT_PHASE (-1)
#endif
#ifndef MK_REPEAT_ITEM
#define MK_REPEAT_ITEM (-1)
#endif
#ifndef MK_REPEAT_KIND
#define MK_REPEAT_KIND (-1)
#endif
#ifndef MK_SIMPLE_BAR
#define MK_SIMPLE_BAR 0
#endif
__device__ __forceinline__ void simple_barrier(unsigned* bar, unsigned& epoch) {
    asm volatile("s_waitcnt vmcnt(0)" ::: "memory");
    __syncthreads();
    if (threadIdx.x == 0) {
        __builtin_amdgcn_fence(__ATOMIC_RELEASE, "agent");
        asm volatile("s_waitcnt vmcnt(0)" ::: "memory");
        (void)xb_add(&bar[XB_TOP], 1u);
        const unsigned target = (epoch + 1u) * gridDim.x;
        XB_SPIN(xb_ld(&bar[XB_TOP]) < target, bar);
        __builtin_amdgcn_fence(__ATOMIC_ACQUIRE, "agent");
        asm volatile("s_waitcnt vmcnt(0)" ::: "memory");
    }
    ++epoch;
    __syncthreads();
}
enum { K_CONVERT = 0, K_MODFINAL, K_NORM, K_UP, K_DOWN, K_WIN, K_P1, K_P2, K_P3, K_WOUT, K_FINAL, K_DOWNF };
template <int KIND> __device__ __forceinline__ void run_phase(int l_, int sub_, LAS unsigned char* lds) {
    const int l = lsgpr(l_), sub = lsgpr(sub_);
    const KP P = kp_fresh();
    const float* modf = (const float*)(P->ws + WS_MODF);
    bf16_t* HY = (bf16_t*)(P->ws + WS_HY); bf16_t* UU = (bf16_t*)(P->ws + WS_U);
    const bf16_t* Wl = (const bf16_t*)(P->ws + WS_W) + (size_t)l * LW_ELEMS;
    bf16_t* XB = (bf16_t*)P->out; bf16_t* X2 = (bf16_t*)(P->ws + WS_LRUA);
    const int xf32 = (l == 0 && sub == 0) ? 1 : 0;
    const void* xcur = xf32 ? (const void*)P->in[I_X] : ((l == 1 && sub == 2) ? (const void*)X2 : (const void*)XB);
    const int f = sub >> 1;
    if constexpr (KIND == K_CONVERT) phase_convert(P, lds);
    if constexpr (KIND == K_MODFINAL) phase_modfinal(P);
    if constexpr (KIND == K_NORM) phase_norm(P, l, sub, xcur, xf32, lds);
    if constexpr (KIND == K_UP) {
        pg8::Gemm g{HY, Wl + (f ? LW_W13B : LW_W13A), NTOK, 2 * DFF, DM}; pg8::StaticOrder S; S.init(NTOK, 2 * DFF, lgdim(), lbid());
        EpiSwiGLU E{UU};
        pg8::gemm_phase<EpiSwiGLU, pg8::StaticOrder, true, true>(lds, g, S, E);
    }
    if constexpr (KIND == K_DOWN) {
        pg8::Gemm g{UU, Wl + (f ? LW_W2B : LW_W2A), NTOK, DM, DFF}; pg8::StaticOrder S; S.init(NTOK, DM, lgdim(), lbid(), 4);
        EpiResid E{xcur, XB, modf + (size_t)l * 8 * NMOD + sub * 6144 + 4096, 0.5f, xf32};
        pg8::gemm_phase<EpiResid, pg8::StaticOrder, true, true>(lds, g, S, E);
    }
    if constexpr (KIND == K_DOWNF) {
        pg8::Gemm g{UU, Wl + (f ? LW_W2B : LW_W2A), NTOK, DM, DFF}; pg8::StaticOrder S; S.init(NTOK, DM, lgdim(), lbid(), 4);
        EpiFinal E{X2, P->out, modf + (size_t)l * 8 * NMOD + sub * 6144 + 4096, 0.5f, P->in[I_FNORM], (float*)(P->ws + WS_RWW), (unsigned*)(P->ws + WS_BAR + (size_t)29 * WS_BAR_STRIDE) + 256,
                   (unsigned*)(P->ws + WS_BAR + (size_t)P->li * WS_BAR_STRIDE), (LAS float*)(lds + pg8::STAGE_BYTES)};
        pg8::gemm_phase<EpiFinal, pg8::StaticOrder, true, true>(lds, g, S, E);
    }
    if constexpr (KIND == K_WIN) {
        pg8::Gemm g{HY, Wl + LW_WIN, NTOK, LDU, DM}; pg8::StaticOrder S; S.init(NTOK, LDU, lgdim(), lbid());
        EpiU E{UU};
        pg8::gemm_phase<EpiU, pg8::StaticOrder, true, true>(lds, g, S, E);
    }
    if constexpr (KIND == K_P1) { const int part = P->pad; if (part != 2) p1_rw_lora(P, l, lds); if (part != 1) p1_lru_prep(P, l, lds); }
    if constexpr (KIND == K_P2) {
        for (int it = lbid(); it < 256; it += lgdim()) {
            if (it < 64) { _Pragma("unroll 1") for (int rep = 0; rep < ((MK_REPEAT_ITEM == 0) ? 2 : 1); ++rep) p2_rw(P, l, it, lds); }
            else if (it < 96) { p2_hg(P, l, it - 64, lds); if (MK_REPEAT_ITEM == 1) p2_hg(P, l, it - 64, lds); }
            else if (it < 128) { p2_ml(P, l, it - 96, lds); if (MK_REPEAT_ITEM == 2) p2_ml(P, l, it - 96, lds); }
            else if (it < 192) { p2_lru(P, l, it - 128, lds); }
        }
        if (l == 0) convert_dynamic(P, lds);
    }
    if constexpr (KIND == K_P3) phase_p3(P, l);
    if constexpr (KIND == K_WOUT) {
        pg8::Gemm g{HY, Wl + LW_WOUT, NTOK, DM, DM}; pg8::StaticOrder S; S.init(NTOK, DM, lgdim(), lbid(), 4);
        EpiResid E{XB, (l == 1) ? X2 : XB, modf + (size_t)l * 8 * NMOD + 1 * 6144 + 4096, 1.0f, 0};
        pg8::gemm_phase<EpiResid, pg8::StaticOrder, true, true>(lds, g, S, E);
    }
    if constexpr (KIND == K_FINAL) { }
}

template <int KIND> __global__ void __launch_bounds__(NTHR, 2) k_phase(Params P_unused, int l, int sub) {
    extern __shared__ __attribute__((aligned(16))) unsigned char lds_raw[];
    run_phase<KIND>(l, sub, (LAS unsigned char*)lds_raw);
}
constexpr int N_PHASES = 27;
__global__ void __launch_bounds__(NTHR, 2) hymba_fwd(Params P_unused) {
    extern __shared__ __attribute__((aligned(16))) unsigned char lds_raw[];
    LAS unsigned char* lds = (LAS unsigned char*)lds_raw;
    const KP P = kp_fresh();
    const int lo = P->ph_lo, hi = P->ph_hi;
    if (threadIdx.x == 0) *(LAS u32x4*)(lds + LDS_BARW) = (u32x4){0u, 0u, 0u, 0u};
    __syncthreads();
    unsigned* barw = (unsigned*)(P->ws + WS_BAR + (size_t)P->li * WS_BAR_STRIDE);
    XcdBarrier bar = xcd_barrier_post(barw, (volatile LAS unsigned*)(lds + LDS_BARW));
#define SEAM(k) do { if ((k) + 1 < hi) xcd_barrier(bar); } while (0)
#define IN(k) (lo <= (k) && (k) < hi)
#define PH(k, KIND, l, sub) do { if (IN(k)) { run_phase<KIND>(l, sub, lds); if ((MK_REPEAT_KIND) == (KIND) || (MK_REPEAT_PHASE) == (k)) { xcd_barrier(bar); run_phase<KIND>(l, sub, lds); } SEAM(k); } } while (0)
    PH(0, K_CONVERT, 0, 0);
    PH(1, K_MODFINAL, 0, 0);
#define LAYER(l, b, KDOWN2) \
    PH((b) + 0, K_NORM, l, 0); PH((b) + 1, K_UP, l, 0); PH((b) + 2, K_DOWN, l, 0); \
    PH((b) + 3, K_NORM, l, 1); PH((b) + 4, K_WIN, l, 1); PH((b) + 5, K_P1, l, 1); PH((b) + 6, K_P2, l, 1); PH((b) + 8, K_WOUT, l, 1); \
    PH((b) + 9, K_NORM, l, 2); PH((b) + 10, K_UP, l, 2); PH((b) + 11, KDOWN2, l, 2);
    LAYER(0, 2, K_DOWN)
    LAYER(1, 14, K_DOWNF)
#undef LAYER
    {
        unsigned bad = 0u;
        if (IN(25)) { for (int li = 0; li < 32; ++li) bad |= __hip_atomic_load((unsigned*)(P->ws + WS_BAR + (size_t)li * WS_BAR_STRIDE) + XB_TMO, __ATOMIC_RELAXED, __HIP_MEMORY_SCOPE_AGENT); }
        if (bad) { const float qn = __builtin_nanf(""); for (size_t i = (size_t)blockIdx.x * NTHR + threadIdx.x; i < (size_t)NTOK * DM; i += (size_t)gridDim.x * NTHR) P->out[i] = qn; }
    }
#undef PH
#undef IN
#undef SEAM
}

#if 1
template <int KIND> static void launch_phase(const Params& p, int l, int sub, int grid, hipStream_t stream) {
    static bool attr_set = false;
    if (!attr_set) { (void)hipFuncSetAttribute((const void*)k_phase<KIND>, hipFuncAttributeMaxDynamicSharedMemorySize, LDS_BYTES); attr_set = true; }
    hipLaunchKernelGGL(k_phase<KIND>, dim3(grid), dim3(NTHR), LDS_BYTES, stream, p, l, sub);
}
#endif
extern "C" void kernel_launch(void* const* d_in, const int* in_sizes, int n_in, void* d_out, int out_size, void* d_ws, size_t ws_size, hipStream_t stream) {
    static int grid = 0;
    if (grid == 0) {
        if (n_in != N_IN || out_size != NTOK * DM || ws_size < WS_END) { fprintf(stderr, "kernel_launch: unexpected shapes (n_in %d, out %d, ws %zu < %zu)\n", n_in, out_size, ws_size, (size_t)WS_END); grid = -1; return; }
        int dev = 0, cus = 0;
        if (hipGetDevice(&dev) != hipSuccess || hipDeviceGetAttribute(&cus, hipDeviceAttributeMultiprocessorCount, dev) != hipSuccess) { grid = -1; return; }
#if MK_ONE_LAUNCH
        int per_cu = 0;
        if (hipFuncSetAttribute((const void*)hymba_fwd, hipFuncAttributeMaxDynamicSharedMemorySize, LDS_BYTES) != hipSuccess) { fprintf(stderr, "kernel_launch: hipFuncSetAttribute failed\n"); grid = -1; return; }
        if (hipOccupancyMaxActiveBlocksPerMultiprocessor(&per_cu, (const void*)hymba_fwd, NTHR, LDS_BYTES) != hipSuccess || per_cu < 1) fprintf(stderr, "kernel_launch: occupancy query says %d\n", per_cu);
        (void)hipGetLastError();
#endif
        grid = cus;
        if (grid != 256) fprintf(stderr, "kernel_launch: %d CUs (built for 256)\n", grid);
    }
    if (grid < 0) return;
    Params p{};
    for (int i = 0; i < N_IN; ++i) p.in[i] = (const float*)d_in[i];
    p.out = (float*)d_out; p.ws = (unsigned char*)d_ws;
#if MK_ONE_LAUNCH
    (void)hipMemsetAsync((char*)d_ws + WS_BAR, 0, 32 * WS_BAR_STRIDE, stream);
    {
        int lo = 0, li = 0;
        for (int k = 0; k < N_PHASES; ++k) {
            const bool fused = (k + 1 < N_PHASES) && ((MK_FUSE_MASK >> k) & 1ull);
            if (!fused) { p.ph_lo = lo; p.ph_hi = k + 1; p.li = li++; hipLaunchKernelGGL(hymba_fwd, dim3(grid), dim3(NTHR), LDS_BYTES, stream, p); lo = k + 1; }
        }
    }
#else
    (void)hipMemsetAsync((char*)d_ws + WS_BAR, 0, 32 * WS_BAR_STRIDE, stream);
    static bool attr2 = false;
    if (!attr2) { (void)hipFuncSetAttribute((const void*)hymba_fwd, hipFuncAttributeMaxDynamicSharedMemorySize, LDS_BYTES); attr2 = true; }
    int k = 0;
#define LAUNCH(KIND, l, sub) do { if ((MK_KIND_MASK >> (KIND)) & 1) { p.ph_lo = k; p.ph_hi = k + 1; p.li = 0; hipLaunchKernelGGL(hymba_fwd, dim3(grid), dim3(NTHR), LDS_BYTES, stream, p); } \
        else { p.ph_lo = 0; p.ph_hi = 0; launch_phase<KIND>(p, l, sub, grid, stream); } ++k; } while (0)
    LAUNCH(K_CONVERT, 0, 0);
    LAUNCH(K_MODFINAL, 0, 0);
    for (int l = 0; l < 2; ++l)
        for (int sub = 0; sub < 3; ++sub) {
            LAUNCH(K_NORM, l, sub);
            if (sub != 1) { LAUNCH(K_UP, l, sub); if (l == 1 && sub == 2) { LAUNCH(K_DOWNF, l, sub); } else { LAUNCH(K_DOWN, l, sub); } }
            else { LAUNCH(K_WIN, l, sub); {
                   if (MK_P1_SPLIT == 0) { LAUNCH(K_P1, l, sub); }
                   else { const int fa = (MK_P1_SPLIT == 1);
                       p.pad = 1; if (fa) { p.ph_lo = k; p.ph_hi = k + 1; p.li = 0; hipLaunchKernelGGL(hymba_fwd, dim3(grid), dim3(NTHR), LDS_BYTES, stream, p); } else { p.ph_lo = 0; p.ph_hi = 0; launch_phase<K_P1>(p, l, sub, grid, stream); }
                       p.pad = 2; if (!fa) { p.ph_lo = k; p.ph_hi = k + 1; p.li = 0; hipLaunchKernelGGL(hymba_fwd, dim3(grid), dim3(NTHR), LDS_BYTES, stream, p); } else { p.ph_lo = 0; p.ph_hi = 0; launch_phase<K_P1>(p, l, sub, grid, stream); }
                       p.pad = 0; ++k; } } LAUNCH(K_P2, l, sub); LAUNCH(K_P3, l, sub); LAUNCH(K_WOUT, l, sub); }
        }
    LAUNCH(K_FINAL, 0, 0);
#undef LAUNCH
#endif
}
```

```cpp
#include <hip/hip_runtime.h>
#include <cstdio>
#include <cstdint>
__device__ __forceinline__ int ltid() { int t = (int)threadIdx.x; asm volatile("" : "+v"(t)); return t; }
__device__ __forceinline__ int lbid() { int x = (int)blockIdx.x; asm volatile("" : "+s"(x)); return x; }
__device__ __forceinline__ int lgdim() { int x = (int)gridDim.x; asm volatile("" : "+s"(x)); return x; }
__device__ __forceinline__ int lsgpr(int x) { asm volatile("" : "+s"(x)); return x; }
namespace pg8 {
#define PG8_LAS __attribute__((address_space(3)))
typedef unsigned short bf16_t;
typedef short bf16x8 __attribute__((ext_vector_type(8)));
typedef float f32x4 __attribute__((ext_vector_type(4)));
typedef unsigned u32x4 __attribute__((ext_vector_type(4)));
constexpr int BM = 256, BK = 64, HALF = 128, HTB = HALF * BK * 2  , STAGE_BYTES = 8 * HTB, NXCD = 8, WGM = 8;

__host__ __device__ __forceinline__ int lds_byte(int r, int c) { const int st = (r >> 4) * 2 + (c >> 5), rr = r & 15, cc = c & 31, ob = rr * 64 + cc * 2; return st * 1024 + (ob ^ (((ob >> 9) & 1) << 5)); }
__host__ __device__ __forceinline__ void stage_rc(int b, int& R, int& C) { const int st = b / 1024, sb = b % 1024, swz = sb ^ (((sb >> 9) & 1) << 5); R = (st >> 1) * 16 + swz / 64; C = (st & 1) * 32 + (swz % 64) / 2; }
__host__ __device__ __forceinline__ int perm32(int rho) { const int n = rho >> 4, i = rho & 15; return 8 * (i >> 2) + 4 * n + (i & 3); }

struct Unit { int pm, pn; };
struct Gemm { const bf16_t* A; const bf16_t* Bt; int M, N, K; };

struct StaticOrder {
    int nM, nN, nwg, G, c, wgm;
    __host__ __device__ void init(int M, int N, int G_, int c_, int wgm_ = WGM) { nM = M / BM; nN = N / BM; nwg = nM * nN; G = G_; c = c_; wgm = wgm_; }
    __host__ __device__ bool next(int i, Unit& u) const {
        const long L = (long)i * G + c; if (L >= nwg) return false;
        int wgid = (int)L; { const int q = nwg / NXCD, r = nwg % NXCD, xcd = wgid % NXCD, off = wgid / NXCD; wgid = (xcd < r ? xcd * (q + 1) : r * (q + 1) + (xcd - r) * q) + off; }
        const int nig = wgm * nN, gid = wgid / nig, fm = gid * wgm, gsz = (nM - fm) < wgm ? (nM - fm) : wgm;
        u.pm = fm + ((wgid % nig) % gsz); u.pn = (wgid % nig) / gsz; return true;
    }
    __device__ __forceinline__ void a_ready(const Unit&) const {}
    __device__ __forceinline__ void done(const Unit&) const {}
};
template <class Epi, class Sched, bool ALIGN_EPI = false, bool SP2 = false>
__device__ __forceinline__ void gemm_phase(PG8_LAS unsigned char* lds, const Gemm g, const Sched& S, const Epi& E) {
    const int tid = ltid(), wid = __builtin_amdgcn_readfirstlane(tid >> 6), lane = tid & 63, wr = wid >> 2, wc = wid & 3, fr = lane & 15, fq = lane >> 4;
    const int K = g.K, nt = K / BK;
    unsigned voffA[2], voffB[2];
#pragma unroll
    for (int i = 0; i < 2; ++i) { int R, C; stage_rc(tid * 16 + i * 8192, R, C); const int Rb = Epi::PERM ? ((R & ~31) + perm32(R & 31)) : R;
        voffA[i] = (unsigned)(R * K + C) * 2u; voffB[i] = (unsigned)(Rb * K + C) * 2u; }
    const size_t kstep = (size_t)(BK * 2);
    const size_t hstep = (size_t)HALF * K * 2;
    const size_t tstep = 2 * hstep;
    const unsigned ldsw = (unsigned)wid * 1024u;
    const int aoff = lds_byte(wr * 64 + fr, fq * 8), boff = lds_byte(wc * 32 + fr, fq * 8);
#define PG8_SA(b, h) (((b) * 2 + (h)) * HTB)
#define PG8_SB(b, h) ((4 + (b) * 2 + (h)) * HTB)
#define PG8_STAGE(bufoff, gbase, voff) do { _Pragma("unroll") for (int _i = 0; _i < 2; ++_i) \
        __builtin_amdgcn_global_load_lds((const unsigned*)((const char*)(gbase) + (voff)[_i]), (PG8_LAS unsigned*)(lds + (bufoff) + ldsw + _i * 8192), 16, 0, 0); } while (0)
#define PG8_LDA(dst, b, h) do { _Pragma("unroll") for (int m = 0; m < 4; ++m) _Pragma("unroll") for (int k = 0; k < 2; ++k) dst[m][k] = *(const PG8_LAS bf16x8*)(lds + PG8_SA(b, h) + aoff + m * 2048 + k * 1024); } while (0)
#define PG8_LDB(dst, b, h) do { _Pragma("unroll") for (int n = 0; n < 2; ++n) _Pragma("unroll") for (int k = 0; k < 2; ++k) dst[n][k] = *(const PG8_LAS bf16x8*)(lds + PG8_SB(b, h) + boff + n * 2048 + k * 1024); } while (0)
#define PG8_MMA(ai, bj, At, Bt) do { __builtin_amdgcn_s_setprio(1); _Pragma("unroll") for (int m = 0; m < 4; ++m) _Pragma("unroll") for (int n = 0; n < 2; ++n) _Pragma("unroll") for (int k = 0; k < 2; ++k) \
        acc[ai][bj][m][n] = __builtin_amdgcn_mfma_f32_16x16x32_bf16(Bt[n][k], At[m][k], acc[ai][bj][m][n], 0, 0, 0); __builtin_amdgcn_s_setprio(0); } while (0)
#define PG8_WAIT_V(n) asm volatile("s_waitcnt vmcnt(" #n ")" ::: "memory")
#define PG8_WAIT_L(n) asm volatile("s_waitcnt lgkmcnt(" #n ")" ::: "memory")
#define PG8_BAR __builtin_amdgcn_s_barrier()
#define PG8_SCHED __builtin_amdgcn_sched_barrier(0)
    Unit cur, nxt; int ui = 0;
    if (!S.next(0, cur)) return;
    f32x4 acc[2][2][4][2];
#pragma unroll
    for (int a = 0; a < 2; ++a)
#pragma unroll
        for (int b = 0; b < 2; ++b)
#pragma unroll
            for (int m = 0; m < 4; ++m)
#pragma unroll
                for (int n = 0; n < 2; ++n) acc[a][b][m][n] = (f32x4){0.f, 0.f, 0.f, 0.f};
    bf16x8 At[4][2], B0[2][2], B1[2][2];
    const char* cA = (const char*)g.A + (size_t)cur.pm * tstep; const char* cB = (const char*)g.Bt + (size_t)cur.pn * tstep;
    S.a_ready(cur);
    if constexpr (SP2) {
        PG8_STAGE(PG8_SB(0, 0), cB, voffB); PG8_STAGE(PG8_SB(0, 1), cB + hstep, voffB); PG8_STAGE(PG8_SA(0, 0), cA, voffA); PG8_STAGE(PG8_SA(0, 1), cA + hstep, voffA);
        if (wr == 1) PG8_BAR;
        PG8_WAIT_V(2); PG8_BAR;
        PG8_STAGE(PG8_SB(1, 0), cB + kstep, voffB); PG8_STAGE(PG8_SA(1, 0), cA + kstep, voffA); PG8_STAGE(PG8_SB(1, 1), cB + hstep + kstep, voffB);
        PG8_WAIT_V(6); PG8_BAR;
    } else {
        PG8_STAGE(PG8_SB(0, 0), cB, voffB); PG8_STAGE(PG8_SA(0, 0), cA, voffA); PG8_STAGE(PG8_SB(0, 1), cB + hstep, voffB); PG8_STAGE(PG8_SA(0, 1), cA + hstep, voffA);
        if (wr == 1) PG8_BAR;
        PG8_WAIT_V(4); PG8_BAR;
        PG8_STAGE(PG8_SB(1, 0), cB + kstep, voffB); PG8_STAGE(PG8_SA(1, 0), cA + kstep, voffA); PG8_STAGE(PG8_SB(1, 1), cB + hstep + kstep, voffB);
        PG8_WAIT_V(6); PG8_BAR;
    }
    for (;;) {
        const bool has_next = S.next(ui + 1, nxt);
        const char* nA = has_next ? (const char*)g.A + (size_t)nxt.pm * tstep : cA; const char* nB = has_next ? (const char*)g.Bt + (size_t)nxt.pn * tstep : cB;
        for (int t = 0; t < nt; t += 2) {
            const bool last = (t == nt - 2);
            const char* a1 = cA + (size_t)(t + 1) * kstep;
            const char* a2 = last ? nA : cA + (size_t)(t + 2) * kstep; const char* b2 = last ? nB : cB + (size_t)(t + 2) * kstep;
            const char* a3 = a2 + kstep; const char* b3 = b2 + kstep;
            if (last && has_next) S.a_ready(nxt);
            if constexpr (SP2) {
            PG8_LDB(B0, 0, 0); PG8_LDB(B1, 0, 1); PG8_SCHED; PG8_LDA(At, 0, 0); PG8_STAGE(PG8_SA(1, 1), a1 + hstep, voffA);
            PG8_WAIT_V(8); PG8_WAIT_L(0); PG8_BAR; PG8_MMA(0, 0, At, B0); PG8_MMA(0, 1, At, B1); PG8_BAR; PG8_SCHED;
            PG8_LDA(At, 0, 1); PG8_STAGE(PG8_SB(0, 0), b2, voffB); PG8_STAGE(PG8_SB(0, 1), b2 + hstep, voffB); PG8_STAGE(PG8_SA(0, 0), a2, voffA);
            PG8_WAIT_V(8); PG8_WAIT_L(0); PG8_BAR; PG8_MMA(1, 0, At, B0); PG8_MMA(1, 1, At, B1); PG8_BAR; PG8_SCHED;
            PG8_LDB(B0, 1, 0); PG8_LDB(B1, 1, 1); PG8_SCHED; PG8_LDA(At, 1, 0); PG8_STAGE(PG8_SA(0, 1), a2 + hstep, voffA);
            PG8_WAIT_V(8); PG8_WAIT_L(0); PG8_BAR; PG8_MMA(0, 0, At, B0); PG8_MMA(0, 1, At, B1); PG8_BAR; PG8_SCHED;
            PG8_LDA(At, 1, 1); PG8_STAGE(PG8_SB(1, 0), b3, voffB); PG8_STAGE(PG8_SB(1, 1), b3 + hstep, voffB); PG8_STAGE(PG8_SA(1, 0), a3, voffA);
            PG8_WAIT_V(8); PG8_WAIT_L(0); PG8_BAR; PG8_MMA(1, 0, At, B0); PG8_MMA(1, 1, At, B1); PG8_BAR; PG8_SCHED;
            } else {
            PG8_LDB(B0, 0, 0); PG8_SCHED; PG8_LDA(At, 0, 0); PG8_STAGE(PG8_SA(1, 1), a1 + hstep, voffA);
            PG8_WAIT_L(8); PG8_BAR; PG8_WAIT_L(0); PG8_MMA(0, 0, At, B0); PG8_BAR; PG8_SCHED;
            PG8_LDB(B1, 0, 1); PG8_STAGE(PG8_SB(0, 0), b2, voffB);
            PG8_BAR; PG8_WAIT_L(0); PG8_MMA(0, 1, At, B1); PG8_BAR;
            PG8_LDA(At, 0, 1); PG8_STAGE(PG8_SA(0, 0), a2, voffA);
            PG8_BAR; PG8_WAIT_L(0); PG8_MMA(1, 0, At, B0); PG8_BAR; PG8_SCHED;
            PG8_STAGE(PG8_SB(0, 1), b2 + hstep, voffB);
            PG8_WAIT_V(6); PG8_BAR; PG8_MMA(1, 1, At, B1); PG8_BAR;
            PG8_LDB(B0, 1, 0); PG8_SCHED; PG8_LDA(At, 1, 0); PG8_STAGE(PG8_SA(0, 1), a2 + hstep, voffA);
            PG8_WAIT_L(8); PG8_BAR; PG8_WAIT_L(0); PG8_MMA(0, 0, At, B0); PG8_BAR; PG8_SCHED;
            PG8_LDB(B1, 1, 1); PG8_STAGE(PG8_SB(1, 0), b3, voffB);
            PG8_BAR; PG8_WAIT_L(0); PG8_MMA(0, 1, At, B1); PG8_BAR;
            PG8_LDA(At, 1, 1); PG8_STAGE(PG8_SA(1, 0), a3, voffA);
            PG8_BAR; PG8_WAIT_L(0); PG8_MMA(1, 0, At, B0); PG8_BAR; PG8_SCHED;
            PG8_STAGE(PG8_SB(1, 1), b3 + hstep, voffB);
            PG8_WAIT_V(6); PG8_BAR; PG8_MMA(1, 1, At, B1); PG8_BAR;
            }
        }
        if constexpr (ALIGN_EPI) { if (wr == 0) PG8_BAR; }
        if constexpr (!Epi::AFTER_DRAIN) { E(acc, cur, wr, wc, fr, fq); S.done(cur); }
        if (!has_next) break;
#pragma unroll
        for (int a = 0; a < 2; ++a)
#pragma unroll
            for (int b = 0; b < 2; ++b)
#pragma unroll
                for (int m = 0; m < 4; ++m)
#pragma unroll
                    for (int n = 0; n < 2; ++n) acc[a][b][m][n] = (f32x4){0.f, 0.f, 0.f, 0.f};
        cur = nxt; cA = nA; cB = nB; ++ui;
        if constexpr (ALIGN_EPI) { if (wr == 1) PG8_BAR; }
    }
    PG8_WAIT_V(0);
    if constexpr (!ALIGN_EPI) { if (wr == 0) PG8_BAR; }
    PG8_BAR;
    if constexpr (Epi::AFTER_DRAIN) { E.fused(acc, cur, wr, wc, fr, fq, lds, wid, lane); S.done(cur); }
#undef PG8_SA
#undef PG8_SB
#undef PG8_STAGE
#undef PG8_LDA
#undef PG8_LDB
#undef PG8_MMA
#undef PG8_WAIT_V
#undef PG8_WAIT_L
#undef PG8_BAR
#undef PG8_SCHED
}
}
#define XB_TMO      128
#define XB_XCNT(j)  (256  + 64 * (j))
#define XB_XSUB(j)  (1280 + 64 * (j))
#define XB_XGEN(j)  (2304 + 64 * (j))
#define XB_TOP      3328
#define XB_TOPGEN   3392
#define XCD_BAR_WORDS 3456
#define XB_SPIN_CAP (1u << 18)
#define LAS __attribute__((address_space(3)))

__device__ __forceinline__ unsigned xb_ld(unsigned* p)              { return __hip_atomic_load(p, __ATOMIC_RELAXED, __HIP_MEMORY_SCOPE_AGENT); }
__device__ __forceinline__ unsigned xb_add(unsigned* p, unsigned v) { return __hip_atomic_fetch_add(p, v, __ATOMIC_RELAXED, __HIP_MEMORY_SCOPE_AGENT); }
__device__ __forceinline__ unsigned xb_xcc_id() { return (unsigned)__builtin_amdgcn_s_getreg((3 << 11) | 20) & 0xFu; }
#define XB_SPIN(cond, bar) do { unsigned _sp = 0; while (cond) { __builtin_amdgcn_s_sleep(1); \
    if ((++_sp & 255u) == 0u) { if (xb_ld(&(bar)[XB_TMO])) break; if (_sp > XB_SPIN_CAP) { atomicAdd(&(bar)[XB_TMO], 1u); break; } } } } while (0)

struct XcdBarrier {
    unsigned* bar; unsigned x;
    volatile LAS unsigned* st;
};

__device__ __forceinline__ XcdBarrier xcd_barrier_post(unsigned* bar, volatile LAS unsigned* st) {
    XcdBarrier b; b.bar = bar; b.x = xb_xcc_id(); b.st = st;
    if (threadIdx.x == 0) (void)xb_add(&bar[XB_XCNT(b.x)], 1u);
    return b;
}
__device__ __forceinline__ void xcd_barrier_complete(unsigned* bar, unsigned x, unsigned& nloc, unsigned& nx) {
    const unsigned G = gridDim.x * gridDim.y * gridDim.z;
    unsigned sum, cnt, mine, sp = 0u;
    for (;;) {
        sum = 0u; cnt = 0u; mine = 0u;
#pragma unroll
        for (unsigned j = 0; j < 16; ++j) { const unsigned c = xb_ld(&bar[XB_XCNT(j)]); sum += c; cnt += (c > 0u) ? 1u : 0u; mine = (j == x) ? c : mine; }
        if (sum == G) break;
        __builtin_amdgcn_s_sleep(1);
        if ((++sp & 255u) == 0u) { if (xb_ld(&bar[XB_TMO])) break; if (sp > XB_SPIN_CAP) { atomicAdd(&bar[XB_TMO], 1u); break; } }
    }
    nloc = mine > 0u ? mine : 1u; nx = cnt > 0u ? cnt : 1u;
}

__device__ __forceinline__ void xcd_barrier(const XcdBarrier& b) {
    asm volatile("s_waitcnt vmcnt(0)" ::: "memory");
    __syncthreads();
    if (threadIdx.x == 0) {
        unsigned* bar = b.bar;
        __builtin_amdgcn_s_waitcnt(0);
        unsigned nloc = b.st[0], nx = b.st[1];
        if (nloc == 0u) { xcd_barrier_complete(bar, b.x, nloc, nx); b.st[0] = nloc; b.st[1] = nx; }
        const unsigned old = xb_add(&bar[XB_XSUB(b.x)], 1u);
        const unsigned gen = old / nloc;
        if (old + 1u == (gen + 1u) * nloc) {
            __builtin_amdgcn_fence(__ATOMIC_RELEASE, "agent");
            asm volatile("s_waitcnt vmcnt(0)" ::: "memory");
            const unsigned og = xb_add(&bar[XB_TOP], 1u);
            const unsigned tg = og / nx;
            if (og + 1u == (tg + 1u) * nx) xb_add(&bar[XB_TOPGEN], 1u);
            else XB_SPIN(xb_ld(&bar[XB_TOPGEN]) == tg, bar);
            __builtin_amdgcn_fence(__ATOMIC_ACQUIRE, "agent");
            xb_add(&bar[XB_XGEN(b.x)], 1u);
            asm volatile("s_waitcnt vmcnt(0)" ::: "memory");
        } else {
            XB_SPIN(xb_ld(&bar[XB_XGEN(b.x)]) == gen, bar);
            __builtin_amdgcn_fence(__ATOMIC_ACQUIRE, "agent");
            asm volatile("s_waitcnt vmcnt(0)" ::: "memory");
        }
    }
    __syncthreads();
}

typedef unsigned short bf16_t;
typedef short bf16x8 __attribute__((ext_vector_type(8)));
typedef float f32x4 __attribute__((ext_vector_type(4)));
typedef float f32x2 __attribute__((ext_vector_type(2)));
typedef unsigned u32x4 __attribute__((ext_vector_type(4)));
typedef unsigned u32x2 __attribute__((ext_vector_type(2)));

constexpr int NB = 8, SEQ = 4096, DM = 2048, NTOK = NB * SEQ, DFF = 5632, DIN = 6312, LDU = 6400, NMOD = 18432, NTHR = 512;
constexpr int U_HG_Q = 0, U_HG_F = 512, U_HG_I = 1024, U_HG_G = 1536;
constexpr int U_RW_R = 2048, U_RW_K = 2560, U_RW_V = 3072, U_RW_WD = 3584;
constexpr int U_ML_X = 3744, U_ML_V = 4256, U_ML_O = 4768, U_ML_I = 5280, U_ML_F = 5284;
constexpr int U_LRU_X = 5288, U_LRU_G = 5800;
constexpr int RW_IN = 1696;

enum { I_X = 0, I_C, I_GAIN, I_MODW, I_MODB, I_W1, I_W3, I_W2, I_WIN, I_WOUT, I_HGLB, I_HGNORM, I_RWMU, I_RWW0, I_RWW2, I_RWA0, I_RWA2, I_RWG2, I_RWKK, I_RWKA,
       I_RWRK, I_RWLNW, I_RWLNB, I_MLCW, I_MLCB, I_MLWQ, I_MLWK, I_MLIB, I_MLFB, I_MLNORM, I_MLSKIP, I_LRUCW, I_LRUCB, I_LRUWA, I_LRUBA, I_LRUWX, I_LRUBX,
       I_LRULAM, I_LRUNORM, I_FNORM, N_IN };

constexpr size_t WS_BAR = 0;
constexpr size_t WS_BAR_STRIDE = 16384, WS_MODP = 32 * WS_BAR_STRIDE;
constexpr size_t WS_MODF = WS_MODP + (size_t)2 * 16 * 8 * NMOD * 4;
constexpr size_t WS_LRUW = WS_MODF + (size_t)2 * 8 * NMOD * 4;
constexpr size_t WS_W = WS_LRUW + (size_t)2 * 2 * 4 * 16384 * 2;
constexpr size_t LW_W13A = 0, LW_W2A = 23068672, LW_W13B = 34603008, LW_W2B = 57671680, LW_WIN = 69206016, LW_WOUT = 82313216, LW_ELEMS = 86507520;
constexpr size_t WS_HY = WS_W + 2 * LW_ELEMS * 2;
constexpr size_t WS_U = WS_HY + (size_t)NTOK * DM * 2;
constexpr size_t WS_LRUA = WS_U + (size_t)NTOK * LDU * 2;
constexpr size_t WS_LRUB = WS_LRUA + (size_t)NTOK * 512 * 4;
constexpr size_t WS_RWW = WS_LRUB + (size_t)NTOK * 512 * 4;
constexpr size_t WS_RWA = WS_RWW + (size_t)NTOK * 512 * 4;
constexpr size_t WS_RWG = WS_RWA + (size_t)NTOK * 512 * 2;
constexpr size_t WS_LORAT = WS_RWG + (size_t)NTOK * 512 * 2;
constexpr size_t WS_END = WS_LORAT + (size_t)2 * 512 * 160 * 2;

constexpr int LDS_BYTES = 144 * 1024;
constexpr int LDS_BARW = LDS_BYTES - 16;

struct Params { const float* in[N_IN]; float* out; unsigned char* ws; int ph_lo, ph_hi, li, pad; };
typedef const Params __attribute__((address_space(4)))* KP;
__device__ __forceinline__ KP kp_fresh() { KP p = (KP)__builtin_amdgcn_kernarg_segment_ptr(); asm volatile("" : "+s"(p)); return p; }

__device__ __forceinline__ float bflo(unsigned w) { return __uint_as_float(w << 16); }
__device__ __forceinline__ float bfhi(unsigned w) { return __uint_as_float(w & 0xffff0000u); }
__device__ __forceinline__ float bf2f(bf16_t h) { return __uint_as_float(((unsigned)h) << 16); }
typedef __bf16 bf16x2n __attribute__((ext_vector_type(2)));
__device__ __forceinline__ unsigned pk_bf16(float lo, float hi) { const f32x2 v = {lo, hi}; return __builtin_bit_cast(unsigned, __builtin_convertvector(v, bf16x2n)); }
__device__ __forceinline__ void unpack8(const u32x4 w, float (&f)[8]) { f[0] = bflo(w.x); f[1] = bfhi(w.x); f[2] = bflo(w.y); f[3] = bfhi(w.y); f[4] = bflo(w.z); f[5] = bfhi(w.z); f[6] = bflo(w.w); f[7] = bfhi(w.w); }
__device__ __forceinline__ u32x4 pack8(const float (&f)[8]) { u32x4 w; w.x = pk_bf16(f[0], f[1]); w.y = pk_bf16(f[2], f[3]); w.z = pk_bf16(f[4], f[5]); w.w = pk_bf16(f[6], f[7]); return w; }
__device__ __forceinline__ float fast_rcp(float x) { return __builtin_amdgcn_rcpf(x); }
__device__ __forceinline__ float sigmoidf_(float x) { return fast_rcp(1.0f + __expf(-x)); }
__device__ __forceinline__ float siluf_(float x) { return x * sigmoidf_(x); }
__device__ __forceinline__ float softplusf_(float x) { return fmaxf(x, 0.0f) + __logf(1.0f + __expf(-fabsf(x))); }
__device__ __forceinline__ float tanhf_(float x) { const float e = __expf(2.0f * x); return 1.0f - 2.0f * fast_rcp(e + 1.0f); }
__device__ __forceinline__ float gelu_tanhf_(float x) { return 0.5f * x * (1.0f + tanhf_(0.7978845608028654f * (x + 0.044715f * x * x * x))); }
template <int CTRL> __device__ __forceinline__ float dpp_f(float x) { return __int_as_float(__builtin_amdgcn_update_dpp(0, __float_as_int(x), CTRL, 0xF, 0xF, true)); }
__device__ __forceinline__ float wave_scan_sum(float x) {
#define DPP_SC_(v, old, ctrl, rmask) __int_as_float(__builtin_amdgcn_update_dpp(__float_as_int(old), __float_as_int(v), ctrl, rmask, 0xF, false))
    x += DPP_SC_(x, 0.f, 0x111, 0xF); x += DPP_SC_(x, 0.f, 0x112, 0xF); x += DPP_SC_(x, 0.f, 0x114, 0xF); x += DPP_SC_(x, 0.f, 0x118, 0xF);
    x += DPP_SC_(x, 0.f, 0x142, 0xA); x += DPP_SC_(x, 0.f, 0x143, 0xC);
    return x;
}
__device__ __forceinline__ float wave_scan_max(float x) {
    x = fmaxf(x, DPP_SC_(x, x, 0x111, 0xF)); x = fmaxf(x, DPP_SC_(x, x, 0x112, 0xF)); x = fmaxf(x, DPP_SC_(x, x, 0x114, 0xF)); x = fmaxf(x, DPP_SC_(x, x, 0x118, 0xF));
    x = fmaxf(x, DPP_SC_(x, x, 0x142, 0xA)); x = fmaxf(x, DPP_SC_(x, x, 0x143, 0xC));
    return x;
#undef DPP_SC_
}
__device__ __forceinline__ float red8(float x) { x += dpp_f<0xB1>(x); x += dpp_f<0x4E>(x); x += dpp_f<0x141>(x); return x; }
__device__ __forceinline__ float red16(float x) { x = red8(x); x += dpp_f<0x140>(x); return x; }
__device__ __forceinline__ float red64(float x) { x = red16(x); x += __shfl_xor(x, 16); x += __shfl_xor(x, 32); return x; }


#define DPP_ADD4_(CTRL) "v_add_f32_dpp %0, %0, %0 " CTRL " row_mask:0xf bank_mask:0xf bound_ctrl:1\n\t" "v_add_f32_dpp %1, %1, %1 " CTRL " row_mask:0xf bank_mask:0xf bound_ctrl:1\n\t" \
                        "v_add_f32_dpp %2, %2, %2 " CTRL " row_mask:0xf bank_mask:0xf bound_ctrl:1\n\t" "v_add_f32_dpp %3, %3, %3 " CTRL " row_mask:0xf bank_mask:0xf bound_ctrl:1\n\t"
__device__ __forceinline__ void red16x4(float& a, float& b, float& c, float& d) {
    asm volatile("s_nop 4\n\t" DPP_ADD4_("quad_perm:[1,0,3,2]") DPP_ADD4_("quad_perm:[2,3,0,1]") DPP_ADD4_("row_half_mirror") DPP_ADD4_("row_mirror") : "+v"(a), "+v"(b), "+v"(c), "+v"(d));
}

__device__ __forceinline__ void rw1_dots(float s0, float s1, float s2, float s3, const f32x4 ma, const f32x4 wr, float& p1, float& p2) {
    asm volatile(
        "v_mul_f32 %[p1], %[s0], %[ma0]\n\t" "v_mul_f32 %[p2], %[s0], %[wr0]\n\t" "v_fmac_f32 %[p1], %[s1], %[ma1]\n\t" "v_fmac_f32 %[p2], %[s1], %[wr1]\n\t"
        "v_fmac_f32 %[p1], %[s2], %[ma2]\n\t" "v_fmac_f32 %[p2], %[s2], %[wr2]\n\t" "v_fmac_f32 %[p1], %[s3], %[ma3]\n\t" "v_fmac_f32 %[p2], %[s3], %[wr3]\n\t"
        : [p1] "=&v"(p1), [p2] "=&v"(p2)
        : [s0] "v"(s0), [s1] "v"(s1), [s2] "v"(s2), [s3] "v"(s3), [ma0] "v"(ma[0]), [ma1] "v"(ma[1]), [ma2] "v"(ma[2]), [ma3] "v"(ma[3]),
          [wr0] "v"(wr[0]), [wr1] "v"(wr[1]), [wr2] "v"(wr[2]), [wr3] "v"(wr[3]));
}
#define DPP_ADD2_(CTRL, TL) "v_add_f32_dpp %[a], %[a], %[a] " CTRL " row_mask:0xf bank_mask:0xf bound_ctrl:1\n\t" "v_add_f32_dpp %[b], %[b], %[b] " CTRL " row_mask:0xf bank_mask:0xf bound_ctrl:1\n\t" TL
__device__ __forceinline__ void rw1_reduce(float& a, float& b, float v, const f32x4 kp, float& t0, float& t1, float& t2, float& t3) {
    asm volatile("s_nop 4\n\t"
        DPP_ADD2_("quad_perm:[1,0,3,2]", "v_mul_f32 %[t0], %[v], %[kp0]\n\t") DPP_ADD2_("quad_perm:[2,3,0,1]", "v_mul_f32 %[t1], %[v], %[kp1]\n\t")
        DPP_ADD2_("row_half_mirror", "v_mul_f32 %[t2], %[v], %[kp2]\n\t") DPP_ADD2_("row_mirror", "v_mul_f32 %[t3], %[v], %[kp3]\n\t")
        : [a] "+v"(a), [b] "+v"(b), [t0] "=&v"(t0), [t1] "=&v"(t1), [t2] "=&v"(t2), [t3] "=&v"(t3)
        : [v] "v"(v), [kp0] "v"(kp[0]), [kp1] "v"(kp[1]), [kp2] "v"(kp[2]), [kp3] "v"(kp[3]));
}
__device__ __forceinline__ void rw1_update(float& s0, float& s1, float& s2, float& s3, float sa, float t0, float t1, float t2, float t3, const f32x4 wd, const f32x4 bv) {
    asm volatile(
        "v_fmac_f32 %[t0], %[sa], %[bv0]\n\t" "v_fmac_f32 %[t1], %[sa], %[bv1]\n\t" "v_fmac_f32 %[t2], %[sa], %[bv2]\n\t" "v_fmac_f32 %[t3], %[sa], %[bv3]\n\t"
        "v_fma_f32 %[s0], %[s0], %[wd0], %[t0]\n\t" "v_fma_f32 %[s1], %[s1], %[wd1], %[t1]\n\t" "v_fma_f32 %[s2], %[s2], %[wd2], %[t2]\n\t" "v_fma_f32 %[s3], %[s3], %[wd3], %[t3]\n\t"
        : [s0] "+v"(s0), [s1] "+v"(s1), [s2] "+v"(s2), [s3] "+v"(s3), [t0] "+v"(t0), [t1] "+v"(t1), [t2] "+v"(t2), [t3] "+v"(t3)
        : [sa] "v"(sa), [wd0] "v"(wd[0]), [wd1] "v"(wd[1]), [wd2] "v"(wd[2]), [wd3] "v"(wd[3]), [bv0] "v"(bv[0]), [bv1] "v"(bv[1]), [bv2] "v"(bv[2]), [bv3] "v"(bv[3]));
}

#define LDSF(off) ((LAS float*)(lds + (off)))

__device__ __forceinline__ void cvt_tile(const float* __restrict__ src, bf16_t* __restrict__ dst, int K, int N, int kt, int nt, int mode, LAS unsigned char* lds) {
    const int tid = ltid(); LAS float* tile = LDSF(0);
    const int k0 = kt * 64, n0 = nt * 64;
#pragma unroll
    for (int p = 0; p < 2; ++p) {
        const int kk = p * 32 + (tid >> 4), n4 = (tid & 15) * 4;
        f32x4 v = (f32x4){0.f, 0.f, 0.f, 0.f};
        if (n0 + n4 < N) v = *(const f32x4*)(src + (size_t)(k0 + kk) * N + n0 + n4);
        tile[kk * 65 + n4 + 0] = v[0]; tile[kk * 65 + n4 + 1] = v[1]; tile[kk * 65 + n4 + 2] = v[2]; tile[kk * 65 + n4 + 3] = v[3];
    }
    __syncthreads();
    {
        const int nn = tid >> 3, k8 = (tid & 7) * 8, n = n0 + nn;
        float f[8];
#pragma unroll
        for (int j = 0; j < 8; ++j) f[j] = tile[(k8 + j) * 65 + nn];
        const int row = (mode == 0) ? n : ((n >> 7) * 256 + ((mode == 2) ? 128 : 0) + (n & 127));
        *(u32x4*)(dst + (size_t)row * K + k0 + k8) = pack8(f);
    }
    __syncthreads();
}

constexpr int T_FF = 2816, T_WIN = 3200, T_WOUT = 1024, T_LAYER = 6 * T_FF + T_WIN + T_WOUT;
struct CvtTile { const float* src; bf16_t* dst; int K, N, kt, nt, mode; };
__device__ __forceinline__ CvtTile cvt_desc(KP P, int l, int r) {
    bf16_t* Wl = (bf16_t*)(P->ws + WS_W) + (size_t)l * LW_ELEMS;
    CvtTile t;
    if (r < 6 * T_FF) {
        const int m = r / T_FF, q = r % T_FF, f = m / 3, which = m % 3;
        if (which < 2) { t.src = P->in[which == 0 ? I_W1 : I_W3] + (size_t)(l * 2 + f) * DM * DFF; t.dst = Wl + (f ? LW_W13B : LW_W13A); t.K = DM; t.N = DFF; t.kt = q / 88; t.nt = q % 88; t.mode = which + 1; }
        else { t.src = P->in[I_W2] + (size_t)(l * 2 + f) * DFF * DM; t.dst = Wl + (f ? LW_W2B : LW_W2A); t.K = DFF; t.N = DM; t.kt = q / 32; t.nt = q % 32; t.mode = 0; }
    } else if (r < 6 * T_FF + T_WIN) {
        const int q = r - 6 * T_FF;
        t.src = P->in[I_WIN] + (size_t)l * DM * DIN; t.dst = Wl + LW_WIN; t.K = DM; t.N = DIN; t.kt = q / 100; t.nt = q % 100; t.mode = 0;
    } else {
        const int q = r - 6 * T_FF - T_WIN;
        t.src = P->in[I_WOUT] + (size_t)l * DM * DM; t.dst = Wl + LW_WOUT; t.K = DM; t.N = DM; t.kt = q / 32; t.nt = q % 32; t.mode = 0;
    }
    return t;
}
__device__ __forceinline__ void cvt_load(const CvtTile& t, f32x4 (&v)[2]) {
    const int tid = ltid(), n4 = (tid & 15) * 4;
#pragma unroll
    for (int p = 0; p < 2; ++p) {
        const int kk = p * 32 + (tid >> 4);
        v[p] = (f32x4){0.f, 0.f, 0.f, 0.f};
        if (t.nt * 64 + n4 < t.N) v[p] = *(const f32x4*)(t.src + (size_t)(t.kt * 64 + kk) * t.N + t.nt * 64 + n4);
    }
}
__device__ __forceinline__ void cvt_store(const CvtTile& t, const f32x4 (&v)[2], LAS unsigned char* lds) {
    const int tid = ltid(); LAS float* tile = LDSF(0);
#pragma unroll
    for (int p = 0; p < 2; ++p) {
        const int kk = p * 32 + (tid >> 4), n4 = (tid & 15) * 4;
        tile[kk * 65 + n4 + 0] = v[p][0]; tile[kk * 65 + n4 + 1] = v[p][1]; tile[kk * 65 + n4 + 2] = v[p][2]; tile[kk * 65 + n4 + 3] = v[p][3];
    }
    __syncthreads();
    {
        const int nn = tid >> 3, k8 = (tid & 7) * 8, n = t.nt * 64 + nn;
        float f[8];
#pragma unroll
        for (int j = 0; j < 8; ++j) f[j] = tile[(k8 + j) * 65 + nn];
        const int row = (t.mode == 0) ? n : ((n >> 7) * 256 + ((t.mode == 2) ? 128 : 0) + (n & 127));
        *(u32x4*)(t.dst + (size_t)row * t.K + t.kt * 64 + k8) = pack8(f);
    }
    __syncthreads();
}
__device__ __forceinline__ CvtTile cvt_desc_dyn(KP P, int r);
constexpr int T_EARLY = 3 * T_FF + T_WIN, T_LATE0 = 3 * T_FF + T_WOUT, T_DYN = T_LATE0 + T_LAYER;
__device__ __forceinline__ CvtTile cvt_desc_dyn(KP P, int r) {
    if (r < T_LATE0) return cvt_desc(P, 0, (r < 3 * T_FF) ? r + 3 * T_FF : r + 3 * T_FF + T_WIN);
    return cvt_desc(P, 1, r - T_LATE0);
}
__device__ __forceinline__ void convert_dynamic(KP P, LAS unsigned char* lds) {
    unsigned* ctr = (unsigned*)(P->ws + WS_BAR + (size_t)31 * WS_BAR_STRIDE);
    LAS unsigned* sh = (LAS unsigned*)(lds + 32768);
    const int tid = ltid();
    for (;;) {
        __syncthreads();
        if (tid == 0) *sh = __hip_atomic_fetch_add(ctr, 8u, __ATOMIC_RELAXED, __HIP_MEMORY_SCOPE_AGENT);
        __syncthreads();
        const int base = (int)*sh;
        if (base >= T_DYN) break;
        const int end = (base + 8 < T_DYN) ? base + 8 : T_DYN;
        CvtTile cur = cvt_desc_dyn(P, base); f32x4 v[2]; cvt_load(cur, v);
        for (int r = base; r < end; ++r) {
            CvtTile nxt = cur; f32x4 w[2] = {v[0], v[1]};
            if (r + 1 < end) { nxt = cvt_desc_dyn(P, r + 1); cvt_load(nxt, w); }
            cvt_store(cur, v, lds);
            cur = nxt; v[0] = w[0]; v[1] = w[1];
        }
    }
}
__device__ __forceinline__ void phase_convert(KP P, LAS unsigned char* lds) {
    const int tid = ltid(), wg = lbid(), nwg = lgdim();
    constexpr int T_BIG = 0, T_LRU = 64, T_MOD = 2 * 36 * 16;
    if (wg < T_EARLY) {
        CvtTile cur = cvt_desc(P, 0, (wg < 3 * T_FF) ? wg : wg + 3 * T_FF); f32x4 v[2]; cvt_load(cur, v);
        for (int r = wg; r < T_EARLY; r += nwg) {
            CvtTile nxt = cur; f32x4 w[2] = {v[0], v[1]};
            const int rn = r + nwg;
            if (rn < T_EARLY) { nxt = cvt_desc(P, 0, (rn < 3 * T_FF) ? rn : rn + 3 * T_FF); cvt_load(nxt, w); }
            cvt_store(cur, v, lds);
            cur = nxt; v[0] = w[0]; v[1] = w[1];
        }
    }
    {
        bf16_t* LT = (bf16_t*)(P->ws + WS_LORAT);
        for (int e = wg * NTHR + tid; e < 2 * 512 * 160; e += nwg * NTHR) {
            const int l = e / 81920, r = e % 81920, ch = r / 160, j = r % 160;
            const float v = (j < 32) ? P->in[I_RWW2][(size_t)(l * 32 + j) * 512 + ch] : ((j < 64) ? P->in[I_RWA2][(size_t)(l * 32 + j - 32) * 512 + ch] : P->in[I_RWG2][(size_t)(l * 96 + j - 64) * 512 + ch]);
            LT[e] = (bf16_t)(pk_bf16(v, 0.f) & 0xffffu);
        }
    }
    for (int it = wg; it < T_BIG + T_LRU + T_MOD; it += nwg) {
        if (false) {
        } else if (it < T_BIG + T_LRU) {
            const int q = it - T_BIG, m16 = q >> 2, tl = q & 3, l = m16 >> 3, which = (m16 >> 2) & 1, blk = m16 & 3;
            const float* src = P->in[which ? I_LRUWX : I_LRUWA] + (size_t)(l * 4 + blk) * 16384;
            bf16_t* dst = (bf16_t*)(P->ws + WS_LRUW) + (size_t)((l * 2 + which) * 4 + blk) * 16384;
            cvt_tile(src, dst, 128, 128, tl >> 1, tl & 1, 0, lds);
        } else {
            const int m = it - T_BIG - T_LRU, l = m / 576, r = m % 576, jb = r / 16, ks = r % 16;
            LAS float* cact = LDSF(0);
#pragma unroll
            for (int e2 = 0; e2 < 2; ++e2) { const int e = tid * 2 + e2, kk = e >> 3, b = e & 7; cact[e] = siluf_(P->in[I_C][b * DM + ks * 128 + kk]); }
            __syncthreads();
            const int j = jb * 512 + tid;
            const float* wp = P->in[I_MODW] + (size_t)l * DM * NMOD + (size_t)(ks * 128) * NMOD + j;
            float acc[8];
#pragma unroll
            for (int b = 0; b < 8; ++b) acc[b] = 0.f;
#pragma unroll 32
            for (int kk = 0; kk < 128; ++kk) {
                const float w = wp[(size_t)kk * NMOD];
                const f32x4 c0 = *(const LAS f32x4*)(cact + kk * 8), c1 = *(const LAS f32x4*)(cact + kk * 8 + 4);
                acc[0] += c0[0] * w; acc[1] += c0[1] * w; acc[2] += c0[2] * w; acc[3] += c0[3] * w;
                acc[4] += c1[0] * w; acc[5] += c1[1] * w; acc[6] += c1[2] * w; acc[7] += c1[3] * w;
            }
            float* mp = (float*)(P->ws + WS_MODP) + (size_t)((l * 16 + ks) * 8) * NMOD + j;
#pragma unroll
            for (int b = 0; b < 8; ++b) mp[(size_t)b * NMOD] = acc[b];
            __syncthreads();
        }
    }
}

__device__ __forceinline__ void phase_modfinal(KP P) {
    const float* mp = (const float*)(P->ws + WS_MODP); float* mf = (float*)(P->ws + WS_MODF);
    for (int i = lbid() * NTHR + ltid(); i < 2 * 8 * NMOD; i += lgdim() * NTHR) {
        const int l = i / (8 * NMOD), r = i % (8 * NMOD), b = r / NMOD, j = r % NMOD;
        float s = P->in[I_MODB][l * NMOD + j];
#pragma unroll
        for (int ks = 0; ks < 16; ++ks) s += mp[(size_t)((l * 16 + ks) * 8 + b) * NMOD + j];
        mf[i] = s;
    }
}

__device__ __forceinline__ void phase_norm(KP P, int l, int sub, const void* __restrict__ xsrc, int xf32, LAS unsigned char* lds) {
    const int tid = ltid(), lane = tid & 63, wave = tid >> 6;
    bf16_t* H = (bf16_t*)(P->ws + WS_HY);
    LAS float* cv = LDSF(0); LAS float* sv = LDSF(8192);
    for (int rb = lbid(); rb < NTOK / 128; rb += lgdim()) {
        const int b = rb >> 5;
        const float* mod = (const float*)(P->ws + WS_MODF) + (size_t)(l * 8 + b) * NMOD + sub * 6144;
        __syncthreads();
        for (int d = tid; d < DM; d += NTHR) { cv[d] = P->in[I_GAIN][(l * 3 + sub) * DM + d] * (1.0f + mod[2048 + d]); sv[d] = mod[d]; }
        __syncthreads();
        if (xf32) {
            for (int rr = 0; rr < 16; ++rr) {
                const int row = rb * 128 + wave * 16 + rr;
                const float* xr = (const float*)xsrc + (size_t)row * DM;
                f32x4 v[8]; float ss = 0.f;
#pragma unroll
                for (int i = 0; i < 8; ++i) { v[i] = *(const f32x4*)(xr + i * 256 + lane * 4); ss += v[i][0] * v[i][0] + v[i][1] * v[i][1] + v[i][2] * v[i][2] + v[i][3] * v[i][3]; }
                ss = red64(ss);
                const float rstd = rsqrtf(ss * (1.0f / DM) + 1e-6f);
#pragma unroll
                for (int i = 0; i < 8; ++i) {
                    const int d = i * 256 + lane * 4;
                    const f32x4 c = *(const LAS f32x4*)(cv + d), s = *(const LAS f32x4*)(sv + d);
                    u32x2 w; w.x = pk_bf16(v[i][0] * rstd * c[0] + s[0], v[i][1] * rstd * c[1] + s[1]); w.y = pk_bf16(v[i][2] * rstd * c[2] + s[2], v[i][3] * rstd * c[3] + s[3]);
                    *(u32x2*)(H + (size_t)row * DM + d) = w;
                }
            }
        } else {
            for (int rr = 0; rr < 16; ++rr) {
                const int row = rb * 128 + wave * 16 + rr;
                const bf16_t* xr = (const bf16_t*)xsrc + (size_t)row * DM;
                u32x4 xw[4]; float ss = 0.f;
#pragma unroll
                for (int i = 0; i < 4; ++i) xw[i] = *(const u32x4*)(xr + i * 512 + lane * 8);
                float v[4][8];
#pragma unroll
                for (int i = 0; i < 4; ++i) {
                    unpack8(xw[i], v[i]);
#pragma unroll
                    for (int j = 0; j < 8; ++j) ss += v[i][j] * v[i][j];
                }
                ss = red64(ss);
                const float rstd = rsqrtf(ss * (1.0f / DM) + 1e-6f);
#pragma unroll
                for (int i = 0; i < 4; ++i) {
                    const int d = i * 512 + lane * 8;
                    const f32x4 c0 = *(const LAS f32x4*)(cv + d), c1 = *(const LAS f32x4*)(cv + d + 4), s0 = *(const LAS f32x4*)(sv + d), s1 = *(const LAS f32x4*)(sv + d + 4);
                    float o[8];
#pragma unroll
                    for (int j = 0; j < 4; ++j) { o[j] = v[i][j] * rstd * c0[j] + s0[j]; o[4 + j] = v[i][4 + j] * rstd * c1[j] + s1[j]; }
                    *(u32x4*)(H + (size_t)row * DM + d) = pack8(o);
                }
            }
        }
    }
}

__device__ __forceinline__ void phase_final_norm(KP P, const bf16_t* __restrict__ X) {
    const int tid = ltid(), lane = tid & 63, wave = tid >> 6;
    const float* fn = P->in[I_FNORM];
    for (int row = lbid() * 8 + wave; row < NTOK; row += lgdim() * 8) {
        const bf16_t* xr = X + (size_t)row * DM; float* orow = P->out + (size_t)row * DM;
        u32x4 xw[4]; float ss = 0.f;
#pragma unroll
        for (int i = 0; i < 4; ++i) xw[i] = *(const u32x4*)(xr + i * 512 + lane * 8);
        float v[4][8];
#pragma unroll
        for (int i = 0; i < 4; ++i) {
            unpack8(xw[i], v[i]);
#pragma unroll
            for (int j = 0; j < 8; ++j) ss += v[i][j] * v[i][j];
        }
        ss = red64(ss);
        const float rstd = rsqrtf(ss * (1.0f / DM) + 1e-6f);
#pragma unroll
        for (int i = 0; i < 4; ++i) {
            const int d = i * 512 + lane * 8;
            const f32x4 g0 = *(const f32x4*)(fn + d), g1 = *(const f32x4*)(fn + d + 4);
            f32x4 o0, o1;
#pragma unroll
            for (int j = 0; j < 4; ++j) { o0[j] = v[i][j] * rstd * g0[j]; o1[j] = v[i][4 + j] * rstd * g1[j]; }
            *(f32x4*)(orow + d) = o0; *(f32x4*)(orow + d + 4) = o1;
        }
    }
}

struct EpiSwiGLU {
    static constexpr bool PERM = true, AFTER_DRAIN = false;
    bf16_t* G;
    __device__ __forceinline__ void operator()(const pg8::f32x4 (&acc)[2][2][4][2], const pg8::Unit& u, int wr, int wc, int fr, int fq) const {
        const int row0 = u.pm * 256 + wr * 64 + fr, col0 = u.pn * 128 + wc * 32 + 8 * fq;
#pragma unroll
        for (int ai = 0; ai < 2; ++ai)
#pragma unroll
            for (int m = 0; m < 4; ++m) {
                float o[8];
#pragma unroll
                for (int n = 0; n < 2; ++n)
#pragma unroll
                    for (int j = 0; j < 4; ++j) { const float g = acc[ai][0][m][n][j]; o[n * 4 + j] = g * fast_rcp(1.0f + __expf(-g)) * acc[ai][1][m][n][j]; }
                *(u32x4*)(G + (size_t)(row0 + ai * 128 + m * 16) * DFF + col0) = pack8(o);
            }
    }
};
struct EpiResid {
    static constexpr bool PERM = false, AFTER_DRAIN = false;
    const void* xin; bf16_t* xout; const float* gate; float coef; int xf32;
    __device__ __forceinline__ void operator()(const pg8::f32x4 (&acc)[2][2][4][2], const pg8::Unit& u, int wr, int wc, int fr, int fq) const {
        const int row0 = u.pm * 256 + wr * 64 + fr, col0 = u.pn * 256 + wc * 32 + 4 * fq, b = u.pm >> 4;
        f32x4 gv[2][2];
#pragma unroll
        for (int bj = 0; bj < 2; ++bj)
#pragma unroll
            for (int n = 0; n < 2; ++n) gv[bj][n] = (*(const f32x4*)(gate + (size_t)b * NMOD + col0 + bj * 128 + n * 16) + 1.0f) * coef;
#pragma unroll
        for (int ai = 0; ai < 2; ++ai) {
            if (xf32) {
                const float* xi = (const float*)xin;
                f32x4 xv[4][2][2];
#pragma unroll
                for (int m = 0; m < 4; ++m)
#pragma unroll
                    for (int bj = 0; bj < 2; ++bj)
#pragma unroll
                        for (int n = 0; n < 2; ++n) xv[m][bj][n] = *(const f32x4*)(xi + (size_t)(row0 + ai * 128 + m * 16) * DM + col0 + bj * 128 + n * 16);
#pragma unroll
                for (int m = 0; m < 4; ++m)
#pragma unroll
                    for (int bj = 0; bj < 2; ++bj)
#pragma unroll
                        for (int n = 0; n < 2; ++n) {
                            const f32x4 r = xv[m][bj][n] + gv[bj][n] * acc[ai][bj][m][n];
                            u32x2 w; w.x = pk_bf16(r[0], r[1]); w.y = pk_bf16(r[2], r[3]);
                            *(u32x2*)(xout + (size_t)(row0 + ai * 128 + m * 16) * DM + col0 + bj * 128 + n * 16) = w;
                        }
            } else {
                const bf16_t* xi = (const bf16_t*)xin;
                u32x2 xw[4][2][2];
#pragma unroll
                for (int m = 0; m < 4; ++m)
#pragma unroll
                    for (int bj = 0; bj < 2; ++bj)
#pragma unroll
                        for (int n = 0; n < 2; ++n) xw[m][bj][n] = *(const u32x2*)(xi + (size_t)(row0 + ai * 128 + m * 16) * DM + col0 + bj * 128 + n * 16);
#pragma unroll
                for (int m = 0; m < 4; ++m)
#pragma unroll
                    for (int bj = 0; bj < 2; ++bj)
#pragma unroll
                        for (int n = 0; n < 2; ++n) {
                            const f32x4 xv = (f32x4){bflo(xw[m][bj][n].x), bfhi(xw[m][bj][n].x), bflo(xw[m][bj][n].y), bfhi(xw[m][bj][n].y)};
                            const f32x4 r = xv + gv[bj][n] * acc[ai][bj][m][n];
                            u32x2 w; w.x = pk_bf16(r[0], r[1]); w.y = pk_bf16(r[2], r[3]);
                            *(u32x2*)(xout + (size_t)(row0 + ai * 128 + m * 16) * DM + col0 + bj * 128 + n * 16) = w;
                        }
            }
        }
    }
};
struct EpiFinal {
    static constexpr bool PERM = false, AFTER_DRAIN = false;
    const bf16_t* xin; float* out; const float* gate; float coef; const float* fn; float* part; unsigned* flags; unsigned* bar0; LAS float* spare;
    __device__ __forceinline__ void operator()(const pg8::f32x4 (&acc_)[2][2][4][2], const pg8::Unit& u, int wr, int wc, int fr, int fq) const {
        pg8::f32x4 (&acc)[2][2][4][2] = const_cast<pg8::f32x4 (&)[2][2][4][2]>(acc_);
        const int row0 = u.pm * 256 + wr * 64 + fr, col0 = u.pn * 256 + wc * 32 + 4 * fq, b = u.pm >> 4, tid = ltid();
        f32x4 gv[2][2];
#pragma unroll
        for (int bj = 0; bj < 2; ++bj)
#pragma unroll
            for (int n = 0; n < 2; ++n) gv[bj][n] = (*(const f32x4*)(gate + (size_t)b * NMOD + col0 + bj * 128 + n * 16) + 1.0f) * coef;
#pragma unroll
        for (int ai = 0; ai < 2; ++ai) {
            u32x2 xw[4][2][2];
#pragma unroll
            for (int m = 0; m < 4; ++m)
#pragma unroll
                for (int bj = 0; bj < 2; ++bj)
#pragma unroll
                    for (int n = 0; n < 2; ++n) xw[m][bj][n] = *(const u32x2*)(xin + (size_t)(row0 + ai * 128 + m * 16) * DM + col0 + bj * 128 + n * 16);
#pragma unroll
            for (int m = 0; m < 4; ++m) {
                float sq = 0.f;
#pragma unroll
                for (int bj = 0; bj < 2; ++bj)
#pragma unroll
                    for (int n = 0; n < 2; ++n) {
                        const f32x4 xv = (f32x4){bflo(xw[m][bj][n].x), bfhi(xw[m][bj][n].x), bflo(xw[m][bj][n].y), bfhi(xw[m][bj][n].y)};
                        const f32x4 r = xv + gv[bj][n] * acc[ai][bj][m][n];
                        acc[ai][bj][m][n] = r;
                        sq += r[0] * r[0] + r[1] * r[1] + r[2] * r[2] + r[3] * r[3];
                    }
                sq += __int_as_float(__builtin_amdgcn_ds_bpermute(((tid & 63) ^ 16) << 2, __float_as_int(sq))); sq += __int_as_float(__builtin_amdgcn_ds_bpermute(((tid & 63) ^ 32) << 2, __float_as_int(sq)));
                if (fq == 0) spare[wc * 256 + wr * 64 + fr + ai * 128 + m * 16] = sq;
            }
        }
        __syncthreads();
        if (tid < 256) __hip_atomic_store(part + (size_t)(u.pm * 256 + tid) * 8 + u.pn, (spare[tid] + spare[256 + tid]) + (spare[512 + tid] + spare[768 + tid]), __ATOMIC_RELAXED, __HIP_MEMORY_SCOPE_AGENT);
        asm volatile("s_waitcnt vmcnt(0)" ::: "memory");
        __syncthreads();
        if (threadIdx.x == 0) {
            (void)xb_add(flags + u.pm, 1u);
            XB_SPIN(xb_ld(flags + u.pm) < 8u, bar0);
        }
        __syncthreads();
        if (tid < 256) {
            const float* pr = part + (size_t)(u.pm * 256 + tid) * 8;
            float t = 0.f;
#pragma unroll
            for (int j = 0; j < 8; ++j) t += __hip_atomic_load(pr + j, __ATOMIC_RELAXED, __HIP_MEMORY_SCOPE_AGENT);
            spare[1024 + tid] = rsqrtf(t * (1.0f / DM) + 1e-6f);
        }
        __syncthreads();
        f32x4 fv[2][2];
#pragma unroll
        for (int bj = 0; bj < 2; ++bj)
#pragma unroll
            for (int n = 0; n < 2; ++n) fv[bj][n] = *(const f32x4*)(fn + col0 + bj * 128 + n * 16);
#pragma unroll
        for (int ai = 0; ai < 2; ++ai)
#pragma unroll
            for (int m = 0; m < 4; ++m) {
                const size_t row = (size_t)(row0 + ai * 128 + m * 16);
                const float rstd = spare[1024 + wr * 64 + fr + ai * 128 + m * 16];
#pragma unroll
                for (int bj = 0; bj < 2; ++bj)
#pragma unroll
                    for (int n = 0; n < 2; ++n) *(f32x4*)(out + row * DM + col0 + bj * 128 + n * 16) = acc[ai][bj][m][n] * rstd * fv[bj][n];
            }
    }
};
struct EpiU {
    static constexpr bool PERM = true, AFTER_DRAIN = false;
    bf16_t* U;
    __device__ __forceinline__ void operator()(const pg8::f32x4 (&acc)[2][2][4][2], const pg8::Unit& u, int wr, int wc, int fr, int fq) const {
        const int row0 = u.pm * 256 + wr * 64 + fr, col0 = u.pn * 256 + wc * 32 + 8 * fq;
#pragma unroll
        for (int ai = 0; ai < 2; ++ai)
#pragma unroll
            for (int m = 0; m < 4; ++m)
#pragma unroll
                for (int bj = 0; bj < 2; ++bj) {
                    u32x4 w; w.x = pk_bf16(acc[ai][bj][m][0][0], acc[ai][bj][m][0][1]); w.y = pk_bf16(acc[ai][bj][m][0][2], acc[ai][bj][m][0][3]);
                    w.z = pk_bf16(acc[ai][bj][m][1][0], acc[ai][bj][m][1][1]); w.w = pk_bf16(acc[ai][bj][m][1][2], acc[ai][bj][m][1][3]);
                    *(u32x4*)(U + (size_t)(row0 + ai * 128 + m * 16) * LDU + col0 + bj * 128) = w;
                }
    }
};

__device__ __forceinline__ void p1_rw_lora(KP P, int l, LAS unsigned char* lds) {
    const int tid = ltid(), lane = tid & 63, wave = tid >> 6, fq = lane >> 4, fr = lane & 15, half = lbid() & 1;
    const bf16_t* U = (const bf16_t*)(P->ws + WS_U);
    float* RWW = (float*)(P->ws + WS_RWW); bf16_t* RWA = (bf16_t*)(P->ws + WS_RWA); bf16_t* RWG = (bf16_t*)(P->ws + WS_RWG);
    constexpr int O_WT = 0, O_ACT = 256 * 168 * 2, LDW = 168;
    const float* mu = P->in[I_RWMU] + l * RW_IN + 1536;
    __syncthreads();
    {
        const bf16_t* LT = (const bf16_t*)(P->ws + WS_LORAT) + (size_t)(l * 512 + half * 256) * 160;
#pragma unroll 2
        for (int e = tid; e < 256 * 20; e += NTHR) { const int ch = e / 20, c = e % 20; *(LAS u32x4*)(lds + O_WT + (ch * LDW + c * 8) * 2) = *(const u32x4*)(LT + (size_t)ch * 160 + c * 8); }
    }
    float w0[2], a0[2];
#pragma unroll
    for (int q = 0; q < 2; ++q) { const int ch = half * 256 + (wave * 2 + q) * 16 + fr; w0[q] = P->in[I_RWW0][l * 512 + ch]; a0[q] = P->in[I_RWA0][l * 512 + ch]; }
    u32x4 pc[3], pp[3];
#define LORA_PREFETCH(tt_) do { _Pragma("unroll") for (int i = 0; i < 3; ++i) { const int e_ = tid + i * NTHR; if (e_ < 1280) { const int tk_ = e_ / 20, c_ = e_ % 20, tok_ = (tt_) * 64 + tk_; \
        const bf16_t* uc_ = U + (size_t)tok_ * LDU + U_RW_WD + c_ * 8; pc[i] = *(const u32x4*)uc_; pp[i] = *(const u32x4*)((tok_ & (SEQ - 1)) ? uc_ - LDU : uc_); } } } while (0)
    const int tstep = lgdim() >> 1;
    if ((lbid() >> 1) < NTOK / 64) LORA_PREFETCH(lbid() >> 1);
    for (int tt = lbid() >> 1; tt < NTOK / 64; tt += tstep) {
        const int tok0 = tt * 64;
        __syncthreads();
#pragma unroll
        for (int i = 0; i < 3; ++i) {
            const int e = tid + i * NTHR;
            if (e < 1280) {
                const int tk = e / 20, c = e % 20, tok = tok0 + tk;
                float cur[8], prv[8], av[8]; unpack8(pc[i], cur); unpack8(pp[i], prv);
                const float pf = (tok & (SEQ - 1)) ? 1.0f : 0.0f;
                const f32x4 m0 = *(const f32x4*)(mu + c * 8), m1 = *(const f32x4*)(mu + c * 8 + 4);
#pragma unroll
                for (int j = 0; j < 8; ++j) {
                    const float v = cur[j] + (prv[j] * pf - cur[j]) * ((j < 4) ? m0[j & 3] : m1[j & 3]);
                    av[j] = (c < 4) ? tanhf_(v) : ((c < 8) ? v : sigmoidf_(v));
                }
                *(LAS u32x4*)(lds + O_ACT + (tk * LDW + c * 8) * 2) = pack8(av);
            }
        }
        if (tt + tstep < NTOK / 64) LORA_PREFETCH(tt + tstep);
        __syncthreads();
#pragma unroll
        for (int q = 0; q < 2; ++q) {
            const int nrow = (wave * 2 + q) * 16 + fr;
            const bf16x8 bw = *(const LAS bf16x8*)(lds + O_WT + (nrow * LDW + fq * 8) * 2), ba = *(const LAS bf16x8*)(lds + O_WT + (nrow * LDW + 32 + fq * 8) * 2);
            const bf16x8 bg0 = *(const LAS bf16x8*)(lds + O_WT + (nrow * LDW + 64 + fq * 8) * 2), bg1 = *(const LAS bf16x8*)(lds + O_WT + (nrow * LDW + 96 + fq * 8) * 2), bg2 = *(const LAS bf16x8*)(lds + O_WT + (nrow * LDW + 128 + fq * 8) * 2);
            const int ch = half * 256 + (wave * 2 + q) * 16 + fr;
#pragma unroll
            for (int mi = 0; mi < 4; ++mi) {
                const int arow = mi * 16 + fr;
                const bf16x8 aw = *(const LAS bf16x8*)(lds + O_ACT + (arow * LDW + fq * 8) * 2), aa = *(const LAS bf16x8*)(lds + O_ACT + (arow * LDW + 32 + fq * 8) * 2);
                const bf16x8 ag0 = *(const LAS bf16x8*)(lds + O_ACT + (arow * LDW + 64 + fq * 8) * 2), ag1 = *(const LAS bf16x8*)(lds + O_ACT + (arow * LDW + 96 + fq * 8) * 2), ag2 = *(const LAS bf16x8*)(lds + O_ACT + (arow * LDW + 128 + fq * 8) * 2);
                const f32x4 z = (f32x4){0.f, 0.f, 0.f, 0.f};
                const f32x4 cw = __builtin_amdgcn_mfma_f32_16x16x32_bf16(aw, bw, z, 0, 0, 0);
                const f32x4 ca = __builtin_amdgcn_mfma_f32_16x16x32_bf16(aa, ba, z, 0, 0, 0);
                f32x4 cg = __builtin_amdgcn_mfma_f32_16x16x32_bf16(ag0, bg0, z, 0, 0, 0);
                cg = __builtin_amdgcn_mfma_f32_16x16x32_bf16(ag1, bg1, cg, 0, 0, 0);
                cg = __builtin_amdgcn_mfma_f32_16x16x32_bf16(ag2, bg2, cg, 0, 0, 0);
#pragma unroll
                for (int rg = 0; rg < 4; ++rg) {
                    const size_t o = (size_t)(tok0 + mi * 16 + fq * 4 + rg) * 512 + ch;
                    const float wlog = -softplusf_(-(w0[q] + cw[rg])) - 0.5f;
                    RWW[o] = __expf(-__expf(wlog));
                    RWA[o] = (bf16_t)(pk_bf16(sigmoidf_(a0[q] + ca[rg]), 0.f) & 0xffffu);
                    RWG[o] = (bf16_t)(pk_bf16(cg[rg], 0.f) & 0xffffu);
                }
            }
        }
    }
}

#undef LORA_PREFETCH
__device__ __forceinline__ void p1_lru_prep(KP P, int l, LAS unsigned char* lds) {
    const int tid = ltid(), lane = tid & 63, wave = tid >> 6, wg = lbid(), nwg = lgdim();
    const bf16_t* U = (const bf16_t*)(P->ws + WS_U);
    float* LA = (float*)(P->ws + WS_LRUA); float* LB = (float*)(P->ws + WS_LRUB);
    constexpr int O_WA = 0, O_WX = 34816, O_XC = 69632, O_XF = 87040;
    const int n = wg & 3;
    __syncthreads();
    {
        const bf16_t* wa = (const bf16_t*)(P->ws + WS_LRUW) + (size_t)((l * 2 + 0) * 4 + n) * 16384;
        const bf16_t* wx = (const bf16_t*)(P->ws + WS_LRUW) + (size_t)((l * 2 + 1) * 4 + n) * 16384;
#pragma unroll
        for (int e4 = 0; e4 < 4; ++e4) {
            const int e = tid + e4 * NTHR, j = e >> 4, i8 = (e & 15) * 8;
            *(LAS u32x4*)(lds + O_WA + (j * 136 + i8) * 2) = *(const u32x4*)(wa + j * 128 + i8);
            *(LAS u32x4*)(lds + O_WX + (j * 136 + i8) * 2) = *(const u32x4*)(wx + j * 128 + i8);
        }
    }
    const int jloc = wave * 16 + (lane & 15), cg = n * 128 + jloc, fq = lane >> 4;
    const float ba = P->in[I_LRUBA][l * 512 + cg], bx = P->in[I_LRUBX][l * 512 + cg], sp8 = 8.0f * softplusf_(-P->in[I_LRULAM][l * 512 + cg]);
    const int tk = tid >> 3, c16 = (tid & 7) * 16;
    const float* cw = P->in[I_LRUCW] + l * 2048 + n * 128 + c16;
    const float* cb = P->in[I_LRUCB] + l * 512 + n * 128 + c16;
    u32x4 pr[4][2];
#define LRU_PREFETCH(tt_) do { const int tok_ = (tt_) * 64 + tk, ts_ = tok_ & (SEQ - 1); _Pragma("unroll") for (int jj = 0; jj < 4; ++jj) { \
        const bf16_t* up_ = U + (size_t)(((ts_ - 3 + jj) >= 0) ? tok_ - 3 + jj : tok_) * LDU + U_LRU_X + n * 128 + c16; pr[jj][0] = *(const u32x4*)up_; pr[jj][1] = *(const u32x4*)(up_ + 8); } } while (0)
    const int tstep = nwg >> 2;
    if ((wg >> 2) < NTOK / 64) LRU_PREFETCH(wg >> 2);
    for (int tt = wg >> 2; tt < NTOK / 64; tt += tstep) {
        const int tok0 = tt * 64, tok = tok0 + tk, tseq = tok & (SEQ - 1);
        float xc[16];
#pragma unroll
        for (int q = 0; q < 4; ++q) { const f32x4 c = *(const f32x4*)(cb + q * 4); xc[q * 4 + 0] = c[0]; xc[q * 4 + 1] = c[1]; xc[q * 4 + 2] = c[2]; xc[q * 4 + 3] = c[3]; }
#pragma unroll
        for (int jj = 0; jj < 4; ++jj) {
            const bool valid = (tseq - 3 + jj) >= 0;
            float x[16]; { float t0[8], t1[8]; unpack8(pr[jj][0], t0); unpack8(pr[jj][1], t1);
#pragma unroll
                for (int j = 0; j < 8; ++j) { x[j] = t0[j]; x[8 + j] = t1[j]; } }
            const float vf = valid ? 1.0f : 0.0f;
#pragma unroll
            for (int q = 0; q < 4; ++q) { const f32x4 w = *(const f32x4*)(cw + jj * 512 + q * 4);
                xc[q * 4 + 0] += vf * w[0] * x[q * 4 + 0]; xc[q * 4 + 1] += vf * w[1] * x[q * 4 + 1]; xc[q * 4 + 2] += vf * w[2] * x[q * 4 + 2]; xc[q * 4 + 3] += vf * w[3] * x[q * 4 + 3]; }
        }
        __syncthreads();
        {
            float a8[8], b8[8];
#pragma unroll
            for (int j = 0; j < 8; ++j) { a8[j] = xc[j]; b8[j] = xc[8 + j]; }
            *(LAS u32x4*)(lds + O_XC + (tk * 136 + c16) * 2) = pack8(a8);
            *(LAS u32x4*)(lds + O_XC + (tk * 136 + c16 + 8) * 2) = pack8(b8);
#pragma unroll
            for (int q = 0; q < 4; ++q) *(LAS f32x4*)(lds + O_XF + (tk * 132 + c16 + q * 4) * 4) = (f32x4){xc[q * 4], xc[q * 4 + 1], xc[q * 4 + 2], xc[q * 4 + 3]};
        }
        __syncthreads();
        if (tt + tstep < NTOK / 64) LRU_PREFETCH(tt + tstep);
        f32x4 accA[4], accX[4];
#pragma unroll
        for (int mi = 0; mi < 4; ++mi) { accA[mi] = (f32x4){0.f, 0.f, 0.f, 0.f}; accX[mi] = (f32x4){0.f, 0.f, 0.f, 0.f}; }
#pragma unroll
        for (int kk = 0; kk < 4; ++kk) {
            const bf16x8 fa = *(const LAS bf16x8*)(lds + O_WA + (jloc * 136 + kk * 32 + fq * 8) * 2);
            const bf16x8 fx = *(const LAS bf16x8*)(lds + O_WX + (jloc * 136 + kk * 32 + fq * 8) * 2);
#pragma unroll
            for (int mi = 0; mi < 4; ++mi) {
                const bf16x8 xa = *(const LAS bf16x8*)(lds + O_XC + ((mi * 16 + (lane & 15)) * 136 + kk * 32 + fq * 8) * 2);
                accA[mi] = __builtin_amdgcn_mfma_f32_16x16x32_bf16(xa, fa, accA[mi], 0, 0, 0);
                accX[mi] = __builtin_amdgcn_mfma_f32_16x16x32_bf16(xa, fx, accX[mi], 0, 0, 0);
            }
        }
#pragma unroll
        for (int mi = 0; mi < 4; ++mi)
#pragma unroll
            for (int rg = 0; rg < 4; ++rg) {
                const int t = mi * 16 + fq * 4 + rg;
                const float xv = *(const LAS float*)(lds + O_XF + (t * 132 + jloc) * 4);
                const float r = sigmoidf_(accA[mi][rg] + ba), ig = sigmoidf_(accX[mi][rg] + bx);
                const float la = -r * sp8;
                const size_t o = (size_t)(tok0 + t) * 512 + cg;
                LA[o] = __expf(la);
                LB[o] = sqrtf(fmaxf(-expm1f(2.0f * la), 0.0f)) * (ig * xv);
            }
    }
}

#undef LRU_PREFETCH
__device__ __forceinline__ bf16x8 rw_op16(LAS unsigned char* lds, int off) { return *(const LAS bf16x8*)(lds + off); }
__device__ __forceinline__ bf16x8 rw_op8x2(LAS unsigned char* lds, int off0, int off1) { const u32x2 lo = *(const LAS u32x2*)(lds + off0), hi = *(const LAS u32x2*)(lds + off1); const u32x4 w = (u32x4){lo.x, lo.y, hi.x, hi.y}; return __builtin_bit_cast(bf16x8, w); }
__device__ __forceinline__ bf16x8 rw_accop(const f32x4 a, const f32x4 b) { u32x4 w; w.x = pk_bf16(a[0], a[1]); w.y = pk_bf16(a[2], a[3]); w.z = pk_bf16(b[0], b[1]); w.w = pk_bf16(b[2], b[3]); return __builtin_bit_cast(bf16x8, w); }
#define RW_MFMA(a, b, c) __builtin_amdgcn_mfma_f32_16x16x32_bf16(a, b, c, 0, 0, 0)
__device__ __forceinline__ void p2_rw(KP P, int l, int item, LAS unsigned char* lds) {
    const int tid = ltid(), lane = tid & 63, wave = tid >> 6, b = item >> 3, h = item & 7;
    const int fr = lane & 15, fq = lane >> 4, st = tid >> 3, sc = (tid & 7) * 8;
    const bf16_t* U = (const bf16_t*)(P->ws + WS_U);
    const float* RWW = (const float*)(P->ws + WS_RWW); const bf16_t* RWA = (const bf16_t*)(P->ws + WS_RWA); const bf16_t* RWG = (const bf16_t*)(P->ws + WS_RWG);
    bf16_t* Y = (bf16_t*)(P->ws + WS_HY);
    LAS float* F = LDSF(0);
    constexpr int CN = 0, WC = 512, TOT = 4608, LD = 4864;
    constexpr int XD = 23552, AT = 25600, RT = AT + 9216, BT = RT + 9216, KT = BT + 9216, BTT = KT + 9216, KTT = BTT + 9216, VT = KTT + 9216, GAB = VT + 9216, GAK = GAB + 9216, GRB = GAK + 9216, GRK = GRB + 9216, OO = GRK + 9216;
    __syncthreads();
    {
        const int kind = tid >> 6, c = tid & 63; float v;
        if (kind < 3) v = P->in[I_RWMU][l * RW_IN + kind * 512 + h * 64 + c];
        else if (kind == 3) v = P->in[I_RWKK][l * 512 + h * 64 + c];
        else if (kind == 4) v = P->in[I_RWKA][l * 512 + h * 64 + c];
        else if (kind == 5) v = P->in[I_RWRK][l * 512 + h * 64 + c];
        else if (kind == 6) v = P->in[I_RWLNW][l * 512 + h * 64 + c];
        else v = P->in[I_RWLNB][l * 512 + h * 64 + c];
        F[CN + kind * 64 + c] = v;
        for (int e = tid; e < 4 * 9216 / 16; e += NTHR) *(LAS u32x4*)(lds + GAB + e * 16) = (u32x4){0u, 0u, 0u, 0u};
    }
    __syncthreads();
    f32x4 ST[4];
#pragma unroll
    for (int j = 0; j < 4; ++j) ST[j] = (f32x4){0.f, 0.f, 0.f, 0.f};
    u32x4 pr_c, pk_c, pv_c, pr_p, pk_p, pv_p, pa, pg; f32x4 pw0, pw1; float pflag;
#define RW_IDS const int tid = ltid(), lane = tid & 63, wave = tid >> 6, fr = lane & 15, fq = lane >> 4, st = tid >> 3, sc = (tid & 7) * 8; (void)lane; (void)wave; (void)fr; (void)fq; (void)st; (void)sc;
#define RW_PREFETCH(ch) do { RW_IDS const int tk_ = b * SEQ + (ch) * 64 + st; const bool first_ = ((ch) == 0 && st == 0); \
        const bf16_t* uc_ = U + (size_t)tk_ * LDU + h * 64 + sc; const bf16_t* up_ = first_ ? uc_ : uc_ - LDU; pflag = first_ ? 0.f : 1.f; \
        pr_c = *(const u32x4*)(uc_ + U_RW_R); pk_c = *(const u32x4*)(uc_ + U_RW_K); pv_c = *(const u32x4*)(uc_ + U_RW_V); \
        pr_p = *(const u32x4*)(up_ + U_RW_R); pk_p = *(const u32x4*)(up_ + U_RW_K); pv_p = *(const u32x4*)(up_ + U_RW_V); \
        const size_t o_ = (size_t)tk_ * 512 + h * 64 + sc; pw0 = *(const f32x4*)(RWW + o_); pw1 = *(const f32x4*)(RWW + o_ + 4); pa = *(const u32x4*)(RWA + o_); pg = *(const u32x4*)(RWG + o_); } while (0)
    RW_PREFETCH(0);
    for (int ch = 0; ch < SEQ / 64; ++ch) {
        u32x4 cg, cvp; float bsum = 0.f;
        {   RW_IDS
        {
        float wt[8];
        {
            wt[0] = pw0[0]; wt[1] = pw0[1]; wt[2] = pw0[2]; wt[3] = pw0[3]; wt[4] = pw1[0]; wt[5] = pw1[1]; wt[6] = pw1[2]; wt[7] = pw1[3];
            const int sl = lane >> 3;
#pragma unroll
            for (int d = 1; d < 8; d <<= 1) {
#pragma unroll
                for (int j = 0; j < 8; ++j) { const float o = __shfl_up(wt[j], 8 * d); if (sl >= d) wt[j] *= o; }
            }
            if (sl == 7) { *(LAS f32x4*)(F + TOT + wave * 64 + sc) = (f32x4){wt[0], wt[1], wt[2], wt[3]}; *(LAS f32x4*)(F + TOT + wave * 64 + sc + 4) = (f32x4){wt[4], wt[5], wt[6], wt[7]}; }
        }
        __syncthreads();
        {
            f32x4 b0 = (f32x4){1.f, 1.f, 1.f, 1.f}, b1 = b0;
            for (int wv = 0; wv < wave; ++wv) { b0 *= *(const LAS f32x4*)(F + TOT + wv * 64 + sc); b1 *= *(const LAS f32x4*)(F + TOT + wv * 64 + sc + 4); }
#pragma unroll
            for (int j = 0; j < 4; ++j) { wt[j] *= b0[j]; wt[4 + j] *= b1[j]; }
            *(LAS f32x4*)(F + WC + st * 64 + sc) = (f32x4){wt[0], wt[1], wt[2], wt[3]}; *(LAS f32x4*)(F + WC + st * 64 + sc + 4) = (f32x4){wt[4], wt[5], wt[6], wt[7]};
        }
        }
        float r[8], v[8], ma[8], bv[8], kp[8];
        cg = pg;
        {
            float k[8], a[8];
            {
                float c[8], p[8], m[8];
                unpack8(pr_c, c); unpack8(pr_p, p);
#pragma unroll
                for (int j = 0; j < 8; ++j) m[j] = F[CN + 0 * 64 + sc + j];
#pragma unroll
                for (int j = 0; j < 8; ++j) r[j] = c[j] + (p[j] * pflag - c[j]) * m[j];
                unpack8(pk_c, c); unpack8(pk_p, p);
#pragma unroll
                for (int j = 0; j < 8; ++j) m[j] = F[CN + 1 * 64 + sc + j];
#pragma unroll
                for (int j = 0; j < 8; ++j) k[j] = c[j] + (p[j] * pflag - c[j]) * m[j];
                unpack8(pv_c, c); unpack8(pv_p, p);
#pragma unroll
                for (int j = 0; j < 8; ++j) m[j] = F[CN + 2 * 64 + sc + j];
#pragma unroll
                for (int j = 0; j < 8; ++j) v[j] = c[j] + (p[j] * pflag - c[j]) * m[j];
                unpack8(pa, a);
            }
            float ss = 0.f, kkv[8];
#pragma unroll
            for (int j = 0; j < 8; ++j) { kkv[j] = k[j] * F[CN + 3 * 64 + sc + j]; ss += kkv[j] * kkv[j]; }
            ss = red8(ss);
            const float inv = 1.0f / fmaxf(sqrtf(ss + 1e-12f), 1e-6f);
#pragma unroll
            for (int j = 0; j < 8; ++j) {
                const float kn = kkv[j] * inv;
                kp[j] = k[j] * (1.0f + (a[j] - 1.0f) * F[CN + 4 * 64 + sc + j]);
                ma[j] = -kn; bv[j] = kn * a[j];
                bsum += r[j] * kp[j] * F[CN + 5 * 64 + sc + j];
            }
            bsum = red8(bsum);
        }
        {
#pragma unroll
            for (int j = 0; j < 8; j += 2) {
                const unsigned pw = pk_bf16(v[j], v[j + 1]);
                *(LAS bf16_t*)(lds + VT + ((sc + j) * 72 + st) * 2) = (bf16_t)(pw & 0xffffu);
                *(LAS bf16_t*)(lds + VT + ((sc + j + 1) * 72 + st) * 2) = (bf16_t)(pw >> 16);
            }
        }
        cvp = pack8(v);
        {
            float al[8], be[8], ka[8], rh[8];
            const f32x4 wa0 = *(const LAS f32x4*)(F + WC + st * 64 + sc), wa1 = *(const LAS f32x4*)(F + WC + st * 64 + sc + 4);
#pragma unroll
            for (int j = 0; j < 8; ++j) {
                const float wtj = (j < 4) ? wa0[j & 3] : wa1[j & 3];
                const float w1 = (j < 4) ? pw0[j & 3] : pw1[j & 3], iw = fast_rcp(wtj), wp = wtj * fast_rcp(w1);
                al[j] = ma[j] * wp; be[j] = bv[j] * iw; ka[j] = kp[j] * iw; rh[j] = r[j] * wtj;
            }
            const u32x4 qa = pack8(al), qb = pack8(be), qk = pack8(ka), qr = pack8(rh);
            *(LAS u32x4*)(lds + AT + (st * 72 + sc) * 2) = qa; *(LAS u32x4*)(lds + RT + (st * 72 + sc) * 2) = qr;
            *(LAS u32x4*)(lds + BT + (st * 72 + sc) * 2) = qb; *(LAS u32x4*)(lds + KT + (st * 72 + sc) * 2) = qk;
#pragma unroll
            for (int j = 0; j < 8; ++j) {
                const unsigned wb = qb[j >> 1], wk = qk[j >> 1];
                *(LAS bf16_t*)(lds + BTT + ((sc + j) * 72 + st) * 2) = (bf16_t)((j & 1) ? (wb >> 16) : (wb & 0xffffu));
                *(LAS bf16_t*)(lds + KTT + ((sc + j) * 72 + st) * 2) = (bf16_t)((j & 1) ? (wk >> 16) : (wk & 0xffffu));
            }
        }
        }
        __syncthreads();
        if (ch + 1 < SEQ / 64) RW_PREFETCH(ch + 1);
        {   RW_IDS
            const int m = wave >> 1;
            const int ta = (m < 2) ? AT : RT, tb = (m & 1) ? KT : BT, tg = GAB + m * 9216;
#pragma unroll
            for (int e = 0; e < 5; ++e) {
                int ti, ji;
                if (wave & 1) { ti = (e < 2) ? 1 : 2; ji = (e < 2) ? e : e - 2; } else { ti = (e < 1) ? 0 : 3; ji = (e < 1) ? 0 : e - 1; }
                f32x4 g = (f32x4){0.f, 0.f, 0.f, 0.f};
#pragma unroll
                for (int kk = 0; kk < 2; ++kk) g = RW_MFMA(rw_op16(lds, ta + ((ti * 16 + fr) * 72 + kk * 32 + fq * 8) * 2), rw_op16(lds, tb + ((ji * 16 + fr) * 72 + kk * 32 + fq * 8) * 2), g);
#pragma unroll
                for (int rg = 0; rg < 4; ++rg) {
                    const int t = ti * 16 + fq * 4 + rg, j = ji * 16 + fr;
                    const bool keep = (m >= 2) ? (j <= t) : (j < t);
                    const float val = keep ? g[rg] : 0.f;
                    *(LAS bf16_t*)(lds + tg + (t * 72 + j) * 2) = (bf16_t)(pk_bf16(val, 0.f) & 0xffffu);
                    if (m == 0 && ti == ji) F[LD + ti * 256 + (fq * 4 + rg) * 16 + fr] = val;
                }
            }
        }
        __syncthreads();
        f32x4 Yc[4]; bf16x8 s0b[2], vtb[2];
        {   RW_IDS
        if (wave == 4) {
            const int c = lane >> 4, col = lane & 15;
            float x[16];
#pragma unroll
            for (int t = 0; t < 16; ++t) {
                float acc = (t == col) ? 1.0f : 0.0f, acc1 = 0.f;
#pragma unroll
                for (int j = 0; j < t; ++j) { if (j & 1) acc1 += F[LD + c * 256 + t * 16 + j] * x[j]; else acc += F[LD + c * 256 + t * 16 + j] * x[j]; }
                acc += acc1;
                x[t] = acc;
                __builtin_amdgcn_sched_barrier(0);
                *(LAS bf16_t*)(lds + XD + ((c * 16 + t) * 16 + col) * 2) = (bf16_t)(pk_bf16(acc, 0.f) & 0xffffu);
            }
        }
        if (wave < 4) {
#pragma unroll
            for (int kk = 0; kk < 2; ++kk) { s0b[kk] = rw_accop(ST[2 * kk], ST[2 * kk + 1]); vtb[kk] = rw_op16(lds, VT + ((wave * 16 + fr) * 72 + kk * 32 + fq * 8) * 2); }
#pragma unroll
            for (int c = 0; c < 4; ++c) {
                const int row = c * 16 + fr;
                f32x4 y = (f32x4){0.f, 0.f, 0.f, 0.f};
#pragma unroll
                for (int kk = 0; kk < 2; ++kk) y = RW_MFMA(rw_op8x2(lds, AT + (row * 72 + kk * 32 + fq * 4) * 2, AT + (row * 72 + kk * 32 + 16 + fq * 4) * 2), s0b[kk], y);
                y = RW_MFMA(rw_op16(lds, GAK + (row * 72 + fq * 8) * 2), vtb[0], y);
                if (c >= 2) y = RW_MFMA(rw_op16(lds, GAK + (row * 72 + 32 + fq * 8) * 2), vtb[1], y);
                Yc[c] = y;
            }
        }
        }
        __syncthreads();
        {   RW_IDS
        if (wave < 4) {
            const f32x4 z4 = (f32x4){0.f, 0.f, 0.f, 0.f};
#define RW_XOP(c) __builtin_bit_cast(bf16x8, (u32x4){(*(const LAS u32x2*)(lds + XD + (((c) * 16 + fr) * 16 + fq * 4) * 2)).x, (*(const LAS u32x2*)(lds + XD + (((c) * 16 + fr) * 16 + fq * 4) * 2)).y, 0u, 0u})
#define RW_LOP(c, kk) rw_op8x2(lds, GAB + (((c) * 16 + fr) * 72 + (kk) * 32 + fq * 4) * 2, GAB + (((c) * 16 + fr) * 72 + (kk) * 32 + 16 + fq * 4) * 2)
            const f32x4 U0 = RW_MFMA(RW_XOP(0), rw_accop(Yc[0], z4), z4);
            const f32x4 Y1 = RW_MFMA(RW_LOP(1, 0), rw_accop(U0, z4), Yc[1]);
            const f32x4 U1 = RW_MFMA(RW_XOP(1), rw_accop(Y1, z4), z4);
            const bf16x8 ub0 = rw_accop(U0, U1);
            const f32x4 Y2 = RW_MFMA(RW_LOP(2, 0), ub0, Yc[2]);
            const f32x4 U2 = RW_MFMA(RW_XOP(2), rw_accop(Y2, z4), z4);
            f32x4 Y3 = RW_MFMA(RW_LOP(3, 0), ub0, Yc[3]);
            Y3 = RW_MFMA(RW_LOP(3, 1), rw_accop(U2, z4), Y3);
            const f32x4 U3 = RW_MFMA(RW_XOP(3), rw_accop(Y3, z4), z4);
            const bf16x8 ub1 = rw_accop(U2, U3);
#undef RW_XOP
#undef RW_LOP
            {
                f32x4 o[4];
#pragma unroll
                for (int c = 0; c < 4; ++c) o[c] = (f32x4){0.f, 0.f, 0.f, 0.f};
#pragma unroll
                for (int kk = 0; kk < 2; ++kk)
#pragma unroll
                    for (int c = 0; c < 4; ++c) o[c] = RW_MFMA(rw_op8x2(lds, RT + ((c * 16 + fr) * 72 + kk * 32 + fq * 4) * 2, RT + ((c * 16 + fr) * 72 + kk * 32 + 16 + fq * 4) * 2), s0b[kk], o[c]);
#pragma unroll
                for (int c = 0; c < 4; ++c) o[c] = RW_MFMA(rw_op8x2(lds, GRB + ((c * 16 + fr) * 72 + fq * 4) * 2, GRB + ((c * 16 + fr) * 72 + 16 + fq * 4) * 2), ub0, o[c]);
#pragma unroll
                for (int c = 0; c < 4; ++c) o[c] = RW_MFMA(rw_op16(lds, GRK + ((c * 16 + fr) * 72 + fq * 8) * 2), vtb[0], o[c]);
#pragma unroll
                for (int c = 2; c < 4; ++c) o[c] = RW_MFMA(rw_op8x2(lds, GRB + ((c * 16 + fr) * 72 + 32 + fq * 4) * 2, GRB + ((c * 16 + fr) * 72 + 48 + fq * 4) * 2), ub1, o[c]);
#pragma unroll
                for (int c = 2; c < 4; ++c) o[c] = RW_MFMA(rw_op16(lds, GRK + ((c * 16 + fr) * 72 + 32 + fq * 8) * 2), vtb[1], o[c]);
#pragma unroll
                for (int c = 0; c < 4; ++c)
#pragma unroll
                    for (int rg = 0; rg < 4; ++rg) *(LAS float*)(lds + OO + ((c * 16 + fq * 4 + rg) * 68 + wave * 16 + fr) * 4) = o[c][rg];
            }
#pragma unroll
            for (int kt = 0; kt < 4; ++kt) ST[kt] = RW_MFMA(rw_op8x2(lds, BTT + ((kt * 16 + fr) * 72 + fq * 4) * 2, BTT + ((kt * 16 + fr) * 72 + 16 + fq * 4) * 2), ub0, ST[kt]);
#pragma unroll
            for (int kt = 0; kt < 4; ++kt) ST[kt] = RW_MFMA(rw_op8x2(lds, BTT + ((kt * 16 + fr) * 72 + 32 + fq * 4) * 2, BTT + ((kt * 16 + fr) * 72 + 48 + fq * 4) * 2), ub1, ST[kt]);
#pragma unroll
            for (int kt = 0; kt < 4; ++kt) ST[kt] = RW_MFMA(rw_op16(lds, KTT + ((kt * 16 + fr) * 72 + fq * 8) * 2), vtb[0], ST[kt]);
#pragma unroll
            for (int kt = 0; kt < 4; ++kt) ST[kt] = RW_MFMA(rw_op16(lds, KTT + ((kt * 16 + fr) * 72 + 32 + fq * 8) * 2), vtb[1], ST[kt]);
#pragma unroll
            for (int kt = 0; kt < 4; ++kt) ST[kt] *= *(const LAS f32x4*)(F + WC + 63 * 64 + kt * 16 + fq * 4);
        }
        }
        __syncthreads();
        {   RW_IDS
            const f32x4 o0 = *(const LAS f32x4*)(lds + OO + (st * 68 + sc) * 4), o1 = *(const LAS f32x4*)(lds + OO + (st * 68 + sc + 4) * 4);
            float o[8] = {o0[0], o0[1], o0[2], o0[3], o1[0], o1[1], o1[2], o1[3]}, v8[8], g8[8], y8[8];
            unpack8(cvp, v8); unpack8(cg, g8);
            float sm = 0.f;
#pragma unroll
            for (int j = 0; j < 8; ++j) sm += o[j];
            const float mean = red8(sm) * (1.0f / 64.0f);
            float q = 0.f;
#pragma unroll
            for (int j = 0; j < 8; ++j) { o[j] -= mean; q += o[j] * o[j]; }
            const float rs = rsqrtf(red8(q) * (1.0f / 64.0f) + 64e-5f);
#pragma unroll
            for (int j = 0; j < 8; ++j) y8[j] = (o[j] * rs * F[CN + 6 * 64 + sc + j] + F[CN + 7 * 64 + sc + j] + bsum * v8[j]) * g8[j];
            *(u32x4*)(Y + (size_t)(b * SEQ + ch * 64 + st) * DM + 512 + h * 64 + sc) = pack8(y8);
        }
    }
#undef RW_PREFETCH
#undef RW_IDS
}
#undef RW_MFMA


__device__ __forceinline__ void p2_hg(KP P, int l, int item, LAS unsigned char* lds) {
    const int tid = ltid(), lane = tid & 63, wave = tid >> 6, b = item >> 2, h = item & 3;
    const int fr = lane & 15, fq = lane >> 4, st = tid >> 3, c16 = tid & 7, sv = c16 * 16;
    const bf16_t* U = (const bf16_t*)(P->ws + WS_U); bf16_t* Y = (bf16_t*)(P->ws + WS_HY);
    LAS float* F = LDSF(0);
    constexpr int LBO = 0, HN = 128, FF = 256, TT = 8448;
    constexpr int QB = 35840, KB = QB + 64 * 136 * 2, KT = KB + 64 * 136 * 2, VT = KT + 128 * 72 * 2, AB = VT + 128 * 72 * 2, OO = AB + 64 * 40 * 2;
    __syncthreads();
    if (tid < 128) { float lb = 0.f; if (l == 1) lb = sigmoidf_(P->in[I_HGLB][512 + h * 128 + tid] - P->in[I_HGLB][h * 128 + tid]); F[LBO + tid] = lb; F[HN + tid] = P->in[I_HGNORM][l * 512 + h * 128 + tid]; }
    __syncthreads();
    f32x4 S[8];
#pragma unroll
    for (int j = 0; j < 8; ++j) S[j] = (f32x4){0.f, 0.f, 0.f, 0.f};
    u32x4 pq0, pq1, pf0, pf1, pv0, pv1;
#define HG_IDS const int tid = ltid(), lane = tid & 63, wave = tid >> 6, fr = lane & 15, fq = lane >> 4, st = tid >> 3, c16 = tid & 7, sv = c16 * 16; (void)lane; (void)wave; (void)fr; (void)fq; (void)st; (void)c16; (void)sv;
#define HG_PREFETCH(ch) do { HG_IDS const bf16_t* ur_ = U + (size_t)(b * SEQ + (ch) * 64 + st) * LDU + h * 128; \
        pq0 = *(const u32x4*)(ur_ + U_HG_Q + c16 * 16); pq1 = *(const u32x4*)(ur_ + U_HG_Q + c16 * 16 + 8); pf0 = *(const u32x4*)(ur_ + U_HG_F + c16 * 16); pf1 = *(const u32x4*)(ur_ + U_HG_F + c16 * 16 + 8); \
        pv0 = *(const u32x4*)(ur_ + U_HG_I + sv); pv1 = *(const u32x4*)(ur_ + U_HG_I + sv + 8); } while (0)
    HG_PREFETCH(0);
    for (int ch = 0; ch < SEQ / 64; ++ch) {
        float fo[16], kx[16], qs[16];
        u32x4 cg0, cg1;
        {   HG_IDS
            { const bf16_t* ug_ = U + (size_t)(b * SEQ + ch * 64 + st) * LDU + U_HG_G + h * 128 + sv; cg0 = *(const u32x4*)ug_; cg1 = *(const u32x4*)(ug_ + 8); }
            float q[16], z[16];
            { float t0[8], t1[8]; unpack8(pq0, t0); unpack8(pq1, t1);
#pragma unroll
              for (int j = 0; j < 8; ++j) { q[j] = t0[j]; q[8 + j] = t1[j]; }
              unpack8(pf0, t0); unpack8(pf1, t1);
#pragma unroll
              for (int j = 0; j < 8; ++j) { z[j] = t0[j]; z[8 + j] = t1[j]; } }
#pragma unroll
            for (int j = 0; j < 16; ++j) {
                const float lb = F[LBO + c16 * 16 + j], e = __expf(-z[j]), sg = fast_rcp(1.0f + e);
                fo[j] = lb + (1.0f - lb) * sg; kx[j] = (1.0f - lb) * (e * sg);
                qs[j] = siluf_(q[j]);
            }
        }
        const u32x4 cv0 = pv0, cv1 = pv1;
        __syncthreads();
        {   HG_IDS
#pragma unroll
            for (int m = 0; m < 4; ++m) *(LAS f32x4*)(F + FF + st * 128 + c16 * 16 + 4 * m) = (f32x4){fo[4 * m], fo[4 * m + 1], fo[4 * m + 2], fo[4 * m + 3]};
#pragma unroll
            for (int j = 0; j < 8; ++j) {
                const unsigned w0 = cv0[j >> 1], w1 = cv1[j >> 1];
                *(LAS bf16_t*)(lds + VT + ((sv + j) * 72 + st) * 2) = (bf16_t)((j & 1) ? (w0 >> 16) : (w0 & 0xffffu));
                *(LAS bf16_t*)(lds + VT + ((sv + 8 + j) * 72 + st) * 2) = (bf16_t)((j & 1) ? (w1 >> 16) : (w1 & 0xffffu));
            }
        }
        __syncthreads();
        {   HG_IDS
            const int kk = tid & 127, w4 = tid >> 7; float c = 1.0f;
#pragma unroll 4
            for (int i = 0; i < 16; ++i) { const int ix = FF + (w4 * 16 + i) * 128 + kk; c *= F[ix]; F[ix] = c; }
            F[TT + w4 * 128 + kk] = c;
        }
        __syncthreads();
        if ((ltid() >> 7) & 1) {   HG_IDS
            const int kk = tid & 127, w4 = tid >> 7; const float m0 = F[TT + (w4 - 1) * 128 + kk];
#pragma unroll 4
            for (int i = 0; i < 16; ++i) F[FF + (w4 * 16 + i) * 128 + kk] *= m0;
        }
        __syncthreads();
        {   HG_IDS
#pragma unroll
            for (int m = 0; m < 4; ++m) {
                const f32x4 c4 = *(const LAS f32x4*)(F + FF + st * 128 + c16 * 16 + 4 * m);
                float qc[4], kc[4];
#pragma unroll
                for (int j = 0; j < 4; ++j) { const float cc = fmaxf(c4[j], 1e-30f); qc[j] = qs[4 * m + j] * cc; kc[j] = kx[4 * m + j] * fast_rcp(cc); }
                u32x2 w; w.x = pk_bf16(qc[0], qc[1]); w.y = pk_bf16(qc[2], qc[3]);
                *(LAS u32x2*)(lds + QB + (st * 136 + c16 * 16 + 4 * m) * 2) = w;
                w.x = pk_bf16(kc[0], kc[1]); w.y = pk_bf16(kc[2], kc[3]);
                *(LAS u32x2*)(lds + KB + (st * 136 + c16 * 16 + 4 * m) * 2) = w;
                *(LAS bf16_t*)(lds + KT + ((c16 * 16 + 4 * m + 0) * 72 + st) * 2) = (bf16_t)(w.x & 0xffffu);
                *(LAS bf16_t*)(lds + KT + ((c16 * 16 + 4 * m + 1) * 72 + st) * 2) = (bf16_t)(w.x >> 16);
                *(LAS bf16_t*)(lds + KT + ((c16 * 16 + 4 * m + 2) * 72 + st) * 2) = (bf16_t)(w.y & 0xffffu);
                *(LAS bf16_t*)(lds + KT + ((c16 * 16 + 4 * m + 3) * 72 + st) * 2) = (bf16_t)(w.y >> 16);
            }
        }
        __syncthreads();
        {   HG_IDS
        if (ch + 1 < SEQ / 64) HG_PREFETCH(ch + 1);
        {
            const int wn = wave >> 2, ti = (wave >> 1) & 1, si = wave & 1;
            f32x4 a0 = (f32x4){0.f, 0.f, 0.f, 0.f};
#pragma unroll
            for (int kk = 0; kk < 4; ++kk) {
                const bf16x8 qa = *(const LAS bf16x8*)(lds + QB + ((wn * 32 + ti * 16 + fr) * 136 + kk * 32 + fq * 8) * 2);
                const bf16x8 k0 = *(const LAS bf16x8*)(lds + KB + ((wn * 32 + si * 16 + fr) * 136 + kk * 32 + fq * 8) * 2);
                a0 = __builtin_amdgcn_mfma_f32_16x16x32_bf16(qa, k0, a0, 0, 0, 0);
            }
#pragma unroll
            for (int rg = 0; rg < 4; ++rg) {
                const int tl = ti * 16 + fq * 4 + rg, sl = si * 16 + fr;
                const unsigned w0 = pk_bf16((sl <= tl) ? a0[rg] : 0.f, 0.f) & 0xffffu;
                *(LAS bf16_t*)(lds + AB + ((wn * 32 + tl) * 40 + sl) * 2) = (bf16_t)w0;
            }
        }
        }
        __syncthreads();
        {   HG_IDS
        *(LAS u32x4*)(lds + KB + (st * 136 + sv) * 2) = cg0; *(LAS u32x4*)(lds + KB + (st * 136 + sv + 8) * 2) = cg1;
        {
            bf16x8 vb[2];
#pragma unroll
            for (int wn = 0; wn < 2; ++wn) vb[wn] = *(const LAS bf16x8*)(lds + VT + ((wave * 16 + fr) * 72 + wn * 32 + fq * 8) * 2);
#pragma unroll
            for (int wn = 0; wn < 2; ++wn) {
                bf16x8 mb[4];
#pragma unroll
                for (int kk = 0; kk < 4; ++kk) {
                    u32x4 w; w.x = pk_bf16(S[2 * kk][0], S[2 * kk][1]); w.y = pk_bf16(S[2 * kk][2], S[2 * kk][3]); w.z = pk_bf16(S[2 * kk + 1][0], S[2 * kk + 1][1]); w.w = pk_bf16(S[2 * kk + 1][2], S[2 * kk + 1][3]);
                    mb[kk] = __builtin_bit_cast(bf16x8, w);
                }
                {
                    f32x4 o[2];
#pragma unroll
                    for (int ti = 0; ti < 2; ++ti) o[ti] = __builtin_amdgcn_mfma_f32_16x16x32_bf16(*(const LAS bf16x8*)(lds + AB + ((wn * 32 + ti * 16 + fr) * 40 + fq * 8) * 2), vb[wn], (f32x4){0.f, 0.f, 0.f, 0.f}, 0, 0, 0);
#pragma unroll
                    for (int kk = 0; kk < 4; ++kk) {
#pragma unroll
                        for (int ti = 0; ti < 2; ++ti) {
                            const int row = wn * 32 + ti * 16 + fr;
                            const u32x2 lo = *(const LAS u32x2*)(lds + QB + (row * 136 + kk * 32 + fq * 4) * 2), hi = *(const LAS u32x2*)(lds + QB + (row * 136 + kk * 32 + 16 + fq * 4) * 2);
                            const u32x4 w = (u32x4){lo.x, lo.y, hi.x, hi.y};
                            o[ti] = __builtin_amdgcn_mfma_f32_16x16x32_bf16(__builtin_bit_cast(bf16x8, w), mb[kk], o[ti], 0, 0, 0);
                        }
#pragma unroll
                        for (int k2 = 0; k2 < 2; ++k2) {
                            const int kt = kk * 2 + k2;
                            const bf16x8 ka = *(const LAS bf16x8*)(lds + KT + ((kt * 16 + fr) * 72 + wn * 32 + fq * 8) * 2);
                            S[kt] = __builtin_amdgcn_mfma_f32_16x16x32_bf16(ka, vb[wn], S[kt], 0, 0, 0);
                        }
                    }
#pragma unroll
                    for (int ti = 0; ti < 2; ++ti)
#pragma unroll
                        for (int rg = 0; rg < 4; ++rg) *(LAS float*)(lds + OO + ((wn * 32 + ti * 16 + fq * 4 + rg) * 132 + wave * 16 + fr) * 4) = o[ti][rg];
#pragma unroll
                    for (int kt = 0; kt < 8; ++kt) S[kt] *= *(const LAS f32x4*)(F + FF + (wn * 32 + 31) * 128 + kt * 16 + fq * 4);
                }
            }
        }
        }
        __syncthreads();
        {   HG_IDS
            float ss = 0.f;
#pragma unroll
            for (int m = 0; m < 4; ++m) { const f32x4 x = *(const LAS f32x4*)(lds + OO + (st * 132 + sv + 4 * m) * 4); ss += x[0] * x[0] + x[1] * x[1] + x[2] * x[2] + x[3] * x[3]; }
            const float rs = rsqrtf(red8(ss) * (1.0f / 128.0f) + 1e-6f);
            bf16_t* yr = Y + (size_t)(b * SEQ + ch * 64 + st) * DM + h * 128 + sv;
#pragma unroll 1
            for (int hf = 0; hf < 2; ++hf) {
                const f32x4 x0 = *(const LAS f32x4*)(lds + OO + (st * 132 + sv + hf * 8) * 4), x1 = *(const LAS f32x4*)(lds + OO + (st * 132 + sv + hf * 8 + 4) * 4);
                const f32x4 n0 = *(const LAS f32x4*)(F + HN + sv + hf * 8), n1 = *(const LAS f32x4*)(F + HN + sv + hf * 8 + 4);
                float g[8], y8[8]; unpack8(*(const LAS u32x4*)(lds + KB + (st * 136 + sv + hf * 8) * 2), g);
#pragma unroll
                for (int j = 0; j < 4; ++j) { y8[j] = x0[j] * rs * n0[j] * siluf_(g[j]); y8[4 + j] = x1[j] * rs * n1[j] * siluf_(g[4 + j]); }
                *(u32x4*)(yr + hf * 8) = pack8(y8);
            }
        }
    }
#undef HG_PREFETCH
#undef HG_IDS
}

__device__ __forceinline__ void p2_ml(KP P, int l, int item, LAS unsigned char* lds) {
    const int tid = ltid(), lane = tid & 63, wave = tid >> 6, b = item >> 2, h = item & 3;
    const int fr = lane & 15, fq = lane >> 4, st = tid >> 3, c8 = tid & 7, sv = c8 * 16;
    const int blk = tid & 31, sg = tid >> 5;
    const bf16_t* U = (const bf16_t*)(P->ws + WS_U); bf16_t* Y = (bf16_t*)(P->ws + WS_HY);
    LAS float* F = LDSF(0);
    constexpr int FD = 0, IW = 64, EN = 128, RS = 256, NK = 512, TNS = 768, CT = 1280, MN = 2944, MS = 3072;
    constexpr int QB = 12800, KB = QB + 64 * 136 * 2, KT = KB + 64 * 136 * 2, VT = KT + 128 * 72 * 2, AB = VT + 128 * 72 * 2, OO = AB + 64 * 72 * 2, XC = OO + 64 * 132 * 4;
    __syncthreads();
    if (tid < 32) {
        const int cgl = h * 128 + blk * 4;
#pragma unroll
        for (int jj = 0; jj < 4; ++jj) *(LAS f32x4*)(F + CT + (jj * 32 + blk) * 4) = *(const f32x4*)(P->in[I_MLCW] + l * 2048 + jj * 512 + cgl);
        *(LAS f32x4*)(F + CT + (4 * 32 + blk) * 4) = *(const f32x4*)(P->in[I_MLCB] + l * 512 + cgl);
#pragma unroll
        for (int j = 0; j < 4; ++j) {
            *(LAS f32x4*)(F + CT + ((5 + j) * 32 + blk) * 4) = *(const f32x4*)(P->in[I_MLWQ] + (size_t)l * 2048 + (h * 32 + blk) * 16 + j * 4) * 0.08838834764831845f;
            *(LAS f32x4*)(F + CT + ((9 + j) * 32 + blk) * 4) = *(const f32x4*)(P->in[I_MLWK] + (size_t)l * 2048 + (h * 32 + blk) * 16 + j * 4);
        }
    }
    const float ib = P->in[I_MLIB][l * 4 + h], fb = P->in[I_MLFB][l * 4 + h];
    f32x4 M[8];
#pragma unroll
    for (int j = 0; j < 8; ++j) M[j] = (f32x4){0.f, 0.f, 0.f, 0.f};
    float mcarry = 0.f;
    u32x2 px[7]; u32x4 pv0, pv1; unsigned pif;
#define ML_IDS const int tid = ltid(), lane = tid & 63, wave = tid >> 6, fr = lane & 15, fq = lane >> 4, st = tid >> 3, c8 = tid & 7, sv = c8 * 16, blk = tid & 31, sg = tid >> 5; (void)lane; (void)wave; (void)fr; (void)fq; (void)st; (void)c8; (void)sv; (void)blk; (void)sg;
#define ML_PREFETCH(ch) do { ML_IDS const int ts0_ = (ch) * 64 + sg * 4 - 3; \
        _Pragma("unroll") for (int r = 0; r < 7; ++r) { const int ts_ = ts0_ + r; \
            px[r] = *(const u32x2*)(U + (size_t)(b * SEQ + (ts_ < 0 ? 0 : ts_)) * LDU + U_ML_X + h * 128 + blk * 4); } \
        { const bf16_t* uv_ = U + (size_t)(b * SEQ + (ch) * 64 + st) * LDU + U_ML_V + h * 128 + sv; pv0 = *(const u32x4*)uv_; pv1 = *(const u32x4*)(uv_ + 8); } \
        { const bf16_t* ug_ = U + (size_t)(b * SEQ + (ch) * 64 + lane) * LDU; pif = (unsigned)ug_[U_ML_I + h] | ((unsigned)ug_[U_ML_F + h] << 16); } } while (0)
    if (tid < 128) { F[NK + tid] = 0.f; F[MN + tid] = P->in[I_MLNORM][l * 512 + h * 128 + tid]; F[MS + tid] = P->in[I_MLSKIP][l * 512 + h * 128 + tid]; }
    ML_PREFETCH(0);
    __syncthreads();
    for (int ch = 0; ch < SEQ / 64; ++ch) {
        const u32x4 cv0 = pv0, cv1 = pv1;
        u32x4 co0, co1;
        {   ML_IDS
        { const bf16_t* uo_ = U + (size_t)(b * SEQ + ch * 64 + st) * LDU + U_ML_O + h * 128 + sv; co0 = *(const u32x4*)uo_; co1 = *(const u32x4*)(uo_ + 8); }
        }
        __syncthreads();
        float q[4][4], k[4][4];
        {   ML_IDS
        {
            float xc[4][4];
            {
                f32x4 cw[4];
#pragma unroll
                for (int j = 0; j < 4; ++j) cw[j] = *(const LAS f32x4*)(F + CT + (j * 32 + blk) * 4);
                const f32x4 cb4 = *(const LAS f32x4*)(F + CT + (4 * 32 + blk) * 4);
                float x[7][4];
#pragma unroll
                for (int r = 0; r < 7; ++r) { const float vf = (ch * 64 + sg * 4 - 3 + r) < 0 ? 0.f : 1.f; x[r][0] = vf * bflo(px[r].x); x[r][1] = vf * bfhi(px[r].x); x[r][2] = vf * bflo(px[r].y); x[r][3] = vf * bfhi(px[r].y); }
#pragma unroll
                for (int s = 0; s < 4; ++s)
#pragma unroll
                    for (int j = 0; j < 4; ++j) xc[s][j] = siluf_(cb4[j] + cw[0][j] * x[s][j] + cw[1][j] * x[s + 1][j] + cw[2][j] * x[s + 2][j] + cw[3][j] * x[s + 3][j]);
            }
#pragma unroll
            for (int s = 0; s < 4; ++s) { u32x2 w; w.x = pk_bf16(xc[s][0], xc[s][1]); w.y = pk_bf16(xc[s][2], xc[s][3]); *(LAS u32x2*)(lds + XC + ((sg * 4 + s) * 136 + blk * 4) * 2) = w; }
            __builtin_amdgcn_sched_barrier(0);
            {
                f32x4 wq[4];
#pragma unroll
                for (int j = 0; j < 4; ++j) wq[j] = *(const LAS f32x4*)(F + CT + ((5 + j) * 32 + blk) * 4);
#pragma unroll
                for (int s = 0; s < 4; ++s)
#pragma unroll
                    for (int i = 0; i < 4; ++i) q[s][i] = xc[s][0] * wq[0][i] + xc[s][1] * wq[1][i] + xc[s][2] * wq[2][i] + xc[s][3] * wq[3][i];
            }
            __builtin_amdgcn_sched_barrier(0);
            {
                f32x4 wk[4];
#pragma unroll
                for (int j = 0; j < 4; ++j) wk[j] = *(const LAS f32x4*)(F + CT + ((9 + j) * 32 + blk) * 4);
#pragma unroll
                for (int s = 0; s < 4; ++s)
#pragma unroll
                    for (int i = 0; i < 4; ++i) k[s][i] = xc[s][0] * wk[0][i] + xc[s][1] * wk[1][i] + xc[s][2] * wk[2][i] + xc[s][3] * wk[3][i];
            }
        }
        if (wave == 0) {
            const float ip = bflo(pif) + ib, xf = bfhi(pif) + fb;
            const float lf = fminf(xf, 0.f) - log1pf(__expf(-fabsf(xf)));
            const float bs = wave_scan_sum(lf);
            const float cm = wave_scan_max(ip - bs);
            const float g = fmaxf(mcarry, cm), mt = bs + g;
            const int lq = lane + lsgpr(0);
            F[FD + lq] = __expf(mcarry - g);
            F[IW + lq] = __expf(ip - bs - mcarry);
            F[EN + lq] = __expf(-mt);
            mcarry = __int_as_float(__builtin_amdgcn_readlane(__float_as_int(mt), 63));
        }
        }
        __syncthreads();
        {   ML_IDS
#pragma unroll
            for (int s = 0; s < 4; ++s) {
                const int t = sg * 4 + s; const float fd = F[FD + t], iw = F[IW + t];
#pragma unroll
                for (int i = 0; i < 4; ++i) { q[s][i] *= fd; k[s][i] *= iw; }
                u32x2 w; w.x = pk_bf16(q[s][0], q[s][1]); w.y = pk_bf16(q[s][2], q[s][3]);
                *(LAS u32x2*)(lds + QB + (t * 136 + blk * 4) * 2) = w;
                w.x = pk_bf16(k[s][0], k[s][1]); w.y = pk_bf16(k[s][2], k[s][3]);
                *(LAS u32x2*)(lds + KB + (t * 136 + blk * 4) * 2) = w;
            }
#pragma unroll
            for (int i = 0; i < 4; ++i) {
                u32x2 w; w.x = pk_bf16(k[0][i], k[1][i]); w.y = pk_bf16(k[2][i], k[3][i]);
                *(LAS u32x2*)(lds + KT + ((blk * 4 + i) * 72 + sg * 4) * 2) = w;
            }
#pragma unroll
            for (int j = 0; j < 8; ++j) {
                const unsigned w0 = cv0[j >> 1], w1 = cv1[j >> 1];
                *(LAS bf16_t*)(lds + VT + ((sv + j) * 72 + st) * 2) = (bf16_t)((j & 1) ? (w0 >> 16) : (w0 & 0xffffu));
                *(LAS bf16_t*)(lds + VT + ((sv + 8 + j) * 72 + st) * 2) = (bf16_t)((j & 1) ? (w1 >> 16) : (w1 & 0xffffu));
            }
        }
        __syncthreads();
        {   ML_IDS
        if (ch + 1 < SEQ / 64) ML_PREFETCH(ch + 1);
        {
            const int ti = wave >> 1, si0 = 2 * (wave & 1);
            f32x4 a0 = (f32x4){0.f, 0.f, 0.f, 0.f}, a1 = a0;
#pragma unroll
            for (int kk = 0; kk < 4; ++kk) {
                const bf16x8 qa = *(const LAS bf16x8*)(lds + QB + ((ti * 16 + fr) * 136 + kk * 32 + fq * 8) * 2);
                const bf16x8 k0 = *(const LAS bf16x8*)(lds + KB + (((si0) * 16 + fr) * 136 + kk * 32 + fq * 8) * 2);
                const bf16x8 k1 = *(const LAS bf16x8*)(lds + KB + (((si0 + 1) * 16 + fr) * 136 + kk * 32 + fq * 8) * 2);
                a0 = __builtin_amdgcn_mfma_f32_16x16x32_bf16(qa, k0, a0, 0, 0, 0);
                a1 = __builtin_amdgcn_mfma_f32_16x16x32_bf16(qa, k1, a1, 0, 0, 0);
            }
#pragma unroll
            for (int rg = 0; rg < 4; ++rg) {
                const int ta = ti * 16 + fq * 4 + rg, s0 = si0 * 16 + fr, s1 = s0 + 16;
                const unsigned w0 = pk_bf16((s0 <= ta) ? a0[rg] : 0.f, 0.f) & 0xffffu, w1 = pk_bf16((s1 <= ta) ? a1[rg] : 0.f, 0.f) & 0xffffu;
                *(LAS bf16_t*)(lds + AB + (ta * 72 + s0) * 2) = (bf16_t)w0;
                *(LAS bf16_t*)(lds + AB + (ta * 72 + s1) * 2) = (bf16_t)w1;
                const float r0 = red16(bflo(w0)), r1 = red16(bflo(w1));
                if (fr == 0) { F[RS + si0 * 64 + ta] = r0; F[RS + (si0 + 1) * 64 + ta] = r1; }
            }
            const int kk = tid & 127, q4 = tid >> 7;
            const u32x4 t0 = *(const LAS u32x4*)(lds + KT + (kk * 72 + q4 * 16) * 2), t1 = *(const LAS u32x4*)(lds + KT + (kk * 72 + q4 * 16 + 8) * 2);
            float f0[8], f1[8]; unpack8(t0, f0); unpack8(t1, f1);
            float s = 0.f;
#pragma unroll
            for (int j = 0; j < 8; ++j) s += f0[j] + f1[j];
            F[TNS + q4 * 128 + kk] = s;
        }
        }
        __syncthreads();
        {   ML_IDS
        *(LAS u32x4*)(lds + KB + (st * 136 + sv) * 2) = co0; *(LAS u32x4*)(lds + KB + (st * 136 + sv + 8) * 2) = co1;
        {
            const float ce = F[FD + 63];
            bf16x8 mb[4], vb[2];
#pragma unroll
            for (int kk = 0; kk < 4; ++kk) {
                u32x4 w; w.x = pk_bf16(M[2 * kk][0], M[2 * kk][1]); w.y = pk_bf16(M[2 * kk][2], M[2 * kk][3]); w.z = pk_bf16(M[2 * kk + 1][0], M[2 * kk + 1][1]); w.w = pk_bf16(M[2 * kk + 1][2], M[2 * kk + 1][3]);
                mb[kk] = __builtin_bit_cast(bf16x8, w);
            }
#pragma unroll
            for (int kk = 0; kk < 2; ++kk) vb[kk] = *(const LAS bf16x8*)(lds + VT + ((wave * 16 + fr) * 72 + kk * 32 + fq * 8) * 2);
            {
                f32x4 o[4];
#pragma unroll
                for (int ti = 0; ti < 4; ++ti) o[ti] = (f32x4){0.f, 0.f, 0.f, 0.f};
#pragma unroll
                for (int kk = 0; kk < 2; ++kk)
#pragma unroll
                    for (int ti = 0; ti < 4; ++ti) {
                        const bf16x8 sa = *(const LAS bf16x8*)(lds + AB + ((ti * 16 + fr) * 72 + kk * 32 + fq * 8) * 2);
                        o[ti] = __builtin_amdgcn_mfma_f32_16x16x32_bf16(sa, vb[kk], o[ti], 0, 0, 0);
                    }
#pragma unroll
                for (int kk = 0; kk < 4; ++kk)
#pragma unroll
                    for (int ti = 0; ti < 4; ++ti) {
                        const u32x2 lo = *(const LAS u32x2*)(lds + QB + ((ti * 16 + fr) * 136 + kk * 32 + fq * 4) * 2), hi = *(const LAS u32x2*)(lds + QB + ((ti * 16 + fr) * 136 + kk * 32 + 16 + fq * 4) * 2);
                        const u32x4 w = (u32x4){lo.x, lo.y, hi.x, hi.y};
                        o[ti] = __builtin_amdgcn_mfma_f32_16x16x32_bf16(__builtin_bit_cast(bf16x8, w), mb[kk], o[ti], 0, 0, 0);
                    }
#pragma unroll
                for (int ti = 0; ti < 4; ++ti)
#pragma unroll
                    for (int rg = 0; rg < 4; ++rg) *(LAS float*)(lds + OO + ((ti * 16 + fq * 4 + rg) * 132 + wave * 16 + fr) * 4) = o[ti][rg];
            }
#pragma unroll
            for (int kk = 0; kk < 2; ++kk)
#pragma unroll
                for (int kt = 0; kt < 8; ++kt) {
                    const bf16x8 ka = *(const LAS bf16x8*)(lds + KT + ((kt * 16 + fr) * 72 + kk * 32 + fq * 8) * 2);
                    M[kt] = __builtin_amdgcn_mfma_f32_16x16x32_bf16(ka, vb[kk], M[kt], 0, 0, 0);
                }
#pragma unroll
            for (int kt = 0; kt < 8; ++kt) M[kt] *= ce;
            if (tid < 128) F[NK + ((ch + 1) & 1) * 128 + tid] = (F[NK + (ch & 1) * 128 + tid] + (F[TNS + tid] + F[TNS + 128 + tid]) + (F[TNS + 256 + tid] + F[TNS + 384 + tid])) * ce;
        }
        }
        __syncthreads();
        {   ML_IDS
            const u32x4 q0 = *(const LAS u32x4*)(lds + QB + (st * 136 + c8 * 16) * 2), q1 = *(const LAS u32x4*)(lds + QB + (st * 136 + c8 * 16 + 8) * 2);
            float f0[8], f1[8]; unpack8(q0, f0); unpack8(q1, f1);
            float d = 0.f;
#pragma unroll
            for (int m = 0; m < 2; ++m) {
                const f32x4 n0 = *(const LAS f32x4*)(F + NK + (ch & 1) * 128 + c8 * 16 + 4 * m), n1 = *(const LAS f32x4*)(F + NK + (ch & 1) * 128 + c8 * 16 + 8 + 4 * m);
#pragma unroll
                for (int j = 0; j < 4; ++j) d += f0[4 * m + j] * n0[j] + f1[4 * m + j] * n1[j];
            }
            d = red8(d);
            d += (F[RS + st] + F[RS + 64 + st]) + (F[RS + 128 + st] + F[RS + 192 + st]);
            const float dinv = 1.0f / fmaxf(fabsf(d), F[EN + st]);
            float o[16], og[16], xs[16];
#pragma unroll
            for (int m = 0; m < 4; ++m) { const f32x4 x = *(const LAS f32x4*)(lds + OO + (st * 132 + sv + 4 * m) * 4); o[4 * m] = x[0] * dinv; o[4 * m + 1] = x[1] * dinv; o[4 * m + 2] = x[2] * dinv; o[4 * m + 3] = x[3] * dinv; }
            { float t0[8], t1[8]; unpack8(*(const LAS u32x4*)(lds + KB + (st * 136 + sv) * 2), t0); unpack8(*(const LAS u32x4*)(lds + KB + (st * 136 + sv + 8) * 2), t1);
#pragma unroll
              for (int j = 0; j < 8; ++j) { og[j] = t0[j]; og[8 + j] = t1[j]; }
              unpack8(*(const LAS u32x4*)(lds + XC + (st * 136 + sv) * 2), t0); unpack8(*(const LAS u32x4*)(lds + XC + (st * 136 + sv + 8) * 2), t1);
#pragma unroll
              for (int j = 0; j < 8; ++j) { xs[j] = t0[j]; xs[8 + j] = t1[j]; } }
            float ss = 0.f;
#pragma unroll
            for (int j = 0; j < 16; ++j) { o[j] *= sigmoidf_(og[j]); ss += o[j] * o[j]; }
            const float rs = rsqrtf(red8(ss) * (1.0f / 128.0f) + 1e-6f);
#pragma unroll
            for (int j = 0; j < 16; ++j) o[j] = o[j] * rs * F[MN + sv + j] + F[MS + sv + j] * xs[j];
            u32x4 w0, w1;
            w0.x = pk_bf16(o[0], o[1]); w0.y = pk_bf16(o[2], o[3]); w0.z = pk_bf16(o[4], o[5]); w0.w = pk_bf16(o[6], o[7]);
            w1.x = pk_bf16(o[8], o[9]); w1.y = pk_bf16(o[10], o[11]); w1.z = pk_bf16(o[12], o[13]); w1.w = pk_bf16(o[14], o[15]);
            bf16_t* yr = Y + (size_t)(b * SEQ + ch * 64 + st) * DM + 1024 + h * 128 + sv;
            *(u32x4*)yr = w0; *(u32x4*)(yr + 8) = w1;
        }
    }
#undef ML_PREFETCH
#undef ML_IDS
}

__device__ __forceinline__ void p2_lru(KP P, int l, int item, LAS unsigned char* lds) {
    const int tid = ltid(), lane = tid & 63, wave = tid >> 6, b = item >> 3, cgp = item & 7;
    const float* LA = (const float*)(P->ws + WS_LRUA); const float* LB = (const float*)(P->ws + WS_LRUB); bf16_t* Y = (bf16_t*)(P->ws + WS_HY);
    LAS float* F = LDSF(0);
    const size_t base = (size_t)(b * SEQ + wave * 512) * 512 + cgp * 64 + lane;
    float hh = 0.f, ap = 1.f;
#pragma unroll 8
    for (int t = 0; t < 512; ++t) { const float a = LA[base + (size_t)t * 512], x = LB[base + (size_t)t * 512]; hh = a * hh + x; ap *= a; }
    __syncthreads();
    F[wave * 64 + lane] = ap; F[512 + wave * 64 + lane] = hh;
    __syncthreads();
    float c = 0.f;
    for (int j = 0; j < wave; ++j) c = F[j * 64 + lane] * c + F[512 + j * 64 + lane];
    hh = c;
    bf16_t* yp = Y + (size_t)(b * SEQ + wave * 512) * DM + 1536 + cgp * 64 + lane;
#pragma unroll 8
    for (int t = 0; t < 512; ++t) { const float a = LA[base + (size_t)t * 512], x = LB[base + (size_t)t * 512]; hh = a * hh + x; yp[(size_t)t * DM] = (bf16_t)(pk_bf16(hh, 0.f) & 0xffffu); }

    {
        unsigned* bar0 = (unsigned*)(P->ws + WS_BAR + (size_t)P->li * WS_BAR_STRIDE);
        unsigned* fl = (unsigned*)(P->ws + WS_BAR + (size_t)30 * WS_BAR_STRIDE) + (l * 8 + b) * 64 + 32;
        asm volatile("s_waitcnt vmcnt(0)" ::: "memory");
        __syncthreads();
        if (threadIdx.x == 0) {
            __builtin_amdgcn_fence(__ATOMIC_RELEASE, "agent");
            asm volatile("s_waitcnt vmcnt(0)" ::: "memory");
            (void)xb_add(fl, 1u);
            XB_SPIN(xb_ld(fl) < 8u, bar0);
            __builtin_amdgcn_fence(__ATOMIC_ACQUIRE, "agent");
            asm volatile("s_waitcnt vmcnt(0)" ::: "memory");
        }
        __syncthreads();
        const bf16_t* U = (const bf16_t*)(P->ws + WS_U);
        const int c0 = lane * 8;
        float lrn[8];
#pragma unroll
        for (int j = 0; j < 8; ++j) lrn[j] = P->in[I_LRUNORM][l * 512 + c0 + j];
#pragma unroll 2
        for (int i = 0; i < 64; ++i) {
            const int tok = b * SEQ + cgp * 512 + wave * 64 + i;
            bf16_t* yr = Y + (size_t)tok * DM; const bf16_t* ur = U + (size_t)tok * LDU;
            float hv[8], gb[8], y8[8]; unpack8(*(const u32x4*)(yr + 1536 + c0), hv); unpack8(*(const u32x4*)(ur + U_LRU_G + c0), gb);
            float ss = 0.f;
#pragma unroll
            for (int j = 0; j < 8; ++j) { hv[j] *= gelu_tanhf_(gb[j]); ss += hv[j] * hv[j]; }
            const float rs = rsqrtf(red64(ss) * (1.0f / 512.0f) + 1e-6f);
#pragma unroll
            for (int j = 0; j < 8; ++j) y8[j] = hv[j] * rs * lrn[j];
            *(u32x4*)(yr + 1536 + c0) = pack8(y8);
        }
    }
}

__device__ __forceinline__ void phase_p3(KP P, int l) { (void)P; (void)l; }

#ifndef MK_ONE_LAUNCH
#define MK_ONE_LAUNCH 1
#endif
#ifndef MK_DEBUG_BAR
#define MK_DEBUG_BAR 0
#endif
#ifndef MK_FUSE_MASK
#define MK_FUSE_MASK 0x3FFFFFFull
#endif
#ifndef MK_SEAM_DELAY
#define MK_SEAM_DELAY 0
#endif
#ifndef MK_KIND_MASK
#define MK_KIND_MASK 0x40
#endif
#ifndef MK_P1_SPLIT
#define MK_P1_SPLIT 0
#endif
#ifndef MK_REPEAT_PHASE
#define MK_REPEAT_PHASE (-1)
#endif
#ifndef MK_REPEAT_ITEM
#define MK_REPEAT_ITEM (-1)
#endif
#ifndef MK_REPEAT_KIND
#define MK_REPEAT_KIND (-1)
#endif
#ifndef MK_SIMPLE_BAR
#define MK_SIMPLE_BAR 0
#endif
__device__ __forceinline__ void simple_barrier(unsigned* bar, unsigned& epoch) {
    asm volatile("s_waitcnt vmcnt(0)" ::: "memory");
    __syncthreads();
    if (threadIdx.x == 0) {
        __builtin_amdgcn_fence(__ATOMIC_RELEASE, "agent");
        asm volatile("s_waitcnt vmcnt(0)" ::: "memory");
        (void)xb_add(&bar[XB_TOP], 1u);
        const unsigned target = (epoch + 1u) * gridDim.x;
        XB_SPIN(xb_ld(&bar[XB_TOP]) < target, bar);
        __builtin_amdgcn_fence(__ATOMIC_ACQUIRE, "agent");
        asm volatile("s_waitcnt vmcnt(0)" ::: "memory");
    }
    ++epoch;
    __syncthreads();
}
enum { K_CONVERT = 0, K_MODFINAL, K_NORM, K_UP, K_DOWN, K_WIN, K_P1, K_P2, K_P3, K_WOUT, K_FINAL, K_DOWNF };
template <int KIND> __device__ __forceinline__ void run_phase(int l_, int sub_, LAS unsigned char* lds) {
    const int l = lsgpr(l_), sub = lsgpr(sub_);
    const KP P = kp_fresh();
    const float* modf = (const float*)(P->ws + WS_MODF);
    bf16_t* HY = (bf16_t*)(P->ws + WS_HY); bf16_t* UU = (bf16_t*)(P->ws + WS_U);
    const bf16_t* Wl = (const bf16_t*)(P->ws + WS_W) + (size_t)l * LW_ELEMS;
    bf16_t* XB = (bf16_t*)P->out; bf16_t* X2 = (bf16_t*)(P->ws + WS_LRUA);
    const int xf32 = (l == 0 && sub == 0) ? 1 : 0;
    const void* xcur = xf32 ? (const void*)P->in[I_X] : ((l == 1 && sub == 2) ? (const void*)X2 : (const void*)XB);
    const int f = sub >> 1;
    if constexpr (KIND == K_CONVERT) phase_convert(P, lds);
    if constexpr (KIND == K_MODFINAL) phase_modfinal(P);
    if constexpr (KIND == K_NORM) phase_norm(P, l, sub, xcur, xf32, lds);
    if constexpr (KIND == K_UP) {
        pg8::Gemm g{HY, Wl + (f ? LW_W13B : LW_W13A), NTOK, 2 * DFF, DM}; pg8::StaticOrder S; S.init(NTOK, 2 * DFF, lgdim(), lbid());
        EpiSwiGLU E{UU};
        pg8::gemm_phase<EpiSwiGLU, pg8::StaticOrder, true, true>(lds, g, S, E);
    }
    if constexpr (KIND == K_DOWN) {
        pg8::Gemm g{UU, Wl + (f ? LW_W2B : LW_W2A), NTOK, DM, DFF}; pg8::StaticOrder S; S.init(NTOK, DM, lgdim(), lbid(), 4);
        EpiResid E{xcur, XB, modf + (size_t)l * 8 * NMOD + sub * 6144 + 4096, 0.5f, xf32};
        pg8::gemm_phase<EpiResid, pg8::StaticOrder, true, true>(lds, g, S, E);
    }
    if constexpr (KIND == K_DOWNF) {
        pg8::Gemm g{UU, Wl + (f ? LW_W2B : LW_W2A), NTOK, DM, DFF}; pg8::StaticOrder S; S.init(NTOK, DM, lgdim(), lbid(), 4);
        EpiFinal E{X2, P->out, modf + (size_t)l * 8 * NMOD + sub * 6144 + 4096, 0.5f, P->in[I_FNORM], (float*)(P->ws + WS_RWW), (unsigned*)(P->ws + WS_BAR + (size_t)29 * WS_BAR_STRIDE) + 256,
                   (unsigned*)(P->ws + WS_BAR + (size_t)P->li * WS_BAR_STRIDE), (LAS float*)(lds + pg8::STAGE_BYTES)};
        pg8::gemm_phase<EpiFinal, pg8::StaticOrder, true, true>(lds, g, S, E);
    }
    if constexpr (KIND == K_WIN) {
        pg8::Gemm g{HY, Wl + LW_WIN, NTOK, LDU, DM}; pg8::StaticOrder S; S.init(NTOK, LDU, lgdim(), lbid());
        EpiU E{UU};
        pg8::gemm_phase<EpiU, pg8::StaticOrder, true, true>(lds, g, S, E);
    }
    if constexpr (KIND == K_P1) { const int part = P->pad; if (part != 2) p1_rw_lora(P, l, lds); if (part != 1) p1_lru_prep(P, l, lds); }
    if constexpr (KIND == K_P2) {
        for (int it = lbid(); it < 256; it += lgdim()) {
            if (it < 64) { _Pragma("unroll 1") for (int rep = 0; rep < ((MK_REPEAT_ITEM == 0) ? 2 : 1); ++rep) p2_rw(P, l, it, lds); }
            else if (it < 96) { p2_hg(P, l, it - 64, lds); if (MK_REPEAT_ITEM == 1) p2_hg(P, l, it - 64, lds); }
            else if (it < 128) { p2_ml(P, l, it - 96, lds); if (MK_REPEAT_ITEM == 2) p2_ml(P, l, it - 96, lds); }
            else if (it < 192) { p2_lru(P, l, it - 128, lds); }
        }
        if (l == 0) convert_dynamic(P, lds);
    }
    if constexpr (KIND == K_P3) phase_p3(P, l);
    if constexpr (KIND == K_WOUT) {
        pg8::Gemm g{HY, Wl + LW_WOUT, NTOK, DM, DM}; pg8::StaticOrder S; S.init(NTOK, DM, lgdim(), lbid(), 4);
        EpiResid E{XB, (l == 1) ? X2 : XB, modf + (size_t)l * 8 * NMOD + 1 * 6144 + 4096, 1.0f, 0};
        pg8::gemm_phase<EpiResid, pg8::StaticOrder, true, true>(lds, g, S, E);
    }
    if constexpr (KIND == K_FINAL) { }
}

template <int KIND> __global__ void __launch_bounds__(NTHR, 2) k_phase(Params P_unused, int l, int sub) {
    extern __shared__ __attribute__((aligned(16))) unsigned char lds_raw[];
    run_phase<KIND>(l, sub, (LAS unsigned char*)lds_raw);
}
constexpr int N_PHASES = 27;
__global__ void __launch_bounds__(NTHR, 2) hymba_fwd(Params P_unused) {
    extern __shared__ __attribute__((aligned(16))) unsigned char lds_raw[];
    LAS unsigned char* lds = (LAS unsigned char*)lds_raw;
    const KP P = kp_fresh();
    const int lo = P->ph_lo, hi = P->ph_hi;
    if (threadIdx.x == 0) *(LAS u32x4*)(lds + LDS_BARW) = (u32x4){0u, 0u, 0u, 0u};
    __syncthreads();
    unsigned* barw = (unsigned*)(P->ws + WS_BAR + (size_t)P->li * WS_BAR_STRIDE);
    XcdBarrier bar = xcd_barrier_post(barw, (volatile LAS unsigned*)(lds + LDS_BARW));
#define SEAM(k) do { if ((k) + 1 < hi) xcd_barrier(bar); } while (0)
#define IN(k) (lo <= (k) && (k) < hi)
#define PH(k, KIND, l, sub) do { if (IN(k)) { run_phase<KIND>(l, sub, lds); if ((MK_REPEAT_KIND) == (KIND) || (MK_REPEAT_PHASE) == (k)) { xcd_barrier(bar); run_phase<KIND>(l, sub, lds); } SEAM(k); } } while (0)
    PH(0, K_CONVERT, 0, 0);
    PH(1, K_MODFINAL, 0, 0);
#define LAYER(l, b, KDOWN2) \
    PH((b) + 0, K_NORM, l, 0); PH((b) + 1, K_UP, l, 0); PH((b) + 2, K_DOWN, l, 0); \
    PH((b) + 3, K_NORM, l, 1); PH((b) + 4, K_WIN, l, 1); PH((b) + 5, K_P1, l, 1); PH((b) + 6, K_P2, l, 1); PH((b) + 8, K_WOUT, l, 1); \
    PH((b) + 9, K_NORM, l, 2); PH((b) + 10, K_UP, l, 2); PH((b) + 11, KDOWN2, l, 2);
    LAYER(0, 2, K_DOWN)
    LAYER(1, 14, K_DOWNF)
#undef LAYER
    {
        unsigned bad = 0u;
        if (IN(25)) { for (int li = 0; li < 32; ++li) bad |= __hip_atomic_load((unsigned*)(P->ws + WS_BAR + (size_t)li * WS_BAR_STRIDE) + XB_TMO, __ATOMIC_RELAXED, __HIP_MEMORY_SCOPE_AGENT); }
        if (bad) { const float qn = __builtin_nanf(""); for (size_t i = (size_t)blockIdx.x * NTHR + threadIdx.x; i < (size_t)NTOK * DM; i += (size_t)gridDim.x * NTHR) P->out[i] = qn; }
    }
#undef PH
#undef IN
#undef SEAM
}

#if 1
template <int KIND> static void launch_phase(const Params& p, int l, int sub, int grid, hipStream_t stream) {
    static bool attr_set = false;
    if (!attr_set) { (void)hipFuncSetAttribute((const void*)k_phase<KIND>, hipFuncAttributeMaxDynamicSharedMemorySize, LDS_BYTES); attr_set = true; }
    hipLaunchKernelGGL(k_phase<KIND>, dim3(grid), dim3(NTHR), LDS_BYTES, stream, p, l, sub);
}
#endif
extern "C" void kernel_launch(void* const* d_in, const int* in_sizes, int n_in, void* d_out, int out_size, void* d_ws, size_t ws_size, hipStream_t stream) {
    static int grid = 0;
    if (grid == 0) {
        if (n_in != N_IN || out_size != NTOK * DM || ws_size < WS_END) { fprintf(stderr, "kernel_launch: unexpected shapes (n_in %d, out %d, ws %zu < %zu)\n", n_in, out_size, ws_size, (size_t)WS_END); grid = -1; return; }
        int dev = 0, cus = 0;
        if (hipGetDevice(&dev) != hipSuccess || hipDeviceGetAttribute(&cus, hipDeviceAttributeMultiprocessorCount, dev) != hipSuccess) { grid = -1; return; }
#if MK_ONE_LAUNCH
        int per_cu = 0;
        if (hipFuncSetAttribute((const void*)hymba_fwd, hipFuncAttributeMaxDynamicSharedMemorySize, LDS_BYTES) != hipSuccess) { fprintf(stderr, "kernel_launch: hipFuncSetAttribute failed\n"); grid = -1; return; }
        if (hipOccupancyMaxActiveBlocksPerMultiprocessor(&per_cu, (const void*)hymba_fwd, NTHR, LDS_BYTES) != hipSuccess || per_cu < 1) fprintf(stderr, "kernel_launch: occupancy query says %d\n", per_cu);
        (void)hipGetLastError();
#endif
        grid = cus;
        if (grid != 256) fprintf(stderr, "kernel_launch: %d CUs (built for 256)\n", grid);
    }
    if (grid < 0) return;
    Params p{};
    for (int i = 0; i < N_IN; ++i) p.in[i] = (const float*)d_in[i];
    p.out = (float*)d_out; p.ws = (unsigned char*)d_ws;
#if MK_ONE_LAUNCH
    (void)hipMemsetAsync((char*)d_ws + WS_BAR, 0, 32 * WS_BAR_STRIDE, stream);
    {
        int lo = 0, li = 0;
        for (int k = 0; k < N_PHASES; ++k) {
            const bool fused = (k + 1 < N_PHASES) && ((MK_FUSE_MASK >> k) & 1ull);
            if (!fused) { p.ph_lo = lo; p.ph_hi = k + 1; p.li = li++; hipLaunchKernelGGL(hymba_fwd, dim3(grid), dim3(NTHR), LDS_BYTES, stream, p); lo = k + 1; }
        }
    }
#else
    (void)hipMemsetAsync((char*)d_ws + WS_BAR, 0, 32 * WS_BAR_STRIDE, stream);
    static bool attr2 = false;
    if (!attr2) { (void)hipFuncSetAttribute((const void*)hymba_fwd, hipFuncAttributeMaxDynamicSharedMemorySize, LDS_BYTES); attr2 = true; }
    int k = 0;
#define LAUNCH(KIND, l, sub) do { if ((MK_KIND_MASK >> (KIND)) & 1) { p.ph_lo = k; p.ph_hi = k + 1; p.li = 0; hipLaunchKernelGGL(hymba_fwd, dim3(grid), dim3(NTHR), LDS_BYTES, stream, p); } \
        else { p.ph_lo = 0; p.ph_hi = 0; launch_phase<KIND>(p, l, sub, grid, stream); } ++k; } while (0)
    LAUNCH(K_CONVERT, 0, 0);
    LAUNCH(K_MODFINAL, 0, 0);
    for (int l = 0; l < 2; ++l)
        for (int sub = 0; sub < 3; ++sub) {
            LAUNCH(K_NORM, l, sub);
            if (sub != 1) { LAUNCH(K_UP, l, sub); if (l == 1 && sub == 2) { LAUNCH(K_DOWNF, l, sub); } else { LAUNCH(K_DOWN, l, sub); } }
            else { LAUNCH(K_WIN, l, sub); {
                   if (MK_P1_SPLIT == 0) { LAUNCH(K_P1, l, sub); }
                   else { const int fa = (MK_P1_SPLIT == 1);
                       p.pad = 1; if (fa) { p.ph_lo = k; p.ph_hi = k + 1; p.li = 0; hipLaunchKernelGGL(hymba_fwd, dim3(grid), dim3(NTHR), LDS_BYTES, stream, p); } else { p.ph_lo = 0; p.ph_hi = 0; launch_phase<K_P1>(p, l, sub, grid, stream); }
                       p.pad = 2; if (!fa) { p.ph_lo = k; p.ph_hi = k + 1; p.li = 0; hipLaunchKernelGGL(hymba_fwd, dim3(grid), dim3(NTHR), LDS_BYTES, stream, p); } else { p.ph_lo = 0; p.ph_hi = 0; launch_phase<K_P1>(p, l, sub, grid, stream); }
                       p.pad = 0; ++k; } } LAUNCH(K_P2, l, sub); LAUNCH(K_P3, l, sub); LAUNCH(K_WOUT, l, sub); }
        }
    LAUNCH(K_FINAL, 0, 0);
#undef LAUNCH
#endif
}
```

```cpp
#include <hip/hip_runtime.h>
#include <cstdio>
#include <cstdint>
__device__ __forceinline__ int ltid() { int t = (int)threadIdx.x; asm volatile("" : "+v"(t)); return t; }
__device__ __forceinline__ int lbid() { int x = (int)blockIdx.x; asm volatile("" : "+s"(x)); return x; }
__device__ __forceinline__ int lgdim() { int x = (int)gridDim.x; asm volatile("" : "+s"(x)); return x; }
__device__ __forceinline__ int lsgpr(int x) { asm volatile("" : "+s"(x)); return x; }
namespace pg8 {
#define PG8_LAS __attribute__((address_space(3)))
typedef unsigned short bf16_t;
typedef short bf16x8 __attribute__((ext_vector_type(8)));
typedef float f32x4 __attribute__((ext_vector_type(4)));
typedef unsigned u32x4 __attribute__((ext_vector_type(4)));
constexpr int BM = 256, BK = 64, HALF = 128, HTB = HALF * BK * 2  , STAGE_BYTES = 8 * HTB, NXCD = 8, WGM = 8;

__host__ __device__ __forceinline__ int lds_byte(int r, int c) { const int st = (r >> 4) * 2 + (c >> 5), rr = r & 15, cc = c & 31, ob = rr * 64 + cc * 2; return st * 1024 + (ob ^ (((ob >> 9) & 1) << 5)); }
__host__ __device__ __forceinline__ void stage_rc(int b, int& R, int& C) { const int st = b / 1024, sb = b % 1024, swz = sb ^ (((sb >> 9) & 1) << 5); R = (st >> 1) * 16 + swz / 64; C = (st & 1) * 32 + (swz % 64) / 2; }
__host__ __device__ __forceinline__ int perm32(int rho) { const int n = rho >> 4, i = rho & 15; return 8 * (i >> 2) + 4 * n + (i & 3); }

struct Unit { int pm, pn; };
struct Gemm { const bf16_t* A; const bf16_t* Bt; int M, N, K; };

struct StaticOrder {
    int nM, nN, nwg, G, c, wgm;
    __host__ __device__ void init(int M, int N, int G_, int c_, int wgm_ = WGM) { nM = M / BM; nN = N / BM; nwg = nM * nN; G = G_; c = c_; wgm = wgm_; }
    __host__ __device__ bool next(int i, Unit& u) const {
        const long L = (long)i * G + c; if (L >= nwg) return false;
        int wgid = (int)L; { const int q = nwg / NXCD, r = nwg % NXCD, xcd = wgid % NXCD, off = wgid / NXCD; wgid = (xcd < r ? xcd * (q + 1) : r * (q + 1) + (xcd - r) * q) + off; }
        const int nig = wgm * nN, gid = wgid / nig, fm = gid * wgm, gsz = (nM - fm) < wgm ? (nM - fm) : wgm;
        u.pm = fm + ((wgid % nig) % gsz); u.pn = (wgid % nig) / gsz; return true;
    }
    __device__ __forceinline__ void a_ready(const Unit&) const {}
    __device__ __forceinline__ void done(const Unit&) const {}
};
template <class Epi, class Sched, bool ALIGN_EPI = false, bool SP2 = false>
__device__ __forceinline__ void gemm_phase(PG8_LAS unsigned char* lds, const Gemm g, const Sched& S, const Epi& E) {
    const int tid = ltid(), wid = __builtin_amdgcn_readfirstlane(tid >> 6), lane = tid & 63, wr = wid >> 2, wc = wid & 3, fr = lane & 15, fq = lane >> 4;
    const int K = g.K, nt = K / BK;
    unsigned voffA[2], voffB[2];
#pragma unroll
    for (int i = 0; i < 2; ++i) { int R, C; stage_rc(tid * 16 + i * 8192, R, C); const int Rb = Epi::PERM ? ((R & ~31) + perm32(R & 31)) : R;
        voffA[i] = (unsigned)(R * K + C) * 2u; voffB[i] = (unsigned)(Rb * K + C) * 2u; }
    const size_t kstep = (size_t)(BK * 2);
    const size_t hstep = (size_t)HALF * K * 2;
    const size_t tstep = 2 * hstep;
    const unsigned ldsw = (unsigned)wid * 1024u;
    const int aoff = lds_byte(wr * 64 + fr, fq * 8), boff = lds_byte(wc * 32 + fr, fq * 8);
#define PG8_SA(b, h) (((b) * 2 + (h)) * HTB)
#define PG8_SB(b, h) ((4 + (b) * 2 + (h)) * HTB)
#define PG8_STAGE(bufoff, gbase, voff) do { _Pragma("unroll") for (int _i = 0; _i < 2; ++_i) \
        __builtin_amdgcn_global_load_lds((const unsigned*)((const char*)(gbase) + (voff)[_i]), (PG8_LAS unsigned*)(lds + (bufoff) + ldsw + _i * 8192), 16, 0, 0); } while (0)
#define PG8_LDA(dst, b, h) do { _Pragma("unroll") for (int m = 0; m < 4; ++m) _Pragma("unroll") for (int k = 0; k < 2; ++k) dst[m][k] = *(const PG8_LAS bf16x8*)(lds + PG8_SA(b, h) + aoff + m * 2048 + k * 1024); } while (0)
#define PG8_LDB(dst, b, h) do { _Pragma("unroll") for (int n = 0; n < 2; ++n) _Pragma("unroll") for (int k = 0; k < 2; ++k) dst[n][k] = *(const PG8_LAS bf16x8*)(lds + PG8_SB(b, h) + boff + n * 2048 + k * 1024); } while (0)
#define PG8_MMA(ai, bj, At, Bt) do { __builtin_amdgcn_s_setprio(1); _Pragma("unroll") for (int m = 0; m < 4; ++m) _Pragma("unroll") for (int n = 0; n < 2; ++n) _Pragma("unroll") for (int k = 0; k < 2; ++k) \
        acc[ai][bj][m][n] = __builtin_amdgcn_mfma_f32_16x16x32_bf16(Bt[n][k], At[m][k], acc[ai][bj][m][n], 0, 0, 0); __builtin_amdgcn_s_setprio(0); } while (0)
#define PG8_WAIT_V(n) asm volatile("s_waitcnt vmcnt(" #n ")" ::: "memory")
#define PG8_WAIT_L(n) asm volatile("s_waitcnt lgkmcnt(" #n ")" ::: "memory")
#define PG8_BAR __builtin_amdgcn_s_barrier()
#define PG8_SCHED __builtin_amdgcn_sched_barrier(0)
    Unit cur, nxt; int ui = 0;
    if (!S.next(0, cur)) return;
    f32x4 acc[2][2][4][2];
#pragma unroll
    for (int a = 0; a < 2; ++a)
#pragma unroll
        for (int b = 0; b < 2; ++b)
#pragma unroll
            for (int m = 0; m < 4; ++m)
#pragma unroll
                for (int n = 0; n < 2; ++n) acc[a][b][m][n] = (f32x4){0.f, 0.f, 0.f, 0.f};
    bf16x8 At[4][2], B0[2][2], B1[2][2];
    const char* cA = (const char*)g.A + (size_t)cur.pm * tstep; const char* cB = (const char*)g.Bt + (size_t)cur.pn * tstep;
    S.a_ready(cur);
    if constexpr (SP2) {
        PG8_STAGE(PG8_SB(0, 0), cB, voffB); PG8_STAGE(PG8_SB(0, 1), cB + hstep, voffB); PG8_STAGE(PG8_SA(0, 0), cA, voffA); PG8_STAGE(PG8_SA(0, 1), cA + hstep, voffA);
        if (wr == 1) PG8_BAR;
        PG8_WAIT_V(2); PG8_BAR;
        PG8_STAGE(PG8_SB(1, 0), cB + kstep, voffB); PG8_STAGE(PG8_SA(1, 0), cA + kstep, voffA); PG8_STAGE(PG8_SB(1, 1), cB + hstep + kstep, voffB);
        PG8_WAIT_V(6); PG8_BAR;
    } else {
        PG8_STAGE(PG8_SB(0, 0), cB, voffB); PG8_STAGE(PG8_SA(0, 0), cA, voffA); PG8_STAGE(PG8_SB(0, 1), cB + hstep, voffB); PG8_STAGE(PG8_SA(0, 1), cA + hstep, voffA);
        if (wr == 1) PG8_BAR;
        PG8_WAIT_V(4); PG8_BAR;
        PG8_STAGE(PG8_SB(1, 0), cB + kstep, voffB); PG8_STAGE(PG8_SA(1, 0), cA + kstep, voffA); PG8_STAGE(PG8_SB(1, 1), cB + hstep + kstep, voffB);
        PG8_WAIT_V(6); PG8_BAR;
    }
    for (;;) {
        const bool has_next = S.next(ui + 1, nxt);
        const char* nA = has_next ? (const char*)g.A + (size_t)nxt.pm * tstep : cA; const char* nB = has_next ? (const char*)g.Bt + (size_t)nxt.pn * tstep : cB;
        for (int t = 0; t < nt; t += 2) {
            const bool last = (t == nt - 2);
            const char* a1 = cA + (size_t)(t + 1) * kstep;
            const char* a2 = last ? nA : cA + (size_t)(t + 2) * kstep; const char* b2 = last ? nB : cB + (size_t)(t + 2) * kstep;
            const char* a3 = a2 + kstep; const char* b3 = b2 + kstep;
            if (last && has_next) S.a_ready(nxt);
            if constexpr (SP2) {
            PG8_LDB(B0, 0, 0); PG8_LDB(B1, 0, 1); PG8_SCHED; PG8_LDA(At, 0, 0); PG8_STAGE(PG8_SA(1, 1), a1 + hstep, voffA);
            PG8_WAIT_V(8); PG8_WAIT_L(0); PG8_BAR; PG8_MMA(0, 0, At, B0); PG8_MMA(0, 1, At, B1); PG8_BAR; PG8_SCHED;
            PG8_LDA(At, 0, 1); PG8_STAGE(PG8_SB(0, 0), b2, voffB); PG8_STAGE(PG8_SB(0, 1), b2 + hstep, voffB); PG8_STAGE(PG8_SA(0, 0), a2, voffA);
            PG8_WAIT_V(8); PG8_WAIT_L(0); PG8_BAR; PG8_MMA(1, 0, At, B0); PG8_MMA(1, 1, At, B1); PG8_BAR; PG8_SCHED;
            PG8_LDB(B0, 1, 0); PG8_LDB(B1, 1, 1); PG8_SCHED; PG8_LDA(At, 1, 0); PG8_STAGE(PG8_SA(0, 1), a2 + hstep, voffA);
            PG8_WAIT_V(8); PG8_WAIT_L(0); PG8_BAR; PG8_MMA(0, 0, At, B0); PG8_MMA(0, 1, At, B1); PG8_BAR; PG8_SCHED;
            PG8_LDA(At, 1, 1); PG8_STAGE(PG8_SB(1, 0), b3, voffB); PG8_STAGE(PG8_SB(1, 1), b3 + hstep, voffB); PG8_STAGE(PG8_SA(1, 0), a3, voffA);
            PG8_WAIT_V(8); PG8_WAIT_L(0); PG8_BAR; PG8_MMA(1, 0, At, B0); PG8_MMA(1, 1, At, B1); PG8_BAR; PG8_SCHED;
            } else {
            PG8_LDB(B0, 0, 0); PG8_SCHED; PG8_LDA(At, 0, 0); PG8_STAGE(PG8_SA(1, 1), a1 + hstep, voffA);
            PG8_WAIT_L(8); PG8_BAR; PG8_WAIT_L(0); PG8_MMA(0, 0, At, B0); PG8_BAR; PG8_SCHED;
            PG8_LDB(B1, 0, 1); PG8_STAGE(PG8_SB(0, 0), b2, voffB);
            PG8_BAR; PG8_WAIT_L(0); PG8_MMA(0, 1, At, B1); PG8_BAR;
            PG8_LDA(At, 0, 1); PG8_STAGE(PG8_SA(0, 0), a2, voffA);
            PG8_BAR; PG8_WAIT_L(0); PG8_MMA(1, 0, At, B0); PG8_BAR; PG8_SCHED;
            PG8_STAGE(PG8_SB(0, 1), b2 + hstep, voffB);
            PG8_WAIT_V(6); PG8_BAR; PG8_MMA(1, 1, At, B1); PG8_BAR;
            PG8_LDB(B0, 1, 0); PG8_SCHED; PG8_LDA(At, 1, 0); PG8_STAGE(PG8_SA(0, 1), a2 + hstep, voffA);
            PG8_WAIT_L(8); PG8_BAR; PG8_WAIT_L(0); PG8_MMA(0, 0, At, B0); PG8_BAR; PG8_SCHED;
            PG8_LDB(B1, 1, 1); PG8_STAGE(PG8_SB(1, 0), b3, voffB);
            PG8_BAR; PG8_WAIT_L(0); PG8_MMA(0, 1, At, B1); PG8_BAR;
            PG8_LDA(At, 1, 1); PG8_STAGE(PG8_SA(1, 0), a3, voffA);
            PG8_BAR; PG8_WAIT_L(0); PG8_MMA(1, 0, At, B0); PG8_BAR; PG8_SCHED;
            PG8_STAGE(PG8_SB(1, 1), b3 + hstep, voffB);
            PG8_WAIT_V(6); PG8_BAR; PG8_MMA(1, 1, At, B1); PG8_BAR;
            }
        }
        if constexpr (ALIGN_EPI) { if (wr == 0) PG8_BAR; }
        if constexpr (!Epi::AFTER_DRAIN) { E(acc, cur, wr, wc, fr, fq); S.done(cur); }
        if (!has_next) break;
#pragma unroll
        for (int a = 0; a < 2; ++a)
#pragma unroll
            for (int b = 0; b < 2; ++b)
#pragma unroll
                for (int m = 0; m < 4; ++m)
#pragma unroll
                    for (int n = 0; n < 2; ++n) acc[a][b][m][n] = (f32x4){0.f, 0.f, 0.f, 0.f};
        cur = nxt; cA = nA; cB = nB; ++ui;
        if constexpr (ALIGN_EPI) { if (wr == 1) PG8_BAR; }
    }
    PG8_WAIT_V(0);
    if constexpr (!ALIGN_EPI) { if (wr == 0) PG8_BAR; }
    PG8_BAR;
    if constexpr (Epi::AFTER_DRAIN) { E.fused(acc, cur, wr, wc, fr, fq, lds, wid, lane); S.done(cur); }
#undef PG8_SA
#undef PG8_SB
#undef PG8_STAGE
#undef PG8_LDA
#undef PG8_LDB
#undef PG8_MMA
#undef PG8_WAIT_V
#undef PG8_WAIT_L
#undef PG8_BAR
#undef PG8_SCHED
}
}
#define XB_TMO      128
#define XB_XCNT(j)  (256  + 64 * (j))
#define XB_XSUB(j)  (1280 + 64 * (j))
#define XB_XGEN(j)  (2304 + 64 * (j))
#define XB_TOP      3328
#define XB_TOPGEN   3392
#define XCD_BAR_WORDS 3456
#define XB_SPIN_CAP (1u << 18)
#define LAS __attribute__((address_space(3)))

__device__ __forceinline__ unsigned xb_ld(unsigned* p)              { return __hip_atomic_load(p, __ATOMIC_RELAXED, __HIP_MEMORY_SCOPE_AGENT); }
__device__ __forceinline__ unsigned xb_add(unsigned* p, unsigned v) { return __hip_atomic_fetch_add(p, v, __ATOMIC_RELAXED, __HIP_MEMORY_SCOPE_AGENT); }
__device__ __forceinline__ unsigned xb_xcc_id() { return (unsigned)__builtin_amdgcn_s_getreg((3 << 11) | 20) & 0xFu; }
#define XB_SPIN(cond, bar) do { unsigned _sp = 0; while (cond) { __builtin_amdgcn_s_sleep(1); \
    if ((++_sp & 255u) == 0u) { if (xb_ld(&(bar)[XB_TMO])) break; if (_sp > XB_SPIN_CAP) { atomicAdd(&(bar)[XB_TMO], 1u); break; } } } } while (0)

struct XcdBarrier {
    unsigned* bar; unsigned x;
    volatile LAS unsigned* st;
};

__device__ __forceinline__ XcdBarrier xcd_barrier_post(unsigned* bar, volatile LAS unsigned* st) {
    XcdBarrier b; b.bar = bar; b.x = xb_xcc_id(); b.st = st;
    if (threadIdx.x == 0) (void)xb_add(&bar[XB_XCNT(b.x)], 1u);
    return b;
}
__device__ __forceinline__ void xcd_barrier_complete(unsigned* bar, unsigned x, unsigned& nloc, unsigned& nx) {
    const unsigned G = gridDim.x * gridDim.y * gridDim.z;
    unsigned sum, cnt, mine, sp = 0u;
    for (;;) {
        sum = 0u; cnt = 0u; mine = 0u;
#pragma unroll
        for (unsigned j = 0; j < 16; ++j) { const unsigned c = xb_ld(&bar[XB_XCNT(j)]); sum += c; cnt += (c > 0u) ? 1u : 0u; mine = (j == x) ? c : mine; }
        if (sum == G) break;
        __builtin_amdgcn_s_sleep(1);
        if ((++sp & 255u) == 0u) { if (xb_ld(&bar[XB_TMO])) break; if (sp > XB_SPIN_CAP) { atomicAdd(&bar[XB_TMO], 1u); break; } }
    }
    nloc = mine > 0u ? mine : 1u; nx = cnt > 0u ? cnt : 1u;
}

__device__ __forceinline__ void xcd_barrier(const XcdBarrier& b) {
    asm volatile("s_waitcnt vmcnt(0)" ::: "memory");
    __syncthreads();
    if (threadIdx.x == 0) {
        unsigned* bar = b.bar;
        __builtin_amdgcn_s_waitcnt(0);
        unsigned nloc = b.st[0], nx = b.st[1];
        if (nloc == 0u) { xcd_barrier_complete(bar, b.x, nloc, nx); b.st[0] = nloc; b.st[1] = nx; }
        const unsigned old = xb_add(&bar[XB_XSUB(b.x)], 1u);
        const unsigned gen = old / nloc;
        if (old + 1u == (gen + 1u) * nloc) {
            __builtin_amdgcn_fence(__ATOMIC_RELEASE, "agent");
            asm volatile("s_waitcnt vmcnt(0)" ::: "memory");
            const unsigned og = xb_add(&bar[XB_TOP], 1u);
            const unsigned tg = og / nx;
            if (og + 1u == (tg + 1u) * nx) xb_add(&bar[XB_TOPGEN], 1u);
            else XB_SPIN(xb_ld(&bar[XB_TOPGEN]) == tg, bar);
            __builtin_amdgcn_fence(__ATOMIC_ACQUIRE, "agent");
            xb_add(&bar[XB_XGEN(b.x)], 1u);
            asm volatile("s_waitcnt vmcnt(0)" ::: "memory");
        } else {
            XB_SPIN(xb_ld(&bar[XB_XGEN(b.x)]) == gen, bar);
            __builtin_amdgcn_fence(__ATOMIC_ACQUIRE, "agent");
            asm volatile("s_waitcnt vmcnt(0)" ::: "memory");
        }
    }
    __syncthreads();
}

typedef unsigned short bf16_t;
typedef short bf16x8 __attribute__((ext_vector_type(8)));
typedef float f32x4 __attribute__((ext_vector_type(4)));
typedef float f32x2 __attribute__((ext_vector_type(2)));
typedef unsigned u32x4 __attribute__((ext_vector_type(4)));
typedef unsigned u32x2 __attribute__((ext_vector_type(2)));

constexpr int NB = 8, SEQ = 4096, DM = 2048, NTOK = NB * SEQ, DFF = 5632, DIN = 6312, LDU = 6400, NMOD = 18432, NTHR = 512;
constexpr int U_HG_Q = 0, U_HG_F = 512, U_HG_I = 1024, U_HG_G = 1536;
constexpr int U_RW_R = 2048, U_RW_K = 2560, U_RW_V = 3072, U_RW_WD = 3584;
constexpr int U_ML_X = 3744, U_ML_V = 4256, U_ML_O = 4768, U_ML_I = 5280, U_ML_F = 5284;
constexpr int U_LRU_X = 5288, U_LRU_G = 5800;
constexpr int RW_IN = 1696;

enum { I_X = 0, I_C, I_GAIN, I_MODW, I_MODB, I_W1, I_W3, I_W2, I_WIN, I_WOUT, I_HGLB, I_HGNORM, I_RWMU, I_RWW0, I_RWW2, I_RWA0, I_RWA2, I_RWG2, I_RWKK, I_RWKA,
       I_RWRK, I_RWLNW, I_RWLNB, I_MLCW, I_MLCB, I_MLWQ, I_MLWK, I_MLIB, I_MLFB, I_MLNORM, I_MLSKIP, I_LRUCW, I_LRUCB, I_LRUWA, I_LRUBA, I_LRUWX, I_LRUBX,
       I_LRULAM, I_LRUNORM, I_FNORM, N_IN };

constexpr size_t WS_BAR = 0;
constexpr size_t WS_BAR_STRIDE = 16384, WS_MODP = 32 * WS_BAR_STRIDE;
constexpr size_t WS_MODF = WS_MODP + (size_t)2 * 16 * 8 * NMOD * 4;
constexpr size_t WS_LRUW = WS_MODF + (size_t)2 * 8 * NMOD * 4;
constexpr size_t WS_W = WS_LRUW + (size_t)2 * 2 * 4 * 16384 * 2;
constexpr size_t LW_W13A = 0, LW_W2A = 23068672, LW_W13B = 34603008, LW_W2B = 57671680, LW_WIN = 69206016, LW_WOUT = 82313216, LW_ELEMS = 86507520;
constexpr size_t WS_HY = WS_W + 2 * LW_ELEMS * 2;
constexpr size_t WS_U = WS_HY + (size_t)NTOK * DM * 2;
constexpr size_t WS_LRUA = WS_U + (size_t)NTOK * LDU * 2;
constexpr size_t WS_LRUB = WS_LRUA + (size_t)NTOK * 512 * 4;
constexpr size_t WS_RWW = WS_LRUB + (size_t)NTOK * 512 * 4;
constexpr size_t WS_RWA = WS_RWW + (size_t)NTOK * 512 * 4;
constexpr size_t WS_RWG = WS_RWA + (size_t)NTOK * 512 * 2;
constexpr size_t WS_LORAT = WS_RWG + (size_t)NTOK * 512 * 2;
constexpr size_t WS_END = WS_LORAT + (size_t)2 * 512 * 160 * 2;

constexpr int LDS_BYTES = 144 * 1024;
constexpr int LDS_BARW = LDS_BYTES - 16;

struct Params { const float* in[N_IN]; float* out; unsigned char* ws; int ph_lo, ph_hi, li, pad; };
typedef const Params __attribute__((address_space(4)))* KP;
__device__ __forceinline__ KP kp_fresh() { KP p = (KP)__builtin_amdgcn_kernarg_segment_ptr(); asm volatile("" : "+s"(p)); return p; }

__device__ __forceinline__ float bflo(unsigned w) { return __uint_as_float(w << 16); }
__device__ __forceinline__ float bfhi(unsigned w) { return __uint_as_float(w & 0xffff0000u); }
__device__ __forceinline__ float bf2f(bf16_t h) { return __uint_as_float(((unsigned)h) << 16); }
typedef __bf16 bf16x2n __attribute__((ext_vector_type(2)));
__device__ __forceinline__ unsigned pk_bf16(float lo, float hi) { const f32x2 v = {lo, hi}; return __builtin_bit_cast(unsigned, __builtin_convertvector(v, bf16x2n)); }
__device__ __forceinline__ void unpack8(const u32x4 w, float (&f)[8]) { f[0] = bflo(w.x); f[1] = bfhi(w.x); f[2] = bflo(w.y); f[3] = bfhi(w.y); f[4] = bflo(w.z); f[5] = bfhi(w.z); f[6] = bflo(w.w); f[7] = bfhi(w.w); }
__device__ __forceinline__ u32x4 pack8(const float (&f)[8]) { u32x4 w; w.x = pk_bf16(f[0], f[1]); w.y = pk_bf16(f[2], f[3]); w.z = pk_bf16(f[4], f[5]); w.w = pk_bf16(f[6], f[7]); return w; }
__device__ __forceinline__ float fast_rcp(float x) { return __builtin_amdgcn_rcpf(x); }
__device__ __forceinline__ float sigmoidf_(float x) { return fast_rcp(1.0f + __expf(-x)); }
__device__ __forceinline__ float siluf_(float x) { return x * sigmoidf_(x); }
__device__ __forceinline__ float softplusf_(float x) { return fmaxf(x, 0.0f) + __logf(1.0f + __expf(-fabsf(x))); }
__device__ __forceinline__ float tanhf_(float x) { const float e = __expf(2.0f * x); return 1.0f - 2.0f * fast_rcp(e + 1.0f); }
__device__ __forceinline__ float gelu_tanhf_(float x) { return 0.5f * x * (1.0f + tanhf_(0.7978845608028654f * (x + 0.044715f * x * x * x))); }
template <int CTRL> __device__ __forceinline__ float dpp_f(float x) { return __int_as_float(__builtin_amdgcn_update_dpp(0, __float_as_int(x), CTRL, 0xF, 0xF, true)); }
__device__ __forceinline__ float wave_scan_sum(float x) {
#define DPP_SC_(v, old, ctrl, rmask) __int_as_float(__builtin_amdgcn_update_dpp(__float_as_int(old), __float_as_int(v), ctrl, rmask, 0xF, false))
    x += DPP_SC_(x, 0.f, 0x111, 0xF); x += DPP_SC_(x, 0.f, 0x112, 0xF); x += DPP_SC_(x, 0.f, 0x114, 0xF); x += DPP_SC_(x, 0.f, 0x118, 0xF);
    x += DPP_SC_(x, 0.f, 0x142, 0xA); x += DPP_SC_(x, 0.f, 0x143, 0xC);
    return x;
}
__device__ __forceinline__ float wave_scan_max(float x) {
    x = fmaxf(x, DPP_SC_(x, x, 0x111, 0xF)); x = fmaxf(x, DPP_SC_(x, x, 0x112, 0xF)); x = fmaxf(x, DPP_SC_(x, x, 0x114, 0xF)); x = fmaxf(x, DPP_SC_(x, x, 0x118, 0xF));
    x = fmaxf(x, DPP_SC_(x, x, 0x142, 0xA)); x = fmaxf(x, DPP_SC_(x, x, 0x143, 0xC));
    return x;
#undef DPP_SC_
}
__device__ __forceinline__ float red8(float x) { x += dpp_f<0xB1>(x); x += dpp_f<0x4E>(x); x += dpp_f<0x141>(x); return x; }
__device__ __forceinline__ float red16(float x) { x = red8(x); x += dpp_f<0x140>(x); return x; }
__device__ __forceinline__ float red64(float x) { x = red16(x); x += __shfl_xor(x, 16); x += __shfl_xor(x, 32); return x; }


#define DPP_ADD4_(CTRL) "v_add_f32_dpp %0, %0, %0 " CTRL " row_mask:0xf bank_mask:0xf bound_ctrl:1\n\t" "v_add_f32_dpp %1, %1, %1 " CTRL " row_mask:0xf bank_mask:0xf bound_ctrl:1\n\t" \
                        "v_add_f32_dpp %2, %2, %2 " CTRL " row_mask:0xf bank_mask:0xf bound_ctrl:1\n\t" "v_add_f32_dpp %3, %3, %3 " CTRL " row_mask:0xf bank_mask:0xf bound_ctrl:1\n\t"
__device__ __forceinline__ void red16x4(float& a, float& b, float& c, float& d) {
    asm volatile("s_nop 4\n\t" DPP_ADD4_("quad_perm:[1,0,3,2]") DPP_ADD4_("quad_perm:[2,3,0,1]") DPP_ADD4_("row_half_mirror") DPP_ADD4_("row_mirror") : "+v"(a), "+v"(b), "+v"(c), "+v"(d));
}

__device__ __forceinline__ void rw1_dots(float s0, float s1, float s2, float s3, const f32x4 ma, const f32x4 wr, float& p1, float& p2) {
    asm volatile(
        "v_mul_f32 %[p1], %[s0], %[ma0]\n\t" "v_mul_f32 %[p2], %[s0], %[wr0]\n\t" "v_fmac_f32 %[p1], %[s1], %[ma1]\n\t" "v_fmac_f32 %[p2], %[s1], %[wr1]\n\t"
        "v_fmac_f32 %[p1], %[s2], %[ma2]\n\t" "v_fmac_f32 %[p2], %[s2], %[wr2]\n\t" "v_fmac_f32 %[p1], %[s3], %[ma3]\n\t" "v_fmac_f32 %[p2], %[s3], %[wr3]\n\t"
        : [p1] "=&v"(p1), [p2] "=&v"(p2)
        : [s0] "v"(s0), [s1] "v"(s1), [s2] "v"(s2), [s3] "v"(s3), [ma0] "v"(ma[0]), [ma1] "v"(ma[1]), [ma2] "v"(ma[2]), [ma3] "v"(ma[3]),
          [wr0] "v"(wr[0]), [wr1] "v"(wr[1]), [wr2] "v"(wr[2]), [wr3] "v"(wr[3]));
}
#define DPP_ADD2_(CTRL, TL) "v_add_f32_dpp %[a], %[a], %[a] " CTRL " row_mask:0xf bank_mask:0xf bound_ctrl:1\n\t" "v_add_f32_dpp %[b], %[b], %[b] " CTRL " row_mask:0xf bank_mask:0xf bound_ctrl:1\n\t" TL
__device__ __forceinline__ void rw1_reduce(float& a, float& b, float v, const f32x4 kp, float& t0, float& t1, float& t2, float& t3) {
    asm volatile("s_nop 4\n\t"
        DPP_ADD2_("quad_perm:[1,0,3,2]", "v_mul_f32 %[t0], %[v], %[kp0]\n\t") DPP_ADD2_("quad_perm:[2,3,0,1]", "v_mul_f32 %[t1], %[v], %[kp1]\n\t")
        DPP_ADD2_("row_half_mirror", "v_mul_f32 %[t2], %[v], %[kp2]\n\t") DPP_ADD2_("row_mirror", "v_mul_f32 %[t3], %[v], %[kp3]\n\t")
        : [a] "+v"(a), [b] "+v"(b), [t0] "=&v"(t0), [t1] "=&v"(t1), [t2] "=&v"(t2), [t3] "=&v"(t3)
        : [v] "v"(v), [kp0] "v"(kp[0]), [kp1] "v"(kp[1]), [kp2] "v"(kp[2]), [kp3] "v"(kp[3]));
}
__device__ __forceinline__ void rw1_update(float& s0, float& s1, float& s2, float& s3, float sa, float t0, float t1, float t2, float t3, const f32x4 wd, const f32x4 bv) {
    asm volatile(
        "v_fmac_f32 %[t0], %[sa], %[bv0]\n\t" "v_fmac_f32 %[t1], %[sa], %[bv1]\n\t" "v_fmac_f32 %[t2], %[sa], %[bv2]\n\t" "v_fmac_f32 %[t3], %[sa], %[bv3]\n\t"
        "v_fma_f32 %[s0], %[s0], %[wd0], %[t0]\n\t" "v_fma_f32 %[s1], %[s1], %[wd1], %[t1]\n\t" "v_fma_f32 %[s2], %[s2], %[wd2], %[t2]\n\t" "v_fma_f32 %[s3], %[s3], %[wd3], %[t3]\n\t"
        : [s0] "+v"(s0), [s1] "+v"(s1), [s2] "+v"(s2), [s3] "+v"(s3), [t0] "+v"(t0), [t1] "+v"(t1), [t2] "+v"(t2), [t3] "+v"(t3)
        : [sa] "v"(sa), [wd0] "v"(wd[0]), [wd1] "v"(wd[1]), [wd2] "v"(wd[2]), [wd3] "v"(wd[3]), [bv0] "v"(bv[0]), [bv1] "v"(bv[1]), [bv2] "v"(bv[2]), [bv3] "v"(bv[3]));
}

#define LDSF(off) ((LAS float*)(lds + (off)))

__device__ __forceinline__ void cvt_tile(const float* __restrict__ src, bf16_t* __restrict__ dst, int K, int N, int kt, int nt, int mode, LAS unsigned char* lds) {
    const int tid = ltid(); LAS float* tile = LDSF(0);
    const int k0 = kt * 64, n0 = nt * 64;
#pragma unroll
    for (int p = 0; p < 2; ++p) {
        const int kk = p * 32 + (tid >> 4), n4 = (tid & 15) * 4;
        f32x4 v = (f32x4){0.f, 0.f, 0.f, 0.f};
        if (n0 + n4 < N) v = *(const f32x4*)(src + (size_t)(k0 + kk) * N + n0 + n4);
        tile[kk * 65 + n4 + 0] = v[0]; tile[kk * 65 + n4 + 1] = v[1]; tile[kk * 65 + n4 + 2] = v[2]; tile[kk * 65 + n4 + 3] = v[3];
    }
    __syncthreads();
    {
        const int nn = tid >> 3, k8 = (tid & 7) * 8, n = n0 + nn;
        float f[8];
#pragma unroll
        for (int j = 0; j < 8; ++j) f[j] = tile[(k8 + j) * 65 + nn];
        const int row = (mode == 0) ? n : ((n >> 7) * 256 + ((mode == 2) ? 128 : 0) + (n & 127));
        *(u32x4*)(dst + (size_t)row * K + k0 + k8) = pack8(f);
    }
    __syncthreads();
}

constexpr int T_FF = 2816, T_WIN = 3200, T_WOUT = 1024, T_LAYER = 6 * T_FF + T_WIN + T_WOUT;
struct CvtTile { const float* src; bf16_t* dst; int K, N, kt, nt, mode; };
__device__ __forceinline__ CvtTile cvt_desc(KP P, int l, int r) {
    bf16_t* Wl = (bf16_t*)(P->ws + WS_W) + (size_t)l * LW_ELEMS;
    CvtTile t;
    if (r < 6 * T_FF) {
        const int m = r / T_FF, q = r % T_FF, f = m / 3, which = m % 3;
        if (which < 2) { t.src = P->in[which == 0 ? I_W1 : I_W3] + (size_t)(l * 2 + f) * DM * DFF; t.dst = Wl + (f ? LW_W13B : LW_W13A); t.K = DM; t.N = DFF; t.kt = q / 88; t.nt = q % 88; t.mode = which + 1; }
        else { t.src = P->in[I_W2] + (size_t)(l * 2 + f) * DFF * DM; t.dst = Wl + (f ? LW_W2B : LW_W2A); t.K = DFF; t.N = DM; t.kt = q / 32; t.nt = q % 32; t.mode = 0; }
    } else if (r < 6 * T_FF + T_WIN) {
        const int q = r - 6 * T_FF;
        t.src = P->in[I_WIN] + (size_t)l * DM * DIN; t.dst = Wl + LW_WIN; t.K = DM; t.N = DIN; t.kt = q / 100; t.nt = q % 100; t.mode = 0;
    } else {
        const int q = r - 6 * T_FF - T_WIN;
        t.src = P->in[I_WOUT] + (size_t)l * DM * DM; t.dst = Wl + LW_WOUT; t.K = DM; t.N = DM; t.kt = q / 32; t.nt = q % 32; t.mode = 0;
    }
    return t;
}
__device__ __forceinline__ void cvt_load(const CvtTile& t, f32x4 (&v)[2]) {
    const int tid = ltid(), n4 = (tid & 15) * 4;
#pragma unroll
    for (int p = 0; p < 2; ++p) {
        const int kk = p * 32 + (tid >> 4);
        v[p] = (f32x4){0.f, 0.f, 0.f, 0.f};
        if (t.nt * 64 + n4 < t.N) v[p] = *(const f32x4*)(t.src + (size_t)(t.kt * 64 + kk) * t.N + t.nt * 64 + n4);
    }
}
__device__ __forceinline__ void cvt_store(const CvtTile& t, const f32x4 (&v)[2], LAS unsigned char* lds) {
    const int tid = ltid(); LAS float* tile = LDSF(0);
#pragma unroll
    for (int p = 0; p < 2; ++p) {
        const int kk = p * 32 + (tid >> 4), n4 = (tid & 15) * 4;
        tile[kk * 65 + n4 + 0] = v[p][0]; tile[kk * 65 + n4 + 1] = v[p][1]; tile[kk * 65 + n4 + 2] = v[p][2]; tile[kk * 65 + n4 + 3] = v[p][3];
    }
    __syncthreads();
    {
        const int nn = tid >> 3, k8 = (tid & 7) * 8, n = t.nt * 64 + nn;
        float f[8];
#pragma unroll
        for (int j = 0; j < 8; ++j) f[j] = tile[(k8 + j) * 65 + nn];
        const int row = (t.mode == 0) ? n : ((n >> 7) * 256 + ((t.mode == 2) ? 128 : 0) + (n & 127));
        *(u32x4*)(t.dst + (size_t)row * t.K + t.kt * 64 + k8) = pack8(f);
    }
    __syncthreads();
}
__device__ __forceinline__ CvtTile cvt_desc_dyn(KP P, int r);
constexpr int T_EARLY = 3 * T_FF + T_WIN, T_LATE0 = 3 * T_FF + T_WOUT, T_DYN = T_LATE0 + T_LAYER;
__device__ __forceinline__ CvtTile cvt_desc_dyn(KP P, int r) {
    if (r < T_LATE0) return cvt_desc(P, 0, (r < 3 * T_FF) ? r + 3 * T_FF : r + 3 * T_FF + T_WIN);
    return cvt_desc(P, 1, r - T_LATE0);
}
__device__ __forceinline__ void convert_dynamic(KP P, LAS unsigned char* lds) {
    unsigned* ctr = (unsigned*)(P->ws + WS_BAR + (size_t)31 * WS_BAR_STRIDE);
    LAS unsigned* sh = (LAS unsigned*)(lds + 32768);
    const int tid = ltid();
    for (;;) {
        __syncthreads();
        if (tid == 0) *sh = __hip_atomic_fetch_add(ctr, 8u, __ATOMIC_RELAXED, __HIP_MEMORY_SCOPE_AGENT);
        __syncthreads();
        const int base = (int)*sh;
        if (base >= T_DYN) break;
        const int end = (base + 8 < T_DYN) ? base + 8 : T_DYN;
        CvtTile cur = cvt_desc_dyn(P, base); f32x4 v[2]; cvt_load(cur, v);
        for (int r = base; r < end; ++r) {
            CvtTile nxt = cur; f32x4 w[2] = {v[0], v[1]};
            if (r + 1 < end) { nxt = cvt_desc_dyn(P, r + 1); cvt_load(nxt, w); }
            cvt_store(cur, v, lds);
            cur = nxt; v[0] = w[0]; v[1] = w[1];
        }
    }
}
__device__ __forceinline__ void phase_convert(KP P, LAS unsigned char* lds) {
    const int tid = ltid(), wg = lbid(), nwg = lgdim();
    constexpr int T_BIG = 0, T_LRU = 64, T_MOD = 2 * 36 * 16;
    if (wg < T_EARLY) {
        CvtTile cur = cvt_desc(P, 0, (wg < 3 * T_FF) ? wg : wg + 3 * T_FF); f32x4 v[2]; cvt_load(cur, v);
        for (int r = wg; r < T_EARLY; r += nwg) {
            CvtTile nxt = cur; f32x4 w[2] = {v[0], v[1]};
            const int rn = r + nwg;
            if (rn < T_EARLY) { nxt = cvt_desc(P, 0, (rn < 3 * T_FF) ? rn : rn + 3 * T_FF); cvt_load(nxt, w); }
            cvt_store(cur, v, lds);
            cur = nxt; v[0] = w[0]; v[1] = w[1];
        }
    }
    {
        bf16_t* LT = (bf16_t*)(P->ws + WS_LORAT);
        for (int e = wg * NTHR + tid; e < 2 * 512 * 160; e += nwg * NTHR) {
            const int l = e / 81920, r = e % 81920, ch = r / 160, j = r % 160;
            const float v = (j < 32) ? P->in[I_RWW2][(size_t)(l * 32 + j) * 512 + ch] : ((j < 64) ? P->in[I_RWA2][(size_t)(l * 32 + j - 32) * 512 + ch] : P->in[I_RWG2][(size_t)(l * 96 + j - 64) * 512 + ch]);
            LT[e] = (bf16_t)(pk_bf16(v, 0.f) & 0xffffu);
        }
    }
    for (int it = wg; it < T_BIG + T_LRU + T_MOD; it += nwg) {
        if (false) {
        } else if (it < T_BIG + T_LRU) {
            const int q = it - T_BIG, m16 = q >> 2, tl = q & 3, l = m16 >> 3, which = (m16 >> 2) & 1, blk = m16 & 3;
            const float* src = P->in[which ? I_LRUWX : I_LRUWA] + (size_t)(l * 4 + blk) * 16384;
            bf16_t* dst = (bf16_t*)(P->ws + WS_LRUW) + (size_t)((l * 2 + which) * 4 + blk) * 16384;
            cvt_tile(src, dst, 128, 128, tl >> 1, tl & 1, 0, lds);
        } else {
            const int m = it - T_BIG - T_LRU, l = m / 576, r = m % 576, jb = r / 16, ks = r % 16;
            LAS float* cact = LDSF(0);
#pragma unroll
            for (int e2 = 0; e2 < 2; ++e2) { const int e = tid * 2 + e2, kk = e >> 3, b = e & 7; cact[e] = siluf_(P->in[I_C][b * DM + ks * 128 + kk]); }
            __syncthreads();
            const int j = jb * 512 + tid;
            const float* wp = P->in[I_MODW] + (size_t)l * DM * NMOD + (size_t)(ks * 128) * NMOD + j;
            float acc[8];
#pragma unroll
            for (int b = 0; b < 8; ++b) acc[b] = 0.f;
#pragma unroll 32
            for (int kk = 0; kk < 128; ++kk) {
                const float w = wp[(size_t)kk * NMOD];
                const f32x4 c0 = *(const LAS f32x4*)(cact + kk * 8), c1 = *(const LAS f32x4*)(cact + kk * 8 + 4);
                acc[0] += c0[0] * w; acc[1] += c0[1] * w; acc[2] += c0[2] * w; acc[3] += c0[3] * w;
                acc[4] += c1[0] * w; acc[5] += c1[1] * w; acc[6] += c1[2] * w; acc[7] += c1[3] * w;
            }
            float* mp = (float*)(P->ws + WS_MODP) + (size_t)((l * 16 + ks) * 8) * NMOD + j;
#pragma unroll
            for (int b = 0; b < 8; ++b) mp[(size_t)b * NMOD] = acc[b];
            __syncthreads();
        }
    }
}

__device__ __forceinline__ void phase_modfinal(KP P) {
    const float* mp = (const float*)(P->ws + WS_MODP); float* mf = (float*)(P->ws + WS_MODF);
    for (int i = lbid() * NTHR + ltid(); i < 2 * 8 * NMOD; i += lgdim() * NTHR) {
        const int l = i / (8 * NMOD), r = i % (8 * NMOD), b = r / NMOD, j = r % NMOD;
        float s = P->in[I_MODB][l * NMOD + j];
#pragma unroll
        for (int ks = 0; ks < 16; ++ks) s += mp[(size_t)((l * 16 + ks) * 8 + b) * NMOD + j];
        mf[i] = s;
    }
}

__device__ __forceinline__ void phase_norm(KP P, int l, int sub, const void* __restrict__ xsrc, int xf32, LAS unsigned char* lds) {
    const int tid = ltid(), lane = tid & 63, wave = tid >> 6;
    bf16_t* H = (bf16_t*)(P->ws + WS_HY);
    LAS float* cv = LDSF(0); LAS float* sv = LDSF(8192);
    for (int rb = lbid(); rb < NTOK / 128; rb += lgdim()) {
        const int b = rb >> 5;
        const float* mod = (const float*)(P->ws + WS_MODF) + (size_t)(l * 8 + b) * NMOD + sub * 6144;
        __syncthreads();
        for (int d = tid; d < DM; d += NTHR) { cv[d] = P->in[I_GAIN][(l * 3 + sub) * DM + d] * (1.0f + mod[2048 + d]); sv[d] = mod[d]; }
        __syncthreads();
        if (xf32) {
            for (int rr = 0; rr < 16; ++rr) {
                const int row = rb * 128 + wave * 16 + rr;
                const float* xr = (const float*)xsrc + (size_t)row * DM;
                f32x4 v[8]; float ss = 0.f;
#pragma unroll
                for (int i = 0; i < 8; ++i) { v[i] = *(const f32x4*)(xr + i * 256 + lane * 4); ss += v[i][0] * v[i][0] + v[i][1] * v[i][1] + v[i][2] * v[i][2] + v[i][3] * v[i][3]; }
                ss = red64(ss);
                const float rstd = rsqrtf(ss * (1.0f / DM) + 1e-6f);
#pragma unroll
                for (int i = 0; i < 8; ++i) {
                    const int d = i * 256 + lane * 4;
                    const f32x4 c = *(const LAS f32x4*)(cv + d), s = *(const LAS f32x4*)(sv + d);
                    u32x2 w; w.x = pk_bf16(v[i][0] * rstd * c[0] + s[0], v[i][1] * rstd * c[1] + s[1]); w.y = pk_bf16(v[i][2] * rstd * c[2] + s[2], v[i][3] * rstd * c[3] + s[3]);
                    *(u32x2*)(H + (size_t)row * DM + d) = w;
                }
            }
        } else {
            for (int rr = 0; rr < 16; ++rr) {
                const int row = rb * 128 + wave * 16 + rr;
                const bf16_t* xr = (const bf16_t*)xsrc + (size_t)row * DM;
                u32x4 xw[4]; float ss = 0.f;
#pragma unroll
                for (int i = 0; i < 4; ++i) xw[i] = *(const u32x4*)(xr + i * 512 + lane * 8);
                float v[4][8];
#pragma unroll
                for (int i = 0; i < 4; ++i) {
                    unpack8(xw[i], v[i]);
#pragma unroll
                    for (int j = 0; j < 8; ++j) ss += v[i][j] * v[i][j];
                }
                ss = red64(ss);
                const float rstd = rsqrtf(ss * (1.0f / DM) + 1e-6f);
#pragma unroll
                for (int i = 0; i < 4; ++i) {
                    const int d = i * 512 + lane * 8;
                    const f32x4 c0 = *(const LAS f32x4*)(cv + d), c1 = *(const LAS f32x4*)(cv + d + 4), s0 = *(const LAS f32x4*)(sv + d), s1 = *(const LAS f32x4*)(sv + d + 4);
                    float o[8];
#pragma unroll
                    for (int j = 0; j < 4; ++j) { o[j] = v[i][j] * rstd * c0[j] + s0[j]; o[4 + j] = v[i][4 + j] * rstd * c1[j] + s1[j]; }
                    *(u32x4*)(H + (size_t)row * DM + d) = pack8(o);
                }
            }
        }
    }
}

__device__ __forceinline__ void phase_final_norm(KP P, const bf16_t* __restrict__ X) {
    const int tid = ltid(), lane = tid & 63, wave = tid >> 6;
    const float* fn = P->in[I_FNORM];
    for (int row = lbid() * 8 + wave; row < NTOK; row += lgdim() * 8) {
        const bf16_t* xr = X + (size_t)row * DM; float* orow = P->out + (size_t)row * DM;
        u32x4 xw[4]; float ss = 0.f;
#pragma unroll
        for (int i = 0; i < 4; ++i) xw[i] = *(const u32x4*)(xr + i * 512 + lane * 8);
        float v[4][8];
#pragma unroll
        for (int i = 0; i < 4; ++i) {
            unpack8(xw[i], v[i]);
#pragma unroll
            for (int j = 0; j < 8; ++j) ss += v[i][j] * v[i][j];
        }
        ss = red64(ss);
        const float rstd = rsqrtf(ss * (1.0f / DM) + 1e-6f);
#pragma unroll
        for (int i = 0; i < 4; ++i) {
            const int d = i * 512 + lane * 8;
            const f32x4 g0 = *(const f32x4*)(fn + d), g1 = *(const f32x4*)(fn + d + 4);
            f32x4 o0, o1;
#pragma unroll
            for (int j = 0; j < 4; ++j) { o0[j] = v[i][j] * rstd * g0[j]; o1[j] = v[i][4 + j] * rstd * g1[j]; }
            *(f32x4*)(orow + d) = o0; *(f32x4*)(orow + d + 4) = o1;
        }
    }
}

struct EpiSwiGLU {
    static constexpr bool PERM = true, AFTER_DRAIN = false;
    bf16_t* G;
    __device__ __forceinline__ void operator()(const pg8::f32x4 (&acc)[2][2][4][2], const pg8::Unit& u, int wr, int wc, int fr, int fq) const {
        const int row0 = u.pm * 256 + wr * 64 + fr, col0 = u.pn * 128 + wc * 32 + 8 * fq;
#pragma unroll
        for (int ai = 0; ai < 2; ++ai)
#pragma unroll
            for (int m = 0; m < 4; ++m) {
                float o[8];
#pragma unroll
                for (int n = 0; n < 2; ++n)
#pragma unroll
                    for (int j = 0; j < 4; ++j) { const float g = acc[ai][0][m][n][j]; o[n * 4 + j] = g * fast_rcp(1.0f + __expf(-g)) * acc[ai][1][m][n][j]; }
                *(u32x4*)(G + (size_t)(row0 + ai * 128 + m * 16) * DFF + col0) = pack8(o);
            }
    }
};
struct EpiResid {
    static constexpr bool PERM = false, AFTER_DRAIN = false;
    const void* xin; bf16_t* xout; const float* gate; float coef; int xf32;
    __device__ __forceinline__ void operator()(const pg8::f32x4 (&acc)[2][2][4][2], const pg8::Unit& u, int wr, int wc, int fr, int fq) const {
        const int row0 = u.pm * 256 + wr * 64 + fr, col0 = u.pn * 256 + wc * 32 + 4 * fq, b = u.pm >> 4;
        f32x4 gv[2][2];
#pragma unroll
        for (int bj = 0; bj < 2; ++bj)
#pragma unroll
            for (int n = 0; n < 2; ++n) gv[bj][n] = (*(const f32x4*)(gate + (size_t)b * NMOD + col0 + bj * 128 + n * 16) + 1.0f) * coef;
#pragma unroll
        for (int ai = 0; ai < 2; ++ai) {
            if (xf32) {
                const float* xi = (const float*)xin;
                f32x4 xv[4][2][2];
#pragma unroll
                for (int m = 0; m < 4; ++m)
#pragma unroll
                    for (int bj = 0; bj < 2; ++bj)
#pragma unroll
                        for (int n = 0; n < 2; ++n) xv[m][bj][n] = *(const f32x4*)(xi + (size_t)(row0 + ai * 128 + m * 16) * DM + col0 + bj * 128 + n * 16);
#pragma unroll
                for (int m = 0; m < 4; ++m)
#pragma unroll
                    for (int bj = 0; bj < 2; ++bj)
#pragma unroll
                        for (int n = 0; n < 2; ++n) {
                            const f32x4 r = xv[m][bj][n] + gv[bj][n] * acc[ai][bj][m][n];
                            u32x2 w; w.x = pk_bf16(r[0], r[1]); w.y = pk_bf16(r[2], r[3]);
                            *(u32x2*)(xout + (size_t)(row0 + ai * 128 + m * 16) * DM + col0 + bj * 128 + n * 16) = w;
                        }
            } else {
                const bf16_t* xi = (const bf16_t*)xin;
                u32x2 xw[4][2][2];
#pragma unroll
                for (int m = 0; m < 4; ++m)
#pragma unroll
                    for (int bj = 0; bj < 2; ++bj)
#pragma unroll
                        for (int n = 0; n < 2; ++n) xw[m][bj][n] = *(const u32x2*)(xi + (size_t)(row0 + ai * 128 + m * 16) * DM + col0 + bj * 128 + n * 16);
#pragma unroll
                for (int m = 0; m < 4; ++m)
#pragma unroll
                    for (int bj = 0; bj < 2; ++bj)
#pragma unroll
                        for (int n = 0; n < 2; ++n) {
                            const f32x4 xv = (f32x4){bflo(xw[m][bj][n].x), bfhi(xw[m][bj][n].x), bflo(xw[m][bj][n].y), bfhi(xw[m][bj][n].y)};
                            const f32x4 r = xv + gv[bj][n] * acc[ai][bj][m][n];
                            u32x2 w; w.x = pk_bf16(r[0], r[1]); w.y = pk_bf16(r[2], r[3]);
                            *(u32x2*)(xout + (size_t)(row0 + ai * 128 + m * 16) * DM + col0 + bj * 128 + n * 16) = w;
                        }
            }
        }
    }
};
struct EpiFinal {
    static constexpr bool PERM = false, AFTER_DRAIN = false;
    const bf16_t* xin; float* out; const float* gate; float coef; const float* fn; float* part; unsigned* flags; unsigned* bar0; LAS float* spare;
    __device__ __forceinline__ void operator()(const pg8::f32x4 (&acc_)[2][2][4][2], const pg8::Unit& u, int wr, int wc, int fr, int fq) const {
        pg8::f32x4 (&acc)[2][2][4][2] = const_cast<pg8::f32x4 (&)[2][2][4][2]>(acc_);
        const int row0 = u.pm * 256 + wr * 64 + fr, col0 = u.pn * 256 + wc * 32 + 4 * fq, b = u.pm >> 4, tid = ltid();
        f32x4 gv[2][2];
#pragma unroll
        for (int bj = 0; bj < 2; ++bj)
#pragma unroll
            for (int n = 0; n < 2; ++n) gv[bj][n] = (*(const f32x4*)(gate + (size_t)b * NMOD + col0 + bj * 128 + n * 16) + 1.0f) * coef;
#pragma unroll
        for (int ai = 0; ai < 2; ++ai) {
            u32x2 xw[4][2][2];
#pragma unroll
            for (int m = 0; m < 4; ++m)
#pragma unroll
                for (int bj = 0; bj < 2; ++bj)
#pragma unroll
                    for (int n = 0; n < 2; ++n) xw[m][bj][n] = *(const u32x2*)(xin + (size_t)(row0 + ai * 128 + m * 16) * DM + col0 + bj * 128 + n * 16);
#pragma unroll
            for (int m = 0; m < 4; ++m) {
                float sq = 0.f;
#pragma unroll
                for (int bj = 0; bj < 2; ++bj)
#pragma unroll
                    for (int n = 0; n < 2; ++n) {
                        const f32x4 xv = (f32x4){bflo(xw[m][bj][n].x), bfhi(xw[m][bj][n].x), bflo(xw[m][bj][n].y), bfhi(xw[m][bj][n].y)};
                        const f32x4 r = xv + gv[bj][n] * acc[ai][bj][m][n];
                        acc[ai][bj][m][n] = r;
                        sq += r[0] * r[0] + r[1] * r[1] + r[2] * r[2] + r[3] * r[3];
                    }
                sq += __int_as_float(__builtin_amdgcn_ds_bpermute(((tid & 63) ^ 16) << 2, __float_as_int(sq))); sq += __int_as_float(__builtin_amdgcn_ds_bpermute(((tid & 63) ^ 32) << 2, __float_as_int(sq)));
                if (fq == 0) spare[wc * 256 + wr * 64 + fr + ai * 128 + m * 16] = sq;
            }
        }
        __syncthreads();
        if (tid < 256) __hip_atomic_store(part + (size_t)(u.pm * 256 + tid) * 8 + u.pn, (spare[tid] + spare[256 + tid]) + (spare[512 + tid] + spare[768 + tid]), __ATOMIC_RELAXED, __HIP_MEMORY_SCOPE_AGENT);
        asm volatile("s_waitcnt vmcnt(0)" ::: "memory");
        __syncthreads();
        if (threadIdx.x == 0) {
            (void)xb_add(flags + u.pm, 1u);
            XB_SPIN(xb_ld(flags + u.pm) < 8u, bar0);
        }
        __syncthreads();
        if (tid < 256) {
            const float* pr = part + (size_t)(u.pm * 256 + tid) * 8;
            float t = 0.f;
#pragma unroll
            for (int j = 0; j < 8; ++j) t += __hip_atomic_load(pr + j, __ATOMIC_RELAXED, __HIP_MEMORY_SCOPE_AGENT);
            spare[1024 + tid] = rsqrtf(t * (1.0f / DM) + 1e-6f);
        }
        __syncthreads();
        f32x4 fv[2][2];
#pragma unroll
        for (int bj = 0; bj < 2; ++bj)
#pragma unroll
            for (int n = 0; n < 2; ++n) fv[bj][n] = *(const f32x4*)(fn + col0 + bj * 128 + n * 16);
#pragma unroll
        for (int ai = 0; ai < 2; ++ai)
#pragma unroll
            for (int m = 0; m < 4; ++m) {
                const size_t row = (size_t)(row0 + ai * 128 + m * 16);
                const float rstd = spare[1024 + wr * 64 + fr + ai * 128 + m * 16];
#pragma unroll
                for (int bj = 0; bj < 2; ++bj)
#pragma unroll
                    for (int n = 0; n < 2; ++n) *(f32x4*)(out + row * DM + col0 + bj * 128 + n * 16) = acc[ai][bj][m][n] * rstd * fv[bj][n];
            }
    }
};
struct EpiU {
    static constexpr bool PERM = true, AFTER_DRAIN = false;
    bf16_t* U;
    __device__ __forceinline__ void operator()(const pg8::f32x4 (&acc)[2][2][4][2], const pg8::Unit& u, int wr, int wc, int fr, int fq) const {
        const int row0 = u.pm * 256 + wr * 64 + fr, col0 = u.pn * 256 + wc * 32 + 8 * fq;
#pragma unroll
        for (int ai = 0; ai < 2; ++ai)
#pragma unroll
            for (int m = 0; m < 4; ++m)
#pragma unroll
                for (int bj = 0; bj < 2; ++bj) {
                    u32x4 w; w.x = pk_bf16(acc[ai][bj][m][0][0], acc[ai][bj][m][0][1]); w.y = pk_bf16(acc[ai][bj][m][0][2], acc[ai][bj][m][0][3]);
                    w.z = pk_bf16(acc[ai][bj][m][1][0], acc[ai][bj][m][1][1]); w.w = pk_bf16(acc[ai][bj][m][1][2], acc[ai][bj][m][1][3]);
                    *(u32x4*)(U + (size_t)(row0 + ai * 128 + m * 16) * LDU + col0 + bj * 128) = w;
                }
    }
};

__device__ __forceinline__ void p1_rw_lora(KP P, int l, LAS unsigned char* lds, int w, int nw) {
    const int tid = ltid(), lane = tid & 63, wave = tid >> 6, fq = lane >> 4, fr = lane & 15, half = w & 1;
    const bf16_t* U = (const bf16_t*)(P->ws + WS_U);
    float* RWW = (float*)(P->ws + WS_RWW); bf16_t* RWA = (bf16_t*)(P->ws + WS_RWA); bf16_t* RWG = (bf16_t*)(P->ws + WS_RWG);
    constexpr int O_WT = 0, O_ACT = 256 * 168 * 2, LDW = 168;
    const float* mu = P->in[I_RWMU] + l * RW_IN + 1536;
    __syncthreads();
    {
        const bf16_t* LT = (const bf16_t*)(P->ws + WS_LORAT) + (size_t)(l * 512 + half * 256) * 160;
#pragma unroll 2
        for (int e = tid; e < 256 * 20; e += NTHR) { const int ch = e / 20, c = e % 20; *(LAS u32x4*)(lds + O_WT + (ch * LDW + c * 8) * 2) = *(const u32x4*)(LT + (size_t)ch * 160 + c * 8); }
    }
    float w0[2], a0[2];
#pragma unroll
    for (int q = 0; q < 2; ++q) { const int ch = half * 256 + (wave * 2 + q) * 16 + fr; w0[q] = P->in[I_RWW0][l * 512 + ch]; a0[q] = P->in[I_RWA0][l * 512 + ch]; }
    u32x4 pc[3], pp[3];
#define LORA_PREFETCH(tt_) do { _Pragma("unroll") for (int i = 0; i < 3; ++i) { const int e_ = tid + i * NTHR; if (e_ < 1280) { const int tk_ = e_ / 20, c_ = e_ % 20, tok_ = (tt_) * 64 + tk_; \
        const bf16_t* uc_ = U + (size_t)tok_ * LDU + U_RW_WD + c_ * 8; pc[i] = *(const u32x4*)uc_; pp[i] = *(const u32x4*)((tok_ & (SEQ - 1)) ? uc_ - LDU : uc_); } } } while (0)
    const int tstep = nw >> 1;
    if ((w >> 1) < NTOK / 64) LORA_PREFETCH(w >> 1);
    for (int tt = w >> 1; tt < NTOK / 64; tt += tstep) {
        const int tok0 = tt * 64;
        __syncthreads();
#pragma unroll
        for (int i = 0; i < 3; ++i) {
            const int e = tid + i * NTHR;
            if (e < 1280) {
                const int tk = e / 20, c = e % 20, tok = tok0 + tk;
                float cur[8], prv[8], av[8]; unpack8(pc[i], cur); unpack8(pp[i], prv);
                const float pf = (tok & (SEQ - 1)) ? 1.0f : 0.0f;
                const f32x4 m0 = *(const f32x4*)(mu + c * 8), m1 = *(const f32x4*)(mu + c * 8 + 4);
#pragma unroll
                for (int j = 0; j < 8; ++j) {
                    const float v = cur[j] + (prv[j] * pf - cur[j]) * ((j < 4) ? m0[j & 3] : m1[j & 3]);
                    av[j] = (c < 4) ? tanhf_(v) : ((c < 8) ? v : sigmoidf_(v));
                }
                *(LAS u32x4*)(lds + O_ACT + (tk * LDW + c * 8) * 2) = pack8(av);
            }
        }
        if (tt + tstep < NTOK / 64) LORA_PREFETCH(tt + tstep);
        __syncthreads();
#pragma unroll
        for (int q = 0; q < 2; ++q) {
            const int nrow = (wave * 2 + q) * 16 + fr;
            const bf16x8 bw = *(const LAS bf16x8*)(lds + O_WT + (nrow * LDW + fq * 8) * 2), ba = *(const LAS bf16x8*)(lds + O_WT + (nrow * LDW + 32 + fq * 8) * 2);
            const bf16x8 bg0 = *(const LAS bf16x8*)(lds + O_WT + (nrow * LDW + 64 + fq * 8) * 2), bg1 = *(const LAS bf16x8*)(lds + O_WT + (nrow * LDW + 96 + fq * 8) * 2), bg2 = *(const LAS bf16x8*)(lds + O_WT + (nrow * LDW + 128 + fq * 8) * 2);
            const int ch = half * 256 + (wave * 2 + q) * 16 + fr;
#pragma unroll
            for (int mi = 0; mi < 4; ++mi) {
                const int arow = mi * 16 + fr;
                const bf16x8 aw = *(const LAS bf16x8*)(lds + O_ACT + (arow * LDW + fq * 8) * 2), aa = *(const LAS bf16x8*)(lds + O_ACT + (arow * LDW + 32 + fq * 8) * 2);
                const bf16x8 ag0 = *(const LAS bf16x8*)(lds + O_ACT + (arow * LDW + 64 + fq * 8) * 2), ag1 = *(const LAS bf16x8*)(lds + O_ACT + (arow * LDW + 96 + fq * 8) * 2), ag2 = *(const LAS bf16x8*)(lds + O_ACT + (arow * LDW + 128 + fq * 8) * 2);
                const f32x4 z = (f32x4){0.f, 0.f, 0.f, 0.f};
                const f32x4 cw = __builtin_amdgcn_mfma_f32_16x16x32_bf16(aw, bw, z, 0, 0, 0);
                const f32x4 ca = __builtin_amdgcn_mfma_f32_16x16x32_bf16(aa, ba, z, 0, 0, 0);
                f32x4 cg = __builtin_amdgcn_mfma_f32_16x16x32_bf16(ag0, bg0, z, 0, 0, 0);
                cg = __builtin_amdgcn_mfma_f32_16x16x32_bf16(ag1, bg1, cg, 0, 0, 0);
                cg = __builtin_amdgcn_mfma_f32_16x16x32_bf16(ag2, bg2, cg, 0, 0, 0);
#pragma unroll
                for (int rg = 0; rg < 4; ++rg) {
                    const size_t o = (size_t)(tok0 + mi * 16 + fq * 4 + rg) * 512 + ch;
                    const float wlog = -softplusf_(-(w0[q] + cw[rg])) - 0.5f;
                    RWW[o] = __expf(-__expf(wlog));
                    RWA[o] = (bf16_t)(pk_bf16(sigmoidf_(a0[q] + ca[rg]), 0.f) & 0xffffu);
                    RWG[o] = (bf16_t)(pk_bf16(cg[rg], 0.f) & 0xffffu);
                }
            }
        }
    }
}

#undef LORA_PREFETCH
__device__ __forceinline__ void p1_lru_prep(KP P, int l, LAS unsigned char* lds, int wg, int nwg) {
    const int tid = ltid(), lane = tid & 63, wave = tid >> 6;
    const bf16_t* U = (const bf16_t*)(P->ws + WS_U);
    float* LA = (float*)(P->ws + WS_LRUA); float* LB = (float*)(P->ws + WS_LRUB);
    constexpr int O_WA = 0, O_WX = 34816, O_XC = 69632, O_XF = 87040;
    const int n = wg & 3;
    __syncthreads();
    {
        const bf16_t* wa = (const bf16_t*)(P->ws + WS_LRUW) + (size_t)((l * 2 + 0) * 4 + n) * 16384;
        const bf16_t* wx = (const bf16_t*)(P->ws + WS_LRUW) + (size_t)((l * 2 + 1) * 4 + n) * 16384;
#pragma unroll
        for (int e4 = 0; e4 < 4; ++e4) {
            const int e = tid + e4 * NTHR, j = e >> 4, i8 = (e & 15) * 8;
            *(LAS u32x4*)(lds + O_WA + (j * 136 + i8) * 2) = *(const u32x4*)(wa + j * 128 + i8);
            *(LAS u32x4*)(lds + O_WX + (j * 136 + i8) * 2) = *(const u32x4*)(wx + j * 128 + i8);
        }
    }
    const int jloc = wave * 16 + (lane & 15), cg = n * 128 + jloc, fq = lane >> 4;
    const float ba = P->in[I_LRUBA][l * 512 + cg], bx = P->in[I_LRUBX][l * 512 + cg], sp8 = 8.0f * softplusf_(-P->in[I_LRULAM][l * 512 + cg]);
    const int tk = tid >> 3, c16 = (tid & 7) * 16;
    const float* cw = P->in[I_LRUCW] + l * 2048 + n * 128 + c16;
    const float* cb = P->in[I_LRUCB] + l * 512 + n * 128 + c16;
    u32x4 pr[4][2];
#define LRU_PREFETCH(tt_) do { const int tok_ = (tt_) * 64 + tk, ts_ = tok_ & (SEQ - 1); _Pragma("unroll") for (int jj = 0; jj < 4; ++jj) { \
        const bf16_t* up_ = U + (size_t)(((ts_ - 3 + jj) >= 0) ? tok_ - 3 + jj : tok_) * LDU + U_LRU_X + n * 128 + c16; pr[jj][0] = *(const u32x4*)up_; pr[jj][1] = *(const u32x4*)(up_ + 8); } } while (0)
    const int tstep = nwg >> 2;
    if ((wg >> 2) < NTOK / 64) LRU_PREFETCH(wg >> 2);
    for (int tt = wg >> 2; tt < NTOK / 64; tt += tstep) {
        const int tok0 = tt * 64, tok = tok0 + tk, tseq = tok & (SEQ - 1);
        float xc[16];
#pragma unroll
        for (int q = 0; q < 4; ++q) { const f32x4 c = *(const f32x4*)(cb + q * 4); xc[q * 4 + 0] = c[0]; xc[q * 4 + 1] = c[1]; xc[q * 4 + 2] = c[2]; xc[q * 4 + 3] = c[3]; }
#pragma unroll
        for (int jj = 0; jj < 4; ++jj) {
            const bool valid = (tseq - 3 + jj) >= 0;
            float x[16]; { float t0[8], t1[8]; unpack8(pr[jj][0], t0); unpack8(pr[jj][1], t1);
#pragma unroll
                for (int j = 0; j < 8; ++j) { x[j] = t0[j]; x[8 + j] = t1[j]; } }
            const float vf = valid ? 1.0f : 0.0f;
#pragma unroll
            for (int q = 0; q < 4; ++q) { const f32x4 w = *(const f32x4*)(cw + jj * 512 + q * 4);
                xc[q * 4 + 0] += vf * w[0] * x[q * 4 + 0]; xc[q * 4 + 1] += vf * w[1] * x[q * 4 + 1]; xc[q * 4 + 2] += vf * w[2] * x[q * 4 + 2]; xc[q * 4 + 3] += vf * w[3] * x[q * 4 + 3]; }
        }
        __syncthreads();
        {
            float a8[8], b8[8];
#pragma unroll
            for (int j = 0; j < 8; ++j) { a8[j] = xc[j]; b8[j] = xc[8 + j]; }
            *(LAS u32x4*)(lds + O_XC + (tk * 136 + c16) * 2) = pack8(a8);
            *(LAS u32x4*)(lds + O_XC + (tk * 136 + c16 + 8) * 2) = pack8(b8);
#pragma unroll
            for (int q = 0; q < 4; ++q) *(LAS f32x4*)(lds + O_XF + (tk * 132 + c16 + q * 4) * 4) = (f32x4){xc[q * 4], xc[q * 4 + 1], xc[q * 4 + 2], xc[q * 4 + 3]};
        }
        __syncthreads();
        if (tt + tstep < NTOK / 64) LRU_PREFETCH(tt + tstep);
        f32x4 accA[4], accX[4];
#pragma unroll
        for (int mi = 0; mi < 4; ++mi) { accA[mi] = (f32x4){0.f, 0.f, 0.f, 0.f}; accX[mi] = (f32x4){0.f, 0.f, 0.f, 0.f}; }
#pragma unroll
        for (int kk = 0; kk < 4; ++kk) {
            const bf16x8 fa = *(const LAS bf16x8*)(lds + O_WA + (jloc * 136 + kk * 32 + fq * 8) * 2);
            const bf16x8 fx = *(const LAS bf16x8*)(lds + O_WX + (jloc * 136 + kk * 32 + fq * 8) * 2);
#pragma unroll
            for (int mi = 0; mi < 4; ++mi) {
                const bf16x8 xa = *(const LAS bf16x8*)(lds + O_XC + ((mi * 16 + (lane & 15)) * 136 + kk * 32 + fq * 8) * 2);
                accA[mi] = __builtin_amdgcn_mfma_f32_16x16x32_bf16(xa, fa, accA[mi], 0, 0, 0);
                accX[mi] = __builtin_amdgcn_mfma_f32_16x16x32_bf16(xa, fx, accX[mi], 0, 0, 0);
            }
        }
#pragma unroll
        for (int mi = 0; mi < 4; ++mi)
#pragma unroll
            for (int rg = 0; rg < 4; ++rg) {
                const int t = mi * 16 + fq * 4 + rg;
                const float xv = *(const LAS float*)(lds + O_XF + (t * 132 + jloc) * 4);
                const float r = sigmoidf_(accA[mi][rg] + ba), ig = sigmoidf_(accX[mi][rg] + bx);
                const float la = -r * sp8;
                const size_t o = (size_t)(tok0 + t) * 512 + cg;
                LA[o] = __expf(la);
                LB[o] = sqrtf(fmaxf(-expm1f(2.0f * la), 0.0f)) * (ig * xv);
            }
    }
}

#undef LRU_PREFETCH
__device__ __forceinline__ bf16x8 rw_op16(LAS unsigned char* lds, int off) { return *(const LAS bf16x8*)(lds + off); }
__device__ __forceinline__ bf16x8 rw_op8x2(LAS unsigned char* lds, int off0, int off1) { const u32x2 lo = *(const LAS u32x2*)(lds + off0), hi = *(const LAS u32x2*)(lds + off1); const u32x4 w = (u32x4){lo.x, lo.y, hi.x, hi.y}; return __builtin_bit_cast(bf16x8, w); }
__device__ __forceinline__ bf16x8 rw_accop(const f32x4 a, const f32x4 b) { u32x4 w; w.x = pk_bf16(a[0], a[1]); w.y = pk_bf16(a[2], a[3]); w.z = pk_bf16(b[0], b[1]); w.w = pk_bf16(b[2], b[3]); return __builtin_bit_cast(bf16x8, w); }
#define RW_MFMA(a, b, c) __builtin_amdgcn_mfma_f32_16x16x32_bf16(a, b, c, 0, 0, 0)
__device__ __forceinline__ void p2_rw(KP P, int l, int item, LAS unsigned char* lds) {
    const int tid = ltid(), lane = tid & 63, wave = tid >> 6, b = item >> 3, h = item & 7;
    const int fr = lane & 15, fq = lane >> 4, st = tid >> 3, sc = (tid & 7) * 8;
    const bf16_t* U = (const bf16_t*)(P->ws + WS_U);
    const float* RWW = (const float*)(P->ws + WS_RWW); const bf16_t* RWA = (const bf16_t*)(P->ws + WS_RWA); const bf16_t* RWG = (const bf16_t*)(P->ws + WS_RWG);
    bf16_t* Y = (bf16_t*)(P->ws + WS_HY);
    LAS float* F = LDSF(0);
    constexpr int CN = 0, WC = 512, TOT = 4608, LD = 4864;
    constexpr int XD = 23552, AT = 25600, RT = AT + 9216, BT = RT + 9216, KT = BT + 9216, BTT = KT + 9216, KTT = BTT + 9216, VT = KTT + 9216, GAB = VT + 9216, GAK = GAB + 9216, GRB = GAK + 9216, GRK = GRB + 9216, OO = GRK + 9216;
    __syncthreads();
    {
        const int kind = tid >> 6, c = tid & 63; float v;
        if (kind < 3) v = P->in[I_RWMU][l * RW_IN + kind * 512 + h * 64 + c];
        else if (kind == 3) v = P->in[I_RWKK][l * 512 + h * 64 + c];
        else if (kind == 4) v = P->in[I_RWKA][l * 512 + h * 64 + c];
        else if (kind == 5) v = P->in[I_RWRK][l * 512 + h * 64 + c];
        else if (kind == 6) v = P->in[I_RWLNW][l * 512 + h * 64 + c];
        else v = P->in[I_RWLNB][l * 512 + h * 64 + c];
        F[CN + kind * 64 + c] = v;
        for (int e = tid; e < 4 * 9216 / 16; e += NTHR) *(LAS u32x4*)(lds + GAB + e * 16) = (u32x4){0u, 0u, 0u, 0u};
    }
    __syncthreads();
    f32x4 ST[4];
#pragma unroll
    for (int j = 0; j < 4; ++j) ST[j] = (f32x4){0.f, 0.f, 0.f, 0.f};
    u32x4 pr_c, pk_c, pv_c, pr_p, pk_p, pv_p, pa, pg; f32x4 pw0, pw1; float pflag;
#define RW_IDS const int tid = ltid(), lane = tid & 63, wave = tid >> 6, fr = lane & 15, fq = lane >> 4, st = tid >> 3, sc = (tid & 7) * 8; (void)lane; (void)wave; (void)fr; (void)fq; (void)st; (void)sc;
#define RW_PREFETCH(ch) do { RW_IDS const int tk_ = b * SEQ + (ch) * 64 + st; const bool first_ = ((ch) == 0 && st == 0); \
        const bf16_t* uc_ = U + (size_t)tk_ * LDU + h * 64 + sc; const bf16_t* up_ = first_ ? uc_ : uc_ - LDU; pflag = first_ ? 0.f : 1.f; \
        pr_c = *(const u32x4*)(uc_ + U_RW_R); pk_c = *(const u32x4*)(uc_ + U_RW_K); pv_c = *(const u32x4*)(uc_ + U_RW_V); \
        pr_p = *(const u32x4*)(up_ + U_RW_R); pk_p = *(const u32x4*)(up_ + U_RW_K); pv_p = *(const u32x4*)(up_ + U_RW_V); \
        const size_t o_ = (size_t)tk_ * 512 + h * 64 + sc; pw0 = *(const f32x4*)(RWW + o_); pw1 = *(const f32x4*)(RWW + o_ + 4); pa = *(const u32x4*)(RWA + o_); pg = *(const u32x4*)(RWG + o_); } while (0)
    RW_PREFETCH(0);
    for (int ch = 0; ch < SEQ / 64; ++ch) {
        u32x4 cg, cvp; float bsum = 0.f;
        {   RW_IDS
        {
        float wt[8];
        {
            wt[0] = pw0[0]; wt[1] = pw0[1]; wt[2] = pw0[2]; wt[3] = pw0[3]; wt[4] = pw1[0]; wt[5] = pw1[1]; wt[6] = pw1[2]; wt[7] = pw1[3];
            const int sl = lane >> 3;
#pragma unroll
            for (int d = 1; d < 8; d <<= 1) {
#pragma unroll
                for (int j = 0; j < 8; ++j) { const float o = __shfl_up(wt[j], 8 * d); if (sl >= d) wt[j] *= o; }
            }
            if (sl == 7) { *(LAS f32x4*)(F + TOT + wave * 64 + sc) = (f32x4){wt[0], wt[1], wt[2], wt[3]}; *(LAS f32x4*)(F + TOT + wave * 64 + sc + 4) = (f32x4){wt[4], wt[5], wt[6], wt[7]}; }
        }
        __syncthreads();
        {
            f32x4 b0 = (f32x4){1.f, 1.f, 1.f, 1.f}, b1 = b0;
            for (int wv = 0; wv < wave; ++wv) { b0 *= *(const LAS f32x4*)(F + TOT + wv * 64 + sc); b1 *= *(const LAS f32x4*)(F + TOT + wv * 64 + sc + 4); }
#pragma unroll
            for (int j = 0; j < 4; ++j) { wt[j] *= b0[j]; wt[4 + j] *= b1[j]; }
            *(LAS f32x4*)(F + WC + st * 64 + sc) = (f32x4){wt[0], wt[1], wt[2], wt[3]}; *(LAS f32x4*)(F + WC + st * 64 + sc + 4) = (f32x4){wt[4], wt[5], wt[6], wt[7]};
        }
        }
        float r[8], v[8], ma[8], bv[8], kp[8];
        cg = pg;
        {
            float k[8], a[8];
            {
                float c[8], p[8], m[8];
                unpack8(pr_c, c); unpack8(pr_p, p);
#pragma unroll
                for (int j = 0; j < 8; ++j) m[j] = F[CN + 0 * 64 + sc + j];
#pragma unroll
                for (int j = 0; j < 8; ++j) r[j] = c[j] + (p[j] * pflag - c[j]) * m[j];
                unpack8(pk_c, c); unpack8(pk_p, p);
#pragma unroll
                for (int j = 0; j < 8; ++j) m[j] = F[CN + 1 * 64 + sc + j];
#pragma unroll
                for (int j = 0; j < 8; ++j) k[j] = c[j] + (p[j] * pflag - c[j]) * m[j];
                unpack8(pv_c, c); unpack8(pv_p, p);
#pragma unroll
                for (int j = 0; j < 8; ++j) m[j] = F[CN + 2 * 64 + sc + j];
#pragma unroll
                for (int j = 0; j < 8; ++j) v[j] = c[j] + (p[j] * pflag - c[j]) * m[j];
                unpack8(pa, a);
            }
            float ss = 0.f, kkv[8];
#pragma unroll
            for (int j = 0; j < 8; ++j) { kkv[j] = k[j] * F[CN + 3 * 64 + sc + j]; ss += kkv[j] * kkv[j]; }
            ss = red8(ss);
            const float inv = 1.0f / fmaxf(sqrtf(ss + 1e-12f), 1e-6f);
#pragma unroll
            for (int j = 0; j < 8; ++j) {
                const float kn = kkv[j] * inv;
                kp[j] = k[j] * (1.0f + (a[j] - 1.0f) * F[CN + 4 * 64 + sc + j]);
                ma[j] = -kn; bv[j] = kn * a[j];
                bsum += r[j] * kp[j] * F[CN + 5 * 64 + sc + j];
            }
            bsum = red8(bsum);
        }
        {
#pragma unroll
            for (int j = 0; j < 8; j += 2) {
                const unsigned pw = pk_bf16(v[j], v[j + 1]);
                *(LAS bf16_t*)(lds + VT + ((sc + j) * 72 + st) * 2) = (bf16_t)(pw & 0xffffu);
                *(LAS bf16_t*)(lds + VT + ((sc + j + 1) * 72 + st) * 2) = (bf16_t)(pw >> 16);
            }
        }
        cvp = pack8(v);
        {
            float al[8], be[8], ka[8], rh[8];
            const f32x4 wa0 = *(const LAS f32x4*)(F + WC + st * 64 + sc), wa1 = *(const LAS f32x4*)(F + WC + st * 64 + sc + 4);
#pragma unroll
            for (int j = 0; j < 8; ++j) {
                const float wtj = (j < 4) ? wa0[j & 3] : wa1[j & 3];
                const float w1 = (j < 4) ? pw0[j & 3] : pw1[j & 3], iw = fast_rcp(wtj), wp = wtj * fast_rcp(w1);
                al[j] = ma[j] * wp; be[j] = bv[j] * iw; ka[j] = kp[j] * iw; rh[j] = r[j] * wtj;
            }
            const u32x4 qa = pack8(al), qb = pack8(be), qk = pack8(ka), qr = pack8(rh);
            *(LAS u32x4*)(lds + AT + (st * 72 + sc) * 2) = qa; *(LAS u32x4*)(lds + RT + (st * 72 + sc) * 2) = qr;
            *(LAS u32x4*)(lds + BT + (st * 72 + sc) * 2) = qb; *(LAS u32x4*)(lds + KT + (st * 72 + sc) * 2) = qk;
#pragma unroll
            for (int j = 0; j < 8; ++j) {
                const unsigned wb = qb[j >> 1], wk = qk[j >> 1];
                *(LAS bf16_t*)(lds + BTT + ((sc + j) * 72 + st) * 2) = (bf16_t)((j & 1) ? (wb >> 16) : (wb & 0xffffu));
                *(LAS bf16_t*)(lds + KTT + ((sc + j) * 72 + st) * 2) = (bf16_t)((j & 1) ? (wk >> 16) : (wk & 0xffffu));
            }
        }
        }
        __syncthreads();
        if (ch + 1 < SEQ / 64) RW_PREFETCH(ch + 1);
        {   RW_IDS
            const int m = wave >> 1;
            const int ta = (m < 2) ? AT : RT, tb = (m & 1) ? KT : BT, tg = GAB + m * 9216;
#pragma unroll
            for (int e = 0; e < 5; ++e) {
                int ti, ji;
                if (wave & 1) { ti = (e < 2) ? 1 : 2; ji = (e < 2) ? e : e - 2; } else { ti = (e < 1) ? 0 : 3; ji = (e < 1) ? 0 : e - 1; }
                f32x4 g = (f32x4){0.f, 0.f, 0.f, 0.f};
#pragma unroll
                for (int kk = 0; kk < 2; ++kk) g = RW_MFMA(rw_op16(lds, ta + ((ti * 16 + fr) * 72 + kk * 32 + fq * 8) * 2), rw_op16(lds, tb + ((ji * 16 + fr) * 72 + kk * 32 + fq * 8) * 2), g);
#pragma unroll
                for (int rg = 0; rg < 4; ++rg) {
                    const int t = ti * 16 + fq * 4 + rg, j = ji * 16 + fr;
                    const bool keep = (m >= 2) ? (j <= t) : (j < t);
                    const float val = keep ? g[rg] : 0.f;
                    *(LAS bf16_t*)(lds + tg + (t * 72 + j) * 2) = (bf16_t)(pk_bf16(val, 0.f) & 0xffffu);
                    if (m == 0 && ti == ji) F[LD + ti * 256 + (fq * 4 + rg) * 16 + fr] = val;
                }
            }
        }
        __syncthreads();
        f32x4 Yc[4]; bf16x8 s0b[2], vtb[2];
        {   RW_IDS
        if (wave == 4) {
            const int c = lane >> 4, col = lane & 15;
            float x[16];
#pragma unroll
            for (int t = 0; t < 16; ++t) {
                float acc = (t == col) ? 1.0f : 0.0f, acc1 = 0.f;
#pragma unroll
                for (int j = 0; j < t; ++j) { if (j & 1) acc1 += F[LD + c * 256 + t * 16 + j] * x[j]; else acc += F[LD + c * 256 + t * 16 + j] * x[j]; }
                acc += acc1;
                x[t] = acc;
                __builtin_amdgcn_sched_barrier(0);
                *(LAS bf16_t*)(lds + XD + ((c * 16 + t) * 16 + col) * 2) = (bf16_t)(pk_bf16(acc, 0.f) & 0xffffu);
            }
        }
        if (wave < 4) {
#pragma unroll
            for (int kk = 0; kk < 2; ++kk) { s0b[kk] = rw_accop(ST[2 * kk], ST[2 * kk + 1]); vtb[kk] = rw_op16(lds, VT + ((wave * 16 + fr) * 72 + kk * 32 + fq * 8) * 2); }
#pragma unroll
            for (int c = 0; c < 4; ++c) {
                const int row = c * 16 + fr;
                f32x4 y = (f32x4){0.f, 0.f, 0.f, 0.f};
#pragma unroll
                for (int kk = 0; kk < 2; ++kk) y = RW_MFMA(rw_op8x2(lds, AT + (row * 72 + kk * 32 + fq * 4) * 2, AT + (row * 72 + kk * 32 + 16 + fq * 4) * 2), s0b[kk], y);
                y = RW_MFMA(rw_op16(lds, GAK + (row * 72 + fq * 8) * 2), vtb[0], y);
                if (c >= 2) y = RW_MFMA(rw_op16(lds, GAK + (row * 72 + 32 + fq * 8) * 2), vtb[1], y);
                Yc[c] = y;
            }
        }
        }
        __syncthreads();
        {   RW_IDS
        if (wave < 4) {
            const f32x4 z4 = (f32x4){0.f, 0.f, 0.f, 0.f};
#define RW_XOP(c) __builtin_bit_cast(bf16x8, (u32x4){(*(const LAS u32x2*)(lds + XD + (((c) * 16 + fr) * 16 + fq * 4) * 2)).x, (*(const LAS u32x2*)(lds + XD + (((c) * 16 + fr) * 16 + fq * 4) * 2)).y, 0u, 0u})
#define RW_LOP(c, kk) rw_op8x2(lds, GAB + (((c) * 16 + fr) * 72 + (kk) * 32 + fq * 4) * 2, GAB + (((c) * 16 + fr) * 72 + (kk) * 32 + 16 + fq * 4) * 2)
            const f32x4 U0 = RW_MFMA(RW_XOP(0), rw_accop(Yc[0], z4), z4);
            const f32x4 Y1 = RW_MFMA(RW_LOP(1, 0), rw_accop(U0, z4), Yc[1]);
            const f32x4 U1 = RW_MFMA(RW_XOP(1), rw_accop(Y1, z4), z4);
            const bf16x8 ub0 = rw_accop(U0, U1);
            const f32x4 Y2 = RW_MFMA(RW_LOP(2, 0), ub0, Yc[2]);
            const f32x4 U2 = RW_MFMA(RW_XOP(2), rw_accop(Y2, z4), z4);
            f32x4 Y3 = RW_MFMA(RW_LOP(3, 0), ub0, Yc[3]);
            Y3 = RW_MFMA(RW_LOP(3, 1), rw_accop(U2, z4), Y3);
            const f32x4 U3 = RW_MFMA(RW_XOP(3), rw_accop(Y3, z4), z4);
            const bf16x8 ub1 = rw_accop(U2, U3);
#undef RW_XOP
#undef RW_LOP
            {
                f32x4 o[4];
#pragma unroll
                for (int c = 0; c < 4; ++c) o[c] = (f32x4){0.f, 0.f, 0.f, 0.f};
#pragma unroll
                for (int kk = 0; kk < 2; ++kk)
#pragma unroll
                    for (int c = 0; c < 4; ++c) o[c] = RW_MFMA(rw_op8x2(lds, RT + ((c * 16 + fr) * 72 + kk * 32 + fq * 4) * 2, RT + ((c * 16 + fr) * 72 + kk * 32 + 16 + fq * 4) * 2), s0b[kk], o[c]);
#pragma unroll
                for (int c = 0; c < 4; ++c) o[c] = RW_MFMA(rw_op8x2(lds, GRB + ((c * 16 + fr) * 72 + fq * 4) * 2, GRB + ((c * 16 + fr) * 72 + 16 + fq * 4) * 2), ub0, o[c]);
#pragma unroll
                for (int c = 0; c < 4; ++c) o[c] = RW_MFMA(rw_op16(lds, GRK + ((c * 16 + fr) * 72 + fq * 8) * 2), vtb[0], o[c]);
#pragma unroll
                for (int c = 2; c < 4; ++c) o[c] = RW_MFMA(rw_op8x2(lds, GRB + ((c * 16 + fr) * 72 + 32 + fq * 4) * 2, GRB + ((c * 16 + fr) * 72 + 48 + fq * 4) * 2), ub1, o[c]);
#pragma unroll
                for (int c = 2; c < 4; ++c) o[c] = RW_MFMA(rw_op16(lds, GRK + ((c * 16 + fr) * 72 + 32 + fq * 8) * 2), vtb[1], o[c]);
#pragma unroll
                for (int c = 0; c < 4; ++c)
#pragma unroll
                    for (int rg = 0; rg < 4; ++rg) *(LAS float*)(lds + OO + ((c * 16 + fq * 4 + rg) * 68 + wave * 16 + fr) * 4) = o[c][rg];
            }
#pragma unroll
            for (int kt = 0; kt < 4; ++kt) ST[kt] = RW_MFMA(rw_op8x2(lds, BTT + ((kt * 16 + fr) * 72 + fq * 4) * 2, BTT + ((kt * 16 + fr) * 72 + 16 + fq * 4) * 2), ub0, ST[kt]);
#pragma unroll
            for (int kt = 0; kt < 4; ++kt) ST[kt] = RW_MFMA(rw_op8x2(lds, BTT + ((kt * 16 + fr) * 72 + 32 + fq * 4) * 2, BTT + ((kt * 16 + fr) * 72 + 48 + fq * 4) * 2), ub1, ST[kt]);
#pragma unroll
            for (int kt = 0; kt < 4; ++kt) ST[kt] = RW_MFMA(rw_op16(lds, KTT + ((kt * 16 + fr) * 72 + fq * 8) * 2), vtb[0], ST[kt]);
#pragma unroll
            for (int kt = 0; kt < 4; ++kt) ST[kt] = RW_MFMA(rw_op16(lds, KTT + ((kt * 16 + fr) * 72 + 32 + fq * 8) * 2), vtb[1], ST[kt]);
#pragma unroll
            for (int kt = 0; kt < 4; ++kt) ST[kt] *= *(const LAS f32x4*)(F + WC + 63 * 64 + kt * 16 + fq * 4);
        }
        }
        __syncthreads();
        {   RW_IDS
            const f32x4 o0 = *(const LAS f32x4*)(lds + OO + (st * 68 + sc) * 4), o1 = *(const LAS f32x4*)(lds + OO + (st * 68 + sc + 4) * 4);
            float o[8] = {o0[0], o0[1], o0[2], o0[3], o1[0], o1[1], o1[2], o1[3]}, v8[8], g8[8], y8[8];
            unpack8(cvp, v8); unpack8(cg, g8);
            float sm = 0.f;
#pragma unroll
            for (int j = 0; j < 8; ++j) sm += o[j];
            const float mean = red8(sm) * (1.0f / 64.0f);
            float q = 0.f;
#pragma unroll
            for (int j = 0; j < 8; ++j) { o[j] -= mean; q += o[j] * o[j]; }
            const float rs = rsqrtf(red8(q) * (1.0f / 64.0f) + 64e-5f);
#pragma unroll
            for (int j = 0; j < 8; ++j) y8[j] = (o[j] * rs * F[CN + 6 * 64 + sc + j] + F[CN + 7 * 64 + sc + j] + bsum * v8[j]) * g8[j];
            *(u32x4*)(Y + (size_t)(b * SEQ + ch * 64 + st) * DM + 512 + h * 64 + sc) = pack8(y8);
        }
    }
#undef RW_PREFETCH
#undef RW_IDS
}
#undef RW_MFMA


__device__ __forceinline__ void p2_hg(KP P, int l, int item, LAS unsigned char* lds) {
    const int tid = ltid(), lane = tid & 63, wave = tid >> 6, b = item >> 2, h = item & 3;
    const int fr = lane & 15, fq = lane >> 4, st = tid >> 3, c16 = tid & 7, sv = c16 * 16;
    const bf16_t* U = (const bf16_t*)(P->ws + WS_U); bf16_t* Y = (bf16_t*)(P->ws + WS_HY);
    LAS float* F = LDSF(0);
    constexpr int LBO = 0, HN = 128, FF = 256, TT = 8448;
    constexpr int QB = 35840, KB = QB + 64 * 136 * 2, KT = KB + 64 * 136 * 2, VT = KT + 128 * 72 * 2, AB = VT + 128 * 72 * 2, OO = AB + 64 * 40 * 2;
    __syncthreads();
    if (tid < 128) { float lb = 0.f; if (l == 1) lb = sigmoidf_(P->in[I_HGLB][512 + h * 128 + tid] - P->in[I_HGLB][h * 128 + tid]); F[LBO + tid] = lb; F[HN + tid] = P->in[I_HGNORM][l * 512 + h * 128 + tid]; }
    __syncthreads();
    f32x4 S[8];
#pragma unroll
    for (int j = 0; j < 8; ++j) S[j] = (f32x4){0.f, 0.f, 0.f, 0.f};
    u32x4 pq0, pq1, pf0, pf1, pv0, pv1;
#define HG_IDS const int tid = ltid(), lane = tid & 63, wave = tid >> 6, fr = lane & 15, fq = lane >> 4, st = tid >> 3, c16 = tid & 7, sv = c16 * 16; (void)lane; (void)wave; (void)fr; (void)fq; (void)st; (void)c16; (void)sv;
#define HG_PREFETCH(ch) do { HG_IDS const bf16_t* ur_ = U + (size_t)(b * SEQ + (ch) * 64 + st) * LDU + h * 128; \
        pq0 = *(const u32x4*)(ur_ + U_HG_Q + c16 * 16); pq1 = *(const u32x4*)(ur_ + U_HG_Q + c16 * 16 + 8); pf0 = *(const u32x4*)(ur_ + U_HG_F + c16 * 16); pf1 = *(const u32x4*)(ur_ + U_HG_F + c16 * 16 + 8); \
        pv0 = *(const u32x4*)(ur_ + U_HG_I + sv); pv1 = *(const u32x4*)(ur_ + U_HG_I + sv + 8); } while (0)
    HG_PREFETCH(0);
    for (int ch = 0; ch < SEQ / 64; ++ch) {
        float fo[16], kx[16], qs[16];
        u32x4 cg0, cg1;
        {   HG_IDS
            { const bf16_t* ug_ = U + (size_t)(b * SEQ + ch * 64 + st) * LDU + U_HG_G + h * 128 + sv; cg0 = *(const u32x4*)ug_; cg1 = *(const u32x4*)(ug_ + 8); }
            float q[16], z[16];
            { float t0[8], t1[8]; unpack8(pq0, t0); unpack8(pq1, t1);
#pragma unroll
              for (int j = 0; j < 8; ++j) { q[j] = t0[j]; q[8 + j] = t1[j]; }
              unpack8(pf0, t0); unpack8(pf1, t1);
#pragma unroll
              for (int j = 0; j < 8; ++j) { z[j] = t0[j]; z[8 + j] = t1[j]; } }
#pragma unroll
            for (int j = 0; j < 16; ++j) {
                const float lb = F[LBO + c16 * 16 + j], e = __expf(-z[j]), sg = fast_rcp(1.0f + e);
                fo[j] = lb + (1.0f - lb) * sg; kx[j] = (1.0f - lb) * (e * sg);
                qs[j] = siluf_(q[j]);
            }
        }
        const u32x4 cv0 = pv0, cv1 = pv1;
        __syncthreads();
        {   HG_IDS
#pragma unroll
            for (int m = 0; m < 4; ++m) *(LAS f32x4*)(F + FF + st * 128 + c16 * 16 + 4 * m) = (f32x4){fo[4 * m], fo[4 * m + 1], fo[4 * m + 2], fo[4 * m + 3]};
#pragma unroll
            for (int j = 0; j < 8; ++j) {
                const unsigned w0 = cv0[j >> 1], w1 = cv1[j >> 1];
                *(LAS bf16_t*)(lds + VT + ((sv + j) * 72 + st) * 2) = (bf16_t)((j & 1) ? (w0 >> 16) : (w0 & 0xffffu));
                *(LAS bf16_t*)(lds + VT + ((sv + 8 + j) * 72 + st) * 2) = (bf16_t)((j & 1) ? (w1 >> 16) : (w1 & 0xffffu));
            }
        }
        __syncthreads();
        {   HG_IDS
            const int kk = tid & 127, w4 = tid >> 7; float c = 1.0f;
#pragma unroll 4
            for (int i = 0; i < 16; ++i) { const int ix = FF + (w4 * 16 + i) * 128 + kk; c *= F[ix]; F[ix] = c; }
            F[TT + w4 * 128 + kk] = c;
        }
        __syncthreads();
        if ((ltid() >> 7) & 1) {   HG_IDS
            const int kk = tid & 127, w4 = tid >> 7; const float m0 = F[TT + (w4 - 1) * 128 + kk];
#pragma unroll 4
            for (int i = 0; i < 16; ++i) F[FF + (w4 * 16 + i) * 128 + kk] *= m0;
        }
        __syncthreads();
        {   HG_IDS
#pragma unroll
            for (int m = 0; m < 4; ++m) {
                const f32x4 c4 = *(const LAS f32x4*)(F + FF + st * 128 + c16 * 16 + 4 * m);
                float qc[4], kc[4];
#pragma unroll
                for (int j = 0; j < 4; ++j) { const float cc = fmaxf(c4[j], 1e-30f); qc[j] = qs[4 * m + j] * cc; kc[j] = kx[4 * m + j] * fast_rcp(cc); }
                u32x2 w; w.x = pk_bf16(qc[0], qc[1]); w.y = pk_bf16(qc[2], qc[3]);
                *(LAS u32x2*)(lds + QB + (st * 136 + c16 * 16 + 4 * m) * 2) = w;
                w.x = pk_bf16(kc[0], kc[1]); w.y = pk_bf16(kc[2], kc[3]);
                *(LAS u32x2*)(lds + KB + (st * 136 + c16 * 16 + 4 * m) * 2) = w;
                *(LAS bf16_t*)(lds + KT + ((c16 * 16 + 4 * m + 0) * 72 + st) * 2) = (bf16_t)(w.x & 0xffffu);
                *(LAS bf16_t*)(lds + KT + ((c16 * 16 + 4 * m + 1) * 72 + st) * 2) = (bf16_t)(w.x >> 16);
                *(LAS bf16_t*)(lds + KT + ((c16 * 16 + 4 * m + 2) * 72 + st) * 2) = (bf16_t)(w.y & 0xffffu);
                *(LAS bf16_t*)(lds + KT + ((c16 * 16 + 4 * m + 3) * 72 + st) * 2) = (bf16_t)(w.y >> 16);
            }
        }
        __syncthreads();
        {   HG_IDS
        if (ch + 1 < SEQ / 64) HG_PREFETCH(ch + 1);
        {
            const int wn = wave >> 2, ti = (wave >> 1) & 1, si = wave & 1;
            f32x4 a0 = (f32x4){0.f, 0.f, 0.f, 0.f};
#pragma unroll
            for (int kk = 0; kk < 4; ++kk) {
                const bf16x8 qa = *(const LAS bf16x8*)(lds + QB + ((wn * 32 + ti * 16 + fr) * 136 + kk * 32 + fq * 8) * 2);
                const bf16x8 k0 = *(const LAS bf16x8*)(lds + KB + ((wn * 32 + si * 16 + fr) * 136 + kk * 32 + fq * 8) * 2);
                a0 = __builtin_amdgcn_mfma_f32_16x16x32_bf16(qa, k0, a0, 0, 0, 0);
            }
#pragma unroll
            for (int rg = 0; rg < 4; ++rg) {
                const int tl = ti * 16 + fq * 4 + rg, sl = si * 16 + fr;
                const unsigned w0 = pk_bf16((sl <= tl) ? a0[rg] : 0.f, 0.f) & 0xffffu;
                *(LAS bf16_t*)(lds + AB + ((wn * 32 + tl) * 40 + sl) * 2) = (bf16_t)w0;
            }
        }
        }
        __syncthreads();
        {   HG_IDS
        *(LAS u32x4*)(lds + KB + (st * 136 + sv) * 2) = cg0; *(LAS u32x4*)(lds + KB + (st * 136 + sv + 8) * 2) = cg1;
        {
            bf16x8 vb[2];
#pragma unroll
            for (int wn = 0; wn < 2; ++wn) vb[wn] = *(const LAS bf16x8*)(lds + VT + ((wave * 16 + fr) * 72 + wn * 32 + fq * 8) * 2);
#pragma unroll
            for (int wn = 0; wn < 2; ++wn) {
                bf16x8 mb[4];
#pragma unroll
                for (int kk = 0; kk < 4; ++kk) {
                    u32x4 w; w.x = pk_bf16(S[2 * kk][0], S[2 * kk][1]); w.y = pk_bf16(S[2 * kk][2], S[2 * kk][3]); w.z = pk_bf16(S[2 * kk + 1][0], S[2 * kk + 1][1]); w.w = pk_bf16(S[2 * kk + 1][2], S[2 * kk + 1][3]);
                    mb[kk] = __builtin_bit_cast(bf16x8, w);
                }
                {
                    f32x4 o[2];
#pragma unroll
                    for (int ti = 0; ti < 2; ++ti) o[ti] = __builtin_amdgcn_mfma_f32_16x16x32_bf16(*(const LAS bf16x8*)(lds + AB + ((wn * 32 + ti * 16 + fr) * 40 + fq * 8) * 2), vb[wn], (f32x4){0.f, 0.f, 0.f, 0.f}, 0, 0, 0);
#pragma unroll
                    for (int kk = 0; kk < 4; ++kk) {
#pragma unroll
                        for (int ti = 0; ti < 2; ++ti) {
                            const int row = wn * 32 + ti * 16 + fr;
                            const u32x2 lo = *(const LAS u32x2*)(lds + QB + (row * 136 + kk * 32 + fq * 4) * 2), hi = *(const LAS u32x2*)(lds + QB + (row * 136 + kk * 32 + 16 + fq * 4) * 2);
                            const u32x4 w = (u32x4){lo.x, lo.y, hi.x, hi.y};
                            o[ti] = __builtin_amdgcn_mfma_f32_16x16x32_bf16(__builtin_bit_cast(bf16x8, w), mb[kk], o[ti], 0, 0, 0);
                        }
#pragma unroll
                        for (int k2 = 0; k2 < 2; ++k2) {
                            const int kt = kk * 2 + k2;
                            const bf16x8 ka = *(const LAS bf16x8*)(lds + KT + ((kt * 16 + fr) * 72 + wn * 32 + fq * 8) * 2);
                            S[kt] = __builtin_amdgcn_mfma_f32_16x16x32_bf16(ka, vb[wn], S[kt], 0, 0, 0);
                        }
                    }
#pragma unroll
                    for (int ti = 0; ti < 2; ++ti)
#pragma unroll
                        for (int rg = 0; rg < 4; ++rg) *(LAS float*)(lds + OO + ((wn * 32 + ti * 16 + fq * 4 + rg) * 132 + wave * 16 + fr) * 4) = o[ti][rg];
#pragma unroll
                    for (int kt = 0; kt < 8; ++kt) S[kt] *= *(const LAS f32x4*)(F + FF + (wn * 32 + 31) * 128 + kt * 16 + fq * 4);
                }
            }
        }
        }
        __syncthreads();
        {   HG_IDS
            float ss = 0.f;
#pragma unroll
            for (int m = 0; m < 4; ++m) { const f32x4 x = *(const LAS f32x4*)(lds + OO + (st * 132 + sv + 4 * m) * 4); ss += x[0] * x[0] + x[1] * x[1] + x[2] * x[2] + x[3] * x[3]; }
            const float rs = rsqrtf(red8(ss) * (1.0f / 128.0f) + 1e-6f);
            bf16_t* yr = Y + (size_t)(b * SEQ + ch * 64 + st) * DM + h * 128 + sv;
#pragma unroll 1
            for (int hf = 0; hf < 2; ++hf) {
                const f32x4 x0 = *(const LAS f32x4*)(lds + OO + (st * 132 + sv + hf * 8) * 4), x1 = *(const LAS f32x4*)(lds + OO + (st * 132 + sv + hf * 8 + 4) * 4);
                const f32x4 n0 = *(const LAS f32x4*)(F + HN + sv + hf * 8), n1 = *(const LAS f32x4*)(F + HN + sv + hf * 8 + 4);
                float g[8], y8[8]; unpack8(*(const LAS u32x4*)(lds + KB + (st * 136 + sv + hf * 8) * 2), g);
#pragma unroll
                for (int j = 0; j < 4; ++j) { y8[j] = x0[j] * rs * n0[j] * siluf_(g[j]); y8[4 + j] = x1[j] * rs * n1[j] * siluf_(g[4 + j]); }
                *(u32x4*)(yr + hf * 8) = pack8(y8);
            }
        }
    }
#undef HG_PREFETCH
#undef HG_IDS
}

__device__ __forceinline__ void p2_ml(KP P, int l, int item, LAS unsigned char* lds) {
    const int tid = ltid(), lane = tid & 63, wave = tid >> 6, b = item >> 2, h = item & 3;
    const int fr = lane & 15, fq = lane >> 4, st = tid >> 3, c8 = tid & 7, sv = c8 * 16;
    const int blk = tid & 31, sg = tid >> 5;
    const bf16_t* U = (const bf16_t*)(P->ws + WS_U); bf16_t* Y = (bf16_t*)(P->ws + WS_HY);
    LAS float* F = LDSF(0);
    constexpr int FD = 0, IW = 64, EN = 128, RS = 256, NK = 512, TNS = 768, CT = 1280, MN = 2944, MS = 3072;
    constexpr int QB = 12800, KB = QB + 64 * 136 * 2, KT = KB + 64 * 136 * 2, VT = KT + 128 * 72 * 2, AB = VT + 128 * 72 * 2, OO = AB + 64 * 72 * 2, XC = OO + 64 * 132 * 4;
    __syncthreads();
    if (tid < 32) {
        const int cgl = h * 128 + blk * 4;
#pragma unroll
        for (int jj = 0; jj < 4; ++jj) *(LAS f32x4*)(F + CT + (jj * 32 + blk) * 4) = *(const f32x4*)(P->in[I_MLCW] + l * 2048 + jj * 512 + cgl);
        *(LAS f32x4*)(F + CT + (4 * 32 + blk) * 4) = *(const f32x4*)(P->in[I_MLCB] + l * 512 + cgl);
#pragma unroll
        for (int j = 0; j < 4; ++j) {
            *(LAS f32x4*)(F + CT + ((5 + j) * 32 + blk) * 4) = *(const f32x4*)(P->in[I_MLWQ] + (size_t)l * 2048 + (h * 32 + blk) * 16 + j * 4) * 0.08838834764831845f;
            *(LAS f32x4*)(F + CT + ((9 + j) * 32 + blk) * 4) = *(const f32x4*)(P->in[I_MLWK] + (size_t)l * 2048 + (h * 32 + blk) * 16 + j * 4);
        }
    }
    const float ib = P->in[I_MLIB][l * 4 + h], fb = P->in[I_MLFB][l * 4 + h];
    f32x4 M[8];
#pragma unroll
    for (int j = 0; j < 8; ++j) M[j] = (f32x4){0.f, 0.f, 0.f, 0.f};
    float mcarry = 0.f;
    u32x2 px[7]; u32x4 pv0, pv1; unsigned pif;
#define ML_IDS const int tid = ltid(), lane = tid & 63, wave = tid >> 6, fr = lane & 15, fq = lane >> 4, st = tid >> 3, c8 = tid & 7, sv = c8 * 16, blk = tid & 31, sg = tid >> 5; (void)lane; (void)wave; (void)fr; (void)fq; (void)st; (void)c8; (void)sv; (void)blk; (void)sg;
#define ML_PREFETCH(ch) do { ML_IDS const int ts0_ = (ch) * 64 + sg * 4 - 3; \
        _Pragma("unroll") for (int r = 0; r < 7; ++r) { const int ts_ = ts0_ + r; \
            px[r] = *(const u32x2*)(U + (size_t)(b * SEQ + (ts_ < 0 ? 0 : ts_)) * LDU + U_ML_X + h * 128 + blk * 4); } \
        { const bf16_t* uv_ = U + (size_t)(b * SEQ + (ch) * 64 + st) * LDU + U_ML_V + h * 128 + sv; pv0 = *(const u32x4*)uv_; pv1 = *(const u32x4*)(uv_ + 8); } \
        { const bf16_t* ug_ = U + (size_t)(b * SEQ + (ch) * 64 + lane) * LDU; pif = (unsigned)ug_[U_ML_I + h] | ((unsigned)ug_[U_ML_F + h] << 16); } } while (0)
    if (tid < 128) { F[NK + tid] = 0.f; F[MN + tid] = P->in[I_MLNORM][l * 512 + h * 128 + tid]; F[MS + tid] = P->in[I_MLSKIP][l * 512 + h * 128 + tid]; }
    ML_PREFETCH(0);
    __syncthreads();
    for (int ch = 0; ch < SEQ / 64; ++ch) {
        const u32x4 cv0 = pv0, cv1 = pv1;
        u32x4 co0, co1;
        {   ML_IDS
        { const bf16_t* uo_ = U + (size_t)(b * SEQ + ch * 64 + st) * LDU + U_ML_O + h * 128 + sv; co0 = *(const u32x4*)uo_; co1 = *(const u32x4*)(uo_ + 8); }
        }
        __syncthreads();
        float q[4][4], k[4][4];
        {   ML_IDS
        {
            float xc[4][4];
            {
                f32x4 cw[4];
#pragma unroll
                for (int j = 0; j < 4; ++j) cw[j] = *(const LAS f32x4*)(F + CT + (j * 32 + blk) * 4);
                const f32x4 cb4 = *(const LAS f32x4*)(F + CT + (4 * 32 + blk) * 4);
                float x[7][4];
#pragma unroll
                for (int r = 0; r < 7; ++r) { const float vf = (ch * 64 + sg * 4 - 3 + r) < 0 ? 0.f : 1.f; x[r][0] = vf * bflo(px[r].x); x[r][1] = vf * bfhi(px[r].x); x[r][2] = vf * bflo(px[r].y); x[r][3] = vf * bfhi(px[r].y); }
#pragma unroll
                for (int s = 0; s < 4; ++s)
#pragma unroll
                    for (int j = 0; j < 4; ++j) xc[s][j] = siluf_(cb4[j] + cw[0][j] * x[s][j] + cw[1][j] * x[s + 1][j] + cw[2][j] * x[s + 2][j] + cw[3][j] * x[s + 3][j]);
            }
#pragma unroll
            for (int s = 0; s < 4; ++s) { u32x2 w; w.x = pk_bf16(xc[s][0], xc[s][1]); w.y = pk_bf16(xc[s][2], xc[s][3]); *(LAS u32x2*)(lds + XC + ((sg * 4 + s) * 136 + blk * 4) * 2) = w; }
            __builtin_amdgcn_sched_barrier(0);
            {
                f32x4 wq[4];
#pragma unroll
                for (int j = 0; j < 4; ++j) wq[j] = *(const LAS f32x4*)(F + CT + ((5 + j) * 32 + blk) * 4);
#pragma unroll
                for (int s = 0; s < 4; ++s)
#pragma unroll
                    for (int i = 0; i < 4; ++i) q[s][i] = xc[s][0] * wq[0][i] + xc[s][1] * wq[1][i] + xc[s][2] * wq[2][i] + xc[s][3] * wq[3][i];
            }
            __builtin_amdgcn_sched_barrier(0);
            {
                f32x4 wk[4];
#pragma unroll
                for (int j = 0; j < 4; ++j) wk[j] = *(const LAS f32x4*)(F + CT + ((9 + j) * 32 + blk) * 4);
#pragma unroll
                for (int s = 0; s < 4; ++s)
#pragma unroll
                    for (int i = 0; i < 4; ++i) k[s][i] = xc[s][0] * wk[0][i] + xc[s][1] * wk[1][i] + xc[s][2] * wk[2][i] + xc[s][3] * wk[3][i];
            }
        }
        if (wave == 0) {
            const float ip = bflo(pif) + ib, xf = bfhi(pif) + fb;
            const float lf = fminf(xf, 0.f) - log1pf(__expf(-fabsf(xf)));
            const float bs = wave_scan_sum(lf);
            const float cm = wave_scan_max(ip - bs);
            const float g = fmaxf(mcarry, cm), mt = bs + g;
            const int lq = lane + lsgpr(0);
            F[FD + lq] = __expf(mcarry - g);
            F[IW + lq] = __expf(ip - bs - mcarry);
            F[EN + lq] = __expf(-mt);
            mcarry = __int_as_float(__builtin_amdgcn_readlane(__float_as_int(mt), 63));
        }
        }
        __syncthreads();
        {   ML_IDS
#pragma unroll
            for (int s = 0; s < 4; ++s) {
                const int t = sg * 4 + s; const float fd = F[FD + t], iw = F[IW + t];
#pragma unroll
                for (int i = 0; i < 4; ++i) { q[s][i] *= fd; k[s][i] *= iw; }
                u32x2 w; w.x = pk_bf16(q[s][0], q[s][1]); w.y = pk_bf16(q[s][2], q[s][3]);
                *(LAS u32x2*)(lds + QB + (t * 136 + blk * 4) * 2) = w;
                w.x = pk_bf16(k[s][0], k[s][1]); w.y = pk_bf16(k[s][2], k[s][3]);
                *(LAS u32x2*)(lds + KB + (t * 136 + blk * 4) * 2) = w;
            }
#pragma unroll
            for (int i = 0; i < 4; ++i) {
                u32x2 w; w.x = pk_bf16(k[0][i], k[1][i]); w.y = pk_bf16(k[2][i], k[3][i]);
                *(LAS u32x2*)(lds + KT + ((blk * 4 + i) * 72 + sg * 4) * 2) = w;
            }
#pragma unroll
            for (int j = 0; j < 8; ++j) {
                const unsigned w0 = cv0[j >> 1], w1 = cv1[j >> 1];
                *(LAS bf16_t*)(lds + VT + ((sv + j) * 72 + st) * 2) = (bf16_t)((j & 1) ? (w0 >> 16) : (w0 & 0xffffu));
                *(LAS bf16_t*)(lds + VT + ((sv + 8 + j) * 72 + st) * 2) = (bf16_t)((j & 1) ? (w1 >> 16) : (w1 & 0xffffu));
            }
        }
        __syncthreads();
        {   ML_IDS
        if (ch + 1 < SEQ / 64) ML_PREFETCH(ch + 1);
        {
            const int ti = wave >> 1, si0 = 2 * (wave & 1);
            f32x4 a0 = (f32x4){0.f, 0.f, 0.f, 0.f}, a1 = a0;
#pragma unroll
            for (int kk = 0; kk < 4; ++kk) {
                const bf16x8 qa = *(const LAS bf16x8*)(lds + QB + ((ti * 16 + fr) * 136 + kk * 32 + fq * 8) * 2);
                const bf16x8 k0 = *(const LAS bf16x8*)(lds + KB + (((si0) * 16 + fr) * 136 + kk * 32 + fq * 8) * 2);
                const bf16x8 k1 = *(const LAS bf16x8*)(lds + KB + (((si0 + 1) * 16 + fr) * 136 + kk * 32 + fq * 8) * 2);
                a0 = __builtin_amdgcn_mfma_f32_16x16x32_bf16(qa, k0, a0, 0, 0, 0);
                a1 = __builtin_amdgcn_mfma_f32_16x16x32_bf16(qa, k1, a1, 0, 0, 0);
            }
#pragma unroll
            for (int rg = 0; rg < 4; ++rg) {
                const int ta = ti * 16 + fq * 4 + rg, s0 = si0 * 16 + fr, s1 = s0 + 16;
                const unsigned w0 = pk_bf16((s0 <= ta) ? a0[rg] : 0.f, 0.f) & 0xffffu, w1 = pk_bf16((s1 <= ta) ? a1[rg] : 0.f, 0.f) & 0xffffu;
                *(LAS bf16_t*)(lds + AB + (ta * 72 + s0) * 2) = (bf16_t)w0;
                *(LAS bf16_t*)(lds + AB + (ta * 72 + s1) * 2) = (bf16_t)w1;
                const float r0 = red16(bflo(w0)), r1 = red16(bflo(w1));
                if (fr == 0) { F[RS + si0 * 64 + ta] = r0; F[RS + (si0 + 1) * 64 + ta] = r1; }
            }
            const int kk = tid & 127, q4 = tid >> 7;
            const u32x4 t0 = *(const LAS u32x4*)(lds + KT + (kk * 72 + q4 * 16) * 2), t1 = *(const LAS u32x4*)(lds + KT + (kk * 72 + q4 * 16 + 8) * 2);
            float f0[8], f1[8]; unpack8(t0, f0); unpack8(t1, f1);
            float s = 0.f;
#pragma unroll
            for (int j = 0; j < 8; ++j) s += f0[j] + f1[j];
            F[TNS + q4 * 128 + kk] = s;
        }
        }
        __syncthreads();
        {   ML_IDS
        *(LAS u32x4*)(lds + KB + (st * 136 + sv) * 2) = co0; *(LAS u32x4*)(lds + KB + (st * 136 + sv + 8) * 2) = co1;
        {
            const float ce = F[FD + 63];
            bf16x8 mb[4], vb[2];
#pragma unroll
            for (int kk = 0; kk < 4; ++kk) {
                u32x4 w; w.x = pk_bf16(M[2 * kk][0], M[2 * kk][1]); w.y = pk_bf16(M[2 * kk][2], M[2 * kk][3]); w.z = pk_bf16(M[2 * kk + 1][0], M[2 * kk + 1][1]); w.w = pk_bf16(M[2 * kk + 1][2], M[2 * kk + 1][3]);
                mb[kk] = __builtin_bit_cast(bf16x8, w);
            }
#pragma unroll
            for (int kk = 0; kk < 2; ++kk) vb[kk] = *(const LAS bf16x8*)(lds + VT + ((wave * 16 + fr) * 72 + kk * 32 + fq * 8) * 2);
            {
                f32x4 o[4];
#pragma unroll
                for (int ti = 0; ti < 4; ++ti) o[ti] = (f32x4){0.f, 0.f, 0.f, 0.f};
#pragma unroll
                for (int kk = 0; kk < 2; ++kk)
#pragma unroll
                    for (int ti = 0; ti < 4; ++ti) {
                        const bf16x8 sa = *(const LAS bf16x8*)(lds + AB + ((ti * 16 + fr) * 72 + kk * 32 + fq * 8) * 2);
                        o[ti] = __builtin_amdgcn_mfma_f32_16x16x32_bf16(sa, vb[kk], o[ti], 0, 0, 0);
                    }
#pragma unroll
                for (int kk = 0; kk < 4; ++kk)
#pragma unroll
                    for (int ti = 0; ti < 4; ++ti) {
                        const u32x2 lo = *(const LAS u32x2*)(lds + QB + ((ti * 16 + fr) * 136 + kk * 32 + fq * 4) * 2), hi = *(const LAS u32x2*)(lds + QB + ((ti * 16 + fr) * 136 + kk * 32 + 16 + fq * 4) * 2);
                        const u32x4 w = (u32x4){lo.x, lo.y, hi.x, hi.y};
                        o[ti] = __builtin_amdgcn_mfma_f32_16x16x32_bf16(__builtin_bit_cast(bf16x8, w), mb[kk], o[ti], 0, 0, 0);
                    }
#pragma unroll
                for (int ti = 0; ti < 4; ++ti)
#pragma unroll
                    for (int rg = 0; rg < 4; ++rg) *(LAS float*)(lds + OO + ((ti * 16 + fq * 4 + rg) * 132 + wave * 16 + fr) * 4) = o[ti][rg];
            }
#pragma unroll
            for (int kk = 0; kk < 2; ++kk)
#pragma unroll
                for (int kt = 0; kt < 8; ++kt) {
                    const bf16x8 ka = *(const LAS bf16x8*)(lds + KT + ((kt * 16 + fr) * 72 + kk * 32 + fq * 8) * 2);
                    M[kt] = __builtin_amdgcn_mfma_f32_16x16x32_bf16(ka, vb[kk], M[kt], 0, 0, 0);
                }
#pragma unroll
            for (int kt = 0; kt < 8; ++kt) M[kt] *= ce;
            if (tid < 128) F[NK + ((ch + 1) & 1) * 128 + tid] = (F[NK + (ch & 1) * 128 + tid] + (F[TNS + tid] + F[TNS + 128 + tid]) + (F[TNS + 256 + tid] + F[TNS + 384 + tid])) * ce;
        }
        }
        __syncthreads();
        {   ML_IDS
            const u32x4 q0 = *(const LAS u32x4*)(lds + QB + (st * 136 + c8 * 16) * 2), q1 = *(const LAS u32x4*)(lds + QB + (st * 136 + c8 * 16 + 8) * 2);
            float f0[8], f1[8]; unpack8(q0, f0); unpack8(q1, f1);
            float d = 0.f;
#pragma unroll
            for (int m = 0; m < 2; ++m) {
                const f32x4 n0 = *(const LAS f32x4*)(F + NK + (ch & 1) * 128 + c8 * 16 + 4 * m), n1 = *(const LAS f32x4*)(F + NK + (ch & 1) * 128 + c8 * 16 + 8 + 4 * m);
#pragma unroll
                for (int j = 0; j < 4; ++j) d += f0[4 * m + j] * n0[j] + f1[4 * m + j] * n1[j];
            }
            d = red8(d);
            d += (F[RS + st] + F[RS + 64 + st]) + (F[RS + 128 + st] + F[RS + 192 + st]);
            const float dinv = 1.0f / fmaxf(fabsf(d), F[EN + st]);
            float o[16], og[16], xs[16];
#pragma unroll
            for (int m = 0; m < 4; ++m) { const f32x4 x = *(const LAS f32x4*)(lds + OO + (st * 132 + sv + 4 * m) * 4); o[4 * m] = x[0] * dinv; o[4 * m + 1] = x[1] * dinv; o[4 * m + 2] = x[2] * dinv; o[4 * m + 3] = x[3] * dinv; }
            { float t0[8], t1[8]; unpack8(*(const LAS u32x4*)(lds + KB + (st * 136 + sv) * 2), t0); unpack8(*(const LAS u32x4*)(lds + KB + (st * 136 + sv + 8) * 2), t1);
#pragma unroll
              for (int j = 0; j < 8; ++j) { og[j] = t0[j]; og[8 + j] = t1[j]; }
              unpack8(*(const LAS u32x4*)(lds + XC + (st * 136 + sv) * 2), t0); unpack8(*(const LAS u32x4*)(lds + XC + (st * 136 + sv + 8) * 2), t1);
#pragma unroll
              for (int j = 0; j < 8; ++j) { xs[j] = t0[j]; xs[8 + j] = t1[j]; } }
            float ss = 0.f;
#pragma unroll
            for (int j = 0; j < 16; ++j) { o[j] *= sigmoidf_(og[j]); ss += o[j] * o[j]; }
            const float rs = rsqrtf(red8(ss) * (1.0f / 128.0f) + 1e-6f);
#pragma unroll
            for (int j = 0; j < 16; ++j) o[j] = o[j] * rs * F[MN + sv + j] + F[MS + sv + j] * xs[j];
            u32x4 w0, w1;
            w0.x = pk_bf16(o[0], o[1]); w0.y = pk_bf16(o[2], o[3]); w0.z = pk_bf16(o[4], o[5]); w0.w = pk_bf16(o[6], o[7]);
            w1.x = pk_bf16(o[8], o[9]); w1.y = pk_bf16(o[10], o[11]); w1.z = pk_bf16(o[12], o[13]); w1.w = pk_bf16(o[14], o[15]);
            bf16_t* yr = Y + (size_t)(b * SEQ + ch * 64 + st) * DM + 1024 + h * 128 + sv;
            *(u32x4*)yr = w0; *(u32x4*)(yr + 8) = w1;
        }
    }
#undef ML_PREFETCH
#undef ML_IDS
}

__device__ __forceinline__ void p2_lru(KP P, int l, int item, LAS unsigned char* lds) {
    const int tid = ltid(), lane = tid & 63, wave = tid >> 6, b = item >> 3, cgp = item & 7;
    const float* LA = (const float*)(P->ws + WS_LRUA); const float* LB = (const float*)(P->ws + WS_LRUB); bf16_t* Y = (bf16_t*)(P->ws + WS_HY);
    LAS float* F = LDSF(0);
    const size_t base = (size_t)(b * SEQ + wave * 512) * 512 + cgp * 64 + lane;
    float hh = 0.f, ap = 1.f;
#pragma unroll 8
    for (int t = 0; t < 512; ++t) { const float a = LA[base + (size_t)t * 512], x = LB[base + (size_t)t * 512]; hh = a * hh + x; ap *= a; }
    __syncthreads();
    F[wave * 64 + lane] = ap; F[512 + wave * 64 + lane] = hh;
    __syncthreads();
    float c = 0.f;
    for (int j = 0; j < wave; ++j) c = F[j * 64 + lane] * c + F[512 + j * 64 + lane];
    hh = c;
    bf16_t* yp = Y + (size_t)(b * SEQ + wave * 512) * DM + 1536 + cgp * 64 + lane;
#pragma unroll 8
    for (int t = 0; t < 512; ++t) { const float a = LA[base + (size_t)t * 512], x = LB[base + (size_t)t * 512]; hh = a * hh + x; yp[(size_t)t * DM] = (bf16_t)(pk_bf16(hh, 0.f) & 0xffffu); }

    {
        unsigned* bar0 = (unsigned*)(P->ws + WS_BAR + (size_t)P->li * WS_BAR_STRIDE);
        unsigned* fl = (unsigned*)(P->ws + WS_BAR + (size_t)30 * WS_BAR_STRIDE) + (l * 8 + b) * 64 + 32;
        asm volatile("s_waitcnt vmcnt(0)" ::: "memory");
        __syncthreads();
        if (threadIdx.x == 0) {
            __builtin_amdgcn_fence(__ATOMIC_RELEASE, "agent");
            asm volatile("s_waitcnt vmcnt(0)" ::: "memory");
            (void)xb_add(fl, 1u);
            XB_SPIN(xb_ld(fl) < 8u, bar0);
            __builtin_amdgcn_fence(__ATOMIC_ACQUIRE, "agent");
            asm volatile("s_waitcnt vmcnt(0)" ::: "memory");
        }
        __syncthreads();
        const bf16_t* U = (const bf16_t*)(P->ws + WS_U);
        const int c0 = lane * 8;
        float lrn[8];
#pragma unroll
        for (int j = 0; j < 8; ++j) lrn[j] = P->in[I_LRUNORM][l * 512 + c0 + j];
#pragma unroll 2
        for (int i = 0; i < 64; ++i) {
            const int tok = b * SEQ + cgp * 512 + wave * 64 + i;
            bf16_t* yr = Y + (size_t)tok * DM; const bf16_t* ur = U + (size_t)tok * LDU;
            float hv[8], gb[8], y8[8]; unpack8(*(const u32x4*)(yr + 1536 + c0), hv); unpack8(*(const u32x4*)(ur + U_LRU_G + c0), gb);
            float ss = 0.f;
#pragma unroll
            for (int j = 0; j < 8; ++j) { hv[j] *= gelu_tanhf_(gb[j]); ss += hv[j] * hv[j]; }
            const float rs = rsqrtf(red64(ss) * (1.0f / 512.0f) + 1e-6f);
#pragma unroll
            for (int j = 0; j < 8; ++j) y8[j] = hv[j] * rs * lrn[j];
            *(u32x4*)(yr + 1536 + c0) = pack8(y8);
        }
    }
}

__device__ __forceinline__ void phase_p3(KP P, int l) { (void)P; (void)l; }

#ifndef MK_ONE_LAUNCH
#define MK_ONE_LAUNCH 1
#endif
#ifndef MK_DEBUG_BAR
#define MK_DEBUG_BAR 0
#endif
#ifndef MK_FUSE_MASK
#define MK_FUSE_MASK 0x3FFFFFFull
#endif
#ifndef MK_SEAM_DELAY
#define MK_SEAM_DELAY 0
#endif
#ifndef MK_KIND_MASK
#define MK_KIND_MASK 0x40
#endif
#ifndef MK_P1_SPLIT
#define MK_P1_SPLIT 0
#endif
#ifndef MK_REPEAT_PHASE
#define MK_REPEAT_PHASE (-1)
#endif
#ifndef MK_REPEAT_ITEM
#define MK_REPEAT_ITEM (-1)
#endif
#ifndef MK_REPEAT_KIND
#define MK_REPEAT_KIND (-1)
#endif
#ifndef MK_SIMPLE_BAR
#define MK_SIMPLE_BAR 0
#endif
__device__ __forceinline__ void simple_barrier(unsigned* bar, unsigned& epoch) {
    asm volatile("s_waitcnt vmcnt(0)" ::: "memory");
    __syncthreads();
    if (threadIdx.x == 0) {
        __builtin_amdgcn_fence(__ATOMIC_RELEASE, "agent");
        asm volatile("s_waitcnt vmcnt(0)" ::: "memory");
        (void)xb_add(&bar[XB_TOP], 1u);
        const unsigned target = (epoch + 1u) * gridDim.x;
        XB_SPIN(xb_ld(&bar[XB_TOP]) < target, bar);
        __builtin_amdgcn_fence(__ATOMIC_ACQUIRE, "agent");
        asm volatile("s_waitcnt vmcnt(0)" ::: "memory");
    }
    ++epoch;
    __syncthreads();
}
enum { K_CONVERT = 0, K_MODFINAL, K_NORM, K_UP, K_DOWN, K_WIN, K_P1, K_P2, K_P3, K_WOUT, K_FINAL, K_DOWNF };
template <int KIND> __device__ __forceinline__ void run_phase(int l_, int sub_, LAS unsigned char* lds) {
    const int l = lsgpr(l_), sub = lsgpr(sub_);
    const KP P = kp_fresh();
    const float* modf = (const float*)(P->ws + WS_MODF);
    bf16_t* HY = (bf16_t*)(P->ws + WS_HY); bf16_t* UU = (bf16_t*)(P->ws + WS_U);
    const bf16_t* Wl = (const bf16_t*)(P->ws + WS_W) + (size_t)l * LW_ELEMS;
    bf16_t* XB = (bf16_t*)P->out; bf16_t* X2 = (bf16_t*)(P->ws + WS_LRUA);
    const int xf32 = (l == 0 && sub == 0) ? 1 : 0;
    const void* xcur = xf32 ? (const void*)P->in[I_X] : ((l == 1 && sub == 2) ? (const void*)X2 : (const void*)XB);
    const int f = sub >> 1;
    if constexpr (KIND == K_CONVERT) phase_convert(P, lds);
    if constexpr (KIND == K_MODFINAL) phase_modfinal(P);
    if constexpr (KIND == K_NORM) phase_norm(P, l, sub, xcur, xf32, lds);
    if constexpr (KIND == K_UP) {
        pg8::Gemm g{HY, Wl + (f ? LW_W13B : LW_W13A), NTOK, 2 * DFF, DM}; pg8::StaticOrder S; S.init(NTOK, 2 * DFF, lgdim(), lbid());
        EpiSwiGLU E{UU};
        pg8::gemm_phase<EpiSwiGLU, pg8::StaticOrder, true, true>(lds, g, S, E);
    }
    if constexpr (KIND == K_DOWN) {
        pg8::Gemm g{UU, Wl + (f ? LW_W2B : LW_W2A), NTOK, DM, DFF}; pg8::StaticOrder S; S.init(NTOK, DM, lgdim(), lbid(), 4);
        EpiResid E{xcur, XB, modf + (size_t)l * 8 * NMOD + sub * 6144 + 4096, 0.5f, xf32};
        pg8::gemm_phase<EpiResid, pg8::StaticOrder, true, true>(lds, g, S, E);
    }
    if constexpr (KIND == K_DOWNF) {
        pg8::Gemm g{UU, Wl + (f ? LW_W2B : LW_W2A), NTOK, DM, DFF}; pg8::StaticOrder S; S.init(NTOK, DM, lgdim(), lbid(), 4);
        EpiFinal E{X2, P->out, modf + (size_t)l * 8 * NMOD + sub * 6144 + 4096, 0.5f, P->in[I_FNORM], (float*)(P->ws + WS_RWW), (unsigned*)(P->ws + WS_BAR + (size_t)29 * WS_BAR_STRIDE) + 256,
                   (unsigned*)(P->ws + WS_BAR + (size_t)P->li * WS_BAR_STRIDE), (LAS float*)(lds + pg8::STAGE_BYTES)};
        pg8::gemm_phase<EpiFinal, pg8::StaticOrder, true, true>(lds, g, S, E);
    }
    if constexpr (KIND == K_WIN) {
        pg8::Gemm g{HY, Wl + LW_WIN, NTOK, LDU, DM}; pg8::StaticOrder S; S.init(NTOK, LDU, lgdim(), lbid());
        EpiU E{UU};
        pg8::gemm_phase<EpiU, pg8::StaticOrder, true, true>(lds, g, S, E);
    }
    if constexpr (KIND == K_P1) { const int part = P->pad; if (part != 2) p1_rw_lora(P, l, lds, lbid(), lgdim()); if (part != 1) p1_lru_prep(P, l, lds, lbid(), lgdim()); }
    if constexpr (KIND == K_P2) {
        {
            const int it = lbid();
            if (it >= 64 && it < 128) {
                if (it < 96) { p2_hg(P, l, it - 64, lds); if (MK_REPEAT_ITEM == 1) p2_hg(P, l, it - 64, lds); }
                else { p2_ml(P, l, it - 96, lds); if (MK_REPEAT_ITEM == 2) p2_ml(P, l, it - 96, lds); }
            } else {
                const int w = (it < 64) ? it : it - 64;
                p1_rw_lora(P, l, lds, w, 192); p1_lru_prep(P, l, lds, w, 192);
                {
                    unsigned* ctr = (unsigned*)(P->ws + WS_BAR + (size_t)28 * WS_BAR_STRIDE) + 32 + l * 64;
                    unsigned* bar0 = (unsigned*)(P->ws + WS_BAR + (size_t)P->li * WS_BAR_STRIDE);
                    asm volatile("s_waitcnt vmcnt(0)" ::: "memory");
                    __syncthreads();
                    if (threadIdx.x == 0) {
                        __builtin_amdgcn_fence(__ATOMIC_RELEASE, "agent");
                        asm volatile("s_waitcnt vmcnt(0)" ::: "memory");
                        (void)xb_add(ctr, 1u);
                        XB_SPIN(xb_ld(ctr) < 192u, bar0);
                        __builtin_amdgcn_fence(__ATOMIC_ACQUIRE, "agent");
                        asm volatile("s_waitcnt vmcnt(0)" ::: "memory");
                    }
                    __syncthreads();
                }
                if (it < 64) { _Pragma("unroll 1") for (int rep = 0; rep < ((MK_REPEAT_ITEM == 0) ? 2 : 1); ++rep) p2_rw(P, l, it, lds); }
                else if (it < 192) p2_lru(P, l, it - 128, lds);
            }
        }
        if (l == 0) convert_dynamic(P, lds);
    }
    if constexpr (KIND == K_P3) phase_p3(P, l);
    if constexpr (KIND == K_WOUT) {
        pg8::Gemm g{HY, Wl + LW_WOUT, NTOK, DM, DM}; pg8::StaticOrder S; S.init(NTOK, DM, lgdim(), lbid(), 4);
        EpiResid E{XB, (l == 1) ? X2 : XB, modf + (size_t)l * 8 * NMOD + 1 * 6144 + 4096, 1.0f, 0};
        pg8::gemm_phase<EpiResid, pg8::StaticOrder, true, true>(lds, g, S, E);
    }
    if constexpr (KIND == K_FINAL) { }
}

template <int KIND> __global__ void __launch_bounds__(NTHR, 2) k_phase(Params P_unused, int l, int sub) {
    extern __shared__ __attribute__((aligned(16))) unsigned char lds_raw[];
    run_phase<KIND>(l, sub, (LAS unsigned char*)lds_raw);
}
constexpr int N_PHASES = 27;
__global__ void __launch_bounds__(NTHR, 2) hymba_fwd(Params P_unused) {
    extern __shared__ __attribute__((aligned(16))) unsigned char lds_raw[];
    LAS unsigned char* lds = (LAS unsigned char*)lds_raw;
    const KP P = kp_fresh();
    const int lo = P->ph_lo, hi = P->ph_hi;
    if (threadIdx.x == 0) *(LAS u32x4*)(lds + LDS_BARW) = (u32x4){0u, 0u, 0u, 0u};
    __syncthreads();
    unsigned* barw = (unsigned*)(P->ws + WS_BAR + (size_t)P->li * WS_BAR_STRIDE);
    XcdBarrier bar = xcd_barrier_post(barw, (volatile LAS unsigned*)(lds + LDS_BARW));
#define SEAM(k) do { if ((k) + 1 < hi) xcd_barrier(bar); } while (0)
#define IN(k) (lo <= (k) && (k) < hi)
#define PH(k, KIND, l, sub) do { if (IN(k)) { run_phase<KIND>(l, sub, lds); if ((MK_REPEAT_KIND) == (KIND) || (MK_REPEAT_PHASE) == (k)) { xcd_barrier(bar); run_phase<KIND>(l, sub, lds); } SEAM(k); } } while (0)
    PH(0, K_CONVERT, 0, 0);
    PH(1, K_MODFINAL, 0, 0);
#define LAYER(l, b, KDOWN2) \
    PH((b) + 0, K_NORM, l, 0); PH((b) + 1, K_UP, l, 0); PH((b) + 2, K_DOWN, l, 0); \
    PH((b) + 3, K_NORM, l, 1); PH((b) + 4, K_WIN, l, 1); PH((b) + 6, K_P2, l, 1); PH((b) + 8, K_WOUT, l, 1); \
    PH((b) + 9, K_NORM, l, 2); PH((b) + 10, K_UP, l, 2); PH((b) + 11, KDOWN2, l, 2);
    LAYER(0, 2, K_DOWN)
    LAYER(1, 14, K_DOWNF)
#undef LAYER
    {
        unsigned bad = 0u;
        if (IN(25)) { for (int li = 0; li < 32; ++li) bad |= __hip_atomic_load((unsigned*)(P->ws + WS_BAR + (size_t)li * WS_BAR_STRIDE) + XB_TMO, __ATOMIC_RELAXED, __HIP_MEMORY_SCOPE_AGENT); }
        if (bad) { const float qn = __builtin_nanf(""); for (size_t i = (size_t)blockIdx.x * NTHR + threadIdx.x; i < (size_t)NTOK * DM; i += (size_t)gridDim.x * NTHR) P->out[i] = qn; }
    }
#undef PH
#undef IN
#undef SEAM
}

#if 1
template <int KIND> static void launch_phase(const Params& p, int l, int sub, int grid, hipStream_t stream) {
    static bool attr_set = false;
    if (!attr_set) { (void)hipFuncSetAttribute((const void*)k_phase<KIND>, hipFuncAttributeMaxDynamicSharedMemorySize, LDS_BYTES); attr_set = true; }
    hipLaunchKernelGGL(k_phase<KIND>, dim3(grid), dim3(NTHR), LDS_BYTES, stream, p, l, sub);
}
#endif
extern "C" void kernel_launch(void* const* d_in, const int* in_sizes, int n_in, void* d_out, int out_size, void* d_ws, size_t ws_size, hipStream_t stream) {
    static int grid = 0;
    if (grid == 0) {
        if (n_in != N_IN || out_size != NTOK * DM || ws_size < WS_END) { fprintf(stderr, "kernel_launch: unexpected shapes (n_in %d, out %d, ws %zu < %zu)\n", n_in, out_size, ws_size, (size_t)WS_END); grid = -1; return; }
        int dev = 0, cus = 0;
        if (hipGetDevice(&dev) != hipSuccess || hipDeviceGetAttribute(&cus, hipDeviceAttributeMultiprocessorCount, dev) != hipSuccess) { grid = -1; return; }
#if MK_ONE_LAUNCH
        int per_cu = 0;
        if (hipFuncSetAttribute((const void*)hymba_fwd, hipFuncAttributeMaxDynamicSharedMemorySize, LDS_BYTES) != hipSuccess) { fprintf(stderr, "kernel_launch: hipFuncSetAttribute failed\n"); grid = -1; return; }
        if (hipOccupancyMaxActiveBlocksPerMultiprocessor(&per_cu, (const void*)hymba_fwd, NTHR, LDS_BYTES) != hipSuccess || per_cu < 1) fprintf(stderr, "kernel_launch: occupancy query says %d\n", per_cu);
        (void)hipGetLastError();
#endif
        grid = cus;
        if (grid != 256) fprintf(stderr, "kernel_launch: %d CUs (built for 256)\n", grid);
    }
    if (grid < 0) return;
    Params p{};
    for (int i = 0; i < N_IN; ++i) p.in[i] = (const float*)d_in[i];
    p.out = (float*)d_out; p.ws = (unsigned char*)d_ws;
#if MK_ONE_LAUNCH
    (void)hipMemsetAsync((char*)d_ws + WS_BAR, 0, 32 * WS_BAR_STRIDE, stream);
    {
        int lo = 0, li = 0;
        for (int k = 0; k < N_PHASES; ++k) {
            const bool fused = (k + 1 < N_PHASES) && ((MK_FUSE_MASK >> k) & 1ull);
            if (!fused) { p.ph_lo = lo; p.ph_hi = k + 1; p.li = li++; hipLaunchKernelGGL(hymba_fwd, dim3(grid), dim3(NTHR), LDS_BYTES, stream, p); lo = k + 1; }
        }
    }
#else
    (void)hipMemsetAsync((char*)d_ws + WS_BAR, 0, 32 * WS_BAR_STRIDE, stream);
    static bool attr2 = false;
    if (!attr2) { (void)hipFuncSetAttribute((const void*)hymba_fwd, hipFuncAttributeMaxDynamicSharedMemorySize, LDS_BYTES); attr2 = true; }
    int k = 0;
#define LAUNCH(KIND, l, sub) do { if ((MK_KIND_MASK >> (KIND)) & 1) { p.ph_lo = k; p.ph_hi = k + 1; p.li = 0; hipLaunchKernelGGL(hymba_fwd, dim3(grid), dim3(NTHR), LDS_BYTES, stream, p); } \
        else { p.ph_lo = 0; p.ph_hi = 0; launch_phase<KIND>(p, l, sub, grid, stream); } ++k; } while (0)
    LAUNCH(K_CONVERT, 0, 0);
    LAUNCH(K_MODFINAL, 0, 0);
    for (int l = 0; l < 2; ++l)
        for (int sub = 0; sub < 3; ++sub) {
            LAUNCH(K_NORM, l, sub);
            if (sub != 1) { LAUNCH(K_UP, l, sub); if (l == 1 && sub == 2) { LAUNCH(K_DOWNF, l, sub); } else { LAUNCH(K_DOWN, l, sub); } }
            else { LAUNCH(K_WIN, l, sub); {
                   if (MK_P1_SPLIT == 0) { LAUNCH(K_P1, l, sub); }
                   else { const int fa = (MK_P1_SPLIT == 1);
                       p.pad = 1; if (fa) { p.ph_lo = k; p.ph_hi = k + 1; p.li = 0; hipLaunchKernelGGL(hymba_fwd, dim3(grid), dim3(NTHR), LDS_BYTES, stream, p); } else { p.ph_lo = 0; p.ph_hi = 0; launch_phase<K_P1>(p, l, sub, grid, stream); }
                       p.pad = 2; if (!fa) { p.ph_lo = k; p.ph_hi = k + 1; p.li = 0; hipLaunchKernelGGL(hymba_fwd, dim3(grid), dim3(NTHR), LDS_BYTES, stream, p); } else { p.ph_lo = 0; p.ph_hi = 0; launch_phase<K_P1>(p, l, sub, grid, stream); }
                       p.pad = 0; ++k; } } LAUNCH(K_P2, l, sub); LAUNCH(K_P3, l, sub); LAUNCH(K_WOUT, l, sub); }
        }
    LAUNCH(K_FINAL, 0, 0);
#undef LAUNCH
#endif
}
```

```cpp
#include <hip/hip_runtime.h>
#include <cstdio>
#include <cstdint>
__device__ __forceinline__ int ltid() { int t = (int)threadIdx.x; asm volatile("" : "+v"(t)); return t; }
__device__ __forceinline__ int lbid() { int x = (int)blockIdx.x; asm volatile("" : "+s"(x)); return x; }
__device__ __forceinline__ int lgdim() { int x = (int)gridDim.x; asm volatile("" : "+s"(x)); return x; }
__device__ __forceinline__ int lsgpr(int x) { asm volatile("" : "+s"(x)); return x; }
namespace pg8 {
#define PG8_LAS __attribute__((address_space(3)))
typedef unsigned short bf16_t;
typedef short bf16x8 __attribute__((ext_vector_type(8)));
typedef float f32x4 __attribute__((ext_vector_type(4)));
typedef unsigned u32x4 __attribute__((ext_vector_type(4)));
constexpr int BM = 256, BK = 64, HALF = 128, HTB = HALF * BK * 2  , STAGE_BYTES = 8 * HTB, NXCD = 8, WGM = 8;

__host__ __device__ __forceinline__ int lds_byte(int r, int c) { const int st = (r >> 4) * 2 + (c >> 5), rr = r & 15, cc = c & 31, ob = rr * 64 + cc * 2; return st * 1024 + (ob ^ (((ob >> 9) & 1) << 5)); }
__host__ __device__ __forceinline__ void stage_rc(int b, int& R, int& C) { const int st = b / 1024, sb = b % 1024, swz = sb ^ (((sb >> 9) & 1) << 5); R = (st >> 1) * 16 + swz / 64; C = (st & 1) * 32 + (swz % 64) / 2; }
__host__ __device__ __forceinline__ int perm32(int rho) { const int n = rho >> 4, i = rho & 15; return 8 * (i >> 2) + 4 * n + (i & 3); }

struct Unit { int pm, pn; };
struct Gemm { const bf16_t* A; const bf16_t* Bt; int M, N, K; };

struct StaticOrder {
    int nM, nN, nwg, G, c, wgm;
    __host__ __device__ void init(int M, int N, int G_, int c_, int wgm_ = WGM) { nM = M / BM; nN = N / BM; nwg = nM * nN; G = G_; c = c_; wgm = wgm_; }
    __host__ __device__ bool next(int i, Unit& u) const {
        const long L = (long)i * G + c; if (L >= nwg) return false;
        int wgid = (int)L; { const int q = nwg / NXCD, r = nwg % NXCD, xcd = wgid % NXCD, off = wgid / NXCD; wgid = (xcd < r ? xcd * (q + 1) : r * (q + 1) + (xcd - r) * q) + off; }
        const int nig = wgm * nN, gid = wgid / nig, fm = gid * wgm, gsz = (nM - fm) < wgm ? (nM - fm) : wgm;
        u.pm = fm + ((wgid % nig) % gsz); u.pn = (wgid % nig) / gsz; return true;
    }
    __device__ __forceinline__ void a_ready(const Unit&) const {}
    __device__ __forceinline__ void done(const Unit&) const {}
};
template <class Epi, class Sched, bool ALIGN_EPI = false, bool SP2 = false>
__device__ __forceinline__ void gemm_phase(PG8_LAS unsigned char* lds, const Gemm g, const Sched& S, const Epi& E) {
    const int tid = ltid(), wid = __builtin_amdgcn_readfirstlane(tid >> 6), lane = tid & 63, wr = wid >> 2, wc = wid & 3, fr = lane & 15, fq = lane >> 4;
    const int K = g.K, nt = K / BK;
    unsigned voffA[2], voffB[2];
#pragma unroll
    for (int i = 0; i < 2; ++i) { int R, C; stage_rc(tid * 16 + i * 8192, R, C); const int Rb = Epi::PERM ? ((R & ~31) + perm32(R & 31)) : R;
        voffA[i] = (unsigned)(R * K + C) * 2u; voffB[i] = (unsigned)(Rb * K + C) * 2u; }
    const size_t kstep = (size_t)(BK * 2);
    const size_t hstep = (size_t)HALF * K * 2;
    const size_t tstep = 2 * hstep;
    const unsigned ldsw = (unsigned)wid * 1024u;
    const int aoff = lds_byte(wr * 64 + fr, fq * 8), boff = lds_byte(wc * 32 + fr, fq * 8);
#define PG8_SA(b, h) (((b) * 2 + (h)) * HTB)
#define PG8_SB(b, h) ((4 + (b) * 2 + (h)) * HTB)
#define PG8_STAGE(bufoff, gbase, voff) do { _Pragma("unroll") for (int _i = 0; _i < 2; ++_i) \
        __builtin_amdgcn_global_load_lds((const unsigned*)((const char*)(gbase) + (voff)[_i]), (PG8_LAS unsigned*)(lds + (bufoff) + ldsw + _i * 8192), 16, 0, 0); } while (0)
#define PG8_LDA(dst, b, h) do { _Pragma("unroll") for (int m = 0; m < 4; ++m) _Pragma("unroll") for (int k = 0; k < 2; ++k) dst[m][k] = *(const PG8_LAS bf16x8*)(lds + PG8_SA(b, h) + aoff + m * 2048 + k * 1024); } while (0)
#define PG8_LDB(dst, b, h) do { _Pragma("unroll") for (int n = 0; n < 2; ++n) _Pragma("unroll") for (int k = 0; k < 2; ++k) dst[n][k] = *(const PG8_LAS bf16x8*)(lds + PG8_SB(b, h) + boff + n * 2048 + k * 1024); } while (0)
#define PG8_MMA(ai, bj, At, Bt) do { __builtin_amdgcn_s_setprio(1); _Pragma("unroll") for (int m = 0; m < 4; ++m) _Pragma("unroll") for (int n = 0; n < 2; ++n) _Pragma("unroll") for (int k = 0; k < 2; ++k) \
        acc[ai][bj][m][n] = __builtin_amdgcn_mfma_f32_16x16x32_bf16(Bt[n][k], At[m][k], acc[ai][bj][m][n], 0, 0, 0); __builtin_amdgcn_s_setprio(0); } while (0)
#define PG8_WAIT_V(n) asm volatile("s_waitcnt vmcnt(" #n ")" ::: "memory")
#define PG8_WAIT_L(n) asm volatile("s_waitcnt lgkmcnt(" #n ")" ::: "memory")
#define PG8_BAR __builtin_amdgcn_s_barrier()
#define PG8_SCHED __builtin_amdgcn_sched_barrier(0)
    Unit cur, nxt; int ui = 0;
    if (!S.next(0, cur)) return;
    f32x4 acc[2][2][4][2];
#pragma unroll
    for (int a = 0; a < 2; ++a)
#pragma unroll
        for (int b = 0; b < 2; ++b)
#pragma unroll
            for (int m = 0; m < 4; ++m)
#pragma unroll
                for (int n = 0; n < 2; ++n) acc[a][b][m][n] = (f32x4){0.f, 0.f, 0.f, 0.f};
    bf16x8 At[4][2], B0[2][2], B1[2][2];
    const char* cA = (const char*)g.A + (size_t)cur.pm * tstep; const char* cB = (const char*)g.Bt + (size_t)cur.pn * tstep;
    S.a_ready(cur);
    if constexpr (SP2) {
        PG8_STAGE(PG8_SB(0, 0), cB, voffB); PG8_STAGE(PG8_SB(0, 1), cB + hstep, voffB); PG8_STAGE(PG8_SA(0, 0), cA, voffA); PG8_STAGE(PG8_SA(0, 1), cA + hstep, voffA);
        if (wr == 1) PG8_BAR;
        PG8_WAIT_V(2); PG8_BAR;
        PG8_STAGE(PG8_SB(1, 0), cB + kstep, voffB); PG8_STAGE(PG8_SA(1, 0), cA + kstep, voffA); PG8_STAGE(PG8_SB(1, 1), cB + hstep + kstep, voffB);
        PG8_WAIT_V(6); PG8_BAR;
    } else {
        PG8_STAGE(PG8_SB(0, 0), cB, voffB); PG8_STAGE(PG8_SA(0, 0), cA, voffA); PG8_STAGE(PG8_SB(0, 1), cB + hstep, voffB); PG8_STAGE(PG8_SA(0, 1), cA + hstep, voffA);
        if (wr == 1) PG8_BAR;
        PG8_WAIT_V(4); PG8_BAR;
        PG8_STAGE(PG8_SB(1, 0), cB + kstep, voffB); PG8_STAGE(PG8_SA(1, 0), cA + kstep, voffA); PG8_STAGE(PG8_SB(1, 1), cB + hstep + kstep, voffB);
        PG8_WAIT_V(6); PG8_BAR;
    }
    for (;;) {
        const bool has_next = S.next(ui + 1, nxt);
        const char* nA = has_next ? (const char*)g.A + (size_t)nxt.pm * tstep : cA; const char* nB = has_next ? (const char*)g.Bt + (size_t)nxt.pn * tstep : cB;
        for (int t = 0; t < nt; t += 2) {
            const bool last = (t == nt - 2);
            const char* a1 = cA + (size_t)(t + 1) * kstep;
            const char* a2 = last ? nA : cA + (size_t)(t + 2) * kstep; const char* b2 = last ? nB : cB + (size_t)(t + 2) * kstep;
            const char* a3 = a2 + kstep; const char* b3 = b2 + kstep;
            if (last && has_next) S.a_ready(nxt);
            if constexpr (SP2) {
            PG8_LDB(B0, 0, 0); PG8_LDB(B1, 0, 1); PG8_SCHED; PG8_LDA(At, 0, 0); PG8_STAGE(PG8_SA(1, 1), a1 + hstep, voffA);
            PG8_WAIT_V(8); PG8_WAIT_L(0); PG8_BAR; PG8_MMA(0, 0, At, B0); PG8_MMA(0, 1, At, B1); PG8_BAR; PG8_SCHED;
            PG8_LDA(At, 0, 1); PG8_STAGE(PG8_SB(0, 0), b2, voffB); PG8_STAGE(PG8_SB(0, 1), b2 + hstep, voffB); PG8_STAGE(PG8_SA(0, 0), a2, voffA);
            PG8_WAIT_V(8); PG8_WAIT_L(0); PG8_BAR; PG8_MMA(1, 0, At, B0); PG8_MMA(1, 1, At, B1); PG8_BAR; PG8_SCHED;
            PG8_LDB(B0, 1, 0); PG8_LDB(B1, 1, 1); PG8_SCHED; PG8_LDA(At, 1, 0); PG8_STAGE(PG8_SA(0, 1), a2 + hstep, voffA);
            PG8_WAIT_V(8); PG8_WAIT_L(0); PG8_BAR; PG8_MMA(0, 0, At, B0); PG8_MMA(0, 1, At, B1); PG8_BAR; PG8_SCHED;
            PG8_LDA(At, 1, 1); PG8_STAGE(PG8_SB(1, 0), b3, voffB); PG8_STAGE(PG8_SB(1, 1), b3 + hstep, voffB); PG8_STAGE(PG8_SA(1, 0), a3, voffA);
            PG8_WAIT_V(8); PG8_WAIT_L(0); PG8_BAR; PG8_MMA(1, 0, At, B0); PG8_MMA(1, 1, At, B1); PG8_BAR; PG8_SCHED;
            } else {
            PG8_LDB(B0, 0, 0); PG8_SCHED; PG8_LDA(At, 0, 0); PG8_STAGE(PG8_SA(1, 1), a1 + hstep, voffA);
            PG8_WAIT_L(8); PG8_BAR; PG8_WAIT_L(0); PG8_MMA(0, 0, At, B0); PG8_BAR; PG8_SCHED;
            PG8_LDB(B1, 0, 1); PG8_STAGE(PG8_SB(0, 0), b2, voffB);
            PG8_BAR; PG8_WAIT_L(0); PG8_MMA(0, 1, At, B1); PG8_BAR;
            PG8_LDA(At, 0, 1); PG8_STAGE(PG8_SA(0, 0), a2, voffA);
            PG8_BAR; PG8_WAIT_L(0); PG8_MMA(1, 0, At, B0); PG8_BAR; PG8_SCHED;
            PG8_STAGE(PG8_SB(0, 1), b2 + hstep, voffB);
            PG8_WAIT_V(6); PG8_BAR; PG8_MMA(1, 1, At, B1); PG8_BAR;
            PG8_LDB(B0, 1, 0); PG8_SCHED; PG8_LDA(At, 1, 0); PG8_STAGE(PG8_SA(0, 1), a2 + hstep, voffA);
            PG8_WAIT_L(8); PG8_BAR; PG8_WAIT_L(0); PG8_MMA(0, 0, At, B0); PG8_BAR; PG8_SCHED;
            PG8_LDB(B1, 1, 1); PG8_STAGE(PG8_SB(1, 0), b3, voffB);
            PG8_BAR; PG8_WAIT_L(0); PG8_MMA(0, 1, At, B1); PG8_BAR;
            PG8_LDA(At, 1, 1); PG8_STAGE(PG8_SA(1, 0), a3, voffA);
            PG8_BAR; PG8_WAIT_L(0); PG8_MMA(1, 0, At, B0); PG8_BAR; PG8_SCHED;
            PG8_STAGE(PG8_SB(1, 1), b3 + hstep, voffB);
            PG8_WAIT_V(6); PG8_BAR; PG8_MMA(1, 1, At, B1); PG8_BAR;
            }
        }
        if constexpr (ALIGN_EPI) { if (wr == 0) PG8_BAR; }
        if constexpr (!Epi::AFTER_DRAIN) { E(acc, cur, wr, wc, fr, fq); S.done(cur); }
        if (!has_next) break;
#pragma unroll
        for (int a = 0; a < 2; ++a)
#pragma unroll
            for (int b = 0; b < 2; ++b)
#pragma unroll
                for (int m = 0; m < 4; ++m)
#pragma unroll
                    for (int n = 0; n < 2; ++n) acc[a][b][m][n] = (f32x4){0.f, 0.f, 0.f, 0.f};
        cur = nxt; cA = nA; cB = nB; ++ui;
        if constexpr (ALIGN_EPI) { if (wr == 1) PG8_BAR; }
    }
    PG8_WAIT_V(0);
    if constexpr (!ALIGN_EPI) { if (wr == 0) PG8_BAR; }
    PG8_BAR;
    if constexpr (Epi::AFTER_DRAIN) { E.fused(acc, cur, wr, wc, fr, fq, lds, wid, lane); S.done(cur); }
#undef PG8_SA
#undef PG8_SB
#undef PG8_STAGE
#undef PG8_LDA
#undef PG8_LDB
#undef PG8_MMA
#undef PG8_WAIT_V
#undef PG8_WAIT_L
#undef PG8_BAR
#undef PG8_SCHED
}
}
#define XB_TMO      128
#define XB_XCNT(j)  (256  + 64 * (j))
#define XB_XSUB(j)  (1280 + 64 * (j))
#define XB_XGEN(j)  (2304 + 64 * (j))
#define XB_TOP      3328
#define XB_TOPGEN   3392
#define XCD_BAR_WORDS 3456
#define XB_SPIN_CAP (1u << 18)
#define LAS __attribute__((address_space(3)))

__device__ __forceinline__ unsigned xb_ld(unsigned* p)              { return __hip_atomic_load(p, __ATOMIC_RELAXED, __HIP_MEMORY_SCOPE_AGENT); }
__device__ __forceinline__ unsigned xb_add(unsigned* p, unsigned v) { return __hip_atomic_fetch_add(p, v, __ATOMIC_RELAXED, __HIP_MEMORY_SCOPE_AGENT); }
__device__ __forceinline__ unsigned xb_xcc_id() { return (unsigned)__builtin_amdgcn_s_getreg((3 << 11) | 20) & 0xFu; }
#define XB_SPIN(cond, bar) do { unsigned _sp = 0; while (cond) { __builtin_amdgcn_s_sleep(1); \
    if ((++_sp & 255u) == 0u) { if (xb_ld(&(bar)[XB_TMO])) break; if (_sp > XB_SPIN_CAP) { atomicAdd(&(bar)[XB_TMO], 1u); break; } } } } while (0)

struct XcdBarrier {
    unsigned* bar; unsigned x;
    volatile LAS unsigned* st;
};

__device__ __forceinline__ XcdBarrier xcd_barrier_post(unsigned* bar, volatile LAS unsigned* st) {
    XcdBarrier b; b.bar = bar; b.x = xb_xcc_id(); b.st = st;
    if (threadIdx.x == 0) (void)xb_add(&bar[XB_XCNT(b.x)], 1u);
    return b;
}
__device__ __forceinline__ void xcd_barrier_complete(unsigned* bar, unsigned x, unsigned& nloc, unsigned& nx) {
    const unsigned G = gridDim.x * gridDim.y * gridDim.z;
    unsigned sum, cnt, mine, sp = 0u;
    for (;;) {
        sum = 0u; cnt = 0u; mine = 0u;
#pragma unroll
        for (unsigned j = 0; j < 16; ++j) { const unsigned c = xb_ld(&bar[XB_XCNT(j)]); sum += c; cnt += (c > 0u) ? 1u : 0u; mine = (j == x) ? c : mine; }
        if (sum == G) break;
        __builtin_amdgcn_s_sleep(1);
        if ((++sp & 255u) == 0u) { if (xb_ld(&bar[XB_TMO])) break; if (sp > XB_SPIN_CAP) { atomicAdd(&bar[XB_TMO], 1u); break; } }
    }
    nloc = mine > 0u ? mine : 1u; nx = cnt > 0u ? cnt : 1u;
}

__device__ __forceinline__ void xcd_barrier(const XcdBarrier& b) {
    asm volatile("s_waitcnt vmcnt(0)" ::: "memory");
    __syncthreads();
    if (threadIdx.x == 0) {
        unsigned* bar = b.bar;
        __builtin_amdgcn_s_waitcnt(0);
        unsigned nloc = b.st[0], nx = b.st[1];
        if (nloc == 0u) { xcd_barrier_complete(bar, b.x, nloc, nx); b.st[0] = nloc; b.st[1] = nx; }
        const unsigned old = xb_add(&bar[XB_XSUB(b.x)], 1u);
        const unsigned gen = old / nloc;
        if (old + 1u == (gen + 1u) * nloc) {
            __builtin_amdgcn_fence(__ATOMIC_RELEASE, "agent");
            asm volatile("s_waitcnt vmcnt(0)" ::: "memory");
            const unsigned og = xb_add(&bar[XB_TOP], 1u);
            const unsigned tg = og / nx;
            if (og + 1u == (tg + 1u) * nx) xb_add(&bar[XB_TOPGEN], 1u);
            else XB_SPIN(xb_ld(&bar[XB_TOPGEN]) == tg, bar);
            __builtin_amdgcn_fence(__ATOMIC_ACQUIRE, "agent");
            xb_add(&bar[XB_XGEN(b.x)], 1u);
            asm volatile("s_waitcnt vmcnt(0)" ::: "memory");
        } else {
            XB_SPIN(xb_ld(&bar[XB_XGEN(b.x)]) == gen, bar);
            __builtin_amdgcn_fence(__ATOMIC_ACQUIRE, "agent");
            asm volatile("s_waitcnt vmcnt(0)" ::: "memory");
        }
    }
    __syncthreads();
}

typedef unsigned short bf16_t;
typedef short bf16x8 __attribute__((ext_vector_type(8)));
typedef float f32x4 __attribute__((ext_vector_type(4)));
typedef float f32x2 __attribute__((ext_vector_type(2)));
typedef unsigned u32x4 __attribute__((ext_vector_type(4)));
typedef unsigned u32x2 __attribute__((ext_vector_type(2)));

constexpr int NB = 8, SEQ = 4096, DM = 2048, NTOK = NB * SEQ, DFF = 5632, DIN = 6312, LDU = 6400, NMOD = 18432, NTHR = 512;
constexpr int U_HG_Q = 0, U_HG_F = 512, U_HG_I = 1024, U_HG_G = 1536;
constexpr int U_RW_R = 2048, U_RW_K = 2560, U_RW_V = 3072, U_RW_WD = 3584;
constexpr int U_ML_X = 3744, U_ML_V = 4256, U_ML_O = 4768, U_ML_I = 5280, U_ML_F = 5284;
constexpr int U_LRU_X = 5288, U_LRU_G = 5800;
constexpr int RW_IN = 1696;

enum { I_X = 0, I_C, I_GAIN, I_MODW, I_MODB, I_W1, I_W3, I_W2, I_WIN, I_WOUT, I_HGLB, I_HGNORM, I_RWMU, I_RWW0, I_RWW2, I_RWA0, I_RWA2, I_RWG2, I_RWKK, I_RWKA,
       I_RWRK, I_RWLNW, I_RWLNB, I_MLCW, I_MLCB, I_MLWQ, I_MLWK, I_MLIB, I_MLFB, I_MLNORM, I_MLSKIP, I_LRUCW, I_LRUCB, I_LRUWA, I_LRUBA, I_LRUWX, I_LRUBX,
       I_LRULAM, I_LRUNORM, I_FNORM, N_IN };

constexpr size_t WS_BAR = 0;
constexpr size_t WS_BAR_STRIDE = 16384, WS_MODP = 32 * WS_BAR_STRIDE;
constexpr size_t WS_MODF = WS_MODP + (size_t)2 * 16 * 8 * NMOD * 4;
constexpr size_t WS_LRUW = WS_MODF + (size_t)2 * 8 * NMOD * 4;
constexpr size_t WS_W = WS_LRUW + (size_t)2 * 2 * 4 * 16384 * 2;
constexpr size_t LW_W13A = 0, LW_W2A = 23068672, LW_W13B = 34603008, LW_W2B = 57671680, LW_WIN = 69206016, LW_WOUT = 82313216, LW_ELEMS = 86507520;
constexpr size_t WS_HY = WS_W + 2 * LW_ELEMS * 2;
constexpr size_t WS_U = WS_HY + (size_t)NTOK * DM * 2;
constexpr size_t WS_LRUA = WS_U + (size_t)NTOK * LDU * 2;
constexpr size_t WS_LRUB = WS_LRUA + (size_t)NTOK * 512 * 4;
constexpr size_t WS_RWW = WS_LRUB + (size_t)NTOK * 512 * 4;
constexpr size_t WS_RWA = WS_RWW + (size_t)NTOK * 512 * 4;
constexpr size_t WS_RWG = WS_RWA + (size_t)NTOK * 512 * 2;
constexpr size_t WS_LORAT = WS_RWG + (size_t)NTOK * 512 * 2;
constexpr size_t WS_END = WS_LORAT + (size_t)2 * 512 * 160 * 2;

constexpr int LDS_BYTES = 144 * 1024;
constexpr int LDS_BARW = LDS_BYTES - 16;

struct Params { const float* in[N_IN]; float* out; unsigned char* ws; int ph_lo, ph_hi, li, pad; };
typedef const Params __attribute__((address_space(4)))* KP;
__device__ __forceinline__ KP kp_fresh() { KP p = (KP)__builtin_amdgcn_kernarg_segment_ptr(); asm volatile("" : "+s"(p)); return p; }

__device__ __forceinline__ float bflo(unsigned w) { return __uint_as_float(w << 16); }
__device__ __forceinline__ float bfhi(unsigned w) { return __uint_as_float(w & 0xffff0000u); }
__device__ __forceinline__ float bf2f(bf16_t h) { return __uint_as_float(((unsigned)h) << 16); }
typedef __bf16 bf16x2n __attribute__((ext_vector_type(2)));
__device__ __forceinline__ unsigned pk_bf16(float lo, float hi) { const f32x2 v = {lo, hi}; return __builtin_bit_cast(unsigned, __builtin_convertvector(v, bf16x2n)); }
__device__ __forceinline__ void unpack8(const u32x4 w, float (&f)[8]) { f[0] = bflo(w.x); f[1] = bfhi(w.x); f[2] = bflo(w.y); f[3] = bfhi(w.y); f[4] = bflo(w.z); f[5] = bfhi(w.z); f[6] = bflo(w.w); f[7] = bfhi(w.w); }
__device__ __forceinline__ u32x4 pack8(const float (&f)[8]) { u32x4 w; w.x = pk_bf16(f[0], f[1]); w.y = pk_bf16(f[2], f[3]); w.z = pk_bf16(f[4], f[5]); w.w = pk_bf16(f[6], f[7]); return w; }
__device__ __forceinline__ float fast_rcp(float x) { return __builtin_amdgcn_rcpf(x); }
__device__ __forceinline__ float sigmoidf_(float x) { return fast_rcp(1.0f + __expf(-x)); }
__device__ __forceinline__ float siluf_(float x) { return x * sigmoidf_(x); }
__device__ __forceinline__ float softplusf_(float x) { return fmaxf(x, 0.0f) + __logf(1.0f + __expf(-fabsf(x))); }
__device__ __forceinline__ float tanhf_(float x) { const float e = __expf(2.0f * x); return 1.0f - 2.0f * fast_rcp(e + 1.0f); }
__device__ __forceinline__ float gelu_tanhf_(float x) { return 0.5f * x * (1.0f + tanhf_(0.7978845608028654f * (x + 0.044715f * x * x * x))); }
template <int CTRL> __device__ __forceinline__ float dpp_f(float x) { return __int_as_float(__builtin_amdgcn_update_dpp(0, __float_as_int(x), CTRL, 0xF, 0xF, true)); }
__device__ __forceinline__ float wave_scan_sum(float x) {
#define DPP_SC_(v, old, ctrl, rmask) __int_as_float(__builtin_amdgcn_update_dpp(__float_as_int(old), __float_as_int(v), ctrl, rmask, 0xF, false))
    x += DPP_SC_(x, 0.f, 0x111, 0xF); x += DPP_SC_(x, 0.f, 0x112, 0xF); x += DPP_SC_(x, 0.f, 0x114, 0xF); x += DPP_SC_(x, 0.f, 0x118, 0xF);
    x += DPP_SC_(x, 0.f, 0x142, 0xA); x += DPP_SC_(x, 0.f, 0x143, 0xC);
    return x;
}
__device__ __forceinline__ float wave_scan_max(float x) {
    x = fmaxf(x, DPP_SC_(x, x, 0x111, 0xF)); x = fmaxf(x, DPP_SC_(x, x, 0x112, 0xF)); x = fmaxf(x, DPP_SC_(x, x, 0x114, 0xF)); x = fmaxf(x, DPP_SC_(x, x, 0x118, 0xF));
    x = fmaxf(x, DPP_SC_(x, x, 0x142, 0xA)); x = fmaxf(x, DPP_SC_(x, x, 0x143, 0xC));
    return x;
#undef DPP_SC_
}
__device__ __forceinline__ float red8(float x) { x += dpp_f<0xB1>(x); x += dpp_f<0x4E>(x); x += dpp_f<0x141>(x); return x; }
__device__ __forceinline__ float red16(float x) { x = red8(x); x += dpp_f<0x140>(x); return x; }
__device__ __forceinline__ float red64(float x) { x = red16(x); x += __shfl_xor(x, 16); x += __shfl_xor(x, 32); return x; }


#define DPP_ADD4_(CTRL) "v_add_f32_dpp %0, %0, %0 " CTRL " row_mask:0xf bank_mask:0xf bound_ctrl:1\n\t" "v_add_f32_dpp %1, %1, %1 " CTRL " row_mask:0xf bank_mask:0xf bound_ctrl:1\n\t" \
                        "v_add_f32_dpp %2, %2, %2 " CTRL " row_mask:0xf bank_mask:0xf bound_ctrl:1\n\t" "v_add_f32_dpp %3, %3, %3 " CTRL " row_mask:0xf bank_mask:0xf bound_ctrl:1\n\t"
__device__ __forceinline__ void red16x4(float& a, float& b, float& c, float& d) {
    asm volatile("s_nop 4\n\t" DPP_ADD4_("quad_perm:[1,0,3,2]") DPP_ADD4_("quad_perm:[2,3,0,1]") DPP_ADD4_("row_half_mirror") DPP_ADD4_("row_mirror") : "+v"(a), "+v"(b), "+v"(c), "+v"(d));
}

__device__ __forceinline__ void rw1_dots(float s0, float s1, float s2, float s3, const f32x4 ma, const f32x4 wr, float& p1, float& p2) {
    asm volatile(
        "v_mul_f32 %[p1], %[s0], %[ma0]\n\t" "v_mul_f32 %[p2], %[s0], %[wr0]\n\t" "v_fmac_f32 %[p1], %[s1], %[ma1]\n\t" "v_fmac_f32 %[p2], %[s1], %[wr1]\n\t"
        "v_fmac_f32 %[p1], %[s2], %[ma2]\n\t" "v_fmac_f32 %[p2], %[s2], %[wr2]\n\t" "v_fmac_f32 %[p1], %[s3], %[ma3]\n\t" "v_fmac_f32 %[p2], %[s3], %[wr3]\n\t"
        : [p1] "=&v"(p1), [p2] "=&v"(p2)
        : [s0] "v"(s0), [s1] "v"(s1), [s2] "v"(s2), [s3] "v"(s3), [ma0] "v"(ma[0]), [ma1] "v"(ma[1]), [ma2] "v"(ma[2]), [ma3] "v"(ma[3]),
          [wr0] "v"(wr[0]), [wr1] "v"(wr[1]), [wr2] "v"(wr[2]), [wr3] "v"(wr[3]));
}
#define DPP_ADD2_(CTRL, TL) "v_add_f32_dpp %[a], %[a], %[a] " CTRL " row_mask:0xf bank_mask:0xf bound_ctrl:1\n\t" "v_add_f32_dpp %[b], %[b], %[b] " CTRL " row_mask:0xf bank_mask:0xf bound_ctrl:1\n\t" TL
__device__ __forceinline__ void rw1_reduce(float& a, float& b, float v, const f32x4 kp, float& t0, float& t1, float& t2, float& t3) {
    asm volatile("s_nop 4\n\t"
        DPP_ADD2_("quad_perm:[1,0,3,2]", "v_mul_f32 %[t0], %[v], %[kp0]\n\t") DPP_ADD2_("quad_perm:[2,3,0,1]", "v_mul_f32 %[t1], %[v], %[kp1]\n\t")
        DPP_ADD2_("row_half_mirror", "v_mul_f32 %[t2], %[v], %[kp2]\n\t") DPP_ADD2_("row_mirror", "v_mul_f32 %[t3], %[v], %[kp3]\n\t")
        : [a] "+v"(a), [b] "+v"(b), [t0] "=&v"(t0), [t1] "=&v"(t1), [t2] "=&v"(t2), [t3] "=&v"(t3)
        : [v] "v"(v), [kp0] "v"(kp[0]), [kp1] "v"(kp[1]), [kp2] "v"(kp[2]), [kp3] "v"(kp[3]));
}
__device__ __forceinline__ void rw1_update(float& s0, float& s1, float& s2, float& s3, float sa, float t0, float t1, float t2, float t3, const f32x4 wd, const f32x4 bv) {
    asm volatile(
        "v_fmac_f32 %[t0], %[sa], %[bv0]\n\t" "v_fmac_f32 %[t1], %[sa], %[bv1]\n\t" "v_fmac_f32 %[t2], %[sa], %[bv2]\n\t" "v_fmac_f32 %[t3], %[sa], %[bv3]\n\t"
        "v_fma_f32 %[s0], %[s0], %[wd0], %[t0]\n\t" "v_fma_f32 %[s1], %[s1], %[wd1], %[t1]\n\t" "v_fma_f32 %[s2], %[s2], %[wd2], %[t2]\n\t" "v_fma_f32 %[s3], %[s3], %[wd3], %[t3]\n\t"
        : [s0] "+v"(s0), [s1] "+v"(s1), [s2] "+v"(s2), [s3] "+v"(s3), [t0] "+v"(t0), [t1] "+v"(t1), [t2] "+v"(t2), [t3] "+v"(t3)
        : [sa] "v"(sa), [wd0] "v"(wd[0]), [wd1] "v"(wd[1]), [wd2] "v"(wd[2]), [wd3] "v"(wd[3]), [bv0] "v"(bv[0]), [bv1] "v"(bv[1]), [bv2] "v"(bv[2]), [bv3] "v"(bv[3]));
}

#define LDSF(off) ((LAS float*)(lds + (off)))

__device__ __forceinline__ void cvt_tile(const float* __restrict__ src, bf16_t* __restrict__ dst, int K, int N, int kt, int nt, int mode, LAS unsigned char* lds) {
    const int tid = ltid(); LAS float* tile = LDSF(0);
    const int k0 = kt * 64, n0 = nt * 64;
#pragma unroll
    for (int p = 0; p < 2; ++p) {
        const int kk = p * 32 + (tid >> 4), n4 = (tid & 15) * 4;
        f32x4 v = (f32x4){0.f, 0.f, 0.f, 0.f};
        if (n0 + n4 < N) v = *(const f32x4*)(src + (size_t)(k0 + kk) * N + n0 + n4);
        tile[kk * 65 + n4 + 0] = v[0]; tile[kk * 65 + n4 + 1] = v[1]; tile[kk * 65 + n4 + 2] = v[2]; tile[kk * 65 + n4 + 3] = v[3];
    }
    __syncthreads();
    {
        const int nn = tid >> 3, k8 = (tid & 7) * 8, n = n0 + nn;
        float f[8];
#pragma unroll
        for (int j = 0; j < 8; ++j) f[j] = tile[(k8 + j) * 65 + nn];
        const int row = (mode == 0) ? n : ((n >> 7) * 256 + ((mode == 2) ? 128 : 0) + (n & 127));
        *(u32x4*)(dst + (size_t)row * K + k0 + k8) = pack8(f);
    }
    __syncthreads();
}

constexpr int T_FF = 2816, T_WIN = 3200, T_WOUT = 1024, T_LAYER = 6 * T_FF + T_WIN + T_WOUT;
struct CvtTile { const float* src; bf16_t* dst; int K, N, kt, nt, mode; };
__device__ __forceinline__ CvtTile cvt_desc(KP P, int l, int r) {
    bf16_t* Wl = (bf16_t*)(P->ws + WS_W) + (size_t)l * LW_ELEMS;
    CvtTile t;
    if (r < 6 * T_FF) {
        const int m = r / T_FF, q = r % T_FF, f = m / 3, which = m % 3;
        if (which < 2) { t.src = P->in[which == 0 ? I_W1 : I_W3] + (size_t)(l * 2 + f) * DM * DFF; t.dst = Wl + (f ? LW_W13B : LW_W13A); t.K = DM; t.N = DFF; t.kt = q / 88; t.nt = q % 88; t.mode = which + 1; }
        else { t.src = P->in[I_W2] + (size_t)(l * 2 + f) * DFF * DM; t.dst = Wl + (f ? LW_W2B : LW_W2A); t.K = DFF; t.N = DM; t.kt = q / 32; t.nt = q % 32; t.mode = 0; }
    } else if (r < 6 * T_FF + T_WIN) {
        const int q = r - 6 * T_FF;
        t.src = P->in[I_WIN] + (size_t)l * DM * DIN; t.dst = Wl + LW_WIN; t.K = DM; t.N = DIN; t.kt = q / 100; t.nt = q % 100; t.mode = 0;
    } else {
        const int q = r - 6 * T_FF - T_WIN;
        t.src = P->in[I_WOUT] + (size_t)l * DM * DM; t.dst = Wl + LW_WOUT; t.K = DM; t.N = DM; t.kt = q / 32; t.nt = q % 32; t.mode = 0;
    }
    return t;
}
__device__ __forceinline__ void cvt_load(const CvtTile& t, f32x4 (&v)[2]) {
    const int tid = ltid(), n4 = (tid & 15) * 4;
#pragma unroll
    for (int p = 0; p < 2; ++p) {
        const int kk = p * 32 + (tid >> 4);
        v[p] = (f32x4){0.f, 0.f, 0.f, 0.f};
        if (t.nt * 64 + n4 < t.N) v[p] = *(const f32x4*)(t.src + (size_t)(t.kt * 64 + kk) * t.N + t.nt * 64 + n4);
    }
}
__device__ __forceinline__ void cvt_store(const CvtTile& t, const f32x4 (&v)[2], LAS unsigned char* lds) {
    const int tid = ltid(); LAS float* tile = LDSF(0);
#pragma unroll
    for (int p = 0; p < 2; ++p) {
        const int kk = p * 32 + (tid >> 4), n4 = (tid & 15) * 4;
        tile[kk * 65 + n4 + 0] = v[p][0]; tile[kk * 65 + n4 + 1] = v[p][1]; tile[kk * 65 + n4 + 2] = v[p][2]; tile[kk * 65 + n4 + 3] = v[p][3];
    }
    __syncthreads();
    {
        const int nn = tid >> 3, k8 = (tid & 7) * 8, n = t.nt * 64 + nn;
        float f[8];
#pragma unroll
        for (int j = 0; j < 8; ++j) f[j] = tile[(k8 + j) * 65 + nn];
        const int row = (t.mode == 0) ? n : ((n >> 7) * 256 + ((t.mode == 2) ? 128 : 0) + (n & 127));
        *(u32x4*)(t.dst + (size_t)row * t.K + t.kt * 64 + k8) = pack8(f);
    }
    __syncthreads();
}
__device__ __forceinline__ CvtTile cvt_desc_dyn(KP P, int r);
constexpr int T_EARLY = 3 * T_FF + T_WIN, T_LATE0 = 3 * T_FF + T_WOUT, T_DYN = T_LATE0 + T_LAYER;
__device__ __forceinline__ CvtTile cvt_desc_dyn(KP P, int r) {
    if (r < T_LATE0) return cvt_desc(P, 0, (r < 3 * T_FF) ? r + 3 * T_FF : r + 3 * T_FF + T_WIN);
    return cvt_desc(P, 1, r - T_LATE0);
}
__device__ __forceinline__ void convert_dynamic(KP P, LAS unsigned char* lds) {
    unsigned* ctr = (unsigned*)(P->ws + WS_BAR + (size_t)31 * WS_BAR_STRIDE);
    LAS unsigned* sh = (LAS unsigned*)(lds + 32768);
    const int tid = ltid();
    for (;;) {
        __syncthreads();
        if (tid == 0) *sh = __hip_atomic_fetch_add(ctr, 8u, __ATOMIC_RELAXED, __HIP_MEMORY_SCOPE_AGENT);
        __syncthreads();
        const int base = (int)*sh;
        if (base >= T_DYN) break;
        const int end = (base + 8 < T_DYN) ? base + 8 : T_DYN;
        CvtTile cur = cvt_desc_dyn(P, base); f32x4 v[2]; cvt_load(cur, v);
        for (int r = base; r < end; ++r) {
            CvtTile nxt = cur; f32x4 w[2] = {v[0], v[1]};
            if (r + 1 < end) { nxt = cvt_desc_dyn(P, r + 1); cvt_load(nxt, w); }
            cvt_store(cur, v, lds);
            cur = nxt; v[0] = w[0]; v[1] = w[1];
        }
    }
}
__device__ __forceinline__ void phase_convert(KP P, LAS unsigned char* lds) {
    const int tid = ltid(), wg = lbid(), nwg = lgdim();
    constexpr int T_BIG = 0, T_LRU = 64, T_MOD = 2 * 36 * 16;
    if (wg < T_EARLY) {
        CvtTile cur = cvt_desc(P, 0, (wg < 3 * T_FF) ? wg : wg + 3 * T_FF); f32x4 v[2]; cvt_load(cur, v);
        for (int r = wg; r < T_EARLY; r += nwg) {
            CvtTile nxt = cur; f32x4 w[2] = {v[0], v[1]};
            const int rn = r + nwg;
            if (rn < T_EARLY) { nxt = cvt_desc(P, 0, (rn < 3 * T_FF) ? rn : rn + 3 * T_FF); cvt_load(nxt, w); }
            cvt_store(cur, v, lds);
            cur = nxt; v[0] = w[0]; v[1] = w[1];
        }
    }
    {
        bf16_t* LT = (bf16_t*)(P->ws + WS_LORAT);
        for (int e = wg * NTHR + tid; e < 2 * 512 * 160; e += nwg * NTHR) {
            const int l = e / 81920, r = e % 81920, ch = r / 160, j = r % 160;
            const float v = (j < 32) ? P->in[I_RWW2][(size_t)(l * 32 + j) * 512 + ch] : ((j < 64) ? P->in[I_RWA2][(size_t)(l * 32 + j - 32) * 512 + ch] : P->in[I_RWG2][(size_t)(l * 96 + j - 64) * 512 + ch]);
            LT[e] = (bf16_t)(pk_bf16(v, 0.f) & 0xffffu);
        }
    }
    for (int it = wg; it < T_BIG + T_LRU + T_MOD; it += nwg) {
        if (false) {
        } else if (it < T_BIG + T_LRU) {
            const int q = it - T_BIG, m16 = q >> 2, tl = q & 3, l = m16 >> 3, which = (m16 >> 2) & 1, blk = m16 & 3;
            const float* src = P->in[which ? I_LRUWX : I_LRUWA] + (size_t)(l * 4 + blk) * 16384;
            bf16_t* dst = (bf16_t*)(P->ws + WS_LRUW) + (size_t)((l * 2 + which) * 4 + blk) * 16384;
            cvt_tile(src, dst, 128, 128, tl >> 1, tl & 1, 0, lds);
        } else {
            const int m = it - T_BIG - T_LRU, l = m / 576, r = m % 576, jb = r / 16, ks = r % 16;
            LAS float* cact = LDSF(0);
#pragma unroll
            for (int e2 = 0; e2 < 2; ++e2) { const int e = tid * 2 + e2, kk = e >> 3, b = e & 7; cact[e] = siluf_(P->in[I_C][b * DM + ks * 128 + kk]); }
            __syncthreads();
            const int j = jb * 512 + tid;
            const float* wp = P->in[I_MODW] + (size_t)l * DM * NMOD + (size_t)(ks * 128) * NMOD + j;
            float acc[8];
#pragma unroll
            for (int b = 0; b < 8; ++b) acc[b] = 0.f;
#pragma unroll 32
            for (int kk = 0; kk < 128; ++kk) {
                const float w = wp[(size_t)kk * NMOD];
                const f32x4 c0 = *(const LAS f32x4*)(cact + kk * 8), c1 = *(const LAS f32x4*)(cact + kk * 8 + 4);
                acc[0] += c0[0] * w; acc[1] += c0[1] * w; acc[2] += c0[2] * w; acc[3] += c0[3] * w;
                acc[4] += c1[0] * w; acc[5] += c1[1] * w; acc[6] += c1[2] * w; acc[7] += c1[3] * w;
            }
            float* mp = (float*)(P->ws + WS_MODP) + (size_t)((l * 16 + ks) * 8) * NMOD + j;
#pragma unroll
            for (int b = 0; b < 8; ++b) mp[(size_t)b * NMOD] = acc[b];
            __syncthreads();
        }
    }
}

__device__ __forceinline__ void phase_modfinal(KP P) {
    const float* mp = (const float*)(P->ws + WS_MODP); float* mf = (float*)(P->ws + WS_MODF);
    for (int i = lbid() * NTHR + ltid(); i < 2 * 8 * NMOD; i += lgdim() * NTHR) {
        const int l = i / (8 * NMOD), r = i % (8 * NMOD), b = r / NMOD, j = r % NMOD;
        float s = P->in[I_MODB][l * NMOD + j];
#pragma unroll
        for (int ks = 0; ks < 16; ++ks) s += mp[(size_t)((l * 16 + ks) * 8 + b) * NMOD + j];
        mf[i] = s;
    }
}

__device__ __forceinline__ void phase_norm(KP P, int l, int sub, const void* __restrict__ xsrc, int xf32, LAS unsigned char* lds) {
    const int tid = ltid(), lane = tid & 63, wave = tid >> 6;
    bf16_t* H = (bf16_t*)(P->ws + WS_HY);
    LAS float* cv = LDSF(0); LAS float* sv = LDSF(8192);
    for (int rb = lbid(); rb < NTOK / 128; rb += lgdim()) {
        const int b = rb >> 5;
        const float* mod = (const float*)(P->ws + WS_MODF) + (size_t)(l * 8 + b) * NMOD + sub * 6144;
        __syncthreads();
        for (int d = tid; d < DM; d += NTHR) { cv[d] = P->in[I_GAIN][(l * 3 + sub) * DM + d] * (1.0f + mod[2048 + d]); sv[d] = mod[d]; }
        __syncthreads();
        if (xf32) {
            for (int rr = 0; rr < 16; ++rr) {
                const int row = rb * 128 + wave * 16 + rr;
                const float* xr = (const float*)xsrc + (size_t)row * DM;
                f32x4 v[8]; float ss = 0.f;
#pragma unroll
                for (int i = 0; i < 8; ++i) { v[i] = *(const f32x4*)(xr + i * 256 + lane * 4); ss += v[i][0] * v[i][0] + v[i][1] * v[i][1] + v[i][2] * v[i][2] + v[i][3] * v[i][3]; }
                ss = red64(ss);
                const float rstd = rsqrtf(ss * (1.0f / DM) + 1e-6f);
#pragma unroll
                for (int i = 0; i < 8; ++i) {
                    const int d = i * 256 + lane * 4;
                    const f32x4 c = *(const LAS f32x4*)(cv + d), s = *(const LAS f32x4*)(sv + d);
                    u32x2 w; w.x = pk_bf16(v[i][0] * rstd * c[0] + s[0], v[i][1] * rstd * c[1] + s[1]); w.y = pk_bf16(v[i][2] * rstd * c[2] + s[2], v[i][3] * rstd * c[3] + s[3]);
                    *(u32x2*)(H + (size_t)row * DM + d) = w;
                }
            }
        } else {
            for (int rr = 0; rr < 16; ++rr) {
                const int row = rb * 128 + wave * 16 + rr;
                const bf16_t* xr = (const bf16_t*)xsrc + (size_t)row * DM;
                u32x4 xw[4]; float ss = 0.f;
#pragma unroll
                for (int i = 0; i < 4; ++i) xw[i] = *(const u32x4*)(xr + i * 512 + lane * 8);
                float v[4][8];
#pragma unroll
                for (int i = 0; i < 4; ++i) {
                    unpack8(xw[i], v[i]);
#pragma unroll
                    for (int j = 0; j < 8; ++j) ss += v[i][j] * v[i][j];
                }
                ss = red64(ss);
                const float rstd = rsqrtf(ss * (1.0f / DM) + 1e-6f);
#pragma unroll
                for (int i = 0; i < 4; ++i) {
                    const int d = i * 512 + lane * 8;
                    const f32x4 c0 = *(const LAS f32x4*)(cv + d), c1 = *(const LAS f32x4*)(cv + d + 4), s0 = *(const LAS f32x4*)(sv + d), s1 = *(const LAS f32x4*)(sv + d + 4);
                    float o[8];
#pragma unroll
                    for (int j = 0; j < 4; ++j) { o[j] = v[i][j] * rstd * c0[j] + s0[j]; o[4 + j] = v[i][4 + j] * rstd * c1[j] + s1[j]; }
                    *(u32x4*)(H + (size_t)row * DM + d) = pack8(o);
                }
            }
        }
    }
}

__device__ __forceinline__ void phase_final_norm(KP P, const bf16_t* __restrict__ X) {
    const int tid = ltid(), lane = tid & 63, wave = tid >> 6;
    const float* fn = P->in[I_FNORM];
    for (int row = lbid() * 8 + wave; row < NTOK; row += lgdim() * 8) {
        const bf16_t* xr = X + (size_t)row * DM; float* orow = P->out + (size_t)row * DM;
        u32x4 xw[4]; float ss = 0.f;
#pragma unroll
        for (int i = 0; i < 4; ++i) xw[i] = *(const u32x4*)(xr + i * 512 + lane * 8);
        float v[4][8];
#pragma unroll
        for (int i = 0; i < 4; ++i) {
            unpack8(xw[i], v[i]);
#pragma unroll
            for (int j = 0; j < 8; ++j) ss += v[i][j] * v[i][j];
        }
        ss = red64(ss);
        const float rstd = rsqrtf(ss * (1.0f / DM) + 1e-6f);
#pragma unroll
        for (int i = 0; i < 4; ++i) {
            const int d = i * 512 + lane * 8;
            const f32x4 g0 = *(const f32x4*)(fn + d), g1 = *(const f32x4*)(fn + d + 4);
            f32x4 o0, o1;
#pragma unroll
            for (int j = 0; j < 4; ++j) { o0[j] = v[i][j] * rstd * g0[j]; o1[j] = v[i][4 + j] * rstd * g1[j]; }
            *(f32x4*)(orow + d) = o0; *(f32x4*)(orow + d + 4) = o1;
        }
    }
}

struct EpiSwiGLU {
    static constexpr bool PERM = true, AFTER_DRAIN = false;
    bf16_t* G;
    __device__ __forceinline__ void operator()(const pg8::f32x4 (&acc)[2][2][4][2], const pg8::Unit& u, int wr, int wc, int fr, int fq) const {
        const int row0 = u.pm * 256 + wr * 64 + fr, col0 = u.pn * 128 + wc * 32 + 8 * fq;
#pragma unroll
        for (int ai = 0; ai < 2; ++ai)
#pragma unroll
            for (int m = 0; m < 4; ++m) {
                float o[8];
#pragma unroll
                for (int n = 0; n < 2; ++n)
#pragma unroll
                    for (int j = 0; j < 4; ++j) { const float g = acc[ai][0][m][n][j]; o[n * 4 + j] = g * fast_rcp(1.0f + __expf(-g)) * acc[ai][1][m][n][j]; }
                *(u32x4*)(G + (size_t)(row0 + ai * 128 + m * 16) * DFF + col0) = pack8(o);
            }
    }
};
struct EpiResid {
    static constexpr bool PERM = false, AFTER_DRAIN = false;
    const void* xin; bf16_t* xout; const float* gate; float coef; int xf32;
    __device__ __forceinline__ void operator()(const pg8::f32x4 (&acc)[2][2][4][2], const pg8::Unit& u, int wr, int wc, int fr, int fq) const {
        const int row0 = u.pm * 256 + wr * 64 + fr, col0 = u.pn * 256 + wc * 32 + 4 * fq, b = u.pm >> 4;
        f32x4 gv[2][2];
#pragma unroll
        for (int bj = 0; bj < 2; ++bj)
#pragma unroll
            for (int n = 0; n < 2; ++n) gv[bj][n] = (*(const f32x4*)(gate + (size_t)b * NMOD + col0 + bj * 128 + n * 16) + 1.0f) * coef;
#pragma unroll
        for (int ai = 0; ai < 2; ++ai) {
            if (xf32) {
                const float* xi = (const float*)xin;
                f32x4 xv[4][2][2];
#pragma unroll
                for (int m = 0; m < 4; ++m)
#pragma unroll
                    for (int bj = 0; bj < 2; ++bj)
#pragma unroll
                        for (int n = 0; n < 2; ++n) xv[m][bj][n] = *(const f32x4*)(xi + (size_t)(row0 + ai * 128 + m * 16) * DM + col0 + bj * 128 + n * 16);
#pragma unroll
                for (int m = 0; m < 4; ++m)
#pragma unroll
                    for (int bj = 0; bj < 2; ++bj)
#pragma unroll
                        for (int n = 0; n < 2; ++n) {
                            const f32x4 r = xv[m][bj][n] + gv[bj][n] * acc[ai][bj][m][n];
                            u32x2 w; w.x = pk_bf16(r[0], r[1]); w.y = pk_bf16(r[2], r[3]);
                            *(u32x2*)(xout + (size_t)(row0 + ai * 128 + m * 16) * DM + col0 + bj * 128 + n * 16) = w;
                        }
            } else {
                const bf16_t* xi = (const bf16_t*)xin;
                u32x2 xw[4][2][2];
#pragma unroll
                for (int m = 0; m < 4; ++m)
#pragma unroll
                    for (int bj = 0; bj < 2; ++bj)
#pragma unroll
                        for (int n = 0; n < 2; ++n) xw[m][bj][n] = *(const u32x2*)(xi + (size_t)(row0 + ai * 128 + m * 16) * DM + col0 + bj * 128 + n * 16);
#pragma unroll
                for (int m = 0; m < 4; ++m)
#pragma unroll
                    for (int bj = 0; bj < 2; ++bj)
#pragma unroll
                        for (int n = 0; n < 2; ++n) {
                            const f32x4 xv = (f32x4){bflo(xw[m][bj][n].x), bfhi(xw[m][bj][n].x), bflo(xw[m][bj][n].y), bfhi(xw[m][bj][n].y)};
                            const f32x4 r = xv + gv[bj][n] * acc[ai][bj][m][n];
                            u32x2 w; w.x = pk_bf16(r[0], r[1]); w.y = pk_bf16(r[2], r[3]);
                            *(u32x2*)(xout + (size_t)(row0 + ai * 128 + m * 16) * DM + col0 + bj * 128 + n * 16) = w;
                        }
            }
        }
    }
};
struct EpiFinal {
    static constexpr bool PERM = false, AFTER_DRAIN = false;
    const bf16_t* xin; float* out; const float* gate; float coef; const float* fn; float* part; unsigned* flags; unsigned* bar0; LAS float* spare;
    __device__ __forceinline__ void operator()(const pg8::f32x4 (&acc_)[2][2][4][2], const pg8::Unit& u, int wr, int wc, int fr, int fq) const {
        pg8::f32x4 (&acc)[2][2][4][2] = const_cast<pg8::f32x4 (&)[2][2][4][2]>(acc_);
        const int row0 = u.pm * 256 + wr * 64 + fr, col0 = u.pn * 256 + wc * 32 + 4 * fq, b = u.pm >> 4, tid = ltid();
        f32x4 gv[2][2];
#pragma unroll
        for (int bj = 0; bj < 2; ++bj)
#pragma unroll
            for (int n = 0; n < 2; ++n) gv[bj][n] = (*(const f32x4*)(gate + (size_t)b * NMOD + col0 + bj * 128 + n * 16) + 1.0f) * coef;
#pragma unroll
        for (int ai = 0; ai < 2; ++ai) {
            u32x2 xw[4][2][2];
#pragma unroll
            for (int m = 0; m < 4; ++m)
#pragma unroll
                for (int bj = 0; bj < 2; ++bj)
#pragma unroll
                    for (int n = 0; n < 2; ++n) xw[m][bj][n] = *(const u32x2*)(xin + (size_t)(row0 + ai * 128 + m * 16) * DM + col0 + bj * 128 + n * 16);
#pragma unroll
            for (int m = 0; m < 4; ++m) {
                float sq = 0.f;
#pragma unroll
                for (int bj = 0; bj < 2; ++bj)
#pragma unroll
                    for (int n = 0; n < 2; ++n) {
                        const f32x4 xv = (f32x4){bflo(xw[m][bj][n].x), bfhi(xw[m][bj][n].x), bflo(xw[m][bj][n].y), bfhi(xw[m][bj][n].y)};
                        const f32x4 r = xv + gv[bj][n] * acc[ai][bj][m][n];
                        acc[ai][bj][m][n] = r;
                        sq += r[0] * r[0] + r[1] * r[1] + r[2] * r[2] + r[3] * r[3];
                    }
                sq += __int_as_float(__builtin_amdgcn_ds_bpermute(((tid & 63) ^ 16) << 2, __float_as_int(sq))); sq += __int_as_float(__builtin_amdgcn_ds_bpermute(((tid & 63) ^ 32) << 2, __float_as_int(sq)));
                if (fq == 0) spare[wc * 256 + wr * 64 + fr + ai * 128 + m * 16] = sq;
            }
        }
        __syncthreads();
        if (tid < 256) __hip_atomic_store(part + (size_t)(u.pm * 256 + tid) * 8 + u.pn, (spare[tid] + spare[256 + tid]) + (spare[512 + tid] + spare[768 + tid]), __ATOMIC_RELAXED, __HIP_MEMORY_SCOPE_AGENT);
        asm volatile("s_waitcnt vmcnt(0)" ::: "memory");
        __syncthreads();
        if (threadIdx.x == 0) {
            (void)xb_add(flags + u.pm, 1u);
            XB_SPIN(xb_ld(flags + u.pm) < 8u, bar0);
        }
        __syncthreads();
        if (tid < 256) {
            const float* pr = part + (size_t)(u.pm * 256 + tid) * 8;
            float t = 0.f;
#pragma unroll
            for (int j = 0; j < 8; ++j) t += __hip_atomic_load(pr + j, __ATOMIC_RELAXED, __HIP_MEMORY_SCOPE_AGENT);
            spare[1024 + tid] = rsqrtf(t * (1.0f / DM) + 1e-6f);
        }
        __syncthreads();
        f32x4 fv[2][2];
#pragma unroll
        for (int bj = 0; bj < 2; ++bj)
#pragma unroll
            for (int n = 0; n < 2; ++n) fv[bj][n] = *(const f32x4*)(fn + col0 + bj * 128 + n * 16);
#pragma unroll
        for (int ai = 0; ai < 2; ++ai)
#pragma unroll
            for (int m = 0; m < 4; ++m) {
                const size_t row = (size_t)(row0 + ai * 128 + m * 16);
                const float rstd = spare[1024 + wr * 64 + fr + ai * 128 + m * 16];
#pragma unroll
                for (int bj = 0; bj < 2; ++bj)
#pragma unroll
                    for (int n = 0; n < 2; ++n) *(f32x4*)(out + row * DM + col0 + bj * 128 + n * 16) = acc[ai][bj][m][n] * rstd * fv[bj][n];
            }
    }
};
struct EpiU {
    static constexpr bool PERM = true, AFTER_DRAIN = false;
    bf16_t* U;
    __device__ __forceinline__ void operator()(const pg8::f32x4 (&acc)[2][2][4][2], const pg8::Unit& u, int wr, int wc, int fr, int fq) const {
        const int row0 = u.pm * 256 + wr * 64 + fr, col0 = u.pn * 256 + wc * 32 + 8 * fq;
#pragma unroll
        for (int ai = 0; ai < 2; ++ai)
#pragma unroll
            for (int m = 0; m < 4; ++m)
#pragma unroll
                for (int bj = 0; bj < 2; ++bj) {
                    u32x4 w; w.x = pk_bf16(acc[ai][bj][m][0][0], acc[ai][bj][m][0][1]); w.y = pk_bf16(acc[ai][bj][m][0][2], acc[ai][bj][m][0][3]);
                    w.z = pk_bf16(acc[ai][bj][m][1][0], acc[ai][bj][m][1][1]); w.w = pk_bf16(acc[ai][bj][m][1][2], acc[ai][bj][m][1][3]);
                    *(u32x4*)(U + (size_t)(row0 + ai * 128 + m * 16) * LDU + col0 + bj * 128) = w;
                }
    }
};

__device__ __forceinline__ void p1_rw_lora(KP P, int l, LAS unsigned char* lds, int w, int nw) {
    const int tid = ltid(), lane = tid & 63, wave = tid >> 6, fq = lane >> 4, fr = lane & 15, half = w & 1;
    const bf16_t* U = (const bf16_t*)(P->ws + WS_U);
    float* RWW = (float*)(P->ws + WS_RWW); bf16_t* RWA = (bf16_t*)(P->ws + WS_RWA); bf16_t* RWG = (bf16_t*)(P->ws + WS_RWG);
    constexpr int O_WT = 0, O_ACT = 256 * 168 * 2, LDW = 168;
    const float* mu = P->in[I_RWMU] + l * RW_IN + 1536;
    __syncthreads();
    {
        const bf16_t* LT = (const bf16_t*)(P->ws + WS_LORAT) + (size_t)(l * 512 + half * 256) * 160;
#pragma unroll 2
        for (int e = tid; e < 256 * 20; e += NTHR) { const int ch = e / 20, c = e % 20; *(LAS u32x4*)(lds + O_WT + (ch * LDW + c * 8) * 2) = *(const u32x4*)(LT + (size_t)ch * 160 + c * 8); }
    }
    float w0[2], a0[2];
#pragma unroll
    for (int q = 0; q < 2; ++q) { const int ch = half * 256 + (wave * 2 + q) * 16 + fr; w0[q] = P->in[I_RWW0][l * 512 + ch]; a0[q] = P->in[I_RWA0][l * 512 + ch]; }
    u32x4 pc[3], pp[3];
#define LORA_PREFETCH(tt_) do { _Pragma("unroll") for (int i = 0; i < 3; ++i) { const int e_ = tid + i * NTHR; if (e_ < 1280) { const int tk_ = e_ / 20, c_ = e_ % 20, tok_ = (tt_) * 64 + tk_; \
        const bf16_t* uc_ = U + (size_t)tok_ * LDU + U_RW_WD + c_ * 8; pc[i] = *(const u32x4*)uc_; pp[i] = *(const u32x4*)((tok_ & (SEQ - 1)) ? uc_ - LDU : uc_); } } } while (0)
    const int tstep = nw >> 1;
    if ((w >> 1) < NTOK / 64) LORA_PREFETCH(w >> 1);
    for (int tt = w >> 1; tt < NTOK / 64; tt += tstep) {
        const int tok0 = tt * 64;
        __syncthreads();
#pragma unroll
        for (int i = 0; i < 3; ++i) {
            const int e = tid + i * NTHR;
            if (e < 1280) {
                const int tk = e / 20, c = e % 20, tok = tok0 + tk;
                float cur[8], prv[8], av[8]; unpack8(pc[i], cur); unpack8(pp[i], prv);
                const float pf = (tok & (SEQ - 1)) ? 1.0f : 0.0f;
                const f32x4 m0 = *(const f32x4*)(mu + c * 8), m1 = *(const f32x4*)(mu + c * 8 + 4);
#pragma unroll
                for (int j = 0; j < 8; ++j) {
                    const float v = cur[j] + (prv[j] * pf - cur[j]) * ((j < 4) ? m0[j & 3] : m1[j & 3]);
                    av[j] = (c < 4) ? tanhf_(v) : ((c < 8) ? v : sigmoidf_(v));
                }
                *(LAS u32x4*)(lds + O_ACT + (tk * LDW + c * 8) * 2) = pack8(av);
            }
        }
        if (tt + tstep < NTOK / 64) LORA_PREFETCH(tt + tstep);
        __syncthreads();
#pragma unroll
        for (int q = 0; q < 2; ++q) {
            const int nrow = (wave * 2 + q) * 16 + fr;
            const bf16x8 bw = *(const LAS bf16x8*)(lds + O_WT + (nrow * LDW + fq * 8) * 2), ba = *(const LAS bf16x8*)(lds + O_WT + (nrow * LDW + 32 + fq * 8) * 2);
            const bf16x8 bg0 = *(const LAS bf16x8*)(lds + O_WT + (nrow * LDW + 64 + fq * 8) * 2), bg1 = *(const LAS bf16x8*)(lds + O_WT + (nrow * LDW + 96 + fq * 8) * 2), bg2 = *(const LAS bf16x8*)(lds + O_WT + (nrow * LDW + 128 + fq * 8) * 2);
            const int ch = half * 256 + (wave * 2 + q) * 16 + fr;
#pragma unroll
            for (int mi = 0; mi < 4; ++mi) {
                const int arow = mi * 16 + fr;
                const bf16x8 aw = *(const LAS bf16x8*)(lds + O_ACT + (arow * LDW + fq * 8) * 2), aa = *(const LAS bf16x8*)(lds + O_ACT + (arow * LDW + 32 + fq * 8) * 2);
                const bf16x8 ag0 = *(const LAS bf16x8*)(lds + O_ACT + (arow * LDW + 64 + fq * 8) * 2), ag1 = *(const LAS bf16x8*)(lds + O_ACT + (arow * LDW + 96 + fq * 8) * 2), ag2 = *(const LAS bf16x8*)(lds + O_ACT + (arow * LDW + 128 + fq * 8) * 2);
                const f32x4 z = (f32x4){0.f, 0.f, 0.f, 0.f};
                const f32x4 cw = __builtin_amdgcn_mfma_f32_16x16x32_bf16(aw, bw, z, 0, 0, 0);
                const f32x4 ca = __builtin_amdgcn_mfma_f32_16x16x32_bf16(aa, ba, z, 0, 0, 0);
                f32x4 cg = __builtin_amdgcn_mfma_f32_16x16x32_bf16(ag0, bg0, z, 0, 0, 0);
                cg = __builtin_amdgcn_mfma_f32_16x16x32_bf16(ag1, bg1, cg, 0, 0, 0);
                cg = __builtin_amdgcn_mfma_f32_16x16x32_bf16(ag2, bg2, cg, 0, 0, 0);
#pragma unroll
                for (int rg = 0; rg < 4; ++rg) {
                    const size_t o = (size_t)(tok0 + mi * 16 + fq * 4 + rg) * 512 + ch;
                    const float wlog = -softplusf_(-(w0[q] + cw[rg])) - 0.5f;
                    RWW[o] = __expf(-__expf(wlog));
                    RWA[o] = (bf16_t)(pk_bf16(sigmoidf_(a0[q] + ca[rg]), 0.f) & 0xffffu);
                    RWG[o] = (bf16_t)(pk_bf16(cg[rg], 0.f) & 0xffffu);
                }
            }
        }
    }
}

#undef LORA_PREFETCH
__device__ __forceinline__ void p1_lru_prep(KP P, int l, LAS unsigned char* lds, int wg, int nwg) {
    const int tid = ltid(), lane = tid & 63, wave = tid >> 6;
    const bf16_t* U = (const bf16_t*)(P->ws + WS_U);
    float* LA = (float*)(P->ws + WS_LRUA); float* LB = (float*)(P->ws + WS_LRUB);
    constexpr int O_WA = 0, O_WX = 34816, O_XC = 69632, O_XF = 87040;
    const int n = wg & 3;
    __syncthreads();
    {
        const bf16_t* wa = (const bf16_t*)(P->ws + WS_LRUW) + (size_t)((l * 2 + 0) * 4 + n) * 16384;
        const bf16_t* wx = (const bf16_t*)(P->ws + WS_LRUW) + (size_t)((l * 2 + 1) * 4 + n) * 16384;
#pragma unroll
        for (int e4 = 0; e4 < 4; ++e4) {
            const int e = tid + e4 * NTHR, j = e >> 4, i8 = (e & 15) * 8;
            *(LAS u32x4*)(lds + O_WA + (j * 136 + i8) * 2) = *(const u32x4*)(wa + j * 128 + i8);
            *(LAS u32x4*)(lds + O_WX + (j * 136 + i8) * 2) = *(const u32x4*)(wx + j * 128 + i8);
        }
    }
    const int jloc = wave * 16 + (lane & 15), cg = n * 128 + jloc, fq = lane >> 4;
    const float ba = P->in[I_LRUBA][l * 512 + cg], bx = P->in[I_LRUBX][l * 512 + cg], sp8 = 8.0f * softplusf_(-P->in[I_LRULAM][l * 512 + cg]);
    const int tk = tid >> 3, c16 = (tid & 7) * 16;
    const float* cw = P->in[I_LRUCW] + l * 2048 + n * 128 + c16;
    const float* cb = P->in[I_LRUCB] + l * 512 + n * 128 + c16;
    u32x4 pr[4][2];
#define LRU_PREFETCH(tt_) do { const int tok_ = (tt_) * 64 + tk, ts_ = tok_ & (SEQ - 1); _Pragma("unroll") for (int jj = 0; jj < 4; ++jj) { \
        const bf16_t* up_ = U + (size_t)(((ts_ - 3 + jj) >= 0) ? tok_ - 3 + jj : tok_) * LDU + U_LRU_X + n * 128 + c16; pr[jj][0] = *(const u32x4*)up_; pr[jj][1] = *(const u32x4*)(up_ + 8); } } while (0)
    const int tstep = nwg >> 2;
    if ((wg >> 2) < NTOK / 64) LRU_PREFETCH(wg >> 2);
    for (int tt = wg >> 2; tt < NTOK / 64; tt += tstep) {
        const int tok0 = tt * 64, tok = tok0 + tk, tseq = tok & (SEQ - 1);
        float xc[16];
#pragma unroll
        for (int q = 0; q < 4; ++q) { const f32x4 c = *(const f32x4*)(cb + q * 4); xc[q * 4 + 0] = c[0]; xc[q * 4 + 1] = c[1]; xc[q * 4 + 2] = c[2]; xc[q * 4 + 3] = c[3]; }
#pragma unroll
        for (int jj = 0; jj < 4; ++jj) {
            const bool valid = (tseq - 3 + jj) >= 0;
            float x[16]; { float t0[8], t1[8]; unpack8(pr[jj][0], t0); unpack8(pr[jj][1], t1);
#pragma unroll
                for (int j = 0; j < 8; ++j) { x[j] = t0[j]; x[8 + j] = t1[j]; } }
            const float vf = valid ? 1.0f : 0.0f;
#pragma unroll
            for (int q = 0; q < 4; ++q) { const f32x4 w = *(const f32x4*)(cw + jj * 512 + q * 4);
                xc[q * 4 + 0] += vf * w[0] * x[q * 4 + 0]; xc[q * 4 + 1] += vf * w[1] * x[q * 4 + 1]; xc[q * 4 + 2] += vf * w[2] * x[q * 4 + 2]; xc[q * 4 + 3] += vf * w[3] * x[q * 4 + 3]; }
        }
        __syncthreads();
        {
            float a8[8], b8[8];
#pragma unroll
            for (int j = 0; j < 8; ++j) { a8[j] = xc[j]; b8[j] = xc[8 + j]; }
            *(LAS u32x4*)(lds + O_XC + (tk * 136 + c16) * 2) = pack8(a8);
            *(LAS u32x4*)(lds + O_XC + (tk * 136 + c16 + 8) * 2) = pack8(b8);
#pragma unroll
            for (int q = 0; q < 4; ++q) *(LAS f32x4*)(lds + O_XF + (tk * 132 + c16 + q * 4) * 4) = (f32x4){xc[q * 4], xc[q * 4 + 1], xc[q * 4 + 2], xc[q * 4 + 3]};
        }
        __syncthreads();
        if (tt + tstep < NTOK / 64) LRU_PREFETCH(tt + tstep);
        f32x4 accA[4], accX[4];
#pragma unroll
        for (int mi = 0; mi < 4; ++mi) { accA[mi] = (f32x4){0.f, 0.f, 0.f, 0.f}; accX[mi] = (f32x4){0.f, 0.f, 0.f, 0.f}; }
#pragma unroll
        for (int kk = 0; kk < 4; ++kk) {
            const bf16x8 fa = *(const LAS bf16x8*)(lds + O_WA + (jloc * 136 + kk * 32 + fq * 8) * 2);
            const bf16x8 fx = *(const LAS bf16x8*)(lds + O_WX + (jloc * 136 + kk * 32 + fq * 8) * 2);
#pragma unroll
            for (int mi = 0; mi < 4; ++mi) {
                const bf16x8 xa = *(const LAS bf16x8*)(lds + O_XC + ((mi * 16 + (lane & 15)) * 136 + kk * 32 + fq * 8) * 2);
                accA[mi] = __builtin_amdgcn_mfma_f32_16x16x32_bf16(xa, fa, accA[mi], 0, 0, 0);
                accX[mi] = __builtin_amdgcn_mfma_f32_16x16x32_bf16(xa, fx, accX[mi], 0, 0, 0);
            }
        }
#pragma unroll
        for (int mi = 0; mi < 4; ++mi)
#pragma unroll
            for (int rg = 0; rg < 4; ++rg) {
                const int t = mi * 16 + fq * 4 + rg;
                const float xv = *(const LAS float*)(lds + O_XF + (t * 132 + jloc) * 4);
                const float r = sigmoidf_(accA[mi][rg] + ba), ig = sigmoidf_(accX[mi][rg] + bx);
                const float la = -r * sp8;
                const size_t o = (size_t)(tok0 + t) * 512 + cg;
                LA[o] = __expf(la);
                LB[o] = sqrtf(fmaxf(-expm1f(2.0f * la), 0.0f)) * (ig * xv);
            }
    }
}

#undef LRU_PREFETCH
__device__ __forceinline__ bf16x8 rw_op16(LAS unsigned char* lds, int off) { return *(const LAS bf16x8*)(lds + off); }
__device__ __forceinline__ bf16x8 rw_op8x2(LAS unsigned char* lds, int off0, int off1) { const u32x2 lo = *(const LAS u32x2*)(lds + off0), hi = *(const LAS u32x2*)(lds + off1); const u32x4 w = (u32x4){lo.x, lo.y, hi.x, hi.y}; return __builtin_bit_cast(bf16x8, w); }
__device__ __forceinline__ bf16x8 rw_accop(const f32x4 a, const f32x4 b) { u32x4 w; w.x = pk_bf16(a[0], a[1]); w.y = pk_bf16(a[2], a[3]); w.z = pk_bf16(b[0], b[1]); w.w = pk_bf16(b[2], b[3]); return __builtin_bit_cast(bf16x8, w); }
#define RW_MFMA(a, b, c) __builtin_amdgcn_mfma_f32_16x16x32_bf16(a, b, c, 0, 0, 0)
__device__ __forceinline__ void p2_rw(KP P, int l, int item, LAS unsigned char* lds) {
    const int tid = ltid(), lane = tid & 63, wave = tid >> 6, b = item >> 3, h = item & 7;
    const int fr = lane & 15, fq = lane >> 4, st = tid >> 3, sc = (tid & 7) * 8;
    const bf16_t* U = (const bf16_t*)(P->ws + WS_U);
    const float* RWW = (const float*)(P->ws + WS_RWW); const bf16_t* RWA = (const bf16_t*)(P->ws + WS_RWA); const bf16_t* RWG = (const bf16_t*)(P->ws + WS_RWG);
    bf16_t* Y = (bf16_t*)(P->ws + WS_HY);
    LAS float* F = LDSF(0);
    constexpr int CN = 0, WC = 512, TOT = 4608, LD = 4864;
    constexpr int XD = 23552, AT = 25600, RT = AT + 9216, BT = RT + 9216, KT = BT + 9216, BTT = KT + 9216, KTT = BTT + 9216, VT = KTT + 9216, GAB = VT + 9216, GAK = GAB + 9216, GRB = GAK + 9216, GRK = GRB + 9216, OO = GRK + 9216;
    __syncthreads();
    {
        const int kind = tid >> 6, c = tid & 63; float v;
        if (kind < 3) v = P->in[I_RWMU][l * RW_IN + kind * 512 + h * 64 + c];
        else if (kind == 3) v = P->in[I_RWKK][l * 512 + h * 64 + c];
        else if (kind == 4) v = P->in[I_RWKA][l * 512 + h * 64 + c];
        else if (kind == 5) v = P->in[I_RWRK][l * 512 + h * 64 + c];
        else if (kind == 6) v = P->in[I_RWLNW][l * 512 + h * 64 + c];
        else v = P->in[I_RWLNB][l * 512 + h * 64 + c];
        F[CN + kind * 64 + c] = v;
        for (int e = tid; e < 4 * 9216 / 16; e += NTHR) *(LAS u32x4*)(lds + GAB + e * 16) = (u32x4){0u, 0u, 0u, 0u};
    }
    __syncthreads();
    f32x4 ST[4];
#pragma unroll
    for (int j = 0; j < 4; ++j) ST[j] = (f32x4){0.f, 0.f, 0.f, 0.f};
    u32x4 pr_c, pk_c, pv_c, pr_p, pk_p, pv_p, pa, pg; f32x4 pw0, pw1; float pflag;
#define RW_IDS const int tid = ltid(), lane = tid & 63, wave = tid >> 6, fr = lane & 15, fq = lane >> 4, st = tid >> 3, sc = (tid & 7) * 8; (void)lane; (void)wave; (void)fr; (void)fq; (void)st; (void)sc;
#define RW_PREFETCH(ch) do { RW_IDS const int tk_ = b * SEQ + (ch) * 64 + st; const bool first_ = ((ch) == 0 && st == 0); \
        const bf16_t* uc_ = U + (size_t)tk_ * LDU + h * 64 + sc; const bf16_t* up_ = first_ ? uc_ : uc_ - LDU; pflag = first_ ? 0.f : 1.f; \
        pr_c = *(const u32x4*)(uc_ + U_RW_R); pk_c = *(const u32x4*)(uc_ + U_RW_K); pv_c = *(const u32x4*)(uc_ + U_RW_V); \
        pr_p = *(const u32x4*)(up_ + U_RW_R); pk_p = *(const u32x4*)(up_ + U_RW_K); pv_p = *(const u32x4*)(up_ + U_RW_V); \
        const size_t o_ = (size_t)tk_ * 512 + h * 64 + sc; pw0 = *(const f32x4*)(RWW + o_); pw1 = *(const f32x4*)(RWW + o_ + 4); pa = *(const u32x4*)(RWA + o_); pg = *(const u32x4*)(RWG + o_); } while (0)
    RW_PREFETCH(0);
    for (int ch = 0; ch < SEQ / 64; ++ch) {
        u32x4 cg, cvp; float bsum = 0.f;
        {   RW_IDS
        {
        float wt[8];
        {
            wt[0] = pw0[0]; wt[1] = pw0[1]; wt[2] = pw0[2]; wt[3] = pw0[3]; wt[4] = pw1[0]; wt[5] = pw1[1]; wt[6] = pw1[2]; wt[7] = pw1[3];
            const int sl = lane >> 3;
#pragma unroll
            for (int d = 1; d < 8; d <<= 1) {
#pragma unroll
                for (int j = 0; j < 8; ++j) { const float o = __shfl_up(wt[j], 8 * d); if (sl >= d) wt[j] *= o; }
            }
            if (sl == 7) { *(LAS f32x4*)(F + TOT + wave * 64 + sc) = (f32x4){wt[0], wt[1], wt[2], wt[3]}; *(LAS f32x4*)(F + TOT + wave * 64 + sc + 4) = (f32x4){wt[4], wt[5], wt[6], wt[7]}; }
        }
        __syncthreads();
        {
            f32x4 b0 = (f32x4){1.f, 1.f, 1.f, 1.f}, b1 = b0;
            for (int wv = 0; wv < wave; ++wv) { b0 *= *(const LAS f32x4*)(F + TOT + wv * 64 + sc); b1 *= *(const LAS f32x4*)(F + TOT + wv * 64 + sc + 4); }
#pragma unroll
            for (int j = 0; j < 4; ++j) { wt[j] *= b0[j]; wt[4 + j] *= b1[j]; }
            *(LAS f32x4*)(F + WC + st * 64 + sc) = (f32x4){wt[0], wt[1], wt[2], wt[3]}; *(LAS f32x4*)(F + WC + st * 64 + sc + 4) = (f32x4){wt[4], wt[5], wt[6], wt[7]};
        }
        }
        float r[8], v[8], ma[8], bv[8], kp[8];
        cg = pg;
        {
            float k[8], a[8];
            {
                float c[8], p[8], m[8];
                unpack8(pr_c, c); unpack8(pr_p, p);
#pragma unroll
                for (int j = 0; j < 8; ++j) m[j] = F[CN + 0 * 64 + sc + j];
#pragma unroll
                for (int j = 0; j < 8; ++j) r[j] = c[j] + (p[j] * pflag - c[j]) * m[j];
                unpack8(pk_c, c); unpack8(pk_p, p);
#pragma unroll
                for (int j = 0; j < 8; ++j) m[j] = F[CN + 1 * 64 + sc + j];
#pragma unroll
                for (int j = 0; j < 8; ++j) k[j] = c[j] + (p[j] * pflag - c[j]) * m[j];
                unpack8(pv_c, c); unpack8(pv_p, p);
#pragma unroll
                for (int j = 0; j < 8; ++j) m[j] = F[CN + 2 * 64 + sc + j];
#pragma unroll
                for (int j = 0; j < 8; ++j) v[j] = c[j] + (p[j] * pflag - c[j]) * m[j];
                unpack8(pa, a);
            }
            float ss = 0.f, kkv[8];
#pragma unroll
            for (int j = 0; j < 8; ++j) { kkv[j] = k[j] * F[CN + 3 * 64 + sc + j]; ss += kkv[j] * kkv[j]; }
            ss = red8(ss);
            const float inv = 1.0f / fmaxf(sqrtf(ss + 1e-12f), 1e-6f);
#pragma unroll
            for (int j = 0; j < 8; ++j) {
                const float kn = kkv[j] * inv;
                kp[j] = k[j] * (1.0f + (a[j] - 1.0f) * F[CN + 4 * 64 + sc + j]);
                ma[j] = -kn; bv[j] = kn * a[j];
                bsum += r[j] * kp[j] * F[CN + 5 * 64 + sc + j];
            }
            bsum = red8(bsum);
        }
        {
#pragma unroll
            for (int j = 0; j < 8; j += 2) {
                const unsigned pw = pk_bf16(v[j], v[j + 1]);
                *(LAS bf16_t*)(lds + VT + ((sc + j) * 72 + st) * 2) = (bf16_t)(pw & 0xffffu);
                *(LAS bf16_t*)(lds + VT + ((sc + j + 1) * 72 + st) * 2) = (bf16_t)(pw >> 16);
            }
        }
        cvp = pack8(v);
        {
            float al[8], be[8], ka[8], rh[8];
            const f32x4 wa0 = *(const LAS f32x4*)(F + WC + st * 64 + sc), wa1 = *(const LAS f32x4*)(F + WC + st * 64 + sc + 4);
#pragma unroll
            for (int j = 0; j < 8; ++j) {
                const float wtj = (j < 4) ? wa0[j & 3] : wa1[j & 3];
                const float w1 = (j < 4) ? pw0[j & 3] : pw1[j & 3], iw = fast_rcp(wtj), wp = wtj * fast_rcp(w1);
                al[j] = ma[j] * wp; be[j] = bv[j] * iw; ka[j] = kp[j] * iw; rh[j] = r[j] * wtj;
            }
            const u32x4 qa = pack8(al), qb = pack8(be), qk = pack8(ka), qr = pack8(rh);
            *(LAS u32x4*)(lds + AT + (st * 72 + sc) * 2) = qa; *(LAS u32x4*)(lds + RT + (st * 72 + sc) * 2) = qr;
            *(LAS u32x4*)(lds + BT + (st * 72 + sc) * 2) = qb; *(LAS u32x4*)(lds + KT + (st * 72 + sc) * 2) = qk;
#pragma unroll
            for (int j = 0; j < 8; ++j) {
                const unsigned wb = qb[j >> 1], wk = qk[j >> 1];
                *(LAS bf16_t*)(lds + BTT + ((sc + j) * 72 + st) * 2) = (bf16_t)((j & 1) ? (wb >> 16) : (wb & 0xffffu));
                *(LAS bf16_t*)(lds + KTT + ((sc + j) * 72 + st) * 2) = (bf16_t)((j & 1) ? (wk >> 16) : (wk & 0xffffu));
            }
        }
        }
        __syncthreads();
        if (ch + 1 < SEQ / 64) RW_PREFETCH(ch + 1);
        {   RW_IDS
            const int m = wave >> 1;
            const int ta = (m < 2) ? AT : RT, tb = (m & 1) ? KT : BT, tg = GAB + m * 9216;
#pragma unroll
            for (int e = 0; e < 5; ++e) {
                int ti, ji;
                if (wave & 1) { ti = (e < 2) ? 1 : 2; ji = (e < 2) ? e : e - 2; } else { ti = (e < 1) ? 0 : 3; ji = (e < 1) ? 0 : e - 1; }
                f32x4 g = (f32x4){0.f, 0.f, 0.f, 0.f};
#pragma unroll
                for (int kk = 0; kk < 2; ++kk) g = RW_MFMA(rw_op16(lds, ta + ((ti * 16 + fr) * 72 + kk * 32 + fq * 8) * 2), rw_op16(lds, tb + ((ji * 16 + fr) * 72 + kk * 32 + fq * 8) * 2), g);
#pragma unroll
                for (int rg = 0; rg < 4; ++rg) {
                    const int t = ti * 16 + fq * 4 + rg, j = ji * 16 + fr;
                    const bool keep = (m >= 2) ? (j <= t) : (j < t);
                    const float val = keep ? g[rg] : 0.f;
                    *(LAS bf16_t*)(lds + tg + (t * 72 + j) * 2) = (bf16_t)(pk_bf16(val, 0.f) & 0xffffu);
                    if (m == 0 && ti == ji) F[LD + ti * 256 + (fq * 4 + rg) * 16 + fr] = val;
                }
            }
        }
        __syncthreads();
        f32x4 Yc[4]; bf16x8 s0b[2], vtb[2];
        {   RW_IDS
        if (wave == 4) {
            const int c = lane >> 4, col = lane & 15;
            float x[16];
#pragma unroll
            for (int t = 0; t < 16; ++t) {
                float acc = (t == col) ? 1.0f : 0.0f, acc1 = 0.f;
#pragma unroll
                for (int j = 0; j < t; ++j) { if (j & 1) acc1 += F[LD + c * 256 + t * 16 + j] * x[j]; else acc += F[LD + c * 256 + t * 16 + j] * x[j]; }
                acc += acc1;
                x[t] = acc;
                __builtin_amdgcn_sched_barrier(0);
                *(LAS bf16_t*)(lds + XD + ((c * 16 + t) * 16 + col) * 2) = (bf16_t)(pk_bf16(acc, 0.f) & 0xffffu);
            }
        }
        if (wave < 4) {
#pragma unroll
            for (int kk = 0; kk < 2; ++kk) { s0b[kk] = rw_accop(ST[2 * kk], ST[2 * kk + 1]); vtb[kk] = rw_op16(lds, VT + ((wave * 16 + fr) * 72 + kk * 32 + fq * 8) * 2); }
#pragma unroll
            for (int c = 0; c < 4; ++c) {
                const int row = c * 16 + fr;
                f32x4 y = (f32x4){0.f, 0.f, 0.f, 0.f};
#pragma unroll
                for (int kk = 0; kk < 2; ++kk) y = RW_MFMA(rw_op8x2(lds, AT + (row * 72 + kk * 32 + fq * 4) * 2, AT + (row * 72 + kk * 32 + 16 + fq * 4) * 2), s0b[kk], y);
                y = RW_MFMA(rw_op16(lds, GAK + (row * 72 + fq * 8) * 2), vtb[0], y);
                if (c >= 2) y = RW_MFMA(rw_op16(lds, GAK + (row * 72 + 32 + fq * 8) * 2), vtb[1], y);
                Yc[c] = y;
            }
        }
        }
        __syncthreads();
        {   RW_IDS
        if (wave < 4) {
            const f32x4 z4 = (f32x4){0.f, 0.f, 0.f, 0.f};
#define RW_XOP(c) __builtin_bit_cast(bf16x8, (u32x4){(*(const LAS u32x2*)(lds + XD + (((c) * 16 + fr) * 16 + fq * 4) * 2)).x, (*(const LAS u32x2*)(lds + XD + (((c) * 16 + fr) * 16 + fq * 4) * 2)).y, 0u, 0u})
#define RW_LOP(c, kk) rw_op8x2(lds, GAB + (((c) * 16 + fr) * 72 + (kk) * 32 + fq * 4) * 2, GAB + (((c) * 16 + fr) * 72 + (kk) * 32 + 16 + fq * 4) * 2)
            const f32x4 U0 = RW_MFMA(RW_XOP(0), rw_accop(Yc[0], z4), z4);
            const f32x4 Y1 = RW_MFMA(RW_LOP(1, 0), rw_accop(U0, z4), Yc[1]);
            const f32x4 U1 = RW_MFMA(RW_XOP(1), rw_accop(Y1, z4), z4);
            const bf16x8 ub0 = rw_accop(U0, U1);
            const f32x4 Y2 = RW_MFMA(RW_LOP(2, 0), ub0, Yc[2]);
            const f32x4 U2 = RW_MFMA(RW_XOP(2), rw_accop(Y2, z4), z4);
            f32x4 Y3 = RW_MFMA(RW_LOP(3, 0), ub0, Yc[3]);
            Y3 = RW_MFMA(RW_LOP(3, 1), rw_accop(U2, z4), Y3);
            const f32x4 U3 = RW_MFMA(RW_XOP(3), rw_accop(Y3, z4), z4);
            const bf16x8 ub1 = rw_accop(U2, U3);
#undef RW_XOP
#undef RW_LOP
            {
                f32x4 o[4];
#pragma unroll
                for (int c = 0; c < 4; ++c) o[c] = (f32x4){0.f, 0.f, 0.f, 0.f};
#pragma unroll
                for (int kk = 0; kk < 2; ++kk)
#pragma unroll
                    for (int c = 0; c < 4; ++c) o[c] = RW_MFMA(rw_op8x2(lds, RT + ((c * 16 + fr) * 72 + kk * 32 + fq * 4) * 2, RT + ((c * 16 + fr) * 72 + kk * 32 + 16 + fq * 4) * 2), s0b[kk], o[c]);
#pragma unroll
                for (int c = 0; c < 4; ++c) o[c] = RW_MFMA(rw_op8x2(lds, GRB + ((c * 16 + fr) * 72 + fq * 4) * 2, GRB + ((c * 16 + fr) * 72 + 16 + fq * 4) * 2), ub0, o[c]);
#pragma unroll
                for (int c = 0; c < 4; ++c) o[c] = RW_MFMA(rw_op16(lds, GRK + ((c * 16 + fr) * 72 + fq * 8) * 2), vtb[0], o[c]);
#pragma unroll
                for (int c = 2; c < 4; ++c) o[c] = RW_MFMA(rw_op8x2(lds, GRB + ((c * 16 + fr) * 72 + 32 + fq * 4) * 2, GRB + ((c * 16 + fr) * 72 + 48 + fq * 4) * 2), ub1, o[c]);
#pragma unroll
                for (int c = 2; c < 4; ++c) o[c] = RW_MFMA(rw_op16(lds, GRK + ((c * 16 + fr) * 72 + 32 + fq * 8) * 2), vtb[1], o[c]);
#pragma unroll
                for (int c = 0; c < 4; ++c)
#pragma unroll
                    for (int rg = 0; rg < 4; ++rg) *(LAS float*)(lds + OO + ((c * 16 + fq * 4 + rg) * 68 + wave * 16 + fr) * 4) = o[c][rg];
            }
#pragma unroll
            for (int kt = 0; kt < 4; ++kt) ST[kt] = RW_MFMA(rw_op8x2(lds, BTT + ((kt * 16 + fr) * 72 + fq * 4) * 2, BTT + ((kt * 16 + fr) * 72 + 16 + fq * 4) * 2), ub0, ST[kt]);
#pragma unroll
            for (int kt = 0; kt < 4; ++kt) ST[kt] = RW_MFMA(rw_op8x2(lds, BTT + ((kt * 16 + fr) * 72 + 32 + fq * 4) * 2, BTT + ((kt * 16 + fr) * 72 + 48 + fq * 4) * 2), ub1, ST[kt]);
#pragma unroll
            for (int kt = 0; kt < 4; ++kt) ST[kt] = RW_MFMA(rw_op16(lds, KTT + ((kt * 16 + fr) * 72 + fq * 8) * 2), vtb[0], ST[kt]);
#pragma unroll
            for (int kt = 0; kt < 4; ++kt) ST[kt] = RW_MFMA(rw_op16(lds, KTT + ((kt * 16 + fr) * 72 + 32 + fq * 8) * 2), vtb[1], ST[kt]);
#pragma unroll
            for (int kt = 0; kt < 4; ++kt) ST[kt] *= *(const LAS f32x4*)(F + WC + 63 * 64 + kt * 16 + fq * 4);
        }
        }
        __syncthreads();
        {   RW_IDS
            const f32x4 o0 = *(const LAS f32x4*)(lds + OO + (st * 68 + sc) * 4), o1 = *(const LAS f32x4*)(lds + OO + (st * 68 + sc + 4) * 4);
            float o[8] = {o0[0], o0[1], o0[2], o0[3], o1[0], o1[1], o1[2], o1[3]}, v8[8], g8[8], y8[8];
            unpack8(cvp, v8); unpack8(cg, g8);
            float sm = 0.f;
#pragma unroll
            for (int j = 0; j < 8; ++j) sm += o[j];
            const float mean = red8(sm) * (1.0f / 64.0f);
            float q = 0.f;
#pragma unroll
            for (int j = 0; j < 8; ++j) { o[j] -= mean; q += o[j] * o[j]; }
            const float rs = rsqrtf(red8(q) * (1.0f / 64.0f) + 64e-5f);
#pragma unroll
            for (int j = 0; j < 8; ++j) y8[j] = (o[j] * rs * F[CN + 6 * 64 + sc + j] + F[CN + 7 * 64 + sc + j] + bsum * v8[j]) * g8[j];
            *(u32x4*)(Y + (size_t)(b * SEQ + ch * 64 + st) * DM + 512 + h * 64 + sc) = pack8(y8);
        }
    }
#undef RW_PREFETCH
#undef RW_IDS
}
#undef RW_MFMA


__device__ __forceinline__ void p2_hg(KP P, int l, int item, LAS unsigned char* lds) {
    const int tid = ltid(), lane = tid & 63, wave = tid >> 6, b = item >> 2, h = item & 3;
    const int fr = lane & 15, fq = lane >> 4, st = tid >> 3, c16 = tid & 7, sv = c16 * 16;
    const bf16_t* U = (const bf16_t*)(P->ws + WS_U); bf16_t* Y = (bf16_t*)(P->ws + WS_HY);
    LAS float* F = LDSF(0);
    constexpr int LBO = 0, HN = 128, FF = 256, TT = 8448;
    constexpr int QB = 35840, KB = QB + 64 * 136 * 2, KT = KB + 64 * 136 * 2, VT = KT + 128 * 72 * 2, AB = VT + 128 * 72 * 2, OO = AB + 64 * 40 * 2;
    __syncthreads();
    if (tid < 128) { float lb = 0.f; if (l == 1) lb = sigmoidf_(P->in[I_HGLB][512 + h * 128 + tid] - P->in[I_HGLB][h * 128 + tid]); F[LBO + tid] = lb; F[HN + tid] = P->in[I_HGNORM][l * 512 + h * 128 + tid]; }
    __syncthreads();
    f32x4 S[8];
#pragma unroll
    for (int j = 0; j < 8; ++j) S[j] = (f32x4){0.f, 0.f, 0.f, 0.f};
    u32x4 pq0, pq1, pf0, pf1, pv0, pv1;
#define HG_IDS const int tid = ltid(), lane = tid & 63, wave = tid >> 6, fr = lane & 15, fq = lane >> 4, st = tid >> 3, c16 = tid & 7, sv = c16 * 16; (void)lane; (void)wave; (void)fr; (void)fq; (void)st; (void)c16; (void)sv;
#define HG_PREFETCH(ch) do { HG_IDS const bf16_t* ur_ = U + (size_t)(b * SEQ + (ch) * 64 + st) * LDU + h * 128; \
        pq0 = *(const u32x4*)(ur_ + U_HG_Q + c16 * 16); pq1 = *(const u32x4*)(ur_ + U_HG_Q + c16 * 16 + 8); pf0 = *(const u32x4*)(ur_ + U_HG_F + c16 * 16); pf1 = *(const u32x4*)(ur_ + U_HG_F + c16 * 16 + 8); \
        pv0 = *(const u32x4*)(ur_ + U_HG_I + sv); pv1 = *(const u32x4*)(ur_ + U_HG_I + sv + 8); } while (0)
    HG_PREFETCH(0);
    for (int ch = 0; ch < SEQ / 64; ++ch) {
        float fo[16], kx[16], qs[16];
        u32x4 cg0, cg1;
        {   HG_IDS
            { const bf16_t* ug_ = U + (size_t)(b * SEQ + ch * 64 + st) * LDU + U_HG_G + h * 128 + sv; cg0 = *(const u32x4*)ug_; cg1 = *(const u32x4*)(ug_ + 8); }
            float q[16], z[16];
            { float t0[8], t1[8]; unpack8(pq0, t0); unpack8(pq1, t1);
#pragma unroll
              for (int j = 0; j < 8; ++j) { q[j] = t0[j]; q[8 + j] = t1[j]; }
              unpack8(pf0, t0); unpack8(pf1, t1);
#pragma unroll
              for (int j = 0; j < 8; ++j) { z[j] = t0[j]; z[8 + j] = t1[j]; } }
#pragma unroll
            for (int j = 0; j < 16; ++j) {
                const float lb = F[LBO + c16 * 16 + j], e = __expf(-z[j]), sg = fast_rcp(1.0f + e);
                fo[j] = lb + (1.0f - lb) * sg; kx[j] = (1.0f - lb) * (e * sg);
                qs[j] = siluf_(q[j]);
            }
        }
        const u32x4 cv0 = pv0, cv1 = pv1;
        __syncthreads();
        {   HG_IDS
#pragma unroll
            for (int m = 0; m < 4; ++m) *(LAS f32x4*)(F + FF + st * 128 + c16 * 16 + 4 * m) = (f32x4){fo[4 * m], fo[4 * m + 1], fo[4 * m + 2], fo[4 * m + 3]};
#pragma unroll
            for (int j = 0; j < 8; ++j) {
                const unsigned w0 = cv0[j >> 1], w1 = cv1[j >> 1];
                *(LAS bf16_t*)(lds + VT + ((sv + j) * 72 + st) * 2) = (bf16_t)((j & 1) ? (w0 >> 16) : (w0 & 0xffffu));
                *(LAS bf16_t*)(lds + VT + ((sv + 8 + j) * 72 + st) * 2) = (bf16_t)((j & 1) ? (w1 >> 16) : (w1 & 0xffffu));
            }
        }
        __syncthreads();
        {   HG_IDS
            const int kk = tid & 127, w4 = tid >> 7; float c = 1.0f;
#pragma unroll 4
            for (int i = 0; i < 16; ++i) { const int ix = FF + (w4 * 16 + i) * 128 + kk; c *= F[ix]; F[ix] = c; }
            F[TT + w4 * 128 + kk] = c;
        }
        __syncthreads();
        if ((ltid() >> 7) & 1) {   HG_IDS
            const int kk = tid & 127, w4 = tid >> 7; const float m0 = F[TT + (w4 - 1) * 128 + kk];
#pragma unroll 4
            for (int i = 0; i < 16; ++i) F[FF + (w4 * 16 + i) * 128 + kk] *= m0;
        }
        __syncthreads();
        {   HG_IDS
#pragma unroll
            for (int m = 0; m < 4; ++m) {
                const f32x4 c4 = *(const LAS f32x4*)(F + FF + st * 128 + c16 * 16 + 4 * m);
                float qc[4], kc[4];
#pragma unroll
                for (int j = 0; j < 4; ++j) { const float cc = fmaxf(c4[j], 1e-30f); qc[j] = qs[4 * m + j] * cc; kc[j] = kx[4 * m + j] * fast_rcp(cc); }
                u32x2 w; w.x = pk_bf16(qc[0], qc[1]); w.y = pk_bf16(qc[2], qc[3]);
                *(LAS u32x2*)(lds + QB + (st * 136 + c16 * 16 + 4 * m) * 2) = w;
                w.x = pk_bf16(kc[0], kc[1]); w.y = pk_bf16(kc[2], kc[3]);
                *(LAS u32x2*)(lds + KB + (st * 136 + c16 * 16 + 4 * m) * 2) = w;
                *(LAS bf16_t*)(lds + KT + ((c16 * 16 + 4 * m + 0) * 72 + st) * 2) = (bf16_t)(w.x & 0xffffu);
                *(LAS bf16_t*)(lds + KT + ((c16 * 16 + 4 * m + 1) * 72 + st) * 2) = (bf16_t)(w.x >> 16);
                *(LAS bf16_t*)(lds + KT + ((c16 * 16 + 4 * m + 2) * 72 + st) * 2) = (bf16_t)(w.y & 0xffffu);
                *(LAS bf16_t*)(lds + KT + ((c16 * 16 + 4 * m + 3) * 72 + st) * 2) = (bf16_t)(w.y >> 16);
            }
        }
        __syncthreads();
        {   HG_IDS
        if (ch + 1 < SEQ / 64) HG_PREFETCH(ch + 1);
        {
            const int wn = wave >> 2, ti = (wave >> 1) & 1, si = wave & 1;
            f32x4 a0 = (f32x4){0.f, 0.f, 0.f, 0.f};
#pragma unroll
            for (int kk = 0; kk < 4; ++kk) {
                const bf16x8 qa = *(const LAS bf16x8*)(lds + QB + ((wn * 32 + ti * 16 + fr) * 136 + kk * 32 + fq * 8) * 2);
                const bf16x8 k0 = *(const LAS bf16x8*)(lds + KB + ((wn * 32 + si * 16 + fr) * 136 + kk * 32 + fq * 8) * 2);
                a0 = __builtin_amdgcn_mfma_f32_16x16x32_bf16(qa, k0, a0, 0, 0, 0);
            }
#pragma unroll
            for (int rg = 0; rg < 4; ++rg) {
                const int tl = ti * 16 + fq * 4 + rg, sl = si * 16 + fr;
                const unsigned w0 = pk_bf16((sl <= tl) ? a0[rg] : 0.f, 0.f) & 0xffffu;
                *(LAS bf16_t*)(lds + AB + ((wn * 32 + tl) * 40 + sl) * 2) = (bf16_t)w0;
            }
        }
        }
        __syncthreads();
        {   HG_IDS
        *(LAS u32x4*)(lds + KB + (st * 136 + sv) * 2) = cg0; *(LAS u32x4*)(lds + KB + (st * 136 + sv + 8) * 2) = cg1;
        {
            bf16x8 vb[2];
#pragma unroll
            for (int wn = 0; wn < 2; ++wn) vb[wn] = *(const LAS bf16x8*)(lds + VT + ((wave * 16 + fr) * 72 + wn * 32 + fq * 8) * 2);
#pragma unroll
            for (int wn = 0; wn < 2; ++wn) {
                bf16x8 mb[4];
#pragma unroll
                for (int kk = 0; kk < 4; ++kk) {
                    u32x4 w; w.x = pk_bf16(S[2 * kk][0], S[2 * kk][1]); w.y = pk_bf16(S[2 * kk][2], S[2 * kk][3]); w.z = pk_bf16(S[2 * kk + 1][0], S[2 * kk + 1][1]); w.w = pk_bf16(S[2 * kk + 1][2], S[2 * kk + 1][3]);
                    mb[kk] = __builtin_bit_cast(bf16x8, w);
                }
                {
                    f32x4 o[2];
#pragma unroll
                    for (int ti = 0; ti < 2; ++ti) o[ti] = __builtin_amdgcn_mfma_f32_16x16x32_bf16(*(const LAS bf16x8*)(lds + AB + ((wn * 32 + ti * 16 + fr) * 40 + fq * 8) * 2), vb[wn], (f32x4){0.f, 0.f, 0.f, 0.f}, 0, 0, 0);
#pragma unroll
                    for (int kk = 0; kk < 4; ++kk) {
#pragma unroll
                        for (int ti = 0; ti < 2; ++ti) {
                            const int row = wn * 32 + ti * 16 + fr;
                            const u32x2 lo = *(const LAS u32x2*)(lds + QB + (row * 136 + kk * 32 + fq * 4) * 2), hi = *(const LAS u32x2*)(lds + QB + (row * 136 + kk * 32 + 16 + fq * 4) * 2);
                            const u32x4 w = (u32x4){lo.x, lo.y, hi.x, hi.y};
                            o[ti] = __builtin_amdgcn_mfma_f32_16x16x32_bf16(__builtin_bit_cast(bf16x8, w), mb[kk], o[ti], 0, 0, 0);
                        }
#pragma unroll
                        for (int k2 = 0; k2 < 2; ++k2) {
                            const int kt = kk * 2 + k2;
                            const bf16x8 ka = *(const LAS bf16x8*)(lds + KT + ((kt * 16 + fr) * 72 + wn * 32 + fq * 8) * 2);
                            S[kt] = __builtin_amdgcn_mfma_f32_16x16x32_bf16(ka, vb[wn], S[kt], 0, 0, 0);
                        }
                    }
#pragma unroll
                    for (int ti = 0; ti < 2; ++ti)
#pragma unroll
                        for (int rg = 0; rg < 4; ++rg) *(LAS float*)(lds + OO + ((wn * 32 + ti * 16 + fq * 4 + rg) * 132 + wave * 16 + fr) * 4) = o[ti][rg];
#pragma unroll
                    for (int kt = 0; kt < 8; ++kt) S[kt] *= *(const LAS f32x4*)(F + FF + (wn * 32 + 31) * 128 + kt * 16 + fq * 4);
                }
            }
        }
        }
        __syncthreads();
        {   HG_IDS
            float ss = 0.f;
#pragma unroll
            for (int m = 0; m < 4; ++m) { const f32x4 x = *(const LAS f32x4*)(lds + OO + (st * 132 + sv + 4 * m) * 4); ss += x[0] * x[0] + x[1] * x[1] + x[2] * x[2] + x[3] * x[3]; }
            const float rs = rsqrtf(red8(ss) * (1.0f / 128.0f) + 1e-6f);
            bf16_t* yr = Y + (size_t)(b * SEQ + ch * 64 + st) * DM + h * 128 + sv;
#pragma unroll 1
            for (int hf = 0; hf < 2; ++hf) {
                const f32x4 x0 = *(const LAS f32x4*)(lds + OO + (st * 132 + sv + hf * 8) * 4), x1 = *(const LAS f32x4*)(lds + OO + (st * 132 + sv + hf * 8 + 4) * 4);
                const f32x4 n0 = *(const LAS f32x4*)(F + HN + sv + hf * 8), n1 = *(const LAS f32x4*)(F + HN + sv + hf * 8 + 4);
                float g[8], y8[8]; unpack8(*(const LAS u32x4*)(lds + KB + (st * 136 + sv + hf * 8) * 2), g);
#pragma unroll
                for (int j = 0; j < 4; ++j) { y8[j] = x0[j] * rs * n0[j] * siluf_(g[j]); y8[4 + j] = x1[j] * rs * n1[j] * siluf_(g[4 + j]); }
                *(u32x4*)(yr + hf * 8) = pack8(y8);
            }
        }
    }
#undef HG_PREFETCH
#undef HG_IDS
}

__device__ __forceinline__ void p2_ml(KP P, int l, int item, LAS unsigned char* lds) {
    const int tid = ltid(), lane = tid & 63, wave = tid >> 6, b = item >> 2, h = item & 3;
    const int fr = lane & 15, fq = lane >> 4, st = tid >> 3, c8 = tid & 7, sv = c8 * 16;
    const int blk = tid & 31, sg = tid >> 5;
    const bf16_t* U = (const bf16_t*)(P->ws + WS_U); bf16_t* Y = (bf16_t*)(P->ws + WS_HY);
    LAS float* F = LDSF(0);
    constexpr int FD = 0, IW = 64, EN = 128, RS = 256, NK = 512, TNS = 768, CT = 1280, MN = 2944, MS = 3072;
    constexpr int QB = 12800, KB = QB + 64 * 136 * 2, KT = KB + 64 * 136 * 2, VT = KT + 128 * 72 * 2, AB = VT + 128 * 72 * 2, OO = AB + 64 * 72 * 2, XC = OO + 64 * 132 * 4;
    __syncthreads();
    if (tid < 32) {
        const int cgl = h * 128 + blk * 4;
#pragma unroll
        for (int jj = 0; jj < 4; ++jj) *(LAS f32x4*)(F + CT + (jj * 32 + blk) * 4) = *(const f32x4*)(P->in[I_MLCW] + l * 2048 + jj * 512 + cgl);
        *(LAS f32x4*)(F + CT + (4 * 32 + blk) * 4) = *(const f32x4*)(P->in[I_MLCB] + l * 512 + cgl);
#pragma unroll
        for (int j = 0; j < 4; ++j) {
            *(LAS f32x4*)(F + CT + ((5 + j) * 32 + blk) * 4) = *(const f32x4*)(P->in[I_MLWQ] + (size_t)l * 2048 + (h * 32 + blk) * 16 + j * 4) * 0.08838834764831845f;
            *(LAS f32x4*)(F + CT + ((9 + j) * 32 + blk) * 4) = *(const f32x4*)(P->in[I_MLWK] + (size_t)l * 2048 + (h * 32 + blk) * 16 + j * 4);
        }
    }
    const float ib = P->in[I_MLIB][l * 4 + h], fb = P->in[I_MLFB][l * 4 + h];
    f32x4 M[8];
#pragma unroll
    for (int j = 0; j < 8; ++j) M[j] = (f32x4){0.f, 0.f, 0.f, 0.f};
    float mcarry = 0.f;
    u32x2 px[7]; u32x4 pv0, pv1; unsigned pif;
#define ML_IDS const int tid = ltid(), lane = tid & 63, wave = tid >> 6, fr = lane & 15, fq = lane >> 4, st = tid >> 3, c8 = tid & 7, sv = c8 * 16, blk = tid & 31, sg = tid >> 5; (void)lane; (void)wave; (void)fr; (void)fq; (void)st; (void)c8; (void)sv; (void)blk; (void)sg;
#define ML_PREFETCH(ch) do { ML_IDS const int ts0_ = (ch) * 64 + sg * 4 - 3; \
        _Pragma("unroll") for (int r = 0; r < 7; ++r) { const int ts_ = ts0_ + r; \
            px[r] = *(const u32x2*)(U + (size_t)(b * SEQ + (ts_ < 0 ? 0 : ts_)) * LDU + U_ML_X + h * 128 + blk * 4); } \
        { const bf16_t* uv_ = U + (size_t)(b * SEQ + (ch) * 64 + st) * LDU + U_ML_V + h * 128 + sv; pv0 = *(const u32x4*)uv_; pv1 = *(const u32x4*)(uv_ + 8); } \
        { const bf16_t* ug_ = U + (size_t)(b * SEQ + (ch) * 64 + lane) * LDU; pif = (unsigned)ug_[U_ML_I + h] | ((unsigned)ug_[U_ML_F + h] << 16); } } while (0)
    if (tid < 128) { F[NK + tid] = 0.f; F[MN + tid] = P->in[I_MLNORM][l * 512 + h * 128 + tid]; F[MS + tid] = P->in[I_MLSKIP][l * 512 + h * 128 + tid]; }
    ML_PREFETCH(0);
    __syncthreads();
    for (int ch = 0; ch < SEQ / 64; ++ch) {
        const u32x4 cv0 = pv0, cv1 = pv1;
        u32x4 co0, co1;
        {   ML_IDS
        { const bf16_t* uo_ = U + (size_t)(b * SEQ + ch * 64 + st) * LDU + U_ML_O + h * 128 + sv; co0 = *(const u32x4*)uo_; co1 = *(const u32x4*)(uo_ + 8); }
        }
        __syncthreads();
        float q[4][4], k[4][4];
        {   ML_IDS
        {
            float xc[4][4];
            {
                f32x4 cw[4];
#pragma unroll
                for (int j = 0; j < 4; ++j) cw[j] = *(const LAS f32x4*)(F + CT + (j * 32 + blk) * 4);
                const f32x4 cb4 = *(const LAS f32x4*)(F + CT + (4 * 32 + blk) * 4);
                float x[7][4];
#pragma unroll
                for (int r = 0; r < 7; ++r) { const float vf = (ch * 64 + sg * 4 - 3 + r) < 0 ? 0.f : 1.f; x[r][0] = vf * bflo(px[r].x); x[r][1] = vf * bfhi(px[r].x); x[r][2] = vf * bflo(px[r].y); x[r][3] = vf * bfhi(px[r].y); }
#pragma unroll
                for (int s = 0; s < 4; ++s)
#pragma unroll
                    for (int j = 0; j < 4; ++j) xc[s][j] = siluf_(cb4[j] + cw[0][j] * x[s][j] + cw[1][j] * x[s + 1][j] + cw[2][j] * x[s + 2][j] + cw[3][j] * x[s + 3][j]);
            }
#pragma unroll
            for (int s = 0; s < 4; ++s) { u32x2 w; w.x = pk_bf16(xc[s][0], xc[s][1]); w.y = pk_bf16(xc[s][2], xc[s][3]); *(LAS u32x2*)(lds + XC + ((sg * 4 + s) * 136 + blk * 4) * 2) = w; }
            __builtin_amdgcn_sched_barrier(0);
            {
                f32x4 wq[4];
#pragma unroll
                for (int j = 0; j < 4; ++j) wq[j] = *(const LAS f32x4*)(F + CT + ((5 + j) * 32 + blk) * 4);
#pragma unroll
                for (int s = 0; s < 4; ++s)
#pragma unroll
                    for (int i = 0; i < 4; ++i) q[s][i] = xc[s][0] * wq[0][i] + xc[s][1] * wq[1][i] + xc[s][2] * wq[2][i] + xc[s][3] * wq[3][i];
            }
            __builtin_amdgcn_sched_barrier(0);
            {
                f32x4 wk[4];
#pragma unroll
                for (int j = 0; j < 4; ++j) wk[j] = *(const LAS f32x4*)(F + CT + ((9 + j) * 32 + blk) * 4);
#pragma unroll
                for (int s = 0; s < 4; ++s)
#pragma unroll
                    for (int i = 0; i < 4; ++i) k[s][i] = xc[s][0] * wk[0][i] + xc[s][1] * wk[1][i] + xc[s][2] * wk[2][i] + xc[s][3] * wk[3][i];
            }
        }
        if (wave == 0) {
            const float ip = bflo(pif) + ib, xf = bfhi(pif) + fb;
            const float lf = fminf(xf, 0.f) - log1pf(__expf(-fabsf(xf)));
            const float bs = wave_scan_sum(lf);
            const float cm = wave_scan_max(ip - bs);
            const float g = fmaxf(mcarry, cm), mt = bs + g;
            const int lq = lane + lsgpr(0);
            F[FD + lq] = __expf(mcarry - g);
            F[IW + lq] = __expf(ip - bs - mcarry);
            F[EN + lq] = __expf(-mt);
            mcarry = __int_as_float(__builtin_amdgcn_readlane(__float_as_int(mt), 63));
        }
        }
        __syncthreads();
        {   ML_IDS
#pragma unroll
            for (int s = 0; s < 4; ++s) {
                const int t = sg * 4 + s; const float fd = F[FD + t], iw = F[IW + t];
#pragma unroll
                for (int i = 0; i < 4; ++i) { q[s][i] *= fd; k[s][i] *= iw; }
                u32x2 w; w.x = pk_bf16(q[s][0], q[s][1]); w.y = pk_bf16(q[s][2], q[s][3]);
                *(LAS u32x2*)(lds + QB + (t * 136 + blk * 4) * 2) = w;
                w.x = pk_bf16(k[s][0], k[s][1]); w.y = pk_bf16(k[s][2], k[s][3]);
                *(LAS u32x2*)(lds + KB + (t * 136 + blk * 4) * 2) = w;
            }
#pragma unroll
            for (int i = 0; i < 4; ++i) {
                u32x2 w; w.x = pk_bf16(k[0][i], k[1][i]); w.y = pk_bf16(k[2][i], k[3][i]);
                *(LAS u32x2*)(lds + KT + ((blk * 4 + i) * 72 + sg * 4) * 2) = w;
            }
#pragma unroll
            for (int j = 0; j < 8; ++j) {
                const unsigned w0 = cv0[j >> 1], w1 = cv1[j >> 1];
                *(LAS bf16_t*)(lds + VT + ((sv + j) * 72 + st) * 2) = (bf16_t)((j & 1) ? (w0 >> 16) : (w0 & 0xffffu));
                *(LAS bf16_t*)(lds + VT + ((sv + 8 + j) * 72 + st) * 2) = (bf16_t)((j & 1) ? (w1 >> 16) : (w1 & 0xffffu));
            }
        }
        __syncthreads();
        {   ML_IDS
        if (ch + 1 < SEQ / 64) ML_PREFETCH(ch + 1);
        {
            const int ti = wave >> 1, si0 = 2 * (wave & 1);
            f32x4 a0 = (f32x4){0.f, 0.f, 0.f, 0.f}, a1 = a0;
#pragma unroll
            for (int kk = 0; kk < 4; ++kk) {
                const bf16x8 qa = *(const LAS bf16x8*)(lds + QB + ((ti * 16 + fr) * 136 + kk * 32 + fq * 8) * 2);
                const bf16x8 k0 = *(const LAS bf16x8*)(lds + KB + (((si0) * 16 + fr) * 136 + kk * 32 + fq * 8) * 2);
                const bf16x8 k1 = *(const LAS bf16x8*)(lds + KB + (((si0 + 1) * 16 + fr) * 136 + kk * 32 + fq * 8) * 2);
                a0 = __builtin_amdgcn_mfma_f32_16x16x32_bf16(qa, k0, a0, 0, 0, 0);
                a1 = __builtin_amdgcn_mfma_f32_16x16x32_bf16(qa, k1, a1, 0, 0, 0);
            }
#pragma unroll
            for (int rg = 0; rg < 4; ++rg) {
                const int ta = ti * 16 + fq * 4 + rg, s0 = si0 * 16 + fr, s1 = s0 + 16;
                const unsigned w0 = pk_bf16((s0 <= ta) ? a0[rg] : 0.f, 0.f) & 0xffffu, w1 = pk_bf16((s1 <= ta) ? a1[rg] : 0.f, 0.f) & 0xffffu;
                *(LAS bf16_t*)(lds + AB + (ta * 72 + s0) * 2) = (bf16_t)w0;
                *(LAS bf16_t*)(lds + AB + (ta * 72 + s1) * 2) = (bf16_t)w1;
                const float r0 = red16(bflo(w0)), r1 = red16(bflo(w1));
                if (fr == 0) { F[RS + si0 * 64 + ta] = r0; F[RS + (si0 + 1) * 64 + ta] = r1; }
            }
            const int kk = tid & 127, q4 = tid >> 7;
            const u32x4 t0 = *(const LAS u32x4*)(lds + KT + (kk * 72 + q4 * 16) * 2), t1 = *(const LAS u32x4*)(lds + KT + (kk * 72 + q4 * 16 + 8) * 2);
            float f0[8], f1[8]; unpack8(t0, f0); unpack8(t1, f1);
            float s = 0.f;
#pragma unroll
            for (int j = 0; j < 8; ++j) s += f0[j] + f1[j];
            F[TNS + q4 * 128 + kk] = s;
        }
        }
        __syncthreads();
        {   ML_IDS
        *(LAS u32x4*)(lds + KB + (st * 136 + sv) * 2) = co0; *(LAS u32x4*)(lds + KB + (st * 136 + sv + 8) * 2) = co1;
        {
            const float ce = F[FD + 63];
            bf16x8 mb[4], vb[2];
#pragma unroll
            for (int kk = 0; kk < 4; ++kk) {
                u32x4 w; w.x = pk_bf16(M[2 * kk][0], M[2 * kk][1]); w.y = pk_bf16(M[2 * kk][2], M[2 * kk][3]); w.z = pk_bf16(M[2 * kk + 1][0], M[2 * kk + 1][1]); w.w = pk_bf16(M[2 * kk + 1][2], M[2 * kk + 1][3]);
                mb[kk] = __builtin_bit_cast(bf16x8, w);
            }
#pragma unroll
            for (int kk = 0; kk < 2; ++kk) vb[kk] = *(const LAS bf16x8*)(lds + VT + ((wave * 16 + fr) * 72 + kk * 32 + fq * 8) * 2);
            {
                f32x4 o[4];
#pragma unroll
                for (int ti = 0; ti < 4; ++ti) o[ti] = (f32x4){0.f, 0.f, 0.f, 0.f};
#pragma unroll
                for (int kk = 0; kk < 2; ++kk)
#pragma unroll
                    for (int ti = 0; ti < 4; ++ti) {
                        const bf16x8 sa = *(const LAS bf16x8*)(lds + AB + ((ti * 16 + fr) * 72 + kk * 32 + fq * 8) * 2);
                        o[ti] = __builtin_amdgcn_mfma_f32_16x16x32_bf16(sa, vb[kk], o[ti], 0, 0, 0);
                    }
#pragma unroll
                for (int kk = 0; kk < 4; ++kk)
#pragma unroll
                    for (int ti = 0; ti < 4; ++ti) {
                        const u32x2 lo = *(const LAS u32x2*)(lds + QB + ((ti * 16 + fr) * 136 + kk * 32 + fq * 4) * 2), hi = *(const LAS u32x2*)(lds + QB + ((ti * 16 + fr) * 136 + kk * 32 + 16 + fq * 4) * 2);
                        const u32x4 w = (u32x4){lo.x, lo.y, hi.x, hi.y};
                        o[ti] = __builtin_amdgcn_mfma_f32_16x16x32_bf16(__builtin_bit_cast(bf16x8, w), mb[kk], o[ti], 0, 0, 0);
                    }
#pragma unroll
                for (int ti = 0; ti < 4; ++ti)
#pragma unroll
                    for (int rg = 0; rg < 4; ++rg) *(LAS float*)(lds + OO + ((ti * 16 + fq * 4 + rg) * 132 + wave * 16 + fr) * 4) = o[ti][rg];
            }
#pragma unroll
            for (int kk = 0; kk < 2; ++kk)
#pragma unroll
                for (int kt = 0; kt < 8; ++kt) {
                    const bf16x8 ka = *(const LAS bf16x8*)(lds + KT + ((kt * 16 + fr) * 72 + kk * 32 + fq * 8) * 2);
                    M[kt] = __builtin_amdgcn_mfma_f32_16x16x32_bf16(ka, vb[kk], M[kt], 0, 0, 0);
                }
#pragma unroll
            for (int kt = 0; kt < 8; ++kt) M[kt] *= ce;
            if (tid < 128) F[NK + ((ch + 1) & 1) * 128 + tid] = (F[NK + (ch & 1) * 128 + tid] + (F[TNS + tid] + F[TNS + 128 + tid]) + (F[TNS + 256 + tid] + F[TNS + 384 + tid])) * ce;
        }
        }
        __syncthreads();
        {   ML_IDS
            const u32x4 q0 = *(const LAS u32x4*)(lds + QB + (st * 136 + c8 * 16) * 2), q1 = *(const LAS u32x4*)(lds + QB + (st * 136 + c8 * 16 + 8) * 2);
            float f0[8], f1[8]; unpack8(q0, f0); unpack8(q1, f1);
            float d = 0.f;
#pragma unroll
            for (int m = 0; m < 2; ++m) {
                const f32x4 n0 = *(const LAS f32x4*)(F + NK + (ch & 1) * 128 + c8 * 16 + 4 * m), n1 = *(const LAS f32x4*)(F + NK + (ch & 1) * 128 + c8 * 16 + 8 + 4 * m);
#pragma unroll
                for (int j = 0; j < 4; ++j) d += f0[4 * m + j] * n0[j] + f1[4 * m + j] * n1[j];
            }
            d = red8(d);
            d += (F[RS + st] + F[RS + 64 + st]) + (F[RS + 128 + st] + F[RS + 192 + st]);
            const float dinv = 1.0f / fmaxf(fabsf(d), F[EN + st]);
            float o[16], og[16], xs[16];
#pragma unroll
            for (int m = 0; m < 4; ++m) { const f32x4 x = *(const LAS f32x4*)(lds + OO + (st * 132 + sv + 4 * m) * 4); o[4 * m] = x[0] * dinv; o[4 * m + 1] = x[1] * dinv; o[4 * m + 2] = x[2] * dinv; o[4 * m + 3] = x[3] * dinv; }
            { float t0[8], t1[8]; unpack8(*(const LAS u32x4*)(lds + KB + (st * 136 + sv) * 2), t0); unpack8(*(const LAS u32x4*)(lds + KB + (st * 136 + sv + 8) * 2), t1);
#pragma unroll
              for (int j = 0; j < 8; ++j) { og[j] = t0[j]; og[8 + j] = t1[j]; }
              unpack8(*(const LAS u32x4*)(lds + XC + (st * 136 + sv) * 2), t0); unpack8(*(const LAS u32x4*)(lds + XC + (st * 136 + sv + 8) * 2), t1);
#pragma unroll
              for (int j = 0; j < 8; ++j) { xs[j] = t0[j]; xs[8 + j] = t1[j]; } }
            float ss = 0.f;
#pragma unroll
            for (int j = 0; j < 16; ++j) { o[j] *= sigmoidf_(og[j]); ss += o[j] * o[j]; }
            const float rs = rsqrtf(red8(ss) * (1.0f / 128.0f) + 1e-6f);
#pragma unroll
            for (int j = 0; j < 16; ++j) o[j] = o[j] * rs * F[MN + sv + j] + F[MS + sv + j] * xs[j];
            u32x4 w0, w1;
            w0.x = pk_bf16(o[0], o[1]); w0.y = pk_bf16(o[2], o[3]); w0.z = pk_bf16(o[4], o[5]); w0.w = pk_bf16(o[6], o[7]);
            w1.x = pk_bf16(o[8], o[9]); w1.y = pk_bf16(o[10], o[11]); w1.z = pk_bf16(o[12], o[13]); w1.w = pk_bf16(o[14], o[15]);
            bf16_t* yr = Y + (size_t)(b * SEQ + ch * 64 + st) * DM + 1024 + h * 128 + sv;
            *(u32x4*)yr = w0; *(u32x4*)(yr + 8) = w1;
        }
    }
#undef ML_PREFETCH
#undef ML_IDS
}

__device__ __forceinline__ void p2_lru(KP P, int l, int item, LAS unsigned char* lds) {
    const int tid = ltid(), lane = tid & 63, wave = tid >> 6, b = item >> 3, cgp = item & 7;
    const float* LA = (const float*)(P->ws + WS_LRUA); const float* LB = (const float*)(P->ws + WS_LRUB); bf16_t* Y = (bf16_t*)(P->ws + WS_HY);
    LAS float* F = LDSF(0);
    const size_t base = (size_t)(b * SEQ + wave * 512) * 512 + cgp * 64 + lane;
    float hh = 0.f, ap = 1.f;
#pragma unroll 8
    for (int t = 0; t < 512; ++t) { const float a = LA[base + (size_t)t * 512], x = LB[base + (size_t)t * 512]; hh = a * hh + x; ap *= a; }
    __syncthreads();
    F[wave * 64 + lane] = ap; F[512 + wave * 64 + lane] = hh;
    __syncthreads();
    float c = 0.f;
    for (int j = 0; j < wave; ++j) c = F[j * 64 + lane] * c + F[512 + j * 64 + lane];
    hh = c;
    bf16_t* yp = Y + (size_t)(b * SEQ + wave * 512) * DM + 1536 + cgp * 64 + lane;
#pragma unroll 8
    for (int t = 0; t < 512; ++t) { const float a = LA[base + (size_t)t * 512], x = LB[base + (size_t)t * 512]; hh = a * hh + x; yp[(size_t)t * DM] = (bf16_t)(pk_bf16(hh, 0.f) & 0xffffu); }

    {
        unsigned* bar0 = (unsigned*)(P->ws + WS_BAR + (size_t)P->li * WS_BAR_STRIDE);
        unsigned* fl = (unsigned*)(P->ws + WS_BAR + (size_t)30 * WS_BAR_STRIDE) + (l * 8 + b) * 64 + 32;
        asm volatile("s_waitcnt vmcnt(0)" ::: "memory");
        __syncthreads();
        if (threadIdx.x == 0) {
            __builtin_amdgcn_fence(__ATOMIC_RELEASE, "agent");
            asm volatile("s_waitcnt vmcnt(0)" ::: "memory");
            (void)xb_add(fl, 1u);
            XB_SPIN(xb_ld(fl) < 8u, bar0);
            __builtin_amdgcn_fence(__ATOMIC_ACQUIRE, "agent");
            asm volatile("s_waitcnt vmcnt(0)" ::: "memory");
        }
        __syncthreads();
        const bf16_t* U = (const bf16_t*)(P->ws + WS_U);
        const int c0 = lane * 8;
        float lrn[8];
#pragma unroll
        for (int j = 0; j < 8; ++j) lrn[j] = P->in[I_LRUNORM][l * 512 + c0 + j];
#pragma unroll 2
        for (int i = 0; i < 64; ++i) {
            const int tok = b * SEQ + cgp * 512 + wave * 64 + i;
            bf16_t* yr = Y + (size_t)tok * DM; const bf16_t* ur = U + (size_t)tok * LDU;
            float hv[8], gb[8], y8[8]; unpack8(*(const u32x4*)(yr + 1536 + c0), hv); unpack8(*(const u32x4*)(ur + U_LRU_G + c0), gb);
            float ss = 0.f;
#pragma unroll
            for (int j = 0; j < 8; ++j) { hv[j] *= gelu_tanhf_(gb[j]); ss += hv[j] * hv[j]; }
            const float rs = rsqrtf(red64(ss) * (1.0f / 512.0f) + 1e-6f);
#pragma unroll
            for (int j = 0; j < 8; ++j) y8[j] = hv[j] * rs * lrn[j];
            *(u32x4*)(yr + 1536 + c0) = pack8(y8);
        }
    }
}

__device__ __forceinline__ void phase_p3(KP P, int l) { (void)P; (void)l; }

#ifndef MK_ONE_LAUNCH
#define MK_ONE_LAUNCH 1
#endif
#ifndef MK_DEBUG_BAR
#define MK_DEBUG_BAR 0
#endif
#ifndef MK_FUSE_MASK
#define MK_FUSE_MASK 0x3FFFFFFull
#endif
#ifndef MK_SEAM_DELAY
#define MK_SEAM_DELAY 0
#endif
#ifndef MK_KIND_MASK
#define MK_KIND_MASK 0x40
#endif
#ifndef MK_P1_SPLIT
#define MK_P1_SPLIT 0
#endif
#ifndef MK_REPEAT_PHASE
#define MK_REPEAT_PHASE (-1)
#endif
#ifndef MK_REPEAT_ITEM
#define MK_REPEAT_ITEM (-1)
#endif
#ifndef MK_REPEAT_KIND
#define MK_REPEAT_KIND (-1)
#endif
#ifndef MK_SIMPLE_BAR
#define MK_SIMPLE_BAR 0
#endif
__device__ __forceinline__ void simple_barrier(unsigned* bar, unsigned& epoch) {
    asm volatile("s_waitcnt vmcnt(0)" ::: "memory");
    __syncthreads();
    if (threadIdx.x == 0) {
        __builtin_amdgcn_fence(__ATOMIC_RELEASE, "agent");
        asm volatile("s_waitcnt vmcnt(0)" ::: "memory");
        (void)xb_add(&bar[XB_TOP], 1u);
        const unsigned target = (epoch + 1u) * gridDim.x;
        XB_SPIN(xb_ld(&bar[XB_TOP]) < target, bar);
        __builtin_amdgcn_fence(__ATOMIC_ACQUIRE, "agent");
        asm volatile("s_waitcnt vmcnt(0)" ::: "memory");
    }
    ++epoch;
    __syncthreads();
}
enum { K_CONVERT = 0, K_MODFINAL, K_NORM, K_UP, K_DOWN, K_WIN, K_P1, K_P2, K_P3, K_WOUT, K_FINAL, K_DOWNF };
template <int KIND> __device__ __forceinline__ void run_phase(int l_, int sub_, LAS unsigned char* lds) {
    const int l = lsgpr(l_), sub = lsgpr(sub_);
    const KP P = kp_fresh();
    const float* modf = (const float*)(P->ws + WS_MODF);
    bf16_t* HY = (bf16_t*)(P->ws + WS_HY); bf16_t* UU = (bf16_t*)(P->ws + WS_U);
    const bf16_t* Wl = (const bf16_t*)(P->ws + WS_W) + (size_t)l * LW_ELEMS;
    bf16_t* XB = (bf16_t*)P->out; bf16_t* X2 = (bf16_t*)(P->ws + WS_LRUA);
    const int xf32 = (l == 0 && sub == 0) ? 1 : 0;
    const void* xcur = xf32 ? (const void*)P->in[I_X] : ((l == 1 && sub == 2) ? (const void*)X2 : (const void*)XB);
    const int f = sub >> 1;
    if constexpr (KIND == K_CONVERT) phase_convert(P, lds);
    if constexpr (KIND == K_MODFINAL) phase_modfinal(P);
    if constexpr (KIND == K_NORM) phase_norm(P, l, sub, xcur, xf32, lds);
    if constexpr (KIND == K_UP) {
        pg8::Gemm g{HY, Wl + (f ? LW_W13B : LW_W13A), NTOK, 2 * DFF, DM}; pg8::StaticOrder S; S.init(NTOK, 2 * DFF, lgdim(), lbid());
        EpiSwiGLU E{UU};
        pg8::gemm_phase<EpiSwiGLU, pg8::StaticOrder, true, true>(lds, g, S, E);
    }
    if constexpr (KIND == K_DOWN) {
        pg8::Gemm g{UU, Wl + (f ? LW_W2B : LW_W2A), NTOK, DM, DFF}; pg8::StaticOrder S; S.init(NTOK, DM, lgdim(), lbid(), 4);
        EpiResid E{xcur, XB, modf + (size_t)l * 8 * NMOD + sub * 6144 + 4096, 0.5f, xf32};
        pg8::gemm_phase<EpiResid, pg8::StaticOrder, true, true>(lds, g, S, E);
    }
    if constexpr (KIND == K_DOWNF) {
        pg8::Gemm g{UU, Wl + (f ? LW_W2B : LW_W2A), NTOK, DM, DFF}; pg8::StaticOrder S; S.init(NTOK, DM, lgdim(), lbid(), 4);
        EpiFinal E{X2, P->out, modf + (size_t)l * 8 * NMOD + sub * 6144 + 4096, 0.5f, P->in[I_FNORM], (float*)(P->ws + WS_RWW), (unsigned*)(P->ws + WS_BAR + (size_t)29 * WS_BAR_STRIDE) + 256,
                   (unsigned*)(P->ws + WS_BAR + (size_t)P->li * WS_BAR_STRIDE), (LAS float*)(lds + pg8::STAGE_BYTES)};
        pg8::gemm_phase<EpiFinal, pg8::StaticOrder, true, true>(lds, g, S, E);
    }
    if constexpr (KIND == K_WIN) {
        pg8::Gemm g{HY, Wl + LW_WIN, NTOK, LDU, DM}; pg8::StaticOrder S; S.init(NTOK, LDU, lgdim(), lbid());
        EpiU E{UU};
        pg8::gemm_phase<EpiU, pg8::StaticOrder, true, true>(lds, g, S, E);
    }
    if constexpr (KIND == K_P1) { const int part = P->pad; if (part != 2) p1_rw_lora(P, l, lds, lbid(), lgdim()); if (part != 1) p1_lru_prep(P, l, lds, lbid(), lgdim()); }
    if constexpr (KIND == K_P2) {
        {
            const int it = lbid();
            if (it >= 64 && it < 128) {
                if (it < 96) { p2_hg(P, l, it - 64, lds); if (MK_REPEAT_ITEM == 1) p2_hg(P, l, it - 64, lds); }
                else { p2_ml(P, l, it - 96, lds); if (MK_REPEAT_ITEM == 2) p2_ml(P, l, it - 96, lds); }
            } else {
                const int w = (it < 64) ? it : it - 64;
                unsigned* ctr = (unsigned*)(P->ws + WS_BAR + (size_t)28 * WS_BAR_STRIDE) + 32 + l * 64;
                unsigned* bar0 = (unsigned*)(P->ws + WS_BAR + (size_t)P->li * WS_BAR_STRIDE);
#define GROUP_BARRIER(c_, n_) do { asm volatile("s_waitcnt vmcnt(0)" ::: "memory"); __syncthreads(); \
                    if (threadIdx.x == 0) { __builtin_amdgcn_fence(__ATOMIC_RELEASE, "agent"); asm volatile("s_waitcnt vmcnt(0)" ::: "memory"); (void)xb_add((c_), 1u); XB_SPIN(xb_ld(c_) < (n_), bar0); \
                        __builtin_amdgcn_fence(__ATOMIC_ACQUIRE, "agent"); asm volatile("s_waitcnt vmcnt(0)" ::: "memory"); } \
                    __syncthreads(); } while (0)
                p1_rw_lora(P, l, lds, w, 192);
                GROUP_BARRIER(ctr, 192u);
                if (it < 64) { _Pragma("unroll 1") for (int rep = 0; rep < ((MK_REPEAT_ITEM == 0) ? 2 : 1); ++rep) p2_rw(P, l, it, lds); }
                else {
                    p1_lru_prep(P, l, lds, it - 128, 128);
                    GROUP_BARRIER(ctr + 16, 128u);
                    if (it < 192) p2_lru(P, l, it - 128, lds);
                }
#undef GROUP_BARRIER
            }
        }
        if (l == 0) convert_dynamic(P, lds);
    }
    if constexpr (KIND == K_P3) phase_p3(P, l);
    if constexpr (KIND == K_WOUT) {
        pg8::Gemm g{HY, Wl + LW_WOUT, NTOK, DM, DM}; pg8::StaticOrder S; S.init(NTOK, DM, lgdim(), lbid(), 4);
        EpiResid E{XB, (l == 1) ? X2 : XB, modf + (size_t)l * 8 * NMOD + 1 * 6144 + 4096, 1.0f, 0};
        pg8::gemm_phase<EpiResid, pg8::StaticOrder, true, true>(lds, g, S, E);
    }
    if constexpr (KIND == K_FINAL) { }
}

template <int KIND> __global__ void __launch_bounds__(NTHR, 2) k_phase(Params P_unused, int l, int sub) {
    extern __shared__ __attribute__((aligned(16))) unsigned char lds_raw[];
    run_phase<KIND>(l, sub, (LAS unsigned char*)lds_raw);
}
constexpr int N_PHASES = 27;
__global__ void __launch_bounds__(NTHR, 2) hymba_fwd(Params P_unused) {
    extern __shared__ __attribute__((aligned(16))) unsigned char lds_raw[];
    LAS unsigned char* lds = (LAS unsigned char*)lds_raw;
    const KP P = kp_fresh();
    const int lo = P->ph_lo, hi = P->ph_hi;
    if (threadIdx.x == 0) *(LAS u32x4*)(lds + LDS_BARW) = (u32x4){0u, 0u, 0u, 0u};
    __syncthreads();
    unsigned* barw = (unsigned*)(P->ws + WS_BAR + (size_t)P->li * WS_BAR_STRIDE);
    XcdBarrier bar = xcd_barrier_post(barw, (volatile LAS unsigned*)(lds + LDS_BARW));
#define SEAM(k) do { if ((k) + 1 < hi) xcd_barrier(bar); } while (0)
#define IN(k) (lo <= (k) && (k) < hi)
#define PH(k, KIND, l, sub) do { if (IN(k)) { run_phase<KIND>(l, sub, lds); if ((MK_REPEAT_KIND) == (KIND) || (MK_REPEAT_PHASE) == (k)) { xcd_barrier(bar); run_phase<KIND>(l, sub, lds); } SEAM(k); } } while (0)
    PH(0, K_CONVERT, 0, 0);
    PH(1, K_MODFINAL, 0, 0);
#define LAYER(l, b, KDOWN2) \
    PH((b) + 0, K_NORM, l, 0); PH((b) + 1, K_UP, l, 0); PH((b) + 2, K_DOWN, l, 0); \
    PH((b) + 3, K_NORM, l, 1); PH((b) + 4, K_WIN, l, 1); PH((b) + 6, K_P2, l, 1); PH((b) + 8, K_WOUT, l, 1); \
    PH((b) + 9, K_NORM, l, 2); PH((b) + 10, K_UP, l, 2); PH((b) + 11, KDOWN2, l, 2);
    LAYER(0, 2, K_DOWN)
    LAYER(1, 14, K_DOWNF)
#undef LAYER
    {
        unsigned bad = 0u;
        if (IN(25)) { for (int li = 0; li < 32; ++li) bad |= __hip_atomic_load((unsigned*)(P->ws + WS_BAR + (size_t)li * WS_BAR_STRIDE) + XB_TMO, __ATOMIC_RELAXED, __HIP_MEMORY_SCOPE_AGENT); }
        if (bad) { const float qn = __builtin_nanf(""); for (size_t i = (size_t)blockIdx.x * NTHR + threadIdx.x; i < (size_t)NTOK * DM; i += (size_t)gridDim.x * NTHR) P->out[i] = qn; }
    }
#undef PH
#undef IN
#undef SEAM
}

#if 1
template <int KIND> static void launch_phase(const Params& p, int l, int sub, int grid, hipStream_t stream) {
    static bool attr_set = false;
    if (!attr_set) { (void)hipFuncSetAttribute((const void*)k_phase<KIND>, hipFuncAttributeMaxDynamicSharedMemorySize, LDS_BYTES); attr_set = true; }
    hipLaunchKernelGGL(k_phase<KIND>, dim3(grid), dim3(NTHR), LDS_BYTES, stream, p, l, sub);
}
#endif
extern "C" void kernel_launch(void* const* d_in, const int* in_sizes, int n_in, void* d_out, int out_size, void* d_ws, size_t ws_size, hipStream_t stream) {
    static int grid = 0;
    if (grid == 0) {
        if (n_in != N_IN || out_size != NTOK * DM || ws_size < WS_END) { fprintf(stderr, "kernel_launch: unexpected shapes (n_in %d, out %d, ws %zu < %zu)\n", n_in, out_size, ws_size, (size_t)WS_END); grid = -1; return; }
        int dev = 0, cus = 0;
        if (hipGetDevice(&dev) != hipSuccess || hipDeviceGetAttribute(&cus, hipDeviceAttributeMultiprocessorCount, dev) != hipSuccess) { grid = -1; return; }
#if MK_ONE_LAUNCH
        int per_cu = 0;
        if (hipFuncSetAttribute((const void*)hymba_fwd, hipFuncAttributeMaxDynamicSharedMemorySize, LDS_BYTES) != hipSuccess) { fprintf(stderr, "kernel_launch: hipFuncSetAttribute failed\n"); grid = -1; return; }
        if (hipOccupancyMaxActiveBlocksPerMultiprocessor(&per_cu, (const void*)hymba_fwd, NTHR, LDS_BYTES) != hipSuccess || per_cu < 1) fprintf(stderr, "kernel_launch: occupancy query says %d\n", per_cu);
        (void)hipGetLastError();
#endif
        grid = cus;
        if (grid != 256) fprintf(stderr, "kernel_launch: %d CUs (built for 256)\n", grid);
    }
    if (grid < 0) return;
    Params p{};
    for (int i = 0; i < N_IN; ++i) p.in[i] = (const float*)d_in[i];
    p.out = (float*)d_out; p.ws = (unsigned char*)d_ws;
#if MK_ONE_LAUNCH
    (void)hipMemsetAsync((char*)d_ws + WS_BAR, 0, 32 * WS_BAR_STRIDE, stream);
    {
        int lo = 0, li = 0;
        for (int k = 0; k < N_PHASES; ++k) {
            const bool fused = (k + 1 < N_PHASES) && ((MK_FUSE_MASK >> k) & 1ull);
            if (!fused) { p.ph_lo = lo; p.ph_hi = k + 1; p.li = li++; hipLaunchKernelGGL(hymba_fwd, dim3(grid), dim3(NTHR), LDS_BYTES, stream, p); lo = k + 1; }
        }
    }
#else
    (void)hipMemsetAsync((char*)d_ws + WS_BAR, 0, 32 * WS_BAR_STRIDE, stream);
    static bool attr2 = false;
    if (!attr2) { (void)hipFuncSetAttribute((const void*)hymba_fwd, hipFuncAttributeMaxDynamicSharedMemorySize, LDS_BYTES); attr2 = true; }
    int k = 0;
#define LAUNCH(KIND, l, sub) do { if ((MK_KIND_MASK >> (KIND)) & 1) { p.ph_lo = k; p.ph_hi = k + 1; p.li = 0; hipLaunchKernelGGL(hymba_fwd, dim3(grid), dim3(NTHR), LDS_BYTES, stream, p); } \
        else { p.ph_lo = 0; p.ph_hi = 0; launch_phase<KIND>(p, l, sub, grid, stream); } ++k; } while (0)
    LAUNCH(K_CONVERT, 0, 0);
    LAUNCH(K_MODFINAL, 0, 0);
    for (int l = 0; l < 2; ++l)
        for (int sub = 0; sub < 3; ++sub) {
            LAUNCH(K_NORM, l, sub);
            if (sub != 1) { LAUNCH(K_UP, l, sub); if (l == 1 && sub == 2) { LAUNCH(K_DOWNF, l, sub); } else { LAUNCH(K_DOWN, l, sub); } }
            else { LAUNCH(K_WIN, l, sub); {
                   if (MK_P1_SPLIT == 0) { LAUNCH(K_P1, l, sub); }
                   else { const int fa = (MK_P1_SPLIT == 1);
                       p.pad = 1; if (fa) { p.ph_lo = k; p.ph_hi = k + 1; p.li = 0; hipLaunchKernelGGL(hymba_fwd, dim3(grid), dim3(NTHR), LDS_BYTES, stream, p); } else { p.ph_lo = 0; p.ph_hi = 0; launch_phase<K_P1>(p, l, sub, grid, stream); }
                       p.pad = 2; if (!fa) { p.ph_lo = k; p.ph_hi = k + 1; p.li = 0; hipLaunchKernelGGL(hymba_fwd, dim3(grid), dim3(NTHR), LDS_BYTES, stream, p); } else { p.ph_lo = 0; p.ph_hi = 0; launch_phase<K_P1>(p, l, sub, grid, stream); }
                       p.pad = 0; ++k; } } LAUNCH(K_P2, l, sub); LAUNCH(K_P3, l, sub); LAUNCH(K_WOUT, l, sub); }
        }
    LAUNCH(K_FINAL, 0, 0);
#undef LAUNCH
#endif
}
```

```cpp
#include <hip/hip_runtime.h>
#include <cstdio>
#include <cstdint>
__device__ __forceinline__ int ltid() { int t = (int)threadIdx.x; asm volatile("" : "+v"(t)); return t; }
__device__ __forceinline__ int lbid() { int x = (int)blockIdx.x; asm volatile("" : "+s"(x)); return x; }
__device__ __forceinline__ int lgdim() { int x = (int)gridDim.x; asm volatile("" : "+s"(x)); return x; }
__device__ __forceinline__ int lsgpr(int x) { asm volatile("" : "+s"(x)); return x; }
namespace pg8 {
#define PG8_LAS __attribute__((address_space(3)))
typedef unsigned short bf16_t;
typedef short bf16x8 __attribute__((ext_vector_type(8)));
typedef float f32x4 __attribute__((ext_vector_type(4)));
typedef unsigned u32x4 __attribute__((ext_vector_type(4)));
constexpr int BM = 256, BK = 64, HALF = 128, HTB = HALF * BK * 2  , STAGE_BYTES = 8 * HTB, NXCD = 8, WGM = 8;

__host__ __device__ __forceinline__ int lds_byte(int r, int c) { const int st = (r >> 4) * 2 + (c >> 5), rr = r & 15, cc = c & 31, ob = rr * 64 + cc * 2; return st * 1024 + (ob ^ (((ob >> 9) & 1) << 5)); }
__host__ __device__ __forceinline__ void stage_rc(int b, int& R, int& C) { const int st = b / 1024, sb = b % 1024, swz = sb ^ (((sb >> 9) & 1) << 5); R = (st >> 1) * 16 + swz / 64; C = (st & 1) * 32 + (swz % 64) / 2; }
__host__ __device__ __forceinline__ int perm32(int rho) { const int n = rho >> 4, i = rho & 15; return 8 * (i >> 2) + 4 * n + (i & 3); }

struct Unit { int pm, pn; };
struct Gemm { const bf16_t* A; const bf16_t* Bt; int M, N, K; };

struct StaticOrder {
    int nM, nN, nwg, G, c, wgm;
    __host__ __device__ void init(int M, int N, int G_, int c_, int wgm_ = WGM) { nM = M / BM; nN = N / BM; nwg = nM * nN; G = G_; c = c_; wgm = wgm_; }
    __host__ __device__ bool next(int i, Unit& u) const {
        const long L = (long)i * G + c; if (L >= nwg) return false;
        int wgid = (int)L; { const int q = nwg / NXCD, r = nwg % NXCD, xcd = wgid % NXCD, off = wgid / NXCD; wgid = (xcd < r ? xcd * (q + 1) : r * (q + 1) + (xcd - r) * q) + off; }
        const int nig = wgm * nN, gid = wgid / nig, fm = gid * wgm, gsz = (nM - fm) < wgm ? (nM - fm) : wgm;
        u.pm = fm + ((wgid % nig) % gsz); u.pn = (wgid % nig) / gsz; return true;
    }
    __device__ __forceinline__ void a_ready(const Unit&) const {}
    __device__ __forceinline__ void done(const Unit&) const {}
};
template <class Epi, class Sched, bool ALIGN_EPI = false, bool SP2 = false>
__device__ __forceinline__ void gemm_phase(PG8_LAS unsigned char* lds, const Gemm g, const Sched& S, const Epi& E) {
    const int tid = ltid(), wid = __builtin_amdgcn_readfirstlane(tid >> 6), lane = tid & 63, wr = wid >> 2, wc = wid & 3, fr = lane & 15, fq = lane >> 4;
    const int K = g.K, nt = K / BK;
    unsigned voffA[2], voffB[2];
#pragma unroll
    for (int i = 0; i < 2; ++i) { int R, C; stage_rc(tid * 16 + i * 8192, R, C); const int Rb = Epi::PERM ? ((R & ~31) + perm32(R & 31)) : R;
        voffA[i] = (unsigned)(R * K + C) * 2u; voffB[i] = (unsigned)(Rb * K + C) * 2u; }
    const size_t kstep = (size_t)(BK * 2);
    const size_t hstep = (size_t)HALF * K * 2;
    const size_t tstep = 2 * hstep;
    const unsigned ldsw = (unsigned)wid * 1024u;
    const int aoff = lds_byte(wr * 64 + fr, fq * 8), boff = lds_byte(wc * 32 + fr, fq * 8);
#define PG8_SA(b, h) (((b) * 2 + (h)) * HTB)
#define PG8_SB(b, h) ((4 + (b) * 2 + (h)) * HTB)
#define PG8_STAGE(bufoff, gbase, voff) do { _Pragma("unroll") for (int _i = 0; _i < 2; ++_i) \
        __builtin_amdgcn_global_load_lds((const unsigned*)((const char*)(gbase) + (voff)[_i]), (PG8_LAS unsigned*)(lds + (bufoff) + ldsw + _i * 8192), 16, 0, 0); } while (0)
#define PG8_LDA(dst, b, h) do { _Pragma("unroll") for (int m = 0; m < 4; ++m) _Pragma("unroll") for (int k = 0; k < 2; ++k) dst[m][k] = *(const PG8_LAS bf16x8*)(lds + PG8_SA(b, h) + aoff + m * 2048 + k * 1024); } while (0)
#define PG8_LDB(dst, b, h) do { _Pragma("unroll") for (int n = 0; n < 2; ++n) _Pragma("unroll") for (int k = 0; k < 2; ++k) dst[n][k] = *(const PG8_LAS bf16x8*)(lds + PG8_SB(b, h) + boff + n * 2048 + k * 1024); } while (0)
#define PG8_MMA(ai, bj, At, Bt) do { __builtin_amdgcn_s_setprio(1); _Pragma("unroll") for (int m = 0; m < 4; ++m) _Pragma("unroll") for (int n = 0; n < 2; ++n) _Pragma("unroll") for (int k = 0; k < 2; ++k) \
        acc[ai][bj][m][n] = __builtin_amdgcn_mfma_f32_16x16x32_bf16(Bt[n][k], At[m][k], acc[ai][bj][m][n], 0, 0, 0); __builtin_amdgcn_s_setprio(0); } while (0)
#define PG8_WAIT_V(n) asm volatile("s_waitcnt vmcnt(" #n ")" ::: "memory")
#define PG8_WAIT_L(n) asm volatile("s_waitcnt lgkmcnt(" #n ")" ::: "memory")
#define PG8_BAR __builtin_amdgcn_s_barrier()
#define PG8_SCHED __builtin_amdgcn_sched_barrier(0)
    Unit cur, nxt; int ui = 0;
    if (!S.next(0, cur)) return;
    f32x4 acc[2][2][4][2];
#pragma unroll
    for (int a = 0; a < 2; ++a)
#pragma unroll
        for (int b = 0; b < 2; ++b)
#pragma unroll
            for (int m = 0; m < 4; ++m)
#pragma unroll
                for (int n = 0; n < 2; ++n) acc[a][b][m][n] = (f32x4){0.f, 0.f, 0.f, 0.f};
    bf16x8 At[4][2], B0[2][2], B1[2][2];
    const char* cA = (const char*)g.A + (size_t)cur.pm * tstep; const char* cB = (const char*)g.Bt + (size_t)cur.pn * tstep;
    S.a_ready(cur);
    if constexpr (SP2) {
        PG8_STAGE(PG8_SB(0, 0), cB, voffB); PG8_STAGE(PG8_SB(0, 1), cB + hstep, voffB); PG8_STAGE(PG8_SA(0, 0), cA, voffA); PG8_STAGE(PG8_SA(0, 1), cA + hstep, voffA);
        if (wr == 1) PG8_BAR;
        PG8_WAIT_V(2); PG8_BAR;
        PG8_STAGE(PG8_SB(1, 0), cB + kstep, voffB); PG8_STAGE(PG8_SA(1, 0), cA + kstep, voffA); PG8_STAGE(PG8_SB(1, 1), cB + hstep + kstep, voffB);
        PG8_WAIT_V(6); PG8_BAR;
    } else {
        PG8_STAGE(PG8_SB(0, 0), cB, voffB); PG8_STAGE(PG8_SA(0, 0), cA, voffA); PG8_STAGE(PG8_SB(0, 1), cB + hstep, voffB); PG8_STAGE(PG8_SA(0, 1), cA + hstep, voffA);
        if (wr == 1) PG8_BAR;
        PG8_WAIT_V(4); PG8_BAR;
        PG8_STAGE(PG8_SB(1, 0), cB + kstep, voffB); PG8_STAGE(PG8_SA(1, 0), cA + kstep, voffA); PG8_STAGE(PG8_SB(1, 1), cB + hstep + kstep, voffB);
        PG8_WAIT_V(6); PG8_BAR;
    }
    for (;;) {
        const bool has_next = S.next(ui + 1, nxt);
        const char* nA = has_next ? (const char*)g.A + (size_t)nxt.pm * tstep : cA; const char* nB = has_next ? (const char*)g.Bt + (size_t)nxt.pn * tstep : cB;
        for (int t = 0; t < nt; t += 2) {
            const bool last = (t == nt - 2);
            const char* a1 = cA + (size_t)(t + 1) * kstep;
            const char* a2 = last ? nA : cA + (size_t)(t + 2) * kstep; const char* b2 = last ? nB : cB + (size_t)(t + 2) * kstep;
            const char* a3 = a2 + kstep; const char* b3 = b2 + kstep;
            if (last && has_next) S.a_ready(nxt);
            if constexpr (SP2) {
            PG8_LDB(B0, 0, 0); PG8_LDB(B1, 0, 1); PG8_SCHED; PG8_LDA(At, 0, 0); PG8_STAGE(PG8_SA(1, 1), a1 + hstep, voffA);
            PG8_WAIT_V(8); PG8_WAIT_L(0); PG8_BAR; PG8_MMA(0, 0, At, B0); PG8_MMA(0, 1, At, B1); PG8_BAR; PG8_SCHED;
            PG8_LDA(At, 0, 1); PG8_STAGE(PG8_SB(0, 0), b2, voffB); PG8_STAGE(PG8_SB(0, 1), b2 + hstep, voffB); PG8_STAGE(PG8_SA(0, 0), a2, voffA);
            PG8_WAIT_V(8); PG8_WAIT_L(0); PG8_BAR; PG8_MMA(1, 0, At, B0); PG8_MMA(1, 1, At, B1); PG8_BAR; PG8_SCHED;
            PG8_LDB(B0, 1, 0); PG8_LDB(B1, 1, 1); PG8_SCHED; PG8_LDA(At, 1, 0); PG8_STAGE(PG8_SA(0, 1), a2 + hstep, voffA);
            PG8_WAIT_V(8); PG8_WAIT_L(0); PG8_BAR; PG8_MMA(0, 0, At, B0); PG8_MMA(0, 1, At, B1); PG8_BAR; PG8_SCHED;
            PG8_LDA(At, 1, 1); PG8_STAGE(PG8_SB(1, 0), b3, voffB); PG8_STAGE(PG8_SB(1, 1), b3 + hstep, voffB); PG8_STAGE(PG8_SA(1, 0), a3, voffA);
            PG8_WAIT_V(8); PG8_WAIT_L(0); PG8_BAR; PG8_MMA(1, 0, At, B0); PG8_MMA(1, 1, At, B1); PG8_BAR; PG8_SCHED;
            } else {
            PG8_LDB(B0, 0, 0); PG8_SCHED; PG8_LDA(At, 0, 0); PG8_STAGE(PG8_SA(1, 1), a1 + hstep, voffA);
            PG8_WAIT_L(8); PG8_BAR; PG8_WAIT_L(0); PG8_MMA(0, 0, At, B0); PG8_BAR; PG8_SCHED;
            PG8_LDB(B1, 0, 1); PG8_STAGE(PG8_SB(0, 0), b2, voffB);
            PG8_BAR; PG8_WAIT_L(0); PG8_MMA(0, 1, At, B1); PG8_BAR;
            PG8_LDA(At, 0, 1); PG8_STAGE(PG8_SA(0, 0), a2, voffA);
            PG8_BAR; PG8_WAIT_L(0); PG8_MMA(1, 0, At, B0); PG8_BAR; PG8_SCHED;
            PG8_STAGE(PG8_SB(0, 1), b2 + hstep, voffB);
            PG8_WAIT_V(6); PG8_BAR; PG8_MMA(1, 1, At, B1); PG8_BAR;
            PG8_LDB(B0, 1, 0); PG8_SCHED; PG8_LDA(At, 1, 0); PG8_STAGE(PG8_SA(0, 1), a2 + hstep, voffA);
            PG8_WAIT_L(8); PG8_BAR; PG8_WAIT_L(0); PG8_MMA(0, 0, At, B0); PG8_BAR; PG8_SCHED;
            PG8_LDB(B1, 1, 1); PG8_STAGE(PG8_SB(1, 0), b3, voffB);
            PG8_BAR; PG8_WAIT_L(0); PG8_MMA(0, 1, At, B1); PG8_BAR;
            PG8_LDA(At, 1, 1); PG8_STAGE(PG8_SA(1, 0), a3, voffA);
            PG8_BAR; PG8_WAIT_L(0); PG8_MMA(1, 0, At, B0); PG8_BAR; PG8_SCHED;
            PG8_STAGE(PG8_SB(1, 1), b3 + hstep, voffB);
            PG8_WAIT_V(6); PG8_BAR; PG8_MMA(1, 1, At, B1); PG8_BAR;
            }
        }
        if constexpr (ALIGN_EPI) { if (wr == 0) PG8_BAR; }
        if constexpr (!Epi::AFTER_DRAIN) { E(acc, cur, wr, wc, fr, fq); S.done(cur); }
        if (!has_next) break;
#pragma unroll
        for (int a = 0; a < 2; ++a)
#pragma unroll
            for (int b = 0; b < 2; ++b)
#pragma unroll
                for (int m = 0; m < 4; ++m)
#pragma unroll
                    for (int n = 0; n < 2; ++n) acc[a][b][m][n] = (f32x4){0.f, 0.f, 0.f, 0.f};
        cur = nxt; cA = nA; cB = nB; ++ui;
        if constexpr (ALIGN_EPI) { if (wr == 1) PG8_BAR; }
    }
    PG8_WAIT_V(0);
    if constexpr (!ALIGN_EPI) { if (wr == 0) PG8_BAR; }
    PG8_BAR;
    if constexpr (Epi::AFTER_DRAIN) { E.fused(acc, cur, wr, wc, fr, fq, lds, wid, lane); S.done(cur); }
#undef PG8_SA
#undef PG8_SB
#undef PG8_STAGE
#undef PG8_LDA
#undef PG8_LDB
#undef PG8_MMA
#undef PG8_WAIT_V
#undef PG8_WAIT_L
#undef PG8_BAR
#undef PG8_SCHED
}
}
#define XB_TMO      128
#define XB_XCNT(j)  (256  + 64 * (j))
#define XB_XSUB(j)  (1280 + 64 * (j))
#define XB_XGEN(j)  (2304 + 64 * (j))
#define XB_TOP      3328
#define XB_TOPGEN   3392
#define XCD_BAR_WORDS 3456
#define XB_SPIN_CAP (1u << 18)
#define LAS __attribute__((address_space(3)))

__device__ __forceinline__ unsigned xb_ld(unsigned* p)              { return __hip_atomic_load(p, __ATOMIC_RELAXED, __HIP_MEMORY_SCOPE_AGENT); }
__device__ __forceinline__ unsigned xb_add(unsigned* p, unsigned v) { return __hip_atomic_fetch_add(p, v, __ATOMIC_RELAXED, __HIP_MEMORY_SCOPE_AGENT); }
__device__ __forceinline__ unsigned xb_xcc_id() { return (unsigned)__builtin_amdgcn_s_getreg((3 << 11) | 20) & 0xFu; }
#define XB_SPIN(cond, bar) do { unsigned _sp = 0; while (cond) { __builtin_amdgcn_s_sleep(1); \
    if ((++_sp & 255u) == 0u) { if (xb_ld(&(bar)[XB_TMO])) break; if (_sp > XB_SPIN_CAP) { atomicAdd(&(bar)[XB_TMO], 1u); break; } } } } while (0)

struct XcdBarrier {
    unsigned* bar; unsigned x;
    volatile LAS unsigned* st;
};

__device__ __forceinline__ XcdBarrier xcd_barrier_post(unsigned* bar, volatile LAS unsigned* st) {
    XcdBarrier b; b.bar = bar; b.x = xb_xcc_id(); b.st = st;
    if (threadIdx.x == 0) (void)xb_add(&bar[XB_XCNT(b.x)], 1u);
    return b;
}
__device__ __forceinline__ void xcd_barrier_complete(unsigned* bar, unsigned x, unsigned& nloc, unsigned& nx) {
    const unsigned G = gridDim.x * gridDim.y * gridDim.z;
    unsigned sum, cnt, mine, sp = 0u;
    for (;;) {
        sum = 0u; cnt = 0u; mine = 0u;
#pragma unroll
        for (unsigned j = 0; j < 16; ++j) { const unsigned c = xb_ld(&bar[XB_XCNT(j)]); sum += c; cnt += (c > 0u) ? 1u : 0u; mine = (j == x) ? c : mine; }
        if (sum == G) break;
        __builtin_amdgcn_s_sleep(1);
        if ((++sp & 255u) == 0u) { if (xb_ld(&bar[XB_TMO])) break; if (sp > XB_SPIN_CAP) { atomicAdd(&bar[XB_TMO], 1u); break; } }
    }
    nloc = mine > 0u ? mine : 1u; nx = cnt > 0u ? cnt : 1u;
}

__device__ __forceinline__ void xcd_barrier(const XcdBarrier& b) {
    asm volatile("s_waitcnt vmcnt(0)" ::: "memory");
    __syncthreads();
    if (threadIdx.x == 0) {
        unsigned* bar = b.bar;
        __builtin_amdgcn_s_waitcnt(0);
        unsigned nloc = b.st[0], nx = b.st[1];
        if (nloc == 0u) { xcd_barrier_complete(bar, b.x, nloc, nx); b.st[0] = nloc; b.st[1] = nx; }
        const unsigned old = xb_add(&bar[XB_XSUB(b.x)], 1u);
        const unsigned gen = old / nloc;
        if (old + 1u == (gen + 1u) * nloc) {
            __builtin_amdgcn_fence(__ATOMIC_RELEASE, "agent");
            asm volatile("s_waitcnt vmcnt(0)" ::: "memory");
            const unsigned og = xb_add(&bar[XB_TOP], 1u);
            const unsigned tg = og / nx;
            if (og + 1u == (tg + 1u) * nx) xb_add(&bar[XB_TOPGEN], 1u);
            else XB_SPIN(xb_ld(&bar[XB_TOPGEN]) == tg, bar);
            __builtin_amdgcn_fence(__ATOMIC_ACQUIRE, "agent");
            xb_add(&bar[XB_XGEN(b.x)], 1u);
            asm volatile("s_waitcnt vmcnt(0)" ::: "memory");
        } else {
            XB_SPIN(xb_ld(&bar[XB_XGEN(b.x)]) == gen, bar);
            __builtin_amdgcn_fence(__ATOMIC_ACQUIRE, "agent");
            asm volatile("s_waitcnt vmcnt(0)" ::: "memory");
        }
    }
    __syncthreads();
}

typedef unsigned short bf16_t;
typedef short bf16x8 __attribute__((ext_vector_type(8)));
typedef float f32x4 __attribute__((ext_vector_type(4)));
typedef float f32x2 __attribute__((ext_vector_type(2)));
typedef unsigned u32x4 __attribute__((ext_vector_type(4)));
typedef unsigned u32x2 __attribute__((ext_vector_type(2)));

constexpr int NB = 8, SEQ = 4096, DM = 2048, NTOK = NB * SEQ, DFF = 5632, DIN = 6312, LDU = 6400, NMOD = 18432, NTHR = 512;
constexpr int U_HG_Q = 0, U_HG_F = 512, U_HG_I = 1024, U_HG_G = 1536;
constexpr int U_RW_R = 2048, U_RW_K = 2560, U_RW_V = 3072, U_RW_WD = 3584;
constexpr int U_ML_X = 3744, U_ML_V = 4256, U_ML_O = 4768, U_ML_I = 5280, U_ML_F = 5284;
constexpr int U_LRU_X = 5288, U_LRU_G = 5800;
constexpr int RW_IN = 1696;

enum { I_X = 0, I_C, I_GAIN, I_MODW, I_MODB, I_W1, I_W3, I_W2, I_WIN, I_WOUT, I_HGLB, I_HGNORM, I_RWMU, I_RWW0, I_RWW2, I_RWA0, I_RWA2, I_RWG2, I_RWKK, I_RWKA,
       I_RWRK, I_RWLNW, I_RWLNB, I_MLCW, I_MLCB, I_MLWQ, I_MLWK, I_MLIB, I_MLFB, I_MLNORM, I_MLSKIP, I_LRUCW, I_LRUCB, I_LRUWA, I_LRUBA, I_LRUWX, I_LRUBX,
       I_LRULAM, I_LRUNORM, I_FNORM, N_IN };

constexpr size_t WS_BAR = 0;
constexpr size_t WS_BAR_STRIDE = 16384, WS_MODP = 32 * WS_BAR_STRIDE;
constexpr size_t WS_MODF = WS_MODP + (size_t)2 * 16 * 8 * NMOD * 4;
constexpr size_t WS_LRUW = WS_MODF + (size_t)2 * 8 * NMOD * 4;
constexpr size_t WS_W = WS_LRUW + (size_t)2 * 2 * 4 * 16384 * 2;
constexpr size_t LW_W13A = 0, LW_W2A = 23068672, LW_W13B = 34603008, LW_W2B = 57671680, LW_WIN = 69206016, LW_WOUT = 82313216, LW_ELEMS = 86507520;
constexpr size_t WS_HY = WS_W + 2 * LW_ELEMS * 2;
constexpr size_t WS_U = WS_HY + (size_t)NTOK * DM * 2;
constexpr size_t WS_LRUA = WS_U + (size_t)NTOK * LDU * 2;
constexpr size_t WS_LRUB = WS_LRUA + (size_t)NTOK * 512 * 4;
constexpr size_t WS_RWW = WS_LRUB + (size_t)NTOK * 512 * 4;
constexpr size_t WS_RWA = WS_RWW + (size_t)NTOK * 512 * 4;
constexpr size_t WS_RWG = WS_RWA + (size_t)NTOK * 512 * 2;
constexpr size_t WS_LORAT = WS_RWG + (size_t)NTOK * 512 * 2;
constexpr size_t WS_END = WS_LORAT + (size_t)2 * 512 * 160 * 2;

constexpr int LDS_BYTES = 144 * 1024;
constexpr int LDS_BARW = LDS_BYTES - 16;

struct Params { const float* in[N_IN]; float* out; unsigned char* ws; int ph_lo, ph_hi, li, pad; };
typedef const Params __attribute__((address_space(4)))* KP;
__device__ __forceinline__ KP kp_fresh() { KP p = (KP)__builtin_amdgcn_kernarg_segment_ptr(); asm volatile("" : "+s"(p)); return p; }

__device__ __forceinline__ float bflo(unsigned w) { return __uint_as_float(w << 16); }
__device__ __forceinline__ float bfhi(unsigned w) { return __uint_as_float(w & 0xffff0000u); }
__device__ __forceinline__ float bf2f(bf16_t h) { return __uint_as_float(((unsigned)h) << 16); }
typedef __bf16 bf16x2n __attribute__((ext_vector_type(2)));
__device__ __forceinline__ unsigned pk_bf16(float lo, float hi) { const f32x2 v = {lo, hi}; return __builtin_bit_cast(unsigned, __builtin_convertvector(v, bf16x2n)); }
__device__ __forceinline__ void unpack8(const u32x4 w, float (&f)[8]) { f[0] = bflo(w.x); f[1] = bfhi(w.x); f[2] = bflo(w.y); f[3] = bfhi(w.y); f[4] = bflo(w.z); f[5] = bfhi(w.z); f[6] = bflo(w.w); f[7] = bfhi(w.w); }
__device__ __forceinline__ u32x4 pack8(const float (&f)[8]) { u32x4 w; w.x = pk_bf16(f[0], f[1]); w.y = pk_bf16(f[2], f[3]); w.z = pk_bf16(f[4], f[5]); w.w = pk_bf16(f[6], f[7]); return w; }
__device__ __forceinline__ float fast_rcp(float x) { return __builtin_amdgcn_rcpf(x); }
__device__ __forceinline__ float sigmoidf_(float x) { return fast_rcp(1.0f + __expf(-x)); }
__device__ __forceinline__ float siluf_(float x) { return x * sigmoidf_(x); }
__device__ __forceinline__ float softplusf_(float x) { return fmaxf(x, 0.0f) + __logf(1.0f + __expf(-fabsf(x))); }
__device__ __forceinline__ float tanhf_(float x) { const float e = __expf(2.0f * x); return 1.0f - 2.0f * fast_rcp(e + 1.0f); }
__device__ __forceinline__ float gelu_tanhf_(float x) { return 0.5f * x * (1.0f + tanhf_(0.7978845608028654f * (x + 0.044715f * x * x * x))); }
template <int CTRL> __device__ __forceinline__ float dpp_f(float x) { return __int_as_float(__builtin_amdgcn_update_dpp(0, __float_as_int(x), CTRL, 0xF, 0xF, true)); }
__device__ __forceinline__ float wave_scan_sum(float x) {
#define DPP_SC_(v, old, ctrl, rmask) __int_as_float(__builtin_amdgcn_update_dpp(__float_as_int(old), __float_as_int(v), ctrl, rmask, 0xF, false))
    x += DPP_SC_(x, 0.f, 0x111, 0xF); x += DPP_SC_(x, 0.f, 0x112, 0xF); x += DPP_SC_(x, 0.f, 0x114, 0xF); x += DPP_SC_(x, 0.f, 0x118, 0xF);
    x += DPP_SC_(x, 0.f, 0x142, 0xA); x += DPP_SC_(x, 0.f, 0x143, 0xC);
    return x;
}
__device__ __forceinline__ float wave_scan_max(float x) {
    x = fmaxf(x, DPP_SC_(x, x, 0x111, 0xF)); x = fmaxf(x, DPP_SC_(x, x, 0x112, 0xF)); x = fmaxf(x, DPP_SC_(x, x, 0x114, 0xF)); x = fmaxf(x, DPP_SC_(x, x, 0x118, 0xF));
    x = fmaxf(x, DPP_SC_(x, x, 0x142, 0xA)); x = fmaxf(x, DPP_SC_(x, x, 0x143, 0xC));
    return x;
#undef DPP_SC_
}
__device__ __forceinline__ float red8(float x) { x += dpp_f<0xB1>(x); x += dpp_f<0x4E>(x); x += dpp_f<0x141>(x); return x; }
__device__ __forceinline__ float red16(float x) { x = red8(x); x += dpp_f<0x140>(x); return x; }
__device__ __forceinline__ float red64(float x) { x = red16(x); x += __shfl_xor(x, 16); x += __shfl_xor(x, 32); return x; }


#define DPP_ADD4_(CTRL) "v_add_f32_dpp %0, %0, %0 " CTRL " row_mask:0xf bank_mask:0xf bound_ctrl:1\n\t" "v_add_f32_dpp %1, %1, %1 " CTRL " row_mask:0xf bank_mask:0xf bound_ctrl:1\n\t" \
                        "v_add_f32_dpp %2, %2, %2 " CTRL " row_mask:0xf bank_mask:0xf bound_ctrl:1\n\t" "v_add_f32_dpp %3, %3, %3 " CTRL " row_mask:0xf bank_mask:0xf bound_ctrl:1\n\t"
__device__ __forceinline__ void red16x4(float& a, float& b, float& c, float& d) {
    asm volatile("s_nop 4\n\t" DPP_ADD4_("quad_perm:[1,0,3,2]") DPP_ADD4_("quad_perm:[2,3,0,1]") DPP_ADD4_("row_half_mirror") DPP_ADD4_("row_mirror") : "+v"(a), "+v"(b), "+v"(c), "+v"(d));
}

__device__ __forceinline__ void rw1_dots(float s0, float s1, float s2, float s3, const f32x4 ma, const f32x4 wr, float& p1, float& p2) {
    asm volatile(
        "v_mul_f32 %[p1], %[s0], %[ma0]\n\t" "v_mul_f32 %[p2], %[s0], %[wr0]\n\t" "v_fmac_f32 %[p1], %[s1], %[ma1]\n\t" "v_fmac_f32 %[p2], %[s1], %[wr1]\n\t"
        "v_fmac_f32 %[p1], %[s2], %[ma2]\n\t" "v_fmac_f32 %[p2], %[s2], %[wr2]\n\t" "v_fmac_f32 %[p1], %[s3], %[ma3]\n\t" "v_fmac_f32 %[p2], %[s3], %[wr3]\n\t"
        : [p1] "=&v"(p1), [p2] "=&v"(p2)
        : [s0] "v"(s0), [s1] "v"(s1), [s2] "v"(s2), [s3] "v"(s3), [ma0] "v"(ma[0]), [ma1] "v"(ma[1]), [ma2] "v"(ma[2]), [ma3] "v"(ma[3]),
          [wr0] "v"(wr[0]), [wr1] "v"(wr[1]), [wr2] "v"(wr[2]), [wr3] "v"(wr[3]));
}
#define DPP_ADD2_(CTRL, TL) "v_add_f32_dpp %[a], %[a], %[a] " CTRL " row_mask:0xf bank_mask:0xf bound_ctrl:1\n\t" "v_add_f32_dpp %[b], %[b], %[b] " CTRL " row_mask:0xf bank_mask:0xf bound_ctrl:1\n\t" TL
__device__ __forceinline__ void rw1_reduce(float& a, float& b, float v, const f32x4 kp, float& t0, float& t1, float& t2, float& t3) {
    asm volatile("s_nop 4\n\t"
        DPP_ADD2_("quad_perm:[1,0,3,2]", "v_mul_f32 %[t0], %[v], %[kp0]\n\t") DPP_ADD2_("quad_perm:[2,3,0,1]", "v_mul_f32 %[t1], %[v], %[kp1]\n\t")
        DPP_ADD2_("row_half_mirror", "v_mul_f32 %[t2], %[v], %[kp2]\n\t") DPP_ADD2_("row_mirror", "v_mul_f32 %[t3], %[v], %[kp3]\n\t")
        : [a] "+v"(a), [b] "+v"(b), [t0] "=&v"(t0), [t1] "=&v"(t1), [t2] "=&v"(t2), [t3] "=&v"(t3)
        : [v] "v"(v), [kp0] "v"(kp[0]), [kp1] "v"(kp[1]), [kp2] "v"(kp[2]), [kp3] "v"(kp[3]));
}
__device__ __forceinline__ void rw1_update(float& s0, float& s1, float& s2, float& s3, float sa, float t0, float t1, float t2, float t3, const f32x4 wd, const f32x4 bv) {
    asm volatile(
        "v_fmac_f32 %[t0], %[sa], %[bv0]\n\t" "v_fmac_f32 %[t1], %[sa], %[bv1]\n\t" "v_fmac_f32 %[t2], %[sa], %[bv2]\n\t" "v_fmac_f32 %[t3], %[sa], %[bv3]\n\t"
        "v_fma_f32 %[s0], %[s0], %[wd0], %[t0]\n\t" "v_fma_f32 %[s1], %[s1], %[wd1], %[t1]\n\t" "v_fma_f32 %[s2], %[s2], %[wd2], %[t2]\n\t" "v_fma_f32 %[s3], %[s3], %[wd3], %[t3]\n\t"
        : [s0] "+v"(s0), [s1] "+v"(s1), [s2] "+v"(s2), [s3] "+v"(s3), [t0] "+v"(t0), [t1] "+v"(t1), [t2] "+v"(t2), [t3] "+v"(t3)
        : [sa] "v"(sa), [wd0] "v"(wd[0]), [wd1] "v"(wd[1]), [wd2] "v"(wd[2]), [wd3] "v"(wd[3]), [bv0] "v"(bv[0]), [bv1] "v"(bv[1]), [bv2] "v"(bv[2]), [bv3] "v"(bv[3]));
}

#define LDSF(off) ((LAS float*)(lds + (off)))

__device__ __forceinline__ void cvt_tile(const float* __restrict__ src, bf16_t* __restrict__ dst, int K, int N, int kt, int nt, int mode, LAS unsigned char* lds) {
    const int tid = ltid(); LAS float* tile = LDSF(0);
    const int k0 = kt * 64, n0 = nt * 64;
#pragma unroll
    for (int p = 0; p < 2; ++p) {
        const int kk = p * 32 + (tid >> 4), n4 = (tid & 15) * 4;
        f32x4 v = (f32x4){0.f, 0.f, 0.f, 0.f};
        if (n0 + n4 < N) v = *(const f32x4*)(src + (size_t)(k0 + kk) * N + n0 + n4);
        tile[kk * 65 + n4 + 0] = v[0]; tile[kk * 65 + n4 + 1] = v[1]; tile[kk * 65 + n4 + 2] = v[2]; tile[kk * 65 + n4 + 3] = v[3];
    }
    __syncthreads();
    {
        const int nn = tid >> 3, k8 = (tid & 7) * 8, n = n0 + nn;
        float f[8];
#pragma unroll
        for (int j = 0; j < 8; ++j) f[j] = tile[(k8 + j) * 65 + nn];
        const int row = (mode == 0) ? n : ((n >> 7) * 256 + ((mode == 2) ? 128 : 0) + (n & 127));
        *(u32x4*)(dst + (size_t)row * K + k0 + k8) = pack8(f);
    }
    __syncthreads();
}

constexpr int T_FF = 2816, T_WIN = 3200, T_WOUT = 1024, T_LAYER = 6 * T_FF + T_WIN + T_WOUT;
struct CvtTile { const float* src; bf16_t* dst; int K, N, kt, nt, mode; };
__device__ __forceinline__ CvtTile cvt_desc(KP P, int l, int r) {
    bf16_t* Wl = (bf16_t*)(P->ws + WS_W) + (size_t)l * LW_ELEMS;
    CvtTile t;
    if (r < 6 * T_FF) {
        const int m = r / T_FF, q = r % T_FF, f = m / 3, which = m % 3;
        if (which < 2) { t.src = P->in[which == 0 ? I_W1 : I_W3] + (size_t)(l * 2 + f) * DM * DFF; t.dst = Wl + (f ? LW_W13B : LW_W13A); t.K = DM; t.N = DFF; t.kt = q / 88; t.nt = q % 88; t.mode = which + 1; }
        else { t.src = P->in[I_W2] + (size_t)(l * 2 + f) * DFF * DM; t.dst = Wl + (f ? LW_W2B : LW_W2A); t.K = DFF; t.N = DM; t.kt = q / 32; t.nt = q % 32; t.mode = 0; }
    } else if (r < 6 * T_FF + T_WIN) {
        const int q = r - 6 * T_FF;
        t.src = P->in[I_WIN] + (size_t)l * DM * DIN; t.dst = Wl + LW_WIN; t.K = DM; t.N = DIN; t.kt = q / 100; t.nt = q % 100; t.mode = 0;
    } else {
        const int q = r - 6 * T_FF - T_WIN;
        t.src = P->in[I_WOUT] + (size_t)l * DM * DM; t.dst = Wl + LW_WOUT; t.K = DM; t.N = DM; t.kt = q / 32; t.nt = q % 32; t.mode = 0;
    }
    return t;
}
__device__ __forceinline__ void cvt_load(const CvtTile& t, f32x4 (&v)[2]) {
    const int tid = ltid(), n4 = (tid & 15) * 4;
#pragma unroll
    for (int p = 0; p < 2; ++p) {
        const int kk = p * 32 + (tid >> 4);
        v[p] = (f32x4){0.f, 0.f, 0.f, 0.f};
        if (t.nt * 64 + n4 < t.N) v[p] = *(const f32x4*)(t.src + (size_t)(t.kt * 64 + kk) * t.N + t.nt * 64 + n4);
    }
}
__device__ __forceinline__ void cvt_store(const CvtTile& t, const f32x4 (&v)[2], LAS unsigned char* lds) {
    const int tid = ltid(); LAS float* tile = LDSF(0);
#pragma unroll
    for (int p = 0; p < 2; ++p) {
        const int kk = p * 32 + (tid >> 4), n4 = (tid & 15) * 4;
        tile[kk * 65 + n4 + 0] = v[p][0]; tile[kk * 65 + n4 + 1] = v[p][1]; tile[kk * 65 + n4 + 2] = v[p][2]; tile[kk * 65 + n4 + 3] = v[p][3];
    }
    __syncthreads();
    {
        const int nn = tid >> 3, k8 = (tid & 7) * 8, n = t.nt * 64 + nn;
        float f[8];
#pragma unroll
        for (int j = 0; j < 8; ++j) f[j] = tile[(k8 + j) * 65 + nn];
        const int row = (t.mode == 0) ? n : ((n >> 7) * 256 + ((t.mode == 2) ? 128 : 0) + (n & 127));
        *(u32x4*)(t.dst + (size_t)row * t.K + t.kt * 64 + k8) = pack8(f);
    }
    __syncthreads();
}
__device__ __forceinline__ CvtTile cvt_desc_dyn(KP P, int r);
constexpr int T_EARLY = 3 * T_FF + T_WIN, T_LATE0 = 3 * T_FF + T_WOUT, T_DYN = T_LATE0 + T_LAYER;
__device__ __forceinline__ CvtTile cvt_desc_dyn(KP P, int r) {
    if (r < T_LATE0) return cvt_desc(P, 0, (r < 3 * T_FF) ? r + 3 * T_FF : r + 3 * T_FF + T_WIN);
    return cvt_desc(P, 1, r - T_LATE0);
}
__device__ __forceinline__ void convert_dynamic(KP P, LAS unsigned char* lds) {
    unsigned* ctr = (unsigned*)(P->ws + WS_BAR + (size_t)31 * WS_BAR_STRIDE);
    LAS unsigned* sh = (LAS unsigned*)(lds + 32768);
    const int tid = ltid();
    for (;;) {
        __syncthreads();
        if (tid == 0) *sh = __hip_atomic_fetch_add(ctr, 8u, __ATOMIC_RELAXED, __HIP_MEMORY_SCOPE_AGENT);
        __syncthreads();
        const int base = (int)*sh;
        if (base >= T_DYN) break;
        const int end = (base + 8 < T_DYN) ? base + 8 : T_DYN;
        CvtTile cur = cvt_desc_dyn(P, base); f32x4 v[2]; cvt_load(cur, v);
        for (int r = base; r < end; ++r) {
            CvtTile nxt = cur; f32x4 w[2] = {v[0], v[1]};
            if (r + 1 < end) { nxt = cvt_desc_dyn(P, r + 1); cvt_load(nxt, w); }
            cvt_store(cur, v, lds);
            cur = nxt; v[0] = w[0]; v[1] = w[1];
        }
    }
}
__device__ __forceinline__ void phase_convert(KP P, LAS unsigned char* lds) {
    const int tid = ltid(), wg = lbid(), nwg = lgdim();
    constexpr int T_BIG = 0, T_LRU = 64, T_MOD = 2 * 36 * 16;
    if (wg < T_EARLY) {
        CvtTile cur = cvt_desc(P, 0, (wg < 3 * T_FF) ? wg : wg + 3 * T_FF); f32x4 v[2]; cvt_load(cur, v);
        for (int r = wg; r < T_EARLY; r += nwg) {
            CvtTile nxt = cur; f32x4 w[2] = {v[0], v[1]};
            const int rn = r + nwg;
            if (rn < T_EARLY) { nxt = cvt_desc(P, 0, (rn < 3 * T_FF) ? rn : rn + 3 * T_FF); cvt_load(nxt, w); }
            cvt_store(cur, v, lds);
            cur = nxt; v[0] = w[0]; v[1] = w[1];
        }
    }
    {
        bf16_t* LT = (bf16_t*)(P->ws + WS_LORAT);
        for (int e = wg * NTHR + tid; e < 2 * 512 * 160; e += nwg * NTHR) {
            const int l = e / 81920, r = e % 81920, ch = r / 160, j = r % 160;
            const float v = (j < 32) ? P->in[I_RWW2][(size_t)(l * 32 + j) * 512 + ch] : ((j < 64) ? P->in[I_RWA2][(size_t)(l * 32 + j - 32) * 512 + ch] : P->in[I_RWG2][(size_t)(l * 96 + j - 64) * 512 + ch]);
            LT[e] = (bf16_t)(pk_bf16(v, 0.f) & 0xffffu);
        }
    }
    for (int it = wg; it < T_BIG + T_LRU + T_MOD; it += nwg) {
        if (false) {
        } else if (it < T_BIG + T_LRU) {
            const int q = it - T_BIG, m16 = q >> 2, tl = q & 3, l = m16 >> 3, which = (m16 >> 2) & 1, blk = m16 & 3;
            const float* src = P->in[which ? I_LRUWX : I_LRUWA] + (size_t)(l * 4 + blk) * 16384;
            bf16_t* dst = (bf16_t*)(P->ws + WS_LRUW) + (size_t)((l * 2 + which) * 4 + blk) * 16384;
            cvt_tile(src, dst, 128, 128, tl >> 1, tl & 1, 0, lds);
        } else {
            const int m = it - T_BIG - T_LRU, l = m / 576, r = m % 576, jb = r / 16, ks = r % 16;
            LAS float* cact = LDSF(0);
#pragma unroll
            for (int e2 = 0; e2 < 2; ++e2) { const int e = tid * 2 + e2, kk = e >> 3, b = e & 7; cact[e] = siluf_(P->in[I_C][b * DM + ks * 128 + kk]); }
            __syncthreads();
            const int j = jb * 512 + tid;
            const float* wp = P->in[I_MODW] + (size_t)l * DM * NMOD + (size_t)(ks * 128) * NMOD + j;
            float acc[8];
#pragma unroll
            for (int b = 0; b < 8; ++b) acc[b] = 0.f;
#pragma unroll 32
            for (int kk = 0; kk < 128; ++kk) {
                const float w = wp[(size_t)kk * NMOD];
                const f32x4 c0 = *(const LAS f32x4*)(cact + kk * 8), c1 = *(const LAS f32x4*)(cact + kk * 8 + 4);
                acc[0] += c0[0] * w; acc[1] += c0[1] * w; acc[2] += c0[2] * w; acc[3] += c0[3] * w;
                acc[4] += c1[0] * w; acc[5] += c1[1] * w; acc[6] += c1[2] * w; acc[7] += c1[3] * w;
            }
            float* mp = (float*)(P->ws + WS_MODP) + (size_t)((l * 16 + ks) * 8) * NMOD + j;
#pragma unroll
            for (int b = 0; b < 8; ++b) mp[(size_t)b * NMOD] = acc[b];
            __syncthreads();
        }
    }
}

__device__ __forceinline__ void phase_modfinal(KP P) {
    const float* mp = (const float*)(P->ws + WS_MODP); float* mf = (float*)(P->ws + WS_MODF);
    for (int i = lbid() * NTHR + ltid(); i < 2 * 8 * NMOD; i += lgdim() * NTHR) {
        const int l = i / (8 * NMOD), r = i % (8 * NMOD), b = r / NMOD, j = r % NMOD;
        float s = P->in[I_MODB][l * NMOD + j];
#pragma unroll
        for (int ks = 0; ks < 16; ++ks) s += mp[(size_t)((l * 16 + ks) * 8 + b) * NMOD + j];
        mf[i] = s;
    }
}

__device__ __forceinline__ void phase_norm(KP P, int l, int sub, const void* __restrict__ xsrc, int xf32, LAS unsigned char* lds) {
    const int tid = ltid(), lane = tid & 63, wave = tid >> 6;
    bf16_t* H = (bf16_t*)(P->ws + WS_HY);
    LAS float* cv = LDSF(0); LAS float* sv = LDSF(8192);
    for (int rb = lbid(); rb < NTOK / 128; rb += lgdim()) {
        const int b = rb >> 5;
        const float* mod = (const float*)(P->ws + WS_MODF) + (size_t)(l * 8 + b) * NMOD + sub * 6144;
        __syncthreads();
        for (int d = tid; d < DM; d += NTHR) { cv[d] = P->in[I_GAIN][(l * 3 + sub) * DM + d] * (1.0f + mod[2048 + d]); sv[d] = mod[d]; }
        __syncthreads();
        if (xf32) {
            for (int rr = 0; rr < 16; ++rr) {
                const int row = rb * 128 + wave * 16 + rr;
                const float* xr = (const float*)xsrc + (size_t)row * DM;
                f32x4 v[8]; float ss = 0.f;
#pragma unroll
                for (int i = 0; i < 8; ++i) { v[i] = *(const f32x4*)(xr + i * 256 + lane * 4); ss += v[i][0] * v[i][0] + v[i][1] * v[i][1] + v[i][2] * v[i][2] + v[i][3] * v[i][3]; }
                ss = red64(ss);
                const float rstd = rsqrtf(ss * (1.0f / DM) + 1e-6f);
#pragma unroll
                for (int i = 0; i < 8; ++i) {
                    const int d = i * 256 + lane * 4;
                    const f32x4 c = *(const LAS f32x4*)(cv + d), s = *(const LAS f32x4*)(sv + d);
                    u32x2 w; w.x = pk_bf16(v[i][0] * rstd * c[0] + s[0], v[i][1] * rstd * c[1] + s[1]); w.y = pk_bf16(v[i][2] * rstd * c[2] + s[2], v[i][3] * rstd * c[3] + s[3]);
                    *(u32x2*)(H + (size_t)row * DM + d) = w;
                }
            }
        } else {
            for (int rr = 0; rr < 16; ++rr) {
                const int row = rb * 128 + wave * 16 + rr;
                const bf16_t* xr = (const bf16_t*)xsrc + (size_t)row * DM;
                u32x4 xw[4]; float ss = 0.f;
#pragma unroll
                for (int i = 0; i < 4; ++i) xw[i] = *(const u32x4*)(xr + i * 512 + lane * 8);
                float v[4][8];
#pragma unroll
                for (int i = 0; i < 4; ++i) {
                    unpack8(xw[i], v[i]);
#pragma unroll
                    for (int j = 0; j < 8; ++j) ss += v[i][j] * v[i][j];
                }
                ss = red64(ss);
                const float rstd = rsqrtf(ss * (1.0f / DM) + 1e-6f);
#pragma unroll
                for (int i = 0; i < 4; ++i) {
                    const int d = i * 512 + lane * 8;
                    const f32x4 c0 = *(const LAS f32x4*)(cv + d), c1 = *(const LAS f32x4*)(cv + d + 4), s0 = *(const LAS f32x4*)(sv + d), s1 = *(const LAS f32x4*)(sv + d + 4);
                    float o[8];
#pragma unroll
                    for (int j = 0; j < 4; ++j) { o[j] = v[i][j] * rstd * c0[j] + s0[j]; o[4 + j] = v[i][4 + j] * rstd * c1[j] + s1[j]; }
                    *(u32x4*)(H + (size_t)row * DM + d) = pack8(o);
                }
            }
        }
    }
}

__device__ __forceinline__ void phase_final_norm(KP P, const bf16_t* __restrict__ X) {
    const int tid = ltid(), lane = tid & 63, wave = tid >> 6;
    const float* fn = P->in[I_FNORM];
    for (int row = lbid() * 8 + wave; row < NTOK; row += lgdim() * 8) {
        const bf16_t* xr = X + (size_t)row * DM; float* orow = P->out + (size_t)row * DM;
        u32x4 xw[4]; float ss = 0.f;
#pragma unroll
        for (int i = 0; i < 4; ++i) xw[i] = *(const u32x4*)(xr + i * 512 + lane * 8);
        float v[4][8];
#pragma unroll
        for (int i = 0; i < 4; ++i) {
            unpack8(xw[i], v[i]);
#pragma unroll
            for (int j = 0; j < 8; ++j) ss += v[i][j] * v[i][j];
        }
        ss = red64(ss);
        const float rstd = rsqrtf(ss * (1.0f / DM) + 1e-6f);
#pragma unroll
        for (int i = 0; i < 4; ++i) {
            const int d = i * 512 + lane * 8;
            const f32x4 g0 = *(const f32x4*)(fn + d), g1 = *(const f32x4*)(fn + d + 4);
            f32x4 o0, o1;
#pragma unroll
            for (int j = 0; j < 4; ++j) { o0[j] = v[i][j] * rstd * g0[j]; o1[j] = v[i][4 + j] * rstd * g1[j]; }
            *(f32x4*)(orow + d) = o0; *(f32x4*)(orow + d + 4) = o1;
        }
    }
}

struct EpiSwiGLU {
    static constexpr bool PERM = true, AFTER_DRAIN = false;
    bf16_t* G;
    __device__ __forceinline__ void operator()(const pg8::f32x4 (&acc)[2][2][4][2], const pg8::Unit& u, int wr, int wc, int fr, int fq) const {
        const int row0 = u.pm * 256 + wr * 64 + fr, col0 = u.pn * 128 + wc * 32 + 8 * fq;
#pragma unroll
        for (int ai = 0; ai < 2; ++ai)
#pragma unroll
            for (int m = 0; m < 4; ++m) {
                float o[8];
#pragma unroll
                for (int n = 0; n < 2; ++n)
#pragma unroll
                    for (int j = 0; j < 4; ++j) { const float g = acc[ai][0][m][n][j]; o[n * 4 + j] = g * fast_rcp(1.0f + __expf(-g)) * acc[ai][1][m][n][j]; }
                *(u32x4*)(G + (size_t)(row0 + ai * 128 + m * 16) * DFF + col0) = pack8(o);
            }
    }
};
struct EpiResid {
    static constexpr bool PERM = false, AFTER_DRAIN = false;
    const void* xin; bf16_t* xout; const float* gate; float coef; int xf32;
    __device__ __forceinline__ void operator()(const pg8::f32x4 (&acc)[2][2][4][2], const pg8::Unit& u, int wr, int wc, int fr, int fq) const {
        const int row0 = u.pm * 256 + wr * 64 + fr, col0 = u.pn * 256 + wc * 32 + 4 * fq, b = u.pm >> 4;
        f32x4 gv[2][2];
#pragma unroll
        for (int bj = 0; bj < 2; ++bj)
#pragma unroll
            for (int n = 0; n < 2; ++n) gv[bj][n] = (*(const f32x4*)(gate + (size_t)b * NMOD + col0 + bj * 128 + n * 16) + 1.0f) * coef;
#pragma unroll
        for (int ai = 0; ai < 2; ++ai) {
            if (xf32) {
                const float* xi = (const float*)xin;
                f32x4 xv[4][2][2];
#pragma unroll
                for (int m = 0; m < 4; ++m)
#pragma unroll
                    for (int bj = 0; bj < 2; ++bj)
#pragma unroll
                        for (int n = 0; n < 2; ++n) xv[m][bj][n] = *(const f32x4*)(xi + (size_t)(row0 + ai * 128 + m * 16) * DM + col0 + bj * 128 + n * 16);
#pragma unroll
                for (int m = 0; m < 4; ++m)
#pragma unroll
                    for (int bj = 0; bj < 2; ++bj)
#pragma unroll
                        for (int n = 0; n < 2; ++n) {
                            const f32x4 r = xv[m][bj][n] + gv[bj][n] * acc[ai][bj][m][n];
                            u32x2 w; w.x = pk_bf16(r[0], r[1]); w.y = pk_bf16(r[2], r[3]);
                            *(u32x2*)(xout + (size_t)(row0 + ai * 128 + m * 16) * DM + col0 + bj * 128 + n * 16) = w;
                        }
            } else {
                const bf16_t* xi = (const bf16_t*)xin;
                u32x2 xw[4][2][2];
#pragma unroll
                for (int m = 0; m < 4; ++m)
#pragma unroll
                    for (int bj = 0; bj < 2; ++bj)
#pragma unroll
                        for (int n = 0; n < 2; ++n) xw[m][bj][n] = *(const u32x2*)(xi + (size_t)(row0 + ai * 128 + m * 16) * DM + col0 + bj * 128 + n * 16);
#pragma unroll
                for (int m = 0; m < 4; ++m)
#pragma unroll
                    for (int bj = 0; bj < 2; ++bj)
#pragma unroll
                        for (int n = 0; n < 2; ++n) {
                            const f32x4 xv = (f32x4){bflo(xw[m][bj][n].x), bfhi(xw[m][bj][n].x), bflo(xw[m][bj][n].y), bfhi(xw[m][bj][n].y)};
                            const f32x4 r = xv + gv[bj][n] * acc[ai][bj][m][n];
                            u32x2 w; w.x = pk_bf16(r[0], r[1]); w.y = pk_bf16(r[2], r[3]);
                            *(u32x2*)(xout + (size_t)(row0 + ai * 128 + m * 16) * DM + col0 + bj * 128 + n * 16) = w;
                        }
            }
        }
    }
};
struct EpiFinal {
    static constexpr bool PERM = false, AFTER_DRAIN = false;
    const bf16_t* xin; float* out; const float* gate; float coef; const float* fn; float* part; unsigned* flags; unsigned* bar0; LAS float* spare;
    __device__ __forceinline__ void operator()(const pg8::f32x4 (&acc_)[2][2][4][2], const pg8::Unit& u, int wr, int wc, int fr, int fq) const {
        pg8::f32x4 (&acc)[2][2][4][2] = const_cast<pg8::f32x4 (&)[2][2][4][2]>(acc_);
        const int row0 = u.pm * 256 + wr * 64 + fr, col0 = u.pn * 256 + wc * 32 + 4 * fq, b = u.pm >> 4, tid = ltid();
        f32x4 gv[2][2];
#pragma unroll
        for (int bj = 0; bj < 2; ++bj)
#pragma unroll
            for (int n = 0; n < 2; ++n) gv[bj][n] = (*(const f32x4*)(gate + (size_t)b * NMOD + col0 + bj * 128 + n * 16) + 1.0f) * coef;
#pragma unroll
        for (int ai = 0; ai < 2; ++ai) {
            u32x2 xw[4][2][2];
#pragma unroll
            for (int m = 0; m < 4; ++m)
#pragma unroll
                for (int bj = 0; bj < 2; ++bj)
#pragma unroll
                    for (int n = 0; n < 2; ++n) xw[m][bj][n] = *(const u32x2*)(xin + (size_t)(row0 + ai * 128 + m * 16) * DM + col0 + bj * 128 + n * 16);
#pragma unroll
            for (int m = 0; m < 4; ++m) {
                float sq = 0.f;
#pragma unroll
                for (int bj = 0; bj < 2; ++bj)
#pragma unroll
                    for (int n = 0; n < 2; ++n) {
                        const f32x4 xv = (f32x4){bflo(xw[m][bj][n].x), bfhi(xw[m][bj][n].x), bflo(xw[m][bj][n].y), bfhi(xw[m][bj][n].y)};
                        const f32x4 r = xv + gv[bj][n] * acc[ai][bj][m][n];
                        acc[ai][bj][m][n] = r;
                        sq += r[0] * r[0] + r[1] * r[1] + r[2] * r[2] + r[3] * r[3];
                    }
                sq += __int_as_float(__builtin_amdgcn_ds_bpermute(((tid & 63) ^ 16) << 2, __float_as_int(sq))); sq += __int_as_float(__builtin_amdgcn_ds_bpermute(((tid & 63) ^ 32) << 2, __float_as_int(sq)));
                if (fq == 0) spare[wc * 256 + wr * 64 + fr + ai * 128 + m * 16] = sq;
            }
        }
        __syncthreads();
        if (tid < 256) __hip_atomic_store(part + (size_t)(u.pm * 256 + tid) * 8 + u.pn, (spare[tid] + spare[256 + tid]) + (spare[512 + tid] + spare[768 + tid]), __ATOMIC_RELAXED, __HIP_MEMORY_SCOPE_AGENT);
        asm volatile("s_waitcnt vmcnt(0)" ::: "memory");
        __syncthreads();
        if (threadIdx.x == 0) {
            (void)xb_add(flags + u.pm, 1u);
            XB_SPIN(xb_ld(flags + u.pm) < 8u, bar0);
        }
        __syncthreads();
        if (tid < 256) {
            const float* pr = part + (size_t)(u.pm * 256 + tid) * 8;
            float t = 0.f;
#pragma unroll
            for (int j = 0; j < 8; ++j) t += __hip_atomic_load(pr + j, __ATOMIC_RELAXED, __HIP_MEMORY_SCOPE_AGENT);
            spare[1024 + tid] = rsqrtf(t * (1.0f / DM) + 1e-6f);
        }
        __syncthreads();
        f32x4 fv[2][2];
#pragma unroll
        for (int bj = 0; bj < 2; ++bj)
#pragma unroll
            for (int n = 0; n < 2; ++n) fv[bj][n] = *(const f32x4*)(fn + col0 + bj * 128 + n * 16);
#pragma unroll
        for (int ai = 0; ai < 2; ++ai)
#pragma unroll
            for (int m = 0; m < 4; ++m) {
                const size_t row = (size_t)(row0 + ai * 128 + m * 16);
                const float rstd = spare[1024 + wr * 64 + fr + ai * 128 + m * 16];
#pragma unroll
                for (int bj = 0; bj < 2; ++bj)
#pragma unroll
                    for (int n = 0; n < 2; ++n) *(f32x4*)(out + row * DM + col0 + bj * 128 + n * 16) = acc[ai][bj][m][n] * rstd * fv[bj][n];
            }
    }
};
struct EpiU {
    static constexpr bool PERM = true, AFTER_DRAIN = false;
    bf16_t* U;
    __device__ __forceinline__ void operator()(const pg8::f32x4 (&acc)[2][2][4][2], const pg8::Unit& u, int wr, int wc, int fr, int fq) const {
        const int row0 = u.pm * 256 + wr * 64 + fr, col0 = u.pn * 256 + wc * 32 + 8 * fq;
#pragma unroll
        for (int ai = 0; ai < 2; ++ai)
#pragma unroll
            for (int m = 0; m < 4; ++m)
#pragma unroll
                for (int bj = 0; bj < 2; ++bj) {
                    u32x4 w; w.x = pk_bf16(acc[ai][bj][m][0][0], acc[ai][bj][m][0][1]); w.y = pk_bf16(acc[ai][bj][m][0][2], acc[ai][bj][m][0][3]);
                    w.z = pk_bf16(acc[ai][bj][m][1][0], acc[ai][bj][m][1][1]); w.w = pk_bf16(acc[ai][bj][m][1][2], acc[ai][bj][m][1][3]);
                    *(u32x4*)(U + (size_t)(row0 + ai * 128 + m * 16) * LDU + col0 + bj * 128) = w;
                }
    }
};

__device__ __forceinline__ void p1_rw_lora(KP P, int l, LAS unsigned char* lds, int w, int nw) {
    const int tid = ltid(), lane = tid & 63, wave = tid >> 6, fq = lane >> 4, fr = lane & 15, half = w & 1;
    const bf16_t* U = (const bf16_t*)(P->ws + WS_U);
    float* RWW = (float*)(P->ws + WS_RWW); bf16_t* RWA = (bf16_t*)(P->ws + WS_RWA); bf16_t* RWG = (bf16_t*)(P->ws + WS_RWG);
    constexpr int O_WT = 0, O_ACT = 256 * 168 * 2, LDW = 168;
    const float* mu = P->in[I_RWMU] + l * RW_IN + 1536;
    __syncthreads();
    {
        const bf16_t* LT = (const bf16_t*)(P->ws + WS_LORAT) + (size_t)(l * 512 + half * 256) * 160;
#pragma unroll 2
        for (int e = tid; e < 256 * 20; e += NTHR) { const int ch = e / 20, c = e % 20; *(LAS u32x4*)(lds + O_WT + (ch * LDW + c * 8) * 2) = *(const u32x4*)(LT + (size_t)ch * 160 + c * 8); }
    }
    float w0[2], a0[2];
#pragma unroll
    for (int q = 0; q < 2; ++q) { const int ch = half * 256 + (wave * 2 + q) * 16 + fr; w0[q] = P->in[I_RWW0][l * 512 + ch]; a0[q] = P->in[I_RWA0][l * 512 + ch]; }
    u32x4 pc[3], pp[3];
#define LORA_PREFETCH(tt_) do { _Pragma("unroll") for (int i = 0; i < 3; ++i) { const int e_ = tid + i * NTHR; if (e_ < 1280) { const int tk_ = e_ / 20, c_ = e_ % 20, tok_ = (tt_) * 64 + tk_; \
        const bf16_t* uc_ = U + (size_t)tok_ * LDU + U_RW_WD + c_ * 8; pc[i] = *(const u32x4*)uc_; pp[i] = *(const u32x4*)((tok_ & (SEQ - 1)) ? uc_ - LDU : uc_); } } } while (0)
    const int tstep = nw >> 1;
    if ((w >> 1) < NTOK / 64) LORA_PREFETCH(w >> 1);
    for (int tt = w >> 1; tt < NTOK / 64; tt += tstep) {
        const int tok0 = tt * 64;
        __syncthreads();
#pragma unroll
        for (int i = 0; i < 3; ++i) {
            const int e = tid + i * NTHR;
            if (e < 1280) {
                const int tk = e / 20, c = e % 20, tok = tok0 + tk;
                float cur[8], prv[8], av[8]; unpack8(pc[i], cur); unpack8(pp[i], prv);
                const float pf = (tok & (SEQ - 1)) ? 1.0f : 0.0f;
                const f32x4 m0 = *(const f32x4*)(mu + c * 8), m1 = *(const f32x4*)(mu + c * 8 + 4);
#pragma unroll
                for (int j = 0; j < 8; ++j) {
                    const float v = cur[j] + (prv[j] * pf - cur[j]) * ((j < 4) ? m0[j & 3] : m1[j & 3]);
                    av[j] = (c < 4) ? tanhf_(v) : ((c < 8) ? v : sigmoidf_(v));
                }
                *(LAS u32x4*)(lds + O_ACT + (tk * LDW + c * 8) * 2) = pack8(av);
            }
        }
        if (tt + tstep < NTOK / 64) LORA_PREFETCH(tt + tstep);
        __syncthreads();
#pragma unroll
        for (int q = 0; q < 2; ++q) {
            const int nrow = (wave * 2 + q) * 16 + fr;
            const bf16x8 bw = *(const LAS bf16x8*)(lds + O_WT + (nrow * LDW + fq * 8) * 2), ba = *(const LAS bf16x8*)(lds + O_WT + (nrow * LDW + 32 + fq * 8) * 2);
            const bf16x8 bg0 = *(const LAS bf16x8*)(lds + O_WT + (nrow * LDW + 64 + fq * 8) * 2), bg1 = *(const LAS bf16x8*)(lds + O_WT + (nrow * LDW + 96 + fq * 8) * 2), bg2 = *(const LAS bf16x8*)(lds + O_WT + (nrow * LDW + 128 + fq * 8) * 2);
            const int ch = half * 256 + (wave * 2 + q) * 16 + fr;
#pragma unroll
            for (int mi = 0; mi < 4; ++mi) {
                const int arow = mi * 16 + fr;
                const bf16x8 aw = *(const LAS bf16x8*)(lds + O_ACT + (arow * LDW + fq * 8) * 2), aa = *(const LAS bf16x8*)(lds + O_ACT + (arow * LDW + 32 + fq * 8) * 2);
                const bf16x8 ag0 = *(const LAS bf16x8*)(lds + O_ACT + (arow * LDW + 64 + fq * 8) * 2), ag1 = *(const LAS bf16x8*)(lds + O_ACT + (arow * LDW + 96 + fq * 8) * 2), ag2 = *(const LAS bf16x8*)(lds + O_ACT + (arow * LDW + 128 + fq * 8) * 2);
                const f32x4 z = (f32x4){0.f, 0.f, 0.f, 0.f};
                const f32x4 cw = __builtin_amdgcn_mfma_f32_16x16x32_bf16(aw, bw, z, 0, 0, 0);
                const f32x4 ca = __builtin_amdgcn_mfma_f32_16x16x32_bf16(aa, ba, z, 0, 0, 0);
                f32x4 cg = __builtin_amdgcn_mfma_f32_16x16x32_bf16(ag0, bg0, z, 0, 0, 0);
                cg = __builtin_amdgcn_mfma_f32_16x16x32_bf16(ag1, bg1, cg, 0, 0, 0);
                cg = __builtin_amdgcn_mfma_f32_16x16x32_bf16(ag2, bg2, cg, 0, 0, 0);
#pragma unroll
                for (int rg = 0; rg < 4; ++rg) {
                    const size_t o = (size_t)(tok0 + mi * 16 + fq * 4 + rg) * 512 + ch;
                    const float wlog = -softplusf_(-(w0[q] + cw[rg])) - 0.5f;
                    RWW[o] = __expf(-__expf(wlog));
                    RWA[o] = (bf16_t)(pk_bf16(sigmoidf_(a0[q] + ca[rg]), 0.f) & 0xffffu);
                    RWG[o] = (bf16_t)(pk_bf16(cg[rg], 0.f) & 0xffffu);
                }
            }
        }
    }
}

#undef LORA_PREFETCH
__device__ __forceinline__ void p1_lru_prep(KP P, int l, LAS unsigned char* lds, int wg, int nwg) {
    const int tid = ltid(), lane = tid & 63, wave = tid >> 6;
    const bf16_t* U = (const bf16_t*)(P->ws + WS_U);
    float* LA = (float*)(P->ws + WS_LRUA); float* LB = (float*)(P->ws + WS_LRUB);
    constexpr int O_WA = 0, O_WX = 34816, O_XC = 69632, O_XF = 87040;
    const int n = wg & 3;
    __syncthreads();
    {
        const bf16_t* wa = (const bf16_t*)(P->ws + WS_LRUW) + (size_t)((l * 2 + 0) * 4 + n) * 16384;
        const bf16_t* wx = (const bf16_t*)(P->ws + WS_LRUW) + (size_t)((l * 2 + 1) * 4 + n) * 16384;
#pragma unroll
        for (int e4 = 0; e4 < 4; ++e4) {
            const int e = tid + e4 * NTHR, j = e >> 4, i8 = (e & 15) * 8;
            *(LAS u32x4*)(lds + O_WA + (j * 136 + i8) * 2) = *(const u32x4*)(wa + j * 128 + i8);
            *(LAS u32x4*)(lds + O_WX + (j * 136 + i8) * 2) = *(const u32x4*)(wx + j * 128 + i8);
        }
    }
    const int jloc = wave * 16 + (lane & 15), cg = n * 128 + jloc, fq = lane >> 4;
    const float ba = P->in[I_LRUBA][l * 512 + cg], bx = P->in[I_LRUBX][l * 512 + cg], sp8 = 8.0f * softplusf_(-P->in[I_LRULAM][l * 512 + cg]);
    const int tk = tid >> 3, c16 = (tid & 7) * 16;
    const float* cw = P->in[I_LRUCW] + l * 2048 + n * 128 + c16;
    const float* cb = P->in[I_LRUCB] + l * 512 + n * 128 + c16;
    u32x4 pr[4][2];
#define LRU_PREFETCH(tt_) do { const int tok_ = (tt_) * 64 + tk, ts_ = tok_ & (SEQ - 1); _Pragma("unroll") for (int jj = 0; jj < 4; ++jj) { \
        const bf16_t* up_ = U + (size_t)(((ts_ - 3 + jj) >= 0) ? tok_ - 3 + jj : tok_) * LDU + U_LRU_X + n * 128 + c16; pr[jj][0] = *(const u32x4*)up_; pr[jj][1] = *(const u32x4*)(up_ + 8); } } while (0)
    const int tstep = nwg >> 2;
    if ((wg >> 2) < NTOK / 64) LRU_PREFETCH(wg >> 2);
    for (int tt = wg >> 2; tt < NTOK / 64; tt += tstep) {
        const int tok0 = tt * 64, tok = tok0 + tk, tseq = tok & (SEQ - 1);
        float xc[16];
#pragma unroll
        for (int q = 0; q < 4; ++q) { const f32x4 c = *(const f32x4*)(cb + q * 4); xc[q * 4 + 0] = c[0]; xc[q * 4 + 1] = c[1]; xc[q * 4 + 2] = c[2]; xc[q * 4 + 3] = c[3]; }
#pragma unroll
        for (int jj = 0; jj < 4; ++jj) {
            const bool valid = (tseq - 3 + jj) >= 0;
            float x[16]; { float t0[8], t1[8]; unpack8(pr[jj][0], t0); unpack8(pr[jj][1], t1);
#pragma unroll
                for (int j = 0; j < 8; ++j) { x[j] = t0[j]; x[8 + j] = t1[j]; } }
            const float vf = valid ? 1.0f : 0.0f;
#pragma unroll
            for (int q = 0; q < 4; ++q) { const f32x4 w = *(const f32x4*)(cw + jj * 512 + q * 4);
                xc[q * 4 + 0] += vf * w[0] * x[q * 4 + 0]; xc[q * 4 + 1] += vf * w[1] * x[q * 4 + 1]; xc[q * 4 + 2] += vf * w[2] * x[q * 4 + 2]; xc[q * 4 + 3] += vf * w[3] * x[q * 4 + 3]; }
        }
        __syncthreads();
        {
            float a8[8], b8[8];
#pragma unroll
            for (int j = 0; j < 8; ++j) { a8[j] = xc[j]; b8[j] = xc[8 + j]; }
            *(LAS u32x4*)(lds + O_XC + (tk * 136 + c16) * 2) = pack8(a8);
            *(LAS u32x4*)(lds + O_XC + (tk * 136 + c16 + 8) * 2) = pack8(b8);
#pragma unroll
            for (int q = 0; q < 4; ++q) *(LAS f32x4*)(lds + O_XF + (tk * 132 + c16 + q * 4) * 4) = (f32x4){xc[q * 4], xc[q * 4 + 1], xc[q * 4 + 2], xc[q * 4 + 3]};
        }
        __syncthreads();
        if (tt + tstep < NTOK / 64) LRU_PREFETCH(tt + tstep);
        f32x4 accA[4], accX[4];
#pragma unroll
        for (int mi = 0; mi < 4; ++mi) { accA[mi] = (f32x4){0.f, 0.f, 0.f, 0.f}; accX[mi] = (f32x4){0.f, 0.f, 0.f, 0.f}; }
#pragma unroll
        for (int kk = 0; kk < 4; ++kk) {
            const bf16x8 fa = *(const LAS bf16x8*)(lds + O_WA + (jloc * 136 + kk * 32 + fq * 8) * 2);
            const bf16x8 fx = *(const LAS bf16x8*)(lds + O_WX + (jloc * 136 + kk * 32 + fq * 8) * 2);
#pragma unroll
            for (int mi = 0; mi < 4; ++mi) {
                const bf16x8 xa = *(const LAS bf16x8*)(lds + O_XC + ((mi * 16 + (lane & 15)) * 136 + kk * 32 + fq * 8) * 2);
                accA[mi] = __builtin_amdgcn_mfma_f32_16x16x32_bf16(xa, fa, accA[mi], 0, 0, 0);
                accX[mi] = __builtin_amdgcn_mfma_f32_16x16x32_bf16(xa, fx, accX[mi], 0, 0, 0);
            }
        }
#pragma unroll
        for (int mi = 0; mi < 4; ++mi)
#pragma unroll
            for (int rg = 0; rg < 4; ++rg) {
                const int t = mi * 16 + fq * 4 + rg;
                const float xv = *(const LAS float*)(lds + O_XF + (t * 132 + jloc) * 4);
                const float r = sigmoidf_(accA[mi][rg] + ba), ig = sigmoidf_(accX[mi][rg] + bx);
                const float la = -r * sp8;
                const size_t o = (size_t)(tok0 + t) * 512 + cg;
                LA[o] = __expf(la);
                LB[o] = sqrtf(fmaxf(-expm1f(2.0f * la), 0.0f)) * (ig * xv);
            }
    }
}

#undef LRU_PREFETCH
__device__ __forceinline__ bf16x8 rw_op16(LAS unsigned char* lds, int off) { return *(const LAS bf16x8*)(lds + off); }
__device__ __forceinline__ bf16x8 rw_op8x2(LAS unsigned char* lds, int off0, int off1) { const u32x2 lo = *(const LAS u32x2*)(lds + off0), hi = *(const LAS u32x2*)(lds + off1); const u32x4 w = (u32x4){lo.x, lo.y, hi.x, hi.y}; return __builtin_bit_cast(bf16x8, w); }
__device__ __forceinline__ bf16x8 rw_accop(const f32x4 a, const f32x4 b) { u32x4 w; w.x = pk_bf16(a[0], a[1]); w.y = pk_bf16(a[2], a[3]); w.z = pk_bf16(b[0], b[1]); w.w = pk_bf16(b[2], b[3]); return __builtin_bit_cast(bf16x8, w); }
#define RW_MFMA(a, b, c) __builtin_amdgcn_mfma_f32_16x16x32_bf16(a, b, c, 0, 0, 0)
__device__ __forceinline__ void p2_rw(KP P, int l, int item, LAS unsigned char* lds) {
    const int tid = ltid(), lane = tid & 63, wave = tid >> 6, b = item >> 3, h = item & 7;
    const int fr = lane & 15, fq = lane >> 4, st = tid >> 3, sc = (tid & 7) * 8;
    const bf16_t* U = (const bf16_t*)(P->ws + WS_U);
    const float* RWW = (const float*)(P->ws + WS_RWW); const bf16_t* RWA = (const bf16_t*)(P->ws + WS_RWA); const bf16_t* RWG = (const bf16_t*)(P->ws + WS_RWG);
    bf16_t* Y = (bf16_t*)(P->ws + WS_HY);
    LAS float* F = LDSF(0);
    constexpr int CN = 0, WC = 512, TOT = 4608, LD = 4864;
    constexpr int XD = 23552, AT = 25600, RT = AT + 9216, BT = RT + 9216, KT = BT + 9216, BTT = KT + 9216, KTT = BTT + 9216, VT = KTT + 9216, GAB = VT + 9216, GAK = GAB + 9216, GRB = GAK + 9216, GRK = GRB + 9216, OO = GRK + 9216;
    __syncthreads();
    {
        const int kind = tid >> 6, c = tid & 63; float v;
        if (kind < 3) v = P->in[I_RWMU][l * RW_IN + kind * 512 + h * 64 + c];
        else if (kind == 3) v = P->in[I_RWKK][l * 512 + h * 64 + c];
        else if (kind == 4) v = P->in[I_RWKA][l * 512 + h * 64 + c];
        else if (kind == 5) v = P->in[I_RWRK][l * 512 + h * 64 + c];
        else if (kind == 6) v = P->in[I_RWLNW][l * 512 + h * 64 + c];
        else v = P->in[I_RWLNB][l * 512 + h * 64 + c];
        F[CN + kind * 64 + c] = v;
        for (int e = tid; e < 4 * 9216 / 16; e += NTHR) *(LAS u32x4*)(lds + GAB + e * 16) = (u32x4){0u, 0u, 0u, 0u};
    }
    __syncthreads();
    f32x4 ST[4];
#pragma unroll
    for (int j = 0; j < 4; ++j) ST[j] = (f32x4){0.f, 0.f, 0.f, 0.f};
    u32x4 pr_c, pk_c, pv_c, pr_p, pk_p, pv_p, pa, pg; f32x4 pw0, pw1; float pflag;
#define RW_IDS const int tid = ltid(), lane = tid & 63, wave = tid >> 6, fr = lane & 15, fq = lane >> 4, st = tid >> 3, sc = (tid & 7) * 8; (void)lane; (void)wave; (void)fr; (void)fq; (void)st; (void)sc;
#define RW_PREFETCH(ch) do { RW_IDS const int tk_ = b * SEQ + (ch) * 64 + st; const bool first_ = ((ch) == 0 && st == 0); \
        const bf16_t* uc_ = U + (size_t)tk_ * LDU + h * 64 + sc; const bf16_t* up_ = first_ ? uc_ : uc_ - LDU; pflag = first_ ? 0.f : 1.f; \
        pr_c = *(const u32x4*)(uc_ + U_RW_R); pk_c = *(const u32x4*)(uc_ + U_RW_K); pv_c = *(const u32x4*)(uc_ + U_RW_V); \
        pr_p = *(const u32x4*)(up_ + U_RW_R); pk_p = *(const u32x4*)(up_ + U_RW_K); pv_p = *(const u32x4*)(up_ + U_RW_V); \
        const size_t o_ = (size_t)tk_ * 512 + h * 64 + sc; pw0 = *(const f32x4*)(RWW + o_); pw1 = *(const f32x4*)(RWW + o_ + 4); pa = *(const u32x4*)(RWA + o_); pg = *(const u32x4*)(RWG + o_); } while (0)
    RW_PREFETCH(0);
    for (int ch = 0; ch < SEQ / 64; ++ch) {
        u32x4 cg, cvp; float bsum = 0.f;
        {   RW_IDS
        {
        float wt[8];
        {
            wt[0] = pw0[0]; wt[1] = pw0[1]; wt[2] = pw0[2]; wt[3] = pw0[3]; wt[4] = pw1[0]; wt[5] = pw1[1]; wt[6] = pw1[2]; wt[7] = pw1[3];
            const int sl = lane >> 3;
#pragma unroll
            for (int d = 1; d < 8; d <<= 1) {
#pragma unroll
                for (int j = 0; j < 8; ++j) { const float o = __shfl_up(wt[j], 8 * d); if (sl >= d) wt[j] *= o; }
            }
            if (sl == 7) { *(LAS f32x4*)(F + TOT + wave * 64 + sc) = (f32x4){wt[0], wt[1], wt[2], wt[3]}; *(LAS f32x4*)(F + TOT + wave * 64 + sc + 4) = (f32x4){wt[4], wt[5], wt[6], wt[7]}; }
        }
        __syncthreads();
        {
            f32x4 b0 = (f32x4){1.f, 1.f, 1.f, 1.f}, b1 = b0;
            for (int wv = 0; wv < wave; ++wv) { b0 *= *(const LAS f32x4*)(F + TOT + wv * 64 + sc); b1 *= *(const LAS f32x4*)(F + TOT + wv * 64 + sc + 4); }
#pragma unroll
            for (int j = 0; j < 4; ++j) { wt[j] *= b0[j]; wt[4 + j] *= b1[j]; }
            *(LAS f32x4*)(F + WC + st * 64 + sc) = (f32x4){wt[0], wt[1], wt[2], wt[3]}; *(LAS f32x4*)(F + WC + st * 64 + sc + 4) = (f32x4){wt[4], wt[5], wt[6], wt[7]};
        }
        }
        float r[8], v[8], ma[8], bv[8], kp[8];
        cg = pg;
        {
            float k[8], a[8];
            {
                float c[8], p[8], m[8];
                unpack8(pr_c, c); unpack8(pr_p, p);
#pragma unroll
                for (int j = 0; j < 8; ++j) m[j] = F[CN + 0 * 64 + sc + j];
#pragma unroll
                for (int j = 0; j < 8; ++j) r[j] = c[j] + (p[j] * pflag - c[j]) * m[j];
                unpack8(pk_c, c); unpack8(pk_p, p);
#pragma unroll
                for (int j = 0; j < 8; ++j) m[j] = F[CN + 1 * 64 + sc + j];
#pragma unroll
                for (int j = 0; j < 8; ++j) k[j] = c[j] + (p[j] * pflag - c[j]) * m[j];
                unpack8(pv_c, c); unpack8(pv_p, p);
#pragma unroll
                for (int j = 0; j < 8; ++j) m[j] = F[CN + 2 * 64 + sc + j];
#pragma unroll
                for (int j = 0; j < 8; ++j) v[j] = c[j] + (p[j] * pflag - c[j]) * m[j];
                unpack8(pa, a);
            }
            float ss = 0.f, kkv[8];
#pragma unroll
            for (int j = 0; j < 8; ++j) { kkv[j] = k[j] * F[CN + 3 * 64 + sc + j]; ss += kkv[j] * kkv[j]; }
            ss = red8(ss);
            const float inv = 1.0f / fmaxf(sqrtf(ss + 1e-12f), 1e-6f);
#pragma unroll
            for (int j = 0; j < 8; ++j) {
                const float kn = kkv[j] * inv;
                kp[j] = k[j] * (1.0f + (a[j] - 1.0f) * F[CN + 4 * 64 + sc + j]);
                ma[j] = -kn; bv[j] = kn * a[j];
                bsum += r[j] * kp[j] * F[CN + 5 * 64 + sc + j];
            }
            bsum = red8(bsum);
        }
        {
#pragma unroll
            for (int j = 0; j < 8; j += 2) {
                const unsigned pw = pk_bf16(v[j], v[j + 1]);
                *(LAS bf16_t*)(lds + VT + ((sc + j) * 72 + st) * 2) = (bf16_t)(pw & 0xffffu);
                *(LAS bf16_t*)(lds + VT + ((sc + j + 1) * 72 + st) * 2) = (bf16_t)(pw >> 16);
            }
        }
        cvp = pack8(v);
        {
            float al[8], be[8], ka[8], rh[8];
            const f32x4 wa0 = *(const LAS f32x4*)(F + WC + st * 64 + sc), wa1 = *(const LAS f32x4*)(F + WC + st * 64 + sc + 4);
#pragma unroll
            for (int j = 0; j < 8; ++j) {
                const float wtj = (j < 4) ? wa0[j & 3] : wa1[j & 3];
                const float w1 = (j < 4) ? pw0[j & 3] : pw1[j & 3], iw = fast_rcp(wtj), wp = wtj * fast_rcp(w1);
                al[j] = ma[j] * wp; be[j] = bv[j] * iw; ka[j] = kp[j] * iw; rh[j] = r[j] * wtj;
            }
            const u32x4 qa = pack8(al), qb = pack8(be), qk = pack8(ka), qr = pack8(rh);
            *(LAS u32x4*)(lds + AT + (st * 72 + sc) * 2) = qa; *(LAS u32x4*)(lds + RT + (st * 72 + sc) * 2) = qr;
            *(LAS u32x4*)(lds + BT + (st * 72 + sc) * 2) = qb; *(LAS u32x4*)(lds + KT + (st * 72 + sc) * 2) = qk;
#pragma unroll
            for (int j = 0; j < 8; ++j) {
                const unsigned wb = qb[j >> 1], wk = qk[j >> 1];
                *(LAS bf16_t*)(lds + BTT + ((sc + j) * 72 + st) * 2) = (bf16_t)((j & 1) ? (wb >> 16) : (wb & 0xffffu));
                *(LAS bf16_t*)(lds + KTT + ((sc + j) * 72 + st) * 2) = (bf16_t)((j & 1) ? (wk >> 16) : (wk & 0xffffu));
            }
        }
        }
        __syncthreads();
        if (ch + 1 < SEQ / 64) RW_PREFETCH(ch + 1);
        {   RW_IDS
            const int m = wave >> 1;
            const int ta = (m < 2) ? AT : RT, tb = (m & 1) ? KT : BT, tg = GAB + m * 9216;
#pragma unroll
            for (int e = 0; e < 5; ++e) {
                int ti, ji;
                if (wave & 1) { ti = (e < 2) ? 1 : 2; ji = (e < 2) ? e : e - 2; } else { ti = (e < 1) ? 0 : 3; ji = (e < 1) ? 0 : e - 1; }
                f32x4 g = (f32x4){0.f, 0.f, 0.f, 0.f};
#pragma unroll
                for (int kk = 0; kk < 2; ++kk) g = RW_MFMA(rw_op16(lds, ta + ((ti * 16 + fr) * 72 + kk * 32 + fq * 8) * 2), rw_op16(lds, tb + ((ji * 16 + fr) * 72 + kk * 32 + fq * 8) * 2), g);
#pragma unroll
                for (int rg = 0; rg < 4; ++rg) {
                    const int t = ti * 16 + fq * 4 + rg, j = ji * 16 + fr;
                    const bool keep = (m >= 2) ? (j <= t) : (j < t);
                    const float val = keep ? g[rg] : 0.f;
                    *(LAS bf16_t*)(lds + tg + (t * 72 + j) * 2) = (bf16_t)(pk_bf16(val, 0.f) & 0xffffu);
                    if (m == 0 && ti == ji) F[LD + ti * 256 + (fq * 4 + rg) * 16 + fr] = val;
                }
            }
        }
        __syncthreads();
        f32x4 Yc[4]; bf16x8 s0b[2], vtb[2];
        {   RW_IDS
        if (wave == 4) {
            const int c = lane >> 4, col = lane & 15;
            float x[16];
#pragma unroll
            for (int t = 0; t < 16; ++t) {
                float acc = (t == col) ? 1.0f : 0.0f, acc1 = 0.f;
#pragma unroll
                for (int j = 0; j < t; ++j) { if (j & 1) acc1 += F[LD + c * 256 + t * 16 + j] * x[j]; else acc += F[LD + c * 256 + t * 16 + j] * x[j]; }
                acc += acc1;
                x[t] = acc;
                __builtin_amdgcn_sched_barrier(0);
                *(LAS bf16_t*)(lds + XD + ((c * 16 + t) * 16 + col) * 2) = (bf16_t)(pk_bf16(acc, 0.f) & 0xffffu);
            }
        }
        if (wave < 4) {
#pragma unroll
            for (int kk = 0; kk < 2; ++kk) { s0b[kk] = rw_accop(ST[2 * kk], ST[2 * kk + 1]); vtb[kk] = rw_op16(lds, VT + ((wave * 16 + fr) * 72 + kk * 32 + fq * 8) * 2); }
#pragma unroll
            for (int c = 0; c < 4; ++c) {
                const int row = c * 16 + fr;
                f32x4 y = (f32x4){0.f, 0.f, 0.f, 0.f};
#pragma unroll
                for (int kk = 0; kk < 2; ++kk) y = RW_MFMA(rw_op8x2(lds, AT + (row * 72 + kk * 32 + fq * 4) * 2, AT + (row * 72 + kk * 32 + 16 + fq * 4) * 2), s0b[kk], y);
                y = RW_MFMA(rw_op16(lds, GAK + (row * 72 + fq * 8) * 2), vtb[0], y);
                if (c >= 2) y = RW_MFMA(rw_op16(lds, GAK + (row * 72 + 32 + fq * 8) * 2), vtb[1], y);
                Yc[c] = y;
            }
        }
        }
        __syncthreads();
        {   RW_IDS
        if (wave < 4) {
            const f32x4 z4 = (f32x4){0.f, 0.f, 0.f, 0.f};
#define RW_XOP(c) __builtin_bit_cast(bf16x8, (u32x4){(*(const LAS u32x2*)(lds + XD + (((c) * 16 + fr) * 16 + fq * 4) * 2)).x, (*(const LAS u32x2*)(lds + XD + (((c) * 16 + fr) * 16 + fq * 4) * 2)).y, 0u, 0u})
#define RW_LOP(c, kk) rw_op8x2(lds, GAB + (((c) * 16 + fr) * 72 + (kk) * 32 + fq * 4) * 2, GAB + (((c) * 16 + fr) * 72 + (kk) * 32 + 16 + fq * 4) * 2)
            const f32x4 U0 = RW_MFMA(RW_XOP(0), rw_accop(Yc[0], z4), z4);
            const f32x4 Y1 = RW_MFMA(RW_LOP(1, 0), rw_accop(U0, z4), Yc[1]);
            const f32x4 U1 = RW_MFMA(RW_XOP(1), rw_accop(Y1, z4), z4);
            const bf16x8 ub0 = rw_accop(U0, U1);
            const f32x4 Y2 = RW_MFMA(RW_LOP(2, 0), ub0, Yc[2]);
            const f32x4 U2 = RW_MFMA(RW_XOP(2), rw_accop(Y2, z4), z4);
            f32x4 Y3 = RW_MFMA(RW_LOP(3, 0), ub0, Yc[3]);
            Y3 = RW_MFMA(RW_LOP(3, 1), rw_accop(U2, z4), Y3);
            const f32x4 U3 = RW_MFMA(RW_XOP(3), rw_accop(Y3, z4), z4);
            const bf16x8 ub1 = rw_accop(U2, U3);
#undef RW_XOP
#undef RW_LOP
            {
                f32x4 o[4];
#pragma unroll
                for (int c = 0; c < 4; ++c) o[c] = (f32x4){0.f, 0.f, 0.f, 0.f};
#pragma unroll
                for (int kk = 0; kk < 2; ++kk)
#pragma unroll
                    for (int c = 0; c < 4; ++c) o[c] = RW_MFMA(rw_op8x2(lds, RT + ((c * 16 + fr) * 72 + kk * 32 + fq * 4) * 2, RT + ((c * 16 + fr) * 72 + kk * 32 + 16 + fq * 4) * 2), s0b[kk], o[c]);
#pragma unroll
                for (int c = 0; c < 4; ++c) o[c] = RW_MFMA(rw_op8x2(lds, GRB + ((c * 16 + fr) * 72 + fq * 4) * 2, GRB + ((c * 16 + fr) * 72 + 16 + fq * 4) * 2), ub0, o[c]);
#pragma unroll
                for (int c = 0; c < 4; ++c) o[c] = RW_MFMA(rw_op16(lds, GRK + ((c * 16 + fr) * 72 + fq * 8) * 2), vtb[0], o[c]);
#pragma unroll
                for (int c = 2; c < 4; ++c) o[c] = RW_MFMA(rw_op8x2(lds, GRB + ((c * 16 + fr) * 72 + 32 + fq * 4) * 2, GRB + ((c * 16 + fr) * 72 + 48 + fq * 4) * 2), ub1, o[c]);
#pragma unroll
                for (int c = 2; c < 4; ++c) o[c] = RW_MFMA(rw_op16(lds, GRK + ((c * 16 + fr) * 72 + 32 + fq * 8) * 2), vtb[1], o[c]);
#pragma unroll
                for (int c = 0; c < 4; ++c)
#pragma unroll
                    for (int rg = 0; rg < 4; ++rg) *(LAS float*)(lds + OO + ((c * 16 + fq * 4 + rg) * 68 + wave * 16 + fr) * 4) = o[c][rg];
            }
#pragma unroll
            for (int kt = 0; kt < 4; ++kt) ST[kt] = RW_MFMA(rw_op8x2(lds, BTT + ((kt * 16 + fr) * 72 + fq * 4) * 2, BTT + ((kt * 16 + fr) * 72 + 16 + fq * 4) * 2), ub0, ST[kt]);
#pragma unroll
            for (int kt = 0; kt < 4; ++kt) ST[kt] = RW_MFMA(rw_op8x2(lds, BTT + ((kt * 16 + fr) * 72 + 32 + fq * 4) * 2, BTT + ((kt * 16 + fr) * 72 + 48 + fq * 4) * 2), ub1, ST[kt]);
#pragma unroll
            for (int kt = 0; kt < 4; ++kt) ST[kt] = RW_MFMA(rw_op16(lds, KTT + ((kt * 16 + fr) * 72 + fq * 8) * 2), vtb[0], ST[kt]);
#pragma unroll
            for (int kt = 0; kt < 4; ++kt) ST[kt] = RW_MFMA(rw_op16(lds, KTT + ((kt * 16 + fr) * 72 + 32 + fq * 8) * 2), vtb[1], ST[kt]);
#pragma unroll
            for (int kt = 0; kt < 4; ++kt) ST[kt] *= *(const LAS f32x4*)(F + WC + 63 * 64 + kt * 16 + fq * 4);
        }
        }
        __syncthreads();
        {   RW_IDS
            const f32x4 o0 = *(const LAS f32x4*)(lds + OO + (st * 68 + sc) * 4), o1 = *(const LAS f32x4*)(lds + OO + (st * 68 + sc + 4) * 4);
            float o[8] = {o0[0], o0[1], o0[2], o0[3], o1[0], o1[1], o1[2], o1[3]}, v8[8], g8[8], y8[8];
            unpack8(cvp, v8); unpack8(cg, g8);
            float sm = 0.f;
#pragma unroll
            for (int j = 0; j < 8; ++j) sm += o[j];
            const float mean = red8(sm) * (1.0f / 64.0f);
            float q = 0.f;
#pragma unroll
            for (int j = 0; j < 8; ++j) { o[j] -= mean; q += o[j] * o[j]; }
            const float rs = rsqrtf(red8(q) * (1.0f / 64.0f) + 64e-5f);
#pragma unroll
            for (int j = 0; j < 8; ++j) y8[j] = (o[j] * rs * F[CN + 6 * 64 + sc + j] + F[CN + 7 * 64 + sc + j] + bsum * v8[j]) * g8[j];
            *(u32x4*)(Y + (size_t)(b * SEQ + ch * 64 + st) * DM + 512 + h * 64 + sc) = pack8(y8);
        }
    }
#undef RW_PREFETCH
#undef RW_IDS
}
#undef RW_MFMA


__device__ __forceinline__ void p2_hg(KP P, int l, int item, LAS unsigned char* lds) {
    const int tid = ltid(), lane = tid & 63, wave = tid >> 6, b = item >> 2, h = item & 3;
    const int fr = lane & 15, fq = lane >> 4, st = tid >> 3, c16 = tid & 7, sv = c16 * 16;
    const bf16_t* U = (const bf16_t*)(P->ws + WS_U); bf16_t* Y = (bf16_t*)(P->ws + WS_HY);
    LAS float* F = LDSF(0);
    constexpr int LBO = 0, HN = 128, FF = 256, TT = 8448;
    constexpr int QB = 35840, KB = QB + 64 * 136 * 2, KT = KB + 64 * 136 * 2, VT = KT + 128 * 72 * 2, AB = VT + 128 * 72 * 2, OO = AB + 64 * 40 * 2;
    __syncthreads();
    if (tid < 128) { float lb = 0.f; if (l == 1) lb = sigmoidf_(P->in[I_HGLB][512 + h * 128 + tid] - P->in[I_HGLB][h * 128 + tid]); F[LBO + tid] = lb; F[HN + tid] = P->in[I_HGNORM][l * 512 + h * 128 + tid]; }
    __syncthreads();
    f32x4 S[8];
#pragma unroll
    for (int j = 0; j < 8; ++j) S[j] = (f32x4){0.f, 0.f, 0.f, 0.f};
    u32x4 pq0, pq1, pf0, pf1, pv0, pv1;
#define HG_IDS const int tid = ltid(), lane = tid & 63, wave = tid >> 6, fr = lane & 15, fq = lane >> 4, st = tid >> 3, c16 = tid & 7, sv = c16 * 16; (void)lane; (void)wave; (void)fr; (void)fq; (void)st; (void)c16; (void)sv;
#define HG_PREFETCH(ch) do { HG_IDS const bf16_t* ur_ = U + (size_t)(b * SEQ + (ch) * 64 + st) * LDU + h * 128; \
        pq0 = *(const u32x4*)(ur_ + U_HG_Q + c16 * 16); pq1 = *(const u32x4*)(ur_ + U_HG_Q + c16 * 16 + 8); pf0 = *(const u32x4*)(ur_ + U_HG_F + c16 * 16); pf1 = *(const u32x4*)(ur_ + U_HG_F + c16 * 16 + 8); \
        pv0 = *(const u32x4*)(ur_ + U_HG_I + sv); pv1 = *(const u32x4*)(ur_ + U_HG_I + sv + 8); } while (0)
    HG_PREFETCH(0);
    for (int ch = 0; ch < SEQ / 64; ++ch) {
        float fo[16], kx[16], qs[16];
        u32x4 cg0, cg1;
        {   HG_IDS
            { const bf16_t* ug_ = U + (size_t)(b * SEQ + ch * 64 + st) * LDU + U_HG_G + h * 128 + sv; cg0 = *(const u32x4*)ug_; cg1 = *(const u32x4*)(ug_ + 8); }
            float q[16], z[16];
            { float t0[8], t1[8]; unpack8(pq0, t0); unpack8(pq1, t1);
#pragma unroll
              for (int j = 0; j < 8; ++j) { q[j] = t0[j]; q[8 + j] = t1[j]; }
              unpack8(pf0, t0); unpack8(pf1, t1);
#pragma unroll
              for (int j = 0; j < 8; ++j) { z[j] = t0[j]; z[8 + j] = t1[j]; } }
#pragma unroll
            for (int j = 0; j < 16; ++j) {
                const float lb = F[LBO + c16 * 16 + j], e = __expf(-z[j]), sg = fast_rcp(1.0f + e);
                fo[j] = lb + (1.0f - lb) * sg; kx[j] = (1.0f - lb) * (e * sg);
                qs[j] = siluf_(q[j]);
            }
        }
        const u32x4 cv0 = pv0, cv1 = pv1;
        __syncthreads();
        {   HG_IDS
#pragma unroll
            for (int m = 0; m < 4; ++m) *(LAS f32x4*)(F + FF + st * 128 + c16 * 16 + 4 * m) = (f32x4){fo[4 * m], fo[4 * m + 1], fo[4 * m + 2], fo[4 * m + 3]};
#pragma unroll
            for (int j = 0; j < 8; ++j) {
                const unsigned w0 = cv0[j >> 1], w1 = cv1[j >> 1];
                *(LAS bf16_t*)(lds + VT + ((sv + j) * 72 + st) * 2) = (bf16_t)((j & 1) ? (w0 >> 16) : (w0 & 0xffffu));
                *(LAS bf16_t*)(lds + VT + ((sv + 8 + j) * 72 + st) * 2) = (bf16_t)((j & 1) ? (w1 >> 16) : (w1 & 0xffffu));
            }
        }
        __syncthreads();
        {   HG_IDS
            const int kk = tid & 127, w4 = tid >> 7; float c = 1.0f;
#pragma unroll 4
            for (int i = 0; i < 16; ++i) { const int ix = FF + (w4 * 16 + i) * 128 + kk; c *= F[ix]; F[ix] = c; }
            F[TT + w4 * 128 + kk] = c;
        }
        __syncthreads();
        if ((ltid() >> 7) & 1) {   HG_IDS
            const int kk = tid & 127, w4 = tid >> 7; const float m0 = F[TT + (w4 - 1) * 128 + kk];
#pragma unroll 4
            for (int i = 0; i < 16; ++i) F[FF + (w4 * 16 + i) * 128 + kk] *= m0;
        }
        __syncthreads();
        {   HG_IDS
#pragma unroll
            for (int m = 0; m < 4; ++m) {
                const f32x4 c4 = *(const LAS f32x4*)(F + FF + st * 128 + c16 * 16 + 4 * m);
                float qc[4], kc[4];
#pragma unroll
                for (int j = 0; j < 4; ++j) { const float cc = fmaxf(c4[j], 1e-30f); qc[j] = qs[4 * m + j] * cc; kc[j] = kx[4 * m + j] * fast_rcp(cc); }
                u32x2 w; w.x = pk_bf16(qc[0], qc[1]); w.y = pk_bf16(qc[2], qc[3]);
                *(LAS u32x2*)(lds + QB + (st * 136 + c16 * 16 + 4 * m) * 2) = w;
                w.x = pk_bf16(kc[0], kc[1]); w.y = pk_bf16(kc[2], kc[3]);
                *(LAS u32x2*)(lds + KB + (st * 136 + c16 * 16 + 4 * m) * 2) = w;
                *(LAS bf16_t*)(lds + KT + ((c16 * 16 + 4 * m + 0) * 72 + st) * 2) = (bf16_t)(w.x & 0xffffu);
                *(LAS bf16_t*)(lds + KT + ((c16 * 16 + 4 * m + 1) * 72 + st) * 2) = (bf16_t)(w.x >> 16);
                *(LAS bf16_t*)(lds + KT + ((c16 * 16 + 4 * m + 2) * 72 + st) * 2) = (bf16_t)(w.y & 0xffffu);
                *(LAS bf16_t*)(lds + KT + ((c16 * 16 + 4 * m + 3) * 72 + st) * 2) = (bf16_t)(w.y >> 16);
            }
        }
        __syncthreads();
        {   HG_IDS
        if (ch + 1 < SEQ / 64) HG_PREFETCH(ch + 1);
        {
            const int wn = wave >> 2, ti = (wave >> 1) & 1, si = wave & 1;
            f32x4 a0 = (f32x4){0.f, 0.f, 0.f, 0.f};
#pragma unroll
            for (int kk = 0; kk < 4; ++kk) {
                const bf16x8 qa = *(const LAS bf16x8*)(lds + QB + ((wn * 32 + ti * 16 + fr) * 136 + kk * 32 + fq * 8) * 2);
                const bf16x8 k0 = *(const LAS bf16x8*)(lds + KB + ((wn * 32 + si * 16 + fr) * 136 + kk * 32 + fq * 8) * 2);
                a0 = __builtin_amdgcn_mfma_f32_16x16x32_bf16(qa, k0, a0, 0, 0, 0);
            }
#pragma unroll
            for (int rg = 0; rg < 4; ++rg) {
                const int tl = ti * 16 + fq * 4 + rg, sl = si * 16 + fr;
                const unsigned w0 = pk_bf16((sl <= tl) ? a0[rg] : 0.f, 0.f) & 0xffffu;
                *(LAS bf16_t*)(lds + AB + ((wn * 32 + tl) * 40 + sl) * 2) = (bf16_t)w0;
            }
        }
        }
        __syncthreads();
        {   HG_IDS
        *(LAS u32x4*)(lds + KB + (st * 136 + sv) * 2) = cg0; *(LAS u32x4*)(lds + KB + (st * 136 + sv + 8) * 2) = cg1;
        {
            bf16x8 vb[2];
#pragma unroll
            for (int wn = 0; wn < 2; ++wn) vb[wn] = *(const LAS bf16x8*)(lds + VT + ((wave * 16 + fr) * 72 + wn * 32 + fq * 8) * 2);
#pragma unroll
            for (int wn = 0; wn < 2; ++wn) {
                bf16x8 mb[4];
#pragma unroll
                for (int kk = 0; kk < 4; ++kk) {
                    u32x4 w; w.x = pk_bf16(S[2 * kk][0], S[2 * kk][1]); w.y = pk_bf16(S[2 * kk][2], S[2 * kk][3]); w.z = pk_bf16(S[2 * kk + 1][0], S[2 * kk + 1][1]); w.w = pk_bf16(S[2 * kk + 1][2], S[2 * kk + 1][3]);
                    mb[kk] = __builtin_bit_cast(bf16x8, w);
                }
                {
                    f32x4 o[2];
#pragma unroll
                    for (int ti = 0; ti < 2; ++ti) o[ti] = __builtin_amdgcn_mfma_f32_16x16x32_bf16(*(const LAS bf16x8*)(lds + AB + ((wn * 32 + ti * 16 + fr) * 40 + fq * 8) * 2), vb[wn], (f32x4){0.f, 0.f, 0.f, 0.f}, 0, 0, 0);
#pragma unroll
                    for (int kk = 0; kk < 4; ++kk) {
#pragma unroll
                        for (int ti = 0; ti < 2; ++ti) {
                            const int row = wn * 32 + ti * 16 + fr;
                            const u32x2 lo = *(const LAS u32x2*)(lds + QB + (row * 136 + kk * 32 + fq * 4) * 2), hi = *(const LAS u32x2*)(lds + QB + (row * 136 + kk * 32 + 16 + fq * 4) * 2);
                            const u32x4 w = (u32x4){lo.x, lo.y, hi.x, hi.y};
                            o[ti] = __builtin_amdgcn_mfma_f32_16x16x32_bf16(__builtin_bit_cast(bf16x8, w), mb[kk], o[ti], 0, 0, 0);
                        }
#pragma unroll
                        for (int k2 = 0; k2 < 2; ++k2) {
                            const int kt = kk * 2 + k2;
                            const bf16x8 ka = *(const LAS bf16x8*)(lds + KT + ((kt * 16 + fr) * 72 + wn * 32 + fq * 8) * 2);
                            S[kt] = __builtin_amdgcn_mfma_f32_16x16x32_bf16(ka, vb[wn], S[kt], 0, 0, 0);
                        }
                    }
#pragma unroll
                    for (int ti = 0; ti < 2; ++ti)
#pragma unroll
                        for (int rg = 0; rg < 4; ++rg) *(LAS float*)(lds + OO + ((wn * 32 + ti * 16 + fq * 4 + rg) * 132 + wave * 16 + fr) * 4) = o[ti][rg];
#pragma unroll
                    for (int kt = 0; kt < 8; ++kt) S[kt] *= *(const LAS f32x4*)(F + FF + (wn * 32 + 31) * 128 + kt * 16 + fq * 4);
                }
            }
        }
        }
        __syncthreads();
        {   HG_IDS
            float ss = 0.f;
#pragma unroll
            for (int m = 0; m < 4; ++m) { const f32x4 x = *(const LAS f32x4*)(lds + OO + (st * 132 + sv + 4 * m) * 4); ss += x[0] * x[0] + x[1] * x[1] + x[2] * x[2] + x[3] * x[3]; }
            const float rs = rsqrtf(red8(ss) * (1.0f / 128.0f) + 1e-6f);
            bf16_t* yr = Y + (size_t)(b * SEQ + ch * 64 + st) * DM + h * 128 + sv;
#pragma unroll 1
            for (int hf = 0; hf < 2; ++hf) {
                const f32x4 x0 = *(const LAS f32x4*)(lds + OO + (st * 132 + sv + hf * 8) * 4), x1 = *(const LAS f32x4*)(lds + OO + (st * 132 + sv + hf * 8 + 4) * 4);
                const f32x4 n0 = *(const LAS f32x4*)(F + HN + sv + hf * 8), n1 = *(const LAS f32x4*)(F + HN + sv + hf * 8 + 4);
                float g[8], y8[8]; unpack8(*(const LAS u32x4*)(lds + KB + (st * 136 + sv + hf * 8) * 2), g);
#pragma unroll
                for (int j = 0; j < 4; ++j) { y8[j] = x0[j] * rs * n0[j] * siluf_(g[j]); y8[4 + j] = x1[j] * rs * n1[j] * siluf_(g[4 + j]); }
                *(u32x4*)(yr + hf * 8) = pack8(y8);
            }
        }
    }
#undef HG_PREFETCH
#undef HG_IDS
}

__device__ __forceinline__ void p2_ml(KP P, int l, int item, LAS unsigned char* lds) {
    const int tid = ltid(), lane = tid & 63, wave = tid >> 6, b = item >> 2, h = item & 3;
    const int fr = lane & 15, fq = lane >> 4, st = tid >> 3, c8 = tid & 7, sv = c8 * 16;
    const int blk = tid & 31, sg = tid >> 5;
    const bf16_t* U = (const bf16_t*)(P->ws + WS_U); bf16_t* Y = (bf16_t*)(P->ws + WS_HY);
    LAS float* F = LDSF(0);
    constexpr int FD = 0, IW = 64, EN = 128, RS = 256, NK = 512, TNS = 768, CT = 1280, MN = 2944, MS = 3072;
    constexpr int QB = 12800, KB = QB + 64 * 136 * 2, KT = KB + 64 * 136 * 2, VT = KT + 128 * 72 * 2, AB = VT + 128 * 72 * 2, OO = AB + 64 * 72 * 2, XC = OO + 64 * 132 * 4;
    __syncthreads();
    if (tid < 32) {
        const int cgl = h * 128 + blk * 4;
#pragma unroll
        for (int jj = 0; jj < 4; ++jj) *(LAS f32x4*)(F + CT + (jj * 32 + blk) * 4) = *(const f32x4*)(P->in[I_MLCW] + l * 2048 + jj * 512 + cgl);
        *(LAS f32x4*)(F + CT + (4 * 32 + blk) * 4) = *(const f32x4*)(P->in[I_MLCB] + l * 512 + cgl);
#pragma unroll
        for (int j = 0; j < 4; ++j) {
            *(LAS f32x4*)(F + CT + ((5 + j) * 32 + blk) * 4) = *(const f32x4*)(P->in[I_MLWQ] + (size_t)l * 2048 + (h * 32 + blk) * 16 + j * 4) * 0.08838834764831845f;
            *(LAS f32x4*)(F + CT + ((9 + j) * 32 + blk) * 4) = *(const f32x4*)(P->in[I_MLWK] + (size_t)l * 2048 + (h * 32 + blk) * 16 + j * 4);
        }
    }
    const float ib = P->in[I_MLIB][l * 4 + h], fb = P->in[I_MLFB][l * 4 + h];
    f32x4 M[8];
#pragma unroll
    for (int j = 0; j < 8; ++j) M[j] = (f32x4){0.f, 0.f, 0.f, 0.f};
    float mcarry = 0.f;
    u32x2 px[7]; u32x4 pv0, pv1; unsigned pif;
#define ML_IDS const int tid = ltid(), lane = tid & 63, wave = tid >> 6, fr = lane & 15, fq = lane >> 4, st = tid >> 3, c8 = tid & 7, sv = c8 * 16, blk = tid & 31, sg = tid >> 5; (void)lane; (void)wave; (void)fr; (void)fq; (void)st; (void)c8; (void)sv; (void)blk; (void)sg;
#define ML_PREFETCH(ch) do { ML_IDS const int ts0_ = (ch) * 64 + sg * 4 - 3; \
        _Pragma("unroll") for (int r = 0; r < 7; ++r) { const int ts_ = ts0_ + r; \
            px[r] = *(const u32x2*)(U + (size_t)(b * SEQ + (ts_ < 0 ? 0 : ts_)) * LDU + U_ML_X + h * 128 + blk * 4); } \
        { const bf16_t* uv_ = U + (size_t)(b * SEQ + (ch) * 64 + st) * LDU + U_ML_V + h * 128 + sv; pv0 = *(const u32x4*)uv_; pv1 = *(const u32x4*)(uv_ + 8); } \
        { const bf16_t* ug_ = U + (size_t)(b * SEQ + (ch) * 64 + lane) * LDU; pif = (unsigned)ug_[U_ML_I + h] | ((unsigned)ug_[U_ML_F + h] << 16); } } while (0)
    if (tid < 128) { F[NK + tid] = 0.f; F[MN + tid] = P->in[I_MLNORM][l * 512 + h * 128 + tid]; F[MS + tid] = P->in[I_MLSKIP][l * 512 + h * 128 + tid]; }
    ML_PREFETCH(0);
    __syncthreads();
    for (int ch = 0; ch < SEQ / 64; ++ch) {
        const u32x4 cv0 = pv0, cv1 = pv1;
        u32x4 co0, co1;
        {   ML_IDS
        { const bf16_t* uo_ = U + (size_t)(b * SEQ + ch * 64 + st) * LDU + U_ML_O + h * 128 + sv; co0 = *(const u32x4*)uo_; co1 = *(const u32x4*)(uo_ + 8); }
        }
        __syncthreads();
        float q[4][4], k[4][4];
        {   ML_IDS
        {
            float xc[4][4];
            {
                f32x4 cw[4];
#pragma unroll
                for (int j = 0; j < 4; ++j) cw[j] = *(const LAS f32x4*)(F + CT + (j * 32 + blk) * 4);
                const f32x4 cb4 = *(const LAS f32x4*)(F + CT + (4 * 32 + blk) * 4);
                float x[7][4];
#pragma unroll
                for (int r = 0; r < 7; ++r) { const float vf = (ch * 64 + sg * 4 - 3 + r) < 0 ? 0.f : 1.f; x[r][0] = vf * bflo(px[r].x); x[r][1] = vf * bfhi(px[r].x); x[r][2] = vf * bflo(px[r].y); x[r][3] = vf * bfhi(px[r].y); }
#pragma unroll
                for (int s = 0; s < 4; ++s)
#pragma unroll
                    for (int j = 0; j < 4; ++j) xc[s][j] = siluf_(cb4[j] + cw[0][j] * x[s][j] + cw[1][j] * x[s + 1][j] + cw[2][j] * x[s + 2][j] + cw[3][j] * x[s + 3][j]);
            }
#pragma unroll
            for (int s = 0; s < 4; ++s) { u32x2 w; w.x = pk_bf16(xc[s][0], xc[s][1]); w.y = pk_bf16(xc[s][2], xc[s][3]); *(LAS u32x2*)(lds + XC + ((sg * 4 + s) * 136 + blk * 4) * 2) = w; }
            __builtin_amdgcn_sched_barrier(0);
            {
                f32x4 wq[4];
#pragma unroll
                for (int j = 0; j < 4; ++j) wq[j] = *(const LAS f32x4*)(F + CT + ((5 + j) * 32 + blk) * 4);
#pragma unroll
                for (int s = 0; s < 4; ++s)
#pragma unroll
                    for (int i = 0; i < 4; ++i) q[s][i] = xc[s][0] * wq[0][i] + xc[s][1] * wq[1][i] + xc[s][2] * wq[2][i] + xc[s][3] * wq[3][i];
            }
            __builtin_amdgcn_sched_barrier(0);
            {
                f32x4 wk[4];
#pragma unroll
                for (int j = 0; j < 4; ++j) wk[j] = *(const LAS f32x4*)(F + CT + ((9 + j) * 32 + blk) * 4);
#pragma unroll
                for (int s = 0; s < 4; ++s)
#pragma unroll
                    for (int i = 0; i < 4; ++i) k[s][i] = xc[s][0] * wk[0][i] + xc[s][1] * wk[1][i] + xc[s][2] * wk[2][i] + xc[s][3] * wk[3][i];
            }
        }
        if (wave == 0) {
            const float ip = bflo(pif) + ib, xf = bfhi(pif) + fb;
            const float lf = fminf(xf, 0.f) - log1pf(__expf(-fabsf(xf)));
            const float bs = wave_scan_sum(lf);
            const float cm = wave_scan_max(ip - bs);
            const float g = fmaxf(mcarry, cm), mt = bs + g;
            const int lq = lane + lsgpr(0);
            F[FD + lq] = __expf(mcarry - g);
            F[IW + lq] = __expf(ip - bs - mcarry);
            F[EN + lq] = __expf(-mt);
            mcarry = __int_as_float(__builtin_amdgcn_readlane(__float_as_int(mt), 63));
        }
        }
        __syncthreads();
        {   ML_IDS
#pragma unroll
            for (int s = 0; s < 4; ++s) {
                const int t = sg * 4 + s; const float fd = F[FD + t], iw = F[IW + t];
#pragma unroll
                for (int i = 0; i < 4; ++i) { q[s][i] *= fd; k[s][i] *= iw; }
                u32x2 w; w.x = pk_bf16(q[s][0], q[s][1]); w.y = pk_bf16(q[s][2], q[s][3]);
                *(LAS u32x2*)(lds + QB + (t * 136 + blk * 4) * 2) = w;
                w.x = pk_bf16(k[s][0], k[s][1]); w.y = pk_bf16(k[s][2], k[s][3]);
                *(LAS u32x2*)(lds + KB + (t * 136 + blk * 4) * 2) = w;
            }
#pragma unroll
            for (int i = 0; i < 4; ++i) {
                u32x2 w; w.x = pk_bf16(k[0][i], k[1][i]); w.y = pk_bf16(k[2][i], k[3][i]);
                *(LAS u32x2*)(lds + KT + ((blk * 4 + i) * 72 + sg * 4) * 2) = w;
            }
#pragma unroll
            for (int j = 0; j < 8; ++j) {
                const unsigned w0 = cv0[j >> 1], w1 = cv1[j >> 1];
                *(LAS bf16_t*)(lds + VT + ((sv + j) * 72 + st) * 2) = (bf16_t)((j & 1) ? (w0 >> 16) : (w0 & 0xffffu));
                *(LAS bf16_t*)(lds + VT + ((sv + 8 + j) * 72 + st) * 2) = (bf16_t)((j & 1) ? (w1 >> 16) : (w1 & 0xffffu));
            }
        }
        __syncthreads();
        {   ML_IDS
        if (ch + 1 < SEQ / 64) ML_PREFETCH(ch + 1);
        {
            const int ti = wave >> 1, si0 = 2 * (wave & 1);
            f32x4 a0 = (f32x4){0.f, 0.f, 0.f, 0.f}, a1 = a0;
#pragma unroll
            for (int kk = 0; kk < 4; ++kk) {
                const bf16x8 qa = *(const LAS bf16x8*)(lds + QB + ((ti * 16 + fr) * 136 + kk * 32 + fq * 8) * 2);
                const bf16x8 k0 = *(const LAS bf16x8*)(lds + KB + (((si0) * 16 + fr) * 136 + kk * 32 + fq * 8) * 2);
                const bf16x8 k1 = *(const LAS bf16x8*)(lds + KB + (((si0 + 1) * 16 + fr) * 136 + kk * 32 + fq * 8) * 2);
                a0 = __builtin_amdgcn_mfma_f32_16x16x32_bf16(qa, k0, a0, 0, 0, 0);
                a1 = __builtin_amdgcn_mfma_f32_16x16x32_bf16(qa, k1, a1, 0, 0, 0);
            }
#pragma unroll
            for (int rg = 0; rg < 4; ++rg) {
                const int ta = ti * 16 + fq * 4 + rg, s0 = si0 * 16 + fr, s1 = s0 + 16;
                const unsigned w0 = pk_bf16((s0 <= ta) ? a0[rg] : 0.f, 0.f) & 0xffffu, w1 = pk_bf16((s1 <= ta) ? a1[rg] : 0.f, 0.f) & 0xffffu;
                *(LAS bf16_t*)(lds + AB + (ta * 72 + s0) * 2) = (bf16_t)w0;
                *(LAS bf16_t*)(lds + AB + (ta * 72 + s1) * 2) = (bf16_t)w1;
                const float r0 = red16(bflo(w0)), r1 = red16(bflo(w1));
                if (fr == 0) { F[RS + si0 * 64 + ta] = r0; F[RS + (si0 + 1) * 64 + ta] = r1; }
            }
            const int kk = tid & 127, q4 = tid >> 7;
            const u32x4 t0 = *(const LAS u32x4*)(lds + KT + (kk * 72 + q4 * 16) * 2), t1 = *(const LAS u32x4*)(lds + KT + (kk * 72 + q4 * 16 + 8) * 2);
            float f0[8], f1[8]; unpack8(t0, f0); unpack8(t1, f1);
            float s = 0.f;
#pragma unroll
            for (int j = 0; j < 8; ++j) s += f0[j] + f1[j];
            F[TNS + q4 * 128 + kk] = s;
        }
        }
        __syncthreads();
        {   ML_IDS
        *(LAS u32x4*)(lds + KB + (st * 136 + sv) * 2) = co0; *(LAS u32x4*)(lds + KB + (st * 136 + sv + 8) * 2) = co1;
        {
            const float ce = F[FD + 63];
            bf16x8 mb[4], vb[2];
#pragma unroll
            for (int kk = 0; kk < 4; ++kk) {
                u32x4 w; w.x = pk_bf16(M[2 * kk][0], M[2 * kk][1]); w.y = pk_bf16(M[2 * kk][2], M[2 * kk][3]); w.z = pk_bf16(M[2 * kk + 1][0], M[2 * kk + 1][1]); w.w = pk_bf16(M[2 * kk + 1][2], M[2 * kk + 1][3]);
                mb[kk] = __builtin_bit_cast(bf16x8, w);
            }
#pragma unroll
            for (int kk = 0; kk < 2; ++kk) vb[kk] = *(const LAS bf16x8*)(lds + VT + ((wave * 16 + fr) * 72 + kk * 32 + fq * 8) * 2);
            {
                f32x4 o[4];
#pragma unroll
                for (int ti = 0; ti < 4; ++ti) o[ti] = (f32x4){0.f, 0.f, 0.f, 0.f};
#pragma unroll
                for (int kk = 0; kk < 2; ++kk)
#pragma unroll
                    for (int ti = 0; ti < 4; ++ti) {
                        const bf16x8 sa = *(const LAS bf16x8*)(lds + AB + ((ti * 16 + fr) * 72 + kk * 32 + fq * 8) * 2);
                        o[ti] = __builtin_amdgcn_mfma_f32_16x16x32_bf16(sa, vb[kk], o[ti], 0, 0, 0);
                    }
#pragma unroll
                for (int kk = 0; kk < 4; ++kk)
#pragma unroll
                    for (int ti = 0; ti < 4; ++ti) {
                        const u32x2 lo = *(const LAS u32x2*)(lds + QB + ((ti * 16 + fr) * 136 + kk * 32 + fq * 4) * 2), hi = *(const LAS u32x2*)(lds + QB + ((ti * 16 + fr) * 136 + kk * 32 + 16 + fq * 4) * 2);
                        const u32x4 w = (u32x4){lo.x, lo.y, hi.x, hi.y};
                        o[ti] = __builtin_amdgcn_mfma_f32_16x16x32_bf16(__builtin_bit_cast(bf16x8, w), mb[kk], o[ti], 0, 0, 0);
                    }
#pragma unroll
                for (int ti = 0; ti < 4; ++ti)
#pragma unroll
                    for (int rg = 0; rg < 4; ++rg) *(LAS float*)(lds + OO + ((ti * 16 + fq * 4 + rg) * 132 + wave * 16 + fr) * 4) = o[ti][rg];
            }
#pragma unroll
            for (int kk = 0; kk < 2; ++kk)
#pragma unroll
                for (int kt = 0; kt < 8; ++kt) {
                    const bf16x8 ka = *(const LAS bf16x8*)(lds + KT + ((kt * 16 + fr) * 72 + kk * 32 + fq * 8) * 2);
                    M[kt] = __builtin_amdgcn_mfma_f32_16x16x32_bf16(ka, vb[kk], M[kt], 0, 0, 0);
                }
#pragma unroll
            for (int kt = 0; kt < 8; ++kt) M[kt] *= ce;
            if (tid < 128) F[NK + ((ch + 1) & 1) * 128 + tid] = (F[NK + (ch & 1) * 128 + tid] + (F[TNS + tid] + F[TNS + 128 + tid]) + (F[TNS + 256 + tid] + F[TNS + 384 + tid])) * ce;
        }
        }
        __syncthreads();
        {   ML_IDS
            const u32x4 q0 = *(const LAS u32x4*)(lds + QB + (st * 136 + c8 * 16) * 2), q1 = *(const LAS u32x4*)(lds + QB + (st * 136 + c8 * 16 + 8) * 2);
            float f0[8], f1[8]; unpack8(q0, f0); unpack8(q1, f1);
            float d = 0.f;
#pragma unroll
            for (int m = 0; m < 2; ++m) {
                const f32x4 n0 = *(const LAS f32x4*)(F + NK + (ch & 1) * 128 + c8 * 16 + 4 * m), n1 = *(const LAS f32x4*)(F + NK + (ch & 1) * 128 + c8 * 16 + 8 + 4 * m);
#pragma unroll
                for (int j = 0; j < 4; ++j) d += f0[4 * m + j] * n0[j] + f1[4 * m + j] * n1[j];
            }
            d = red8(d);
            d += (F[RS + st] + F[RS + 64 + st]) + (F[RS + 128 + st] + F[RS + 192 + st]);
            const float dinv = 1.0f / fmaxf(fabsf(d), F[EN + st]);
            float o[16], og[16], xs[16];
#pragma unroll
            for (int m = 0; m < 4; ++m) { const f32x4 x = *(const LAS f32x4*)(lds + OO + (st * 132 + sv + 4 * m) * 4); o[4 * m] = x[0] * dinv; o[4 * m + 1] = x[1] * dinv; o[4 * m + 2] = x[2] * dinv; o[4 * m + 3] = x[3] * dinv; }
            { float t0[8], t1[8]; unpack8(*(const LAS u32x4*)(lds + KB + (st * 136 + sv) * 2), t0); unpack8(*(const LAS u32x4*)(lds + KB + (st * 136 + sv + 8) * 2), t1);
#pragma unroll
              for (int j = 0; j < 8; ++j) { og[j] = t0[j]; og[8 + j] = t1[j]; }
              unpack8(*(const LAS u32x4*)(lds + XC + (st * 136 + sv) * 2), t0); unpack8(*(const LAS u32x4*)(lds + XC + (st * 136 + sv + 8) * 2), t1);
#pragma unroll
              for (int j = 0; j < 8; ++j) { xs[j] = t0[j]; xs[8 + j] = t1[j]; } }
            float ss = 0.f;
#pragma unroll
            for (int j = 0; j < 16; ++j) { o[j] *= sigmoidf_(og[j]); ss += o[j] * o[j]; }
            const float rs = rsqrtf(red8(ss) * (1.0f / 128.0f) + 1e-6f);
#pragma unroll
            for (int j = 0; j < 16; ++j) o[j] = o[j] * rs * F[MN + sv + j] + F[MS + sv + j] * xs[j];
            u32x4 w0, w1;
            w0.x = pk_bf16(o[0], o[1]); w0.y = pk_bf16(o[2], o[3]); w0.z = pk_bf16(o[4], o[5]); w0.w = pk_bf16(o[6], o[7]);
            w1.x = pk_bf16(o[8], o[9]); w1.y = pk_bf16(o[10], o[11]); w1.z = pk_bf16(o[12], o[13]); w1.w = pk_bf16(o[14], o[15]);
            bf16_t* yr = Y + (size_t)(b * SEQ + ch * 64 + st) * DM + 1024 + h * 128 + sv;
            *(u32x4*)yr = w0; *(u32x4*)(yr + 8) = w1;
        }
    }
#undef ML_PREFETCH
#undef ML_IDS
}

__device__ __forceinline__ void p2_lru(KP P, int l, int item, LAS unsigned char* lds) {
    const int tid = ltid(), lane = tid & 63, wave = tid >> 6, b = item >> 3, cgp = item & 7;
    const float* LA = (const float*)(P->ws + WS_LRUA); const float* LB = (const float*)(P->ws + WS_LRUB); bf16_t* Y = (bf16_t*)(P->ws + WS_HY);
    LAS float* F = LDSF(0);
    const size_t base = (size_t)(b * SEQ + wave * 512) * 512 + cgp * 64 + lane;
    float hh = 0.f, ap = 1.f;
#pragma unroll 8
    for (int t = 0; t < 512; ++t) { const float a = LA[base + (size_t)t * 512], x = LB[base + (size_t)t * 512]; hh = a * hh + x; ap *= a; }
    __syncthreads();
    F[wave * 64 + lane] = ap; F[512 + wave * 64 + lane] = hh;
    __syncthreads();
    float c = 0.f;
    for (int j = 0; j < wave; ++j) c = F[j * 64 + lane] * c + F[512 + j * 64 + lane];
    hh = c;
    bf16_t* yp = Y + (size_t)(b * SEQ + wave * 512) * DM + 1536 + cgp * 64 + lane;
#pragma unroll 8
    for (int t = 0; t < 512; ++t) { const float a = LA[base + (size_t)t * 512], x = LB[base + (size_t)t * 512]; hh = a * hh + x; yp[(size_t)t * DM] = (bf16_t)(pk_bf16(hh, 0.f) & 0xffffu); }

    {
        unsigned* bar0 = (unsigned*)(P->ws + WS_BAR + (size_t)P->li * WS_BAR_STRIDE);
        unsigned* fl = (unsigned*)(P->ws + WS_BAR + (size_t)30 * WS_BAR_STRIDE) + (l * 8 + b) * 64 + 32;
        asm volatile("s_waitcnt vmcnt(0)" ::: "memory");
        __syncthreads();
        if (threadIdx.x == 0) {
            __builtin_amdgcn_fence(__ATOMIC_RELEASE, "agent");
            asm volatile("s_waitcnt vmcnt(0)" ::: "memory");
            (void)xb_add(fl, 1u);
            XB_SPIN(xb_ld(fl) < 8u, bar0);
            __builtin_amdgcn_fence(__ATOMIC_ACQUIRE, "agent");
            asm volatile("s_waitcnt vmcnt(0)" ::: "memory");
        }
        __syncthreads();
        const bf16_t* U = (const bf16_t*)(P->ws + WS_U);
        const int c0 = lane * 8;
        float lrn[8];
#pragma unroll
        for (int j = 0; j < 8; ++j) lrn[j] = P->in[I_LRUNORM][l * 512 + c0 + j];
#pragma unroll 2
        for (int i = 0; i < 64; ++i) {
            const int tok = b * SEQ + cgp * 512 + wave * 64 + i;
            bf16_t* yr = Y + (size_t)tok * DM; const bf16_t* ur = U + (size_t)tok * LDU;
            float hv[8], gb[8], y8[8]; unpack8(*(const u32x4*)(yr + 1536 + c0), hv); unpack8(*(const u32x4*)(ur + U_LRU_G + c0), gb);
            float ss = 0.f;
#pragma unroll
            for (int j = 0; j < 8; ++j) { hv[j] *= gelu_tanhf_(gb[j]); ss += hv[j] * hv[j]; }
            const float rs = rsqrtf(red64(ss) * (1.0f / 512.0f) + 1e-6f);
#pragma unroll
            for (int j = 0; j < 8; ++j) y8[j] = hv[j] * rs * lrn[j];
            *(u32x4*)(yr + 1536 + c0) = pack8(y8);
        }
    }
}

__device__ __forceinline__ void phase_p3(KP P, int l) { (void)P; (void)l; }

#ifndef MK_ONE_LAUNCH
#define MK_ONE_LAUNCH 1
#endif
#ifndef MK_DEBUG_BAR
#define MK_DEBUG_BAR 0
#endif
#ifndef MK_FUSE_MASK
#define MK_FUSE_MASK 0x3FFFFFFull
#endif
#ifndef MK_SEAM_DELAY
#define MK_SEAM_DELAY 0
#endif
#ifndef MK_KIND_MASK
#define MK_KIND_MASK 0x40
#endif
#ifndef MK_P1_SPLIT
#define MK_P1_SPLIT 0
#endif
#ifndef MK_REPEAT_PHASE
#define MK_REPEAT_PHASE (-1)
#endif
#ifndef MK_REPEAT_ITEM
#define MK_REPEAT_ITEM (-1)
#endif
#ifndef MK_REPEAT_KIND
#define MK_REPEAT_KIND (-1)
#endif
#ifndef MK_SIMPLE_BAR
#define MK_SIMPLE_BAR 0
#endif
__device__ __forceinline__ void simple_barrier(unsigned* bar, unsigned& epoch) {
    asm volatile("s_waitcnt vmcnt(0)" ::: "memory");
    __syncthreads();
    if (threadIdx.x == 0) {
        __builtin_amdgcn_fence(__ATOMIC_RELEASE, "agent");
        asm volatile("s_waitcnt vmcnt(0)" ::: "memory");
        (void)xb_add(&bar[XB_TOP], 1u);
        const unsigned target = (epoch + 1u) * gridDim.x;
        XB_SPIN(xb_ld(&bar[XB_TOP]) < target, bar);
        __builtin_amdgcn_fence(__ATOMIC_ACQUIRE, "agent");
        asm volatile("s_waitcnt vmcnt(0)" ::: "memory");
    }
    ++epoch;
    __syncthreads();
}
enum { K_CONVERT = 0, K_MODFINAL, K_NORM, K_UP, K_DOWN, K_WIN, K_P1, K_P2, K_P3, K_WOUT, K_FINAL, K_DOWNF };
template <int KIND> __device__ __forceinline__ void run_phase(int l_, int sub_, LAS unsigned char* lds) {
    const int l = lsgpr(l_), sub = lsgpr(sub_);
    const KP P = kp_fresh();
    const float* modf = (const float*)(P->ws + WS_MODF);
    bf16_t* HY = (bf16_t*)(P->ws + WS_HY); bf16_t* UU = (bf16_t*)(P->ws + WS_U);
    const bf16_t* Wl = (const bf16_t*)(P->ws + WS_W) + (size_t)l * LW_ELEMS;
    bf16_t* XB = (bf16_t*)P->out; bf16_t* X2 = (bf16_t*)(P->ws + WS_LRUA);
    const int xf32 = (l == 0 && sub == 0) ? 1 : 0;
    const void* xcur = xf32 ? (const void*)P->in[I_X] : ((l == 1 && sub == 2) ? (const void*)X2 : (const void*)XB);
    const int f = sub >> 1;
    if constexpr (KIND == K_CONVERT) phase_convert(P, lds);
    if constexpr (KIND == K_MODFINAL) phase_modfinal(P);
    if constexpr (KIND == K_NORM) phase_norm(P, l, sub, xcur, xf32, lds);
    if constexpr (KIND == K_UP) {
        pg8::Gemm g{HY, Wl + (f ? LW_W13B : LW_W13A), NTOK, 2 * DFF, DM}; pg8::StaticOrder S; S.init(NTOK, 2 * DFF, lgdim(), lbid());
        EpiSwiGLU E{UU};
        pg8::gemm_phase<EpiSwiGLU, pg8::StaticOrder, true, true>(lds, g, S, E);
    }
    if constexpr (KIND == K_DOWN) {
        pg8::Gemm g{UU, Wl + (f ? LW_W2B : LW_W2A), NTOK, DM, DFF}; pg8::StaticOrder S; S.init(NTOK, DM, lgdim(), lbid(), 4);
        EpiResid E{xcur, XB, modf + (size_t)l * 8 * NMOD + sub * 6144 + 4096, 0.5f, xf32};
        pg8::gemm_phase<EpiResid, pg8::StaticOrder, true, true>(lds, g, S, E);
    }
    if constexpr (KIND == K_DOWNF) {
        pg8::Gemm g{UU, Wl + (f ? LW_W2B : LW_W2A), NTOK, DM, DFF}; pg8::StaticOrder S; S.init(NTOK, DM, lgdim(), lbid(), 4);
        EpiFinal E{X2, P->out, modf + (size_t)l * 8 * NMOD + sub * 6144 + 4096, 0.5f, P->in[I_FNORM], (float*)(P->ws + WS_RWW), (unsigned*)(P->ws + WS_BAR + (size_t)29 * WS_BAR_STRIDE) + 256,
                   (unsigned*)(P->ws + WS_BAR + (size_t)P->li * WS_BAR_STRIDE), (LAS float*)(lds + pg8::STAGE_BYTES)};
        pg8::gemm_phase<EpiFinal, pg8::StaticOrder, true, true>(lds, g, S, E);
    }
    if constexpr (KIND == K_WIN) {
        pg8::Gemm g{HY, Wl + LW_WIN, NTOK, LDU, DM}; pg8::StaticOrder S; S.init(NTOK, LDU, lgdim(), lbid());
        EpiU E{UU};
        pg8::gemm_phase<EpiU, pg8::StaticOrder, false, true>(lds, g, S, E);
    }
    if constexpr (KIND == K_P1) { const int part = P->pad; if (part != 2) p1_rw_lora(P, l, lds, lbid(), lgdim()); if (part != 1) p1_lru_prep(P, l, lds, lbid(), lgdim()); }
    if constexpr (KIND == K_P2) {
        {
            const int it = lbid();
            if (it >= 64 && it < 128) {
                if (it < 96) { p2_hg(P, l, it - 64, lds); if (MK_REPEAT_ITEM == 1) p2_hg(P, l, it - 64, lds); }
                else { p2_ml(P, l, it - 96, lds); if (MK_REPEAT_ITEM == 2) p2_ml(P, l, it - 96, lds); }
            } else {
                const int w = (it < 64) ? it : it - 64;
                unsigned* ctr = (unsigned*)(P->ws + WS_BAR + (size_t)28 * WS_BAR_STRIDE) + 32 + l * 64;
                unsigned* bar0 = (unsigned*)(P->ws + WS_BAR + (size_t)P->li * WS_BAR_STRIDE);
#define GROUP_BARRIER(c_, n_) do { asm volatile("s_waitcnt vmcnt(0)" ::: "memory"); __syncthreads(); \
                    if (threadIdx.x == 0) { __builtin_amdgcn_fence(__ATOMIC_RELEASE, "agent"); asm volatile("s_waitcnt vmcnt(0)" ::: "memory"); (void)xb_add((c_), 1u); XB_SPIN(xb_ld(c_) < (n_), bar0); \
                        __builtin_amdgcn_fence(__ATOMIC_ACQUIRE, "agent"); asm volatile("s_waitcnt vmcnt(0)" ::: "memory"); } \
                    __syncthreads(); } while (0)
                p1_rw_lora(P, l, lds, w, 192);
                GROUP_BARRIER(ctr, 192u);
                if (it < 64) { _Pragma("unroll 1") for (int rep = 0; rep < ((MK_REPEAT_ITEM == 0) ? 2 : 1); ++rep) p2_rw(P, l, it, lds); }
                else {
                    p1_lru_prep(P, l, lds, it - 128, 128);
                    GROUP_BARRIER(ctr + 16, 128u);
                    if (it < 192) p2_lru(P, l, it - 128, lds);
                }
#undef GROUP_BARRIER
            }
        }
        if (l == 0) convert_dynamic(P, lds);
    }
    if constexpr (KIND == K_P3) phase_p3(P, l);
    if constexpr (KIND == K_WOUT) {
        pg8::Gemm g{HY, Wl + LW_WOUT, NTOK, DM, DM}; pg8::StaticOrder S; S.init(NTOK, DM, lgdim(), lbid(), 4);
        EpiResid E{XB, (l == 1) ? X2 : XB, modf + (size_t)l * 8 * NMOD + 1 * 6144 + 4096, 1.0f, 0};
        pg8::gemm_phase<EpiResid, pg8::StaticOrder, true, true>(lds, g, S, E);
    }
    if constexpr (KIND == K_FINAL) { }
}

template <int KIND> __global__ void __launch_bounds__(NTHR, 2) k_phase(Params P_unused, int l, int sub) {
    extern __shared__ __attribute__((aligned(16))) unsigned char lds_raw[];
    run_phase<KIND>(l, sub, (LAS unsigned char*)lds_raw);
}
constexpr int N_PHASES = 27;
__global__ void __launch_bounds__(NTHR, 2) hymba_fwd(Params P_unused) {
    extern __shared__ __attribute__((aligned(16))) unsigned char lds_raw[];
    LAS unsigned char* lds = (LAS unsigned char*)lds_raw;
    const KP P = kp_fresh();
    const int lo = P->ph_lo, hi = P->ph_hi;
    if (threadIdx.x == 0) *(LAS u32x4*)(lds + LDS_BARW) = (u32x4){0u, 0u, 0u, 0u};
    __syncthreads();
    unsigned* barw = (unsigned*)(P->ws + WS_BAR + (size_t)P->li * WS_BAR_STRIDE);
    XcdBarrier bar = xcd_barrier_post(barw, (volatile LAS unsigned*)(lds + LDS_BARW));
#define SEAM(k) do { if ((k) + 1 < hi) xcd_barrier(bar); } while (0)
#define IN(k) (lo <= (k) && (k) < hi)
#define PH(k, KIND, l, sub) do { if (IN(k)) { run_phase<KIND>(l, sub, lds); if ((MK_REPEAT_KIND) == (KIND) || (MK_REPEAT_PHASE) == (k)) { xcd_barrier(bar); run_phase<KIND>(l, sub, lds); } SEAM(k); } } while (0)
    PH(0, K_CONVERT, 0, 0);
    PH(1, K_MODFINAL, 0, 0);
#define LAYER(l, b, KDOWN2) \
    PH((b) + 0, K_NORM, l, 0); PH((b) + 1, K_UP, l, 0); PH((b) + 2, K_DOWN, l, 0); \
    PH((b) + 3, K_NORM, l, 1); PH((b) + 4, K_WIN, l, 1); PH((b) + 6, K_P2, l, 1); PH((b) + 8, K_WOUT, l, 1); \
    PH((b) + 9, K_NORM, l, 2); PH((b) + 10, K_UP, l, 2); PH((b) + 11, KDOWN2, l, 2);
    LAYER(0, 2, K_DOWN)
    LAYER(1, 14, K_DOWNF)
#undef LAYER
    {
        unsigned bad = 0u;
        if (IN(25)) { for (int li = 0; li < 32; ++li) bad |= __hip_atomic_load((unsigned*)(P->ws + WS_BAR + (size_t)li * WS_BAR_STRIDE) + XB_TMO, __ATOMIC_RELAXED, __HIP_MEMORY_SCOPE_AGENT); }
        if (bad) { const float qn = __builtin_nanf(""); for (size_t i = (size_t)blockIdx.x * NTHR + threadIdx.x; i < (size_t)NTOK * DM; i += (size_t)gridDim.x * NTHR) P->out[i] = qn; }
    }
#undef PH
#undef IN
#undef SEAM
}

#if 1
template <int KIND> static void launch_phase(const Params& p, int l, int sub, int grid, hipStream_t stream) {
    static bool attr_set = false;
    if (!attr_set) { (void)hipFuncSetAttribute((const void*)k_phase<KIND>, hipFuncAttributeMaxDynamicSharedMemorySize, LDS_BYTES); attr_set = true; }
    hipLaunchKernelGGL(k_phase<KIND>, dim3(grid), dim3(NTHR), LDS_BYTES, stream, p, l, sub);
}
#endif
extern "C" void kernel_launch(void* const* d_in, const int* in_sizes, int n_in, void* d_out, int out_size, void* d_ws, size_t ws_size, hipStream_t stream) {
    static int grid = 0;
    if (grid == 0) {
        if (n_in != N_IN || out_size != NTOK * DM || ws_size < WS_END) { fprintf(stderr, "kernel_launch: unexpected shapes (n_in %d, out %d, ws %zu < %zu)\n", n_in, out_size, ws_size, (size_t)WS_END); grid = -1; return; }
        int dev = 0, cus = 0;
        if (hipGetDevice(&dev) != hipSuccess || hipDeviceGetAttribute(&cus, hipDeviceAttributeMultiprocessorCount, dev) != hipSuccess) { grid = -1; return; }
#if MK_ONE_LAUNCH
        int per_cu = 0;
        if (hipFuncSetAttribute((const void*)hymba_fwd, hipFuncAttributeMaxDynamicSharedMemorySize, LDS_BYTES) != hipSuccess) { fprintf(stderr, "kernel_launch: hipFuncSetAttribute failed\n"); grid = -1; return; }
        if (hipOccupancyMaxActiveBlocksPerMultiprocessor(&per_cu, (const void*)hymba_fwd, NTHR, LDS_BYTES) != hipSuccess || per_cu < 1) fprintf(stderr, "kernel_launch: occupancy query says %d\n", per_cu);
        (void)hipGetLastError();
#endif
        grid = cus;
        if (grid != 256) fprintf(stderr, "kernel_launch: %d CUs (built for 256)\n", grid);
    }
    if (grid < 0) return;
    Params p{};
    for (int i = 0; i < N_IN; ++i) p.in[i] = (const float*)d_in[i];
    p.out = (float*)d_out; p.ws = (unsigned char*)d_ws;
#if MK_ONE_LAUNCH
    (void)hipMemsetAsync((char*)d_ws + WS_BAR, 0, 32 * WS_BAR_STRIDE, stream);
    {
        int lo = 0, li = 0;
        for (int k = 0; k < N_PHASES; ++k) {
            const bool fused = (k + 1 < N_PHASES) && ((MK_FUSE_MASK >> k) & 1ull);
            if (!fused) { p.ph_lo = lo; p.ph_hi = k + 1; p.li = li++; hipLaunchKernelGGL(hymba_fwd, dim3(grid), dim3(NTHR), LDS_BYTES, stream, p); lo = k + 1; }
        }
    }
#else
    (void)hipMemsetAsync((char*)d_ws + WS_BAR, 0, 32 * WS_BAR_STRIDE, stream);
    static bool attr2 = false;
    if (!attr2) { (void)hipFuncSetAttribute((const void*)hymba_fwd, hipFuncAttributeMaxDynamicSharedMemorySize, LDS_BYTES); attr2 = true; }
    int k = 0;
#define LAUNCH(KIND, l, sub) do { if ((MK_KIND_MASK >> (KIND)) & 1) { p.ph_lo = k; p.ph_hi = k + 1; p.li = 0; hipLaunchKernelGGL(hymba_fwd, dim3(grid), dim3(NTHR), LDS_BYTES, stream, p); } \
        else { p.ph_lo = 0; p.ph_hi = 0; launch_phase<KIND>(p, l, sub, grid, stream); } ++k; } while (0)
    LAUNCH(K_CONVERT, 0, 0);
    LAUNCH(K_MODFINAL, 0, 0);
    for (int l = 0; l < 2; ++l)
        for (int sub = 0; sub < 3; ++sub) {
            LAUNCH(K_NORM, l, sub);
            if (sub != 1) { LAUNCH(K_UP, l, sub); if (l == 1 && sub == 2) { LAUNCH(K_DOWNF, l, sub); } else { LAUNCH(K_DOWN, l, sub); } }
            else { LAUNCH(K_WIN, l, sub); {
                   if (MK_P1_SPLIT == 0) { LAUNCH(K_P1, l, sub); }
                   else { const int fa = (MK_P1_SPLIT == 1);
                       p.pad = 1; if (fa) { p.ph_lo = k; p.ph_hi = k + 1; p.li = 0; hipLaunchKernelGGL(hymba_fwd, dim3(grid), dim3(NTHR), LDS_BYTES, stream, p); } else { p.ph_lo = 0; p.ph_hi = 0; launch_phase<K_P1>(p, l, sub, grid, stream); }
                       p.pad = 2; if (!fa) { p.ph_lo = k; p.ph_hi = k + 1; p.li = 0; hipLaunchKernelGGL(hymba_fwd, dim3(grid), dim3(NTHR), LDS_BYTES, stream, p); } else { p.ph_lo = 0; p.ph_hi = 0; launch_phase<K_P1>(p, l, sub, grid, stream); }
                       p.pad = 0; ++k; } } LAUNCH(K_P2, l, sub); LAUNCH(K_P3, l, sub); LAUNCH(K_WOUT, l, sub); }
        }
    LAUNCH(K_FINAL, 0, 0);
#undef LAUNCH
#endif
}
```
